# Optimizing an MI355X kernel written in HIP

```python
import math
import jax
import jax.numpy as jnp
from jax import lax

D_MODEL = 1024
BATCH = 16
SEQ = 2048
DEPTH = 4

N_EVEN = (DEPTH + 1) // 2
N_ODD = DEPTH // 2
N_VRES = max(N_EVEN - 1, 0)

MIX_HALF = D_MODEL // 2

RW_WIDTH = MIX_HALF
RW_HEAD_DIM = 64
RW_HEADS = RW_WIDTH // RW_HEAD_DIM
RW_DECAY_RANK = 64
RW_ICLR_RANK = 64
RW_GATE_RANK = 128
RW_VRES_RANK = 32
RW_SHIFT_COLS = 3 * RW_WIDTH + RW_DECAY_RANK + RW_ICLR_RANK + RW_GATE_RANK
RW_SPLITS = (RW_WIDTH, 2 * RW_WIDTH, 3 * RW_WIDTH, 3 * RW_WIDTH + RW_DECAY_RANK,
             3 * RW_WIDTH + RW_DECAY_RANK + RW_ICLR_RANK)
RW_LN_EPS = 64e-5

POOL_WIDTH = MIX_HALF
POOL_WINDOWS = (2, 4, 8, 16)
POOL_GROUPS = len(POOL_WINDOWS)
POOL_GROUP_DIM = POOL_WIDTH // POOL_GROUPS

EVEN_IN = RW_SHIFT_COLS + POOL_WIDTH
EVEN_MIX = RW_WIDTH + POOL_WIDTH

DA_WIDTH = MIX_HALF
DA_HEAD_DIM = 64
DA_VALUE_DIM = 2 * DA_HEAD_DIM
DA_HEADS = DA_WIDTH // DA_VALUE_DIM
DA_QK_COLS = DA_HEADS * 2 * DA_HEAD_DIM
ROPE_THETA = 10000.0
Q_BLOCK = 128
SUBLN_EPS = 1e-5

S5_WIDTH = MIX_HALF
S5_GROUP_DIM = 16
S5_GROUPS = S5_WIDTH // S5_GROUP_DIM
S5_STATE = 64

ODD_IN = 2 * DA_QK_COLS + DA_WIDTH + S5_WIDTH
ODD_MIX = DA_WIDTH + S5_WIDTH

MOE_GROUPS = 4
MOE_EXPERTS_PER_GROUP = 8
MOE_EXPERTS = MOE_GROUPS * MOE_EXPERTS_PER_GROUP
MOE_TOP_K = 2
MOE_HIDDEN = D_MODEL // 2
MOE_BLOCK = 128

RMS_EPS = 1e-6

kernel_name = 'hybrid_rwkv7_pool_diffattn_s5_hmoe'


def rms_norm(x, g, eps=RMS_EPS):
    xf = x.astype(jnp.float32)
    y = xf * lax.rsqrt(jnp.mean(xf * xf, axis=-1, keepdims=True) + eps)
    return (y * g.astype(jnp.float32)).astype(x.dtype)


def token_shift(u):
    return jnp.pad(u, ((0, 0), (1, 0), (0, 0)))[:, :-1]


def rwkv7_recurrence(r, w, k, v, a, b):
    bsz, _, n_heads, n = r.shape
    seq = tuple(jnp.moveaxis(t.astype(jnp.float32), 1, 0) for t in (r, w, k, v, a, b))

    def step(state, inp):
        r_t, w_t, k_t, v_t, a_t, b_t = inp
        sa = jnp.einsum('bhij,bhj->bhi', state, a_t)
        state = (state * w_t[:, :, None, :] + sa[..., None] * b_t[:, :, None, :]
                 + v_t[..., None] * k_t[:, :, None, :])
        return state, jnp.einsum('bhij,bhj->bhi', state, r_t)

    s0 = jnp.zeros((bsz, n_heads, n, n), jnp.float32)
    _, y = lax.scan(step, s0, seq)
    return jnp.moveaxis(y, 0, 1)


def multiscale_pool(u, pool_w, pool_scale):
    bsz, t_len, _ = u.shape
    uf = u.astype(jnp.float32).reshape(bsz, t_len, POOL_GROUPS, POOL_GROUP_DIM)
    csum = jnp.cumsum(uf, axis=1)
    n_seen = jnp.arange(1, t_len + 1, dtype=jnp.float32)
    diffs = []
    for gi, win in enumerate(POOL_WINDOWS):
        c = csum[:, :, gi]
        lagged = jnp.pad(c, ((0, 0), (win, 0), (0, 0)))[:, :t_len]
        mean = (c - lagged) / jnp.minimum(n_seen, float(win))[None, :, None]
        diffs.append(mean - uf[:, :, gi])
    d = jnp.stack(diffs, axis=2).astype(u.dtype)
    y = jnp.einsum('btgc,gcd->btgd', d, pool_w)
    return y.reshape(bsz, t_len, POOL_WIDTH) * pool_scale


def even_mixer(h, v_first, w_in, mu, w0, w2, a0, a2, g2, k_k, k_a, r_k, ln_g, ln_b, vres,
               pool_w, pool_scale, w_out):
    bsz, t_len, _ = h.shape
    u = h @ w_in
    u_rw, u_pool = u[..., :RW_SHIFT_COLS], u[..., RW_SHIFT_COLS:]
    m = u_rw + (token_shift(u_rw) - u_rw) * mu
    r, k, v, dw, da, dg = jnp.split(m, RW_SPLITS, axis=-1)
    w = -jax.nn.softplus(-(w0 + jnp.tanh(dw) @ w2)) - 0.5
    decay = jnp.exp(-jnp.exp(w.astype(jnp.float32)))
    a = jax.nn.sigmoid(a0 + da @ a2)
    g = jax.nn.sigmoid(dg) @ g2
    if v_first is None:
        v_first = v
    else:
        v0, v1, v2 = vres
        v = v + (v_first - v) * jax.nn.sigmoid(v0 + (v @ v1) @ v2)

    def heads(t):
        return t.reshape(bsz, t_len, RW_HEADS, RW_HEAD_DIM)

    kk = heads(k * k_k).astype(jnp.float32)
    kk = kk / jnp.maximum(jnp.sqrt(jnp.sum(kk * kk, axis=-1, keepdims=True)), 1e-12)
    k = k * (1.0 + (a - 1.0) * k_a)
    rh, kh, vh, ah = heads(r), heads(k), heads(v), heads(a)
    y = rwkv7_recurrence(rh, heads(decay), kh, vh, -kk, kk * ah.astype(jnp.float32))
    mean = jnp.mean(y, axis=-1, keepdims=True)
    var = jnp.mean(jnp.square(y - mean), axis=-1, keepdims=True)
    y = ((y - mean) * lax.rsqrt(var + RW_LN_EPS)).reshape(bsz, t_len, RW_WIDTH)
    y = (y * ln_g + ln_b).astype(h.dtype)
    bonus = jnp.sum(rh * kh * r_k, axis=-1, keepdims=True) * vh
    o_rw = (y + bonus.reshape(bsz, t_len, RW_WIDTH)) * g
    o_pool = multiscale_pool(u_pool, pool_w, pool_scale)
    return jnp.concatenate([o_rw, o_pool], axis=-1) @ w_out, v_first


def rope_tables(t_len, dim):
    inv_freq = ROPE_THETA ** (-jnp.arange(0, dim, 2, dtype=jnp.float32) / dim)
    ang = jnp.arange(t_len, dtype=jnp.float32)[:, None] * inv_freq[None, :]
    return jnp.cos(ang), jnp.sin(ang)


def apply_rope(x, cos, sin):
    xf = x.astype(jnp.float32)
    x1, x2 = jnp.split(xf, 2, axis=-1)
    c = cos[:, None, None, :]
    s = sin[:, None, None, :]
    return jnp.concatenate([x1 * c - x2 * s, x2 * c + x1 * s], axis=-1).astype(x.dtype)


def diff_attention(q, k, v, lam):
    t_len = q.shape[1]
    scale = DA_HEAD_DIM ** -0.5
    pos = jnp.arange(t_len)
    outs = []
    for s in range(0, t_len, Q_BLOCK):
        e = s + Q_BLOCK
        sc = jnp.einsum('bqhmd,bkhmd->bhmqk', q[:, s:e], k[:, :e]).astype(jnp.float32) * scale
        mask = pos[s:e, None] >= pos[None, :e]
        p = jax.nn.softmax(jnp.where(mask, sc, -jnp.inf), axis=-1)
        attn = p[:, :, 0] - lam * p[:, :, 1]
        outs.append(jnp.einsum('bhqk,bkhd->bqhd', attn.astype(v.dtype), v[:, :e]))
    return jnp.concatenate(outs, axis=1)


def s5_mixer(u, a_re, a_im, log_step, b_re, b_im, c_re, c_im, d_skip, w_glu):
    bsz, t_len, _ = u.shape
    f32 = jnp.float32
    uf = u.astype(f32).reshape(bsz, t_len, S5_GROUPS, S5_GROUP_DIM)
    lam = lax.complex(jnp.minimum(a_re.astype(f32), -1e-4), a_im.astype(f32))
    step = jnp.exp(log_step.astype(f32))
    lam_bar = jnp.exp(lam * step)
    b_bar = ((lam_bar - 1.0) / lam)[..., None] * lax.complex(b_re.astype(f32), b_im.astype(f32))
    c_mat = lax.complex(c_re.astype(f32), c_im.astype(f32))
    bu = jnp.einsum('gpc,btgc->btgp', b_bar, uf.astype(jnp.complex64))
    a_seq = jnp.broadcast_to(lam_bar, bu.shape)

    def combine(left, right):
        a_l, b_l = left
        a_r, b_r = right
        return a_r * a_l, a_r * b_l + b_r

    _, states = lax.associative_scan(combine, (a_seq, bu), axis=1)
    y = jnp.einsum('gcp,btgp->btgc', c_mat, states).real + d_skip.astype(f32) * uf
    z = jax.nn.gelu(y.reshape(bsz, t_len, S5_WIDTH)).astype(u.dtype)
    return z * jax.nn.sigmoid(z @ w_glu)


def odd_mixer(h, layer_idx, w_in, q_norm, k_norm, lam_q1, lam_k1, lam_q2, lam_k2, subln,
              a_re, a_im, log_step, b_re, b_im, c_re, c_im, d_skip, w_glu, w_out):
    bsz, t_len, _ = h.shape
    f32 = jnp.float32
    u = h @ w_in
    q, k, v, u_s5 = jnp.split(u, (DA_QK_COLS, 2 * DA_QK_COLS, 2 * DA_QK_COLS + DA_WIDTH), axis=-1)
    q = q.reshape(bsz, t_len, DA_HEADS, 2, DA_HEAD_DIM)
    k = k.reshape(bsz, t_len, DA_HEADS, 2, DA_HEAD_DIM)
    v = v.reshape(bsz, t_len, DA_HEADS, DA_VALUE_DIM)
    cos, sin = rope_tables(t_len, DA_HEAD_DIM)
    q = apply_rope(rms_norm(q, q_norm), cos, sin)
    k = apply_rope(rms_norm(k, k_norm), cos, sin)
    lam_init = 0.8 - 0.6 * math.exp(-0.3 * layer_idx)
    lam = (jnp.exp(jnp.sum(lam_q1.astype(f32) * lam_k1.astype(f32)))
           - jnp.exp(jnp.sum(lam_q2.astype(f32) * lam_k2.astype(f32))) + lam_init)
    o = diff_attention(q, k, v, lam)
    o = rms_norm(o, subln, SUBLN_EPS) * (1.0 - lam_init)
    o_attn = o.reshape(bsz, t_len, DA_WIDTH)
    o_ssm = s5_mixer(u_s5, a_re, a_im, log_step, b_re, b_im, c_re, c_im, d_skip, w_glu)
    return jnp.concatenate([o_attn, o_ssm], axis=-1) @ w_out


def routed_experts(hf, expert_idx, gates, w_gate, w_up, w_down):
    n_tok, d = hf.shape
    n_slot = n_tok * MOE_TOP_K
    flat_e = expert_idx.reshape(-1)
    flat_tok = jnp.arange(n_slot, dtype=jnp.int32) // MOE_TOP_K
    flat_g = gates.reshape(-1)
    order = jnp.argsort(flat_e)
    sorted_e = flat_e[order]
    counts = jnp.bincount(flat_e, length=MOE_EXPERTS)
    padded = (counts + MOE_BLOCK - 1) // MOE_BLOCK * MOE_BLOCK
    seg_start = jnp.cumsum(counts) - counts
    cum_padded = jnp.cumsum(padded)
    pad_start = cum_padded - padded
    dest = pad_start[sorted_e] + jnp.arange(n_slot, dtype=jnp.int32) - seg_start[sorted_e]
    n_blocks = -(-n_slot // MOE_BLOCK) + MOE_EXPERTS
    n_pad = n_blocks * MOE_BLOCK
    buf_tok = jnp.full((n_pad,), n_tok, jnp.int32).at[dest].set(flat_tok[order])
    buf_gate = jnp.zeros((n_pad,), jnp.float32).at[dest].set(flat_g[order])
    block_start = jnp.arange(n_blocks, dtype=cum_padded.dtype) * MOE_BLOCK
    block_expert = jnp.minimum(jnp.searchsorted(cum_padded, block_start, side='right'),
                               MOE_EXPERTS - 1).astype(jnp.int32)
    h_pad = jnp.concatenate([hf, jnp.zeros((1, d), hf.dtype)], axis=0)

    def run_block(args):
        tok, e, gt = args
        xb = h_pad[tok]
        hidden = jax.nn.silu(xb @ w_gate[e]) * (xb @ w_up[e])
        return (hidden @ w_down[e]) * gt[:, None].astype(xb.dtype)

    ys = lax.map(run_block, (buf_tok.reshape(n_blocks, MOE_BLOCK), block_expert,
                             buf_gate.reshape(n_blocks, MOE_BLOCK)))
    out = jnp.zeros((n_tok + 1, d), hf.dtype).at[buf_tok].add(ys.reshape(n_pad, d))
    return out[:n_tok]


def hier_moe(h, w_group, b_group, w_expert, b_expert, w_gate, w_up, w_down):
    bsz, t_len, d = h.shape
    n_tok = bsz * t_len
    hf = h.reshape(n_tok, d)
    rows = jnp.arange(n_tok)
    g_logits = (hf @ w_group + b_group).astype(jnp.float32)
    g_prob = jax.nn.softmax(g_logits, axis=-1)
    g_top = jnp.argmax(g_logits, axis=-1).astype(jnp.int32)
    g_w = g_prob[rows, g_top]
    e_logits = (hf @ w_expert + b_expert).astype(jnp.float32)
    e_logits = e_logits.reshape(n_tok, MOE_GROUPS, MOE_EXPERTS_PER_GROUP)[rows, g_top]
    e_prob = jax.nn.softmax(e_logits, axis=-1)
    top_p, top_j = lax.top_k(e_prob, MOE_TOP_K)
    gates = g_w[:, None] * top_p / jnp.sum(top_p, axis=-1, keepdims=True)
    expert_idx = g_top[:, None] * MOE_EXPERTS_PER_GROUP + top_j.astype(jnp.int32)
    y = routed_experts(hf, expert_idx, gates, w_gate, w_up, w_down)
    return y.reshape(bsz, t_len, d)


def setup_inputs(seed: int = 0) -> dict:
    key = jax.random.key(seed)
    keys = jax.random.split(key, 64)
    counter = [0]

    def nk():
        counter[0] += 1
        return keys[counter[0] - 1]

    f32 = jnp.float32

    def nrm(shape, scale):
        return scale * jax.random.normal(nk(), shape, f32)

    def gain(shape, base=1.0, noise=0.02):
        return base + noise * jax.random.normal(nk(), shape, f32)

    def unif(shape, lo, hi):
        return jax.random.uniform(nk(), shape, f32, lo, hi)

    d = D_MODEL
    res = (2.0 * DEPTH) ** -0.5
    return {
        'x': nrm((BATCH, SEQ, d), 1.0),
        'norm_mix_g': gain((DEPTH, d)),
        'norm_ffn_g': gain((DEPTH, d)),
        'even_w_in': nrm((N_EVEN, d, EVEN_IN), d ** -0.5),
        'rw_mu': unif((N_EVEN, RW_SHIFT_COLS), 0.0, 1.0),
        'rw_w0': unif((N_EVEN, RW_WIDTH), -6.0, -1.0),
        'rw_w2': nrm((N_EVEN, RW_DECAY_RANK, RW_WIDTH), RW_DECAY_RANK ** -0.5),
        'rw_a0': nrm((N_EVEN, RW_WIDTH), 0.1),
        'rw_a2': nrm((N_EVEN, RW_ICLR_RANK, RW_WIDTH), RW_ICLR_RANK ** -0.5),
        'rw_g2': nrm((N_EVEN, RW_GATE_RANK, RW_WIDTH), RW_GATE_RANK ** -0.5),
        'rw_k_k': gain((N_EVEN, RW_WIDTH), 0.85, 0.05),
        'rw_k_a': gain((N_EVEN, RW_WIDTH), 1.0, 0.05),
        'rw_r_k': nrm((N_EVEN, RW_HEADS, RW_HEAD_DIM), 0.1),
        'rw_ln_g': gain((N_EVEN, RW_WIDTH)),
        'rw_ln_b': nrm((N_EVEN, RW_WIDTH), 0.02),
        'rw_v0': nrm((N_VRES, RW_WIDTH), 0.1),
        'rw_v1': nrm((N_VRES, RW_WIDTH, RW_VRES_RANK), RW_WIDTH ** -0.5),
        'rw_v2': nrm((N_VRES, RW_VRES_RANK, RW_WIDTH), RW_VRES_RANK ** -0.5),
        'pool_w': nrm((N_EVEN, POOL_GROUPS, POOL_GROUP_DIM, POOL_GROUP_DIM), POOL_GROUP_DIM ** -0.5),
        'pool_scale': gain((N_EVEN, POOL_WIDTH)),
        'even_w_out': nrm((N_EVEN, EVEN_MIX, d), EVEN_MIX ** -0.5 * res),
        'odd_w_in': nrm((N_ODD, d, ODD_IN), d ** -0.5),
        'da_q_norm': gain((N_ODD, DA_HEAD_DIM)),
        'da_k_norm': gain((N_ODD, DA_HEAD_DIM)),
        'da_lam_q1': nrm((N_ODD, DA_HEAD_DIM), 0.1),
        'da_lam_k1': nrm((N_ODD, DA_HEAD_DIM), 0.1),
        'da_lam_q2': nrm((N_ODD, DA_HEAD_DIM), 0.1),
        'da_lam_k2': nrm((N_ODD, DA_HEAD_DIM), 0.1),
        'da_subln': gain((N_ODD, DA_VALUE_DIM)),
        's5_a_re': gain((N_ODD, S5_GROUPS, S5_STATE), -0.5, 0.01),
        's5_a_im': math.pi * jnp.arange(S5_STATE, dtype=f32) + nrm((N_ODD, S5_GROUPS, S5_STATE), 0.01),
        's5_log_step': unif((N_ODD, S5_GROUPS, S5_STATE), math.log(1e-3), math.log(1e-1)),
        's5_b_re': nrm((N_ODD, S5_GROUPS, S5_STATE, S5_GROUP_DIM), (2.0 * S5_GROUP_DIM) ** -0.5),
        's5_b_im': nrm((N_ODD, S5_GROUPS, S5_STATE, S5_GROUP_DIM), (2.0 * S5_GROUP_DIM) ** -0.5),
        's5_c_re': nrm((N_ODD, S5_GROUPS, S5_GROUP_DIM, S5_STATE), (2.0 * S5_STATE) ** -0.5),
        's5_c_im': nrm((N_ODD, S5_GROUPS, S5_GROUP_DIM, S5_STATE), (2.0 * S5_STATE) ** -0.5),
        's5_d': nrm((N_ODD, S5_GROUPS, S5_GROUP_DIM), 1.0),
        's5_w_glu': nrm((N_ODD, S5_WIDTH, S5_WIDTH), S5_WIDTH ** -0.5),
        'odd_w_out': nrm((N_ODD, ODD_MIX, d), ODD_MIX ** -0.5 * res),
        'moe_w_group': nrm((DEPTH, d, MOE_GROUPS), d ** -0.5),
        'moe_b_group': nrm((DEPTH, MOE_GROUPS), 0.01),
        'moe_w_expert': nrm((DEPTH, d, MOE_EXPERTS), d ** -0.5),
        'moe_b_expert': nrm((DEPTH, MOE_EXPERTS), 0.01),
        'moe_w_gate': nrm((DEPTH, MOE_EXPERTS, d, MOE_HIDDEN), d ** -0.5),
        'moe_w_up': nrm((DEPTH, MOE_EXPERTS, d, MOE_HIDDEN), d ** -0.5),
        'moe_w_down': nrm((DEPTH, MOE_EXPERTS, MOE_HIDDEN, d), MOE_HIDDEN ** -0.5 * res),
    }


def reference(x, norm_mix_g, norm_ffn_g,
              even_w_in, rw_mu, rw_w0, rw_w2, rw_a0, rw_a2, rw_g2, rw_k_k, rw_k_a, rw_r_k,
              rw_ln_g, rw_ln_b, rw_v0, rw_v1, rw_v2, pool_w, pool_scale, even_w_out,
              odd_w_in, da_q_norm, da_k_norm, da_lam_q1, da_lam_k1, da_lam_q2, da_lam_k2, da_subln,
              s5_a_re, s5_a_im, s5_log_step, s5_b_re, s5_b_im, s5_c_re, s5_c_im, s5_d, s5_w_glu,
              odd_w_out,
              moe_w_group, moe_b_group, moe_w_expert, moe_b_expert, moe_w_gate, moe_w_up, moe_w_down):
    v_first = None
    for layer in range(DEPTH):
        i = layer // 2
        h = rms_norm(x, norm_mix_g[layer])
        if layer % 2 == 0:
            vres = None if v_first is None else (rw_v0[i - 1], rw_v1[i - 1], rw_v2[i - 1])
            mix, v_first = even_mixer(h, v_first, even_w_in[i], rw_mu[i], rw_w0[i], rw_w2[i],
                                      rw_a0[i], rw_a2[i], rw_g2[i], rw_k_k[i], rw_k_a[i], rw_r_k[i],
                                      rw_ln_g[i], rw_ln_b[i], vres, pool_w[i], pool_scale[i],
                                      even_w_out[i])
        else:
            mix = odd_mixer(h, layer, odd_w_in[i], da_q_norm[i], da_k_norm[i], da_lam_q1[i],
                            da_lam_k1[i], da_lam_q2[i], da_lam_k2[i], da_subln[i], s5_a_re[i],
                            s5_a_im[i], s5_log_step[i], s5_b_re[i], s5_b_im[i], s5_c_re[i],
                            s5_c_im[i], s5_d[i], s5_w_glu[i], odd_w_out[i])
        x = x + mix
        h = rms_norm(x, norm_ffn_g[layer])
        x = x + hier_moe(h, moe_w_group[layer], moe_b_group[layer], moe_w_expert[layer],
                         moe_b_expert[layer], moe_w_gate[layer], moe_w_up[layer], moe_w_down[layer])
    return x
```

```cpp
#include <hip/hip_runtime.h>
#include <stdint.h>
#include <stdio.h>

typedef unsigned short bfr;
typedef __attribute__((ext_vector_type(8))) short bf16x8;
typedef __attribute__((ext_vector_type(16))) float f32x16;
typedef __attribute__((ext_vector_type(2))) __bf16 bf16x2_t;
#define DI __device__ __forceinline__
#define MFMA32(a, b, c) __builtin_amdgcn_mfma_f32_32x32x16_bf16((a), (b), (c), 0, 0, 0)

constexpr int NTOK = 32768, DM = 1024, SEQ = 2048, NB = 16;
constexpr int EVEN_IN = 2304, ODD_IN = 2048;
constexpr int NTHREADS = 256;
constexpr int LDS_BYTES = 81920;

enum { I_X = 0, I_NMIX, I_NFFN, I_EWIN, I_MU, I_W0, I_W2, I_A0, I_A2, I_G2, I_KK, I_KA, I_RK, I_LNG, I_LNB, I_V0, I_V1, I_V2,
       I_POOLW, I_POOLS, I_EWOUT, I_OWIN, I_QN, I_KN, I_LQ1, I_LK1, I_LQ2, I_LK2, I_SUBLN, I_ARE, I_AIM, I_LSTEP, I_BRE, I_BIM,
       I_CRE, I_CIM, I_S5D, I_WGLU, I_OWOUT, I_MWG, I_MBG, I_MWE, I_MBE, I_MWGATE, I_MWUP, I_MWDOWN, N_INPUTS };

constexpr size_t al256(size_t x) { return (x + 255) & ~(size_t)255; }
constexpr size_t OFF_BAR   = 0;
constexpr size_t OFF_CNT   = 16384;
constexpr size_t OFF_ZERO_END = 32768;
constexpr size_t OFF_WINE  = 65536;
constexpr size_t OFF_WOUTE = OFF_WINE  + (size_t)2 * 2304 * 1024 * 2;
constexpr size_t OFF_WINO  = OFF_WOUTE + (size_t)2 * 1024 * 1024 * 2;
constexpr size_t OFF_WOUTO = OFF_WINO  + (size_t)2 * 2048 * 1024 * 2;
constexpr size_t OFF_W2T   = OFF_WOUTO + (size_t)2 * 1024 * 1024 * 2;
constexpr size_t OFF_A2T   = OFF_W2T   + (size_t)2 * 512 * 64 * 2;
constexpr size_t OFF_G2T   = OFF_A2T   + (size_t)2 * 512 * 64 * 2;
constexpr size_t OFF_V12T  = OFF_G2T   + (size_t)2 * 512 * 128 * 2;
constexpr size_t OFF_POOLT = OFF_V12T  + (size_t)512 * 512 * 2;
constexpr size_t OFF_GLUT  = OFF_POOLT + (size_t)2 * 4 * 128 * 128 * 2;
constexpr size_t OFF_RHI   = OFF_GLUT  + (size_t)2 * 512 * 512 * 2;
constexpr size_t OFF_RLO   = OFF_RHI   + (size_t)4 * 128 * 1024 * 2;
constexpr size_t OFF_S5GT  = OFF_RLO   + (size_t)4 * 128 * 1024 * 2;
constexpr size_t OFF_S5BL  = OFF_S5GT  + (size_t)2 * 32 * 512 * 640 * 2;
constexpr size_t OFF_S5L32 = OFF_S5BL  + (size_t)2 * 32 * 128 * 512 * 2;
constexpr size_t OFF_MWGU  = al256(OFF_S5L32 + (size_t)2 * 32 * 64 * 2 * 4);
constexpr size_t OFF_MWD   = OFF_MWGU  + (size_t)32 * 1024 * 1024 * 2;
constexpr size_t OFF_HB    = OFF_MWD   + (size_t)32 * 1024 * 512 * 2;
constexpr size_t OFF_U     = OFF_HB    + (size_t)NTOK * 1024 * 2;
constexpr size_t OFF_US5   = OFF_U     + (size_t)NTOK * 1024 * 2;
constexpr size_t OFF_AMIX  = OFF_U     + (size_t)NTOK * 2304 * 2;
constexpr size_t OFF_VFIRST= OFF_AMIX  + (size_t)NTOK * 1024 * 2;
constexpr size_t OFF_TOK   = OFF_VFIRST+ (size_t)NTOK * 512 * 2;
constexpr size_t OFF_GATE  = OFF_TOK   + (size_t)64 * NTOK * 4;
constexpr size_t OFF_HID   = OFF_GATE  + (size_t)64 * NTOK * 4;
constexpr size_t OFF_HLO   = OFF_HID;
constexpr size_t OFF_EV    = OFF_HID   + (size_t)73728 * 512 * 2;
constexpr size_t OFF_S     = OFF_EV;
constexpr size_t OFF_MV2   = OFF_S     + (size_t)NTOK * 256 * 2;
constexpr size_t OFF_DLOG  = OFF_MV2   + (size_t)NTOK * 512 * 2;
constexpr size_t OFF_ABUF  = OFF_DLOG  + (size_t)NTOK * 512 * 4;
constexpr size_t OFF_GBUF  = OFF_ABUF  + (size_t)NTOK * 512 * 2;
constexpr size_t OFF_VGATE = OFF_GBUF  + (size_t)NTOK * 512 * 2;
constexpr size_t OFF_Y     = OFF_VGATE + (size_t)NTOK * 512 * 2;
constexpr size_t OFF_DPOOL = OFF_Y;
constexpr size_t OFF_BONUS = OFF_Y     + (size_t)NTOK * 512 * 4;
constexpr size_t OFF_EV_END= OFF_BONUS + (size_t)NTOK * 512 * 4;
constexpr size_t OFF_QN    = OFF_EV;
constexpr size_t OFF_KN    = OFF_QN    + (size_t)NTOK * 512 * 2;
constexpr size_t OFF_VT    = OFF_KN    + (size_t)NTOK * 512 * 2;
constexpr size_t OFF_XLOC  = OFF_VT    + (size_t)NTOK * 512 * 2;
constexpr size_t OFF_XIN   = OFF_XLOC  + (size_t)32 * 1024 * 128 * 4;
constexpr size_t OFF_ZBUF  = OFF_XIN   + (size_t)32 * 1024 * 128 * 2;
constexpr size_t OFF_OD_END= OFF_ZBUF  + (size_t)NTOK * 512 * 2;
constexpr size_t WS_NEEDED = OFF_EV_END > OFF_OD_END ? OFF_EV_END : OFF_OD_END;

struct Params {
    const float* in[N_INPUTS];
    float* out;
    unsigned char* ws;
    int ph_lo, ph_hi;
};
typedef const __attribute__((address_space(4))) char* KArgPtr;
struct InTab {
    KArgPtr p;
    DI const float* operator[](int i) const {
        const float* q = *(const float* const __attribute__((address_space(4)))*)(p + 8 * i);
        return (const float*)(const __attribute__((address_space(1))) float*)q;
    }
};
struct Ctx { InTab in; unsigned char* ws; float* out; };

DI unsigned pk2(float a, float b) { bf16x2_t v; v[0] = (__bf16)a; v[1] = (__bf16)b; return __builtin_bit_cast(unsigned, v); }
DI bfr f2bf(float a) { return (bfr)(pk2(a, 0.f) & 0xffffu); }
DI float bf2f(bfr b) { return __uint_as_float(((unsigned)b) << 16); }
DI float bflo(unsigned u) { return __uint_as_float(u << 16); }
DI float bfhi(unsigned u) { return __uint_as_float(u & 0xffff0000u); }
DI uint4 pack8(const float (&v)[8]) { return make_uint4(pk2(v[0], v[1]), pk2(v[2], v[3]), pk2(v[4], v[5]), pk2(v[6], v[7])); }
DI void unpack8(uint4 u, float (&v)[8]) { v[0] = bflo(u.x); v[1] = bfhi(u.x); v[2] = bflo(u.y); v[3] = bfhi(u.y); v[4] = bflo(u.z); v[5] = bfhi(u.z); v[6] = bflo(u.w); v[7] = bfhi(u.w); }
DI float sigmoidf_(float x) { return 1.0f / (1.0f + __expf(-x)); }
template <int CTRL> DI float dpp_f(float x) { return __builtin_bit_cast(float, __builtin_amdgcn_update_dpp(0, __builtin_bit_cast(int, x), CTRL, 0xf, 0xf, false)); }
DI float row16_sum(float s) {
    s += dpp_f<0x128>(s); s += dpp_f<0x124>(s); s += dpp_f<0x122>(s); s += dpp_f<0x121>(s); return s; }
DI int ltid() { int t = threadIdx.x; asm volatile("" : "+v"(t)); return t; }
DI float wave_sum(float s) { s = row16_sum(s); s += __shfl_xor(s, 16); s += __shfl_xor(s, 32); return s; }
#define XB_TMO      128
#define XB_XCNT(j)  (256  + 64 * (j))
#define XB_XSUB(j)  (1280 + 64 * (j))
#define XB_XGEN(j)  (2304 + 64 * (j))
#define XB_TOP      3328
#define XB_TOPGEN   3392
#define XCD_BAR_WORDS 3456
#define XB_SPIN_CAP (1u << 18)
#define LAS __attribute__((address_space(3)))

__device__ __forceinline__ unsigned xb_ld(unsigned* p)              { return __hip_atomic_load(p, __ATOMIC_RELAXED, __HIP_MEMORY_SCOPE_AGENT); }
__device__ __forceinline__ unsigned xb_add(unsigned* p, unsigned v) { return __hip_atomic_fetch_add(p, v, __ATOMIC_RELAXED, __HIP_MEMORY_SCOPE_AGENT); }
__device__ __forceinline__ unsigned xb_xcc_id() { return (unsigned)__builtin_amdgcn_s_getreg((3 << 11) | 20) & 0xFu; }
#define XB_SPIN(cond, bar) do { unsigned _sp = 0; while (cond) { __builtin_amdgcn_s_sleep(1); \
    if ((++_sp & 255u) == 0u) { if (xb_ld(&(bar)[XB_TMO])) break; if (_sp > XB_SPIN_CAP) { atomicAdd(&(bar)[XB_TMO], 1u); break; } } } } while (0)

struct XcdBarrier {
    unsigned* bar; unsigned x;
    volatile LAS unsigned* st;
};
__device__ __forceinline__ XcdBarrier xcd_barrier_post(unsigned* bar, volatile LAS unsigned* st) {
    XcdBarrier b; b.bar = bar; b.x = xb_xcc_id(); b.st = st;
    if (threadIdx.x == 0) (void)xb_add(&bar[XB_XCNT(b.x)], 1u);
    return b;
}
__device__ __forceinline__ void xcd_barrier_complete(unsigned* bar, unsigned x, unsigned& nloc, unsigned& nx) {
    const unsigned G = gridDim.x * gridDim.y * gridDim.z;
    unsigned sum, cnt, mine, sp = 0u;
    for (;;) {
        sum = 0u; cnt = 0u; mine = 0u;
#pragma unroll
        for (unsigned j = 0; j < 16; ++j) { const unsigned c = xb_ld(&bar[XB_XCNT(j)]); sum += c; cnt += (c > 0u) ? 1u : 0u; mine = (j == x) ? c : mine; }
        if (sum == G) break;
        __builtin_amdgcn_s_sleep(1);
        if ((++sp & 255u) == 0u) { if (xb_ld(&bar[XB_TMO])) break; if (sp > XB_SPIN_CAP) { atomicAdd(&bar[XB_TMO], 1u); break; } }
    }
    nloc = mine > 0u ? mine : 1u; nx = cnt > 0u ? cnt : 1u;
}
__device__ __forceinline__ void xcd_barrier(const XcdBarrier& b) {
    asm volatile("s_waitcnt vmcnt(0)" ::: "memory");
    __syncthreads();
    if (threadIdx.x == 0) {
        unsigned* bar = b.bar;
        __builtin_amdgcn_s_waitcnt(0);
        unsigned nloc = b.st[0], nx = b.st[1];
        if (nloc == 0u) { xcd_barrier_complete(bar, b.x, nloc, nx); b.st[0] = nloc; b.st[1] = nx; }
        const unsigned old = xb_add(&bar[XB_XSUB(b.x)], 1u);
        const unsigned gen = old / nloc;
        if (old + 1u == (gen + 1u) * nloc) {
            __builtin_amdgcn_fence(__ATOMIC_RELEASE, "agent");
            asm volatile("s_waitcnt vmcnt(0)" ::: "memory");
            const unsigned og = xb_add(&bar[XB_TOP], 1u);
            const unsigned tg = og / nx;
            if (og + 1u == (tg + 1u) * nx) xb_add(&bar[XB_TOPGEN], 1u);
            else XB_SPIN(xb_ld(&bar[XB_TOPGEN]) == tg, bar);
            __builtin_amdgcn_fence(__ATOMIC_ACQUIRE, "agent");
            xb_add(&bar[XB_XGEN(b.x)], 1u);
            asm volatile("s_waitcnt vmcnt(0)" ::: "memory");
        } else {
            XB_SPIN(xb_ld(&bar[XB_XGEN(b.x)]) == gen, bar);
            __builtin_amdgcn_fence(__ATOMIC_ACQUIRE, "agent");
            asm volatile("s_waitcnt vmcnt(0)" ::: "memory");
        }
    }
    __syncthreads();
}

constexpr int LDA = 72;
constexpr int TILE_B = 128 * LDA * 2;
constexpr int STG_LD = 132;
constexpr int LDS_AUX = 73728;

template <class AF, class BF, class EF>
DI void gemm_tile(char* lds, int nk, AF aptr, BF bptr, EF epi) {
    const int tid = ltid(), lane = tid & 63, wave = tid >> 6;
    const int wr = wave >> 1, wc = wave & 1;
    const int lrow = tid >> 3, lcol = (tid & 7) * 8;
    f32x16 acc[2][2];
#pragma unroll
    for (int a = 0; a < 2; ++a)
#pragma unroll
        for (int b = 0; b < 2; ++b)
#pragma unroll
            for (int r = 0; r < 16; ++r) acc[a][b][r] = 0.f;
    uint4 ra[4], rb[4];
#pragma unroll
    for (int i = 0; i < 4; ++i) { ra[i] = *(const uint4*)aptr(i, 0); rb[i] = *(const uint4*)bptr(i, 0); }
    const int st_off = (lrow * LDA + lcol) * 2;
#pragma unroll
    for (int i = 0; i < 4; ++i) {
        *(uint4*)(lds + st_off + i * (32 * LDA * 2)) = ra[i];
        *(uint4*)(lds + TILE_B + st_off + i * (32 * LDA * 2)) = rb[i];
    }
    __syncthreads();
    const int a_off = ((wr * 64 + (lane & 31)) * LDA + (lane >> 5) * 8) * 2;
    const int b_off = TILE_B + ((wc * 64 + (lane & 31)) * LDA + (lane >> 5) * 8) * 2;
    int buf = 0;
    for (int kt = 0; kt < nk; ++kt) {
        const bool more = (kt + 1 < nk);
        if (more) {
#pragma unroll
            for (int i = 0; i < 4; ++i) { ra[i] = *(const uint4*)aptr(i, kt + 1); rb[i] = *(const uint4*)bptr(i, kt + 1); }
        }
        const char* base = lds + buf * (2 * TILE_B);
#pragma unroll
        for (int ks = 0; ks < 4; ++ks) {
            const bf16x8 a0 = *(const bf16x8*)(base + a_off + ks * 32);
            const bf16x8 a1 = *(const bf16x8*)(base + a_off + ks * 32 + 32 * LDA * 2);
            const bf16x8 b0 = *(const bf16x8*)(base + b_off + ks * 32);
            const bf16x8 b1 = *(const bf16x8*)(base + b_off + ks * 32 + 32 * LDA * 2);
            acc[0][0] = MFMA32(a0, b0, acc[0][0]);
            acc[0][1] = MFMA32(a0, b1, acc[0][1]);
            acc[1][0] = MFMA32(a1, b0, acc[1][0]);
            acc[1][1] = MFMA32(a1, b1, acc[1][1]);
        }
        if (more) {
            char* nb = lds + (buf ^ 1) * (2 * TILE_B);
#pragma unroll
            for (int i = 0; i < 4; ++i) {
                *(uint4*)(nb + st_off + i * (32 * LDA * 2)) = ra[i];
                *(uint4*)(nb + TILE_B + st_off + i * (32 * LDA * 2)) = rb[i];
            }
        }
        __syncthreads();
        buf ^= 1;
    }
    float* stg = (float*)lds;
#pragma unroll
    for (int mi = 0; mi < 2; ++mi)
#pragma unroll
        for (int ni = 0; ni < 2; ++ni)
#pragma unroll
            for (int r = 0; r < 16; ++r) {
                const int row = wr * 64 + mi * 32 + (r & 3) + 8 * (r >> 2) + 4 * (lane >> 5);
                const int col = wc * 64 + ni * 32 + (lane & 31);
                stg[row * STG_LD + col] = acc[mi][ni][r];
            }
    __syncthreads();
    epi((const float*)stg);
    __syncthreads();
}
template <class F> DI void epi_rows8(const float* stg, F f) {
    const int tid0 = ltid();
#pragma unroll
    for (int it = 0; it < 8; ++it) {
        const int idx = it * NTHREADS + tid0;
        const int r = idx >> 4, c0 = (idx & 15) * 8;
        const float4 p = *(const float4*)(stg + r * STG_LD + c0);
        const float4 q = *(const float4*)(stg + r * STG_LD + c0 + 4);
        const float v[8] = {p.x, p.y, p.z, p.w, q.x, q.y, q.z, q.w};
        f(r, c0, v);
    }
}
struct RowLoader {
    const bfr* p; size_t ld;
    DI RowLoader(const bfr* base, int row0, size_t ld_) : ld(ld_) { const int t = ltid(); p = base + (size_t)(row0 + (t >> 3)) * ld_ + (t & 7) * 8; }
    DI const bfr* operator()(int i, int kt) const { return p + (size_t)(32 * i) * ld + kt * 64; }
};
DI int cvt_rowmap(int n, int mode) { return mode == 0 ? n : ((n >> 2) * 8 + (n & 3) + (mode == 2 ? 4 : 0)); }
DI void cvt_tile(char* lds, const float* __restrict__ src, int N, bfr* __restrict__ dst, int ldd, int k0, int n0, int mode) {
    float* t = (float*)lds;
    const int tid = ltid();
    const int r = tid >> 4, c = (tid & 15) * 4;
#pragma unroll
    for (int i = 0; i < 4; ++i) {
        const float4 v = *(const float4*)(src + (size_t)(k0 + r + 16 * i) * N + n0 + c);
        float* d = t + (r + 16 * i) * 65 + c;
        d[0] = v.x; d[1] = v.y; d[2] = v.z; d[3] = v.w;
    }
    __syncthreads();
#pragma unroll
    for (int i = 0; i < 2; ++i) {
        const int idx = tid + i * 256;
        const int n = idx & 63, kg = idx >> 6;
        float v[8];
#pragma unroll
        for (int j = 0; j < 8; ++j) v[j] = t[(kg * 8 + j) * 65 + n];
        *(uint4*)(dst + (size_t)cvt_rowmap(n0 + n, mode) * ldd + k0 + kg * 8) = pack8(v);
    }
    __syncthreads();
}
DI void cvt_matrix(char* lds, const float* src, int K, int N, bfr* dst, int ldd, int mode, int worker, int nworkers, unsigned& base) {
    if (worker < 0) return;
    const int ntn = N >> 6, ntiles = (K >> 6) * ntn;
    int t0 = (int)(((unsigned)worker + (unsigned)nworkers - (base % (unsigned)nworkers)) % (unsigned)nworkers);
    for (int t = t0; t < ntiles; t += nworkers) cvt_tile(lds, src, N, dst, ldd, (t / ntn) * 64, (t % ntn) * 64, mode);
    base += (unsigned)ntiles;
}
DI void moe_convert(char* lds, const Ctx& P, int layer, int worker, int nworkers) {
    unsigned base = 0;
    bfr* wgu = (bfr*)(P.ws + OFF_MWGU); bfr* wd = (bfr*)(P.ws + OFF_MWD);
    for (int e = 0; e < 32; ++e) {
        const size_t we = (size_t)(layer * 32 + e);
        cvt_matrix(lds, P.in[I_MWGATE] + we * 1024 * 512, 1024, 512, wgu + (size_t)e * 1024 * 1024, 1024, 1, worker, nworkers, base);
        cvt_matrix(lds, P.in[I_MWUP]   + we * 1024 * 512, 1024, 512, wgu + (size_t)e * 1024 * 1024, 1024, 2, worker, nworkers, base);
        cvt_matrix(lds, P.in[I_MWDOWN] + we * 512 * 1024, 512, 1024, wd  + (size_t)e * 1024 * 512,  512,  0, worker, nworkers, base);
    }
}

DI void s5_tables(char* lds, const Ctx& P, int i, int g) {
    float2* pw = (float2*)lds;
    float2* bb = pw + 64 * 33;
    float2* cm = bb + 64 * 16;
    float*  kt = (float*)(cm + 16 * 64);
    const int tid = ltid();
    const size_t gp = (size_t)(i * 32 + g) * 64;
    for (int idx = tid; idx < 64 * 33; idx += NTHREADS) {
        const int p = idx / 33, tau = idx % 33;
        const double re = fmin((double)P.in[I_ARE][gp + p], -1e-4), im = (double)P.in[I_AIM][gp + p];
        const double st = exp((double)P.in[I_LSTEP][gp + p]);
        const double mag = exp(re * st * tau), ang = im * st * tau;
        pw[idx] = make_float2((float)(mag * cos(ang)), (float)(mag * sin(ang)));
    }
    for (int idx = tid; idx < 64 * 16; idx += NTHREADS) {
        const int p = idx >> 4, c = idx & 15;
        const double re = fmin((double)P.in[I_ARE][gp + p], -1e-4), im = (double)P.in[I_AIM][gp + p];
        const double st = exp((double)P.in[I_LSTEP][gp + p]);
        const double mag = exp(re * st), lr = mag * cos(im * st) - 1.0, li = mag * sin(im * st);
        const double den = re * re + im * im;
        const double fr = (lr * re + li * im) / den, fi = (li * re - lr * im) / den;
        const double br = (double)P.in[I_BRE][(gp + p) * 16 + c], bi = (double)P.in[I_BIM][(gp + p) * 16 + c];
        bb[idx] = make_float2((float)(fr * br - fi * bi), (float)(fr * bi + fi * br));
        const int cc = idx >> 6, pp = idx & 63;
        cm[idx] = make_float2(P.in[I_CRE][((size_t)(i * 32 + g) * 16 + cc) * 64 + pp], P.in[I_CIM][((size_t)(i * 32 + g) * 16 + cc) * 64 + pp]);
    }
    __syncthreads();
    for (int idx = tid; idx < 32 * 256; idx += NTHREADS) {
        const int tau = idx >> 8, c1 = (idx >> 4) & 15, c = idx & 15;
        float s = 0.f;
        for (int p = 0; p < 64; ++p) {
            const float2 a = cm[c1 * 64 + p], w = pw[p * 33 + tau], b = bb[p * 16 + c];
            const float tr = a.x * w.x - a.y * w.y, ti = a.x * w.y + a.y * w.x;
            s += tr * b.x - ti * b.y;
        }
        kt[idx] = s;
    }
    __syncthreads();
    bfr* gt = (bfr*)(P.ws + OFF_S5GT) + (size_t)(i * 32 + g) * 512 * 640;
    for (int idx = tid; idx < 512 * 80; idx += NTHREADS) {
        const int n = idx / 80, ch = idx % 80;
        const int t = n >> 4, c1 = n & 15;
        float v[8];
        if (ch < 64) {
            const int s = ch >> 1, c0 = (ch & 1) * 8;
#pragma unroll
            for (int j = 0; j < 8; ++j) v[j] = (t >= s) ? kt[((t - s) * 16 + c1) * 16 + c0 + j] : 0.f;
        } else {
            const int p0 = (ch - 64) * 4;
#pragma unroll
            for (int j = 0; j < 4; ++j) {
                const float2 a = cm[c1 * 64 + p0 + j], w = pw[(p0 + j) * 33 + t + 1];
                v[2 * j] = a.x * w.x - a.y * w.y;
                v[2 * j + 1] = -(a.x * w.y + a.y * w.x);
            }
        }
        *(uint4*)(gt + (size_t)n * 640 + ch * 8) = pack8(v);
    }
    bfr* bl = (bfr*)(P.ws + OFF_S5BL) + (size_t)(i * 32 + g) * 128 * 512;
    for (int idx = tid; idx < 128 * 64; idx += NTHREADS) {
        const int n = idx >> 6, ch = idx & 63;
        const int p = n >> 1, ri = n & 1, s = ch >> 1, c0 = (ch & 1) * 8;
        const float2 w = pw[p * 33 + 31 - s];
        float v[8];
#pragma unroll
        for (int j = 0; j < 8; ++j) { const float2 b = bb[p * 16 + c0 + j]; v[j] = ri ? (w.x * b.y + w.y * b.x) : (w.x * b.x - w.y * b.y); }
        *(uint4*)(bl + (size_t)n * 512 + ch * 8) = pack8(v);
    }
    float* l32 = (float*)(P.ws + OFF_S5L32) + (size_t)(i * 32 + g) * 128;
    if (tid < 64) { l32[2 * tid] = pw[tid * 33 + 32].x; l32[2 * tid + 1] = pw[tid * 33 + 32].y; }
    __syncthreads();
}

DI void norm_rows(const float* __restrict__ x, const float* __restrict__ g, bfr* __restrict__ hb, bfr* __restrict__ hlo, float* __restrict__ xcopy, int tok0, int ntok) {
    const int tid_ = ltid();
    const int lane = tid_ & 63, wave = tid_ >> 6;
    for (int tk = wave; tk < ntok; tk += 4) {
        const size_t tok = (size_t)(tok0 + tk);
        float4 v[4];
        float ss = 0.f;
#pragma unroll
        for (int i = 0; i < 4; ++i) {
            v[i] = *(const float4*)(x + tok * DM + i * 256 + lane * 4);
            ss += v[i].x * v[i].x + v[i].y * v[i].y + v[i].z * v[i].z + v[i].w * v[i].w;
        }
        ss = wave_sum(ss);
        const float rs = rsqrtf(ss * (1.0f / DM) + 1e-6f);
#pragma unroll
        for (int i = 0; i < 4; ++i) {
            const float4 gg = *(const float4*)(g + i * 256 + lane * 4);
            const float h0 = v[i].x * rs * gg.x, h1 = v[i].y * rs * gg.y, h2 = v[i].z * rs * gg.z, h3 = v[i].w * rs * gg.w;
            const unsigned p0 = pk2(h0, h1), p1 = pk2(h2, h3);
            *(uint2*)(hb + tok * DM + i * 256 + lane * 4) = make_uint2(p0, p1);
            if (hlo) {
                const unsigned q0 = pk2(h0 - bflo(p0), h1 - bfhi(p0)), q1 = pk2(h2 - bflo(p1), h3 - bfhi(p1));
                *(uint2*)(hlo + tok * DM + i * 256 + lane * 4) = make_uint2(q0, q1);
            }
            if (xcopy) *(float4*)(xcopy + tok * DM + i * 256 + lane * 4) = v[i];
        }
    }
}
DI void phase_e1(char* lds, const Ctx& P, int li) {
    const bfr* hb = (const bfr*)(P.ws + OFF_HB);
    const bfr* w = (const bfr*)(P.ws + OFF_WINE) + (size_t)li * 2304 * 1024;
    bfr* u = (bfr*)(P.ws + OFF_U);
    for (int t = blockIdx.x; t < 256 * 18; t += gridDim.x) {
        const int mt = t / 18, nt = t % 18;
        RowLoader A(hb, mt * 128, 1024), B(w, nt * 128, 1024);
        gemm_tile(lds, 16, A, B, [&](const float* stg) __attribute__((always_inline)) {
            epi_rows8(stg, [&](int r, int c0, const float (&v)[8]) __attribute__((always_inline)) {
                *(uint4*)(u + (size_t)(mt * 128 + r) * EVEN_IN + nt * 128 + c0) = pack8(v);
            });
        });
    }
}

DI void phase_e2a(const Ctx& P, int li) {
    const bfr* u = (const bfr*)(P.ws + OFF_U);
    const float* mu = P.in[I_MU] + (size_t)li * 1792;
    bfr* S = (bfr*)(P.ws + OFF_S);
    bfr* mv = (bfr*)(P.ws + (li == 0 ? OFF_VFIRST : OFF_MV2));
    bfr* dpool = (bfr*)(P.ws + OFF_DPOOL);
    const int total = NTOK * 160;
    for (int idx = blockIdx.x * NTHREADS + ltid(); idx < total; idx += gridDim.x * NTHREADS) {
        const int tok = idx / 160, ch = idx % 160;
        const int col = 1024 + ch * 8;
        const int t = tok & (SEQ - 1);
        const bfr* row = u + (size_t)tok * EVEN_IN;
        float cur[8];
        unpack8(*(const uint4*)(row + col), cur);
        if (col < 1792) {
            float prv[8], m[8];
            if (t > 0) unpack8(*(const uint4*)(row - EVEN_IN + col), prv);
            else {
#pragma unroll
                for (int j = 0; j < 8; ++j) prv[j] = 0.f;
            }
            const float4 m0 = *(const float4*)(mu + col), m1 = *(const float4*)(mu + col + 4);
            const float mm[8] = {m0.x, m0.y, m0.z, m0.w, m1.x, m1.y, m1.z, m1.w};
#pragma unroll
            for (int j = 0; j < 8; ++j) m[j] = cur[j] + (prv[j] - cur[j]) * mm[j];
            if (col < 1536) {
                *(uint4*)(mv + (size_t)tok * 512 + (col - 1024)) = pack8(m);
            } else if (col < 1600) {
#pragma unroll
                for (int j = 0; j < 8; ++j) m[j] = tanhf(m[j]);
                *(uint4*)(S + (size_t)tok * 256 + (col - 1536)) = pack8(m);
            } else if (col < 1664) {
                *(uint4*)(S + (size_t)tok * 256 + 64 + (col - 1600)) = pack8(m);
            } else {
#pragma unroll
                for (int j = 0; j < 8; ++j) m[j] = sigmoidf_(m[j]);
                *(uint4*)(S + (size_t)tok * 256 + 128 + (col - 1664)) = pack8(m);
            }
        } else {
            const int gi = (col - 1792) >> 7;
            const int win = 2 << gi;
            const int nw = (t + 1 < win) ? (t + 1) : win;
            float acc[8];
#pragma unroll
            for (int j = 0; j < 8; ++j) acc[j] = cur[j];
            for (int s = 1; s < nw; ++s) {
                float p[8];
                unpack8(*(const uint4*)(row - (size_t)s * EVEN_IN + col), p);
#pragma unroll
                for (int j = 0; j < 8; ++j) acc[j] += p[j];
            }
            const float inv = 1.0f / (float)nw;
#pragma unroll
            for (int j = 0; j < 8; ++j) acc[j] = acc[j] * inv - cur[j];
            *(uint4*)(dpool + (size_t)tok * 512 + (col - 1792)) = pack8(acc);
        }
    }
}

DI void phase_e2b(char* lds, const Ctx& P, int li) {
    const bfr* S = (const bfr*)(P.ws + OFF_S);
    const int njobs = (li == 1) ? 20 : 16;
    for (int t = blockIdx.x; t < 256 * njobs; t += gridDim.x) {
        const int mt = t / njobs, j = t % njobs;
        const int job = j >> 2, nt = j & 3;
        const int m0 = mt * 128;
        if (job == 0) {
            RowLoader A(S, m0, 256), B((const bfr*)(P.ws + OFF_W2T) + (size_t)li * 512 * 64, nt * 128, 64);
            const float* w0 = P.in[I_W0] + li * 512;
            float* dlog = (float*)(P.ws + OFF_DLOG);
            gemm_tile(lds, 1, A, B, [&](const float* stg) __attribute__((always_inline)) {
                epi_rows8(stg, [&](int r, int c0, const float (&v)[8]) __attribute__((always_inline)) {
                    float o[8];
#pragma unroll
                    for (int q = 0; q < 8; ++q) {
                        const float z = -(w0[nt * 128 + c0 + q] + v[q]);
                        const float sp = fmaxf(z, 0.f) + log1pf(__expf(-fabsf(z)));
                        o[q] = -__expf(-sp - 0.5f);
                    }
                    float* d = dlog + (size_t)(m0 + r) * 512 + nt * 128 + c0;
                    *(float4*)d = make_float4(o[0], o[1], o[2], o[3]); *(float4*)(d + 4) = make_float4(o[4], o[5], o[6], o[7]);
                });
            });
        } else if (job == 1) {
            RowLoader A(S + 64, m0, 256), B((const bfr*)(P.ws + OFF_A2T) + (size_t)li * 512 * 64, nt * 128, 64);
            const float* a0 = P.in[I_A0] + li * 512;
            bfr* ab = (bfr*)(P.ws + OFF_ABUF);
            gemm_tile(lds, 1, A, B, [&](const float* stg) __attribute__((always_inline)) {
                epi_rows8(stg, [&](int r, int c0, const float (&v)[8]) __attribute__((always_inline)) {
                    float o[8];
#pragma unroll
                    for (int q = 0; q < 8; ++q) o[q] = sigmoidf_(a0[nt * 128 + c0 + q] + v[q]);
                    *(uint4*)(ab + (size_t)(m0 + r) * 512 + nt * 128 + c0) = pack8(o);
                });
            });
        } else if (job == 2) {
            RowLoader A(S + 128, m0, 256), B((const bfr*)(P.ws + OFF_G2T) + (size_t)li * 512 * 128, nt * 128, 128);
            bfr* gb = (bfr*)(P.ws + OFF_GBUF);
            gemm_tile(lds, 2, A, B, [&](const float* stg) __attribute__((always_inline)) {
                epi_rows8(stg, [&](int r, int c0, const float (&v)[8]) __attribute__((always_inline)) {
                    *(uint4*)(gb + (size_t)(m0 + r) * 512 + nt * 128 + c0) = pack8(v);
                });
            });
        } else if (job == 3) {
            RowLoader A((const bfr*)(P.ws + OFF_DPOOL) + nt * 128, m0, 512), B((const bfr*)(P.ws + OFF_POOLT) + (size_t)(li * 4 + nt) * 128 * 128, 0, 128);
            const float* ps = P.in[I_POOLS] + li * 512 + nt * 128;
            bfr* am = (bfr*)(P.ws + OFF_AMIX);
            gemm_tile(lds, 2, A, B, [&](const float* stg) __attribute__((always_inline)) {
                epi_rows8(stg, [&](int r, int c0, const float (&v)[8]) __attribute__((always_inline)) {
                    float o[8];
#pragma unroll
                    for (int q = 0; q < 8; ++q) o[q] = v[q] * ps[c0 + q];
                    *(uint4*)(am + (size_t)(m0 + r) * 1024 + 512 + nt * 128 + c0) = pack8(o);
                });
            });
        } else {
            RowLoader A((const bfr*)(P.ws + OFF_MV2), m0, 512), B((const bfr*)(P.ws + OFF_V12T), nt * 128, 512);
            const float* v0 = P.in[I_V0];
            bfr* vg = (bfr*)(P.ws + OFF_VGATE);
            gemm_tile(lds, 8, A, B, [&](const float* stg) __attribute__((always_inline)) {
                epi_rows8(stg, [&](int r, int c0, const float (&v)[8]) __attribute__((always_inline)) {
                    float o[8];
#pragma unroll
                    for (int q = 0; q < 8; ++q) o[q] = sigmoidf_(v0[nt * 128 + c0 + q] + v[q]);
                    *(uint4*)(vg + (size_t)(m0 + r) * 512 + nt * 128 + c0) = pack8(o);
                });
            });
        }
    }
}

constexpr int RW_TC = 32;
DI void phase_e3(char* lds, const Ctx& P, int li) {
    float* s_w = (float*)lds;
    float* s_a = s_w + RW_TC * 64;
    float* s_b = s_a + RW_TC * 64;
    float* s_k = s_b + RW_TC * 64;
    float* s_r = s_k + RW_TC * 64;
    float* s_v = s_r + RW_TC * 64;
    float* s_y = s_v + RW_TC * 16;
    const bfr* u = (const bfr*)(P.ws + OFF_U);
    const float* mu = P.in[I_MU] + (size_t)li * 1792;
    const float* dlog = (const float*)(P.ws + OFF_DLOG);
    const bfr* ab = (const bfr*)(P.ws + OFF_ABUF);
    const bfr* vg = (const bfr*)(P.ws + OFF_VGATE);
    const bfr* vf = (const bfr*)(P.ws + OFF_VFIRST);
    float* yout = (float*)(P.ws + OFF_Y);
    float* bonus = (float*)(P.ws + OFF_BONUS);
    const int tid = ltid(), lane = tid & 63, wave = tid >> 6;
    const int pstep = tid >> 3, pc0 = (tid & 7) * 8;
    for (int item = blockIdx.x; item < 512; item += gridDim.x) {
        const int bh = item >> 2, qtr = item & 3;
        const int b = bh >> 3, h = bh & 7;
        const int i0 = qtr * 16;
        float c_mur[8], c_muk[8], c_muv[8], c_kk[8], c_ka[8], c_rk[8];
#pragma unroll
        for (int j = 0; j < 8; ++j) {
            const int c = h * 64 + pc0 + j;
            c_mur[j] = mu[c]; c_muk[j] = mu[512 + c]; c_muv[j] = mu[1024 + c];
            c_kk[j] = P.in[I_KK][li * 512 + c]; c_ka[j] = P.in[I_KA][li * 512 + c]; c_rk[j] = P.in[I_RK][li * 512 + c];
        }
        float S0 = 0.f, S1 = 0.f, S2 = 0.f, S3 = 0.f;
        const int rloc = wave * 4 + (lane >> 4);
        const int j0 = (lane & 15) * 4;
        for (int t0 = 0; t0 < SEQ; t0 += RW_TC) {
            __syncthreads();
            {
                const int t = t0 + pstep;
                const size_t tok = (size_t)b * SEQ + t;
                const bfr* row = u + tok * EVEN_IN + h * 64 + pc0;
                float ur[8], uk[8], uv[8], pr[8], pk[8], pv[8];
                unpack8(*(const uint4*)(row), ur); unpack8(*(const uint4*)(row + 512), uk); unpack8(*(const uint4*)(row + 1024), uv);
                if (t > 0) { unpack8(*(const uint4*)(row - EVEN_IN), pr); unpack8(*(const uint4*)(row - EVEN_IN + 512), pk); unpack8(*(const uint4*)(row - EVEN_IN + 1024), pv); }
                else {
#pragma unroll
                    for (int j = 0; j < 8; ++j) { pr[j] = 0.f; pk[j] = 0.f; pv[j] = 0.f; }
                }
                const size_t o512 = tok * 512 + h * 64 + pc0;
                float av[8], gv[8], fv[8];
                unpack8(*(const uint4*)(ab + o512), av);
                const float4 d0 = *(const float4*)(dlog + o512), d1 = *(const float4*)(dlog + o512 + 4);
                const float dl[8] = {d0.x, d0.y, d0.z, d0.w, d1.x, d1.y, d1.z, d1.w};
                if (li == 1) { unpack8(*(const uint4*)(vg + o512), gv); unpack8(*(const uint4*)(vf + o512), fv); }
                float kkr[8], kmod[8], rr[8], vv[8];
                float ssq = 0.f, bsum = 0.f;
#pragma unroll
                for (int j = 0; j < 8; ++j) {
                    rr[j] = ur[j] + (pr[j] - ur[j]) * c_mur[j];
                    const float k = uk[j] + (pk[j] - uk[j]) * c_muk[j];
                    float v = uv[j] + (pv[j] - uv[j]) * c_muv[j];
                    if (li == 1) v = v + (fv[j] - v) * gv[j];
                    vv[j] = v;
                    kkr[j] = k * c_kk[j];
                    ssq += kkr[j] * kkr[j];
                    kmod[j] = k * (1.0f + (av[j] - 1.0f) * c_ka[j]);
                    bsum += rr[j] * kmod[j] * c_rk[j];
                }
                ssq += __shfl_xor(ssq, 1); ssq += __shfl_xor(ssq, 2); ssq += __shfl_xor(ssq, 4);
                bsum += __shfl_xor(bsum, 1); bsum += __shfl_xor(bsum, 2); bsum += __shfl_xor(bsum, 4);
                const float inv = 1.0f / fmaxf(sqrtf(ssq), 1e-12f);
#pragma unroll
                for (int j = 0; j < 8; ++j) {
                    const float kk = kkr[j] * inv;
                    s_w[pstep * 64 + pc0 + j] = __expf(dl[j]);
                    s_a[pstep * 64 + pc0 + j] = -kk;
                    s_b[pstep * 64 + pc0 + j] = kk * av[j];
                    s_k[pstep * 64 + pc0 + j] = kmod[j];
                    s_r[pstep * 64 + pc0 + j] = rr[j];
                }
                if ((pc0 >> 4) == qtr) {
                    float bo[8];
#pragma unroll
                    for (int j = 0; j < 8; ++j) { s_v[pstep * 16 + (pc0 & 15) + j] = vv[j]; bo[j] = bsum * vv[j]; }
                    float* bp = bonus + o512;
                    *(float4*)bp = make_float4(bo[0], bo[1], bo[2], bo[3]); *(float4*)(bp + 4) = make_float4(bo[4], bo[5], bo[6], bo[7]);
                }
            }
            __syncthreads();
#pragma unroll 4
            for (int s = 0; s < RW_TC; ++s) {
                const float4 a4 = *(const float4*)(s_a + s * 64 + j0);
                const float4 w4 = *(const float4*)(s_w + s * 64 + j0);
                const float4 b4 = *(const float4*)(s_b + s * 64 + j0);
                const float4 k4 = *(const float4*)(s_k + s * 64 + j0);
                const float4 r4 = *(const float4*)(s_r + s * 64 + j0);
                const float vi = s_v[s * 16 + rloc];
                float sa = S0 * a4.x + S1 * a4.y + S2 * a4.z + S3 * a4.w;
                sa = row16_sum(sa);
                S0 = S0 * w4.x + sa * b4.x + vi * k4.x;
                S1 = S1 * w4.y + sa * b4.y + vi * k4.y;
                S2 = S2 * w4.z + sa * b4.z + vi * k4.z;
                S3 = S3 * w4.w + sa * b4.w + vi * k4.w;
                float y = S0 * r4.x + S1 * r4.y + S2 * r4.z + S3 * r4.w;
                y = row16_sum(y);
                if ((lane & 15) == 0) s_y[s * 16 + rloc] = y;
            }
            __syncthreads();
            {
                for (int idx = tid; idx < RW_TC * 16; idx += NTHREADS) {
                    const int s = idx >> 4, r = idx & 15;
                    yout[((size_t)b * SEQ + t0 + s) * 512 + h * 64 + i0 + r] = s_y[idx];
                }
            }
        }
    }
}

DI void phase_e4(const Ctx& P, int li) {
    const float* y = (const float*)(P.ws + OFF_Y);
    const float* bonus = (const float*)(P.ws + OFF_BONUS);
    const bfr* gb = (const bfr*)(P.ws + OFF_GBUF);
    const float* lng = P.in[I_LNG] + li * 512;
    const float* lnb = P.in[I_LNB] + li * 512;
    bfr* am = (bfr*)(P.ws + OFF_AMIX);
    const int total = NTOK * 64;
    for (int idx = blockIdx.x * NTHREADS + ltid(); idx < total; idx += gridDim.x * NTHREADS) {
        const int tok = idx >> 6, c = (idx & 63) * 8;
        const size_t o = (size_t)tok * 512 + c;
        const float4 y0 = *(const float4*)(y + o), y1 = *(const float4*)(y + o + 4);
        float v[8] = {y0.x, y0.y, y0.z, y0.w, y1.x, y1.y, y1.z, y1.w};
        float s = 0.f;
#pragma unroll
        for (int j = 0; j < 8; ++j) s += v[j];
        s += __shfl_xor(s, 1); s += __shfl_xor(s, 2); s += __shfl_xor(s, 4);
        const float mean = s * (1.0f / 64.0f);
        float q = 0.f;
#pragma unroll
        for (int j = 0; j < 8; ++j) { v[j] -= mean; q += v[j] * v[j]; }
        q += __shfl_xor(q, 1); q += __shfl_xor(q, 2); q += __shfl_xor(q, 4);
        const float rstd = rsqrtf(q * (1.0f / 64.0f) + 64e-5f);
        const float4 b0 = *(const float4*)(bonus + o), b1 = *(const float4*)(bonus + o + 4);
        const float bo[8] = {b0.x, b0.y, b0.z, b0.w, b1.x, b1.y, b1.z, b1.w};
        float gv[8];
        unpack8(*(const uint4*)(gb + o), gv);
        float out[8];
#pragma unroll
        for (int j = 0; j < 8; ++j) out[j] = (v[j] * rstd * lng[c + j] + lnb[c + j] + bo[j]) * gv[j];
        *(uint4*)(am + (size_t)tok * 1024 + c) = pack8(out);
    }
}

DI void phase_wout(char* lds, const Ctx& P, const bfr* w) {
    const bfr* am = (const bfr*)(P.ws + OFF_AMIX);
    float* x = P.out;
    for (int t = blockIdx.x; t < 256 * 8; t += gridDim.x) {
        const int mt = t >> 3, nt = t & 7;
        RowLoader A(am, mt * 128, 1024), B(w, nt * 128, 1024);
        gemm_tile(lds, 16, A, B, [&](const float* stg) __attribute__((always_inline)) {
            epi_rows8(stg, [&](int r, int c0, const float (&v)[8]) __attribute__((always_inline)) {
                float* d = x + (size_t)(mt * 128 + r) * DM + nt * 128 + c0;
                float4 a = *(float4*)d, b = *(float4*)(d + 4);
                a.x += v[0]; a.y += v[1]; a.z += v[2]; a.w += v[3]; b.x += v[4]; b.y += v[5]; b.z += v[6]; b.w += v[7];
                *(float4*)d = a; *(float4*)(d + 4) = b;
            });
        });
    }
}
DI void phase_o1(char* lds, const Ctx& P, int li) {
    const bfr* hb = (const bfr*)(P.ws + OFF_HB);
    const bfr* w = (const bfr*)(P.ws + OFF_WINO) + (size_t)li * 2048 * 1024;
    bfr* qk = (bfr*)(P.ws + OFF_U);
    bfr* vT = (bfr*)(P.ws + OFF_VT);
    bfr* us5 = (bfr*)(P.ws + OFF_US5);
    for (int t = blockIdx.x; t < 256 * 16; t += gridDim.x) {
        const int mt = t >> 4, nt = t & 15;
        const int m0 = mt * 128;
        RowLoader A(hb, m0, 1024), B(w, nt * 128, 1024);
        gemm_tile(lds, 16, A, B, [&](const float* stg) __attribute__((always_inline)) {
            if (nt < 8) {
                epi_rows8(stg, [&](int r, int c0, const float (&v)[8]) __attribute__((always_inline)) {
                    *(uint4*)(qk + (size_t)(m0 + r) * 1024 + nt * 128 + c0) = pack8(v);
                });
            } else if (nt < 12) {
                const int b = m0 >> 11, tq = m0 & (SEQ - 1);
                bfr* dst = vT + ((size_t)(b * 4 + (nt - 8)) * 128) * SEQ + tq;
                const int tid0 = ltid();
#pragma unroll
                for (int it = 0; it < 8; ++it) {
                    const int idx = it * NTHREADS + tid0;
                    const int dv = idx & 127, rg = idx >> 7;
                    float v[8];
#pragma unroll
                    for (int j = 0; j < 8; ++j) v[j] = stg[(rg * 8 + j) * STG_LD + dv];
                    *(uint4*)(dst + (size_t)dv * SEQ + rg * 8) = pack8(v);
                }
            } else {
                epi_rows8(stg, [&](int r, int c0, const float (&v)[8]) __attribute__((always_inline)) {
                    const int cc = (nt - 12) * 128 + c0;
                    *(uint4*)(us5 + ((size_t)(cc >> 4) * NTOK + m0 + r) * 16 + (cc & 15)) = pack8(v);
                });
            }
        });
    }
}

DI void phase_o2(char* lds, const Ctx& P, int li) {
    const bfr* qk = (const bfr*)(P.ws + OFF_U);
    bfr* qn = (bfr*)(P.ws + OFF_QN);
    bfr* kn = (bfr*)(P.ws + OFF_KN);
    const float* gq = P.in[I_QN] + li * 64;
    const float* gk = P.in[I_KN] + li * 64;
    const bfr* us5 = (const bfr*)(P.ws + OFF_US5);
    const bfr* bl = (const bfr*)(P.ws + OFF_S5BL) + (size_t)li * 32 * 128 * 512;
    float* xloc = (float*)(P.ws + OFF_XLOC);
    for (int t = blockIdx.x; t < 256; t += gridDim.x) {
        const int g = t >> 3, mt = t & 7;
        RowLoader A(us5 + (size_t)g * NTOK * 16, mt * 128, 512), B(bl + (size_t)g * 128 * 512, 0, 512);
        gemm_tile(lds, 8, A, B, [&](const float* stg) __attribute__((always_inline)) {
            epi_rows8(stg, [&](int r, int c0, const float (&v)[8]) __attribute__((always_inline)) {
                float* d = xloc + ((size_t)g * 1024 + mt * 128 + r) * 128 + c0;
                *(float4*)d = make_float4(v[0], v[1], v[2], v[3]); *(float4*)(d + 4) = make_float4(v[4], v[5], v[6], v[7]);
            });
        });
    }
    const int total = NTOK * 16 * 8;
    for (int idx = blockIdx.x * NTHREADS + ltid(); idx < total; idx += gridDim.x * NTHREADS) {
        const int l8 = idx & 7, item = idx >> 3;
        const int hm = item & 7, which = (item >> 3) & 1, tok = item >> 4;
        const int d0 = l8 * 4;
        const bfr* src = qk + (size_t)tok * 1024 + which * 512 + hm * 64;
        const uint2 ua = *(const uint2*)(src + d0), ub = *(const uint2*)(src + 32 + d0);
        float x1[4] = {bflo(ua.x), bfhi(ua.x), bflo(ua.y), bfhi(ua.y)};
        float x2[4] = {bflo(ub.x), bfhi(ub.x), bflo(ub.y), bfhi(ub.y)};
        float ss = 0.f;
#pragma unroll
        for (int j = 0; j < 4; ++j) ss += x1[j] * x1[j] + x2[j] * x2[j];
        ss += __shfl_xor(ss, 1); ss += __shfl_xor(ss, 2); ss += __shfl_xor(ss, 4);
        const float rs = rsqrtf(ss * (1.0f / 64.0f) + 1e-6f);
        const float* gg = which ? gk : gq;
        const float scl = which ? 1.0f : (0.125f * 1.4426950408889634f);
        const int t = tok & (SEQ - 1);
        float o1[4], o2[4];
#pragma unroll
        for (int j = 0; j < 4; ++j) {
            const int i = d0 + j;
            const float invf = exp2f(-(float)i * (13.287712379549449f / 32.0f));
            const float ang = (float)t * invf;
            float sn, cs;
            sincosf(ang, &sn, &cs);
            const float a = x1[j] * rs * gg[i], b2 = x2[j] * rs * gg[32 + i];
            o1[j] = (a * cs - b2 * sn) * scl;
            o2[j] = (b2 * cs + a * sn) * scl;
        }
        bfr* dst = (which ? kn : qn) + (size_t)tok * 512 + hm * 64;
        *(uint2*)(dst + d0) = make_uint2(pk2(o1[0], o1[1]), pk2(o1[2], o1[3]));
        *(uint2*)(dst + 32 + d0) = make_uint2(pk2(o2[0], o2[1]), pk2(o2[2], o2[3]));
    }
}

DI void s5_scan(const Ctx& P, int li) {
    const float* xloc = (const float*)(P.ws + OFF_XLOC);
    bfr* xin = (bfr*)(P.ws + OFF_XIN);
    const float* l32 = (const float*)(P.ws + OFF_S5L32) + (size_t)li * 32 * 128;
    for (int idx = blockIdx.x * NTHREADS + ltid(); idx < 32 * 16 * 64; idx += gridDim.x * NTHREADS) {
        const int p = idx & 63, b = (idx >> 6) & 15, g = idx >> 10;
        const float lr = l32[g * 128 + 2 * p], lim = l32[g * 128 + 2 * p + 1];
        float xr = 0.f, xi = 0.f;
        for (int ch = 0; ch < 64; ++ch) {
            const size_t o = ((size_t)g * 1024 + b * 64 + ch) * 128 + 2 * p;
            *(unsigned*)(xin + o) = pk2(xr, xi);
            const float2 a = *(const float2*)(xloc + o);
            const float nr = lr * xr - lim * xi + a.x, ni = lr * xi + lim * xr + a.y;
            xr = nr; xi = ni;
        }
    }
}

DI void attn_item(char* lds, const Ctx& P, int b, int h, int qt, float lam, float lam_init, const float* subln) {
    const bfr* qn = (const bfr*)(P.ws + OFF_QN);
    const bfr* kn = (const bfr*)(P.ws + OFF_KN);
    const bfr* vT = (const bfr*)(P.ws + OFF_VT) + (size_t)(b * 4 + h) * 128 * SEQ;
    bfr* am = (bfr*)(P.ws + OFF_AMIX);
    const int tid = ltid(), lane = tid & 63, wave = tid >> 6;
    const int m = wave >> 1, qw = (wave & 1) * 32;
    const int q0 = qt * 64 + qw;
    const int ln = lane & 31, hf = lane >> 5;
    bf16x8 qf[4];
    {
        const bfr* qp = qn + ((size_t)b * SEQ + q0 + ln) * 512 + h * 128 + m * 64 + hf * 8;
#pragma unroll
        for (int ks = 0; ks < 4; ++ks) qf[ks] = *(const bf16x8*)(qp + ks * 16);
    }
    f32x16 o[4];
#pragma unroll
    for (int d = 0; d < 4; ++d)
#pragma unroll
        for (int r = 0; r < 16; ++r) o[d][r] = 0.f;
    float mrun = -INFINITY, lrun = 0.f;
    const int nkt = qt + 1;
    const int lrow = tid >> 3, lcol = (tid & 7) * 8;
    const bfr* kbase = kn + ((size_t)b * SEQ) * 512 + h * 128;
    unsigned ko = (unsigned)(lrow * 512 + lcol) * 2u, vo = (unsigned)(lrow * SEQ + lcol) * 2u;
    asm volatile("" : "+v"(ko), "+v"(vo));
    uint4 rk0, rk1, rk2, rk3, rv0, rv1, rv2, rv3;
#define ATT_GLOAD(kt_) do { const char* kp_ = (const char*)(kbase + (size_t)(kt_) * (64 * 512)); const char* vp_ = (const char*)(vT + (kt_) * 64); \
        rk0 = *(const uint4*)(kp_ + ko); rk1 = *(const uint4*)(kp_ + 32 * 512 * 2 + ko); rk2 = *(const uint4*)(kp_ + 64 * 2 + ko); rk3 = *(const uint4*)(kp_ + 32 * 512 * 2 + 64 * 2 + ko); \
        rv0 = *(const uint4*)(vp_ + vo); rv1 = *(const uint4*)(vp_ + 32 * SEQ * 2 + vo); rv2 = *(const uint4*)(vp_ + 64 * SEQ * 2 + vo); rv3 = *(const uint4*)(vp_ + 96 * SEQ * 2 + vo); } while (0)
#define ATT_S1(base_, i_, RK, RV) { *(uint4*)((base_) + (32 * (i_)) * LDA * 2) = RK; \
        *(uint4*)((base_) + TILE_B + (32 * (i_)) * LDA * 2) = RV; }
#define ATT_LSTORE(buf_) do { char* base_ = lds + (buf_) * (2 * TILE_B) + s_off; ATT_S1(base_, 0, rk0, rv0) ATT_S1(base_, 1, rk1, rv1) ATT_S1(base_, 2, rk2, rv2) ATT_S1(base_, 3, rk3, rv3) } while (0)
    int k_off = ((m * 64 + ln) * LDA + hf * 8) * 2;
    int v_off = TILE_B + (ln * LDA + 4 * hf) * 2;
    int s_off = (lrow * LDA + lcol) * 2;
    asm volatile("" : "+v"(k_off), "+v"(v_off), "+v"(s_off));
    ATT_GLOAD(0); ATT_LSTORE(0);
    __syncthreads();
    int buf = 0;
    for (int kt = 0; kt < nkt; ++kt) {
        const bool more = (kt + 1 < nkt);
        const char* ks_ = lds + buf * (2 * TILE_B) + k_off;
        const char* vs_ = lds + buf * (2 * TILE_B) + v_off;
        if (kt * 64 <= q0 + 31) {
            f32x16 s[2];
#pragma unroll
            for (int kb = 0; kb < 2; ++kb) {
#pragma unroll
                for (int r = 0; r < 16; ++r) s[kb][r] = 0.f;
#pragma unroll
                for (int ks = 0; ks < 4; ++ks) {
                    const bf16x8 kf = *(const bf16x8*)(ks_ + ((kb * 32) * LDA + ks * 16) * 2);
                    s[kb] = MFMA32(kf, qf[ks], s[kb]);
                }
            }
            const int qpos = q0 + ln;
            if (kt * 64 + 63 > q0) {
#pragma unroll
                for (int kb = 0; kb < 2; ++kb)
#pragma unroll
                    for (int r = 0; r < 16; ++r) {
                        const int key = kt * 64 + kb * 32 + (r & 3) + 8 * (r >> 2) + 4 * hf;
                        if (key > qpos) s[kb][r] = -INFINITY;
                    }
            }
            float mx = s[0][0];
#pragma unroll
            for (int kb = 0; kb < 2; ++kb)
#pragma unroll
                for (int r = 0; r < 16; ++r) mx = fmaxf(mx, s[kb][r]);
            mx = fmaxf(mx, __shfl_xor(mx, 32));
            const float mnew = fmaxf(mrun, mx);
            const float alpha = __builtin_amdgcn_exp2f(mrun - mnew);
            mrun = mnew;
            float rsum = 0.f;
#pragma unroll
            for (int kb = 0; kb < 2; ++kb)
#pragma unroll
                for (int r = 0; r < 16; ++r) { const float p = __builtin_amdgcn_exp2f(s[kb][r] - mnew); s[kb][r] = p; rsum += p; }
            lrun = lrun * alpha + rsum;
#pragma unroll
            for (int d = 0; d < 4; ++d)
#pragma unroll
                for (int r = 0; r < 16; ++r) o[d][r] *= alpha;
            __builtin_amdgcn_sched_barrier(0);
            if (more) ATT_GLOAD(kt + 1);
#pragma unroll
            for (int kb = 0; kb < 2; ++kb)
#pragma unroll
                for (int st = 0; st < 2; ++st) {
                    const uint4 pp = make_uint4(pk2(s[kb][8 * st + 0], s[kb][8 * st + 1]), pk2(s[kb][8 * st + 2], s[kb][8 * st + 3]),
                                                pk2(s[kb][8 * st + 4], s[kb][8 * st + 5]), pk2(s[kb][8 * st + 6], s[kb][8 * st + 7]));
                    const bf16x8 pf = __builtin_bit_cast(bf16x8, pp);
                    const int kc = kb * 32 + 16 * st;
#pragma unroll
                    for (int d = 0; d < 4; ++d) {
                        const uint2 v0 = *(const uint2*)(vs_ + ((d * 32) * LDA + kc) * 2);
                        const uint2 v1 = *(const uint2*)(vs_ + ((d * 32) * LDA + kc + 8) * 2);
                        const bf16x8 vf = __builtin_bit_cast(bf16x8, make_uint4(v0.x, v0.y, v1.x, v1.y));
                        o[d] = MFMA32(vf, pf, o[d]);
                    }
                }
        }
        else if (more) ATT_GLOAD(kt + 1);
        if (more) ATT_LSTORE(buf ^ 1);
        __syncthreads();
        buf ^= 1;
    }
    const float ltot = lrun + __shfl_xor(lrun, 32);
    const float linv = 1.0f / ltot;
    float* ob = (float*)lds;
    int o_off = (m * 64 + qw + ln) * 129 + 4 * hf;
    asm volatile("" : "+v"(o_off));
#pragma unroll
    for (int d = 0; d < 4; ++d)
#pragma unroll
        for (int r = 0; r < 16; ++r) ob[o_off + d * 32 + (r & 3) + 8 * (r >> 2)] = o[d][r] * linv;
    __syncthreads();
#pragma unroll
    for (int it = 0; it < 4; ++it) {
        const int idx = it * NTHREADS + tid;
        const int q = idx >> 4, c0 = (idx & 15) * 8;
        float v[8];
        float ss = 0.f;
        int r_off = q * 129 + c0;
        asm volatile("" : "+v"(r_off));
#pragma unroll
        for (int j = 0; j < 8; ++j) { v[j] = ob[r_off + j] - lam * ob[r_off + 64 * 129 + j]; ss += v[j] * v[j]; }
        ss = row16_sum(ss);
        const float rs = rsqrtf(ss * (1.0f / 128.0f) + 1e-5f) * (1.0f - lam_init);
#pragma unroll
        for (int j = 0; j < 8; ++j) v[j] = v[j] * rs * subln[c0 + j];
        *(uint4*)(am + ((size_t)b * SEQ + qt * 64 + q) * 1024 + h * 128 + c0) = pack8(v);
    }
    __syncthreads();
}

DI void phase_o3(char* lds, const Ctx& P, int li, int layer) {
    s5_scan(P, li);
    float lam;
    {
        const int j = ltid() & 63;
        const float s1 = wave_sum(P.in[I_LQ1][li * 64 + j] * P.in[I_LK1][li * 64 + j]);
        const float s2 = wave_sum(P.in[I_LQ2][li * 64 + j] * P.in[I_LK2][li * 64 + j]);
        const float lam_init0 = 0.8f - 0.6f * __expf(-0.3f * (float)layer);
        lam = __expf(s1) - __expf(s2) + lam_init0;
    }
    const float lam_init = 0.8f - 0.6f * __expf(-0.3f * (float)layer);
    const float* subln = P.in[I_SUBLN] + li * 128;
    for (int item = blockIdx.x; item < 1024; item += gridDim.x) {
        const int bh = item >> 4, pr = item & 15;
        for (int half = 0; half < 2; ++half) attn_item(lds, P, bh >> 2, bh & 3, half ? 31 - pr : pr, lam, lam_init, subln);
    }
}

DI void phase_o4(char* lds, const Ctx& P, int li) {
    const bfr* us5 = (const bfr*)(P.ws + OFF_US5);
    const bfr* xin = (const bfr*)(P.ws + OFF_XIN);
    const bfr* gt = (const bfr*)(P.ws + OFF_S5GT) + (size_t)li * 32 * 512 * 640;
    const float* dsk = P.in[I_S5D] + li * 512;
    bfr* zb = (bfr*)(P.ws + OFF_ZBUF);
    for (int t = blockIdx.x; t < 1024; t += gridDim.x) {
        const int g = t >> 5, mt = (t >> 2) & 7, nt = t & 3;
        const int nloc = 2 * (nt + 1);
        const bfr* ag = us5 + (size_t)g * NTOK * 16;
        const bfr* xg = xin + (size_t)g * 1024 * 128;
        const int tq = ltid();
        const int arow = mt * 128 + (tq >> 3), acol = (tq & 7) * 8;
        auto aptr = [&](int i, int kt) __attribute__((always_inline)) -> const bfr* {
            return (kt < nloc) ? ag + (size_t)(arow + 32 * i) * 512 + kt * 64 + acol
                               : xg + (size_t)(arow + 32 * i) * 128 + (kt - nloc) * 64 + acol;
        };
        const bfr* bg = gt + (size_t)g * 512 * 640 + (size_t)(nt * 128 + (tq >> 3)) * 640 + acol;
        auto bptr = [&](int i, int kt) __attribute__((always_inline)) -> const bfr* {
            return bg + (size_t)(32 * i) * 640 + ((kt < nloc) ? kt : (8 + kt - nloc)) * 64;
        };
        gemm_tile(lds, nloc + 2, aptr, bptr, [&](const float* stg) __attribute__((always_inline)) {
            epi_rows8(stg, [&](int r, int c0, const float (&v)[8]) __attribute__((always_inline)) {
                const int cb = mt * 128 + r;
                const int n = nt * 128 + c0, tt = n >> 4, c1 = n & 15;
                const size_t tok = (size_t)cb * 32 + tt;
                float uu[8], z[8];
                unpack8(*(const uint4*)(ag + tok * 16 + c1), uu);
#pragma unroll
                for (int j = 0; j < 8; ++j) {
                    const float y = v[j] + dsk[g * 16 + c1 + j] * uu[j];
                    const float inner = 0.7978845608028654f * (y + 0.044715f * y * y * y);
                    z[j] = 0.5f * y * (1.0f + tanhf(inner));
                }
                *(uint4*)(zb + tok * 512 + g * 16 + c1) = pack8(z);
            });
        });
    }
}

DI void phase_o5(char* lds, const Ctx& P, int li) {
    const bfr* zb = (const bfr*)(P.ws + OFF_ZBUF);
    const bfr* w = (const bfr*)(P.ws + OFF_GLUT) + (size_t)li * 512 * 512;
    bfr* am = (bfr*)(P.ws + OFF_AMIX);
    for (int t = blockIdx.x; t < 1024; t += gridDim.x) {
        const int mt = t >> 2, nt = t & 3;
        RowLoader A(zb, mt * 128, 512), B(w, nt * 128, 512);
        gemm_tile(lds, 8, A, B, [&](const float* stg) __attribute__((always_inline)) {
            epi_rows8(stg, [&](int r, int c0, const float (&v)[8]) __attribute__((always_inline)) {
                float zz[8], o[8];
                unpack8(*(const uint4*)(zb + (size_t)(mt * 128 + r) * 512 + nt * 128 + c0), zz);
#pragma unroll
                for (int j = 0; j < 8; ++j) o[j] = zz[j] * sigmoidf_(v[j]);
                *(uint4*)(am + (size_t)(mt * 128 + r) * 1024 + 512 + nt * 128 + c0) = pack8(o);
            });
        });
    }
}
DI void phase_router(char* lds, const Ctx& P, int layer) {
    const float* x = P.out;
    bfr* hb = (bfr*)(P.ws + OFF_HB);
    bfr* hlo = (bfr*)(P.ws + OFF_HLO);
    const bfr* rhi = (const bfr*)(P.ws + OFF_RHI) + (size_t)layer * 128 * 1024;
    const bfr* rlo = (const bfr*)(P.ws + OFF_RLO) + (size_t)layer * 128 * 1024;
    int* gcnt = (int*)(P.ws + OFF_CNT) + layer * 64;
    int* stok = (int*)(P.ws + OFF_TOK);
    float* sgate = (float*)(P.ws + OFF_GATE);
    int* lcnt = (int*)(lds + LDS_AUX);
    int* lbase = lcnt + 64;
    const float* bg = P.in[I_MBG] + layer * 4;
    const float* be = P.in[I_MBE] + layer * 32;
    const int tid = ltid();
    for (int u = blockIdx.x; u < 256; u += gridDim.x) {
        const int m0 = u * 128;
        norm_rows(x, P.in[I_NFFN] + (size_t)layer * DM, hb, hlo, nullptr, m0, 128);
        __syncthreads();
        const size_t roff = (size_t)(m0 + (tid >> 3)) * 1024 + (tid & 7) * 8;
        const size_t boff = (size_t)(tid >> 3) * 1024 + (tid & 7) * 8;
        auto aptr = [&](int i, int kt) __attribute__((always_inline)) -> const bfr* { return (kt < 32 ? hb : hlo) + roff + (size_t)(32 * i) * 1024 + (kt & 15) * 64; };
        auto bptr = [&](int i, int kt) __attribute__((always_inline)) -> const bfr* { return ((kt >= 16 && kt < 32) ? rlo : rhi) + boff + (size_t)(32 * i) * 1024 + (kt & 15) * 64; };
        gemm_tile(lds, 48, aptr, bptr, [&](const float* stg) __attribute__((always_inline)) {
            if (tid < 64) lcnt[tid] = 0;
            __syncthreads();
            int seg0 = 0, seg1 = 0, p0 = 0, p1 = 0;
            float g0 = 0.f, g1 = 0.f;
            if (tid < 128) {
                const float* row = stg + tid * STG_LD;
                float gl[4];
#pragma unroll
                for (int j = 0; j < 4; ++j) gl[j] = row[32 + j] + bg[j];
                int gt = 0; float gm = gl[0];
#pragma unroll
                for (int j = 1; j < 4; ++j) if (gl[j] > gm) { gm = gl[j]; gt = j; }
                float gs = 0.f;
#pragma unroll
                for (int j = 0; j < 4; ++j) gs += __expf(gl[j] - gm);
                const float gw = 1.0f / gs;
                float l1 = -INFINITY, l2 = -INFINITY; int j1 = 0, j2 = 0;
                for (int j = 0; j < 8; ++j) {
                    const float v = row[gt * 8 + j] + be[gt * 8 + j];
                    if (v > l1) { l2 = l1; j2 = j1; l1 = v; j1 = j; }
                    else if (v > l2) { l2 = v; j2 = j; }
                }
                const float w1 = 1.0f / (1.0f + __expf(l2 - l1));
                g0 = gw * w1; g1 = gw * (1.0f - w1);
                seg0 = gt * 8 + j1; seg1 = 32 + gt * 8 + j2;
                p0 = atomicAdd(&lcnt[seg0], 1);
                p1 = atomicAdd(&lcnt[seg1], 1);
            }
            __syncthreads();
            if (tid < 64) { const int c = lcnt[tid]; lbase[tid] = c ? atomicAdd(&gcnt[tid], c) : 0; }
            __syncthreads();
            if (tid < 128) {
                const int q0 = lbase[seg0] + p0, q1 = lbase[seg1] + p1;
                stok[(size_t)seg0 * NTOK + q0] = m0 + tid; sgate[(size_t)seg0 * NTOK + q0] = g0;
                stok[(size_t)seg1 * NTOK + q1] = m0 + tid; sgate[(size_t)seg1 * NTOK + q1] = g1;
            }
        });
    }
}

DI void moe_tables(char* lds, const Ctx& P, int layer) {
    int* cnt = (int*)(lds + LDS_AUX); int* rb0 = cnt + 64; int* hoff = rb0 + 65;
    const int* gcnt = (const int*)(P.ws + OFF_CNT) + layer * 64;
    const int tid = ltid();
    if (tid < 64) cnt[tid] = gcnt[tid];
    __syncthreads();
    if (tid == 0) {
        int acc = 0;
        for (int s = 0; s < 64; ++s) { rb0[s] = acc; hoff[s] = acc * 128; acc += (cnt[s] + 127) >> 7; }
        rb0[64] = acc;
    }
    __syncthreads();
}
DI int moe_find_seg(const int* rb0, int rbi) { int s = 0; while (rb0[s + 1] <= rbi) ++s; return s; }

DI void phase_moe_up(char* lds, const Ctx& P, int layer) {
    moe_tables(lds, P, layer);
    const int* cnt = (const int*)(lds + LDS_AUX); const int* rb0 = cnt + 64; const int* hoff = rb0 + 65;
    const bfr* hb = (const bfr*)(P.ws + OFF_HB);
    const bfr* wgu = (const bfr*)(P.ws + OFF_MWGU);
    const int* stok = (const int*)(P.ws + OFF_TOK);
    bfr* hid = (bfr*)(P.ws + OFF_HID);
    const int ntiles = rb0[64] * 8;
    for (int t = blockIdx.x; t < ntiles; t += gridDim.x) {
        const int rbi = t >> 3, nt = t & 7;
        const int seg = moe_find_seg(rb0, rbi);
        const int rb = rbi - rb0[seg], e = seg & 31, c = cnt[seg];
        const bfr* ap[4];
        const int tq = ltid();
#pragma unroll
        for (int i = 0; i < 4; ++i) {
            int p = rb * 128 + (tq >> 3) + 32 * i; p = p < c ? p : c - 1;
            ap[i] = hb + (size_t)stok[(size_t)seg * NTOK + p] * 1024 + (tq & 7) * 8;
        }
        auto aptr = [&](int i, int kt) __attribute__((always_inline)) -> const bfr* { return ap[i] + kt * 64; };
        RowLoader B(wgu + (size_t)e * 1024 * 1024, nt * 128, 1024);
        const size_t hrow0 = (size_t)hoff[seg] + rb * 128;
        gemm_tile(lds, 16, aptr, B, [&](const float* stg) __attribute__((always_inline)) {
            epi_rows8(stg, [&](int r, int c0, const float (&v)[8]) __attribute__((always_inline)) {
                float o[4];
#pragma unroll
                for (int j = 0; j < 4; ++j) o[j] = v[j] * sigmoidf_(v[j]) * v[4 + j];
                *(uint2*)(hid + (hrow0 + r) * 512 + ((nt * 128 + c0) >> 1)) = make_uint2(pk2(o[0], o[1]), pk2(o[2], o[3]));
            });
        });
    }
}

DI void phase_moe_down(char* lds, const Ctx& P, int layer, int k) {
    moe_tables(lds, P, layer);
    const int* cnt = (const int*)(lds + LDS_AUX); const int* rb0 = cnt + 64; const int* hoff = rb0 + 65;
    const bfr* hid = (const bfr*)(P.ws + OFF_HID);
    const bfr* wd = (const bfr*)(P.ws + OFF_MWD);
    const int* stok = (const int*)(P.ws + OFF_TOK);
    const float* sgate = (const float*)(P.ws + OFF_GATE);
    float* x = P.out;
    const int rbA = rb0[k * 32], rbB = rb0[k * 32 + 32];
    const int ntiles = (rbB - rbA) * 8;
    for (int t = blockIdx.x; t < ntiles; t += gridDim.x) {
        const int rbi = rbA + (t >> 3), nt = t & 7;
        const int seg = moe_find_seg(rb0, rbi);
        const int rb = rbi - rb0[seg], e = seg & 31, c = cnt[seg];
        RowLoader A(hid, hoff[seg] + rb * 128, 512), B(wd + (size_t)e * 1024 * 512, nt * 128, 512);
        gemm_tile(lds, 8, A, B, [&](const float* stg) __attribute__((always_inline)) {
            epi_rows8(stg, [&](int r, int c0, const float (&v)[8]) __attribute__((always_inline)) {
                const int p = rb * 128 + r;
                if (p < c) {
                    const int tok = stok[(size_t)seg * NTOK + p];
                    const float gt = sgate[(size_t)seg * NTOK + p];
                    float* d = x + (size_t)tok * DM + nt * 128 + c0;
                    float4 a = *(float4*)d, b = *(float4*)(d + 4);
                    a.x += gt * v[0]; a.y += gt * v[1]; a.z += gt * v[2]; a.w += gt * v[3];
                    b.x += gt * v[4]; b.y += gt * v[5]; b.z += gt * v[6]; b.w += gt * v[7];
                    *(float4*)d = a; *(float4*)(d + 4) = b;
                }
            });
        });
    }
}
constexpr int PH_PER_LAYER = 11;
constexpr int N_PHASES = 1 + 4 * PH_PER_LAYER;

DI void phase_prologue(char* lds, const Ctx& P) {
    for (int u = blockIdx.x; u < 64; u += gridDim.x) s5_tables(lds, P, u >> 5, u & 31);
    unsigned base = 0;
    const int wk = blockIdx.x, nw = gridDim.x;
    for (int i = 0; i < 2; ++i) {
        cvt_matrix(lds, P.in[I_EWIN] + (size_t)i * 1024 * 2304, 1024, 2304, (bfr*)(P.ws + OFF_WINE) + (size_t)i * 2304 * 1024, 1024, 0, wk, nw, base);
        cvt_matrix(lds, P.in[I_EWOUT] + (size_t)i * 1024 * 1024, 1024, 1024, (bfr*)(P.ws + OFF_WOUTE) + (size_t)i * 1024 * 1024, 1024, 0, wk, nw, base);
        cvt_matrix(lds, P.in[I_OWIN] + (size_t)i * 1024 * 2048, 1024, 2048, (bfr*)(P.ws + OFF_WINO) + (size_t)i * 2048 * 1024, 1024, 0, wk, nw, base);
        cvt_matrix(lds, P.in[I_OWOUT] + (size_t)i * 1024 * 1024, 1024, 1024, (bfr*)(P.ws + OFF_WOUTO) + (size_t)i * 1024 * 1024, 1024, 0, wk, nw, base);
        cvt_matrix(lds, P.in[I_W2] + (size_t)i * 64 * 512, 64, 512, (bfr*)(P.ws + OFF_W2T) + (size_t)i * 512 * 64, 64, 0, wk, nw, base);
        cvt_matrix(lds, P.in[I_A2] + (size_t)i * 64 * 512, 64, 512, (bfr*)(P.ws + OFF_A2T) + (size_t)i * 512 * 64, 64, 0, wk, nw, base);
        cvt_matrix(lds, P.in[I_G2] + (size_t)i * 128 * 512, 128, 512, (bfr*)(P.ws + OFF_G2T) + (size_t)i * 512 * 128, 128, 0, wk, nw, base);
        for (int g = 0; g < 4; ++g)
            cvt_matrix(lds, P.in[I_POOLW] + (size_t)(i * 4 + g) * 128 * 128, 128, 128, (bfr*)(P.ws + OFF_POOLT) + (size_t)(i * 4 + g) * 128 * 128, 128, 0, wk, nw, base);
        cvt_matrix(lds, P.in[I_WGLU] + (size_t)i * 512 * 512, 512, 512, (bfr*)(P.ws + OFF_GLUT) + (size_t)i * 512 * 512, 512, 0, wk, nw, base);
    }
    const int gtid = blockIdx.x * NTHREADS + ltid(), gsz = gridDim.x * NTHREADS;
    {
        bfr* rhi = (bfr*)(P.ws + OFF_RHI); bfr* rlo = (bfr*)(P.ws + OFF_RLO);
        for (int idx = gtid; idx < 4 * 128 * 1024; idx += gsz) {
            const int k = idx & 1023, n = (idx >> 10) & 127, l = idx >> 17;
            float w = 0.f;
            if (n < 32) w = P.in[I_MWE][((size_t)l * 1024 + k) * 32 + n];
            else if (n < 36) w = P.in[I_MWG][((size_t)l * 1024 + k) * 4 + (n - 32)];
            const bfr h = f2bf(w);
            rhi[idx] = h; rlo[idx] = f2bf(w - bf2f(h));
        }
    }
    {
        bfr* v12 = (bfr*)(P.ws + OFF_V12T);
        const float* v1 = P.in[I_V1]; const float* v2 = P.in[I_V2];
        for (int idx = gtid; idx < 512 * 512; idx += gsz) {
            const int k = idx & 511, n = idx >> 9;
            float s = 0.f;
            for (int r = 0; r < 32; ++r) s += v1[k * 32 + r] * v2[r * 512 + n];
            v12[idx] = f2bf(s);
        }
    }
    for (int tt = blockIdx.x; tt < 512; tt += gridDim.x)
        norm_rows(P.in[I_X], P.in[I_NMIX], (bfr*)(P.ws + OFF_HB), nullptr, P.out, tt * 64, 64);
}

DI Ctx mkctx(unsigned char* ws, float* out) {
    size_t z = 0;
    asm volatile("" : "+s"(z));
    Ctx c;
    c.in.p = (KArgPtr)__builtin_amdgcn_kernarg_segment_ptr() + z;
    c.ws = ws + z; c.out = (float*)((char*)out + z);
    return c;
}
__global__ void __launch_bounds__(NTHREADS, 2) fwd_kernel(Params PA) {
    extern __shared__ __attribute__((aligned(16))) char lds[];
    if (threadIdx.x == 0) *(uint4*)(lds + LDS_BYTES - 16) = make_uint4(0u, 0u, 0u, 0u);
    __syncthreads();
    XcdBarrier bar = xcd_barrier_post((unsigned*)(PA.ws + OFF_BAR), (volatile LAS unsigned*)(lds + LDS_BYTES - 16));
    const int lo = PA.ph_lo, hi = PA.ph_hi;
#define RUNS(id) ((id) >= lo && (id) < hi)
#define P mkctx(PA.ws, PA.out)
#define SEAM(id) do { if ((id) > lo && (id) < hi) xcd_barrier(bar); } while (0)
    if (RUNS(0)) phase_prologue(lds, P);
    for (int layer = 0; layer < 4; ++layer) {
        const int base = 1 + layer * PH_PER_LAYER;
        const int li = layer >> 1;
        if ((layer & 1) == 0) {
            SEAM(base + 0); if (RUNS(base + 0)) phase_e1(lds, P, li);
            SEAM(base + 1); if (RUNS(base + 1)) phase_e2a(P, li);
            SEAM(base + 2); if (RUNS(base + 2)) phase_e2b(lds, P, li);
            SEAM(base + 3); if (RUNS(base + 3)) phase_e3(lds, P, li);
            SEAM(base + 4); if (RUNS(base + 4)) phase_e4(P, li);
            SEAM(base + 5); if (RUNS(base + 5)) phase_wout(lds, P, (const bfr*)(P.ws + OFF_WOUTE) + (size_t)li * 1024 * 1024);
        } else {
            SEAM(base + 0); if (RUNS(base + 0)) phase_o1(lds, P, li);
            SEAM(base + 1); if (RUNS(base + 1)) phase_o2(lds, P, li);
            SEAM(base + 2); if (RUNS(base + 2)) phase_o3(lds, P, li, layer);
            SEAM(base + 3); if (RUNS(base + 3)) phase_o4(lds, P, li);
            SEAM(base + 4); if (RUNS(base + 4)) phase_o5(lds, P, li);
            SEAM(base + 5); if (RUNS(base + 5)) phase_wout(lds, P, (const bfr*)(P.ws + OFF_WOUTO) + (size_t)li * 1024 * 1024);
        }
        SEAM(base + 6);
        if (RUNS(base + 6)) {
            phase_router(lds, P, layer);
            const bool split = gridDim.x >= 512;
            moe_convert(lds, P, layer, split ? (int)blockIdx.x - 256 : (int)blockIdx.x, split ? (int)gridDim.x - 256 : (int)gridDim.x);
        }
        SEAM(base + 7); if (RUNS(base + 7)) phase_moe_up(lds, P, layer);
        SEAM(base + 8); if (RUNS(base + 8)) phase_moe_down(lds, P, layer, 0);
        SEAM(base + 9); if (RUNS(base + 9)) phase_moe_down(lds, P, layer, 1);
        SEAM(base + 10);
        if (RUNS(base + 10) && layer < 3) {
            for (int tt = blockIdx.x; tt < 512; tt += gridDim.x)
                norm_rows(P.out, P.in[I_NMIX] + (size_t)(layer + 1) * DM, (bfr*)(P.ws + OFF_HB), nullptr, nullptr, tt * 64, 64);
        }
    }
#undef P
#undef RUNS
#undef SEAM
}

#ifndef N_LAUNCH_SPLIT
#define N_LAUNCH_SPLIT 1
#endif
extern "C" void kernel_launch(void* const* d_in, const int* in_sizes, int n_in, void* d_out, int out_size, void* d_ws, size_t ws_size, hipStream_t stream) {
    static int grid = 0;
    if (grid == 0) {
        if (n_in != N_INPUTS || out_size != NTOK * DM || ws_size < WS_NEEDED) {
            fprintf(stderr, "kernel_launch: unexpected shapes: n_in %d out %d ws %zu (need %zu)\n", n_in, out_size, ws_size, (size_t)WS_NEEDED);
            grid = -1; return;
        }
        int dev = 0, cus = 0, per_cu = 0;
        (void)hipGetDevice(&dev);
        (void)hipDeviceGetAttribute(&cus, hipDeviceAttributeMultiprocessorCount, dev);
        if (hipFuncSetAttribute((const void*)fwd_kernel, hipFuncAttributeMaxDynamicSharedMemorySize, LDS_BYTES) != hipSuccess) { fprintf(stderr, "kernel_launch: hipFuncSetAttribute failed\n"); grid = -1; return; }
        if (hipOccupancyMaxActiveBlocksPerMultiprocessor(&per_cu, (const void*)fwd_kernel, NTHREADS, LDS_BYTES) != hipSuccess) per_cu = 1;
        (void)hipGetLastError();
        if (per_cu < 1) per_cu = 1;
        if (per_cu > 2) per_cu = 2;
        if (cus <= 0) cus = 256;
        grid = cus * per_cu;
    }
    if (grid < 0) return;
    (void)hipMemsetAsync(d_ws, 0, OFF_ZERO_END, stream);
    Params p{};
    for (int i = 0; i < N_INPUTS; ++i) p.in[i] = (const float*)d_in[i];
    p.out = (float*)d_out; p.ws = (unsigned char*)d_ws;
#if N_LAUNCH_SPLIT
    for (int ph = 0; ph < N_PHASES - 1; ++ph) {
        p.ph_lo = ph; p.ph_hi = ph + 1;
        hipLaunchKernelGGL(fwd_kernel, dim3(grid), dim3(NTHREADS), LDS_BYTES, stream, p);
    }
#else
    p.ph_lo = 0; p.ph_hi = N_PHASES;
    hipLaunchKernelGGL(fwd_kernel, dim3(grid), dim3(NTHREADS), LDS_BYTES, stream, p);
#endif
}
```

```cpp
#include <hip/hip_runtime.h>
#include <stdint.h>
#include <stdio.h>

typedef unsigned short bfr;
typedef __attribute__((ext_vector_type(8))) short bf16x8;
typedef __attribute__((ext_vector_type(16))) float f32x16;
typedef __attribute__((ext_vector_type(2))) __bf16 bf16x2_t;
#define DI __device__ __forceinline__
#define MFMA32(a, b, c) __builtin_amdgcn_mfma_f32_32x32x16_bf16((a), (b), (c), 0, 0, 0)

constexpr int NTOK = 32768, DM = 1024, SEQ = 2048, NB = 16;
constexpr int EVEN_IN = 2304, ODD_IN = 2048;
constexpr int NTHREADS = 256;
constexpr int LDS_BYTES = 81920;

enum { I_X = 0, I_NMIX, I_NFFN, I_EWIN, I_MU, I_W0, I_W2, I_A0, I_A2, I_G2, I_KK, I_KA, I_RK, I_LNG, I_LNB, I_V0, I_V1, I_V2,
       I_POOLW, I_POOLS, I_EWOUT, I_OWIN, I_QN, I_KN, I_LQ1, I_LK1, I_LQ2, I_LK2, I_SUBLN, I_ARE, I_AIM, I_LSTEP, I_BRE, I_BIM,
       I_CRE, I_CIM, I_S5D, I_WGLU, I_OWOUT, I_MWG, I_MBG, I_MWE, I_MBE, I_MWGATE, I_MWUP, I_MWDOWN, N_INPUTS };

constexpr size_t al256(size_t x) { return (x + 255) & ~(size_t)255; }
constexpr size_t OFF_BAR   = 0;
constexpr size_t OFF_CNT   = 16384;
constexpr size_t OFF_ZERO_END = 32768;
constexpr size_t OFF_WINE  = 65536;
constexpr size_t OFF_WOUTE = OFF_WINE  + (size_t)2 * 2304 * 1024 * 2;
constexpr size_t OFF_WINO  = OFF_WOUTE + (size_t)2 * 1024 * 1024 * 2;
constexpr size_t OFF_WOUTO = OFF_WINO  + (size_t)2 * 2048 * 1024 * 2;
constexpr size_t OFF_W2T   = OFF_WOUTO + (size_t)2 * 1024 * 1024 * 2;
constexpr size_t OFF_A2T   = OFF_W2T   + (size_t)2 * 512 * 64 * 2;
constexpr size_t OFF_G2T   = OFF_A2T   + (size_t)2 * 512 * 64 * 2;
constexpr size_t OFF_V12T  = OFF_G2T   + (size_t)2 * 512 * 128 * 2;
constexpr size_t OFF_POOLT = OFF_V12T  + (size_t)512 * 512 * 2;
constexpr size_t OFF_GLUT  = OFF_POOLT + (size_t)2 * 4 * 128 * 128 * 2;
constexpr size_t OFF_RHI   = OFF_GLUT  + (size_t)2 * 512 * 512 * 2;
constexpr size_t OFF_RLO   = OFF_RHI   + (size_t)4 * 128 * 1024 * 2;
constexpr size_t OFF_S5GT  = OFF_RLO   + (size_t)4 * 128 * 1024 * 2;
constexpr size_t OFF_S5BL  = OFF_S5GT  + (size_t)2 * 32 * 512 * 640 * 2;
constexpr size_t OFF_S5L32 = OFF_S5BL  + (size_t)2 * 32 * 128 * 512 * 2;
constexpr size_t OFF_MWGU  = al256(OFF_S5L32 + (size_t)2 * 32 * 64 * 2 * 4);
constexpr size_t OFF_MWD   = OFF_MWGU  + (size_t)32 * 1024 * 1024 * 2;
constexpr size_t OFF_HB    = OFF_MWD   + (size_t)32 * 1024 * 512 * 2;
constexpr size_t OFF_U     = OFF_HB    + (size_t)NTOK * 1024 * 2;
constexpr size_t OFF_US5   = OFF_U     + (size_t)NTOK * 1024 * 2;
constexpr size_t OFF_AMIX  = OFF_U     + (size_t)NTOK * 2304 * 2;
constexpr size_t OFF_VFIRST= OFF_AMIX  + (size_t)NTOK * 1024 * 2;
constexpr size_t OFF_TOK   = OFF_VFIRST+ (size_t)NTOK * 512 * 2;
constexpr size_t OFF_GATE  = OFF_TOK   + (size_t)64 * NTOK * 4;
constexpr size_t OFF_HID   = OFF_GATE  + (size_t)64 * NTOK * 4;
constexpr size_t OFF_HLO   = OFF_HID;
constexpr size_t OFF_EV    = OFF_HID   + (size_t)73728 * 512 * 2;
constexpr size_t OFF_S     = OFF_EV;
constexpr size_t OFF_MV2   = OFF_S     + (size_t)NTOK * 256 * 2;
constexpr size_t OFF_DLOG  = OFF_MV2   + (size_t)NTOK * 512 * 2;
constexpr size_t OFF_ABUF  = OFF_DLOG  + (size_t)NTOK * 512 * 4;
constexpr size_t OFF_GBUF  = OFF_ABUF  + (size_t)NTOK * 512 * 2;
constexpr size_t OFF_VGATE = OFF_GBUF  + (size_t)NTOK * 512 * 2;
constexpr size_t OFF_Y     = OFF_VGATE + (size_t)NTOK * 512 * 2;
constexpr size_t OFF_DPOOL = OFF_Y;
constexpr size_t OFF_BONUS = OFF_Y     + (size_t)NTOK * 512 * 4;
constexpr size_t OFF_EV_END= OFF_BONUS + (size_t)NTOK * 512 * 4;
constexpr size_t OFF_QN    = OFF_EV;
constexpr size_t OFF_KN    = OFF_QN    + (size_t)NTOK * 512 * 2;
constexpr size_t OFF_VT    = OFF_KN    + (size_t)NTOK * 512 * 2;
constexpr size_t OFF_XLOC  = OFF_VT    + (size_t)NTOK * 512 * 2;
constexpr size_t OFF_XIN   = OFF_XLOC  + (size_t)32 * 1024 * 128 * 4;
constexpr size_t OFF_ZBUF  = OFF_XIN   + (size_t)32 * 1024 * 128 * 2;
constexpr size_t OFF_OD_END= OFF_ZBUF  + (size_t)NTOK * 512 * 2;
constexpr size_t WS_NEEDED = OFF_EV_END > OFF_OD_END ? OFF_EV_END : OFF_OD_END;

struct Params {
    const float* in[N_INPUTS];
    float* out;
    unsigned char* ws;
    int ph_lo, ph_hi;
};
typedef const __attribute__((address_space(4))) char* KArgPtr;
struct InTab {
    KArgPtr p;
    DI const float* operator[](int i) const {
        const float* q = *(const float* const __attribute__((address_space(4)))*)(p + 8 * i);
        return (const float*)(const __attribute__((address_space(1))) float*)q;
    }
};
struct Ctx { InTab in; unsigned char* ws; float* out; };

DI unsigned pk2(float a, float b) { bf16x2_t v; v[0] = (__bf16)a; v[1] = (__bf16)b; return __builtin_bit_cast(unsigned, v); }
DI bfr f2bf(float a) { return (bfr)(pk2(a, 0.f) & 0xffffu); }
DI float bf2f(bfr b) { return __uint_as_float(((unsigned)b) << 16); }
DI float bflo(unsigned u) { return __uint_as_float(u << 16); }
DI float bfhi(unsigned u) { return __uint_as_float(u & 0xffff0000u); }
DI uint4 pack8(const float (&v)[8]) { return make_uint4(pk2(v[0], v[1]), pk2(v[2], v[3]), pk2(v[4], v[5]), pk2(v[6], v[7])); }
DI void unpack8(uint4 u, float (&v)[8]) { v[0] = bflo(u.x); v[1] = bfhi(u.x); v[2] = bflo(u.y); v[3] = bfhi(u.y); v[4] = bflo(u.z); v[5] = bfhi(u.z); v[6] = bflo(u.w); v[7] = bfhi(u.w); }
DI float sigmoidf_(float x) { return 1.0f / (1.0f + __expf(-x)); }
template <int CTRL> DI float dpp_f(float x) { return __builtin_bit_cast(float, __builtin_amdgcn_update_dpp(0, __builtin_bit_cast(int, x), CTRL, 0xf, 0xf, false)); }
DI float row16_sum(float s) {
    s += dpp_f<0x128>(s); s += dpp_f<0x124>(s); s += dpp_f<0x122>(s); s += dpp_f<0x121>(s); return s; }
DI int ltid() { int t = threadIdx.x; asm volatile("" : "+v"(t)); return t; }
DI float wave_sum(float s) { s = row16_sum(s); s += __shfl_xor(s, 16); s += __shfl_xor(s, 32); return s; }
#define XB_TMO      128
#define XB_XCNT(j)  (256  + 64 * (j))
#define XB_XSUB(j)  (1280 + 64 * (j))
#define XB_XGEN(j)  (2304 + 64 * (j))
#define XB_TOP      3328
#define XB_TOPGEN   3392
#define XCD_BAR_WORDS 3456
#define XB_SPIN_CAP (1u << 18)
#define LAS __attribute__((address_space(3)))

__device__ __forceinline__ unsigned xb_ld(unsigned* p)              { return __hip_atomic_load(p, __ATOMIC_RELAXED, __HIP_MEMORY_SCOPE_AGENT); }
__device__ __forceinline__ unsigned xb_add(unsigned* p, unsigned v) { return __hip_atomic_fetch_add(p, v, __ATOMIC_RELAXED, __HIP_MEMORY_SCOPE_AGENT); }
__device__ __forceinline__ unsigned xb_xcc_id() { return (unsigned)__builtin_amdgcn_s_getreg((3 << 11) | 20) & 0xFu; }
#define XB_SPIN(cond, bar) do { unsigned _sp = 0; while (cond) { __builtin_amdgcn_s_sleep(1); \
    if ((++_sp & 255u) == 0u) { if (xb_ld(&(bar)[XB_TMO])) break; if (_sp > XB_SPIN_CAP) { atomicAdd(&(bar)[XB_TMO], 1u); break; } } } } while (0)

struct XcdBarrier {
    unsigned* bar; unsigned x;
    volatile LAS unsigned* st;
};
__device__ __forceinline__ XcdBarrier xcd_barrier_post(unsigned* bar, volatile LAS unsigned* st) {
    XcdBarrier b; b.bar = bar; b.x = xb_xcc_id(); b.st = st;
    if (threadIdx.x == 0) (void)xb_add(&bar[XB_XCNT(b.x)], 1u);
    return b;
}
__device__ __forceinline__ void xcd_barrier_complete(unsigned* bar, unsigned x, unsigned& nloc, unsigned& nx) {
    const unsigned G = gridDim.x * gridDim.y * gridDim.z;
    unsigned sum, cnt, mine, sp = 0u;
    for (;;) {
        sum = 0u; cnt = 0u; mine = 0u;
#pragma unroll
        for (unsigned j = 0; j < 16; ++j) { const unsigned c = xb_ld(&bar[XB_XCNT(j)]); sum += c; cnt += (c > 0u) ? 1u : 0u; mine = (j == x) ? c : mine; }
        if (sum == G) break;
        __builtin_amdgcn_s_sleep(1);
        if ((++sp & 255u) == 0u) { if (xb_ld(&bar[XB_TMO])) break; if (sp > XB_SPIN_CAP) { atomicAdd(&bar[XB_TMO], 1u); break; } }
    }
    nloc = mine > 0u ? mine : 1u; nx = cnt > 0u ? cnt : 1u;
}
__device__ __forceinline__ void xcd_barrier(const XcdBarrier& b) {
    asm volatile("s_waitcnt vmcnt(0)" ::: "memory");
    __syncthreads();
    if (threadIdx.x == 0) {
        unsigned* bar = b.bar;
        __builtin_amdgcn_s_waitcnt(0);
        unsigned nloc = b.st[0], nx = b.st[1];
        if (nloc == 0u) { xcd_barrier_complete(bar, b.x, nloc, nx); b.st[0] = nloc; b.st[1] = nx; }
        const unsigned old = xb_add(&bar[XB_XSUB(b.x)], 1u);
        const unsigned gen = old / nloc;
        if (old + 1u == (gen + 1u) * nloc) {
            __builtin_amdgcn_fence(__ATOMIC_RELEASE, "agent");
            asm volatile("s_waitcnt vmcnt(0)" ::: "memory");
            const unsigned og = xb_add(&bar[XB_TOP], 1u);
            const unsigned tg = og / nx;
            if (og + 1u == (tg + 1u) * nx) xb_add(&bar[XB_TOPGEN], 1u);
            else XB_SPIN(xb_ld(&bar[XB_TOPGEN]) == tg, bar);
            __builtin_amdgcn_fence(__ATOMIC_ACQUIRE, "agent");
            xb_add(&bar[XB_XGEN(b.x)], 1u);
            asm volatile("s_waitcnt vmcnt(0)" ::: "memory");
        } else {
            XB_SPIN(xb_ld(&bar[XB_XGEN(b.x)]) == gen, bar);
            __builtin_amdgcn_fence(__ATOMIC_ACQUIRE, "agent");
            asm volatile("s_waitcnt vmcnt(0)" ::: "memory");
        }
    }
    __syncthreads();
}

constexpr int LDA = 72;
constexpr int TILE_B = 128 * LDA * 2;
constexpr int STG_LD = 132;
constexpr int LDS_AUX = 73728;

template <class AF, class BF, class EF>
DI void gemm_tile(char* lds, int nk, AF aptr, BF bptr, EF epi) {
    const int tid = ltid(), lane = tid & 63, wave = tid >> 6;
    const int wr = wave >> 1, wc = wave & 1;
    const int lrow = tid >> 3, lcol = (tid & 7) * 8;
    f32x16 acc[2][2];
#pragma unroll
    for (int a = 0; a < 2; ++a)
#pragma unroll
        for (int b = 0; b < 2; ++b)
#pragma unroll
            for (int r = 0; r < 16; ++r) acc[a][b][r] = 0.f;
    uint4 ra[4], rb[4];
#pragma unroll
    for (int i = 0; i < 4; ++i) { ra[i] = *(const uint4*)aptr(i, 0); rb[i] = *(const uint4*)bptr(i, 0); }
    const int st_off = (lrow * LDA + lcol) * 2;
#pragma unroll
    for (int i = 0; i < 4; ++i) {
        *(uint4*)(lds + st_off + i * (32 * LDA * 2)) = ra[i];
        *(uint4*)(lds + TILE_B + st_off + i * (32 * LDA * 2)) = rb[i];
    }
    __syncthreads();
    const int a_off = ((wr * 64 + (lane & 31)) * LDA + (lane >> 5) * 8) * 2;
    const int b_off = TILE_B + ((wc * 64 + (lane & 31)) * LDA + (lane >> 5) * 8) * 2;
    int buf = 0;
    for (int kt = 0; kt < nk; ++kt) {
        const bool more = (kt + 1 < nk);
        if (more) {
#pragma unroll
            for (int i = 0; i < 4; ++i) { ra[i] = *(const uint4*)aptr(i, kt + 1); rb[i] = *(const uint4*)bptr(i, kt + 1); }
        }
        const char* base = lds + buf * (2 * TILE_B);
#pragma unroll
        for (int ks = 0; ks < 4; ++ks) {
            const bf16x8 a0 = *(const bf16x8*)(base + a_off + ks * 32);
            const bf16x8 a1 = *(const bf16x8*)(base + a_off + ks * 32 + 32 * LDA * 2);
            const bf16x8 b0 = *(const bf16x8*)(base + b_off + ks * 32);
            const bf16x8 b1 = *(const bf16x8*)(base + b_off + ks * 32 + 32 * LDA * 2);
            acc[0][0] = MFMA32(a0, b0, acc[0][0]);
            acc[0][1] = MFMA32(a0, b1, acc[0][1]);
            acc[1][0] = MFMA32(a1, b0, acc[1][0]);
            acc[1][1] = MFMA32(a1, b1, acc[1][1]);
        }
        if (more) {
            char* nb = lds + (buf ^ 1) * (2 * TILE_B);
#pragma unroll
            for (int i = 0; i < 4; ++i) {
                *(uint4*)(nb + st_off + i * (32 * LDA * 2)) = ra[i];
                *(uint4*)(nb + TILE_B + st_off + i * (32 * LDA * 2)) = rb[i];
            }
        }
        __syncthreads();
        buf ^= 1;
    }
    float* stg = (float*)lds;
#pragma unroll
    for (int mi = 0; mi < 2; ++mi)
#pragma unroll
        for (int ni = 0; ni < 2; ++ni)
#pragma unroll
            for (int r = 0; r < 16; ++r) {
                const int row = wr * 64 + mi * 32 + (r & 3) + 8 * (r >> 2) + 4 * (lane >> 5);
                const int col = wc * 64 + ni * 32 + (lane & 31);
                stg[row * STG_LD + col] = acc[mi][ni][r];
            }
    __syncthreads();
    epi((const float*)stg);
    __syncthreads();
}
template <class F> DI void epi_rows8(const float* stg, F f) {
    const int tid0 = ltid();
#pragma unroll
    for (int it = 0; it < 8; ++it) {
        const int idx = it * NTHREADS + tid0;
        const int r = idx >> 4, c0 = (idx & 15) * 8;
        const float4 p = *(const float4*)(stg + r * STG_LD + c0);
        const float4 q = *(const float4*)(stg + r * STG_LD + c0 + 4);
        const float v[8] = {p.x, p.y, p.z, p.w, q.x, q.y, q.z, q.w};
        f(r, c0, v);
    }
}
struct RowLoader {
    const bfr* p; size_t ld;
    DI RowLoader(const bfr* base, int row0, size_t ld_) : ld(ld_) { const int t = ltid(); p = base + (size_t)(row0 + (t >> 3)) * ld_ + (t & 7) * 8; }
    DI const bfr* operator()(int i, int kt) const { return p + (size_t)(32 * i) * ld + kt * 64; }
};
DI int cvt_rowmap(int n, int mode) { return mode == 0 ? n : ((n >> 2) * 8 + (n & 3) + (mode == 2 ? 4 : 0)); }
DI void cvt_tile(char* lds, const float* __restrict__ src, int N, bfr* __restrict__ dst, int ldd, int k0, int n0, int mode) {
    float* t = (float*)lds;
    const int tid = ltid();
    const int r = tid >> 4, c = (tid & 15) * 4;
#pragma unroll
    for (int i = 0; i < 4; ++i) {
        const float4 v = *(const float4*)(src + (size_t)(k0 + r + 16 * i) * N + n0 + c);
        float* d = t + (r + 16 * i) * 65 + c;
        d[0] = v.x; d[1] = v.y; d[2] = v.z; d[3] = v.w;
    }
    __syncthreads();
#pragma unroll
    for (int i = 0; i < 2; ++i) {
        const int idx = tid + i * 256;
        const int n = idx & 63, kg = idx >> 6;
        float v[8];
#pragma unroll
        for (int j = 0; j < 8; ++j) v[j] = t[(kg * 8 + j) * 65 + n];
        *(uint4*)(dst + (size_t)cvt_rowmap(n0 + n, mode) * ldd + k0 + kg * 8) = pack8(v);
    }
    __syncthreads();
}
DI void cvt_matrix(char* lds, const float* src, int K, int N, bfr* dst, int ldd, int mode, int worker, int nworkers, unsigned& base) {
    if (worker < 0) return;
    const int ntn = N >> 6, ntiles = (K >> 6) * ntn;
    int t0 = (int)(((unsigned)worker + (unsigned)nworkers - (base % (unsigned)nworkers)) % (unsigned)nworkers);
    for (int t = t0; t < ntiles; t += nworkers) cvt_tile(lds, src, N, dst, ldd, (t / ntn) * 64, (t % ntn) * 64, mode);
    base += (unsigned)ntiles;
}
DI void moe_convert(char* lds, const Ctx& P, int layer, int worker, int nworkers) {
    unsigned base = 0;
    bfr* wgu = (bfr*)(P.ws + OFF_MWGU); bfr* wd = (bfr*)(P.ws + OFF_MWD);
    for (int e = 0; e < 32; ++e) {
        const size_t we = (size_t)(layer * 32 + e);
        cvt_matrix(lds, P.in[I_MWGATE] + we * 1024 * 512, 1024, 512, wgu + (size_t)e * 1024 * 1024, 1024, 1, worker, nworkers, base);
        cvt_matrix(lds, P.in[I_MWUP]   + we * 1024 * 512, 1024, 512, wgu + (size_t)e * 1024 * 1024, 1024, 2, worker, nworkers, base);
        cvt_matrix(lds, P.in[I_MWDOWN] + we * 512 * 1024, 512, 1024, wd  + (size_t)e * 1024 * 512,  512,  0, worker, nworkers, base);
    }
}

DI void s5_tables(char* lds, const Ctx& P, int i, int g) {
    float2* pw = (float2*)lds;
    float2* bb = pw + 64 * 33;
    float2* cm = bb + 64 * 16;
    float*  kt = (float*)(cm + 16 * 64);
    const int tid = ltid();
    const size_t gp = (size_t)(i * 32 + g) * 64;
    for (int idx = tid; idx < 64 * 33; idx += NTHREADS) {
        const int p = idx / 33, tau = idx % 33;
        const double re = fmin((double)P.in[I_ARE][gp + p], -1e-4), im = (double)P.in[I_AIM][gp + p];
        const double st = exp((double)P.in[I_LSTEP][gp + p]);
        const double mag = exp(re * st * tau), ang = im * st * tau;
        pw[idx] = make_float2((float)(mag * cos(ang)), (float)(mag * sin(ang)));
    }
    for (int idx = tid; idx < 64 * 16; idx += NTHREADS) {
        const int p = idx >> 4, c = idx & 15;
        const double re = fmin((double)P.in[I_ARE][gp + p], -1e-4), im = (double)P.in[I_AIM][gp + p];
        const double st = exp((double)P.in[I_LSTEP][gp + p]);
        const double mag = exp(re * st), lr = mag * cos(im * st) - 1.0, li = mag * sin(im * st);
        const double den = re * re + im * im;
        const double fr = (lr * re + li * im) / den, fi = (li * re - lr * im) / den;
        const double br = (double)P.in[I_BRE][(gp + p) * 16 + c], bi = (double)P.in[I_BIM][(gp + p) * 16 + c];
        bb[idx] = make_float2((float)(fr * br - fi * bi), (float)(fr * bi + fi * br));
        const int cc = idx >> 6, pp = idx & 63;
        cm[idx] = make_float2(P.in[I_CRE][((size_t)(i * 32 + g) * 16 + cc) * 64 + pp], P.in[I_CIM][((size_t)(i * 32 + g) * 16 + cc) * 64 + pp]);
    }
    __syncthreads();
    for (int idx = tid; idx < 32 * 256; idx += NTHREADS) {
        const int tau = idx >> 8, c1 = (idx >> 4) & 15, c = idx & 15;
        float s = 0.f;
        for (int p = 0; p < 64; ++p) {
            const float2 a = cm[c1 * 64 + p], w = pw[p * 33 + tau], b = bb[p * 16 + c];
            const float tr = a.x * w.x - a.y * w.y, ti = a.x * w.y + a.y * w.x;
            s += tr * b.x - ti * b.y;
        }
        kt[idx] = s;
    }
    __syncthreads();
    bfr* gt = (bfr*)(P.ws + OFF_S5GT) + (size_t)(i * 32 + g) * 512 * 640;
    for (int idx = tid; idx < 512 * 80; idx += NTHREADS) {
        const int n = idx / 80, ch = idx % 80;
        const int t = n >> 4, c1 = n & 15;
        float v[8];
        if (ch < 64) {
            const int s = ch >> 1, c0 = (ch & 1) * 8;
#pragma unroll
            for (int j = 0; j < 8; ++j) v[j] = (t >= s) ? kt[((t - s) * 16 + c1) * 16 + c0 + j] : 0.f;
        } else {
            const int p0 = (ch - 64) * 4;
#pragma unroll
            for (int j = 0; j < 4; ++j) {
                const float2 a = cm[c1 * 64 + p0 + j], w = pw[(p0 + j) * 33 + t + 1];
                v[2 * j] = a.x * w.x - a.y * w.y;
                v[2 * j + 1] = -(a.x * w.y + a.y * w.x);
            }
        }
        *(uint4*)(gt + (size_t)n * 640 + ch * 8) = pack8(v);
    }
    bfr* bl = (bfr*)(P.ws + OFF_S5BL) + (size_t)(i * 32 + g) * 128 * 512;
    for (int idx = tid; idx < 128 * 64; idx += NTHREADS) {
        const int n = idx >> 6, ch = idx & 63;
        const int p = n >> 1, ri = n & 1, s = ch >> 1, c0 = (ch & 1) * 8;
        const float2 w = pw[p * 33 + 31 - s];
        float v[8];
#pragma unroll
        for (int j = 0; j < 8; ++j) { const float2 b = bb[p * 16 + c0 + j]; v[j] = ri ? (w.x * b.y + w.y * b.x) : (w.x * b.x - w.y * b.y); }
        *(uint4*)(bl + (size_t)n * 512 + ch * 8) = pack8(v);
    }
    float* l32 = (float*)(P.ws + OFF_S5L32) + (size_t)(i * 32 + g) * 128;
    if (tid < 64) { l32[2 * tid] = pw[tid * 33 + 32].x; l32[2 * tid + 1] = pw[tid * 33 + 32].y; }
    __syncthreads();
}

DI void norm_rows(const float* __restrict__ x, const float* __restrict__ g, bfr* __restrict__ hb, bfr* __restrict__ hlo, float* __restrict__ xcopy, int tok0, int ntok) {
    const int tid_ = ltid();
    const int lane = tid_ & 63, wave = tid_ >> 6;
    for (int tk = wave; tk < ntok; tk += 4) {
        const size_t tok = (size_t)(tok0 + tk);
        float4 v[4];
        float ss = 0.f;
#pragma unroll
        for (int i = 0; i < 4; ++i) {
            v[i] = *(const float4*)(x + tok * DM + i * 256 + lane * 4);
            ss += v[i].x * v[i].x + v[i].y * v[i].y + v[i].z * v[i].z + v[i].w * v[i].w;
        }
        ss = wave_sum(ss);
        const float rs = rsqrtf(ss * (1.0f / DM) + 1e-6f);
#pragma unroll
        for (int i = 0; i < 4; ++i) {
            const float4 gg = *(const float4*)(g + i * 256 + lane * 4);
            const float h0 = v[i].x * rs * gg.x, h1 = v[i].y * rs * gg.y, h2 = v[i].z * rs * gg.z, h3 = v[i].w * rs * gg.w;
            const unsigned p0 = pk2(h0, h1), p1 = pk2(h2, h3);
            *(uint2*)(hb + tok * DM + i * 256 + lane * 4) = make_uint2(p0, p1);
            if (hlo) {
                const unsigned q0 = pk2(h0 - bflo(p0), h1 - bfhi(p0)), q1 = pk2(h2 - bflo(p1), h3 - bfhi(p1));
                *(uint2*)(hlo + tok * DM + i * 256 + lane * 4) = make_uint2(q0, q1);
            }
            if (xcopy) *(float4*)(xcopy + tok * DM + i * 256 + lane * 4) = v[i];
        }
    }
}
DI void phase_e1(char* lds, const Ctx& P, int li) {
    const bfr* hb = (const bfr*)(P.ws + OFF_HB);
    const bfr* w = (const bfr*)(P.ws + OFF_WINE) + (size_t)li * 2304 * 1024;
    bfr* u = (bfr*)(P.ws + OFF_U);
    for (int t = blockIdx.x; t < 256 * 18; t += gridDim.x) {
        const int mt = t / 18, nt = t % 18;
        RowLoader A(hb, mt * 128, 1024), B(w, nt * 128, 1024);
        gemm_tile(lds, 16, A, B, [&](const float* stg) __attribute__((always_inline)) {
            epi_rows8(stg, [&](int r, int c0, const float (&v)[8]) __attribute__((always_inline)) {
                *(uint4*)(u + (size_t)(mt * 128 + r) * EVEN_IN + nt * 128 + c0) = pack8(v);
            });
        });
    }
}

DI void phase_e2a(const Ctx& P, int li) {
    const bfr* u = (const bfr*)(P.ws + OFF_U);
    const float* mu = P.in[I_MU] + (size_t)li * 1792;
    bfr* S = (bfr*)(P.ws + OFF_S);
    bfr* mv = (bfr*)(P.ws + (li == 0 ? OFF_VFIRST : OFF_MV2));
    bfr* dpool = (bfr*)(P.ws + OFF_DPOOL);
    const int total = NTOK * 160;
    for (int idx = blockIdx.x * NTHREADS + ltid(); idx < total; idx += gridDim.x * NTHREADS) {
        const int tok = idx / 160, ch = idx % 160;
        const int col = 1024 + ch * 8;
        const int t = tok & (SEQ - 1);
        const bfr* row = u + (size_t)tok * EVEN_IN;
        float cur[8];
        unpack8(*(const uint4*)(row + col), cur);
        if (col < 1792) {
            float prv[8], m[8];
            if (t > 0) unpack8(*(const uint4*)(row - EVEN_IN + col), prv);
            else {
#pragma unroll
                for (int j = 0; j < 8; ++j) prv[j] = 0.f;
            }
            const float4 m0 = *(const float4*)(mu + col), m1 = *(const float4*)(mu + col + 4);
            const float mm[8] = {m0.x, m0.y, m0.z, m0.w, m1.x, m1.y, m1.z, m1.w};
#pragma unroll
            for (int j = 0; j < 8; ++j) m[j] = cur[j] + (prv[j] - cur[j]) * mm[j];
            if (col < 1536) {
                *(uint4*)(mv + (size_t)tok * 512 + (col - 1024)) = pack8(m);
            } else if (col < 1600) {
#pragma unroll
                for (int j = 0; j < 8; ++j) m[j] = tanhf(m[j]);
                *(uint4*)(S + (size_t)tok * 256 + (col - 1536)) = pack8(m);
            } else if (col < 1664) {
                *(uint4*)(S + (size_t)tok * 256 + 64 + (col - 1600)) = pack8(m);
            } else {
#pragma unroll
                for (int j = 0; j < 8; ++j) m[j] = sigmoidf_(m[j]);
                *(uint4*)(S + (size_t)tok * 256 + 128 + (col - 1664)) = pack8(m);
            }
        } else {
            const int gi = (col - 1792) >> 7;
            const int win = 2 << gi;
            const int nw = (t + 1 < win) ? (t + 1) : win;
            float acc[8];
#pragma unroll
            for (int j = 0; j < 8; ++j) acc[j] = cur[j];
            for (int s = 1; s < nw; ++s) {
                float p[8];
                unpack8(*(const uint4*)(row - (size_t)s * EVEN_IN + col), p);
#pragma unroll
                for (int j = 0; j < 8; ++j) acc[j] += p[j];
            }
            const float inv = 1.0f / (float)nw;
#pragma unroll
            for (int j = 0; j < 8; ++j) acc[j] = acc[j] * inv - cur[j];
            *(uint4*)(dpool + (size_t)tok * 512 + (col - 1792)) = pack8(acc);
        }
    }
}

DI void phase_e2b(char* lds, const Ctx& P, int li) {
    const bfr* S = (const bfr*)(P.ws + OFF_S);
    const int njobs = (li == 1) ? 20 : 16;
    for (int t = blockIdx.x; t < 256 * njobs; t += gridDim.x) {
        const int mt = t / njobs, j = t % njobs;
        const int job = j >> 2, nt = j & 3;
        const int m0 = mt * 128;
        if (job == 0) {
            RowLoader A(S, m0, 256), B((const bfr*)(P.ws + OFF_W2T) + (size_t)li * 512 * 64, nt * 128, 64);
            const float* w0 = P.in[I_W0] + li * 512;
            float* dlog = (float*)(P.ws + OFF_DLOG);
            gemm_tile(lds, 1, A, B, [&](const float* stg) __attribute__((always_inline)) {
                epi_rows8(stg, [&](int r, int c0, const float (&v)[8]) __attribute__((always_inline)) {
                    float o[8];
#pragma unroll
                    for (int q = 0; q < 8; ++q) {
                        const float z = -(w0[nt * 128 + c0 + q] + v[q]);
                        const float sp = fmaxf(z, 0.f) + log1pf(__expf(-fabsf(z)));
                        o[q] = -__expf(-sp - 0.5f);
                    }
                    float* d = dlog + (size_t)(m0 + r) * 512 + nt * 128 + c0;
                    *(float4*)d = make_float4(o[0], o[1], o[2], o[3]); *(float4*)(d + 4) = make_float4(o[4], o[5], o[6], o[7]);
                });
            });
        } else if (job == 1) {
            RowLoader A(S + 64, m0, 256), B((const bfr*)(P.ws + OFF_A2T) + (size_t)li * 512 * 64, nt * 128, 64);
            const float* a0 = P.in[I_A0] + li * 512;
            bfr* ab = (bfr*)(P.ws + OFF_ABUF);
            gemm_tile(lds, 1, A, B, [&](const float* stg) __attribute__((always_inline)) {
                epi_rows8(stg, [&](int r, int c0, const float (&v)[8]) __attribute__((always_inline)) {
                    float o[8];
#pragma unroll
                    for (int q = 0; q < 8; ++q) o[q] = sigmoidf_(a0[nt * 128 + c0 + q] + v[q]);
                    *(uint4*)(ab + (size_t)(m0 + r) * 512 + nt * 128 + c0) = pack8(o);
                });
            });
        } else if (job == 2) {
            RowLoader A(S + 128, m0, 256), B((const bfr*)(P.ws + OFF_G2T) + (size_t)li * 512 * 128, nt * 128, 128);
            bfr* gb = (bfr*)(P.ws + OFF_GBUF);
            gemm_tile(lds, 2, A, B, [&](const float* stg) __attribute__((always_inline)) {
                epi_rows8(stg, [&](int r, int c0, const float (&v)[8]) __attribute__((always_inline)) {
                    *(uint4*)(gb + (size_t)(m0 + r) * 512 + nt * 128 + c0) = pack8(v);
                });
            });
        } else if (job == 3) {
            RowLoader A((const bfr*)(P.ws + OFF_DPOOL) + nt * 128, m0, 512), B((const bfr*)(P.ws + OFF_POOLT) + (size_t)(li * 4 + nt) * 128 * 128, 0, 128);
            const float* ps = P.in[I_POOLS] + li * 512 + nt * 128;
            bfr* am = (bfr*)(P.ws + OFF_AMIX);
            gemm_tile(lds, 2, A, B, [&](const float* stg) __attribute__((always_inline)) {
                epi_rows8(stg, [&](int r, int c0, const float (&v)[8]) __attribute__((always_inline)) {
                    float o[8];
#pragma unroll
                    for (int q = 0; q < 8; ++q) o[q] = v[q] * ps[c0 + q];
                    *(uint4*)(am + (size_t)(m0 + r) * 1024 + 512 + nt * 128 + c0) = pack8(o);
                });
            });
        } else {
            RowLoader A((const bfr*)(P.ws + OFF_MV2), m0, 512), B((const bfr*)(P.ws + OFF_V12T), nt * 128, 512);
            const float* v0 = P.in[I_V0];
            bfr* vg = (bfr*)(P.ws + OFF_VGATE);
            gemm_tile(lds, 8, A, B, [&](const float* stg) __attribute__((always_inline)) {
                epi_rows8(stg, [&](int r, int c0, const float (&v)[8]) __attribute__((always_inline)) {
                    float o[8];
#pragma unroll
                    for (int q = 0; q < 8; ++q) o[q] = sigmoidf_(v0[nt * 128 + c0 + q] + v[q]);
                    *(uint4*)(vg + (size_t)(m0 + r) * 512 + nt * 128 + c0) = pack8(o);
                });
            });
        }
    }
}

constexpr int RW_TC = 32;
DI void phase_e3(char* lds, const Ctx& P, int li) {
    float* s_w = (float*)lds;
    float* s_a = s_w + RW_TC * 64;
    float* s_b = s_a + RW_TC * 64;
    float* s_k = s_b + RW_TC * 64;
    float* s_r = s_k + RW_TC * 64;
    float* s_v = s_r + RW_TC * 64;
    float* s_y = s_v + RW_TC * 16;
    const bfr* u = (const bfr*)(P.ws + OFF_U);
    const float* mu = P.in[I_MU] + (size_t)li * 1792;
    const float* dlog = (const float*)(P.ws + OFF_DLOG);
    const bfr* ab = (const bfr*)(P.ws + OFF_ABUF);
    const bfr* vg = (const bfr*)(P.ws + OFF_VGATE);
    const bfr* vf = (const bfr*)(P.ws + OFF_VFIRST);
    float* yout = (float*)(P.ws + OFF_Y);
    float* bonus = (float*)(P.ws + OFF_BONUS);
    const int tid = ltid(), lane = tid & 63, wave = tid >> 6;
    const int pstep = tid >> 3, pc0 = (tid & 7) * 8;
    for (int item = blockIdx.x; item < 512; item += gridDim.x) {
        const int bh = item >> 2, qtr = item & 3;
        const int b = bh >> 3, h = bh & 7;
        const int i0 = qtr * 16;
        float c_mur[8], c_muk[8], c_muv[8], c_kk[8], c_ka[8], c_rk[8];
#pragma unroll
        for (int j = 0; j < 8; ++j) {
            const int c = h * 64 + pc0 + j;
            c_mur[j] = mu[c]; c_muk[j] = mu[512 + c]; c_muv[j] = mu[1024 + c];
            c_kk[j] = P.in[I_KK][li * 512 + c]; c_ka[j] = P.in[I_KA][li * 512 + c]; c_rk[j] = P.in[I_RK][li * 512 + c];
        }
        float S0 = 0.f, S1 = 0.f, S2 = 0.f, S3 = 0.f;
        const int rloc = wave * 4 + (lane >> 4);
        const int j0 = (lane & 15) * 4;
        for (int t0 = 0; t0 < SEQ; t0 += RW_TC) {
            __syncthreads();
            {
                const int t = t0 + pstep;
                const size_t tok = (size_t)b * SEQ + t;
                const bfr* row = u + tok * EVEN_IN + h * 64 + pc0;
                float ur[8], uk[8], uv[8], pr[8], pk[8], pv[8];
                unpack8(*(const uint4*)(row), ur); unpack8(*(const uint4*)(row + 512), uk); unpack8(*(const uint4*)(row + 1024), uv);
                if (t > 0) { unpack8(*(const uint4*)(row - EVEN_IN), pr); unpack8(*(const uint4*)(row - EVEN_IN + 512), pk); unpack8(*(const uint4*)(row - EVEN_IN + 1024), pv); }
                else {
#pragma unroll
                    for (int j = 0; j < 8; ++j) { pr[j] = 0.f; pk[j] = 0.f; pv[j] = 0.f; }
                }
                const size_t o512 = tok * 512 + h * 64 + pc0;
                float av[8], gv[8], fv[8];
                unpack8(*(const uint4*)(ab + o512), av);
                const float4 d0 = *(const float4*)(dlog + o512), d1 = *(const float4*)(dlog + o512 + 4);
                const float dl[8] = {d0.x, d0.y, d0.z, d0.w, d1.x, d1.y, d1.z, d1.w};
                if (li == 1) { unpack8(*(const uint4*)(vg + o512), gv); unpack8(*(const uint4*)(vf + o512), fv); }
                float kkr[8], kmod[8], rr[8], vv[8];
                float ssq = 0.f, bsum = 0.f;
#pragma unroll
                for (int j = 0; j < 8; ++j) {
                    rr[j] = ur[j] + (pr[j] - ur[j]) * c_mur[j];
                    const float k = uk[j] + (pk[j] - uk[j]) * c_muk[j];
                    float v = uv[j] + (pv[j] - uv[j]) * c_muv[j];
                    if (li == 1) v = v + (fv[j] - v) * gv[j];
                    vv[j] = v;
                    kkr[j] = k * c_kk[j];
                    ssq += kkr[j] * kkr[j];
                    kmod[j] = k * (1.0f + (av[j] - 1.0f) * c_ka[j]);
                    bsum += rr[j] * kmod[j] * c_rk[j];
                }
                ssq += __shfl_xor(ssq, 1); ssq += __shfl_xor(ssq, 2); ssq += __shfl_xor(ssq, 4);
                bsum += __shfl_xor(bsum, 1); bsum += __shfl_xor(bsum, 2); bsum += __shfl_xor(bsum, 4);
                const float inv = 1.0f / fmaxf(sqrtf(ssq), 1e-12f);
#pragma unroll
                for (int j = 0; j < 8; ++j) {
                    const float kk = kkr[j] * inv;
                    s_w[pstep * 64 + pc0 + j] = __expf(dl[j]);
                    s_a[pstep * 64 + pc0 + j] = -kk;
                    s_b[pstep * 64 + pc0 + j] = kk * av[j];
                    s_k[pstep * 64 + pc0 + j] = kmod[j];
                    s_r[pstep * 64 + pc0 + j] = rr[j];
                }
                if ((pc0 >> 4) == qtr) {
                    float bo[8];
#pragma unroll
                    for (int j = 0; j < 8; ++j) { s_v[pstep * 16 + (pc0 & 15) + j] = vv[j]; bo[j] = bsum * vv[j]; }
                    float* bp = bonus + o512;
                    *(float4*)bp = make_float4(bo[0], bo[1], bo[2], bo[3]); *(float4*)(bp + 4) = make_float4(bo[4], bo[5], bo[6], bo[7]);
                }
            }
            __syncthreads();
#pragma unroll 4
            for (int s = 0; s < RW_TC; ++s) {
                const float4 a4 = *(const float4*)(s_a + s * 64 + j0);
                const float4 w4 = *(const float4*)(s_w + s * 64 + j0);
                const float4 b4 = *(const float4*)(s_b + s * 64 + j0);
                const float4 k4 = *(const float4*)(s_k + s * 64 + j0);
                const float4 r4 = *(const float4*)(s_r + s * 64 + j0);
                const float vi = s_v[s * 16 + rloc];
                float sa = S0 * a4.x + S1 * a4.y + S2 * a4.z + S3 * a4.w;
                sa = row16_sum(sa);
                S0 = S0 * w4.x + sa * b4.x + vi * k4.x;
                S1 = S1 * w4.y + sa * b4.y + vi * k4.y;
                S2 = S2 * w4.z + sa * b4.z + vi * k4.z;
                S3 = S3 * w4.w + sa * b4.w + vi * k4.w;
                float y = S0 * r4.x + S1 * r4.y + S2 * r4.z + S3 * r4.w;
                y = row16_sum(y);
                if ((lane & 15) == 0) s_y[s * 16 + rloc] = y;
            }
            __syncthreads();
            {
                for (int idx = tid; idx < RW_TC * 16; idx += NTHREADS) {
                    const int s = idx >> 4, r = idx & 15;
                    yout[((size_t)b * SEQ + t0 + s) * 512 + h * 64 + i0 + r] = s_y[idx];
                }
            }
        }
    }
}

DI void phase_e4(const Ctx& P, int li) {
    const float* y = (const float*)(P.ws + OFF_Y);
    const float* bonus = (const float*)(P.ws + OFF_BONUS);
    const bfr* gb = (const bfr*)(P.ws + OFF_GBUF);
    const float* lng = P.in[I_LNG] + li * 512;
    const float* lnb = P.in[I_LNB] + li * 512;
    bfr* am = (bfr*)(P.ws + OFF_AMIX);
    const int total = NTOK * 64;
    for (int idx = blockIdx.x * NTHREADS + ltid(); idx < total; idx += gridDim.x * NTHREADS) {
        const int tok = idx >> 6, c = (idx & 63) * 8;
        const size_t o = (size_t)tok * 512 + c;
        const float4 y0 = *(const float4*)(y + o), y1 = *(const float4*)(y + o + 4);
        float v[8] = {y0.x, y0.y, y0.z, y0.w, y1.x, y1.y, y1.z, y1.w};
        float s = 0.f;
#pragma unroll
        for (int j = 0; j < 8; ++j) s += v[j];
        s += __shfl_xor(s, 1); s += __shfl_xor(s, 2); s += __shfl_xor(s, 4);
        const float mean = s * (1.0f / 64.0f);
        float q = 0.f;
#pragma unroll
        for (int j = 0; j < 8; ++j) { v[j] -= mean; q += v[j] * v[j]; }
        q += __shfl_xor(q, 1); q += __shfl_xor(q, 2); q += __shfl_xor(q, 4);
        const float rstd = rsqrtf(q * (1.0f / 64.0f) + 64e-5f);
        const float4 b0 = *(const float4*)(bonus + o), b1 = *(const float4*)(bonus + o + 4);
        const float bo[8] = {b0.x, b0.y, b0.z, b0.w, b1.x, b1.y, b1.z, b1.w};
        float gv[8];
        unpack8(*(const uint4*)(gb + o), gv);
        float out[8];
#pragma unroll
        for (int j = 0; j < 8; ++j) out[j] = (v[j] * rstd * lng[c + j] + lnb[c + j] + bo[j]) * gv[j];
        *(uint4*)(am + (size_t)tok * 1024 + c) = pack8(out);
    }
}

DI void phase_wout(char* lds, const Ctx& P, const bfr* w) {
    const bfr* am = (const bfr*)(P.ws + OFF_AMIX);
    float* x = P.out;
    for (int t = blockIdx.x; t < 256 * 8; t += gridDim.x) {
        const int mt = t >> 3, nt = t & 7;
        RowLoader A(am, mt * 128, 1024), B(w, nt * 128, 1024);
        gemm_tile(lds, 16, A, B, [&](const float* stg) __attribute__((always_inline)) {
            epi_rows8(stg, [&](int r, int c0, const float (&v)[8]) __attribute__((always_inline)) {
                float* d = x + (size_t)(mt * 128 + r) * DM + nt * 128 + c0;
                float4 a = *(float4*)d, b = *(float4*)(d + 4);
                a.x += v[0]; a.y += v[1]; a.z += v[2]; a.w += v[3]; b.x += v[4]; b.y += v[5]; b.z += v[6]; b.w += v[7];
                *(float4*)d = a; *(float4*)(d + 4) = b;
            });
        });
    }
}
DI void phase_o1(char* lds, const Ctx& P, int li) {
    const bfr* hb = (const bfr*)(P.ws + OFF_HB);
    const bfr* w = (const bfr*)(P.ws + OFF_WINO) + (size_t)li * 2048 * 1024;
    bfr* qk = (bfr*)(P.ws + OFF_U);
    bfr* vT = (bfr*)(P.ws + OFF_VT);
    bfr* us5 = (bfr*)(P.ws + OFF_US5);
    for (int t = blockIdx.x; t < 256 * 16; t += gridDim.x) {
        const int mt = t >> 4, nt = t & 15;
        const int m0 = mt * 128;
        RowLoader A(hb, m0, 1024), B(w, nt * 128, 1024);
        gemm_tile(lds, 16, A, B, [&](const float* stg) __attribute__((always_inline)) {
            if (nt < 8) {
                epi_rows8(stg, [&](int r, int c0, const float (&v)[8]) __attribute__((always_inline)) {
                    *(uint4*)(qk + (size_t)(m0 + r) * 1024 + nt * 128 + c0) = pack8(v);
                });
            } else if (nt < 12) {
                const int b = m0 >> 11, tq = m0 & (SEQ - 1);
                bfr* dst = vT + ((size_t)(b * 4 + (nt - 8)) * 128) * SEQ + tq;
                const int tid0 = ltid();
#pragma unroll
                for (int it = 0; it < 8; ++it) {
                    const int idx = it * NTHREADS + tid0;
                    const int dv = idx & 127, rg = idx >> 7;
                    float v[8];
#pragma unroll
                    for (int j = 0; j < 8; ++j) v[j] = stg[(rg * 8 + j) * STG_LD + dv];
                    *(uint4*)(dst + (size_t)dv * SEQ + rg * 8) = pack8(v);
                }
            } else {
                epi_rows8(stg, [&](int r, int c0, const float (&v)[8]) __attribute__((always_inline)) {
                    const int cc = (nt - 12) * 128 + c0;
                    *(uint4*)(us5 + ((size_t)(cc >> 4) * NTOK + m0 + r) * 16 + (cc & 15)) = pack8(v);
                });
            }
        });
    }
}

DI void phase_o2(char* lds, const Ctx& P, int li) {
    const bfr* qk = (const bfr*)(P.ws + OFF_U);
    bfr* qn = (bfr*)(P.ws + OFF_QN);
    bfr* kn = (bfr*)(P.ws + OFF_KN);
    const float* gq = P.in[I_QN] + li * 64;
    const float* gk = P.in[I_KN] + li * 64;
    const bfr* us5 = (const bfr*)(P.ws + OFF_US5);
    const bfr* bl = (const bfr*)(P.ws + OFF_S5BL) + (size_t)li * 32 * 128 * 512;
    float* xloc = (float*)(P.ws + OFF_XLOC);
    for (int t = blockIdx.x; t < 256; t += gridDim.x) {
        const int g = t >> 3, mt = t & 7;
        RowLoader A(us5 + (size_t)g * NTOK * 16, mt * 128, 512), B(bl + (size_t)g * 128 * 512, 0, 512);
        gemm_tile(lds, 8, A, B, [&](const float* stg) __attribute__((always_inline)) {
            epi_rows8(stg, [&](int r, int c0, const float (&v)[8]) __attribute__((always_inline)) {
                float* d = xloc + ((size_t)g * 1024 + mt * 128 + r) * 128 + c0;
                *(float4*)d = make_float4(v[0], v[1], v[2], v[3]); *(float4*)(d + 4) = make_float4(v[4], v[5], v[6], v[7]);
            });
        });
    }
    const int total = NTOK * 16 * 8;
    for (int idx = blockIdx.x * NTHREADS + ltid(); idx < total; idx += gridDim.x * NTHREADS) {
        const int l8 = idx & 7, item = idx >> 3;
        const int hm = item & 7, which = (item >> 3) & 1, tok = item >> 4;
        const int d0 = l8 * 4;
        const bfr* src = qk + (size_t)tok * 1024 + which * 512 + hm * 64;
        const uint2 ua = *(const uint2*)(src + d0), ub = *(const uint2*)(src + 32 + d0);
        float x1[4] = {bflo(ua.x), bfhi(ua.x), bflo(ua.y), bfhi(ua.y)};
        float x2[4] = {bflo(ub.x), bfhi(ub.x), bflo(ub.y), bfhi(ub.y)};
        float ss = 0.f;
#pragma unroll
        for (int j = 0; j < 4; ++j) ss += x1[j] * x1[j] + x2[j] * x2[j];
        ss += __shfl_xor(ss, 1); ss += __shfl_xor(ss, 2); ss += __shfl_xor(ss, 4);
        const float rs = rsqrtf(ss * (1.0f / 64.0f) + 1e-6f);
        const float* gg = which ? gk : gq;
        const float scl = which ? 1.0f : (0.125f * 1.4426950408889634f);
        const int t = tok & (SEQ - 1);
        float o1[4], o2[4];
#pragma unroll
        for (int j = 0; j < 4; ++j) {
            const int i = d0 + j;
            const float invf = exp2f(-(float)i * (13.287712379549449f / 32.0f));
            const float ang = (float)t * invf;
            float sn, cs;
            sincosf(ang, &sn, &cs);
            const float a = x1[j] * rs * gg[i], b2 = x2[j] * rs * gg[32 + i];
            o1[j] = (a * cs - b2 * sn) * scl;
            o2[j] = (b2 * cs + a * sn) * scl;
        }
        bfr* dst = (which ? kn : qn) + (size_t)tok * 512 + hm * 64;
        *(uint2*)(dst + d0) = make_uint2(pk2(o1[0], o1[1]), pk2(o1[2], o1[3]));
        *(uint2*)(dst + 32 + d0) = make_uint2(pk2(o2[0], o2[1]), pk2(o2[2], o2[3]));
    }
}

DI void s5_scan(const Ctx& P, int li) {
    const float* xloc = (const float*)(P.ws + OFF_XLOC);
    bfr* xin = (bfr*)(P.ws + OFF_XIN);
    const float* l32 = (const float*)(P.ws + OFF_S5L32) + (size_t)li * 32 * 128;
    for (int idx = blockIdx.x * NTHREADS + ltid(); idx < 32 * 16 * 64; idx += gridDim.x * NTHREADS) {
        const int p = idx & 63, b = (idx >> 6) & 15, g = idx >> 10;
        const float lr = l32[g * 128 + 2 * p], lim = l32[g * 128 + 2 * p + 1];
        float xr = 0.f, xi = 0.f;
        for (int ch = 0; ch < 64; ++ch) {
            const size_t o = ((size_t)g * 1024 + b * 64 + ch) * 128 + 2 * p;
            *(unsigned*)(xin + o) = pk2(xr, xi);
            const float2 a = *(const float2*)(xloc + o);
            const float nr = lr * xr - lim * xi + a.x, ni = lr * xi + lim * xr + a.y;
            xr = nr; xi = ni;
        }
    }
}

DI void attn_item(char* lds, const Ctx& P, int b, int h, int qt, float lam, float lam_init, const float* subln) {
    const bfr* qn = (const bfr*)(P.ws + OFF_QN);
    const bfr* kn = (const bfr*)(P.ws + OFF_KN);
    const bfr* vT = (const bfr*)(P.ws + OFF_VT) + (size_t)(b * 4 + h) * 128 * SEQ;
    bfr* am = (bfr*)(P.ws + OFF_AMIX);
    const int tid = ltid(), lane = tid & 63, wave = tid >> 6;
    const int m = wave >> 1, qw = (wave & 1) * 32;
    const int q0 = qt * 64 + qw;
    const int ln = lane & 31, hf = lane >> 5;
    bf16x8 qf[4];
    {
        const bfr* qp = qn + ((size_t)b * SEQ + q0 + ln) * 512 + h * 128 + m * 64 + hf * 8;
#pragma unroll
        for (int ks = 0; ks < 4; ++ks) qf[ks] = *(const bf16x8*)(qp + ks * 16);
    }
    f32x16 o[4];
#pragma unroll
    for (int d = 0; d < 4; ++d)
#pragma unroll
        for (int r = 0; r < 16; ++r) o[d][r] = 0.f;
    float mrun = -INFINITY, lrun = 0.f;
    const int nkt = qt + 1;
    const int lrow = tid >> 3, lcol = (tid & 7) * 8;
    const bfr* kbase = kn + ((size_t)b * SEQ) * 512 + h * 128;
    unsigned ko = (unsigned)(lrow * 512 + lcol) * 2u, vo = (unsigned)(lrow * SEQ + lcol) * 2u;
    asm volatile("" : "+v"(ko), "+v"(vo));
    uint4 rk0, rk1, rk2, rk3, rv0, rv1, rv2, rv3;
#define ATT_GLOAD(kt_) do { const char* kp_ = (const char*)(kbase + (size_t)(kt_) * (64 * 512)); const char* vp_ = (const char*)(vT + (kt_) * 64); \
        rk0 = *(const uint4*)(kp_ + ko); rk1 = *(const uint4*)(kp_ + 32 * 512 * 2 + ko); rk2 = *(const uint4*)(kp_ + 64 * 2 + ko); rk3 = *(const uint4*)(kp_ + 32 * 512 * 2 + 64 * 2 + ko); \
        rv0 = *(const uint4*)(vp_ + vo); rv1 = *(const uint4*)(vp_ + 32 * SEQ * 2 + vo); rv2 = *(const uint4*)(vp_ + 64 * SEQ * 2 + vo); rv3 = *(const uint4*)(vp_ + 96 * SEQ * 2 + vo); } while (0)
#define ATT_S1(base_, i_, RK, RV) { *(uint4*)((base_) + (32 * (i_)) * LDA * 2) = RK; \
        *(uint4*)((base_) + TILE_B + (32 * (i_)) * LDA * 2) = RV; }
#define ATT_LSTORE(buf_) do { char* base_ = lds + (buf_) * (2 * TILE_B) + s_off; ATT_S1(base_, 0, rk0, rv0) ATT_S1(base_, 1, rk1, rv1) ATT_S1(base_, 2, rk2, rv2) ATT_S1(base_, 3, rk3, rv3) } while (0)
    int k_off = ((m * 64 + ln) * LDA + hf * 8) * 2;
    int v_off = TILE_B + (ln * LDA + 4 * hf) * 2;
    int s_off = (lrow * LDA + lcol) * 2;
    asm volatile("" : "+v"(k_off), "+v"(v_off), "+v"(s_off));
    ATT_GLOAD(0); ATT_LSTORE(0);
    __syncthreads();
    int buf = 0;
    for (int kt = 0; kt < nkt; ++kt) {
        const bool more = (kt + 1 < nkt);
        const char* ks_ = lds + buf * (2 * TILE_B) + k_off;
        const char* vs_ = lds + buf * (2 * TILE_B) + v_off;
        if (kt * 64 <= q0 + 31) {
            f32x16 s[2];
#pragma unroll
            for (int kb = 0; kb < 2; ++kb) {
#pragma unroll
                for (int r = 0; r < 16; ++r) s[kb][r] = 0.f;
#pragma unroll
                for (int ks = 0; ks < 4; ++ks) {
                    const bf16x8 kf = *(const bf16x8*)(ks_ + ((kb * 32) * LDA + ks * 16) * 2);
                    s[kb] = MFMA32(kf, qf[ks], s[kb]);
                }
            }
            const int qpos = q0 + ln;
            if (kt * 64 + 63 > q0) {
#pragma unroll
                for (int kb = 0; kb < 2; ++kb)
#pragma unroll
                    for (int r = 0; r < 16; ++r) {
                        const int key = kt * 64 + kb * 32 + (r & 3) + 8 * (r >> 2) + 4 * hf;
                        if (key > qpos) s[kb][r] = -INFINITY;
                    }
            }
            float mx = s[0][0];
#pragma unroll
            for (int kb = 0; kb < 2; ++kb)
#pragma unroll
                for (int r = 0; r < 16; ++r) mx = fmaxf(mx, s[kb][r]);
            mx = fmaxf(mx, __shfl_xor(mx, 32));
            const float mnew = fmaxf(mrun, mx);
            const float alpha = __builtin_amdgcn_exp2f(mrun - mnew);
            mrun = mnew;
            float rsum = 0.f;
#pragma unroll
            for (int kb = 0; kb < 2; ++kb)
#pragma unroll
                for (int r = 0; r < 16; ++r) { const float p = __builtin_amdgcn_exp2f(s[kb][r] - mnew); s[kb][r] = p; rsum += p; }
            lrun = lrun * alpha + rsum;
#pragma unroll
            for (int d = 0; d < 4; ++d)
#pragma unroll
                for (int r = 0; r < 16; ++r) o[d][r] *= alpha;
            __builtin_amdgcn_sched_barrier(0);
            if (more) ATT_GLOAD(kt + 1);
#pragma unroll
            for (int kb = 0; kb < 2; ++kb)
#pragma unroll
                for (int st = 0; st < 2; ++st) {
                    const uint4 pp = make_uint4(pk2(s[kb][8 * st + 0], s[kb][8 * st + 1]), pk2(s[kb][8 * st + 2], s[kb][8 * st + 3]),
                                                pk2(s[kb][8 * st + 4], s[kb][8 * st + 5]), pk2(s[kb][8 * st + 6], s[kb][8 * st + 7]));
                    const bf16x8 pf = __builtin_bit_cast(bf16x8, pp);
                    const int kc = kb * 32 + 16 * st;
#pragma unroll
                    for (int d = 0; d < 4; ++d) {
                        const uint2 v0 = *(const uint2*)(vs_ + ((d * 32) * LDA + kc) * 2);
                        const uint2 v1 = *(const uint2*)(vs_ + ((d * 32) * LDA + kc + 8) * 2);
                        const bf16x8 vf = __builtin_bit_cast(bf16x8, make_uint4(v0.x, v0.y, v1.x, v1.y));
                        o[d] = MFMA32(vf, pf, o[d]);
                    }
                }
        }
        else if (more) ATT_GLOAD(kt + 1);
        if (more) ATT_LSTORE(buf ^ 1);
        __syncthreads();
        buf ^= 1;
    }
    const float ltot = lrun + __shfl_xor(lrun, 32);
    const float linv = 1.0f / ltot;
    float* ob = (float*)lds;
    int o_off = (m * 64 + qw + ln) * 129 + 4 * hf;
    asm volatile("" : "+v"(o_off));
#pragma unroll
    for (int d = 0; d < 4; ++d)
#pragma unroll
        for (int r = 0; r < 16; ++r) ob[o_off + d * 32 + (r & 3) + 8 * (r >> 2)] = o[d][r] * linv;
    __syncthreads();
#pragma unroll
    for (int it = 0; it < 4; ++it) {
        const int idx = it * NTHREADS + tid;
        const int q = idx >> 4, c0 = (idx & 15) * 8;
        float v[8];
        float ss = 0.f;
        int r_off = q * 129 + c0;
        asm volatile("" : "+v"(r_off));
#pragma unroll
        for (int j = 0; j < 8; ++j) { v[j] = ob[r_off + j] - lam * ob[r_off + 64 * 129 + j]; ss += v[j] * v[j]; }
        ss = row16_sum(ss);
        const float rs = rsqrtf(ss * (1.0f / 128.0f) + 1e-5f) * (1.0f - lam_init);
#pragma unroll
        for (int j = 0; j < 8; ++j) v[j] = v[j] * rs * subln[c0 + j];
        *(uint4*)(am + ((size_t)b * SEQ + qt * 64 + q) * 1024 + h * 128 + c0) = pack8(v);
    }
    __syncthreads();
}

DI void phase_o3(char* lds, const Ctx& P, int li, int layer) {
    s5_scan(P, li);
    float lam;
    {
        const int j = ltid() & 63;
        const float s1 = wave_sum(P.in[I_LQ1][li * 64 + j] * P.in[I_LK1][li * 64 + j]);
        const float s2 = wave_sum(P.in[I_LQ2][li * 64 + j] * P.in[I_LK2][li * 64 + j]);
        const float lam_init0 = 0.8f - 0.6f * __expf(-0.3f * (float)layer);
        lam = __expf(s1) - __expf(s2) + lam_init0;
    }
    const float lam_init = 0.8f - 0.6f * __expf(-0.3f * (float)layer);
    const float* subln = P.in[I_SUBLN] + li * 128;
    for (int item = blockIdx.x; item < 1024; item += gridDim.x) {
        const int bh = item >> 4, pr = item & 15;
        for (int half = 0; half < 2; ++half) attn_item(lds, P, bh >> 2, bh & 3, half ? 31 - pr : pr, lam, lam_init, subln);
    }
}

DI void phase_o4(char* lds, const Ctx& P, int li) {
    const bfr* us5 = (const bfr*)(P.ws + OFF_US5);
    const bfr* xin = (const bfr*)(P.ws + OFF_XIN);
    const bfr* gt = (const bfr*)(P.ws + OFF_S5GT) + (size_t)li * 32 * 512 * 640;
    const float* dsk = P.in[I_S5D] + li * 512;
    bfr* zb = (bfr*)(P.ws + OFF_ZBUF);
    for (int t = blockIdx.x; t < 1024; t += gridDim.x) {
        const int g = t >> 5, mt = (t >> 2) & 7, nt = t & 3;
        const int nloc = 2 * (nt + 1);
        const bfr* ag = us5 + (size_t)g * NTOK * 16;
        const bfr* xg = xin + (size_t)g * 1024 * 128;
        const int tq = ltid();
        const int arow = mt * 128 + (tq >> 3), acol = (tq & 7) * 8;
        auto aptr = [&](int i, int kt) __attribute__((always_inline)) -> const bfr* {
            return (kt < nloc) ? ag + (size_t)(arow + 32 * i) * 512 + kt * 64 + acol
                               : xg + (size_t)(arow + 32 * i) * 128 + (kt - nloc) * 64 + acol;
        };
        const bfr* bg = gt + (size_t)g * 512 * 640 + (size_t)(nt * 128 + (tq >> 3)) * 640 + acol;
        auto bptr = [&](int i, int kt) __attribute__((always_inline)) -> const bfr* {
            return bg + (size_t)(32 * i) * 640 + ((kt < nloc) ? kt : (8 + kt - nloc)) * 64;
        };
        gemm_tile(lds, nloc + 2, aptr, bptr, [&](const float* stg) __attribute__((always_inline)) {
            epi_rows8(stg, [&](int r, int c0, const float (&v)[8]) __attribute__((always_inline)) {
                const int cb = mt * 128 + r;
                const int n = nt * 128 + c0, tt = n >> 4, c1 = n & 15;
                const size_t tok = (size_t)cb * 32 + tt;
                float uu[8], z[8];
                unpack8(*(const uint4*)(ag + tok * 16 + c1), uu);
#pragma unroll
                for (int j = 0; j < 8; ++j) {
                    const float y = v[j] + dsk[g * 16 + c1 + j] * uu[j];
                    const float inner = 0.7978845608028654f * (y + 0.044715f * y * y * y);
                    z[j] = 0.5f * y * (1.0f + tanhf(inner));
                }
                *(uint4*)(zb + tok * 512 + g * 16 + c1) = pack8(z);
            });
        });
    }
}

DI void phase_o5(char* lds, const Ctx& P, int li) {
    const bfr* zb = (const bfr*)(P.ws + OFF_ZBUF);
    const bfr* w = (const bfr*)(P.ws + OFF_GLUT) + (size_t)li * 512 * 512;
    bfr* am = (bfr*)(P.ws + OFF_AMIX);
    for (int t = blockIdx.x; t < 1024; t += gridDim.x) {
        const int mt = t >> 2, nt = t & 3;
        RowLoader A(zb, mt * 128, 512), B(w, nt * 128, 512);
        gemm_tile(lds, 8, A, B, [&](const float* stg) __attribute__((always_inline)) {
            epi_rows8(stg, [&](int r, int c0, const float (&v)[8]) __attribute__((always_inline)) {
                float zz[8], o[8];
                unpack8(*(const uint4*)(zb + (size_t)(mt * 128 + r) * 512 + nt * 128 + c0), zz);
#pragma unroll
                for (int j = 0; j < 8; ++j) o[j] = zz[j] * sigmoidf_(v[j]);
                *(uint4*)(am + (size_t)(mt * 128 + r) * 1024 + 512 + nt * 128 + c0) = pack8(o);
            });
        });
    }
}
DI void phase_router(char* lds, const Ctx& P, int layer) {
    const float* x = P.out;
    bfr* hb = (bfr*)(P.ws + OFF_HB);
    bfr* hlo = (bfr*)(P.ws + OFF_HLO);
    const bfr* rhi = (const bfr*)(P.ws + OFF_RHI) + (size_t)layer * 128 * 1024;
    const bfr* rlo = (const bfr*)(P.ws + OFF_RLO) + (size_t)layer * 128 * 1024;
    int* gcnt = (int*)(P.ws + OFF_CNT) + layer * 64;
    int* stok = (int*)(P.ws + OFF_TOK);
    float* sgate = (float*)(P.ws + OFF_GATE);
    int* lcnt = (int*)(lds + LDS_AUX);
    int* lbase = lcnt + 64;
    const float* bg = P.in[I_MBG] + layer * 4;
    const float* be = P.in[I_MBE] + layer * 32;
    const int tid = ltid();
    for (int u = blockIdx.x; u < 256; u += gridDim.x) {
        const int m0 = u * 128;
        norm_rows(x, P.in[I_NFFN] + (size_t)layer * DM, hb, hlo, nullptr, m0, 128);
        __syncthreads();
        const size_t roff = (size_t)(m0 + (tid >> 3)) * 1024 + (tid & 7) * 8;
        const size_t boff = (size_t)(tid >> 3) * 1024 + (tid & 7) * 8;
        auto aptr = [&](int i, int kt) __attribute__((always_inline)) -> const bfr* { return (kt < 32 ? hb : hlo) + roff + (size_t)(32 * i) * 1024 + (kt & 15) * 64; };
        auto bptr = [&](int i, int kt) __attribute__((always_inline)) -> const bfr* { return ((kt >= 16 && kt < 32) ? rlo : rhi) + boff + (size_t)(32 * i) * 1024 + (kt & 15) * 64; };
        gemm_tile(lds, 48, aptr, bptr, [&](const float* stg) __attribute__((always_inline)) {
            if (tid < 64) lcnt[tid] = 0;
            __syncthreads();
            int seg0 = 0, seg1 = 0, p0 = 0, p1 = 0;
            float g0 = 0.f, g1 = 0.f;
            if (tid < 128) {
                const float* row = stg + tid * STG_LD;
                float gl[4];
#pragma unroll
                for (int j = 0; j < 4; ++j) gl[j] = row[32 + j] + bg[j];
                int gt = 0; float gm = gl[0];
#pragma unroll
                for (int j = 1; j < 4; ++j) if (gl[j] > gm) { gm = gl[j]; gt = j; }
                float gs = 0.f;
#pragma unroll
                for (int j = 0; j < 4; ++j) gs += __expf(gl[j] - gm);
                const float gw = 1.0f / gs;
                float l1 = -INFINITY, l2 = -INFINITY; int j1 = 0, j2 = 0;
                for (int j = 0; j < 8; ++j) {
                    const float v = row[gt * 8 + j] + be[gt * 8 + j];
                    if (v > l1) { l2 = l1; j2 = j1; l1 = v; j1 = j; }
                    else if (v > l2) { l2 = v; j2 = j; }
                }
                const float w1 = 1.0f / (1.0f + __expf(l2 - l1));
                g0 = gw * w1; g1 = gw * (1.0f - w1);
                seg0 = gt * 8 + j1; seg1 = 32 + gt * 8 + j2;
                p0 = atomicAdd(&lcnt[seg0], 1);
                p1 = atomicAdd(&lcnt[seg1], 1);
            }
            __syncthreads();
            if (tid < 64) { const int c = lcnt[tid]; lbase[tid] = c ? atomicAdd(&gcnt[tid], c) : 0; }
            __syncthreads();
            if (tid < 128) {
                const int q0 = lbase[seg0] + p0, q1 = lbase[seg1] + p1;
                stok[(size_t)seg0 * NTOK + q0] = m0 + tid; sgate[(size_t)seg0 * NTOK + q0] = g0;
                stok[(size_t)seg1 * NTOK + q1] = m0 + tid; sgate[(size_t)seg1 * NTOK + q1] = g1;
            }
        });
    }
}

DI void moe_tables(char* lds, const Ctx& P, int layer) {
    int* cnt = (int*)(lds + LDS_AUX); int* rb0 = cnt + 64; int* hoff = rb0 + 65;
    const int* gcnt = (const int*)(P.ws + OFF_CNT) + layer * 64;
    const int tid = ltid();
    if (tid < 64) cnt[tid] = gcnt[tid];
    __syncthreads();
    if (tid == 0) {
        int acc = 0;
        for (int s = 0; s < 64; ++s) { rb0[s] = acc; hoff[s] = acc * 128; acc += (cnt[s] + 127) >> 7; }
        rb0[64] = acc;
    }
    __syncthreads();
}
DI int moe_find_seg(const int* rb0, int rbi) { int s = 0; while (rb0[s + 1] <= rbi) ++s; return s; }

DI void phase_moe_up(char* lds, const Ctx& P, int layer) {
    moe_tables(lds, P, layer);
    const int* cnt = (const int*)(lds + LDS_AUX); const int* rb0 = cnt + 64; const int* hoff = rb0 + 65;
    const bfr* hb = (const bfr*)(P.ws + OFF_HB);
    const bfr* wgu = (const bfr*)(P.ws + OFF_MWGU);
    const int* stok = (const int*)(P.ws + OFF_TOK);
    bfr* hid = (bfr*)(P.ws + OFF_HID);
    const int ntiles = rb0[64] * 8;
    for (int t = blockIdx.x; t < ntiles; t += gridDim.x) {
        const int rbi = t >> 3, nt = t & 7;
        const int seg = moe_find_seg(rb0, rbi);
        const int rb = rbi - rb0[seg], e = seg & 31, c = cnt[seg];
        const bfr* ap[4];
        const int tq = ltid();
#pragma unroll
        for (int i = 0; i < 4; ++i) {
            int p = rb * 128 + (tq >> 3) + 32 * i; p = p < c ? p : c - 1;
            ap[i] = hb + (size_t)stok[(size_t)seg * NTOK + p] * 1024 + (tq & 7) * 8;
        }
        auto aptr = [&](int i, int kt) __attribute__((always_inline)) -> const bfr* { return ap[i] + kt * 64; };
        RowLoader B(wgu + (size_t)e * 1024 * 1024, nt * 128, 1024);
        const size_t hrow0 = (size_t)hoff[seg] + rb * 128;
        gemm_tile(lds, 16, aptr, B, [&](const float* stg) __attribute__((always_inline)) {
            epi_rows8(stg, [&](int r, int c0, const float (&v)[8]) __attribute__((always_inline)) {
                float o[4];
#pragma unroll
                for (int j = 0; j < 4; ++j) o[j] = v[j] * sigmoidf_(v[j]) * v[4 + j];
                *(uint2*)(hid + (hrow0 + r) * 512 + ((nt * 128 + c0) >> 1)) = make_uint2(pk2(o[0], o[1]), pk2(o[2], o[3]));
            });
        });
    }
}

DI void phase_moe_down(char* lds, const Ctx& P, int layer, int k) {
    moe_tables(lds, P, layer);
    const int* cnt = (const int*)(lds + LDS_AUX); const int* rb0 = cnt + 64; const int* hoff = rb0 + 65;
    const bfr* hid = (const bfr*)(P.ws + OFF_HID);
    const bfr* wd = (const bfr*)(P.ws + OFF_MWD);
    const int* stok = (const int*)(P.ws + OFF_TOK);
    const float* sgate = (const float*)(P.ws + OFF_GATE);
    float* x = P.out;
    const int rbA = rb0[k * 32], rbB = rb0[k * 32 + 32];
    const int ntiles = (rbB - rbA) * 8;
    for (int t = blockIdx.x; t < ntiles; t += gridDim.x) {
        const int rbi = rbA + (t >> 3), nt = t & 7;
        const int seg = moe_find_seg(rb0, rbi);
        const int rb = rbi - rb0[seg], e = seg & 31, c = cnt[seg];
        RowLoader A(hid, hoff[seg] + rb * 128, 512), B(wd + (size_t)e * 1024 * 512, nt * 128, 512);
        gemm_tile(lds, 8, A, B, [&](const float* stg) __attribute__((always_inline)) {
            epi_rows8(stg, [&](int r, int c0, const float (&v)[8]) __attribute__((always_inline)) {
                const int p = rb * 128 + r;
                if (p < c) {
                    const int tok = stok[(size_t)seg * NTOK + p];
                    const float gt = sgate[(size_t)seg * NTOK + p];
                    float* d = x + (size_t)tok * DM + nt * 128 + c0;
                    float4 a = *(float4*)d, b = *(float4*)(d + 4);
                    a.x += gt * v[0]; a.y += gt * v[1]; a.z += gt * v[2]; a.w += gt * v[3];
                    b.x += gt * v[4]; b.y += gt * v[5]; b.z += gt * v[6]; b.w += gt * v[7];
                    *(float4*)d = a; *(float4*)(d + 4) = b;
                }
            });
        });
    }
}
constexpr int PH_PER_LAYER = 11;
constexpr int N_PHASES = 1 + 4 * PH_PER_LAYER;

DI void phase_prologue(char* lds, const Ctx& P) {
    for (int u = blockIdx.x; u < 64; u += gridDim.x) s5_tables(lds, P, u >> 5, u & 31);
    unsigned base = 0;
    const int wk = blockIdx.x, nw = gridDim.x;
    for (int i = 0; i < 2; ++i) {
        cvt_matrix(lds, P.in[I_EWIN] + (size_t)i * 1024 * 2304, 1024, 2304, (bfr*)(P.ws + OFF_WINE) + (size_t)i * 2304 * 1024, 1024, 0, wk, nw, base);
        cvt_matrix(lds, P.in[I_EWOUT] + (size_t)i * 1024 * 1024, 1024, 1024, (bfr*)(P.ws + OFF_WOUTE) + (size_t)i * 1024 * 1024, 1024, 0, wk, nw, base);
        cvt_matrix(lds, P.in[I_OWIN] + (size_t)i * 1024 * 2048, 1024, 2048, (bfr*)(P.ws + OFF_WINO) + (size_t)i * 2048 * 1024, 1024, 0, wk, nw, base);
        cvt_matrix(lds, P.in[I_OWOUT] + (size_t)i * 1024 * 1024, 1024, 1024, (bfr*)(P.ws + OFF_WOUTO) + (size_t)i * 1024 * 1024, 1024, 0, wk, nw, base);
        cvt_matrix(lds, P.in[I_W2] + (size_t)i * 64 * 512, 64, 512, (bfr*)(P.ws + OFF_W2T) + (size_t)i * 512 * 64, 64, 0, wk, nw, base);
        cvt_matrix(lds, P.in[I_A2] + (size_t)i * 64 * 512, 64, 512, (bfr*)(P.ws + OFF_A2T) + (size_t)i * 512 * 64, 64, 0, wk, nw, base);
        cvt_matrix(lds, P.in[I_G2] + (size_t)i * 128 * 512, 128, 512, (bfr*)(P.ws + OFF_G2T) + (size_t)i * 512 * 128, 128, 0, wk, nw, base);
        for (int g = 0; g < 4; ++g)
            cvt_matrix(lds, P.in[I_POOLW] + (size_t)(i * 4 + g) * 128 * 128, 128, 128, (bfr*)(P.ws + OFF_POOLT) + (size_t)(i * 4 + g) * 128 * 128, 128, 0, wk, nw, base);
        cvt_matrix(lds, P.in[I_WGLU] + (size_t)i * 512 * 512, 512, 512, (bfr*)(P.ws + OFF_GLUT) + (size_t)i * 512 * 512, 512, 0, wk, nw, base);
    }
    const int gtid = blockIdx.x * NTHREADS + ltid(), gsz = gridDim.x * NTHREADS;
    {
        bfr* rhi = (bfr*)(P.ws + OFF_RHI); bfr* rlo = (bfr*)(P.ws + OFF_RLO);
        for (int idx = gtid; idx < 4 * 128 * 1024; idx += gsz) {
            const int k = idx & 1023, n = (idx >> 10) & 127, l = idx >> 17;
            float w = 0.f;
            if (n < 32) w = P.in[I_MWE][((size_t)l * 1024 + k) * 32 + n];
            else if (n < 36) w = P.in[I_MWG][((size_t)l * 1024 + k) * 4 + (n - 32)];
            const bfr h = f2bf(w);
            rhi[idx] = h; rlo[idx] = f2bf(w - bf2f(h));
        }
    }
    {
        bfr* v12 = (bfr*)(P.ws + OFF_V12T);
        const float* v1 = P.in[I_V1]; const float* v2 = P.in[I_V2];
        for (int idx = gtid; idx < 512 * 512; idx += gsz) {
            const int k = idx & 511, n = idx >> 9;
            float s = 0.f;
            for (int r = 0; r < 32; ++r) s += v1[k * 32 + r] * v2[r * 512 + n];
            v12[idx] = f2bf(s);
        }
    }
    for (int tt = blockIdx.x; tt < 512; tt += gridDim.x)
        norm_rows(P.in[I_X], P.in[I_NMIX], (bfr*)(P.ws + OFF_HB), nullptr, P.out, tt * 64, 64);
}

DI Ctx mkctx(unsigned char* ws, float* out) {
    size_t z = 0;
    asm volatile("" : "+s"(z));
    Ctx c;
    c.in.p = (KArgPtr)__builtin_amdgcn_kernarg_segment_ptr() + z;
    c.ws = ws + z; c.out = (float*)((char*)out + z);
    return c;
}
__global__ void __launch_bounds__(NTHREADS, 2) fwd_kernel(Params PA) {
    extern __shared__ __attribute__((aligned(16))) char lds[];
    if (threadIdx.x == 0) *(uint4*)(lds + LDS_BYTES - 16) = make_uint4(0u, 0u, 0u, 0u);
    __syncthreads();
    XcdBarrier bar = xcd_barrier_post((unsigned*)(PA.ws + OFF_BAR), (volatile LAS unsigned*)(lds + LDS_BYTES - 16));
    const int lo = PA.ph_lo, hi = PA.ph_hi;
#define RUNS(id) ((id) >= lo && (id) < hi)
#define P mkctx(PA.ws, PA.out)
#define SEAM(id) do { if ((id) > lo && (id) < hi) xcd_barrier(bar); } while (0)
    if (RUNS(0)) phase_prologue(lds, P);
    for (int layer = 0; layer < 4; ++layer) {
        const int base = 1 + layer * PH_PER_LAYER;
        const int li = layer >> 1;
        if ((layer & 1) == 0) {
            SEAM(base + 0); if (RUNS(base + 0)) phase_e1(lds, P, li);
            SEAM(base + 1); if (RUNS(base + 1)) phase_e2a(P, li);
            SEAM(base + 2); if (RUNS(base + 2)) phase_e2b(lds, P, li);
            SEAM(base + 3); if (RUNS(base + 3)) phase_e3(lds, P, li);
            SEAM(base + 4); if (RUNS(base + 4)) phase_e4(P, li);
            SEAM(base + 5); if (RUNS(base + 5)) phase_wout(lds, P, (const bfr*)(P.ws + OFF_WOUTE) + (size_t)li * 1024 * 1024);
        } else {
            SEAM(base + 0); if (RUNS(base + 0)) phase_o1(lds, P, li);
            SEAM(base + 1); if (RUNS(base + 1)) phase_o2(lds, P, li);
            SEAM(base + 2); if (RUNS(base + 2)) phase_o3(lds, P, li, layer);
            SEAM(base + 3); if (RUNS(base + 3)) phase_o4(lds, P, li);
            SEAM(base + 4); if (RUNS(base + 4)) phase_o5(lds, P, li);
            SEAM(base + 5); if (RUNS(base + 5)) phase_wout(lds, P, (const bfr*)(P.ws + OFF_WOUTO) + (size_t)li * 1024 * 1024);
        }
        SEAM(base + 6);
        if (RUNS(base + 6)) {
            phase_router(lds, P, layer);
            const bool split = gridDim.x >= 512;
            moe_convert(lds, P, layer, split ? (int)blockIdx.x - 256 : (int)blockIdx.x, split ? (int)gridDim.x - 256 : (int)gridDim.x);
        }
        SEAM(base + 7); if (RUNS(base + 7)) phase_moe_up(lds, P, layer);
        SEAM(base + 8); if (RUNS(base + 8)) phase_moe_down(lds, P, layer, 0);
        SEAM(base + 9); if (RUNS(base + 9)) phase_moe_down(lds, P, layer, 1);
        SEAM(base + 10);
        if (RUNS(base + 10) && layer < 3) {
            for (int tt = blockIdx.x; tt < 512; tt += gridDim.x)
                norm_rows(P.out, P.in[I_NMIX] + (size_t)(layer + 1) * DM, (bfr*)(P.ws + OFF_HB), nullptr, nullptr, tt * 64, 64);
        }
    }
#undef P
#undef RUNS
#undef SEAM
}

#ifndef N_LAUNCH_SPLIT
#define N_LAUNCH_SPLIT 0
#endif
extern "C" void kernel_launch(void* const* d_in, const int* in_sizes, int n_in, void* d_out, int out_size, void* d_ws, size_t ws_size, hipStream_t stream) {
    static int grid = 0;
    if (grid == 0) {
        if (n_in != N_INPUTS || out_size != NTOK * DM || ws_size < WS_NEEDED) {
            fprintf(stderr, "kernel_launch: unexpected shapes: n_in %d out %d ws %zu (need %zu)\n", n_in, out_size, ws_size, (size_t)WS_NEEDED);
            grid = -1; return;
        }
        int dev = 0, cus = 0, per_cu = 0;
        (void)hipGetDevice(&dev);
        (void)hipDeviceGetAttribute(&cus, hipDeviceAttributeMultiprocessorCount, dev);
        if (hipFuncSetAttribute((const void*)fwd_kernel, hipFuncAttributeMaxDynamicSharedMemorySize, LDS_BYTES) != hipSuccess) { fprintf(stderr, "kernel_launch: hipFuncSetAttribute failed\n"); grid = -1; return; }
        if (hipOccupancyMaxActiveBlocksPerMultiprocessor(&per_cu, (const void*)fwd_kernel, NTHREADS, LDS_BYTES) != hipSuccess) per_cu = 1;
        (void)hipGetLastError();
        if (per_cu < 1) per_cu = 1;
        if (per_cu > 2) per_cu = 2;
        if (cus <= 0) cus = 256;
        grid = cus * per_cu;
    }
    if (grid < 0) return;
    (void)hipMemsetAsync(d_ws, 0, OFF_ZERO_END, stream);
    Params p{};
    for (int i = 0; i < N_INPUTS; ++i) p.in[i] = (const float*)d_in[i];
    p.out = (float*)d_out; p.ws = (unsigned char*)d_ws;
#if N_LAUNCH_SPLIT
    for (int ph = 0; ph < N_PHASES - 1; ++ph) {
        p.ph_lo = ph; p.ph_hi = ph + 1;
        hipLaunchKernelGGL(fwd_kernel, dim3(grid), dim3(NTHREADS), LDS_BYTES, stream, p);
    }
#else
    p.ph_lo = 0; p.ph_hi = N_PHASES;
    hipLaunchKernelGGL(fwd_kernel, dim3(grid), dim3(NTHREADS), LDS_BYTES, stream, p);
#endif
}
```

```cpp
#include <hip/hip_runtime.h>
#include <stdint.h>
#include <stdio.h>

typedef unsigned short bfr;
typedef __attribute__((ext_vector_type(8))) short bf16x8;
typedef __attribute__((ext_vector_type(16))) float f32x16;
typedef __attribute__((ext_vector_type(2))) __bf16 bf16x2_t;
#define DI __device__ __forceinline__
#define MFMA32(a, b, c) __builtin_amdgcn_mfma_f32_32x32x16_bf16((a), (b), (c), 0, 0, 0)

constexpr int NTOK = 32768, DM = 1024, SEQ = 2048, NB = 16;
constexpr int EVEN_IN = 2304, ODD_IN = 2048;
constexpr int NTHREADS = 256;
constexpr int LDS_BYTES = 81920;

enum { I_X = 0, I_NMIX, I_NFFN, I_EWIN, I_MU, I_W0, I_W2, I_A0, I_A2, I_G2, I_KK, I_KA, I_RK, I_LNG, I_LNB, I_V0, I_V1, I_V2,
       I_POOLW, I_POOLS, I_EWOUT, I_OWIN, I_QN, I_KN, I_LQ1, I_LK1, I_LQ2, I_LK2, I_SUBLN, I_ARE, I_AIM, I_LSTEP, I_BRE, I_BIM,
       I_CRE, I_CIM, I_S5D, I_WGLU, I_OWOUT, I_MWG, I_MBG, I_MWE, I_MBE, I_MWGATE, I_MWUP, I_MWDOWN, N_INPUTS };

constexpr size_t al256(size_t x) { return (x + 255) & ~(size_t)255; }
constexpr size_t OFF_BAR   = 0;
constexpr size_t OFF_CNT   = 16384;
constexpr size_t OFF_ZERO_END = 32768;
constexpr size_t OFF_WINE  = 65536;
constexpr size_t OFF_WOUTE = OFF_WINE  + (size_t)2 * 2304 * 1024 * 2;
constexpr size_t OFF_WINO  = OFF_WOUTE + (size_t)2 * 1024 * 1024 * 2;
constexpr size_t OFF_WOUTO = OFF_WINO  + (size_t)2 * 2048 * 1024 * 2;
constexpr size_t OFF_W2T   = OFF_WOUTO + (size_t)2 * 1024 * 1024 * 2;
constexpr size_t OFF_A2T   = OFF_W2T   + (size_t)2 * 512 * 64 * 2;
constexpr size_t OFF_G2T   = OFF_A2T   + (size_t)2 * 512 * 64 * 2;
constexpr size_t OFF_V12T  = OFF_G2T   + (size_t)2 * 512 * 128 * 2;
constexpr size_t OFF_POOLT = OFF_V12T  + (size_t)512 * 512 * 2;
constexpr size_t OFF_GLUT  = OFF_POOLT + (size_t)2 * 4 * 128 * 128 * 2;
constexpr size_t OFF_RHI   = OFF_GLUT  + (size_t)2 * 512 * 512 * 2;
constexpr size_t OFF_RLO   = OFF_RHI   + (size_t)4 * 128 * 1024 * 2;
constexpr size_t OFF_S5GT  = OFF_RLO   + (size_t)4 * 128 * 1024 * 2;
constexpr size_t OFF_S5BL  = OFF_S5GT  + (size_t)2 * 32 * 512 * 640 * 2;
constexpr size_t OFF_S5L32 = OFF_S5BL  + (size_t)2 * 32 * 128 * 512 * 2;
constexpr size_t OFF_MWGU  = al256(OFF_S5L32 + (size_t)2 * 32 * 64 * 2 * 4);
constexpr size_t OFF_MWD   = OFF_MWGU  + (size_t)32 * 1024 * 1024 * 2;
constexpr size_t OFF_HB    = OFF_MWD   + (size_t)32 * 1024 * 512 * 2;
constexpr size_t OFF_U     = OFF_HB    + (size_t)NTOK * 1024 * 2;
constexpr size_t OFF_US5   = OFF_U     + (size_t)NTOK * 1024 * 2;
constexpr size_t OFF_AMIX  = OFF_U     + (size_t)NTOK * 2304 * 2;
constexpr size_t OFF_VFIRST= OFF_AMIX  + (size_t)NTOK * 1024 * 2;
constexpr size_t OFF_TOK   = OFF_VFIRST+ (size_t)NTOK * 512 * 2;
constexpr size_t OFF_GATE  = OFF_TOK   + (size_t)64 * NTOK * 4;
constexpr size_t OFF_HID   = OFF_GATE  + (size_t)64 * NTOK * 4;
constexpr size_t OFF_HLO   = OFF_HID;
constexpr size_t OFF_EV    = OFF_HID   + (size_t)73728 * 512 * 2;
constexpr size_t OFF_S     = OFF_EV;
constexpr size_t OFF_MV2   = OFF_S     + (size_t)NTOK * 256 * 2;
constexpr size_t OFF_DLOG  = OFF_MV2   + (size_t)NTOK * 512 * 2;
constexpr size_t OFF_ABUF  = OFF_DLOG  + (size_t)NTOK * 512 * 4;
constexpr size_t OFF_GBUF  = OFF_ABUF  + (size_t)NTOK * 512 * 2;
constexpr size_t OFF_VGATE = OFF_GBUF  + (size_t)NTOK * 512 * 2;
constexpr size_t OFF_Y     = OFF_VGATE + (size_t)NTOK * 512 * 2;
constexpr size_t OFF_DPOOL = OFF_Y;
constexpr size_t OFF_BONUS = OFF_Y     + (size_t)NTOK * 512 * 4;
constexpr size_t OFF_EV_END= OFF_BONUS + (size_t)NTOK * 512 * 4;
constexpr size_t OFF_QN    = OFF_EV;
constexpr size_t OFF_KN    = OFF_QN    + (size_t)NTOK * 512 * 2;
constexpr size_t OFF_VT    = OFF_KN    + (size_t)NTOK * 512 * 2;
constexpr size_t OFF_XLOC  = OFF_VT    + (size_t)NTOK * 512 * 2;
constexpr size_t OFF_XIN   = OFF_XLOC  + (size_t)32 * 1024 * 128 * 4;
constexpr size_t OFF_ZBUF  = OFF_XIN   + (size_t)32 * 1024 * 128 * 2;
constexpr size_t OFF_OD_END= OFF_ZBUF  + (size_t)NTOK * 512 * 2;
constexpr size_t WS_NEEDED = OFF_EV_END > OFF_OD_END ? OFF_EV_END : OFF_OD_END;

struct Params {
    const float* in[N_INPUTS];
    float* out;
    unsigned char* ws;
    int ph_lo, ph_hi;
};
typedef const __attribute__((address_space(4))) char* KArgPtr;
struct InTab {
    KArgPtr p;
    DI const float* operator[](int i) const {
        const float* q = *(const float* const __attribute__((address_space(4)))*)(p + 8 * i);
        return (const float*)(const __attribute__((address_space(1))) float*)q;
    }
};
struct Ctx { InTab in; unsigned char* ws; float* out; };

DI unsigned pk2(float a, float b) { bf16x2_t v; v[0] = (__bf16)a; v[1] = (__bf16)b; return __builtin_bit_cast(unsigned, v); }
DI bfr f2bf(float a) { return (bfr)(pk2(a, 0.f) & 0xffffu); }
DI float bf2f(bfr b) { return __uint_as_float(((unsigned)b) << 16); }
DI float bflo(unsigned u) { return __uint_as_float(u << 16); }
DI float bfhi(unsigned u) { return __uint_as_float(u & 0xffff0000u); }
DI uint4 pack8(const float (&v)[8]) { return make_uint4(pk2(v[0], v[1]), pk2(v[2], v[3]), pk2(v[4], v[5]), pk2(v[6], v[7])); }
DI void unpack8(uint4 u, float (&v)[8]) { v[0] = bflo(u.x); v[1] = bfhi(u.x); v[2] = bflo(u.y); v[3] = bfhi(u.y); v[4] = bflo(u.z); v[5] = bfhi(u.z); v[6] = bflo(u.w); v[7] = bfhi(u.w); }
DI float frcp(float x) { return __builtin_amdgcn_rcpf(x); }
DI float fexp(float x) { return __builtin_amdgcn_exp2f(x * 1.4426950408889634f); }
DI float sigmoidf_(float x) { return frcp(1.0f + fexp(-x)); }
DI float ftanh(float x) { return 2.0f * frcp(1.0f + fexp(-2.0f * x)) - 1.0f; }
DI float fsoftplus(float z) { return z > 20.0f ? z : __logf(1.0f + fexp(z)); }
template <int CTRL> DI float dpp_f(float x) { return __builtin_bit_cast(float, __builtin_amdgcn_update_dpp(0, __builtin_bit_cast(int, x), CTRL, 0xf, 0xf, false)); }
DI float row16_sum(float s) {
    s += dpp_f<0x128>(s); s += dpp_f<0x124>(s); s += dpp_f<0x122>(s); s += dpp_f<0x121>(s); return s; }
DI int ltid() { int t = threadIdx.x; asm volatile("" : "+v"(t)); return t; }
DI float wave_sum(float s) { s = row16_sum(s); s += __shfl_xor(s, 16); s += __shfl_xor(s, 32); return s; }
#define XB_TMO      128
#define XB_XCNT(j)  (256  + 64 * (j))
#define XB_XSUB(j)  (1280 + 64 * (j))
#define XB_XGEN(j)  (2304 + 64 * (j))
#define XB_TOP      3328
#define XB_TOPGEN   3392
#define XCD_BAR_WORDS 3456
#define XB_SPIN_CAP (1u << 18)
#define LAS __attribute__((address_space(3)))

__device__ __forceinline__ unsigned xb_ld(unsigned* p)              { return __hip_atomic_load(p, __ATOMIC_RELAXED, __HIP_MEMORY_SCOPE_AGENT); }
__device__ __forceinline__ unsigned xb_add(unsigned* p, unsigned v) { return __hip_atomic_fetch_add(p, v, __ATOMIC_RELAXED, __HIP_MEMORY_SCOPE_AGENT); }
__device__ __forceinline__ unsigned xb_xcc_id() { return (unsigned)__builtin_amdgcn_s_getreg((3 << 11) | 20) & 0xFu; }
#define XB_SPIN(cond, bar) do { unsigned _sp = 0; while (cond) { __builtin_amdgcn_s_sleep(1); \
    if ((++_sp & 255u) == 0u) { if (xb_ld(&(bar)[XB_TMO])) break; if (_sp > XB_SPIN_CAP) { atomicAdd(&(bar)[XB_TMO], 1u); break; } } } } while (0)

struct XcdBarrier {
    unsigned* bar; unsigned x;
    volatile LAS unsigned* st;
};
__device__ __forceinline__ XcdBarrier xcd_barrier_post(unsigned* bar, volatile LAS unsigned* st) {
    XcdBarrier b; b.bar = bar; b.x = xb_xcc_id(); b.st = st;
    if (threadIdx.x == 0) (void)xb_add(&bar[XB_XCNT(b.x)], 1u);
    return b;
}
__device__ __forceinline__ void xcd_barrier_complete(unsigned* bar, unsigned x, unsigned& nloc, unsigned& nx) {
    const unsigned G = gridDim.x * gridDim.y * gridDim.z;
    unsigned sum, cnt, mine, sp = 0u;
    for (;;) {
        sum = 0u; cnt = 0u; mine = 0u;
#pragma unroll
        for (unsigned j = 0; j < 16; ++j) { const unsigned c = xb_ld(&bar[XB_XCNT(j)]); sum += c; cnt += (c > 0u) ? 1u : 0u; mine = (j == x) ? c : mine; }
        if (sum == G) break;
        __builtin_amdgcn_s_sleep(1);
        if ((++sp & 255u) == 0u) { if (xb_ld(&bar[XB_TMO])) break; if (sp > XB_SPIN_CAP) { atomicAdd(&bar[XB_TMO], 1u); break; } }
    }
    nloc = mine > 0u ? mine : 1u; nx = cnt > 0u ? cnt : 1u;
}
__device__ __forceinline__ void xcd_barrier(const XcdBarrier& b) {
    asm volatile("s_waitcnt vmcnt(0)" ::: "memory");
    __syncthreads();
    if (threadIdx.x == 0) {
        unsigned* bar = b.bar;
        __builtin_amdgcn_s_waitcnt(0);
        unsigned nloc = b.st[0], nx = b.st[1];
        if (nloc == 0u) { xcd_barrier_complete(bar, b.x, nloc, nx); b.st[0] = nloc; b.st[1] = nx; }
        const unsigned old = xb_add(&bar[XB_XSUB(b.x)], 1u);
        const unsigned gen = old / nloc;
        if (old + 1u == (gen + 1u) * nloc) {
            __builtin_amdgcn_fence(__ATOMIC_RELEASE, "agent");
            asm volatile("s_waitcnt vmcnt(0)" ::: "memory");
            const unsigned og = xb_add(&bar[XB_TOP], 1u);
            const unsigned tg = og / nx;
            if (og + 1u == (tg + 1u) * nx) xb_add(&bar[XB_TOPGEN], 1u);
            else XB_SPIN(xb_ld(&bar[XB_TOPGEN]) == tg, bar);
            __builtin_amdgcn_fence(__ATOMIC_ACQUIRE, "agent");
            xb_add(&bar[XB_XGEN(b.x)], 1u);
            asm volatile("s_waitcnt vmcnt(0)" ::: "memory");
        } else {
            XB_SPIN(xb_ld(&bar[XB_XGEN(b.x)]) == gen, bar);
            __builtin_amdgcn_fence(__ATOMIC_ACQUIRE, "agent");
            asm volatile("s_waitcnt vmcnt(0)" ::: "memory");
        }
    }
    __syncthreads();
}

constexpr int LDA = 72;
constexpr int TILE_B = 128 * LDA * 2;
constexpr int STG_LD = 132;
constexpr int LDS_AUX = 73728;

template <class AF, class BF, class EF>
DI void gemm_tile(char* lds, int nk, AF aptr, BF bptr, EF epi) {
    const int tid = ltid(), lane = tid & 63, wave = tid >> 6;
    const int wr = wave >> 1, wc = wave & 1;
    f32x16 acc00, acc01, acc10, acc11;
#pragma unroll
    for (int r = 0; r < 16; ++r) { acc00[r] = 0.f; acc01[r] = 0.f; acc10[r] = 0.f; acc11[r] = 0.f; }
    uint4 ra0, ra1, ra2, ra3, rb0, rb1, rb2, rb3;
#define GT_LOAD(kt_) do { ra0 = *(const uint4*)aptr(0, kt_); rb0 = *(const uint4*)bptr(0, kt_); ra1 = *(const uint4*)aptr(1, kt_); rb1 = *(const uint4*)bptr(1, kt_); \
                          ra2 = *(const uint4*)aptr(2, kt_); rb2 = *(const uint4*)bptr(2, kt_); ra3 = *(const uint4*)aptr(3, kt_); rb3 = *(const uint4*)bptr(3, kt_); } while (0)
#define GT_STORE(base_) do { char* sb_ = (base_) + st_off; \
        *(uint4*)(sb_) = ra0; *(uint4*)(sb_ + TILE_B) = rb0; *(uint4*)(sb_ + 32 * LDA * 2) = ra1; *(uint4*)(sb_ + TILE_B + 32 * LDA * 2) = rb1; \
        *(uint4*)(sb_ + 64 * LDA * 2) = ra2; *(uint4*)(sb_ + TILE_B + 64 * LDA * 2) = rb2; *(uint4*)(sb_ + 96 * LDA * 2) = ra3; *(uint4*)(sb_ + TILE_B + 96 * LDA * 2) = rb3; } while (0)
#define GT_COMPUTE(base_) do { const char* cb_ = (base_); _Pragma("unroll") for (int ks = 0; ks < 4; ++ks) { \
            const bf16x8 a0 = *(const bf16x8*)(cb_ + a_off + ks * 32); \
            const bf16x8 a1 = *(const bf16x8*)(cb_ + a_off + ks * 32 + 32 * LDA * 2); \
            const bf16x8 b0 = *(const bf16x8*)(cb_ + b_off + ks * 32); \
            const bf16x8 b1 = *(const bf16x8*)(cb_ + b_off + ks * 32 + 32 * LDA * 2); \
            acc00 = MFMA32(a0, b0, acc00); acc01 = MFMA32(a0, b1, acc01); acc10 = MFMA32(a1, b0, acc10); acc11 = MFMA32(a1, b1, acc11); } } while (0)
    int st_off = ((tid >> 3) * LDA + (tid & 7) * 8) * 2;
    int a_off = ((wr * 64 + (lane & 31)) * LDA + (lane >> 5) * 8) * 2;
    int b_off = TILE_B + ((wc * 64 + (lane & 31)) * LDA + (lane >> 5) * 8) * 2;
    asm volatile("" : "+v"(st_off), "+v"(a_off), "+v"(b_off));
    GT_LOAD(0);
    GT_STORE(lds);
    __syncthreads();
    int buf = 0;
#pragma unroll 1
    for (int kt = 0; kt < nk - 1; ++kt) {
        GT_LOAD(kt + 1);
        GT_COMPUTE(lds + buf * (2 * TILE_B));
        GT_STORE(lds + (buf ^ 1) * (2 * TILE_B));
        __syncthreads();
        buf ^= 1;
    }
    GT_COMPUTE(lds + buf * (2 * TILE_B));
    __syncthreads();
#undef GT_LOAD
#undef GT_STORE
#undef GT_COMPUTE
    float* stg = (float*)lds;
    int w_off = (wr * 64 + 4 * (lane >> 5)) * STG_LD + wc * 64 + (lane & 31);
    asm volatile("" : "+v"(w_off));
#pragma unroll
    for (int r = 0; r < 16; ++r) {
        const int ro = ((r & 3) + 8 * (r >> 2)) * STG_LD;
        stg[w_off + ro] = acc00[r];
        stg[w_off + ro + 32] = acc01[r];
        stg[w_off + ro + 32 * STG_LD] = acc10[r];
        stg[w_off + ro + 32 * STG_LD + 32] = acc11[r];
    }
    __syncthreads();
    epi((const float*)stg);
    __syncthreads();
}
template <class F> DI void epi_rows8(const float* stg, F f) {
    const int tid0 = ltid();
#pragma unroll
    for (int it = 0; it < 8; ++it) {
        const int idx = it * NTHREADS + tid0;
        const int r = idx >> 4, c0 = (idx & 15) * 8;
        const float4 p = *(const float4*)(stg + r * STG_LD + c0);
        const float4 q = *(const float4*)(stg + r * STG_LD + c0 + 4);
        const float v[8] = {p.x, p.y, p.z, p.w, q.x, q.y, q.z, q.w};
        f(r, c0, v);
    }
}
template <class T, class L, class F> DI void epi_rows8_pre(const float* stg, L loadf, F f) {
    const int tid0 = ltid();
    T pre[8];
#pragma unroll
    for (int it = 0; it < 8; ++it) { const int idx = it * NTHREADS + tid0; pre[it] = loadf(idx >> 4, (idx & 15) * 8); }
#pragma unroll
    for (int it = 0; it < 8; ++it) {
        const int idx = it * NTHREADS + tid0;
        const int r = idx >> 4, c0 = (idx & 15) * 8;
        const float4 p = *(const float4*)(stg + r * STG_LD + c0);
        const float4 q = *(const float4*)(stg + r * STG_LD + c0 + 4);
        const float v[8] = {p.x, p.y, p.z, p.w, q.x, q.y, q.z, q.w};
        f(r, c0, v, pre[it]);
    }
}
struct F8 { float4 a, b; };
struct RowLoader {
    const bfr* p; size_t ld;
    DI RowLoader(const bfr* base, int row0, size_t ld_) : ld(ld_) { const int t = ltid(); p = base + (size_t)(row0 + (t >> 3)) * ld_ + (t & 7) * 8; }
    DI const bfr* operator()(int i, int kt) const { return p + (size_t)(32 * i) * ld + kt * 64; }
};
DI int cvt_rowmap(int n, int mode) { return mode == 0 ? n : ((n >> 2) * 8 + (n & 3) + (mode == 2 ? 4 : 0)); }
DI void cvt_tile(char* lds, const float* __restrict__ src, int N, bfr* __restrict__ dst, int ldd, int k0, int n0, int mode) {
    float* t = (float*)lds;
    const int tid = ltid();
    const int r = tid >> 4, c = (tid & 15) * 4;
#pragma unroll
    for (int i = 0; i < 4; ++i) {
        const float4 v = *(const float4*)(src + (size_t)(k0 + r + 16 * i) * N + n0 + c);
        float* d = t + (r + 16 * i) * 65 + c;
        d[0] = v.x; d[1] = v.y; d[2] = v.z; d[3] = v.w;
    }
    __syncthreads();
#pragma unroll
    for (int i = 0; i < 2; ++i) {
        const int idx = tid + i * 256;
        const int n = idx & 63, kg = idx >> 6;
        float v[8];
#pragma unroll
        for (int j = 0; j < 8; ++j) v[j] = t[(kg * 8 + j) * 65 + n];
        *(uint4*)(dst + (size_t)cvt_rowmap(n0 + n, mode) * ldd + k0 + kg * 8) = pack8(v);
    }
    __syncthreads();
}
DI void cvt_matrix(char* lds, const float* src, int K, int N, bfr* dst, int ldd, int mode, int worker, int nworkers, unsigned& base) {
    if (worker < 0) return;
    const int ntn = N >> 6, ntiles = (K >> 6) * ntn;
    int t0 = (int)(((unsigned)worker + (unsigned)nworkers - (base % (unsigned)nworkers)) % (unsigned)nworkers);
    for (int t = t0; t < ntiles; t += nworkers) cvt_tile(lds, src, N, dst, ldd, (t / ntn) * 64, (t % ntn) * 64, mode);
    base += (unsigned)ntiles;
}
DI void moe_convert(char* lds, const Ctx& P, int layer, int worker, int nworkers) {
    unsigned base = 0;
    bfr* wgu = (bfr*)(P.ws + OFF_MWGU); bfr* wd = (bfr*)(P.ws + OFF_MWD);
    for (int e = 0; e < 32; ++e) {
        const size_t we = (size_t)(layer * 32 + e);
        cvt_matrix(lds, P.in[I_MWGATE] + we * 1024 * 512, 1024, 512, wgu + (size_t)e * 1024 * 1024, 1024, 1, worker, nworkers, base);
        cvt_matrix(lds, P.in[I_MWUP]   + we * 1024 * 512, 1024, 512, wgu + (size_t)e * 1024 * 1024, 1024, 2, worker, nworkers, base);
        cvt_matrix(lds, P.in[I_MWDOWN] + we * 512 * 1024, 512, 1024, wd  + (size_t)e * 1024 * 512,  512,  0, worker, nworkers, base);
    }
}

DI void s5_tables(char* lds, const Ctx& P, int i, int g) {
    float2* pw = (float2*)lds;
    float2* bb = pw + 64 * 33;
    float2* cm = bb + 64 * 16;
    float*  kt = (float*)(cm + 16 * 64);
    const int tid = ltid();
    const size_t gp = (size_t)(i * 32 + g) * 64;
    for (int idx = tid; idx < 64 * 33; idx += NTHREADS) {
        const int p = idx / 33, tau = idx % 33;
        const double re = fmin((double)P.in[I_ARE][gp + p], -1e-4), im = (double)P.in[I_AIM][gp + p];
        const double st = exp((double)P.in[I_LSTEP][gp + p]);
        const double mag = exp(re * st * tau), ang = im * st * tau;
        pw[idx] = make_float2((float)(mag * cos(ang)), (float)(mag * sin(ang)));
    }
    for (int idx = tid; idx < 64 * 16; idx += NTHREADS) {
        const int p = idx >> 4, c = idx & 15;
        const double re = fmin((double)P.in[I_ARE][gp + p], -1e-4), im = (double)P.in[I_AIM][gp + p];
        const double st = exp((double)P.in[I_LSTEP][gp + p]);
        const double mag = exp(re * st), lr = mag * cos(im * st) - 1.0, li = mag * sin(im * st);
        const double den = re * re + im * im;
        const double fr = (lr * re + li * im) / den, fi = (li * re - lr * im) / den;
        const double br = (double)P.in[I_BRE][(gp + p) * 16 + c], bi = (double)P.in[I_BIM][(gp + p) * 16 + c];
        bb[idx] = make_float2((float)(fr * br - fi * bi), (float)(fr * bi + fi * br));
        const int cc = idx >> 6, pp = idx & 63;
        cm[idx] = make_float2(P.in[I_CRE][((size_t)(i * 32 + g) * 16 + cc) * 64 + pp], P.in[I_CIM][((size_t)(i * 32 + g) * 16 + cc) * 64 + pp]);
    }
    __syncthreads();
    for (int idx = tid; idx < 32 * 256; idx += NTHREADS) {
        const int tau = idx >> 8, c1 = (idx >> 4) & 15, c = idx & 15;
        float s = 0.f;
        for (int p = 0; p < 64; ++p) {
            const float2 a = cm[c1 * 64 + p], w = pw[p * 33 + tau], b = bb[p * 16 + c];
            const float tr = a.x * w.x - a.y * w.y, ti = a.x * w.y + a.y * w.x;
            s += tr * b.x - ti * b.y;
        }
        kt[idx] = s;
    }
    __syncthreads();
    bfr* gt = (bfr*)(P.ws + OFF_S5GT) + (size_t)(i * 32 + g) * 512 * 640;
    for (int idx = tid; idx < 512 * 80; idx += NTHREADS) {
        const int n = idx / 80, ch = idx % 80;
        const int t = n >> 4, c1 = n & 15;
        float v[8];
        if (ch < 64) {
            const int s = ch >> 1, c0 = (ch & 1) * 8;
#pragma unroll
            for (int j = 0; j < 8; ++j) v[j] = (t >= s) ? kt[((t - s) * 16 + c1) * 16 + c0 + j] : 0.f;
        } else {
            const int p0 = (ch - 64) * 4;
#pragma unroll
            for (int j = 0; j < 4; ++j) {
                const float2 a = cm[c1 * 64 + p0 + j], w = pw[(p0 + j) * 33 + t + 1];
                v[2 * j] = a.x * w.x - a.y * w.y;
                v[2 * j + 1] = -(a.x * w.y + a.y * w.x);
            }
        }
        *(uint4*)(gt + (size_t)n * 640 + ch * 8) = pack8(v);
    }
    bfr* bl = (bfr*)(P.ws + OFF_S5BL) + (size_t)(i * 32 + g) * 128 * 512;
    for (int idx = tid; idx < 128 * 64; idx += NTHREADS) {
        const int n = idx >> 6, ch = idx & 63;
        const int p = n >> 1, ri = n & 1, s = ch >> 1, c0 = (ch & 1) * 8;
        const float2 w = pw[p * 33 + 31 - s];
        float v[8];
#pragma unroll
        for (int j = 0; j < 8; ++j) { const float2 b = bb[p * 16 + c0 + j]; v[j] = ri ? (w.x * b.y + w.y * b.x) : (w.x * b.x - w.y * b.y); }
        *(uint4*)(bl + (size_t)n * 512 + ch * 8) = pack8(v);
    }
    float* l32 = (float*)(P.ws + OFF_S5L32) + (size_t)(i * 32 + g) * 128;
    if (tid < 64) { l32[2 * tid] = pw[tid * 33 + 32].x; l32[2 * tid + 1] = pw[tid * 33 + 32].y; }
    __syncthreads();
}

DI void norm_rows(const float* __restrict__ x, const float* __restrict__ g, bfr* __restrict__ hb, bfr* __restrict__ hlo, float* __restrict__ xcopy, int tok0, int ntok) {
    const int tid_ = ltid();
    const int lane = tid_ & 63, wave = tid_ >> 6;
    for (int tk = wave; tk < ntok; tk += 4) {
        const size_t tok = (size_t)(tok0 + tk);
        float4 v[4];
        float ss = 0.f;
#pragma unroll
        for (int i = 0; i < 4; ++i) {
            v[i] = *(const float4*)(x + tok * DM + i * 256 + lane * 4);
            ss += v[i].x * v[i].x + v[i].y * v[i].y + v[i].z * v[i].z + v[i].w * v[i].w;
        }
        ss = wave_sum(ss);
        const float rs = rsqrtf(ss * (1.0f / DM) + 1e-6f);
#pragma unroll
        for (int i = 0; i < 4; ++i) {
            const float4 gg = *(const float4*)(g + i * 256 + lane * 4);
            const float h0 = v[i].x * rs * gg.x, h1 = v[i].y * rs * gg.y, h2 = v[i].z * rs * gg.z, h3 = v[i].w * rs * gg.w;
            const unsigned p0 = pk2(h0, h1), p1 = pk2(h2, h3);
            *(uint2*)(hb + tok * DM + i * 256 + lane * 4) = make_uint2(p0, p1);
            if (hlo) {
                const unsigned q0 = pk2(h0 - bflo(p0), h1 - bfhi(p0)), q1 = pk2(h2 - bflo(p1), h3 - bfhi(p1));
                *(uint2*)(hlo + tok * DM + i * 256 + lane * 4) = make_uint2(q0, q1);
            }
            if (xcopy) *(float4*)(xcopy + tok * DM + i * 256 + lane * 4) = v[i];
        }
    }
}
DI void phase_e1(char* lds, const Ctx& P, int li) {
    const bfr* hb = (const bfr*)(P.ws + OFF_HB);
    const bfr* w = (const bfr*)(P.ws + OFF_WINE) + (size_t)li * 2304 * 1024;
    bfr* u = (bfr*)(P.ws + OFF_U);
    for (int t = blockIdx.x; t < 256 * 18; t += gridDim.x) {
        const int mt = t / 18, nt = t % 18;
        RowLoader A(hb, mt * 128, 1024), B(w, nt * 128, 1024);
        gemm_tile(lds, 16, A, B, [&](const float* stg) __attribute__((always_inline)) {
            epi_rows8(stg, [&](int r, int c0, const float (&v)[8]) __attribute__((always_inline)) {
                *(uint4*)(u + (size_t)(mt * 128 + r) * EVEN_IN + nt * 128 + c0) = pack8(v);
            });
        });
    }
}

DI void phase_e2a(const Ctx& P, int li) {
    const bfr* u = (const bfr*)(P.ws + OFF_U);
    const float* mu = P.in[I_MU] + (size_t)li * 1792;
    bfr* S = (bfr*)(P.ws + OFF_S);
    bfr* mv = (bfr*)(P.ws + (li == 0 ? OFF_VFIRST : OFF_MV2));
    bfr* dpool = (bfr*)(P.ws + OFF_DPOOL);
    const int total = NTOK * 160;
    for (int idx = blockIdx.x * NTHREADS + ltid(); idx < total; idx += gridDim.x * NTHREADS) {
        const int tok = idx / 160, ch = idx % 160;
        const int col = 1024 + ch * 8;
        const int t = tok & (SEQ - 1);
        const bfr* row = u + (size_t)tok * EVEN_IN;
        float cur[8];
        unpack8(*(const uint4*)(row + col), cur);
        if (col < 1792) {
            float prv[8], m[8];
            if (t > 0) unpack8(*(const uint4*)(row - EVEN_IN + col), prv);
            else {
#pragma unroll
                for (int j = 0; j < 8; ++j) prv[j] = 0.f;
            }
            const float4 m0 = *(const float4*)(mu + col), m1 = *(const float4*)(mu + col + 4);
            const float mm[8] = {m0.x, m0.y, m0.z, m0.w, m1.x, m1.y, m1.z, m1.w};
#pragma unroll
            for (int j = 0; j < 8; ++j) m[j] = cur[j] + (prv[j] - cur[j]) * mm[j];
            if (col < 1536) {
                *(uint4*)(mv + (size_t)tok * 512 + (col - 1024)) = pack8(m);
            } else if (col < 1600) {
#pragma unroll
                for (int j = 0; j < 8; ++j) m[j] = ftanh(m[j]);
                *(uint4*)(S + (size_t)tok * 256 + (col - 1536)) = pack8(m);
            } else if (col < 1664) {
                *(uint4*)(S + (size_t)tok * 256 + 64 + (col - 1600)) = pack8(m);
            } else {
#pragma unroll
                for (int j = 0; j < 8; ++j) m[j] = sigmoidf_(m[j]);
                *(uint4*)(S + (size_t)tok * 256 + 128 + (col - 1664)) = pack8(m);
            }
        } else {
            const int gi = (col - 1792) >> 7;
            const int win = 2 << gi;
            const int nw = (t + 1 < win) ? (t + 1) : win;
            float acc[8];
#pragma unroll
            for (int j = 0; j < 8; ++j) acc[j] = cur[j];
#define POOL_WIN(W) { uint4 pv[W - 1]; _Pragma("unroll") for (int s = 1; s < W; ++s) pv[s - 1] = *(const uint4*)(row - (size_t)(s < nw ? s : 0) * EVEN_IN + col); \
                      _Pragma("unroll") for (int s = 1; s < W; ++s) { float pq[8]; unpack8(pv[s - 1], pq); const float wgt = s < nw ? 1.f : 0.f; \
                          _Pragma("unroll") for (int j = 0; j < 8; ++j) acc[j] += wgt * pq[j]; } }
            if (gi == 0) POOL_WIN(2) else if (gi == 1) POOL_WIN(4) else if (gi == 2) POOL_WIN(8) else POOL_WIN(16)
#undef POOL_WIN
            const float inv = frcp((float)nw);
#pragma unroll
            for (int j = 0; j < 8; ++j) acc[j] = acc[j] * inv - cur[j];
            *(uint4*)(dpool + (size_t)tok * 512 + (col - 1792)) = pack8(acc);
        }
    }
}

DI void phase_e2b(char* lds, const Ctx& P, int li) {
    const bfr* S = (const bfr*)(P.ws + OFF_S);
    const int njobs = (li == 1) ? 20 : 16;
    for (int t = blockIdx.x; t < 256 * njobs; t += gridDim.x) {
        const int mt = t / njobs, j = t % njobs;
        const int job = j >> 2, nt = j & 3;
        const int m0 = mt * 128;
        if (job == 0) {
            RowLoader A(S, m0, 256), B((const bfr*)(P.ws + OFF_W2T) + (size_t)li * 512 * 64, nt * 128, 64);
            const float* w0 = P.in[I_W0] + li * 512;
            float* dlog = (float*)(P.ws + OFF_DLOG);
            gemm_tile(lds, 1, A, B, [&](const float* stg) __attribute__((always_inline)) {
                epi_rows8(stg, [&](int r, int c0, const float (&v)[8]) __attribute__((always_inline)) {
                    float o[8];
#pragma unroll
                    for (int q = 0; q < 8; ++q) {
                        const float z = -(w0[nt * 128 + c0 + q] + v[q]);
                        o[q] = -fexp(-fsoftplus(z) - 0.5f);
                    }
                    float* d = dlog + (size_t)(m0 + r) * 512 + nt * 128 + c0;
                    *(float4*)d = make_float4(o[0], o[1], o[2], o[3]); *(float4*)(d + 4) = make_float4(o[4], o[5], o[6], o[7]);
                });
            });
        } else if (job == 1) {
            RowLoader A(S + 64, m0, 256), B((const bfr*)(P.ws + OFF_A2T) + (size_t)li * 512 * 64, nt * 128, 64);
            const float* a0 = P.in[I_A0] + li * 512;
            bfr* ab = (bfr*)(P.ws + OFF_ABUF);
            gemm_tile(lds, 1, A, B, [&](const float* stg) __attribute__((always_inline)) {
                epi_rows8(stg, [&](int r, int c0, const float (&v)[8]) __attribute__((always_inline)) {
                    float o[8];
#pragma unroll
                    for (int q = 0; q < 8; ++q) o[q] = sigmoidf_(a0[nt * 128 + c0 + q] + v[q]);
                    *(uint4*)(ab + (size_t)(m0 + r) * 512 + nt * 128 + c0) = pack8(o);
                });
            });
        } else if (job == 2) {
            RowLoader A(S + 128, m0, 256), B((const bfr*)(P.ws + OFF_G2T) + (size_t)li * 512 * 128, nt * 128, 128);
            bfr* gb = (bfr*)(P.ws + OFF_GBUF);
            gemm_tile(lds, 2, A, B, [&](const float* stg) __attribute__((always_inline)) {
                epi_rows8(stg, [&](int r, int c0, const float (&v)[8]) __attribute__((always_inline)) {
                    *(uint4*)(gb + (size_t)(m0 + r) * 512 + nt * 128 + c0) = pack8(v);
                });
            });
        } else if (job == 3) {
            RowLoader A((const bfr*)(P.ws + OFF_DPOOL) + nt * 128, m0, 512), B((const bfr*)(P.ws + OFF_POOLT) + (size_t)(li * 4 + nt) * 128 * 128, 0, 128);
            const float* ps = P.in[I_POOLS] + li * 512 + nt * 128;
            bfr* am = (bfr*)(P.ws + OFF_AMIX);
            gemm_tile(lds, 2, A, B, [&](const float* stg) __attribute__((always_inline)) {
                epi_rows8(stg, [&](int r, int c0, const float (&v)[8]) __attribute__((always_inline)) {
                    float o[8];
#pragma unroll
                    for (int q = 0; q < 8; ++q) o[q] = v[q] * ps[c0 + q];
                    *(uint4*)(am + (size_t)(m0 + r) * 1024 + 512 + nt * 128 + c0) = pack8(o);
                });
            });
        } else {
            RowLoader A((const bfr*)(P.ws + OFF_MV2), m0, 512), B((const bfr*)(P.ws + OFF_V12T), nt * 128, 512);
            const float* v0 = P.in[I_V0];
            bfr* vg = (bfr*)(P.ws + OFF_VGATE);
            gemm_tile(lds, 8, A, B, [&](const float* stg) __attribute__((always_inline)) {
                epi_rows8(stg, [&](int r, int c0, const float (&v)[8]) __attribute__((always_inline)) {
                    float o[8];
#pragma unroll
                    for (int q = 0; q < 8; ++q) o[q] = sigmoidf_(v0[nt * 128 + c0 + q] + v[q]);
                    *(uint4*)(vg + (size_t)(m0 + r) * 512 + nt * 128 + c0) = pack8(o);
                });
            });
        }
    }
}

constexpr int RW_TC = 32;
DI void phase_e3(char* lds, const Ctx& P, int li) {
    float* s_w = (float*)lds;
    float* s_a = s_w + RW_TC * 64;
    float* s_b = s_a + RW_TC * 64;
    float* s_k = s_b + RW_TC * 64;
    float* s_r = s_k + RW_TC * 64;
    float* s_v = s_r + RW_TC * 64;
    float* s_y = s_v + RW_TC * 16;
    const bfr* u = (const bfr*)(P.ws + OFF_U);
    const float* mu = P.in[I_MU] + (size_t)li * 1792;
    const float* dlog = (const float*)(P.ws + OFF_DLOG);
    const bfr* ab = (const bfr*)(P.ws + OFF_ABUF);
    const bfr* vg = (const bfr*)(P.ws + OFF_VGATE);
    const bfr* vf = (const bfr*)(P.ws + OFF_VFIRST);
    float* yout = (float*)(P.ws + OFF_Y);
    float* bonus = (float*)(P.ws + OFF_BONUS);
    const int tid = ltid(), lane = tid & 63, wave = tid >> 6;
    const int pstep = tid >> 3, pc0 = (tid & 7) * 8;
    for (int item = blockIdx.x; item < 512; item += gridDim.x) {
        const int bh = item >> 2, qtr = item & 3;
        const int b = bh >> 3, h = bh & 7;
        const int i0 = qtr * 16;
        float c_mur[8], c_muk[8], c_muv[8], c_kk[8], c_ka[8], c_rk[8];
#pragma unroll
        for (int j = 0; j < 8; ++j) {
            const int c = h * 64 + pc0 + j;
            c_mur[j] = mu[c]; c_muk[j] = mu[512 + c]; c_muv[j] = mu[1024 + c];
            c_kk[j] = P.in[I_KK][li * 512 + c]; c_ka[j] = P.in[I_KA][li * 512 + c]; c_rk[j] = P.in[I_RK][li * 512 + c];
        }
        float S0 = 0.f, S1 = 0.f, S2 = 0.f, S3 = 0.f;
        const int rloc = wave * 4 + (lane >> 4);
        const int j0 = (lane & 15) * 4;
        for (int t0 = 0; t0 < SEQ; t0 += RW_TC) {
            __syncthreads();
            {
                const int t = t0 + pstep;
                const size_t tok = (size_t)b * SEQ + t;
                const bfr* row = u + tok * EVEN_IN + h * 64 + pc0;
                float ur[8], uk[8], uv[8], pr[8], pk[8], pv[8];
                unpack8(*(const uint4*)(row), ur); unpack8(*(const uint4*)(row + 512), uk); unpack8(*(const uint4*)(row + 1024), uv);
                if (t > 0) { unpack8(*(const uint4*)(row - EVEN_IN), pr); unpack8(*(const uint4*)(row - EVEN_IN + 512), pk); unpack8(*(const uint4*)(row - EVEN_IN + 1024), pv); }
                else {
#pragma unroll
                    for (int j = 0; j < 8; ++j) { pr[j] = 0.f; pk[j] = 0.f; pv[j] = 0.f; }
                }
                const size_t o512 = tok * 512 + h * 64 + pc0;
                float av[8], gv[8], fv[8];
                unpack8(*(const uint4*)(ab + o512), av);
                const float4 d0 = *(const float4*)(dlog + o512), d1 = *(const float4*)(dlog + o512 + 4);
                const float dl[8] = {d0.x, d0.y, d0.z, d0.w, d1.x, d1.y, d1.z, d1.w};
                if (li == 1) { unpack8(*(const uint4*)(vg + o512), gv); unpack8(*(const uint4*)(vf + o512), fv); }
                float kkr[8], kmod[8], rr[8], vv[8];
                float ssq = 0.f, bsum = 0.f;
#pragma unroll
                for (int j = 0; j < 8; ++j) {
                    rr[j] = ur[j] + (pr[j] - ur[j]) * c_mur[j];
                    const float k = uk[j] + (pk[j] - uk[j]) * c_muk[j];
                    float v = uv[j] + (pv[j] - uv[j]) * c_muv[j];
                    if (li == 1) v = v + (fv[j] - v) * gv[j];
                    vv[j] = v;
                    kkr[j] = k * c_kk[j];
                    ssq += kkr[j] * kkr[j];
                    kmod[j] = k * (1.0f + (av[j] - 1.0f) * c_ka[j]);
                    bsum += rr[j] * kmod[j] * c_rk[j];
                }
                ssq += __shfl_xor(ssq, 1); ssq += __shfl_xor(ssq, 2); ssq += __shfl_xor(ssq, 4);
                bsum += __shfl_xor(bsum, 1); bsum += __shfl_xor(bsum, 2); bsum += __shfl_xor(bsum, 4);
                const float inv = 1.0f / fmaxf(sqrtf(ssq), 1e-12f);
#pragma unroll
                for (int j = 0; j < 8; ++j) {
                    const float kk = kkr[j] * inv;
                    s_w[pstep * 64 + pc0 + j] = __expf(dl[j]);
                    s_a[pstep * 64 + pc0 + j] = -kk;
                    s_b[pstep * 64 + pc0 + j] = kk * av[j];
                    s_k[pstep * 64 + pc0 + j] = kmod[j];
                    s_r[pstep * 64 + pc0 + j] = rr[j];
                }
                if ((pc0 >> 4) == qtr) {
                    float bo[8];
#pragma unroll
                    for (int j = 0; j < 8; ++j) { s_v[pstep * 16 + (pc0 & 15) + j] = vv[j]; bo[j] = bsum * vv[j]; }
                    float* bp = bonus + o512;
                    *(float4*)bp = make_float4(bo[0], bo[1], bo[2], bo[3]); *(float4*)(bp + 4) = make_float4(bo[4], bo[5], bo[6], bo[7]);
                }
            }
            __syncthreads();
#pragma unroll 4
            for (int s = 0; s < RW_TC; ++s) {
                const float4 a4 = *(const float4*)(s_a + s * 64 + j0);
                const float4 w4 = *(const float4*)(s_w + s * 64 + j0);
                const float4 b4 = *(const float4*)(s_b + s * 64 + j0);
                const float4 k4 = *(const float4*)(s_k + s * 64 + j0);
                const float4 r4 = *(const float4*)(s_r + s * 64 + j0);
                const float vi = s_v[s * 16 + rloc];
                float sa = S0 * a4.x + S1 * a4.y + S2 * a4.z + S3 * a4.w;
                sa = row16_sum(sa);
                S0 = S0 * w4.x + sa * b4.x + vi * k4.x;
                S1 = S1 * w4.y + sa * b4.y + vi * k4.y;
                S2 = S2 * w4.z + sa * b4.z + vi * k4.z;
                S3 = S3 * w4.w + sa * b4.w + vi * k4.w;
                float y = S0 * r4.x + S1 * r4.y + S2 * r4.z + S3 * r4.w;
                y = row16_sum(y);
                if ((lane & 15) == 0) s_y[s * 16 + rloc] = y;
            }
            __syncthreads();
            {
                for (int idx = tid; idx < RW_TC * 16; idx += NTHREADS) {
                    const int s = idx >> 4, r = idx & 15;
                    yout[((size_t)b * SEQ + t0 + s) * 512 + h * 64 + i0 + r] = s_y[idx];
                }
            }
        }
    }
}

DI void phase_e4(const Ctx& P, int li) {
    const float* y = (const float*)(P.ws + OFF_Y);
    const float* bonus = (const float*)(P.ws + OFF_BONUS);
    const bfr* gb = (const bfr*)(P.ws + OFF_GBUF);
    const float* lng = P.in[I_LNG] + li * 512;
    const float* lnb = P.in[I_LNB] + li * 512;
    bfr* am = (bfr*)(P.ws + OFF_AMIX);
    const int total = NTOK * 64;
    for (int idx = blockIdx.x * NTHREADS + ltid(); idx < total; idx += gridDim.x * NTHREADS) {
        const int tok = idx >> 6, c = (idx & 63) * 8;
        const size_t o = (size_t)tok * 512 + c;
        const float4 y0 = *(const float4*)(y + o), y1 = *(const float4*)(y + o + 4);
        float v[8] = {y0.x, y0.y, y0.z, y0.w, y1.x, y1.y, y1.z, y1.w};
        float s = 0.f;
#pragma unroll
        for (int j = 0; j < 8; ++j) s += v[j];
        s += __shfl_xor(s, 1); s += __shfl_xor(s, 2); s += __shfl_xor(s, 4);
        const float mean = s * (1.0f / 64.0f);
        float q = 0.f;
#pragma unroll
        for (int j = 0; j < 8; ++j) { v[j] -= mean; q += v[j] * v[j]; }
        q += __shfl_xor(q, 1); q += __shfl_xor(q, 2); q += __shfl_xor(q, 4);
        const float rstd = rsqrtf(q * (1.0f / 64.0f) + 64e-5f);
        const float4 b0 = *(const float4*)(bonus + o), b1 = *(const float4*)(bonus + o + 4);
        const float bo[8] = {b0.x, b0.y, b0.z, b0.w, b1.x, b1.y, b1.z, b1.w};
        float gv[8];
        unpack8(*(const uint4*)(gb + o), gv);
        float out[8];
#pragma unroll
        for (int j = 0; j < 8; ++j) out[j] = (v[j] * rstd * lng[c + j] + lnb[c + j] + bo[j]) * gv[j];
        *(uint4*)(am + (size_t)tok * 1024 + c) = pack8(out);
    }
}

DI void phase_wout(char* lds, const Ctx& P, const bfr* w, float* x) {
    const bfr* am = (const bfr*)(P.ws + OFF_AMIX);
    for (int t = blockIdx.x; t < 256 * 8; t += gridDim.x) {
        const int mt = t >> 3, nt = t & 7;
        RowLoader A(am, mt * 128, 1024), B(w, nt * 128, 1024);
        gemm_tile(lds, 16, A, B, [&](const float* stg) __attribute__((always_inline)) {
            epi_rows8_pre<F8>(stg,
                [&](int r, int c0) __attribute__((always_inline)) -> F8 {
                    const float* d = x + (size_t)(mt * 128 + r) * DM + nt * 128 + c0;
                    F8 o; o.a = *(const float4*)d; o.b = *(const float4*)(d + 4); return o; },
                [&](int r, int c0, const float (&v)[8], const F8& o) __attribute__((always_inline)) {
                    float* d = x + (size_t)(mt * 128 + r) * DM + nt * 128 + c0;
                    *(float4*)d = make_float4(o.a.x + v[0], o.a.y + v[1], o.a.z + v[2], o.a.w + v[3]);
                    *(float4*)(d + 4) = make_float4(o.b.x + v[4], o.b.y + v[5], o.b.z + v[6], o.b.w + v[7]);
                });
        });
    }
}
DI void phase_o1(char* lds, const Ctx& P, int li) {
    const bfr* hb = (const bfr*)(P.ws + OFF_HB);
    const bfr* w = (const bfr*)(P.ws + OFF_WINO) + (size_t)li * 2048 * 1024;
    bfr* qk = (bfr*)(P.ws + OFF_U);
    bfr* vT = (bfr*)(P.ws + OFF_VT);
    bfr* us5 = (bfr*)(P.ws + OFF_US5);
    for (int t = blockIdx.x; t < 256 * 16; t += gridDim.x) {
        const int mt = t >> 4, nt = t & 15;
        const int m0 = mt * 128;
        RowLoader A(hb, m0, 1024), B(w, nt * 128, 1024);
        gemm_tile(lds, 16, A, B, [&](const float* stg) __attribute__((always_inline)) {
            if (nt < 8) {
                epi_rows8(stg, [&](int r, int c0, const float (&v)[8]) __attribute__((always_inline)) {
                    *(uint4*)(qk + (size_t)(m0 + r) * 1024 + nt * 128 + c0) = pack8(v);
                });
            } else if (nt < 12) {
                const int b = m0 >> 11, tq = m0 & (SEQ - 1);
                bfr* dst = vT + ((size_t)(b * 4 + (nt - 8)) * 128) * SEQ + tq;
                const int tid0 = ltid();
#pragma unroll
                for (int it = 0; it < 8; ++it) {
                    const int idx = it * NTHREADS + tid0;
                    const int dv = idx & 127, rg = idx >> 7;
                    float v[8];
#pragma unroll
                    for (int j = 0; j < 8; ++j) v[j] = stg[(rg * 8 + j) * STG_LD + dv];
                    *(uint4*)(dst + (size_t)dv * SEQ + rg * 8) = pack8(v);
                }
            } else {
                epi_rows8(stg, [&](int r, int c0, const float (&v)[8]) __attribute__((always_inline)) {
                    const int cc = (nt - 12) * 128 + c0;
                    *(uint4*)(us5 + ((size_t)(cc >> 4) * NTOK + m0 + r) * 16 + (cc & 15)) = pack8(v);
                });
            }
        });
    }
}

DI void phase_o2(char* lds, const Ctx& P, int li) {
    const bfr* qk = (const bfr*)(P.ws + OFF_U);
    bfr* qn = (bfr*)(P.ws + OFF_QN);
    bfr* kn = (bfr*)(P.ws + OFF_KN);
    const float* gq = P.in[I_QN] + li * 64;
    const float* gk = P.in[I_KN] + li * 64;
    const bfr* us5 = (const bfr*)(P.ws + OFF_US5);
    const bfr* bl = (const bfr*)(P.ws + OFF_S5BL) + (size_t)li * 32 * 128 * 512;
    float* xloc = (float*)(P.ws + OFF_XLOC);
    for (int t = blockIdx.x; t < 256; t += gridDim.x) {
        const int g = t >> 3, mt = t & 7;
        RowLoader A(us5 + (size_t)g * NTOK * 16, mt * 128, 512), B(bl + (size_t)g * 128 * 512, 0, 512);
        gemm_tile(lds, 8, A, B, [&](const float* stg) __attribute__((always_inline)) {
            epi_rows8(stg, [&](int r, int c0, const float (&v)[8]) __attribute__((always_inline)) {
                float* d = xloc + ((size_t)g * 1024 + mt * 128 + r) * 128 + c0;
                *(float4*)d = make_float4(v[0], v[1], v[2], v[3]); *(float4*)(d + 4) = make_float4(v[4], v[5], v[6], v[7]);
            });
        });
    }
    const int total = NTOK * 16 * 8;
    for (int idx = blockIdx.x * NTHREADS + ltid(); idx < total; idx += gridDim.x * NTHREADS) {
        const int l8 = idx & 7, item = idx >> 3;
        const int hm = item & 7, which = (item >> 3) & 1, tok = item >> 4;
        const int d0 = l8 * 4;
        const bfr* src = qk + (size_t)tok * 1024 + which * 512 + hm * 64;
        const uint2 ua = *(const uint2*)(src + d0), ub = *(const uint2*)(src + 32 + d0);
        float x1[4] = {bflo(ua.x), bfhi(ua.x), bflo(ua.y), bfhi(ua.y)};
        float x2[4] = {bflo(ub.x), bfhi(ub.x), bflo(ub.y), bfhi(ub.y)};
        float ss = 0.f;
#pragma unroll
        for (int j = 0; j < 4; ++j) ss += x1[j] * x1[j] + x2[j] * x2[j];
        ss += __shfl_xor(ss, 1); ss += __shfl_xor(ss, 2); ss += __shfl_xor(ss, 4);
        const float rs = rsqrtf(ss * (1.0f / 64.0f) + 1e-6f);
        const float* gg = which ? gk : gq;
        const float scl = which ? 1.0f : (0.125f * 1.4426950408889634f);
        const int t = tok & (SEQ - 1);
        float o1[4], o2[4];
#pragma unroll
        for (int j = 0; j < 4; ++j) {
            const int i = d0 + j;
            const float invf = exp2f(-(float)i * (13.287712379549449f / 32.0f));
            const float ang = (float)t * invf;
            float sn, cs;
            sincosf(ang, &sn, &cs);
            const float a = x1[j] * rs * gg[i], b2 = x2[j] * rs * gg[32 + i];
            o1[j] = (a * cs - b2 * sn) * scl;
            o2[j] = (b2 * cs + a * sn) * scl;
        }
        bfr* dst = (which ? kn : qn) + (size_t)tok * 512 + hm * 64;
        *(uint2*)(dst + d0) = make_uint2(pk2(o1[0], o1[1]), pk2(o1[2], o1[3]));
        *(uint2*)(dst + 32 + d0) = make_uint2(pk2(o2[0], o2[1]), pk2(o2[2], o2[3]));
    }
}

DI void s5_scan(const Ctx& P, int li) {
    const float* xloc = (const float*)(P.ws + OFF_XLOC);
    bfr* xin = (bfr*)(P.ws + OFF_XIN);
    const float* l32 = (const float*)(P.ws + OFF_S5L32) + (size_t)li * 32 * 128;
    for (int idx = blockIdx.x * NTHREADS + ltid(); idx < 32 * 16 * 64; idx += gridDim.x * NTHREADS) {
        const int p = idx & 63, b = (idx >> 6) & 15, g = idx >> 10;
        const float lr = l32[g * 128 + 2 * p], lim = l32[g * 128 + 2 * p + 1];
        float xr = 0.f, xi = 0.f;
        for (int ch = 0; ch < 64; ++ch) {
            const size_t o = ((size_t)g * 1024 + b * 64 + ch) * 128 + 2 * p;
            *(unsigned*)(xin + o) = pk2(xr, xi);
            const float2 a = *(const float2*)(xloc + o);
            const float nr = lr * xr - lim * xi + a.x, ni = lr * xi + lim * xr + a.y;
            xr = nr; xi = ni;
        }
    }
}

DI void attn_item(char* lds, const Ctx& P, int b, int h, int qt, float lam, float lam_init, const float* subln) {
    const bfr* qn = (const bfr*)(P.ws + OFF_QN);
    const bfr* kn = (const bfr*)(P.ws + OFF_KN);
    const bfr* vT = (const bfr*)(P.ws + OFF_VT) + (size_t)(b * 4 + h) * 128 * SEQ;
    bfr* am = (bfr*)(P.ws + OFF_AMIX);
    const int tid = ltid(), lane = tid & 63, wave = tid >> 6;
    const int m = wave >> 1, qw = (wave & 1) * 32;
    const int q0 = qt * 64 + qw;
    const int ln = lane & 31, hf = lane >> 5;
    bf16x8 qf[4];
    {
        const bfr* qp = qn + ((size_t)b * SEQ + q0 + ln) * 512 + h * 128 + m * 64 + hf * 8;
#pragma unroll
        for (int ks = 0; ks < 4; ++ks) qf[ks] = *(const bf16x8*)(qp + ks * 16);
    }
    f32x16 o[4];
#pragma unroll
    for (int d = 0; d < 4; ++d)
#pragma unroll
        for (int r = 0; r < 16; ++r) o[d][r] = 0.f;
    float mrun = -INFINITY, lrun = 0.f;
    const int nkt = qt + 1;
    const int lrow = tid >> 3, lcol = (tid & 7) * 8;
    const bfr* kbase = kn + ((size_t)b * SEQ) * 512 + h * 128;
    unsigned ko = (unsigned)(lrow * 512 + lcol) * 2u, vo = (unsigned)(lrow * SEQ + lcol) * 2u;
    asm volatile("" : "+v"(ko), "+v"(vo));
    uint4 rk0, rk1, rk2, rk3, rv0, rv1, rv2, rv3;
#define ATT_GLOAD(kt_) do { const char* kp_ = (const char*)(kbase + (size_t)(kt_) * (64 * 512)); const char* vp_ = (const char*)(vT + (kt_) * 64); \
        rk0 = *(const uint4*)(kp_ + ko); rk1 = *(const uint4*)(kp_ + 32 * 512 * 2 + ko); rk2 = *(const uint4*)(kp_ + 64 * 2 + ko); rk3 = *(const uint4*)(kp_ + 32 * 512 * 2 + 64 * 2 + ko); \
        rv0 = *(const uint4*)(vp_ + vo); rv1 = *(const uint4*)(vp_ + 32 * SEQ * 2 + vo); rv2 = *(const uint4*)(vp_ + 64 * SEQ * 2 + vo); rv3 = *(const uint4*)(vp_ + 96 * SEQ * 2 + vo); } while (0)
#define ATT_S1(base_, i_, RK, RV) { *(uint4*)((base_) + (32 * (i_)) * LDA * 2) = RK; \
        *(uint4*)((base_) + TILE_B + (32 * (i_)) * LDA * 2) = RV; }
#define ATT_LSTORE(buf_) do { char* base_ = lds + (buf_) * (2 * TILE_B) + s_off; ATT_S1(base_, 0, rk0, rv0) ATT_S1(base_, 1, rk1, rv1) ATT_S1(base_, 2, rk2, rv2) ATT_S1(base_, 3, rk3, rv3) } while (0)
    int k_off = ((m * 64 + ln) * LDA + hf * 8) * 2;
    int v_off = TILE_B + (ln * LDA + 4 * hf) * 2;
    int s_off = (lrow * LDA + lcol) * 2;
    asm volatile("" : "+v"(k_off), "+v"(v_off), "+v"(s_off));
    ATT_GLOAD(0); ATT_LSTORE(0);
    __syncthreads();
    int buf = 0;
#pragma unroll 1
    for (int kt = 0; kt < nkt; ++kt) {
        const bool more = (kt + 1 < nkt);
        const char* ks_ = lds + buf * (2 * TILE_B) + k_off;
        const char* vs_ = lds + buf * (2 * TILE_B) + v_off;
        if (kt * 64 <= q0 + 31) {
            f32x16 s[2];
#pragma unroll
            for (int kb = 0; kb < 2; ++kb) {
#pragma unroll
                for (int r = 0; r < 16; ++r) s[kb][r] = 0.f;
#pragma unroll
                for (int ks = 0; ks < 4; ++ks) {
                    const bf16x8 kf = *(const bf16x8*)(ks_ + ((kb * 32) * LDA + ks * 16) * 2);
                    s[kb] = MFMA32(kf, qf[ks], s[kb]);
                }
            }
            const int qpos = q0 + ln;
            if (kt * 64 + 63 > q0) {
#pragma unroll
                for (int kb = 0; kb < 2; ++kb)
#pragma unroll
                    for (int r = 0; r < 16; ++r) {
                        const int key = kt * 64 + kb * 32 + (r & 3) + 8 * (r >> 2) + 4 * hf;
                        if (key > qpos) s[kb][r] = -INFINITY;
                    }
            }
            float mx = s[0][0];
#pragma unroll
            for (int kb = 0; kb < 2; ++kb)
#pragma unroll
                for (int r = 0; r < 16; ++r) mx = fmaxf(mx, s[kb][r]);
            mx = fmaxf(mx, __shfl_xor(mx, 32));
            const float mnew = fmaxf(mrun, mx);
            const float alpha = __builtin_amdgcn_exp2f(mrun - mnew);
            mrun = mnew;
            float rsum = 0.f;
#pragma unroll
            for (int kb = 0; kb < 2; ++kb)
#pragma unroll
                for (int r = 0; r < 16; ++r) { const float p = __builtin_amdgcn_exp2f(s[kb][r] - mnew); s[kb][r] = p; rsum += p; }
            lrun = lrun * alpha + rsum;
#pragma unroll
            for (int d = 0; d < 4; ++d)
#pragma unroll
                for (int r = 0; r < 16; ++r) o[d][r] *= alpha;
            __builtin_amdgcn_sched_barrier(0);
            if (more) ATT_GLOAD(kt + 1);
#pragma unroll
            for (int kb = 0; kb < 2; ++kb)
#pragma unroll
                for (int st = 0; st < 2; ++st) {
                    const uint4 pp = make_uint4(pk2(s[kb][8 * st + 0], s[kb][8 * st + 1]), pk2(s[kb][8 * st + 2], s[kb][8 * st + 3]),
                                                pk2(s[kb][8 * st + 4], s[kb][8 * st + 5]), pk2(s[kb][8 * st + 6], s[kb][8 * st + 7]));
                    const bf16x8 pf = __builtin_bit_cast(bf16x8, pp);
                    const int kc = kb * 32 + 16 * st;
#pragma unroll
                    for (int d = 0; d < 4; ++d) {
                        const uint2 v0 = *(const uint2*)(vs_ + ((d * 32) * LDA + kc) * 2);
                        const uint2 v1 = *(const uint2*)(vs_ + ((d * 32) * LDA + kc + 8) * 2);
                        const bf16x8 vf = __builtin_bit_cast(bf16x8, make_uint4(v0.x, v0.y, v1.x, v1.y));
                        o[d] = MFMA32(vf, pf, o[d]);
                    }
                }
        }
        else if (more) ATT_GLOAD(kt + 1);
        if (more) ATT_LSTORE(buf ^ 1);
        __syncthreads();
        buf ^= 1;
    }
    const float ltot = lrun + __shfl_xor(lrun, 32);
    const float linv = 1.0f / ltot;
    float* ob = (float*)lds;
    int o_off = (m * 64 + qw + ln) * 129 + 4 * hf;
    asm volatile("" : "+v"(o_off));
#pragma unroll
    for (int d = 0; d < 4; ++d)
#pragma unroll
        for (int r = 0; r < 16; ++r) ob[o_off + d * 32 + (r & 3) + 8 * (r >> 2)] = o[d][r] * linv;
    __syncthreads();
#pragma unroll
    for (int it = 0; it < 4; ++it) {
        const int idx = it * NTHREADS + tid;
        const int q = idx >> 4, c0 = (idx & 15) * 8;
        float v[8];
        float ss = 0.f;
        int r_off = q * 129 + c0;
        asm volatile("" : "+v"(r_off));
#pragma unroll
        for (int j = 0; j < 8; ++j) { v[j] = ob[r_off + j] - lam * ob[r_off + 64 * 129 + j]; ss += v[j] * v[j]; }
        ss = row16_sum(ss);
        const float rs = rsqrtf(ss * (1.0f / 128.0f) + 1e-5f) * (1.0f - lam_init);
#pragma unroll
        for (int j = 0; j < 8; ++j) v[j] = v[j] * rs * subln[c0 + j];
        *(uint4*)(am + ((size_t)b * SEQ + qt * 64 + q) * 1024 + h * 128 + c0) = pack8(v);
    }
    __syncthreads();
}

DI void phase_o3(char* lds, const Ctx& P, int li, int layer) {
    s5_scan(P, li);
    float lam;
    {
        const int j = ltid() & 63;
        const float s1 = wave_sum(P.in[I_LQ1][li * 64 + j] * P.in[I_LK1][li * 64 + j]);
        const float s2 = wave_sum(P.in[I_LQ2][li * 64 + j] * P.in[I_LK2][li * 64 + j]);
        const float lam_init0 = 0.8f - 0.6f * __expf(-0.3f * (float)layer);
        lam = __expf(s1) - __expf(s2) + lam_init0;
    }
    const float lam_init = 0.8f - 0.6f * __expf(-0.3f * (float)layer);
    const float* subln = P.in[I_SUBLN] + li * 128;
    for (int item = blockIdx.x; item < 1024; item += gridDim.x) {
        const int bh = item >> 4, pr = item & 15;
        for (int half = 0; half < 2; ++half) attn_item(lds, P, bh >> 2, bh & 3, half ? 31 - pr : pr, lam, lam_init, subln);
    }
}

DI void phase_o4(char* lds, const Ctx& P, int li) {
    const bfr* us5 = (const bfr*)(P.ws + OFF_US5);
    const bfr* xin = (const bfr*)(P.ws + OFF_XIN);
    const bfr* gt = (const bfr*)(P.ws + OFF_S5GT) + (size_t)li * 32 * 512 * 640;
    const float* dsk = P.in[I_S5D] + li * 512;
    bfr* zb = (bfr*)(P.ws + OFF_ZBUF);
    for (int t = blockIdx.x; t < 1024; t += gridDim.x) {
        const int g = t >> 5, mt = (t >> 2) & 7, nt = t & 3;
        const int nloc = 2 * (nt + 1);
        const bfr* ag = us5 + (size_t)g * NTOK * 16;
        const bfr* xg = xin + (size_t)g * 1024 * 128;
        const int tq = ltid();
        const int arow = mt * 128 + (tq >> 3), acol = (tq & 7) * 8;
        auto aptr = [&](int i, int kt) __attribute__((always_inline)) -> const bfr* {
            return (kt < nloc) ? ag + (size_t)(arow + 32 * i) * 512 + kt * 64 + acol
                               : xg + (size_t)(arow + 32 * i) * 128 + (kt - nloc) * 64 + acol;
        };
        const bfr* bg = gt + (size_t)g * 512 * 640 + (size_t)(nt * 128 + (tq >> 3)) * 640 + acol;
        auto bptr = [&](int i, int kt) __attribute__((always_inline)) -> const bfr* {
            return bg + (size_t)(32 * i) * 640 + ((kt < nloc) ? kt : (8 + kt - nloc)) * 64;
        };
        gemm_tile(lds, nloc + 2, aptr, bptr, [&](const float* stg) __attribute__((always_inline)) {
            epi_rows8_pre<uint4>(stg,
                [&](int r, int c0) __attribute__((always_inline)) -> uint4 {
                    const int n = nt * 128 + c0;
                    return *(const uint4*)(ag + ((size_t)(mt * 128 + r) * 32 + (n >> 4)) * 16 + (n & 15)); },
                [&](int r, int c0, const float (&v)[8], const uint4& up) __attribute__((always_inline)) {
                    const int cb = mt * 128 + r;
                    const int n = nt * 128 + c0, tt = n >> 4, c1 = n & 15;
                    const size_t tok = (size_t)cb * 32 + tt;
                    float uu[8], z[8];
                    unpack8(up, uu);
#pragma unroll
                    for (int j = 0; j < 8; ++j) {
                        const float y = v[j] + dsk[g * 16 + c1 + j] * uu[j];
                        const float inner = 0.7978845608028654f * (y + 0.044715f * y * y * y);
                        z[j] = 0.5f * y * (1.0f + ftanh(inner));
                    }
                    *(uint4*)(zb + tok * 512 + g * 16 + c1) = pack8(z);
                });
        });
    }
}

DI void phase_o5(char* lds, const Ctx& P, int li) {
    const bfr* zb = (const bfr*)(P.ws + OFF_ZBUF);
    const bfr* w = (const bfr*)(P.ws + OFF_GLUT) + (size_t)li * 512 * 512;
    bfr* am = (bfr*)(P.ws + OFF_AMIX);
    for (int t = blockIdx.x; t < 1024; t += gridDim.x) {
        const int mt = t >> 2, nt = t & 3;
        RowLoader A(zb, mt * 128, 512), B(w, nt * 128, 512);
        gemm_tile(lds, 8, A, B, [&](const float* stg) __attribute__((always_inline)) {
            epi_rows8_pre<uint4>(stg,
                [&](int r, int c0) __attribute__((always_inline)) -> uint4 { return *(const uint4*)(zb + (size_t)(mt * 128 + r) * 512 + nt * 128 + c0); },
                [&](int r, int c0, const float (&v)[8], const uint4& zp) __attribute__((always_inline)) {
                    float zz[8], o[8];
                    unpack8(zp, zz);
#pragma unroll
                    for (int j = 0; j < 8; ++j) o[j] = zz[j] * sigmoidf_(v[j]);
                    *(uint4*)(am + (size_t)(mt * 128 + r) * 1024 + 512 + nt * 128 + c0) = pack8(o);
                });
        });
    }
}
DI void phase_router(char* lds, const Ctx& P, int layer) {
    const float* x = P.out;
    bfr* hb = (bfr*)(P.ws + OFF_HB);
    bfr* hlo = (bfr*)(P.ws + OFF_HLO);
    const bfr* rhi = (const bfr*)(P.ws + OFF_RHI) + (size_t)layer * 128 * 1024;
    const bfr* rlo = (const bfr*)(P.ws + OFF_RLO) + (size_t)layer * 128 * 1024;
    int* gcnt = (int*)(P.ws + OFF_CNT) + layer * 64;
    int* stok = (int*)(P.ws + OFF_TOK);
    float* sgate = (float*)(P.ws + OFF_GATE);
    int* lcnt = (int*)(lds + LDS_AUX);
    int* lbase = lcnt + 64;
    const float* bg = P.in[I_MBG] + layer * 4;
    const float* be = P.in[I_MBE] + layer * 32;
    const int tid = ltid();
    for (int u = blockIdx.x; u < 256; u += gridDim.x) {
        const int m0 = u * 128;
        norm_rows(x, P.in[I_NFFN] + (size_t)layer * DM, hb, hlo, nullptr, m0, 128);
        __syncthreads();
        const size_t roff = (size_t)(m0 + (tid >> 3)) * 1024 + (tid & 7) * 8;
        const size_t boff = (size_t)(tid >> 3) * 1024 + (tid & 7) * 8;
        auto aptr = [&](int i, int kt) __attribute__((always_inline)) -> const bfr* { return (kt < 32 ? hb : hlo) + roff + (size_t)(32 * i) * 1024 + (kt & 15) * 64; };
        auto bptr = [&](int i, int kt) __attribute__((always_inline)) -> const bfr* { return ((kt >= 16 && kt < 32) ? rlo : rhi) + boff + (size_t)(32 * i) * 1024 + (kt & 15) * 64; };
        gemm_tile(lds, 48, aptr, bptr, [&](const float* stg) __attribute__((always_inline)) {
            if (tid < 64) lcnt[tid] = 0;
            __syncthreads();
            int seg0 = 0, seg1 = 0, p0 = 0, p1 = 0;
            float g0 = 0.f, g1 = 0.f;
            if (tid < 128) {
                const float* row = stg + tid * STG_LD;
                float gl[4];
#pragma unroll
                for (int j = 0; j < 4; ++j) gl[j] = row[32 + j] + bg[j];
                int gt = 0; float gm = gl[0];
#pragma unroll
                for (int j = 1; j < 4; ++j) if (gl[j] > gm) { gm = gl[j]; gt = j; }
                float gs = 0.f;
#pragma unroll
                for (int j = 0; j < 4; ++j) gs += __expf(gl[j] - gm);
                const float gw = 1.0f / gs;
                float l1 = -INFINITY, l2 = -INFINITY; int j1 = 0, j2 = 0;
                for (int j = 0; j < 8; ++j) {
                    const float v = row[gt * 8 + j] + be[gt * 8 + j];
                    if (v > l1) { l2 = l1; j2 = j1; l1 = v; j1 = j; }
                    else if (v > l2) { l2 = v; j2 = j; }
                }
                const float w1 = 1.0f / (1.0f + __expf(l2 - l1));
                g0 = gw * w1; g1 = gw * (1.0f - w1);
                seg0 = gt * 8 + j1; seg1 = 32 + gt * 8 + j2;
                p0 = atomicAdd(&lcnt[seg0], 1);
                p1 = atomicAdd(&lcnt[seg1], 1);
            }
            __syncthreads();
            if (tid < 64) { const int c = lcnt[tid]; lbase[tid] = c ? atomicAdd(&gcnt[tid], c) : 0; }
            __syncthreads();
            if (tid < 128) {
                const int q0 = lbase[seg0] + p0, q1 = lbase[seg1] + p1;
                stok[(size_t)seg0 * NTOK + q0] = m0 + tid; sgate[(size_t)seg0 * NTOK + q0] = g0;
                stok[(size_t)seg1 * NTOK + q1] = m0 + tid; sgate[(size_t)seg1 * NTOK + q1] = g1;
            }
        });
    }
}

DI void moe_tables(char* lds, const Ctx& P, int layer) {
    int* cnt = (int*)(lds + LDS_AUX); int* rb0 = cnt + 64; int* hoff = rb0 + 65;
    const int* gcnt = (const int*)(P.ws + OFF_CNT) + layer * 64;
    const int tid = ltid();
    if (tid < 64) cnt[tid] = gcnt[tid];
    __syncthreads();
    if (tid == 0) {
        int acc = 0;
        for (int s = 0; s < 64; ++s) { rb0[s] = acc; hoff[s] = acc * 128; acc += (cnt[s] + 127) >> 7; }
        rb0[64] = acc;
    }
    __syncthreads();
}
DI int moe_find_seg(const int* rb0, int rbi) { int s = 0; while (rb0[s + 1] <= rbi) ++s; return s; }

DI void phase_moe_up(char* lds, const Ctx& P, int layer) {
    moe_tables(lds, P, layer);
    const int* cnt = (const int*)(lds + LDS_AUX); const int* rb0 = cnt + 64; const int* hoff = rb0 + 65;
    const bfr* hb = (const bfr*)(P.ws + OFF_HB);
    const bfr* wgu = (const bfr*)(P.ws + OFF_MWGU);
    const int* stok = (const int*)(P.ws + OFF_TOK);
    bfr* hid = (bfr*)(P.ws + OFF_HID);
    const int ntiles = rb0[64] * 8;
    for (int t = blockIdx.x; t < ntiles; t += gridDim.x) {
        const int rbi = t >> 3, nt = t & 7;
        const int seg = moe_find_seg(rb0, rbi);
        const int rb = rbi - rb0[seg], e = seg & 31, c = cnt[seg];
        const bfr* ap[4];
        const int tq = ltid();
#pragma unroll
        for (int i = 0; i < 4; ++i) {
            int p = rb * 128 + (tq >> 3) + 32 * i; p = p < c ? p : c - 1;
            ap[i] = hb + (size_t)stok[(size_t)seg * NTOK + p] * 1024 + (tq & 7) * 8;
        }
        auto aptr = [&](int i, int kt) __attribute__((always_inline)) -> const bfr* { return ap[i] + kt * 64; };
        RowLoader B(wgu + (size_t)e * 1024 * 1024, nt * 128, 1024);
        const size_t hrow0 = (size_t)hoff[seg] + rb * 128;
        gemm_tile(lds, 16, aptr, B, [&](const float* stg) __attribute__((always_inline)) {
            epi_rows8(stg, [&](int r, int c0, const float (&v)[8]) __attribute__((always_inline)) {
                float o[4];
#pragma unroll
                for (int j = 0; j < 4; ++j) o[j] = v[j] * sigmoidf_(v[j]) * v[4 + j];
                *(uint2*)(hid + (hrow0 + r) * 512 + ((nt * 128 + c0) >> 1)) = make_uint2(pk2(o[0], o[1]), pk2(o[2], o[3]));
            });
        });
    }
}

DI void phase_moe_down(char* lds, const Ctx& P, int layer, int k, float* x) {
    moe_tables(lds, P, layer);
    const int* cnt = (const int*)(lds + LDS_AUX); const int* rb0 = cnt + 64; const int* hoff = rb0 + 65;
    const bfr* hid = (const bfr*)(P.ws + OFF_HID);
    const bfr* wd = (const bfr*)(P.ws + OFF_MWD);
    const int* stok = (const int*)(P.ws + OFF_TOK);
    const float* sgate = (const float*)(P.ws + OFF_GATE);
    const int rbA = rb0[k * 32], rbB = rb0[k * 32 + 32];
    const int ntiles = (rbB - rbA) * 8;
    for (int t = blockIdx.x; t < ntiles; t += gridDim.x) {
        const int rbi = rbA + (t >> 3), nt = t & 7;
        const int seg = moe_find_seg(rb0, rbi);
        const int rb = rbi - rb0[seg], e = seg & 31, c = cnt[seg];
        RowLoader A(hid, hoff[seg] + rb * 128, 512), B(wd + (size_t)e * 1024 * 512, nt * 128, 512);
        int* ltok = (int*)(lds + LDS_AUX + 1024); float* lgate = (float*)(lds + LDS_AUX + 1536);
        {
            const int tq = ltid();
            if (tq < 128) {
                const int p = rb * 128 + tq;
                ltok[tq] = p < c ? stok[(size_t)seg * NTOK + p] : -1;
                lgate[tq] = p < c ? sgate[(size_t)seg * NTOK + p] : 0.f;
            }
        }
        gemm_tile(lds, 8, A, B, [&](const float* stg) __attribute__((always_inline)) {
            epi_rows8_pre<F8>(stg,
                [&](int r, int c0) __attribute__((always_inline)) -> F8 {
                    int tok = ltok[r]; tok = tok < 0 ? 0 : tok;
                    const float* d = x + (size_t)tok * DM + nt * 128 + c0;
                    F8 o; o.a = *(const float4*)d; o.b = *(const float4*)(d + 4);
                    return o; },
                [&](int r, int c0, const float (&v)[8], const F8& o) __attribute__((always_inline)) {
                    const int tok = ltok[r];
                    if (tok >= 0) {
                        const float gt = lgate[r];
                        float* d = x + (size_t)tok * DM + nt * 128 + c0;
                        *(float4*)d = make_float4(o.a.x + gt * v[0], o.a.y + gt * v[1], o.a.z + gt * v[2], o.a.w + gt * v[3]);
                        *(float4*)(d + 4) = make_float4(o.b.x + gt * v[4], o.b.y + gt * v[5], o.b.z + gt * v[6], o.b.w + gt * v[7]);
                    }
                });
        });
    }
}
constexpr int PH_PER_LAYER = 11;
constexpr int N_PHASES = 1 + 4 * PH_PER_LAYER;

DI void phase_prologue(char* lds, const Ctx& P) {
    for (int u = blockIdx.x; u < 64; u += gridDim.x) s5_tables(lds, P, u >> 5, u & 31);
    unsigned base = 0;
    const int wk = blockIdx.x, nw = gridDim.x;
    for (int i = 0; i < 2; ++i) {
        cvt_matrix(lds, P.in[I_EWIN] + (size_t)i * 1024 * 2304, 1024, 2304, (bfr*)(P.ws + OFF_WINE) + (size_t)i * 2304 * 1024, 1024, 0, wk, nw, base);
        cvt_matrix(lds, P.in[I_EWOUT] + (size_t)i * 1024 * 1024, 1024, 1024, (bfr*)(P.ws + OFF_WOUTE) + (size_t)i * 1024 * 1024, 1024, 0, wk, nw, base);
        cvt_matrix(lds, P.in[I_OWIN] + (size_t)i * 1024 * 2048, 1024, 2048, (bfr*)(P.ws + OFF_WINO) + (size_t)i * 2048 * 1024, 1024, 0, wk, nw, base);
        cvt_matrix(lds, P.in[I_OWOUT] + (size_t)i * 1024 * 1024, 1024, 1024, (bfr*)(P.ws + OFF_WOUTO) + (size_t)i * 1024 * 1024, 1024, 0, wk, nw, base);
        cvt_matrix(lds, P.in[I_W2] + (size_t)i * 64 * 512, 64, 512, (bfr*)(P.ws + OFF_W2T) + (size_t)i * 512 * 64, 64, 0, wk, nw, base);
        cvt_matrix(lds, P.in[I_A2] + (size_t)i * 64 * 512, 64, 512, (bfr*)(P.ws + OFF_A2T) + (size_t)i * 512 * 64, 64, 0, wk, nw, base);
        cvt_matrix(lds, P.in[I_G2] + (size_t)i * 128 * 512, 128, 512, (bfr*)(P.ws + OFF_G2T) + (size_t)i * 512 * 128, 128, 0, wk, nw, base);
        for (int g = 0; g < 4; ++g)
            cvt_matrix(lds, P.in[I_POOLW] + (size_t)(i * 4 + g) * 128 * 128, 128, 128, (bfr*)(P.ws + OFF_POOLT) + (size_t)(i * 4 + g) * 128 * 128, 128, 0, wk, nw, base);
        cvt_matrix(lds, P.in[I_WGLU] + (size_t)i * 512 * 512, 512, 512, (bfr*)(P.ws + OFF_GLUT) + (size_t)i * 512 * 512, 512, 0, wk, nw, base);
    }
    const int gtid = blockIdx.x * NTHREADS + ltid(), gsz = gridDim.x * NTHREADS;
    {
        bfr* rhi = (bfr*)(P.ws + OFF_RHI); bfr* rlo = (bfr*)(P.ws + OFF_RLO);
        for (int idx = gtid; idx < 4 * 128 * 1024; idx += gsz) {
            const int k = idx & 1023, n = (idx >> 10) & 127, l = idx >> 17;
            float w = 0.f;
            if (n < 32) w = P.in[I_MWE][((size_t)l * 1024 + k) * 32 + n];
            else if (n < 36) w = P.in[I_MWG][((size_t)l * 1024 + k) * 4 + (n - 32)];
            const bfr h = f2bf(w);
            rhi[idx] = h; rlo[idx] = f2bf(w - bf2f(h));
        }
    }
    {
        bfr* v12 = (bfr*)(P.ws + OFF_V12T);
        const float* v1 = P.in[I_V1]; const float* v2 = P.in[I_V2];
        for (int idx = gtid; idx < 512 * 512; idx += gsz) {
            const int k = idx & 511, n = idx >> 9;
            float s = 0.f;
            for (int r = 0; r < 32; ++r) s += v1[k * 32 + r] * v2[r * 512 + n];
            v12[idx] = f2bf(s);
        }
    }
    for (int tt = blockIdx.x; tt < 512; tt += gridDim.x)
        norm_rows(P.in[I_X], P.in[I_NMIX], (bfr*)(P.ws + OFF_HB), nullptr, P.out, tt * 64, 64);
}

DI Ctx mkctx(unsigned char* ws, float* out) {
    size_t z = 0;
    asm volatile("" : "+s"(z));
    Ctx c;
    c.in.p = (KArgPtr)__builtin_amdgcn_kernarg_segment_ptr() + z;
    c.ws = ws + z; c.out = (float*)((char*)out + z);
    return c;
}
__global__ void __launch_bounds__(NTHREADS, 2) fwd_kernel(Params PA) {
    extern __shared__ __attribute__((aligned(16))) char lds[];
    if (threadIdx.x == 0) *(uint4*)(lds + LDS_BYTES - 16) = make_uint4(0u, 0u, 0u, 0u);
    __syncthreads();
    XcdBarrier bar = xcd_barrier_post((unsigned*)(PA.ws + OFF_BAR), (volatile LAS unsigned*)(lds + LDS_BYTES - 16));
    const int lo = PA.ph_lo, hi = PA.ph_hi;
#ifndef DUP_PH
#define DUP_PH (-1)
#endif
#define DUPX(k, call) do { call; if (DUP_PH == (k)) { __syncthreads(); call; } } while (0)
#define RUNS(id) ((id) >= lo && (id) < hi)
#define P mkctx(PA.ws, PA.out)
#define SEAM(id) do { if ((id) > lo && (id) < hi) xcd_barrier(bar); } while (0)
    if (RUNS(0)) DUPX(100, phase_prologue(lds, P));
    for (int layer = 0; layer < 4; ++layer) {
        const int base = 1 + layer * PH_PER_LAYER;
        const int li = layer >> 1;
        if ((layer & 1) == 0) {
            SEAM(base + 0); if (RUNS(base + 0)) DUPX(0, phase_e1(lds, P, li));
            SEAM(base + 1); if (RUNS(base + 1)) DUPX(1, phase_e2a(P, li));
            SEAM(base + 2); if (RUNS(base + 2)) DUPX(2, phase_e2b(lds, P, li));
            SEAM(base + 3); if (RUNS(base + 3)) DUPX(3, phase_e3(lds, P, li));
            SEAM(base + 4); if (RUNS(base + 4)) DUPX(4, phase_e4(P, li));
            SEAM(base + 5); if (RUNS(base + 5)) { phase_wout(lds, P, (const bfr*)(P.ws + OFF_WOUTE) + (size_t)li * 1024 * 1024, P.out); if (DUP_PH == 5) phase_wout(lds, P, (const bfr*)(P.ws + OFF_WOUTE) + (size_t)li * 1024 * 1024, (float*)(P.ws + OFF_EV)); }
        } else {
            SEAM(base + 0); if (RUNS(base + 0)) DUPX(10, phase_o1(lds, P, li));
            SEAM(base + 1); if (RUNS(base + 1)) DUPX(11, phase_o2(lds, P, li));
            SEAM(base + 2); if (RUNS(base + 2)) DUPX(12, phase_o3(lds, P, li, layer));
            SEAM(base + 3); if (RUNS(base + 3)) DUPX(13, phase_o4(lds, P, li));
            SEAM(base + 4); if (RUNS(base + 4)) DUPX(14, phase_o5(lds, P, li));
            SEAM(base + 5); if (RUNS(base + 5)) { phase_wout(lds, P, (const bfr*)(P.ws + OFF_WOUTO) + (size_t)li * 1024 * 1024, P.out); if (DUP_PH == 5) phase_wout(lds, P, (const bfr*)(P.ws + OFF_WOUTO) + (size_t)li * 1024 * 1024, (float*)(P.ws + OFF_EV)); }
        }
        SEAM(base + 6);
        if (RUNS(base + 6)) {
            phase_router(lds, P, layer);
            const bool split = gridDim.x >= 512;
            DUPX(6, moe_convert(lds, P, layer, split ? (int)blockIdx.x - 256 : (int)blockIdx.x, split ? (int)gridDim.x - 256 : (int)gridDim.x));
        }
        SEAM(base + 7); if (RUNS(base + 7)) DUPX(7, phase_moe_up(lds, P, layer));
        SEAM(base + 8); if (RUNS(base + 8)) { phase_moe_down(lds, P, layer, 0, P.out); if (DUP_PH == 8) phase_moe_down(lds, P, layer, 0, (float*)(P.ws + OFF_EV)); }
        SEAM(base + 9); if (RUNS(base + 9)) phase_moe_down(lds, P, layer, 1, P.out);
        SEAM(base + 10);
        if (RUNS(base + 10) && layer < 3) {
            for (int rep = 0; rep < (DUP_PH == 20 ? 2 : 1); ++rep)
            for (int tt = blockIdx.x; tt < 512; tt += gridDim.x)
                norm_rows(P.out, P.in[I_NMIX] + (size_t)(layer + 1) * DM, (bfr*)(P.ws + OFF_HB), nullptr, nullptr, tt * 64, 64);
        }
    }
#undef P
#undef RUNS
#undef SEAM
}

#ifndef N_LAUNCH_SPLIT
#define N_LAUNCH_SPLIT 0
#endif
extern "C" void kernel_launch(void* const* d_in, const int* in_sizes, int n_in, void* d_out, int out_size, void* d_ws, size_t ws_size, hipStream_t stream) {
    static int grid = 0;
    if (grid == 0) {
        if (n_in != N_INPUTS || out_size != NTOK * DM || ws_size < WS_NEEDED) {
            fprintf(stderr, "kernel_launch: unexpected shapes: n_in %d out %d ws %zu (need %zu)\n", n_in, out_size, ws_size, (size_t)WS_NEEDED);
            grid = -1; return;
        }
        int dev = 0, cus = 0, per_cu = 0;
        (void)hipGetDevice(&dev);
        (void)hipDeviceGetAttribute(&cus, hipDeviceAttributeMultiprocessorCount, dev);
        if (hipFuncSetAttribute((const void*)fwd_kernel, hipFuncAttributeMaxDynamicSharedMemorySize, LDS_BYTES) != hipSuccess) { fprintf(stderr, "kernel_launch: hipFuncSetAttribute failed\n"); grid = -1; return; }
        if (hipOccupancyMaxActiveBlocksPerMultiprocessor(&per_cu, (const void*)fwd_kernel, NTHREADS, LDS_BYTES) != hipSuccess) per_cu = 1;
        (void)hipGetLastError();
        if (per_cu < 1) per_cu = 1;
        if (per_cu > 2) per_cu = 2;
        if (cus <= 0) cus = 256;
        grid = cus * per_cu;
    }
    if (grid < 0) return;
    (void)hipMemsetAsync(d_ws, 0, OFF_ZERO_END, stream);
    Params p{};
    for (int i = 0; i < N_INPUTS; ++i) p.in[i] = (const float*)d_in[i];
    p.out = (float*)d_out; p.ws = (unsigned char*)d_ws;
#if N_LAUNCH_SPLIT
    for (int ph = 0; ph < N_PHASES - 1; ++ph) {
        p.ph_lo = ph; p.ph_hi = ph + 1;
        hipLaunchKernelGGL(fwd_kernel, dim3(grid), dim3(NTHREADS), LDS_BYTES, stream, p);
    }
#else
    p.ph_lo = 0; p.ph_hi = N_PHASES;
    hipLaunchKernelGGL(fwd_kernel, dim3(grid), dim3(NTHREADS), LDS_BYTES, stream, p);
#endif
}
```

```cpp
#include <hip/hip_runtime.h>
#include <stdint.h>
#include <stdio.h>

typedef unsigned short bfr;
typedef __attribute__((ext_vector_type(8))) short bf16x8;
typedef __attribute__((ext_vector_type(16))) float f32x16;
typedef __attribute__((ext_vector_type(2))) __bf16 bf16x2_t;
#define DI __device__ __forceinline__
#define MFMA32(a, b, c) __builtin_amdgcn_mfma_f32_32x32x16_bf16((a), (b), (c), 0, 0, 0)

constexpr int NTOK = 32768, DM = 1024, SEQ = 2048, NB = 16;
constexpr int EVEN_IN = 2304, ODD_IN = 2048;
constexpr int NTHREADS = 256;
constexpr int LDS_BYTES = 81920;

enum { I_X = 0, I_NMIX, I_NFFN, I_EWIN, I_MU, I_W0, I_W2, I_A0, I_A2, I_G2, I_KK, I_KA, I_RK, I_LNG, I_LNB, I_V0, I_V1, I_V2,
       I_POOLW, I_POOLS, I_EWOUT, I_OWIN, I_QN, I_KN, I_LQ1, I_LK1, I_LQ2, I_LK2, I_SUBLN, I_ARE, I_AIM, I_LSTEP, I_BRE, I_BIM,
       I_CRE, I_CIM, I_S5D, I_WGLU, I_OWOUT, I_MWG, I_MBG, I_MWE, I_MBE, I_MWGATE, I_MWUP, I_MWDOWN, N_INPUTS };

constexpr size_t al256(size_t x) { return (x + 255) & ~(size_t)255; }
constexpr size_t OFF_BAR   = 0;
constexpr size_t OFF_CNT   = 16384;
constexpr size_t OFF_ZERO_END = 32768;
constexpr size_t OFF_WINE  = 65536;
constexpr size_t OFF_WOUTE = OFF_WINE  + (size_t)2 * 2304 * 1024 * 2;
constexpr size_t OFF_WINO  = OFF_WOUTE + (size_t)2 * 1024 * 1024 * 2;
constexpr size_t OFF_WOUTO = OFF_WINO  + (size_t)2 * 2048 * 1024 * 2;
constexpr size_t OFF_W2T   = OFF_WOUTO + (size_t)2 * 1024 * 1024 * 2;
constexpr size_t OFF_A2T   = OFF_W2T   + (size_t)2 * 512 * 64 * 2;
constexpr size_t OFF_G2T   = OFF_A2T   + (size_t)2 * 512 * 64 * 2;
constexpr size_t OFF_V12T  = OFF_G2T   + (size_t)2 * 512 * 128 * 2;
constexpr size_t OFF_POOLT = OFF_V12T  + (size_t)512 * 512 * 2;
constexpr size_t OFF_GLUT  = OFF_POOLT + (size_t)2 * 4 * 128 * 128 * 2;
constexpr size_t OFF_RHI   = OFF_GLUT  + (size_t)2 * 512 * 512 * 2;
constexpr size_t OFF_RLO   = OFF_RHI   + (size_t)4 * 128 * 1024 * 2;
constexpr size_t OFF_S5GT  = OFF_RLO   + (size_t)4 * 128 * 1024 * 2;
constexpr size_t OFF_S5BL  = OFF_S5GT  + (size_t)2 * 32 * 512 * 640 * 2;
constexpr size_t OFF_S5L32 = OFF_S5BL  + (size_t)2 * 32 * 128 * 512 * 2;
constexpr size_t OFF_MWGU  = al256(OFF_S5L32 + (size_t)2 * 32 * 64 * 2 * 4);
constexpr size_t OFF_MWD   = OFF_MWGU  + (size_t)32 * 1024 * 1024 * 2;
constexpr size_t OFF_HB    = OFF_MWD   + (size_t)32 * 1024 * 512 * 2;
constexpr size_t OFF_U     = OFF_HB    + (size_t)NTOK * 1024 * 2;
constexpr size_t OFF_US5   = OFF_U     + (size_t)NTOK * 1024 * 2;
constexpr size_t OFF_AMIX  = OFF_U     + (size_t)NTOK * 2304 * 2;
constexpr size_t OFF_VFIRST= OFF_AMIX  + (size_t)NTOK * 1024 * 2;
constexpr size_t OFF_TOK   = OFF_VFIRST+ (size_t)NTOK * 512 * 2;
constexpr size_t OFF_GATE  = OFF_TOK   + (size_t)64 * NTOK * 4;
constexpr size_t OFF_HID   = OFF_GATE  + (size_t)64 * NTOK * 4;
constexpr size_t OFF_HLO   = OFF_HID;
constexpr size_t OFF_EV    = OFF_HID   + (size_t)73728 * 512 * 2;
constexpr size_t OFF_S     = OFF_EV;
constexpr size_t OFF_MV2   = OFF_S     + (size_t)NTOK * 256 * 2;
constexpr size_t OFF_DLOG  = OFF_MV2   + (size_t)NTOK * 512 * 2;
constexpr size_t OFF_ABUF  = OFF_DLOG  + (size_t)NTOK * 512 * 4;
constexpr size_t OFF_GBUF  = OFF_ABUF  + (size_t)NTOK * 512 * 2;
constexpr size_t OFF_VGATE = OFF_GBUF  + (size_t)NTOK * 512 * 2;
constexpr size_t OFF_Y     = OFF_VGATE + (size_t)NTOK * 512 * 2;
constexpr size_t OFF_DPOOL = OFF_Y;
constexpr size_t OFF_BONUS = OFF_Y     + (size_t)NTOK * 512 * 4;
constexpr size_t OFF_EV_END= OFF_BONUS + (size_t)NTOK * 512 * 4;
constexpr size_t OFF_QN    = OFF_EV;
constexpr size_t OFF_KN    = OFF_QN    + (size_t)NTOK * 512 * 2;
constexpr size_t OFF_VT    = OFF_KN    + (size_t)NTOK * 512 * 2;
constexpr size_t OFF_XLOC  = OFF_VT    + (size_t)NTOK * 512 * 2;
constexpr size_t OFF_XIN   = OFF_XLOC  + (size_t)32 * 1024 * 128 * 4;
constexpr size_t OFF_ZBUF  = OFF_XIN   + (size_t)32 * 1024 * 128 * 2;
constexpr size_t OFF_OD_END= OFF_ZBUF  + (size_t)NTOK * 512 * 2;
constexpr size_t WS_NEEDED = OFF_EV_END > OFF_OD_END ? OFF_EV_END : OFF_OD_END;

struct Params {
    const float* in[N_INPUTS];
    float* out;
    unsigned char* ws;
    int ph_lo, ph_hi;
};
typedef const __attribute__((address_space(4))) char* KArgPtr;
struct InTab {
    KArgPtr p;
    DI const float* operator[](int i) const {
        const float* q = *(const float* const __attribute__((address_space(4)))*)(p + 8 * i);
        return (const float*)(const __attribute__((address_space(1))) float*)q;
    }
};
struct Ctx { InTab in; unsigned char* ws; float* out; };

DI unsigned pk2(float a, float b) { bf16x2_t v; v[0] = (__bf16)a; v[1] = (__bf16)b; return __builtin_bit_cast(unsigned, v); }
DI bfr f2bf(float a) { return (bfr)(pk2(a, 0.f) & 0xffffu); }
DI float bf2f(bfr b) { return __uint_as_float(((unsigned)b) << 16); }
DI float bflo(unsigned u) { return __uint_as_float(u << 16); }
DI float bfhi(unsigned u) { return __uint_as_float(u & 0xffff0000u); }
DI uint4 pack8(const float (&v)[8]) { return make_uint4(pk2(v[0], v[1]), pk2(v[2], v[3]), pk2(v[4], v[5]), pk2(v[6], v[7])); }
DI void unpack8(uint4 u, float (&v)[8]) { v[0] = bflo(u.x); v[1] = bfhi(u.x); v[2] = bflo(u.y); v[3] = bfhi(u.y); v[4] = bflo(u.z); v[5] = bfhi(u.z); v[6] = bflo(u.w); v[7] = bfhi(u.w); }
DI float frcp(float x) { return __builtin_amdgcn_rcpf(x); }
DI float fexp(float x) { return __builtin_amdgcn_exp2f(x * 1.4426950408889634f); }
DI float sigmoidf_(float x) { return frcp(1.0f + fexp(-x)); }
DI float ftanh(float x) { return 2.0f * frcp(1.0f + fexp(-2.0f * x)) - 1.0f; }
DI float fsoftplus(float z) { return z > 20.0f ? z : __logf(1.0f + fexp(z)); }
template <int CTRL> DI float dpp_f(float x) { return __builtin_bit_cast(float, __builtin_amdgcn_update_dpp(0, __builtin_bit_cast(int, x), CTRL, 0xf, 0xf, false)); }
DI float row16_sum(float s) {
    s += dpp_f<0x128>(s); s += dpp_f<0x124>(s); s += dpp_f<0x122>(s); s += dpp_f<0x121>(s); return s; }
DI int ltid() { int t = threadIdx.x; asm volatile("" : "+v"(t)); return t; }
DI float wave_sum(float s) { s = row16_sum(s); s += __shfl_xor(s, 16); s += __shfl_xor(s, 32); return s; }
#define XB_TMO      128
#define XB_XCNT(j)  (256  + 64 * (j))
#define XB_XSUB(j)  (1280 + 64 * (j))
#define XB_XGEN(j)  (2304 + 64 * (j))
#define XB_TOP      3328
#define XB_TOPGEN   3392
#define XCD_BAR_WORDS 3456
#define XB_SPIN_CAP (1u << 18)
#define LAS __attribute__((address_space(3)))

__device__ __forceinline__ unsigned xb_ld(unsigned* p)              { return __hip_atomic_load(p, __ATOMIC_RELAXED, __HIP_MEMORY_SCOPE_AGENT); }
__device__ __forceinline__ unsigned xb_add(unsigned* p, unsigned v) { return __hip_atomic_fetch_add(p, v, __ATOMIC_RELAXED, __HIP_MEMORY_SCOPE_AGENT); }
__device__ __forceinline__ unsigned xb_xcc_id() { return (unsigned)__builtin_amdgcn_s_getreg((3 << 11) | 20) & 0xFu; }
#define XB_SPIN(cond, bar) do { unsigned _sp = 0; while (cond) { __builtin_amdgcn_s_sleep(1); \
    if ((++_sp & 255u) == 0u) { if (xb_ld(&(bar)[XB_TMO])) break; if (_sp > XB_SPIN_CAP) { atomicAdd(&(bar)[XB_TMO], 1u); break; } } } } while (0)

struct XcdBarrier {
    unsigned* bar; unsigned x;
    volatile LAS unsigned* st;
};
__device__ __forceinline__ XcdBarrier xcd_barrier_post(unsigned* bar, volatile LAS unsigned* st) {
    XcdBarrier b; b.bar = bar; b.x = xb_xcc_id(); b.st = st;
    if (threadIdx.x == 0) (void)xb_add(&bar[XB_XCNT(b.x)], 1u);
    return b;
}
__device__ __forceinline__ void xcd_barrier_complete(unsigned* bar, unsigned x, unsigned& nloc, unsigned& nx) {
    const unsigned G = gridDim.x * gridDim.y * gridDim.z;
    unsigned sum, cnt, mine, sp = 0u;
    for (;;) {
        sum = 0u; cnt = 0u; mine = 0u;
#pragma unroll
        for (unsigned j = 0; j < 16; ++j) { const unsigned c = xb_ld(&bar[XB_XCNT(j)]); sum += c; cnt += (c > 0u) ? 1u : 0u; mine = (j == x) ? c : mine; }
        if (sum == G) break;
        __builtin_amdgcn_s_sleep(1);
        if ((++sp & 255u) == 0u) { if (xb_ld(&bar[XB_TMO])) break; if (sp > XB_SPIN_CAP) { atomicAdd(&bar[XB_TMO], 1u); break; } }
    }
    nloc = mine > 0u ? mine : 1u; nx = cnt > 0u ? cnt : 1u;
}
__device__ __forceinline__ void xcd_barrier(const XcdBarrier& b) {
    asm volatile("s_waitcnt vmcnt(0)" ::: "memory");
    __syncthreads();
    if (threadIdx.x == 0) {
        unsigned* bar = b.bar;
        __builtin_amdgcn_s_waitcnt(0);
        unsigned nloc = b.st[0], nx = b.st[1];
        if (nloc == 0u) { xcd_barrier_complete(bar, b.x, nloc, nx); b.st[0] = nloc; b.st[1] = nx; }
        const unsigned old = xb_add(&bar[XB_XSUB(b.x)], 1u);
        const unsigned gen = old / nloc;
        if (old + 1u == (gen + 1u) * nloc) {
            __builtin_amdgcn_fence(__ATOMIC_RELEASE, "agent");
            asm volatile("s_waitcnt vmcnt(0)" ::: "memory");
            const unsigned og = xb_add(&bar[XB_TOP], 1u);
            const unsigned tg = og / nx;
            if (og + 1u == (tg + 1u) * nx) xb_add(&bar[XB_TOPGEN], 1u);
            else XB_SPIN(xb_ld(&bar[XB_TOPGEN]) == tg, bar);
            __builtin_amdgcn_fence(__ATOMIC_ACQUIRE, "agent");
            xb_add(&bar[XB_XGEN(b.x)], 1u);
            asm volatile("s_waitcnt vmcnt(0)" ::: "memory");
        } else {
            XB_SPIN(xb_ld(&bar[XB_XGEN(b.x)]) == gen, bar);
            __builtin_amdgcn_fence(__ATOMIC_ACQUIRE, "agent");
            asm volatile("s_waitcnt vmcnt(0)" ::: "memory");
        }
    }
    __syncthreads();
}

constexpr int LDA = 72;
constexpr int TILE_B = 128 * LDA * 2;
constexpr int GT_TILE = 128 * 128;
constexpr int STG_LD = 132;
constexpr int LDS_AUX = 73728;
typedef const __attribute__((address_space(1))) unsigned* GPtrU;
typedef __attribute__((address_space(3))) unsigned* LPtrU;
DI int gt_lcol(int t) { return (((t & 7) ^ ((t >> 4) & 7)) * 8); }

template <class AF, class BF, class EF>
DI void gemm_tile(char* lds, int nk, AF aptr, BF bptr, EF epi) {
    const int tid = ltid(), lane = tid & 63, wave = tid >> 6;
    const int wr = wave >> 1, wc = wave & 1;
    f32x16 acc00, acc01, acc10, acc11;
#pragma unroll
    for (int r = 0; r < 16; ++r) { acc00[r] = 0.f; acc01[r] = 0.f; acc10[r] = 0.f; acc11[r] = 0.f; }
#define GT_DMA(kt_, base_) do { char* db_ = (base_) + tid * 16; _Pragma("unroll") for (int i_ = 0; i_ < 4; ++i_) { \
        __builtin_amdgcn_global_load_lds((GPtrU)aptr(i_, kt_), (LPtrU)(db_ + i_ * 4096), 16, 0, 0); \
        __builtin_amdgcn_global_load_lds((GPtrU)bptr(i_, kt_), (LPtrU)(db_ + GT_TILE + i_ * 4096), 16, 0, 0); } } while (0)
#define GT_FRAG(cb_, off_) (*(const bf16x8*)((cb_) + (off_)))
#define GT_COMPUTE(base_) do { const char* cb_ = (base_); \
        { const bf16x8 a0 = GT_FRAG(cb_, ao0), a1 = GT_FRAG(cb_, ao0 + 4096), b0 = GT_FRAG(cb_, bo0), b1 = GT_FRAG(cb_, bo0 + 4096); \
          acc00 = MFMA32(a0, b0, acc00); acc01 = MFMA32(a0, b1, acc01); acc10 = MFMA32(a1, b0, acc10); acc11 = MFMA32(a1, b1, acc11); } \
        { const bf16x8 a0 = GT_FRAG(cb_, ao1), a1 = GT_FRAG(cb_, ao1 + 4096), b0 = GT_FRAG(cb_, bo1), b1 = GT_FRAG(cb_, bo1 + 4096); \
          acc00 = MFMA32(a0, b0, acc00); acc01 = MFMA32(a0, b1, acc01); acc10 = MFMA32(a1, b0, acc10); acc11 = MFMA32(a1, b1, acc11); } \
        { const bf16x8 a0 = GT_FRAG(cb_, ao2), a1 = GT_FRAG(cb_, ao2 + 4096), b0 = GT_FRAG(cb_, bo2), b1 = GT_FRAG(cb_, bo2 + 4096); \
          acc00 = MFMA32(a0, b0, acc00); acc01 = MFMA32(a0, b1, acc01); acc10 = MFMA32(a1, b0, acc10); acc11 = MFMA32(a1, b1, acc11); } \
        { const bf16x8 a0 = GT_FRAG(cb_, ao3), a1 = GT_FRAG(cb_, ao3 + 4096), b0 = GT_FRAG(cb_, bo3), b1 = GT_FRAG(cb_, bo3 + 4096); \
          acc00 = MFMA32(a0, b0, acc00); acc01 = MFMA32(a0, b1, acc01); acc10 = MFMA32(a1, b0, acc10); acc11 = MFMA32(a1, b1, acc11); } } while (0)
    const int ln = lane & 31, hf = lane >> 5, sw = (ln >> 1) & 7;
    int ao0 = wr * 8192 + ln * 128 + ((0 + hf) ^ sw) * 16, ao1 = wr * 8192 + ln * 128 + ((2 + hf) ^ sw) * 16;
    int ao2 = wr * 8192 + ln * 128 + ((4 + hf) ^ sw) * 16, ao3 = wr * 8192 + ln * 128 + ((6 + hf) ^ sw) * 16;
    int bo0 = GT_TILE + wc * 8192 + ln * 128 + ((0 + hf) ^ sw) * 16, bo1 = GT_TILE + wc * 8192 + ln * 128 + ((2 + hf) ^ sw) * 16;
    int bo2 = GT_TILE + wc * 8192 + ln * 128 + ((4 + hf) ^ sw) * 16, bo3 = GT_TILE + wc * 8192 + ln * 128 + ((6 + hf) ^ sw) * 16;
    asm volatile("" : "+v"(ao0), "+v"(ao1), "+v"(ao2), "+v"(ao3), "+v"(bo0), "+v"(bo1), "+v"(bo2), "+v"(bo3));
    GT_DMA(0, lds);
    asm volatile("s_waitcnt vmcnt(0)" ::: "memory");
    __syncthreads();
    int buf = 0;
#pragma unroll 1
    for (int kt = 0; kt < nk - 1; ++kt) {
        GT_DMA(kt + 1, lds + (buf ^ 1) * (2 * GT_TILE));
        GT_COMPUTE(lds + buf * (2 * GT_TILE));
        asm volatile("s_waitcnt vmcnt(0)" ::: "memory");
        __syncthreads();
        buf ^= 1;
    }
    GT_COMPUTE(lds + buf * (2 * GT_TILE));
    __syncthreads();
#undef GT_DMA
#undef GT_FRAG
#undef GT_COMPUTE
    float* stg = (float*)lds;
    int w_off = (wr * 64 + 4 * (lane >> 5)) * STG_LD + wc * 64 + (lane & 31);
    asm volatile("" : "+v"(w_off));
#pragma unroll
    for (int r = 0; r < 16; ++r) {
        const int ro = ((r & 3) + 8 * (r >> 2)) * STG_LD;
        stg[w_off + ro] = acc00[r];
        stg[w_off + ro + 32] = acc01[r];
        stg[w_off + ro + 32 * STG_LD] = acc10[r];
        stg[w_off + ro + 32 * STG_LD + 32] = acc11[r];
    }
    __syncthreads();
    epi((const float*)stg);
    __syncthreads();
}
template <class F> DI void epi_rows8(const float* stg, F f) {
    const int tid0 = ltid();
#pragma unroll
    for (int it = 0; it < 8; ++it) {
        const int idx = it * NTHREADS + tid0;
        const int r = idx >> 4, c0 = (idx & 15) * 8;
        const float4 p = *(const float4*)(stg + r * STG_LD + c0);
        const float4 q = *(const float4*)(stg + r * STG_LD + c0 + 4);
        const float v[8] = {p.x, p.y, p.z, p.w, q.x, q.y, q.z, q.w};
        f(r, c0, v);
    }
}
template <class T, class L, class F> DI void epi_rows8_pre(const float* stg, L loadf, F f) {
    const int tid0 = ltid();
    T pre[8];
#pragma unroll
    for (int it = 0; it < 8; ++it) { const int idx = it * NTHREADS + tid0; pre[it] = loadf(idx >> 4, (idx & 15) * 8); }
#pragma unroll
    for (int it = 0; it < 8; ++it) {
        const int idx = it * NTHREADS + tid0;
        const int r = idx >> 4, c0 = (idx & 15) * 8;
        const float4 p = *(const float4*)(stg + r * STG_LD + c0);
        const float4 q = *(const float4*)(stg + r * STG_LD + c0 + 4);
        const float v[8] = {p.x, p.y, p.z, p.w, q.x, q.y, q.z, q.w};
        f(r, c0, v, pre[it]);
    }
}
struct F8 { float4 a, b; };
DI void tile_remap(int L, int nM, int nN, int& pm, int& pn) {
    const int ntiles = nM * nN;
    int w = L;
    if ((ntiles & 7) == 0) w = (L & 7) * (ntiles >> 3) + (L >> 3);
    const int nig = 8 * nN, gid = w / nig, fm = gid * 8, rem = w - gid * nig;
    const int gsz = (nM - fm) < 8 ? (nM - fm) : 8;
    pm = fm + rem % gsz; pn = rem / gsz;
}
struct RowLoader {
    const bfr* p; size_t ld;
    DI RowLoader(const bfr* base, int row0, size_t ld_) : ld(ld_) { const int t = ltid(); p = base + (size_t)(row0 + (t >> 3)) * ld_ + gt_lcol(t); }
    DI const bfr* operator()(int i, int kt) const { return p + (size_t)(32 * i) * ld + kt * 64; }
};
DI int cvt_rowmap(int n, int mode) { return mode == 0 ? n : ((n >> 2) * 8 + (n & 3) + (mode == 2 ? 4 : 0)); }
DI void cvt_tile(char* lds, const float* __restrict__ src, int N, bfr* __restrict__ dst, int ldd, int k0, int n0, int mode) {
    float* t = (float*)lds;
    const int tid = ltid();
    const int r = tid >> 4, c = (tid & 15) * 4;
#pragma unroll
    for (int i = 0; i < 4; ++i) {
        const float4 v = *(const float4*)(src + (size_t)(k0 + r + 16 * i) * N + n0 + c);
        float* d = t + (r + 16 * i) * 65 + c;
        d[0] = v.x; d[1] = v.y; d[2] = v.z; d[3] = v.w;
    }
    __syncthreads();
#pragma unroll
    for (int i = 0; i < 2; ++i) {
        const int idx = tid + i * 256;
        const int n = idx & 63, kg = idx >> 6;
        float v[8];
#pragma unroll
        for (int j = 0; j < 8; ++j) v[j] = t[(kg * 8 + j) * 65 + n];
        *(uint4*)(dst + (size_t)cvt_rowmap(n0 + n, mode) * ldd + k0 + kg * 8) = pack8(v);
    }
    __syncthreads();
}
DI void cvt_matrix(char* lds, const float* src, int K, int N, bfr* dst, int ldd, int mode, int worker, int nworkers, unsigned& base) {
    if (worker < 0) return;
    const int ntn = N >> 6, ntiles = (K >> 6) * ntn;
    int t0 = (int)(((unsigned)worker + (unsigned)nworkers - (base % (unsigned)nworkers)) % (unsigned)nworkers);
    for (int t = t0; t < ntiles; t += nworkers) cvt_tile(lds, src, N, dst, ldd, (t / ntn) * 64, (t % ntn) * 64, mode);
    base += (unsigned)ntiles;
}
DI void moe_convert(char* lds, const Ctx& P, int layer, int worker, int nworkers) {
    unsigned base = 0;
    bfr* wgu = (bfr*)(P.ws + OFF_MWGU); bfr* wd = (bfr*)(P.ws + OFF_MWD);
    for (int e = 0; e < 32; ++e) {
        const size_t we = (size_t)(layer * 32 + e);
        cvt_matrix(lds, P.in[I_MWGATE] + we * 1024 * 512, 1024, 512, wgu + (size_t)e * 1024 * 1024, 1024, 1, worker, nworkers, base);
        cvt_matrix(lds, P.in[I_MWUP]   + we * 1024 * 512, 1024, 512, wgu + (size_t)e * 1024 * 1024, 1024, 2, worker, nworkers, base);
        cvt_matrix(lds, P.in[I_MWDOWN] + we * 512 * 1024, 512, 1024, wd  + (size_t)e * 1024 * 512,  512,  0, worker, nworkers, base);
    }
}

DI void s5_tables(char* lds, const Ctx& P, int i, int g) {
    float2* pw = (float2*)lds;
    float2* bb = pw + 64 * 33;
    float2* cm = bb + 64 * 16;
    float*  kt = (float*)(cm + 16 * 64);
    const int tid = ltid();
    const size_t gp = (size_t)(i * 32 + g) * 64;
    for (int idx = tid; idx < 64 * 33; idx += NTHREADS) {
        const int p = idx / 33, tau = idx % 33;
        const double re = fmin((double)P.in[I_ARE][gp + p], -1e-4), im = (double)P.in[I_AIM][gp + p];
        const double st = exp((double)P.in[I_LSTEP][gp + p]);
        const double mag = exp(re * st * tau), ang = im * st * tau;
        pw[idx] = make_float2((float)(mag * cos(ang)), (float)(mag * sin(ang)));
    }
    for (int idx = tid; idx < 64 * 16; idx += NTHREADS) {
        const int p = idx >> 4, c = idx & 15;
        const double re = fmin((double)P.in[I_ARE][gp + p], -1e-4), im = (double)P.in[I_AIM][gp + p];
        const double st = exp((double)P.in[I_LSTEP][gp + p]);
        const double mag = exp(re * st), lr = mag * cos(im * st) - 1.0, li = mag * sin(im * st);
        const double den = re * re + im * im;
        const double fr = (lr * re + li * im) / den, fi = (li * re - lr * im) / den;
        const double br = (double)P.in[I_BRE][(gp + p) * 16 + c], bi = (double)P.in[I_BIM][(gp + p) * 16 + c];
        bb[idx] = make_float2((float)(fr * br - fi * bi), (float)(fr * bi + fi * br));
        const int cc = idx >> 6, pp = idx & 63;
        cm[idx] = make_float2(P.in[I_CRE][((size_t)(i * 32 + g) * 16 + cc) * 64 + pp], P.in[I_CIM][((size_t)(i * 32 + g) * 16 + cc) * 64 + pp]);
    }
    __syncthreads();
    for (int idx = tid; idx < 32 * 256; idx += NTHREADS) {
        const int tau = idx >> 8, c1 = (idx >> 4) & 15, c = idx & 15;
        float s = 0.f;
        for (int p = 0; p < 64; ++p) {
            const float2 a = cm[c1 * 64 + p], w = pw[p * 33 + tau], b = bb[p * 16 + c];
            const float tr = a.x * w.x - a.y * w.y, ti = a.x * w.y + a.y * w.x;
            s += tr * b.x - ti * b.y;
        }
        kt[idx] = s;
    }
    __syncthreads();
    bfr* gt = (bfr*)(P.ws + OFF_S5GT) + (size_t)(i * 32 + g) * 512 * 640;
    for (int idx = tid; idx < 512 * 80; idx += NTHREADS) {
        const int n = idx / 80, ch = idx % 80;
        const int t = n >> 4, c1 = n & 15;
        float v[8];
        if (ch < 64) {
            const int s = ch >> 1, c0 = (ch & 1) * 8;
#pragma unroll
            for (int j = 0; j < 8; ++j) v[j] = (t >= s) ? kt[((t - s) * 16 + c1) * 16 + c0 + j] : 0.f;
        } else {
            const int p0 = (ch - 64) * 4;
#pragma unroll
            for (int j = 0; j < 4; ++j) {
                const float2 a = cm[c1 * 64 + p0 + j], w = pw[(p0 + j) * 33 + t + 1];
                v[2 * j] = a.x * w.x - a.y * w.y;
                v[2 * j + 1] = -(a.x * w.y + a.y * w.x);
            }
        }
        *(uint4*)(gt + (size_t)n * 640 + ch * 8) = pack8(v);
    }
    bfr* bl = (bfr*)(P.ws + OFF_S5BL) + (size_t)(i * 32 + g) * 128 * 512;
    for (int idx = tid; idx < 128 * 64; idx += NTHREADS) {
        const int n = idx >> 6, ch = idx & 63;
        const int p = n >> 1, ri = n & 1, s = ch >> 1, c0 = (ch & 1) * 8;
        const float2 w = pw[p * 33 + 31 - s];
        float v[8];
#pragma unroll
        for (int j = 0; j < 8; ++j) { const float2 b = bb[p * 16 + c0 + j]; v[j] = ri ? (w.x * b.y + w.y * b.x) : (w.x * b.x - w.y * b.y); }
        *(uint4*)(bl + (size_t)n * 512 + ch * 8) = pack8(v);
    }
    float* l32 = (float*)(P.ws + OFF_S5L32) + (size_t)(i * 32 + g) * 128;
    if (tid < 64) { l32[2 * tid] = pw[tid * 33 + 32].x; l32[2 * tid + 1] = pw[tid * 33 + 32].y; }
    __syncthreads();
}

DI void norm_rows(const float* __restrict__ x, const float* __restrict__ g, bfr* __restrict__ hb, bfr* __restrict__ hlo, float* __restrict__ xcopy, int tok0, int ntok) {
    const int tid_ = ltid();
    const int lane = tid_ & 63, wave = tid_ >> 6;
    for (int tk = wave; tk < ntok; tk += 4) {
        const size_t tok = (size_t)(tok0 + tk);
        float4 v[4];
        float ss = 0.f;
#pragma unroll
        for (int i = 0; i < 4; ++i) {
            v[i] = *(const float4*)(x + tok * DM + i * 256 + lane * 4);
            ss += v[i].x * v[i].x + v[i].y * v[i].y + v[i].z * v[i].z + v[i].w * v[i].w;
        }
        ss = wave_sum(ss);
        const float rs = rsqrtf(ss * (1.0f / DM) + 1e-6f);
#pragma unroll
        for (int i = 0; i < 4; ++i) {
            const float4 gg = *(const float4*)(g + i * 256 + lane * 4);
            const float h0 = v[i].x * rs * gg.x, h1 = v[i].y * rs * gg.y, h2 = v[i].z * rs * gg.z, h3 = v[i].w * rs * gg.w;
            const unsigned p0 = pk2(h0, h1), p1 = pk2(h2, h3);
            *(uint2*)(hb + tok * DM + i * 256 + lane * 4) = make_uint2(p0, p1);
            if (hlo) {
                const unsigned q0 = pk2(h0 - bflo(p0), h1 - bfhi(p0)), q1 = pk2(h2 - bflo(p1), h3 - bfhi(p1));
                *(uint2*)(hlo + tok * DM + i * 256 + lane * 4) = make_uint2(q0, q1);
            }
            if (xcopy) *(float4*)(xcopy + tok * DM + i * 256 + lane * 4) = v[i];
        }
    }
}
DI void phase_e1(char* lds, const Ctx& P, int li) {
    const bfr* hb = (const bfr*)(P.ws + OFF_HB);
    const bfr* w = (const bfr*)(P.ws + OFF_WINE) + (size_t)li * 2304 * 1024;
    bfr* u = (bfr*)(P.ws + OFF_U);
    for (int t = blockIdx.x; t < 256 * 18; t += gridDim.x) {
        int mt, nt; tile_remap(t, 256, 18, mt, nt);
        RowLoader A(hb, mt * 128, 1024), B(w, nt * 128, 1024);
        gemm_tile(lds, 16, A, B, [&](const float* stg) __attribute__((always_inline)) {
            epi_rows8(stg, [&](int r, int c0, const float (&v)[8]) __attribute__((always_inline)) {
                *(uint4*)(u + (size_t)(mt * 128 + r) * EVEN_IN + nt * 128 + c0) = pack8(v);
            });
        });
    }
}

DI void phase_e2a(const Ctx& P, int li) {
    const bfr* u = (const bfr*)(P.ws + OFF_U);
    const float* mu = P.in[I_MU] + (size_t)li * 1792;
    bfr* S = (bfr*)(P.ws + OFF_S);
    bfr* mv = (bfr*)(P.ws + (li == 0 ? OFF_VFIRST : OFF_MV2));
    bfr* dpool = (bfr*)(P.ws + OFF_DPOOL);
    const int total = NTOK * 160;
    for (int idx = blockIdx.x * NTHREADS + ltid(); idx < total; idx += gridDim.x * NTHREADS) {
        const int tok = idx / 160, ch = idx % 160;
        const int col = 1024 + ch * 8;
        const int t = tok & (SEQ - 1);
        const bfr* row = u + (size_t)tok * EVEN_IN;
        float cur[8];
        unpack8(*(const uint4*)(row + col), cur);
        if (col < 1792) {
            float prv[8], m[8];
            if (t > 0) unpack8(*(const uint4*)(row - EVEN_IN + col), prv);
            else {
#pragma unroll
                for (int j = 0; j < 8; ++j) prv[j] = 0.f;
            }
            const float4 m0 = *(const float4*)(mu + col), m1 = *(const float4*)(mu + col + 4);
            const float mm[8] = {m0.x, m0.y, m0.z, m0.w, m1.x, m1.y, m1.z, m1.w};
#pragma unroll
            for (int j = 0; j < 8; ++j) m[j] = cur[j] + (prv[j] - cur[j]) * mm[j];
            if (col < 1536) {
                *(uint4*)(mv + (size_t)tok * 512 + (col - 1024)) = pack8(m);
            } else if (col < 1600) {
#pragma unroll
                for (int j = 0; j < 8; ++j) m[j] = ftanh(m[j]);
                *(uint4*)(S + (size_t)tok * 256 + (col - 1536)) = pack8(m);
            } else if (col < 1664) {
                *(uint4*)(S + (size_t)tok * 256 + 64 + (col - 1600)) = pack8(m);
            } else {
#pragma unroll
                for (int j = 0; j < 8; ++j) m[j] = sigmoidf_(m[j]);
                *(uint4*)(S + (size_t)tok * 256 + 128 + (col - 1664)) = pack8(m);
            }
        } else {
            const int gi = (col - 1792) >> 7;
            const int win = 2 << gi;
            const int nw = (t + 1 < win) ? (t + 1) : win;
            float acc[8];
#pragma unroll
            for (int j = 0; j < 8; ++j) acc[j] = cur[j];
#define POOL_WIN(W) { uint4 pv[W - 1]; _Pragma("unroll") for (int s = 1; s < W; ++s) pv[s - 1] = *(const uint4*)(row - (size_t)(s < nw ? s : 0) * EVEN_IN + col); \
                      _Pragma("unroll") for (int s = 1; s < W; ++s) { float pq[8]; unpack8(pv[s - 1], pq); const float wgt = s < nw ? 1.f : 0.f; \
                          _Pragma("unroll") for (int j = 0; j < 8; ++j) acc[j] += wgt * pq[j]; } }
            if (gi == 0) POOL_WIN(2) else if (gi == 1) POOL_WIN(4) else if (gi == 2) POOL_WIN(8) else POOL_WIN(16)
#undef POOL_WIN
            const float inv = frcp((float)nw);
#pragma unroll
            for (int j = 0; j < 8; ++j) acc[j] = acc[j] * inv - cur[j];
            *(uint4*)(dpool + (size_t)tok * 512 + (col - 1792)) = pack8(acc);
        }
    }
}

DI void phase_e2b(char* lds, const Ctx& P, int li) {
    const bfr* S = (const bfr*)(P.ws + OFF_S);
    const int njobs = (li == 1) ? 20 : 16;
    for (int t = blockIdx.x; t < 256 * njobs; t += gridDim.x) {
        const int mt = t / njobs, j = t % njobs;
        const int job = j >> 2, nt = j & 3;
        const int m0 = mt * 128;
        if (job == 0) {
            RowLoader A(S, m0, 256), B((const bfr*)(P.ws + OFF_W2T) + (size_t)li * 512 * 64, nt * 128, 64);
            const float* w0 = P.in[I_W0] + li * 512;
            float* dlog = (float*)(P.ws + OFF_DLOG);
            gemm_tile(lds, 1, A, B, [&](const float* stg) __attribute__((always_inline)) {
                epi_rows8(stg, [&](int r, int c0, const float (&v)[8]) __attribute__((always_inline)) {
                    float o[8];
#pragma unroll
                    for (int q = 0; q < 8; ++q) {
                        const float z = -(w0[nt * 128 + c0 + q] + v[q]);
                        o[q] = -fexp(-fsoftplus(z) - 0.5f);
                    }
                    float* d = dlog + (size_t)(m0 + r) * 512 + nt * 128 + c0;
                    *(float4*)d = make_float4(o[0], o[1], o[2], o[3]); *(float4*)(d + 4) = make_float4(o[4], o[5], o[6], o[7]);
                });
            });
        } else if (job == 1) {
            RowLoader A(S + 64, m0, 256), B((const bfr*)(P.ws + OFF_A2T) + (size_t)li * 512 * 64, nt * 128, 64);
            const float* a0 = P.in[I_A0] + li * 512;
            bfr* ab = (bfr*)(P.ws + OFF_ABUF);
            gemm_tile(lds, 1, A, B, [&](const float* stg) __attribute__((always_inline)) {
                epi_rows8(stg, [&](int r, int c0, const float (&v)[8]) __attribute__((always_inline)) {
                    float o[8];
#pragma unroll
                    for (int q = 0; q < 8; ++q) o[q] = sigmoidf_(a0[nt * 128 + c0 + q] + v[q]);
                    *(uint4*)(ab + (size_t)(m0 + r) * 512 + nt * 128 + c0) = pack8(o);
                });
            });
        } else if (job == 2) {
            RowLoader A(S + 128, m0, 256), B((const bfr*)(P.ws + OFF_G2T) + (size_t)li * 512 * 128, nt * 128, 128);
            bfr* gb = (bfr*)(P.ws + OFF_GBUF);
            gemm_tile(lds, 2, A, B, [&](const float* stg) __attribute__((always_inline)) {
                epi_rows8(stg, [&](int r, int c0, const float (&v)[8]) __attribute__((always_inline)) {
                    *(uint4*)(gb + (size_t)(m0 + r) * 512 + nt * 128 + c0) = pack8(v);
                });
            });
        } else if (job == 3) {
            RowLoader A((const bfr*)(P.ws + OFF_DPOOL) + nt * 128, m0, 512), B((const bfr*)(P.ws + OFF_POOLT) + (size_t)(li * 4 + nt) * 128 * 128, 0, 128);
            const float* ps = P.in[I_POOLS] + li * 512 + nt * 128;
            bfr* am = (bfr*)(P.ws + OFF_AMIX);
            gemm_tile(lds, 2, A, B, [&](const float* stg) __attribute__((always_inline)) {
                epi_rows8(stg, [&](int r, int c0, const float (&v)[8]) __attribute__((always_inline)) {
                    float o[8];
#pragma unroll
                    for (int q = 0; q < 8; ++q) o[q] = v[q] * ps[c0 + q];
                    *(uint4*)(am + (size_t)(m0 + r) * 1024 + 512 + nt * 128 + c0) = pack8(o);
                });
            });
        } else {
            RowLoader A((const bfr*)(P.ws + OFF_MV2), m0, 512), B((const bfr*)(P.ws + OFF_V12T), nt * 128, 512);
            const float* v0 = P.in[I_V0];
            bfr* vg = (bfr*)(P.ws + OFF_VGATE);
            gemm_tile(lds, 8, A, B, [&](const float* stg) __attribute__((always_inline)) {
                epi_rows8(stg, [&](int r, int c0, const float (&v)[8]) __attribute__((always_inline)) {
                    float o[8];
#pragma unroll
                    for (int q = 0; q < 8; ++q) o[q] = sigmoidf_(v0[nt * 128 + c0 + q] + v[q]);
                    *(uint4*)(vg + (size_t)(m0 + r) * 512 + nt * 128 + c0) = pack8(o);
                });
            });
        }
    }
}

constexpr int RW_TC = 16;
constexpr int RW_BUF = (5 * RW_TC * 64 + RW_TC * 16 + RW_TC * 16) * 4;
DI void phase_e3(char* lds, const Ctx& P, int li) {
    const bfr* u = (const bfr*)(P.ws + OFF_U);
    const float* mu = P.in[I_MU] + (size_t)li * 1792;
    const float* dlog = (const float*)(P.ws + OFF_DLOG);
    const bfr* ab = (const bfr*)(P.ws + OFF_ABUF);
    const bfr* vg = (const bfr*)(P.ws + OFF_VGATE);
    const bfr* vf = (const bfr*)(P.ws + OFF_VFIRST);
    float* yout = (float*)(P.ws + OFF_Y);
    float* bonus = (float*)(P.ws + OFF_BONUS);
    const int tid = ltid(), lane = tid & 63, wave = tid >> 6;
    const int pstep = tid >> 4, pc0 = (tid & 15) * 4;
    for (int item = blockIdx.x; item < 512; item += gridDim.x) {
        const int bh = item >> 2, qtr = item & 3;
        const int b = bh >> 3, h = bh & 7;
        const int i0 = qtr * 16;
        float c_mur[4], c_muk[4], c_muv[4], c_kk[4], c_ka[4], c_rk[4];
#pragma unroll
        for (int j = 0; j < 4; ++j) {
            const int c = h * 64 + pc0 + j;
            c_mur[j] = mu[c]; c_muk[j] = mu[512 + c]; c_muv[j] = mu[1024 + c];
            c_kk[j] = P.in[I_KK][li * 512 + c]; c_ka[j] = P.in[I_KA][li * 512 + c]; c_rk[j] = P.in[I_RK][li * 512 + c];
        }
        float S0 = 0.f, S1 = 0.f, S2 = 0.f, S3 = 0.f;
        const int rloc = wave * 4 + (lane >> 4);
        const int j0 = (lane & 15) * 4;
        const bool mine = ((pc0 >> 4) == qtr);
        uint2 g_ur, g_uk, g_uv, g_pr, g_pk, g_pv, g_a, g_vg, g_vf; float4 g_d;
#define E3_GLOAD(c_) do { const int t_ = (c_) * RW_TC + pstep; const size_t tok_ = (size_t)b * SEQ + t_; \
            const bfr* row_ = u + tok_ * EVEN_IN + h * 64 + pc0; const bfr* prow_ = row_ - (t_ > 0 ? EVEN_IN : 0); \
            g_ur = *(const uint2*)(row_); g_uk = *(const uint2*)(row_ + 512); g_uv = *(const uint2*)(row_ + 1024); \
            g_pr = *(const uint2*)(prow_); g_pk = *(const uint2*)(prow_ + 512); g_pv = *(const uint2*)(prow_ + 1024); \
            const size_t o_ = tok_ * 512 + h * 64 + pc0; \
            g_a = *(const uint2*)(ab + o_); g_d = *(const float4*)(dlog + o_); \
            if (li == 1) { g_vg = *(const uint2*)(vg + o_); g_vf = *(const uint2*)(vf + o_); } } while (0)
#define E3_PREP(c_, buf_) do { const int t_ = (c_) * RW_TC + pstep; const size_t o_ = ((size_t)b * SEQ + t_) * 512 + h * 64 + pc0; \
            float* sw_ = (float*)(lds + (buf_) * RW_BUF); float* sa_ = sw_ + RW_TC * 64; float* sb_ = sa_ + RW_TC * 64; float* sk_ = sb_ + RW_TC * 64; \
            float* sr_ = sk_ + RW_TC * 64; float* sv_ = sr_ + RW_TC * 64; \
            const float pz_ = t_ > 0 ? 1.f : 0.f; \
            const float ur_[4] = {bflo(g_ur.x), bfhi(g_ur.x), bflo(g_ur.y), bfhi(g_ur.y)}, uk_[4] = {bflo(g_uk.x), bfhi(g_uk.x), bflo(g_uk.y), bfhi(g_uk.y)}; \
            const float uv_[4] = {bflo(g_uv.x), bfhi(g_uv.x), bflo(g_uv.y), bfhi(g_uv.y)}; \
            const float pr_[4] = {bflo(g_pr.x), bfhi(g_pr.x), bflo(g_pr.y), bfhi(g_pr.y)}, pk_[4] = {bflo(g_pk.x), bfhi(g_pk.x), bflo(g_pk.y), bfhi(g_pk.y)}; \
            const float pv_[4] = {bflo(g_pv.x), bfhi(g_pv.x), bflo(g_pv.y), bfhi(g_pv.y)}; \
            const float av_[4] = {bflo(g_a.x), bfhi(g_a.x), bflo(g_a.y), bfhi(g_a.y)}; \
            const float dl_[4] = {g_d.x, g_d.y, g_d.z, g_d.w}; \
            float gv_[4] = {0.f, 0.f, 0.f, 0.f}, fv_[4] = {0.f, 0.f, 0.f, 0.f}; \
            if (li == 1) { gv_[0] = bflo(g_vg.x); gv_[1] = bfhi(g_vg.x); gv_[2] = bflo(g_vg.y); gv_[3] = bfhi(g_vg.y); \
                           fv_[0] = bflo(g_vf.x); fv_[1] = bfhi(g_vf.x); fv_[2] = bflo(g_vf.y); fv_[3] = bfhi(g_vf.y); } \
            float kkr_[4], kmod_[4], rr_[4], vv_[4]; float ssq_ = 0.f, bsum_ = 0.f; \
            _Pragma("unroll") for (int j = 0; j < 4; ++j) { \
                rr_[j] = ur_[j] + (pz_ * pr_[j] - ur_[j]) * c_mur[j]; \
                const float k_ = uk_[j] + (pz_ * pk_[j] - uk_[j]) * c_muk[j]; \
                float v_ = uv_[j] + (pz_ * pv_[j] - uv_[j]) * c_muv[j]; \
                if (li == 1) v_ = v_ + (fv_[j] - v_) * gv_[j]; \
                vv_[j] = v_; kkr_[j] = k_ * c_kk[j]; ssq_ += kkr_[j] * kkr_[j]; \
                kmod_[j] = k_ * (1.0f + (av_[j] - 1.0f) * c_ka[j]); bsum_ += rr_[j] * kmod_[j] * c_rk[j]; } \
            ssq_ = row16_sum(ssq_); bsum_ = row16_sum(bsum_); \
            const float inv_ = frcp(fmaxf(sqrtf(ssq_), 1e-12f)); \
            float4 w4_, a4_, b4_; \
            w4_.x = fexp(dl_[0]); w4_.y = fexp(dl_[1]); w4_.z = fexp(dl_[2]); w4_.w = fexp(dl_[3]); \
            a4_.x = -kkr_[0] * inv_; a4_.y = -kkr_[1] * inv_; a4_.z = -kkr_[2] * inv_; a4_.w = -kkr_[3] * inv_; \
            b4_.x = -a4_.x * av_[0]; b4_.y = -a4_.y * av_[1]; b4_.z = -a4_.z * av_[2]; b4_.w = -a4_.w * av_[3]; \
            *(float4*)(sw_ + pstep * 64 + pc0) = w4_; *(float4*)(sa_ + pstep * 64 + pc0) = a4_; *(float4*)(sb_ + pstep * 64 + pc0) = b4_; \
            *(float4*)(sk_ + pstep * 64 + pc0) = make_float4(kmod_[0], kmod_[1], kmod_[2], kmod_[3]); \
            *(float4*)(sr_ + pstep * 64 + pc0) = make_float4(rr_[0], rr_[1], rr_[2], rr_[3]); \
            if (mine) { *(float4*)(sv_ + pstep * 16 + (pc0 & 15)) = make_float4(vv_[0], vv_[1], vv_[2], vv_[3]); \
                        *(float4*)(bonus + o_) = make_float4(bsum_ * vv_[0], bsum_ * vv_[1], bsum_ * vv_[2], bsum_ * vv_[3]); } } while (0)
        __syncthreads();
        E3_GLOAD(0);
        E3_PREP(0, 0);
        __syncthreads();
        constexpr int NCH = SEQ / RW_TC;
#pragma unroll 1
        for (int c = 0; c < NCH; ++c) {
            const int buf = c & 1;
            if (c + 1 < NCH) E3_GLOAD(c + 1);
            {
                const float* s_w = (const float*)(lds + buf * RW_BUF); const float* s_a = s_w + RW_TC * 64; const float* s_b = s_a + RW_TC * 64;
                const float* s_k = s_b + RW_TC * 64; const float* s_r = s_k + RW_TC * 64; const float* s_v = s_r + RW_TC * 64;
                float* s_y = (float*)(s_v + RW_TC * 16);
#pragma unroll 1
                for (int sg = 0; sg < RW_TC; sg += 4) {
                    float yv[4];
#pragma unroll
                    for (int q = 0; q < 4; ++q) {
                        const int s = sg + q;
                        const float4 a4 = *(const float4*)(s_a + s * 64 + j0);
                        const float4 w4 = *(const float4*)(s_w + s * 64 + j0);
                        const float4 b4 = *(const float4*)(s_b + s * 64 + j0);
                        const float4 k4 = *(const float4*)(s_k + s * 64 + j0);
                        const float4 r4 = *(const float4*)(s_r + s * 64 + j0);
                        const float vi = s_v[s * 16 + rloc];
                        float sa = (S0 * a4.x + S1 * a4.y) + (S2 * a4.z + S3 * a4.w);
                        sa = row16_sum(sa);
                        S0 = S0 * w4.x + (sa * b4.x + vi * k4.x);
                        S1 = S1 * w4.y + (sa * b4.y + vi * k4.y);
                        S2 = S2 * w4.z + (sa * b4.z + vi * k4.z);
                        S3 = S3 * w4.w + (sa * b4.w + vi * k4.w);
                        const float y = (S0 * r4.x + S1 * r4.y) + (S2 * r4.z + S3 * r4.w);
                        yv[q] = row16_sum(y);
                    }
                    const int ls = lane & 3;
                    const float yo = ls == 0 ? yv[0] : (ls == 1 ? yv[1] : (ls == 2 ? yv[2] : yv[3]));
                    if ((lane & 15) < 4) s_y[(sg + ls) * 16 + rloc] = yo;
                }
            }
            if (c + 1 < NCH) E3_PREP(c + 1, buf ^ 1);
            __syncthreads();
            {
                const float* s_y = (const float*)(lds + buf * RW_BUF) + 5 * RW_TC * 64 + RW_TC * 16;
                const int s = tid >> 4, r = tid & 15;
                yout[((size_t)b * SEQ + c * RW_TC + s) * 512 + h * 64 + i0 + r] = s_y[tid];
            }
        }
#undef E3_GLOAD
#undef E3_PREP
    }
}

DI void phase_e4(const Ctx& P, int li) {
    const float* y = (const float*)(P.ws + OFF_Y);
    const float* bonus = (const float*)(P.ws + OFF_BONUS);
    const bfr* gb = (const bfr*)(P.ws + OFF_GBUF);
    const float* lng = P.in[I_LNG] + li * 512;
    const float* lnb = P.in[I_LNB] + li * 512;
    bfr* am = (bfr*)(P.ws + OFF_AMIX);
    const int total = NTOK * 64;
    for (int idx = blockIdx.x * NTHREADS + ltid(); idx < total; idx += gridDim.x * NTHREADS) {
        const int tok = idx >> 6, c = (idx & 63) * 8;
        const size_t o = (size_t)tok * 512 + c;
        const float4 y0 = *(const float4*)(y + o), y1 = *(const float4*)(y + o + 4);
        float v[8] = {y0.x, y0.y, y0.z, y0.w, y1.x, y1.y, y1.z, y1.w};
        float s = 0.f;
#pragma unroll
        for (int j = 0; j < 8; ++j) s += v[j];
        s += __shfl_xor(s, 1); s += __shfl_xor(s, 2); s += __shfl_xor(s, 4);
        const float mean = s * (1.0f / 64.0f);
        float q = 0.f;
#pragma unroll
        for (int j = 0; j < 8; ++j) { v[j] -= mean; q += v[j] * v[j]; }
        q += __shfl_xor(q, 1); q += __shfl_xor(q, 2); q += __shfl_xor(q, 4);
        const float rstd = rsqrtf(q * (1.0f / 64.0f) + 64e-5f);
        const float4 b0 = *(const float4*)(bonus + o), b1 = *(const float4*)(bonus + o + 4);
        const float bo[8] = {b0.x, b0.y, b0.z, b0.w, b1.x, b1.y, b1.z, b1.w};
        float gv[8];
        unpack8(*(const uint4*)(gb + o), gv);
        float out[8];
#pragma unroll
        for (int j = 0; j < 8; ++j) out[j] = (v[j] * rstd * lng[c + j] + lnb[c + j] + bo[j]) * gv[j];
        *(uint4*)(am + (size_t)tok * 1024 + c) = pack8(out);
    }
}

DI void phase_wout(char* lds, const Ctx& P, const bfr* w, float* x) {
    const bfr* am = (const bfr*)(P.ws + OFF_AMIX);
    for (int t = blockIdx.x; t < 256 * 8; t += gridDim.x) {
        int mt, nt; tile_remap(t, 256, 8, mt, nt);
        RowLoader A(am, mt * 128, 1024), B(w, nt * 128, 1024);
        gemm_tile(lds, 16, A, B, [&](const float* stg) __attribute__((always_inline)) {
            epi_rows8_pre<F8>(stg,
                [&](int r, int c0) __attribute__((always_inline)) -> F8 {
                    const float* d = x + (size_t)(mt * 128 + r) * DM + nt * 128 + c0;
                    F8 o; o.a = *(const float4*)d; o.b = *(const float4*)(d + 4); return o; },
                [&](int r, int c0, const float (&v)[8], const F8& o) __attribute__((always_inline)) {
                    float* d = x + (size_t)(mt * 128 + r) * DM + nt * 128 + c0;
                    *(float4*)d = make_float4(o.a.x + v[0], o.a.y + v[1], o.a.z + v[2], o.a.w + v[3]);
                    *(float4*)(d + 4) = make_float4(o.b.x + v[4], o.b.y + v[5], o.b.z + v[6], o.b.w + v[7]);
                });
        });
    }
}
DI void phase_o1(char* lds, const Ctx& P, int li) {
    const bfr* hb = (const bfr*)(P.ws + OFF_HB);
    const bfr* w = (const bfr*)(P.ws + OFF_WINO) + (size_t)li * 2048 * 1024;
    bfr* qk = (bfr*)(P.ws + OFF_U);
    bfr* vT = (bfr*)(P.ws + OFF_VT);
    bfr* us5 = (bfr*)(P.ws + OFF_US5);
    for (int t = blockIdx.x; t < 256 * 16; t += gridDim.x) {
        int mt, nt; tile_remap(t, 256, 16, mt, nt);
        const int m0 = mt * 128;
        RowLoader A(hb, m0, 1024), B(w, nt * 128, 1024);
        gemm_tile(lds, 16, A, B, [&](const float* stg) __attribute__((always_inline)) {
            if (nt < 8) {
                epi_rows8(stg, [&](int r, int c0, const float (&v)[8]) __attribute__((always_inline)) {
                    *(uint4*)(qk + (size_t)(m0 + r) * 1024 + nt * 128 + c0) = pack8(v);
                });
            } else if (nt < 12) {
                const int b = m0 >> 11, tq = m0 & (SEQ - 1);
                bfr* dst = vT + ((size_t)(b * 4 + (nt - 8)) * 128) * SEQ + tq;
                const int tid0 = ltid();
#pragma unroll
                for (int it = 0; it < 8; ++it) {
                    const int idx = it * NTHREADS + tid0;
                    const int dv = idx & 127, rg = idx >> 7;
                    float v[8];
#pragma unroll
                    for (int j = 0; j < 8; ++j) v[j] = stg[(rg * 8 + j) * STG_LD + dv];
                    *(uint4*)(dst + (size_t)dv * SEQ + rg * 8) = pack8(v);
                }
            } else {
                epi_rows8(stg, [&](int r, int c0, const float (&v)[8]) __attribute__((always_inline)) {
                    const int cc = (nt - 12) * 128 + c0;
                    *(uint4*)(us5 + ((size_t)(cc >> 4) * NTOK + m0 + r) * 16 + (cc & 15)) = pack8(v);
                });
            }
        });
    }
}

DI void phase_o2(char* lds, const Ctx& P, int li) {
    const bfr* qk = (const bfr*)(P.ws + OFF_U);
    bfr* qn = (bfr*)(P.ws + OFF_QN);
    bfr* kn = (bfr*)(P.ws + OFF_KN);
    const float* gq = P.in[I_QN] + li * 64;
    const float* gk = P.in[I_KN] + li * 64;
    const bfr* us5 = (const bfr*)(P.ws + OFF_US5);
    const bfr* bl = (const bfr*)(P.ws + OFF_S5BL) + (size_t)li * 32 * 128 * 512;
    float* xloc = (float*)(P.ws + OFF_XLOC);
    for (int t = blockIdx.x; t < 256; t += gridDim.x) {
        const int g = t >> 3, mt = t & 7;
        RowLoader A(us5 + (size_t)g * NTOK * 16, mt * 128, 512), B(bl + (size_t)g * 128 * 512, 0, 512);
        gemm_tile(lds, 8, A, B, [&](const float* stg) __attribute__((always_inline)) {
            epi_rows8(stg, [&](int r, int c0, const float (&v)[8]) __attribute__((always_inline)) {
                float* d = xloc + ((size_t)g * 1024 + mt * 128 + r) * 128 + c0;
                *(float4*)d = make_float4(v[0], v[1], v[2], v[3]); *(float4*)(d + 4) = make_float4(v[4], v[5], v[6], v[7]);
            });
        });
    }
    const int total = NTOK * 16 * 8;
    for (int idx = blockIdx.x * NTHREADS + ltid(); idx < total; idx += gridDim.x * NTHREADS) {
        const int l8 = idx & 7, item = idx >> 3;
        const int hm = item & 7, which = (item >> 3) & 1, tok = item >> 4;
        const int d0 = l8 * 4;
        const bfr* src = qk + (size_t)tok * 1024 + which * 512 + hm * 64;
        const uint2 ua = *(const uint2*)(src + d0), ub = *(const uint2*)(src + 32 + d0);
        float x1[4] = {bflo(ua.x), bfhi(ua.x), bflo(ua.y), bfhi(ua.y)};
        float x2[4] = {bflo(ub.x), bfhi(ub.x), bflo(ub.y), bfhi(ub.y)};
        float ss = 0.f;
#pragma unroll
        for (int j = 0; j < 4; ++j) ss += x1[j] * x1[j] + x2[j] * x2[j];
        ss += __shfl_xor(ss, 1); ss += __shfl_xor(ss, 2); ss += __shfl_xor(ss, 4);
        const float rs = rsqrtf(ss * (1.0f / 64.0f) + 1e-6f);
        const float* gg = which ? gk : gq;
        const float scl = which ? 1.0f : (0.125f * 1.4426950408889634f);
        const int t = tok & (SEQ - 1);
        float o1[4], o2[4];
#pragma unroll
        for (int j = 0; j < 4; ++j) {
            const int i = d0 + j;
            const float invf = exp2f(-(float)i * (13.287712379549449f / 32.0f));
            const float ang = (float)t * invf;
            float sn, cs;
            sincosf(ang, &sn, &cs);
            const float a = x1[j] * rs * gg[i], b2 = x2[j] * rs * gg[32 + i];
            o1[j] = (a * cs - b2 * sn) * scl;
            o2[j] = (b2 * cs + a * sn) * scl;
        }
        bfr* dst = (which ? kn : qn) + (size_t)tok * 512 + hm * 64;
        *(uint2*)(dst + d0) = make_uint2(pk2(o1[0], o1[1]), pk2(o1[2], o1[3]));
        *(uint2*)(dst + 32 + d0) = make_uint2(pk2(o2[0], o2[1]), pk2(o2[2], o2[3]));
    }
}

DI void s5_scan(const Ctx& P, int li) {
    const float* xloc = (const float*)(P.ws + OFF_XLOC);
    bfr* xin = (bfr*)(P.ws + OFF_XIN);
    const float* l32 = (const float*)(P.ws + OFF_S5L32) + (size_t)li * 32 * 128;
    for (int idx = blockIdx.x * NTHREADS + ltid(); idx < 32 * 16 * 64; idx += gridDim.x * NTHREADS) {
        const int p = idx & 63, b = (idx >> 6) & 15, g = idx >> 10;
        const float lr = l32[g * 128 + 2 * p], lim = l32[g * 128 + 2 * p + 1];
        float xr = 0.f, xi = 0.f;
        for (int ch = 0; ch < 64; ++ch) {
            const size_t o = ((size_t)g * 1024 + b * 64 + ch) * 128 + 2 * p;
            *(unsigned*)(xin + o) = pk2(xr, xi);
            const float2 a = *(const float2*)(xloc + o);
            const float nr = lr * xr - lim * xi + a.x, ni = lr * xi + lim * xr + a.y;
            xr = nr; xi = ni;
        }
    }
}

DI void attn_item(char* lds, const Ctx& P, int b, int h, int qt, float lam, float lam_init, const float* subln) {
    const bfr* qn = (const bfr*)(P.ws + OFF_QN);
    const bfr* kn = (const bfr*)(P.ws + OFF_KN);
    const bfr* vT = (const bfr*)(P.ws + OFF_VT) + (size_t)(b * 4 + h) * 128 * SEQ;
    bfr* am = (bfr*)(P.ws + OFF_AMIX);
    const int tid = ltid(), lane = tid & 63, wave = tid >> 6;
    const int m = wave >> 1, qw = (wave & 1) * 32;
    const int q0 = qt * 64 + qw;
    const int ln = lane & 31, hf = lane >> 5;
    bf16x8 qf[4];
    {
        const bfr* qp = qn + ((size_t)b * SEQ + q0 + ln) * 512 + h * 128 + m * 64 + hf * 8;
#pragma unroll
        for (int ks = 0; ks < 4; ++ks) qf[ks] = *(const bf16x8*)(qp + ks * 16);
    }
    f32x16 o[4];
#pragma unroll
    for (int d = 0; d < 4; ++d)
#pragma unroll
        for (int r = 0; r < 16; ++r) o[d][r] = 0.f;
    float mrun = -INFINITY, lrun = 0.f;
    const int nkt = qt + 1;
    const int lrow = tid >> 3, lcol = (tid & 7) * 8;
    const bfr* kbase = kn + ((size_t)b * SEQ) * 512 + h * 128;
    unsigned ko = (unsigned)(lrow * 512 + lcol) * 2u, vo = (unsigned)(lrow * SEQ + lcol) * 2u;
    asm volatile("" : "+v"(ko), "+v"(vo));
    uint4 rk0, rk1, rk2, rk3, rv0, rv1, rv2, rv3;
#define ATT_GLOAD(kt_) do { const char* kp_ = (const char*)(kbase + (size_t)(kt_) * (64 * 512)); const char* vp_ = (const char*)(vT + (kt_) * 64); \
        rk0 = *(const uint4*)(kp_ + ko); rk1 = *(const uint4*)(kp_ + 32 * 512 * 2 + ko); rk2 = *(const uint4*)(kp_ + 64 * 2 + ko); rk3 = *(const uint4*)(kp_ + 32 * 512 * 2 + 64 * 2 + ko); \
        rv0 = *(const uint4*)(vp_ + vo); rv1 = *(const uint4*)(vp_ + 32 * SEQ * 2 + vo); rv2 = *(const uint4*)(vp_ + 64 * SEQ * 2 + vo); rv3 = *(const uint4*)(vp_ + 96 * SEQ * 2 + vo); } while (0)
#define ATT_S1(base_, i_, RK, RV) { *(uint4*)((base_) + (32 * (i_)) * LDA * 2) = RK; \
        *(uint4*)((base_) + TILE_B + (32 * (i_)) * LDA * 2) = RV; }
#define ATT_LSTORE(buf_) do { char* base_ = lds + (buf_) * (2 * TILE_B) + s_off; ATT_S1(base_, 0, rk0, rv0) ATT_S1(base_, 1, rk1, rv1) ATT_S1(base_, 2, rk2, rv2) ATT_S1(base_, 3, rk3, rv3) } while (0)
    int k_off = ((m * 64 + ln) * LDA + hf * 8) * 2;
    int v_off = TILE_B + (ln * LDA + 4 * hf) * 2;
    int s_off = (lrow * LDA + lcol) * 2;
    asm volatile("" : "+v"(k_off), "+v"(v_off), "+v"(s_off));
    ATT_GLOAD(0); ATT_LSTORE(0);
    __syncthreads();
    int buf = 0;
#pragma unroll 1
    for (int kt = 0; kt < nkt; ++kt) {
        const bool more = (kt + 1 < nkt);
        const char* ks_ = lds + buf * (2 * TILE_B) + k_off;
        const char* vs_ = lds + buf * (2 * TILE_B) + v_off;
        if (kt * 64 <= q0 + 31) {
            f32x16 s[2];
#pragma unroll
            for (int kb = 0; kb < 2; ++kb) {
#pragma unroll
                for (int r = 0; r < 16; ++r) s[kb][r] = 0.f;
#pragma unroll
                for (int ks = 0; ks < 4; ++ks) {
                    const bf16x8 kf = *(const bf16x8*)(ks_ + ((kb * 32) * LDA + ks * 16) * 2);
                    s[kb] = MFMA32(kf, qf[ks], s[kb]);
                }
            }
            const int qpos = q0 + ln;
            if (kt * 64 + 63 > q0) {
#pragma unroll
                for (int kb = 0; kb < 2; ++kb)
#pragma unroll
                    for (int r = 0; r < 16; ++r) {
                        const int key = kt * 64 + kb * 32 + (r & 3) + 8 * (r >> 2) + 4 * hf;
                        if (key > qpos) s[kb][r] = -INFINITY;
                    }
            }
            float mx = s[0][0];
#pragma unroll
            for (int kb = 0; kb < 2; ++kb)
#pragma unroll
                for (int r = 0; r < 16; ++r) mx = fmaxf(mx, s[kb][r]);
            mx = fmaxf(mx, __shfl_xor(mx, 32));
            const float mnew = fmaxf(mrun, mx);
            const float alpha = __builtin_amdgcn_exp2f(mrun - mnew);
            mrun = mnew;
            float rsum = 0.f;
#pragma unroll
            for (int kb = 0; kb < 2; ++kb)
#pragma unroll
                for (int r = 0; r < 16; ++r) { const float p = __builtin_amdgcn_exp2f(s[kb][r] - mnew); s[kb][r] = p; rsum += p; }
            lrun = lrun * alpha + rsum;
#pragma unroll
            for (int d = 0; d < 4; ++d)
#pragma unroll
                for (int r = 0; r < 16; ++r) o[d][r] *= alpha;
            __builtin_amdgcn_sched_barrier(0);
            if (more) ATT_GLOAD(kt + 1);
#pragma unroll
            for (int kb = 0; kb < 2; ++kb)
#pragma unroll
                for (int st = 0; st < 2; ++st) {
                    const uint4 pp = make_uint4(pk2(s[kb][8 * st + 0], s[kb][8 * st + 1]), pk2(s[kb][8 * st + 2], s[kb][8 * st + 3]),
                                                pk2(s[kb][8 * st + 4], s[kb][8 * st + 5]), pk2(s[kb][8 * st + 6], s[kb][8 * st + 7]));
                    const bf16x8 pf = __builtin_bit_cast(bf16x8, pp);
                    const int kc = kb * 32 + 16 * st;
#pragma unroll
                    for (int d = 0; d < 4; ++d) {
                        const uint2 v0 = *(const uint2*)(vs_ + ((d * 32) * LDA + kc) * 2);
                        const uint2 v1 = *(const uint2*)(vs_ + ((d * 32) * LDA + kc + 8) * 2);
                        const bf16x8 vf = __builtin_bit_cast(bf16x8, make_uint4(v0.x, v0.y, v1.x, v1.y));
                        o[d] = MFMA32(vf, pf, o[d]);
                    }
                }
        }
        else if (more) ATT_GLOAD(kt + 1);
        if (more) ATT_LSTORE(buf ^ 1);
        __syncthreads();
        buf ^= 1;
    }
    const float ltot = lrun + __shfl_xor(lrun, 32);
    const float linv = 1.0f / ltot;
    float* ob = (float*)lds;
    int o_off = (m * 64 + qw + ln) * 129 + 4 * hf;
    asm volatile("" : "+v"(o_off));
#pragma unroll
    for (int d = 0; d < 4; ++d)
#pragma unroll
        for (int r = 0; r < 16; ++r) ob[o_off + d * 32 + (r & 3) + 8 * (r >> 2)] = o[d][r] * linv;
    __syncthreads();
#pragma unroll
    for (int it = 0; it < 4; ++it) {
        const int idx = it * NTHREADS + tid;
        const int q = idx >> 4, c0 = (idx & 15) * 8;
        float v[8];
        float ss = 0.f;
        int r_off = q * 129 + c0;
        asm volatile("" : "+v"(r_off));
#pragma unroll
        for (int j = 0; j < 8; ++j) { v[j] = ob[r_off + j] - lam * ob[r_off + 64 * 129 + j]; ss += v[j] * v[j]; }
        ss = row16_sum(ss);
        const float rs = rsqrtf(ss * (1.0f / 128.0f) + 1e-5f) * (1.0f - lam_init);
#pragma unroll
        for (int j = 0; j < 8; ++j) v[j] = v[j] * rs * subln[c0 + j];
        *(uint4*)(am + ((size_t)b * SEQ + qt * 64 + q) * 1024 + h * 128 + c0) = pack8(v);
    }
    __syncthreads();
}

DI void phase_o3(char* lds, const Ctx& P, int li, int layer) {
    s5_scan(P, li);
    float lam;
    {
        const int j = ltid() & 63;
        const float s1 = wave_sum(P.in[I_LQ1][li * 64 + j] * P.in[I_LK1][li * 64 + j]);
        const float s2 = wave_sum(P.in[I_LQ2][li * 64 + j] * P.in[I_LK2][li * 64 + j]);
        const float lam_init0 = 0.8f - 0.6f * __expf(-0.3f * (float)layer);
        lam = __expf(s1) - __expf(s2) + lam_init0;
    }
    const float lam_init = 0.8f - 0.6f * __expf(-0.3f * (float)layer);
    const float* subln = P.in[I_SUBLN] + li * 128;
    for (int item = blockIdx.x; item < 1024; item += gridDim.x) {
        const int bh = item >> 4, pr = item & 15;
        for (int half = 0; half < 2; ++half) attn_item(lds, P, bh >> 2, bh & 3, half ? 31 - pr : pr, lam, lam_init, subln);
    }
}

DI void phase_o4(char* lds, const Ctx& P, int li) {
    const bfr* us5 = (const bfr*)(P.ws + OFF_US5);
    const bfr* xin = (const bfr*)(P.ws + OFF_XIN);
    const bfr* gt = (const bfr*)(P.ws + OFF_S5GT) + (size_t)li * 32 * 512 * 640;
    const float* dsk = P.in[I_S5D] + li * 512;
    bfr* zb = (bfr*)(P.ws + OFF_ZBUF);
    for (int t = blockIdx.x; t < 1024; t += gridDim.x) {
        const int g = t >> 5, mt = (t >> 2) & 7, nt = t & 3;
        const int nloc = 2 * (nt + 1);
        const bfr* ag = us5 + (size_t)g * NTOK * 16;
        const bfr* xg = xin + (size_t)g * 1024 * 128;
        const int tq = ltid();
        const int arow = mt * 128 + (tq >> 3), acol = gt_lcol(tq);
        auto aptr = [&](int i, int kt) __attribute__((always_inline)) -> const bfr* {
            return (kt < nloc) ? ag + (size_t)(arow + 32 * i) * 512 + kt * 64 + acol
                               : xg + (size_t)(arow + 32 * i) * 128 + (kt - nloc) * 64 + acol;
        };
        const bfr* bg = gt + (size_t)g * 512 * 640 + (size_t)(nt * 128 + (tq >> 3)) * 640 + acol;
        auto bptr = [&](int i, int kt) __attribute__((always_inline)) -> const bfr* {
            return bg + (size_t)(32 * i) * 640 + ((kt < nloc) ? kt : (8 + kt - nloc)) * 64;
        };
        gemm_tile(lds, nloc + 2, aptr, bptr, [&](const float* stg) __attribute__((always_inline)) {
            epi_rows8_pre<uint4>(stg,
                [&](int r, int c0) __attribute__((always_inline)) -> uint4 {
                    const int n = nt * 128 + c0;
                    return *(const uint4*)(ag + ((size_t)(mt * 128 + r) * 32 + (n >> 4)) * 16 + (n & 15)); },
                [&](int r, int c0, const float (&v)[8], const uint4& up) __attribute__((always_inline)) {
                    const int cb = mt * 128 + r;
                    const int n = nt * 128 + c0, tt = n >> 4, c1 = n & 15;
                    const size_t tok = (size_t)cb * 32 + tt;
                    float uu[8], z[8];
                    unpack8(up, uu);
#pragma unroll
                    for (int j = 0; j < 8; ++j) {
                        const float y = v[j] + dsk[g * 16 + c1 + j] * uu[j];
                        const float inner = 0.7978845608028654f * (y + 0.044715f * y * y * y);
                        z[j] = 0.5f * y * (1.0f + ftanh(inner));
                    }
                    *(uint4*)(zb + tok * 512 + g * 16 + c1) = pack8(z);
                });
        });
    }
}

DI void phase_o5(char* lds, const Ctx& P, int li) {
    const bfr* zb = (const bfr*)(P.ws + OFF_ZBUF);
    const bfr* w = (const bfr*)(P.ws + OFF_GLUT) + (size_t)li * 512 * 512;
    bfr* am = (bfr*)(P.ws + OFF_AMIX);
    for (int t = blockIdx.x; t < 1024; t += gridDim.x) {
        int mt, nt; tile_remap(t, 256, 4, mt, nt);
        RowLoader A(zb, mt * 128, 512), B(w, nt * 128, 512);
        gemm_tile(lds, 8, A, B, [&](const float* stg) __attribute__((always_inline)) {
            epi_rows8_pre<uint4>(stg,
                [&](int r, int c0) __attribute__((always_inline)) -> uint4 { return *(const uint4*)(zb + (size_t)(mt * 128 + r) * 512 + nt * 128 + c0); },
                [&](int r, int c0, const float (&v)[8], const uint4& zp) __attribute__((always_inline)) {
                    float zz[8], o[8];
                    unpack8(zp, zz);
#pragma unroll
                    for (int j = 0; j < 8; ++j) o[j] = zz[j] * sigmoidf_(v[j]);
                    *(uint4*)(am + (size_t)(mt * 128 + r) * 1024 + 512 + nt * 128 + c0) = pack8(o);
                });
        });
    }
}
DI void phase_router(char* lds, const Ctx& P, int layer) {
    const float* x = P.out;
    bfr* hb = (bfr*)(P.ws + OFF_HB);
    bfr* hlo = (bfr*)(P.ws + OFF_HLO);
    const bfr* rhi = (const bfr*)(P.ws + OFF_RHI) + (size_t)layer * 128 * 1024;
    const bfr* rlo = (const bfr*)(P.ws + OFF_RLO) + (size_t)layer * 128 * 1024;
    int* gcnt = (int*)(P.ws + OFF_CNT) + layer * 64;
    int* stok = (int*)(P.ws + OFF_TOK);
    float* sgate = (float*)(P.ws + OFF_GATE);
    int* lcnt = (int*)(lds + LDS_AUX);
    int* lbase = lcnt + 64;
    const float* bg = P.in[I_MBG] + layer * 4;
    const float* be = P.in[I_MBE] + layer * 32;
    const int tid = ltid();
    for (int u = blockIdx.x; u < 256; u += gridDim.x) {
        const int m0 = u * 128;
        norm_rows(x, P.in[I_NFFN] + (size_t)layer * DM, hb, hlo, nullptr, m0, 128);
        __syncthreads();
        const size_t roff = (size_t)(m0 + (tid >> 3)) * 1024 + gt_lcol(tid);
        const size_t boff = (size_t)(tid >> 3) * 1024 + gt_lcol(tid);
        auto aptr = [&](int i, int kt) __attribute__((always_inline)) -> const bfr* { return (kt < 32 ? hb : hlo) + roff + (size_t)(32 * i) * 1024 + (kt & 15) * 64; };
        auto bptr = [&](int i, int kt) __attribute__((always_inline)) -> const bfr* { return ((kt >= 16 && kt < 32) ? rlo : rhi) + boff + (size_t)(32 * i) * 1024 + (kt & 15) * 64; };
        gemm_tile(lds, 48, aptr, bptr, [&](const float* stg) __attribute__((always_inline)) {
            if (tid < 64) lcnt[tid] = 0;
            __syncthreads();
            int seg0 = 0, seg1 = 0, p0 = 0, p1 = 0;
            float g0 = 0.f, g1 = 0.f;
            if (tid < 128) {
                const float* row = stg + tid * STG_LD;
                float gl[4];
#pragma unroll
                for (int j = 0; j < 4; ++j) gl[j] = row[32 + j] + bg[j];
                int gt = 0; float gm = gl[0];
#pragma unroll
                for (int j = 1; j < 4; ++j) if (gl[j] > gm) { gm = gl[j]; gt = j; }
                float gs = 0.f;
#pragma unroll
                for (int j = 0; j < 4; ++j) gs += __expf(gl[j] - gm);
                const float gw = 1.0f / gs;
                float l1 = -INFINITY, l2 = -INFINITY; int j1 = 0, j2 = 0;
                for (int j = 0; j < 8; ++j) {
                    const float v = row[gt * 8 + j] + be[gt * 8 + j];
                    if (v > l1) { l2 = l1; j2 = j1; l1 = v; j1 = j; }
                    else if (v > l2) { l2 = v; j2 = j; }
                }
                const float w1 = 1.0f / (1.0f + __expf(l2 - l1));
                g0 = gw * w1; g1 = gw * (1.0f - w1);
                seg0 = gt * 8 + j1; seg1 = 32 + gt * 8 + j2;
                p0 = atomicAdd(&lcnt[seg0], 1);
                p1 = atomicAdd(&lcnt[seg1], 1);
            }
            __syncthreads();
            if (tid < 64) { const int c = lcnt[tid]; lbase[tid] = c ? atomicAdd(&gcnt[tid], c) : 0; }
            __syncthreads();
            if (tid < 128) {
                const int q0 = lbase[seg0] + p0, q1 = lbase[seg1] + p1;
                stok[(size_t)seg0 * NTOK + q0] = m0 + tid; sgate[(size_t)seg0 * NTOK + q0] = g0;
                stok[(size_t)seg1 * NTOK + q1] = m0 + tid; sgate[(size_t)seg1 * NTOK + q1] = g1;
            }
        });
    }
}

DI void moe_tables(char* lds, const Ctx& P, int layer) {
    int* cnt = (int*)(lds + LDS_AUX); int* rb0 = cnt + 64; int* hoff = rb0 + 65;
    const int* gcnt = (const int*)(P.ws + OFF_CNT) + layer * 64;
    const int tid = ltid();
    if (tid < 64) cnt[tid] = gcnt[tid];
    __syncthreads();
    if (tid == 0) {
        int acc = 0;
        for (int s = 0; s < 64; ++s) { rb0[s] = acc; hoff[s] = acc * 128; acc += (cnt[s] + 127) >> 7; }
        rb0[64] = acc;
    }
    __syncthreads();
}
DI int moe_find_seg(const int* rb0, int rbi) { int s = 0; while (rb0[s + 1] <= rbi) ++s; return s; }

DI void phase_moe_up(char* lds, const Ctx& P, int layer) {
    moe_tables(lds, P, layer);
    const int* cnt = (const int*)(lds + LDS_AUX); const int* rb0 = cnt + 64; const int* hoff = rb0 + 65;
    const bfr* hb = (const bfr*)(P.ws + OFF_HB);
    const bfr* wgu = (const bfr*)(P.ws + OFF_MWGU);
    const int* stok = (const int*)(P.ws + OFF_TOK);
    bfr* hid = (bfr*)(P.ws + OFF_HID);
    const int ntiles = rb0[64] * 8;
    for (int t = blockIdx.x; t < ntiles; t += gridDim.x) {
        int rbi, nt; tile_remap(t, rb0[64], 8, rbi, nt);
        const int seg = moe_find_seg(rb0, rbi);
        const int rb = rbi - rb0[seg], e = seg & 31, c = cnt[seg];
        const bfr* ap[4];
        const int tq = ltid();
#pragma unroll
        for (int i = 0; i < 4; ++i) {
            int p = rb * 128 + (tq >> 3) + 32 * i; p = p < c ? p : c - 1;
            ap[i] = hb + (size_t)stok[(size_t)seg * NTOK + p] * 1024 + gt_lcol(tq);
        }
        auto aptr = [&](int i, int kt) __attribute__((always_inline)) -> const bfr* { return ap[i] + kt * 64; };
        RowLoader B(wgu + (size_t)e * 1024 * 1024, nt * 128, 1024);
        const size_t hrow0 = (size_t)hoff[seg] + rb * 128;
        gemm_tile(lds, 16, aptr, B, [&](const float* stg) __attribute__((always_inline)) {
            epi_rows8(stg, [&](int r, int c0, const float (&v)[8]) __attribute__((always_inline)) {
                float o[4];
#pragma unroll
                for (int j = 0; j < 4; ++j) o[j] = v[j] * sigmoidf_(v[j]) * v[4 + j];
                *(uint2*)(hid + (hrow0 + r) * 512 + ((nt * 128 + c0) >> 1)) = make_uint2(pk2(o[0], o[1]), pk2(o[2], o[3]));
            });
        });
    }
}

DI void phase_moe_down(char* lds, const Ctx& P, int layer, int k, float* x) {
    moe_tables(lds, P, layer);
    const int* cnt = (const int*)(lds + LDS_AUX); const int* rb0 = cnt + 64; const int* hoff = rb0 + 65;
    const bfr* hid = (const bfr*)(P.ws + OFF_HID);
    const bfr* wd = (const bfr*)(P.ws + OFF_MWD);
    const int* stok = (const int*)(P.ws + OFF_TOK);
    const float* sgate = (const float*)(P.ws + OFF_GATE);
    const int rbA = rb0[k * 32], rbB = rb0[k * 32 + 32];
    const int ntiles = (rbB - rbA) * 8;
    for (int t = blockIdx.x; t < ntiles; t += gridDim.x) {
        int rbi, nt; tile_remap(t, rbB - rbA, 8, rbi, nt); rbi += rbA;
        const int seg = moe_find_seg(rb0, rbi);
        const int rb = rbi - rb0[seg], e = seg & 31, c = cnt[seg];
        RowLoader A(hid, hoff[seg] + rb * 128, 512), B(wd + (size_t)e * 1024 * 512, nt * 128, 512);
        int* ltok = (int*)(lds + LDS_AUX + 1024); float* lgate = (float*)(lds + LDS_AUX + 1536);
        {
            const int tq = ltid();
            if (tq < 128) {
                const int p = rb * 128 + tq;
                ltok[tq] = p < c ? stok[(size_t)seg * NTOK + p] : -1;
                lgate[tq] = p < c ? sgate[(size_t)seg * NTOK + p] : 0.f;
            }
        }
        gemm_tile(lds, 8, A, B, [&](const float* stg) __attribute__((always_inline)) {
            epi_rows8_pre<F8>(stg,
                [&](int r, int c0) __attribute__((always_inline)) -> F8 {
                    int tok = ltok[r]; tok = tok < 0 ? 0 : tok;
                    const float* d = x + (size_t)tok * DM + nt * 128 + c0;
                    F8 o; o.a = *(const float4*)d; o.b = *(const float4*)(d + 4);
                    return o; },
                [&](int r, int c0, const float (&v)[8], const F8& o) __attribute__((always_inline)) {
                    const int tok = ltok[r];
                    if (tok >= 0) {
                        const float gt = lgate[r];
                        float* d = x + (size_t)tok * DM + nt * 128 + c0;
                        *(float4*)d = make_float4(o.a.x + gt * v[0], o.a.y + gt * v[1], o.a.z + gt * v[2], o.a.w + gt * v[3]);
                        *(float4*)(d + 4) = make_float4(o.b.x + gt * v[4], o.b.y + gt * v[5], o.b.z + gt * v[6], o.b.w + gt * v[7]);
                    }
                });
        });
    }
}
constexpr int PH_PER_LAYER = 11;
constexpr int N_PHASES = 1 + 4 * PH_PER_LAYER;

DI void phase_prologue(char* lds, const Ctx& P) {
    for (int u = blockIdx.x; u < 64; u += gridDim.x) s5_tables(lds, P, u >> 5, u & 31);
    unsigned base = 0;
    const int wk = blockIdx.x, nw = gridDim.x;
    for (int i = 0; i < 2; ++i) {
        cvt_matrix(lds, P.in[I_EWIN] + (size_t)i * 1024 * 2304, 1024, 2304, (bfr*)(P.ws + OFF_WINE) + (size_t)i * 2304 * 1024, 1024, 0, wk, nw, base);
        cvt_matrix(lds, P.in[I_EWOUT] + (size_t)i * 1024 * 1024, 1024, 1024, (bfr*)(P.ws + OFF_WOUTE) + (size_t)i * 1024 * 1024, 1024, 0, wk, nw, base);
        cvt_matrix(lds, P.in[I_OWIN] + (size_t)i * 1024 * 2048, 1024, 2048, (bfr*)(P.ws + OFF_WINO) + (size_t)i * 2048 * 1024, 1024, 0, wk, nw, base);
        cvt_matrix(lds, P.in[I_OWOUT] + (size_t)i * 1024 * 1024, 1024, 1024, (bfr*)(P.ws + OFF_WOUTO) + (size_t)i * 1024 * 1024, 1024, 0, wk, nw, base);
        cvt_matrix(lds, P.in[I_W2] + (size_t)i * 64 * 512, 64, 512, (bfr*)(P.ws + OFF_W2T) + (size_t)i * 512 * 64, 64, 0, wk, nw, base);
        cvt_matrix(lds, P.in[I_A2] + (size_t)i * 64 * 512, 64, 512, (bfr*)(P.ws + OFF_A2T) + (size_t)i * 512 * 64, 64, 0, wk, nw, base);
        cvt_matrix(lds, P.in[I_G2] + (size_t)i * 128 * 512, 128, 512, (bfr*)(P.ws + OFF_G2T) + (size_t)i * 512 * 128, 128, 0, wk, nw, base);
        for (int g = 0; g < 4; ++g)
            cvt_matrix(lds, P.in[I_POOLW] + (size_t)(i * 4 + g) * 128 * 128, 128, 128, (bfr*)(P.ws + OFF_POOLT) + (size_t)(i * 4 + g) * 128 * 128, 128, 0, wk, nw, base);
        cvt_matrix(lds, P.in[I_WGLU] + (size_t)i * 512 * 512, 512, 512, (bfr*)(P.ws + OFF_GLUT) + (size_t)i * 512 * 512, 512, 0, wk, nw, base);
    }
    const int gtid = blockIdx.x * NTHREADS + ltid(), gsz = gridDim.x * NTHREADS;
    {
        bfr* rhi = (bfr*)(P.ws + OFF_RHI); bfr* rlo = (bfr*)(P.ws + OFF_RLO);
        for (int idx = gtid; idx < 4 * 128 * 1024; idx += gsz) {
            const int k = idx & 1023, n = (idx >> 10) & 127, l = idx >> 17;
            float w = 0.f;
            if (n < 32) w = P.in[I_MWE][((size_t)l * 1024 + k) * 32 + n];
            else if (n < 36) w = P.in[I_MWG][((size_t)l * 1024 + k) * 4 + (n - 32)];
            const bfr h = f2bf(w);
            rhi[idx] = h; rlo[idx] = f2bf(w - bf2f(h));
        }
    }
    {
        bfr* v12 = (bfr*)(P.ws + OFF_V12T);
        const float* v1 = P.in[I_V1]; const float* v2 = P.in[I_V2];
        for (int idx = gtid; idx < 512 * 512; idx += gsz) {
            const int k = idx & 511, n = idx >> 9;
            float s = 0.f;
            for (int r = 0; r < 32; ++r) s += v1[k * 32 + r] * v2[r * 512 + n];
            v12[idx] = f2bf(s);
        }
    }
    for (int tt = blockIdx.x; tt < 512; tt += gridDim.x)
        norm_rows(P.in[I_X], P.in[I_NMIX], (bfr*)(P.ws + OFF_HB), nullptr, P.out, tt * 64, 64);
}

DI Ctx mkctx(unsigned char* ws, float* out) {
    size_t z = 0;
    asm volatile("" : "+s"(z));
    Ctx c;
    c.in.p = (KArgPtr)__builtin_amdgcn_kernarg_segment_ptr() + z;
    c.ws = ws + z; c.out = (float*)((char*)out + z);
    return c;
}
__global__ void __launch_bounds__(NTHREADS, 2) fwd_kernel(Params PA) {
    extern __shared__ __attribute__((aligned(16))) char lds[];
    if (threadIdx.x == 0) *(uint4*)(lds + LDS_BYTES - 16) = make_uint4(0u, 0u, 0u, 0u);
    __syncthreads();
    XcdBarrier bar = xcd_barrier_post((unsigned*)(PA.ws + OFF_BAR), (volatile LAS unsigned*)(lds + LDS_BYTES - 16));
    const int lo = PA.ph_lo, hi = PA.ph_hi;
#ifndef DUP_PH
#define DUP_PH (-1)
#endif
#define DUPX(k, call) do { call; if (DUP_PH == (k)) { __syncthreads(); call; } } while (0)
#define RUNS(id) ((id) >= lo && (id) < hi)
#define P mkctx(PA.ws, PA.out)
#define SEAM(id) do { if ((id) > lo && (id) < hi) xcd_barrier(bar); } while (0)
    if (RUNS(0)) DUPX(100, phase_prologue(lds, P));
    for (int layer = 0; layer < 4; ++layer) {
        const int base = 1 + layer * PH_PER_LAYER;
        const int li = layer >> 1;
        if ((layer & 1) == 0) {
            SEAM(base + 0); if (RUNS(base + 0)) DUPX(0, phase_e1(lds, P, li));
            SEAM(base + 1); if (RUNS(base + 1)) DUPX(1, phase_e2a(P, li));
            SEAM(base + 2); if (RUNS(base + 2)) DUPX(2, phase_e2b(lds, P, li));
            SEAM(base + 3); if (RUNS(base + 3)) DUPX(3, phase_e3(lds, P, li));
            SEAM(base + 4); if (RUNS(base + 4)) DUPX(4, phase_e4(P, li));
            SEAM(base + 5); if (RUNS(base + 5)) { phase_wout(lds, P, (const bfr*)(P.ws + OFF_WOUTE) + (size_t)li * 1024 * 1024, P.out); if (DUP_PH == 5) phase_wout(lds, P, (const bfr*)(P.ws + OFF_WOUTE) + (size_t)li * 1024 * 1024, (float*)(P.ws + OFF_EV)); }
        } else {
            SEAM(base + 0); if (RUNS(base + 0)) DUPX(10, phase_o1(lds, P, li));
            SEAM(base + 1); if (RUNS(base + 1)) DUPX(11, phase_o2(lds, P, li));
            SEAM(base + 2); if (RUNS(base + 2)) DUPX(12, phase_o3(lds, P, li, layer));
            SEAM(base + 3); if (RUNS(base + 3)) DUPX(13, phase_o4(lds, P, li));
            SEAM(base + 4); if (RUNS(base + 4)) DUPX(14, phase_o5(lds, P, li));
            SEAM(base + 5); if (RUNS(base + 5)) { phase_wout(lds, P, (const bfr*)(P.ws + OFF_WOUTO) + (size_t)li * 1024 * 1024, P.out); if (DUP_PH == 5) phase_wout(lds, P, (const bfr*)(P.ws + OFF_WOUTO) + (size_t)li * 1024 * 1024, (float*)(P.ws + OFF_EV)); }
        }
        SEAM(base + 6);
        if (RUNS(base + 6)) {
            phase_router(lds, P, layer);
            const bool split = gridDim.x >= 512;
            DUPX(6, moe_convert(lds, P, layer, split ? (int)blockIdx.x - 256 : (int)blockIdx.x, split ? (int)gridDim.x - 256 : (int)gridDim.x));
        }
        SEAM(base + 7); if (RUNS(base + 7)) DUPX(7, phase_moe_up(lds, P, layer));
        SEAM(base + 8); if (RUNS(base + 8)) { phase_moe_down(lds, P, layer, 0, P.out); if (DUP_PH == 8) phase_moe_down(lds, P, layer, 0, (float*)(P.ws + OFF_EV)); }
        SEAM(base + 9); if (RUNS(base + 9)) phase_moe_down(lds, P, layer, 1, P.out);
        SEAM(base + 10);
        if (RUNS(base + 10) && layer < 3) {
            for (int rep = 0; rep < (DUP_PH == 20 ? 2 : 1); ++rep)
            for (int tt = blockIdx.x; tt < 512; tt += gridDim.x)
                norm_rows(P.out, P.in[I_NMIX] + (size_t)(layer + 1) * DM, (bfr*)(P.ws + OFF_HB), nullptr, nullptr, tt * 64, 64);
        }
    }
#undef P
#undef RUNS
#undef SEAM
}

#ifndef N_LAUNCH_SPLIT
#define N_LAUNCH_SPLIT 0
#endif
extern "C" void kernel_launch(void* const* d_in, const int* in_sizes, int n_in, void* d_out, int out_size, void* d_ws, size_t ws_size, hipStream_t stream) {
    static int grid = 0;
    if (grid == 0) {
        if (n_in != N_INPUTS || out_size != NTOK * DM || ws_size < WS_NEEDED) {
            fprintf(stderr, "kernel_launch: unexpected shapes: n_in %d out %d ws %zu (need %zu)\n", n_in, out_size, ws_size, (size_t)WS_NEEDED);
            grid = -1; return;
        }
        int dev = 0, cus = 0, per_cu = 0;
        (void)hipGetDevice(&dev);
        (void)hipDeviceGetAttribute(&cus, hipDeviceAttributeMultiprocessorCount, dev);
        if (hipFuncSetAttribute((const void*)fwd_kernel, hipFuncAttributeMaxDynamicSharedMemorySize, LDS_BYTES) != hipSuccess) { fprintf(stderr, "kernel_launch: hipFuncSetAttribute failed\n"); grid = -1; return; }
        if (hipOccupancyMaxActiveBlocksPerMultiprocessor(&per_cu, (const void*)fwd_kernel, NTHREADS, LDS_BYTES) != hipSuccess) per_cu = 1;
        (void)hipGetLastError();
        if (per_cu < 1) per_cu = 1;
        if (per_cu > 2) per_cu = 2;
        if (cus <= 0) cus = 256;
        grid = cus * per_cu;
    }
    if (grid < 0) return;
    (void)hipMemsetAsync(d_ws, 0, OFF_ZERO_END, stream);
    Params p{};
    for (int i = 0; i < N_INPUTS; ++i) p.in[i] = (const float*)d_in[i];
    p.out = (float*)d_out; p.ws = (unsigned char*)d_ws;
#if N_LAUNCH_SPLIT
    for (int ph = 0; ph < N_PHASES - 1; ++ph) {
        p.ph_lo = ph; p.ph_hi = ph + 1;
        hipLaunchKernelGGL(fwd_kernel, dim3(grid), dim3(NTHREADS), LDS_BYTES, stream, p);
    }
#else
    p.ph_lo = 0; p.ph_hi = N_PHASES;
    hipLaunchKernelGGL(fwd_kernel, dim3(grid), dim3(NTHREADS), LDS_BYTES, stream, p);
#endif
}
```

```cpp
#include <hip/hip_runtime.h>
#include <stdint.h>
#include <stdio.h>

typedef unsigned short bfr;
typedef __attribute__((ext_vector_type(8))) short bf16x8;
typedef __attribute__((ext_vector_type(16))) float f32x16;
typedef __attribute__((ext_vector_type(2))) __bf16 bf16x2_t;
#define DI __device__ __forceinline__
#define MFMA32(a, b, c) __builtin_amdgcn_mfma_f32_32x32x16_bf16((a), (b), (c), 0, 0, 0)

constexpr int NTOK = 32768, DM = 1024, SEQ = 2048, NB = 16;
constexpr int EVEN_IN = 2304, ODD_IN = 2048;
constexpr int NTHREADS = 256;
constexpr int LDS_BYTES = 81920;

enum { I_X = 0, I_NMIX, I_NFFN, I_EWIN, I_MU, I_W0, I_W2, I_A0, I_A2, I_G2, I_KK, I_KA, I_RK, I_LNG, I_LNB, I_V0, I_V1, I_V2,
       I_POOLW, I_POOLS, I_EWOUT, I_OWIN, I_QN, I_KN, I_LQ1, I_LK1, I_LQ2, I_LK2, I_SUBLN, I_ARE, I_AIM, I_LSTEP, I_BRE, I_BIM,
       I_CRE, I_CIM, I_S5D, I_WGLU, I_OWOUT, I_MWG, I_MBG, I_MWE, I_MBE, I_MWGATE, I_MWUP, I_MWDOWN, N_INPUTS };

constexpr size_t al256(size_t x) { return (x + 255) & ~(size_t)255; }
constexpr size_t OFF_BAR   = 0;
constexpr size_t OFF_CNT   = 16384;
constexpr size_t OFF_ZERO_END = 32768;
constexpr size_t OFF_WINE  = 65536;
constexpr size_t OFF_WOUTE = OFF_WINE  + (size_t)2 * 2304 * 1024 * 2;
constexpr size_t OFF_WINO  = OFF_WOUTE + (size_t)2 * 1024 * 1024 * 2;
constexpr size_t OFF_WOUTO = OFF_WINO  + (size_t)2 * 2048 * 1024 * 2;
constexpr size_t OFF_W2T   = OFF_WOUTO + (size_t)2 * 1024 * 1024 * 2;
constexpr size_t OFF_A2T   = OFF_W2T   + (size_t)2 * 512 * 64 * 2;
constexpr size_t OFF_G2T   = OFF_A2T   + (size_t)2 * 512 * 64 * 2;
constexpr size_t OFF_V12T  = OFF_G2T   + (size_t)2 * 512 * 128 * 2;
constexpr size_t OFF_POOLT = OFF_V12T  + (size_t)512 * 512 * 2;
constexpr size_t OFF_GLUT  = OFF_POOLT + (size_t)2 * 4 * 128 * 128 * 2;
constexpr size_t OFF_RHI   = OFF_GLUT  + (size_t)2 * 512 * 512 * 2;
constexpr size_t OFF_RLO   = OFF_RHI   + (size_t)4 * 128 * 1024 * 2;
constexpr size_t OFF_S5GT  = OFF_RLO   + (size_t)4 * 128 * 1024 * 2;
constexpr size_t OFF_S5BL  = OFF_S5GT  + (size_t)2 * 32 * 512 * 640 * 2;
constexpr size_t OFF_S5L32 = OFF_S5BL  + (size_t)2 * 32 * 128 * 512 * 2;
constexpr size_t OFF_MWGU  = al256(OFF_S5L32 + (size_t)2 * 32 * 64 * 2 * 4);
constexpr size_t OFF_MWD   = OFF_MWGU  + (size_t)32 * 1024 * 1024 * 2;
constexpr size_t OFF_HB    = OFF_MWD   + (size_t)32 * 1024 * 512 * 2;
constexpr size_t OFF_U     = OFF_HB    + (size_t)NTOK * 1024 * 2;
constexpr size_t OFF_US5   = OFF_U     + (size_t)NTOK * 1024 * 2;
constexpr size_t OFF_AMIX  = OFF_U     + (size_t)NTOK * 2304 * 2;
constexpr size_t OFF_VFIRST= OFF_AMIX  + (size_t)NTOK * 1024 * 2;
constexpr size_t OFF_TOK   = OFF_VFIRST+ (size_t)NTOK * 512 * 2;
constexpr size_t OFF_GATE  = OFF_TOK   + (size_t)64 * NTOK * 4;
constexpr size_t OFF_HID   = OFF_GATE  + (size_t)64 * NTOK * 4;
constexpr size_t OFF_HLO   = OFF_HID;
constexpr size_t OFF_EV    = OFF_HID   + (size_t)73728 * 512 * 2;
constexpr size_t OFF_S     = OFF_EV;
constexpr size_t OFF_MV2   = OFF_S     + (size_t)NTOK * 256 * 2;
constexpr size_t OFF_DLOG  = OFF_MV2   + (size_t)NTOK * 512 * 2;
constexpr size_t OFF_ABUF  = OFF_DLOG  + (size_t)NTOK * 512 * 4;
constexpr size_t OFF_GBUF  = OFF_ABUF  + (size_t)NTOK * 512 * 2;
constexpr size_t OFF_VGATE = OFF_GBUF  + (size_t)NTOK * 512 * 2;
constexpr size_t OFF_Y     = OFF_VGATE + (size_t)NTOK * 512 * 2;
constexpr size_t OFF_DPOOL = OFF_Y;
constexpr size_t OFF_BONUS = OFF_Y     + (size_t)NTOK * 512 * 4;
constexpr size_t OFF_EV_END= OFF_BONUS + (size_t)NTOK * 512 * 4;
constexpr size_t OFF_QN    = OFF_EV;
constexpr size_t OFF_KN    = OFF_QN    + (size_t)NTOK * 512 * 2;
constexpr size_t OFF_VT    = OFF_KN    + (size_t)NTOK * 512 * 2;
constexpr size_t OFF_XLOC  = OFF_VT    + (size_t)NTOK * 512 * 2;
constexpr size_t OFF_XIN   = OFF_XLOC  + (size_t)32 * 1024 * 128 * 4;
constexpr size_t OFF_ZBUF  = OFF_XIN   + (size_t)32 * 1024 * 128 * 2;
constexpr size_t OFF_OD_END= OFF_ZBUF  + (size_t)NTOK * 512 * 2;
constexpr size_t WS_NEEDED = OFF_EV_END > OFF_OD_END ? OFF_EV_END : OFF_OD_END;

struct Params {
    const float* in[N_INPUTS];
    float* out;
    unsigned char* ws;
    int ph_lo, ph_hi;
};
typedef const __attribute__((address_space(4))) char* KArgPtr;
struct InTab {
    KArgPtr p;
    DI const float* operator[](int i) const {
        const float* q = *(const float* const __attribute__((address_space(4)))*)(p + 8 * i);
        return (const float*)(const __attribute__((address_space(1))) float*)q;
    }
};
struct Ctx { InTab in; unsigned char* ws; float* out; };

DI unsigned pk2(float a, float b) { bf16x2_t v; v[0] = (__bf16)a; v[1] = (__bf16)b; return __builtin_bit_cast(unsigned, v); }
DI bfr f2bf(float a) { return (bfr)(pk2(a, 0.f) & 0xffffu); }
DI float bf2f(bfr b) { return __uint_as_float(((unsigned)b) << 16); }
DI float bflo(unsigned u) { return __uint_as_float(u << 16); }
DI float bfhi(unsigned u) { return __uint_as_float(u & 0xffff0000u); }
DI uint4 pack8(const float (&v)[8]) { return make_uint4(pk2(v[0], v[1]), pk2(v[2], v[3]), pk2(v[4], v[5]), pk2(v[6], v[7])); }
DI void unpack8(uint4 u, float (&v)[8]) { v[0] = bflo(u.x); v[1] = bfhi(u.x); v[2] = bflo(u.y); v[3] = bfhi(u.y); v[4] = bflo(u.z); v[5] = bfhi(u.z); v[6] = bflo(u.w); v[7] = bfhi(u.w); }
DI float frcp(float x) { return __builtin_amdgcn_rcpf(x); }
DI float fexp(float x) { return __builtin_amdgcn_exp2f(x * 1.4426950408889634f); }
DI float sigmoidf_(float x) { return frcp(1.0f + fexp(-x)); }
DI float ftanh(float x) { return 2.0f * frcp(1.0f + fexp(-2.0f * x)) - 1.0f; }
DI float fsoftplus(float z) { return z > 20.0f ? z : __logf(1.0f + fexp(z)); }
template <int CTRL> DI float dpp_f(float x) { return __builtin_bit_cast(float, __builtin_amdgcn_update_dpp(0, __builtin_bit_cast(int, x), CTRL, 0xf, 0xf, false)); }
DI float row16_sum(float s) {
    s += dpp_f<0x128>(s); s += dpp_f<0x124>(s); s += dpp_f<0x122>(s); s += dpp_f<0x121>(s); return s; }
DI int ltid() { int t = threadIdx.x; asm volatile("" : "+v"(t)); return t; }
DI float dot4n(float s0, float s1, float s2, float s3, const float4& a) {
    float d;
    asm("v_mul_f32 %0, %1, %5\n\tv_fma_f32 %0, %2, %6, %0\n\tv_fma_f32 %0, %3, %7, %0\n\tv_fma_f32 %0, %4, %8, %0\n\ts_nop 1"
        : "=&v"(d) : "v"(s0), "v"(s1), "v"(s2), "v"(s3), "v"(a.x), "v"(a.y), "v"(a.z), "v"(a.w));
    return d;
}
DI void rw_upd(float& S, float w, float sa, float b, float vi, float k) {
    float t;
    asm("v_mul_f32 %1, %4, %5\n\tv_fma_f32 %1, %2, %3, %1\n\tv_fma_f32 %0, %0, %6, %1"
        : "+v"(S), "=&v"(t) : "v"(sa), "v"(b), "v"(vi), "v"(k), "v"(w));
}
DI float wave_sum(float s) { s = row16_sum(s); s += __shfl_xor(s, 16); s += __shfl_xor(s, 32); return s; }
#define XB_TMO      128
#define XB_XCNT(j)  (256  + 64 * (j))
#define XB_XSUB(j)  (1280 + 64 * (j))
#define XB_XGEN(j)  (2304 + 64 * (j))
#define XB_TOP      3328
#define XB_TOPGEN   3392
#define XCD_BAR_WORDS 3456
#define XB_SPIN_CAP (1u << 18)
#define LAS __attribute__((address_space(3)))

__device__ __forceinline__ unsigned xb_ld(unsigned* p)              { return __hip_atomic_load(p, __ATOMIC_RELAXED, __HIP_MEMORY_SCOPE_AGENT); }
__device__ __forceinline__ unsigned xb_add(unsigned* p, unsigned v) { return __hip_atomic_fetch_add(p, v, __ATOMIC_RELAXED, __HIP_MEMORY_SCOPE_AGENT); }
__device__ __forceinline__ unsigned xb_xcc_id() { return (unsigned)__builtin_amdgcn_s_getreg((3 << 11) | 20) & 0xFu; }
#define XB_SPIN(cond, bar) do { unsigned _sp = 0; while (cond) { __builtin_amdgcn_s_sleep(1); \
    if ((++_sp & 255u) == 0u) { if (xb_ld(&(bar)[XB_TMO])) break; if (_sp > XB_SPIN_CAP) { atomicAdd(&(bar)[XB_TMO], 1u); break; } } } } while (0)

struct XcdBarrier {
    unsigned* bar; unsigned x;
    volatile LAS unsigned* st;
};
__device__ __forceinline__ XcdBarrier xcd_barrier_post(unsigned* bar, volatile LAS unsigned* st) {
    XcdBarrier b; b.bar = bar; b.x = xb_xcc_id(); b.st = st;
    if (threadIdx.x == 0) (void)xb_add(&bar[XB_XCNT(b.x)], 1u);
    return b;
}
__device__ __forceinline__ void xcd_barrier_complete(unsigned* bar, unsigned x, unsigned& nloc, unsigned& nx) {
    const unsigned G = gridDim.x * gridDim.y * gridDim.z;
    unsigned sum, cnt, mine, sp = 0u;
    for (;;) {
        sum = 0u; cnt = 0u; mine = 0u;
#pragma unroll
        for (unsigned j = 0; j < 16; ++j) { const unsigned c = xb_ld(&bar[XB_XCNT(j)]); sum += c; cnt += (c > 0u) ? 1u : 0u; mine = (j == x) ? c : mine; }
        if (sum == G) break;
        __builtin_amdgcn_s_sleep(1);
        if ((++sp & 255u) == 0u) { if (xb_ld(&bar[XB_TMO])) break; if (sp > XB_SPIN_CAP) { atomicAdd(&bar[XB_TMO], 1u); break; } }
    }
    nloc = mine > 0u ? mine : 1u; nx = cnt > 0u ? cnt : 1u;
}
__device__ __forceinline__ void xcd_barrier(const XcdBarrier& b) {
    asm volatile("s_waitcnt vmcnt(0)" ::: "memory");
    __syncthreads();
    if (threadIdx.x == 0) {
        unsigned* bar = b.bar;
        __builtin_amdgcn_s_waitcnt(0);
        unsigned nloc = b.st[0], nx = b.st[1];
        if (nloc == 0u) { xcd_barrier_complete(bar, b.x, nloc, nx); b.st[0] = nloc; b.st[1] = nx; }
        const unsigned old = xb_add(&bar[XB_XSUB(b.x)], 1u);
        const unsigned gen = old / nloc;
        if (old + 1u == (gen + 1u) * nloc) {
            __builtin_amdgcn_fence(__ATOMIC_RELEASE, "agent");
            asm volatile("s_waitcnt vmcnt(0)" ::: "memory");
            const unsigned og = xb_add(&bar[XB_TOP], 1u);
            const unsigned tg = og / nx;
            if (og + 1u == (tg + 1u) * nx) xb_add(&bar[XB_TOPGEN], 1u);
            else XB_SPIN(xb_ld(&bar[XB_TOPGEN]) == tg, bar);
            __builtin_amdgcn_fence(__ATOMIC_ACQUIRE, "agent");
            xb_add(&bar[XB_XGEN(b.x)], 1u);
            asm volatile("s_waitcnt vmcnt(0)" ::: "memory");
        } else {
            XB_SPIN(xb_ld(&bar[XB_XGEN(b.x)]) == gen, bar);
            __builtin_amdgcn_fence(__ATOMIC_ACQUIRE, "agent");
            asm volatile("s_waitcnt vmcnt(0)" ::: "memory");
        }
    }
    __syncthreads();
}

constexpr int LDA = 72;
constexpr int TILE_B = 128 * LDA * 2;
constexpr int GT_TILE = 128 * 128;
constexpr int STG_LD = 132;
constexpr int LDS_AUX = 73728;
typedef const __attribute__((address_space(1))) unsigned* GPtrU;
typedef __attribute__((address_space(3))) unsigned* LPtrU;
DI int gt_lcol(int t) { return (((t & 7) ^ ((t >> 4) & 7)) * 8); }

template <class AF, class BF, class EF>
DI void gemm_tile(char* lds, int nk, AF aptr, BF bptr, EF epi) {
    const int tid = ltid(), lane = tid & 63, wave = tid >> 6;
    const int wr = wave >> 1, wc = wave & 1;
    f32x16 acc00, acc01, acc10, acc11;
#pragma unroll
    for (int r = 0; r < 16; ++r) { acc00[r] = 0.f; acc01[r] = 0.f; acc10[r] = 0.f; acc11[r] = 0.f; }
#define GT_DMA(kt_, base_) do { char* db_ = (base_) + tid * 16; _Pragma("unroll") for (int i_ = 0; i_ < 4; ++i_) { \
        __builtin_amdgcn_global_load_lds((GPtrU)aptr(i_, kt_), (LPtrU)(db_ + i_ * 4096), 16, 0, 0); \
        __builtin_amdgcn_global_load_lds((GPtrU)bptr(i_, kt_), (LPtrU)(db_ + GT_TILE + i_ * 4096), 16, 0, 0); } } while (0)
#define GT_FRAG(cb_, off_) (*(const bf16x8*)((cb_) + (off_)))
#define GT_COMPUTE(base_) do { const char* cb_ = (base_); \
        { const bf16x8 a0 = GT_FRAG(cb_, ao0), a1 = GT_FRAG(cb_, ao0 + 4096), b0 = GT_FRAG(cb_, bo0), b1 = GT_FRAG(cb_, bo0 + 4096); \
          acc00 = MFMA32(a0, b0, acc00); acc01 = MFMA32(a0, b1, acc01); acc10 = MFMA32(a1, b0, acc10); acc11 = MFMA32(a1, b1, acc11); } \
        { const bf16x8 a0 = GT_FRAG(cb_, ao1), a1 = GT_FRAG(cb_, ao1 + 4096), b0 = GT_FRAG(cb_, bo1), b1 = GT_FRAG(cb_, bo1 + 4096); \
          acc00 = MFMA32(a0, b0, acc00); acc01 = MFMA32(a0, b1, acc01); acc10 = MFMA32(a1, b0, acc10); acc11 = MFMA32(a1, b1, acc11); } \
        { const bf16x8 a0 = GT_FRAG(cb_, ao2), a1 = GT_FRAG(cb_, ao2 + 4096), b0 = GT_FRAG(cb_, bo2), b1 = GT_FRAG(cb_, bo2 + 4096); \
          acc00 = MFMA32(a0, b0, acc00); acc01 = MFMA32(a0, b1, acc01); acc10 = MFMA32(a1, b0, acc10); acc11 = MFMA32(a1, b1, acc11); } \
        { const bf16x8 a0 = GT_FRAG(cb_, ao3), a1 = GT_FRAG(cb_, ao3 + 4096), b0 = GT_FRAG(cb_, bo3), b1 = GT_FRAG(cb_, bo3 + 4096); \
          acc00 = MFMA32(a0, b0, acc00); acc01 = MFMA32(a0, b1, acc01); acc10 = MFMA32(a1, b0, acc10); acc11 = MFMA32(a1, b1, acc11); } } while (0)
    const int ln = lane & 31, hf = lane >> 5, sw = (ln >> 1) & 7;
    int ao0 = wr * 8192 + ln * 128 + ((0 + hf) ^ sw) * 16, ao1 = wr * 8192 + ln * 128 + ((2 + hf) ^ sw) * 16;
    int ao2 = wr * 8192 + ln * 128 + ((4 + hf) ^ sw) * 16, ao3 = wr * 8192 + ln * 128 + ((6 + hf) ^ sw) * 16;
    int bo0 = GT_TILE + wc * 8192 + ln * 128 + ((0 + hf) ^ sw) * 16, bo1 = GT_TILE + wc * 8192 + ln * 128 + ((2 + hf) ^ sw) * 16;
    int bo2 = GT_TILE + wc * 8192 + ln * 128 + ((4 + hf) ^ sw) * 16, bo3 = GT_TILE + wc * 8192 + ln * 128 + ((6 + hf) ^ sw) * 16;
    asm volatile("" : "+v"(ao0), "+v"(ao1), "+v"(ao2), "+v"(ao3), "+v"(bo0), "+v"(bo1), "+v"(bo2), "+v"(bo3));
    GT_DMA(0, lds);
    asm volatile("s_waitcnt vmcnt(0)" ::: "memory");
    __syncthreads();
    int buf = 0;
#pragma unroll 1
    for (int kt = 0; kt < nk - 1; ++kt) {
        GT_DMA(kt + 1, lds + (buf ^ 1) * (2 * GT_TILE));
        GT_COMPUTE(lds + buf * (2 * GT_TILE));
        asm volatile("s_waitcnt vmcnt(0)" ::: "memory");
        __syncthreads();
        buf ^= 1;
    }
    GT_COMPUTE(lds + buf * (2 * GT_TILE));
    __syncthreads();
#undef GT_DMA
#undef GT_FRAG
#undef GT_COMPUTE
    float* stg = (float*)lds;
    int w_off = (wr * 64 + 4 * (lane >> 5)) * STG_LD + wc * 64 + (lane & 31);
    asm volatile("" : "+v"(w_off));
#pragma unroll
    for (int r = 0; r < 16; ++r) {
        const int ro = ((r & 3) + 8 * (r >> 2)) * STG_LD;
        stg[w_off + ro] = acc00[r];
        stg[w_off + ro + 32] = acc01[r];
        stg[w_off + ro + 32 * STG_LD] = acc10[r];
        stg[w_off + ro + 32 * STG_LD + 32] = acc11[r];
    }
    __syncthreads();
    epi((const float*)stg);
    __syncthreads();
}
constexpr int G2_STAGE = 128 * 64 + 256 * 64;
DI int gt2_lcol(int t) { return (((t & 3) ^ ((t >> 4) & 3)) * 8); }
DI int g2_col(int cs, int p) { return (cs >> 6) * 128 + p * 64 + (cs & 63); }
template <class AF, class BF, class EF>
DI void gemm_tile256(char* lds, int nk, AF aptr, BF bptr, EF epi, int probe = 0) {
    const int tid = ltid(), lane = tid & 63, wave = tid >> 6;
    const int wr = wave >> 1, wc = wave & 1;
    f32x16 c00, c01, c02, c03, c10, c11, c12, c13;
#pragma unroll
    for (int r = 0; r < 16; ++r) { c00[r] = 0.f; c01[r] = 0.f; c02[r] = 0.f; c03[r] = 0.f; c10[r] = 0.f; c11[r] = 0.f; c12[r] = 0.f; c13[r] = 0.f; }
#define G2_DMA(kt_, base_) do { char* db_ = (base_) + tid * 16; \
        __builtin_amdgcn_global_load_lds((GPtrU)aptr(0, kt_), (LPtrU)(db_), 16, 0, 0); \
        __builtin_amdgcn_global_load_lds((GPtrU)aptr(1, kt_), (LPtrU)(db_ + 4096), 16, 0, 0); \
        __builtin_amdgcn_global_load_lds((GPtrU)bptr(0, kt_), (LPtrU)(db_ + 8192), 16, 0, 0); \
        __builtin_amdgcn_global_load_lds((GPtrU)bptr(1, kt_), (LPtrU)(db_ + 12288), 16, 0, 0); \
        __builtin_amdgcn_global_load_lds((GPtrU)bptr(2, kt_), (LPtrU)(db_ + 16384), 16, 0, 0); \
        __builtin_amdgcn_global_load_lds((GPtrU)bptr(3, kt_), (LPtrU)(db_ + 20480), 16, 0, 0); } while (0)
#define G2_FR(cb_, off_) (*(const bf16x8*)((cb_) + (off_)))
#define G2_KS(cb_, ao_, bo_) do { const bf16x8 a0 = G2_FR(cb_, ao_), a1 = G2_FR(cb_, ao_ + 2048); \
        const bf16x8 b0 = G2_FR(cb_, bo_), b1 = G2_FR(cb_, bo_ + 2048), b2 = G2_FR(cb_, bo_ + 4096), b3 = G2_FR(cb_, bo_ + 6144); \
        c00 = MFMA32(a0, b0, c00); c01 = MFMA32(a0, b1, c01); c02 = MFMA32(a0, b2, c02); c03 = MFMA32(a0, b3, c03); \
        c10 = MFMA32(a1, b0, c10); c11 = MFMA32(a1, b1, c11); c12 = MFMA32(a1, b2, c12); c13 = MFMA32(a1, b3, c13); } while (0)
    const int ln = lane & 31, hf = lane >> 5, sw = (ln >> 2) & 3;
    int ao0 = (wr * 64 + ln) * 64 + ((0 + hf) ^ sw) * 16, ao1 = (wr * 64 + ln) * 64 + ((2 + hf) ^ sw) * 16;
    int bo0 = 8192 + (wc * 128 + ln) * 64 + ((0 + hf) ^ sw) * 16, bo1 = 8192 + (wc * 128 + ln) * 64 + ((2 + hf) ^ sw) * 16;
    asm volatile("" : "+v"(ao0), "+v"(ao1), "+v"(bo0), "+v"(bo1));
    G2_DMA(0, lds);
    if (nk > 1) G2_DMA(1, lds + G2_STAGE);
    int st = 0;
#pragma unroll 1
    for (int kt = 0; kt < nk; ++kt) {
        if (probe != 1) {
        if (kt + 1 < nk) asm volatile("s_waitcnt vmcnt(6)" ::: "memory"); else asm volatile("s_waitcnt vmcnt(0)" ::: "memory");
        __builtin_amdgcn_s_barrier();
        }
        asm volatile("" ::: "memory");
        const char* cb = lds + st * G2_STAGE;
        G2_KS(cb, ao0, bo0);
        __builtin_amdgcn_sched_barrier(0);
        if (kt + 2 < nk && probe == 0) { const int s2 = st >= 1 ? st - 1 : 2; G2_DMA(kt + 2, lds + s2 * G2_STAGE); }
        __builtin_amdgcn_sched_barrier(0);
        G2_KS(cb, ao1, bo1);
        st = st == 2 ? 0 : st + 1;
    }
    __syncthreads();
#undef G2_DMA
#undef G2_FR
#undef G2_KS
    float* stg = (float*)lds;
    int w_off = (wr * 64 + 4 * (lane >> 5)) * STG_LD + wc * 64 + (lane & 31);
    asm volatile("" : "+v"(w_off));
#define G2_STAGE_OUT(x00_, x01_, x10_, x11_) do { _Pragma("unroll") for (int r = 0; r < 16; ++r) { const int ro = ((r & 3) + 8 * (r >> 2)) * STG_LD; \
        stg[w_off + ro] = x00_[r]; stg[w_off + ro + 32] = x01_[r]; stg[w_off + ro + 32 * STG_LD] = x10_[r]; stg[w_off + ro + 32 * STG_LD + 32] = x11_[r]; } } while (0)
    G2_STAGE_OUT(c00, c01, c10, c11);
    __syncthreads();
    epi((const float*)stg, 0);
    __syncthreads();
    G2_STAGE_OUT(c02, c03, c12, c13);
    __syncthreads();
    epi((const float*)stg, 1);
    __syncthreads();
#undef G2_STAGE_OUT
}
struct RowLoader2 {
    const bfr* p; size_t ld;
    DI RowLoader2(const bfr* base, int row0, size_t ld_) : ld(ld_) { const int t = ltid(); p = base + (size_t)(row0 + (t >> 2)) * ld_ + gt2_lcol(t); }
    DI const bfr* operator()(int i, int kt) const { return p + (size_t)(64 * i) * ld + kt * 32; }
};
template <class F> DI void epi_rows8(const float* stg, F f) {
    const int tid0 = ltid();
#pragma unroll
    for (int it = 0; it < 8; ++it) {
        const int idx = it * NTHREADS + tid0;
        const int r = idx >> 4, c0 = (idx & 15) * 8;
        const float4 p = *(const float4*)(stg + r * STG_LD + c0);
        const float4 q = *(const float4*)(stg + r * STG_LD + c0 + 4);
        const float v[8] = {p.x, p.y, p.z, p.w, q.x, q.y, q.z, q.w};
        f(r, c0, v);
    }
}
template <class T, class L, class F> DI void epi_rows8_pre(const float* stg, L loadf, F f) {
    const int tid0 = ltid();
    T pre[8];
#pragma unroll
    for (int it = 0; it < 8; ++it) { const int idx = it * NTHREADS + tid0; pre[it] = loadf(idx >> 4, (idx & 15) * 8); }
#pragma unroll
    for (int it = 0; it < 8; ++it) {
        const int idx = it * NTHREADS + tid0;
        const int r = idx >> 4, c0 = (idx & 15) * 8;
        const float4 p = *(const float4*)(stg + r * STG_LD + c0);
        const float4 q = *(const float4*)(stg + r * STG_LD + c0 + 4);
        const float v[8] = {p.x, p.y, p.z, p.w, q.x, q.y, q.z, q.w};
        f(r, c0, v, pre[it]);
    }
}
struct F8 { float4 a, b; };
template <class F> DI void epi2_rows8(const float* stg, int p, F f) {
    epi_rows8(stg, [&](int r, int c0, const float (&v)[8]) __attribute__((always_inline)) { f(r, g2_col(c0, p), v); });
}
template <class T, class L, class F> DI void epi2_rows8_pre(const float* stg, int p, L loadf, F f) {
    epi_rows8_pre<T>(stg, [&](int r, int c0) __attribute__((always_inline)) -> T { return loadf(r, g2_col(c0, p)); },
                     [&](int r, int c0, const float (&v)[8], const T& o) __attribute__((always_inline)) { f(r, g2_col(c0, p), v, o); });
}
DI void tile_remap(int L, int nM, int nN, int& pm, int& pn) {
    const int ntiles = nM * nN;
    int w = L;
    if ((ntiles & 7) == 0) w = (L & 7) * (ntiles >> 3) + (L >> 3);
    const int nig = 8 * nN, gid = w / nig, fm = gid * 8, rem = w - gid * nig;
    const int gsz = (nM - fm) < 8 ? (nM - fm) : 8;
    pm = fm + rem % gsz; pn = rem / gsz;
}
struct RowLoader {
    const bfr* p; size_t ld;
    DI RowLoader(const bfr* base, int row0, size_t ld_) : ld(ld_) { const int t = ltid(); p = base + (size_t)(row0 + (t >> 3)) * ld_ + gt_lcol(t); }
    DI const bfr* operator()(int i, int kt) const { return p + (size_t)(32 * i) * ld + kt * 64; }
};
DI int cvt_rowmap(int n, int mode) { return mode == 0 ? n : ((n >> 2) * 8 + (n & 3) + (mode == 2 ? 4 : 0)); }
DI void cvt_tile(char* lds, const float* __restrict__ src, int N, bfr* __restrict__ dst, int ldd, int k0, int n0, int mode) {
    float* t = (float*)lds;
    const int tid = ltid();
    const int r = tid >> 4, c = (tid & 15) * 4;
#pragma unroll
    for (int i = 0; i < 4; ++i) {
        const float4 v = *(const float4*)(src + (size_t)(k0 + r + 16 * i) * N + n0 + c);
        float* d = t + (r + 16 * i) * 65 + c;
        d[0] = v.x; d[1] = v.y; d[2] = v.z; d[3] = v.w;
    }
    __syncthreads();
#pragma unroll
    for (int i = 0; i < 2; ++i) {
        const int idx = tid + i * 256;
        const int n = idx & 63, kg = idx >> 6;
        float v[8];
#pragma unroll
        for (int j = 0; j < 8; ++j) v[j] = t[(kg * 8 + j) * 65 + n];
        *(uint4*)(dst + (size_t)cvt_rowmap(n0 + n, mode) * ldd + k0 + kg * 8) = pack8(v);
    }
    __syncthreads();
}
DI void cvt_matrix(char* lds, const float* src, int K, int N, bfr* dst, int ldd, int mode, int worker, int nworkers, unsigned& base) {
    if (worker < 0) return;
    const int ntn = N >> 6, ntiles = (K >> 6) * ntn;
    int t0 = (int)(((unsigned)worker + (unsigned)nworkers - (base % (unsigned)nworkers)) % (unsigned)nworkers);
    for (int t = t0; t < ntiles; t += nworkers) cvt_tile(lds, src, N, dst, ldd, (t / ntn) * 64, (t % ntn) * 64, mode);
    base += (unsigned)ntiles;
}
DI void moe_convert(char* lds, const Ctx& P, int layer, int worker, int nworkers) {
    unsigned base = 0;
    bfr* wgu = (bfr*)(P.ws + OFF_MWGU); bfr* wd = (bfr*)(P.ws + OFF_MWD);
    for (int e = 0; e < 32; ++e) {
        const size_t we = (size_t)(layer * 32 + e);
        cvt_matrix(lds, P.in[I_MWGATE] + we * 1024 * 512, 1024, 512, wgu + (size_t)e * 1024 * 1024, 1024, 1, worker, nworkers, base);
        cvt_matrix(lds, P.in[I_MWUP]   + we * 1024 * 512, 1024, 512, wgu + (size_t)e * 1024 * 1024, 1024, 2, worker, nworkers, base);
        cvt_matrix(lds, P.in[I_MWDOWN] + we * 512 * 1024, 512, 1024, wd  + (size_t)e * 1024 * 512,  512,  0, worker, nworkers, base);
    }
}

DI void s5_tables(char* lds, const Ctx& P, int i, int g) {
    float2* pw = (float2*)lds;
    float2* bb = pw + 64 * 33;
    float2* cm = bb + 64 * 16;
    float*  kt = (float*)(cm + 16 * 64);
    const int tid = ltid();
    const size_t gp = (size_t)(i * 32 + g) * 64;
    for (int idx = tid; idx < 64 * 33; idx += NTHREADS) {
        const int p = idx / 33, tau = idx % 33;
        const float re = fminf(P.in[I_ARE][gp + p], -1e-4f), im = P.in[I_AIM][gp + p];
        const float st = expf(P.in[I_LSTEP][gp + p]);
        const float mag = expf(re * st * (float)tau);
        const double angd = (double)im * (double)st * (double)tau;
        const double red = angd - 6.283185307179586 * floor(angd * 0.15915494309189535);
        float sn, cs; sincosf((float)red, &sn, &cs);
        pw[idx] = make_float2(mag * cs, mag * sn);
    }
    for (int idx = tid; idx < 64 * 16; idx += NTHREADS) {
        const int p = idx >> 4, c = idx & 15;
        const double re = fmin((double)P.in[I_ARE][gp + p], -1e-4), im = (double)P.in[I_AIM][gp + p];
        const double st = exp((double)P.in[I_LSTEP][gp + p]);
        const double mag = exp(re * st), lr = mag * cos(im * st) - 1.0, li = mag * sin(im * st);
        const double den = re * re + im * im;
        const double fr = (lr * re + li * im) / den, fi = (li * re - lr * im) / den;
        const double br = (double)P.in[I_BRE][(gp + p) * 16 + c], bi = (double)P.in[I_BIM][(gp + p) * 16 + c];
        bb[idx] = make_float2((float)(fr * br - fi * bi), (float)(fr * bi + fi * br));
        const int cc = idx >> 6, pp = idx & 63;
        cm[idx] = make_float2(P.in[I_CRE][((size_t)(i * 32 + g) * 16 + cc) * 64 + pp], P.in[I_CIM][((size_t)(i * 32 + g) * 16 + cc) * 64 + pp]);
    }
    __syncthreads();
    for (int idx = tid; idx < 32 * 256; idx += NTHREADS) {
        const int tau = idx >> 8, c1 = (idx >> 4) & 15, c = idx & 15;
        float s = 0.f;
        for (int p = 0; p < 64; ++p) {
            const float2 a = cm[c1 * 64 + p], w = pw[p * 33 + tau], b = bb[p * 16 + c];
            const float tr = a.x * w.x - a.y * w.y, ti = a.x * w.y + a.y * w.x;
            s += tr * b.x - ti * b.y;
        }
        kt[idx] = s;
    }
    __syncthreads();
    bfr* gt = (bfr*)(P.ws + OFF_S5GT) + (size_t)(i * 32 + g) * 512 * 640;
    for (int idx = tid; idx < 512 * 80; idx += NTHREADS) {
        const int n = idx / 80, ch = idx % 80;
        const int t = n >> 4, c1 = n & 15;
        float v[8];
        if (ch < 64) {
            const int s = ch >> 1, c0 = (ch & 1) * 8;
#pragma unroll
            for (int j = 0; j < 8; ++j) v[j] = (t >= s) ? kt[((t - s) * 16 + c1) * 16 + c0 + j] : 0.f;
        } else {
            const int p0 = (ch - 64) * 4;
#pragma unroll
            for (int j = 0; j < 4; ++j) {
                const float2 a = cm[c1 * 64 + p0 + j], w = pw[(p0 + j) * 33 + t + 1];
                v[2 * j] = a.x * w.x - a.y * w.y;
                v[2 * j + 1] = -(a.x * w.y + a.y * w.x);
            }
        }
        *(uint4*)(gt + (size_t)n * 640 + ch * 8) = pack8(v);
    }
    bfr* bl = (bfr*)(P.ws + OFF_S5BL) + (size_t)(i * 32 + g) * 128 * 512;
    for (int idx = tid; idx < 128 * 64; idx += NTHREADS) {
        const int n = idx >> 6, ch = idx & 63;
        const int p = n >> 1, ri = n & 1, s = ch >> 1, c0 = (ch & 1) * 8;
        const float2 w = pw[p * 33 + 31 - s];
        float v[8];
#pragma unroll
        for (int j = 0; j < 8; ++j) { const float2 b = bb[p * 16 + c0 + j]; v[j] = ri ? (w.x * b.y + w.y * b.x) : (w.x * b.x - w.y * b.y); }
        *(uint4*)(bl + (size_t)n * 512 + ch * 8) = pack8(v);
    }
    float* l32 = (float*)(P.ws + OFF_S5L32) + (size_t)(i * 32 + g) * 128;
    if (tid < 64) { l32[2 * tid] = pw[tid * 33 + 32].x; l32[2 * tid + 1] = pw[tid * 33 + 32].y; }
    __syncthreads();
}

DI void norm_rows(const float* __restrict__ x, const float* __restrict__ g, bfr* __restrict__ hb, bfr* __restrict__ hlo, float* __restrict__ xcopy, int tok0, int ntok) {
    const int tid_ = ltid();
    const int lane = tid_ & 63, wave = tid_ >> 6;
    for (int tk = wave; tk < ntok; tk += 4) {
        const size_t tok = (size_t)(tok0 + tk);
        float4 v[4];
        float ss = 0.f;
#pragma unroll
        for (int i = 0; i < 4; ++i) {
            v[i] = *(const float4*)(x + tok * DM + i * 256 + lane * 4);
            ss += v[i].x * v[i].x + v[i].y * v[i].y + v[i].z * v[i].z + v[i].w * v[i].w;
        }
        ss = wave_sum(ss);
        const float rs = rsqrtf(ss * (1.0f / DM) + 1e-6f);
#pragma unroll
        for (int i = 0; i < 4; ++i) {
            const float4 gg = *(const float4*)(g + i * 256 + lane * 4);
            const float h0 = v[i].x * rs * gg.x, h1 = v[i].y * rs * gg.y, h2 = v[i].z * rs * gg.z, h3 = v[i].w * rs * gg.w;
            const unsigned p0 = pk2(h0, h1), p1 = pk2(h2, h3);
            *(uint2*)(hb + tok * DM + i * 256 + lane * 4) = make_uint2(p0, p1);
            if (hlo) {
                const unsigned q0 = pk2(h0 - bflo(p0), h1 - bfhi(p0)), q1 = pk2(h2 - bflo(p1), h3 - bfhi(p1));
                *(uint2*)(hlo + tok * DM + i * 256 + lane * 4) = make_uint2(q0, q1);
            }
            if (xcopy) *(float4*)(xcopy + tok * DM + i * 256 + lane * 4) = v[i];
        }
    }
}
DI void phase_e1(char* lds, const Ctx& P, int li, int nk = 32, size_t uoff = OFF_U, int probe = 0) {
    const bfr* hb = (const bfr*)(P.ws + OFF_HB);
    const bfr* w = (const bfr*)(P.ws + OFF_WINE) + (size_t)li * 2304 * 1024;
    bfr* u = (bfr*)(P.ws + uoff);
    for (int t = blockIdx.x; t < 256 * 9; t += gridDim.x) {
        int mt, nt; tile_remap(t, 256, 9, mt, nt);
        RowLoader2 A(hb, mt * 128, 1024), B(w, nt * 256, 1024);
        gemm_tile256(lds, nk, A, B, [&](const float* stg, int p) __attribute__((always_inline)) {
            epi2_rows8(stg, p, [&](int r, int gc, const float (&v)[8]) __attribute__((always_inline)) {
                *(uint4*)(u + (size_t)(mt * 128 + r) * EVEN_IN + nt * 256 + gc) = pack8(v);
            });
        }, probe);
    }
}

DI void phase_e2a(const Ctx& P, int li) {
    const bfr* u = (const bfr*)(P.ws + OFF_U);
    const float* mu = P.in[I_MU] + (size_t)li * 1792;
    bfr* S = (bfr*)(P.ws + OFF_S);
    bfr* mv = (bfr*)(P.ws + (li == 0 ? OFF_VFIRST : OFF_MV2));
    bfr* dpool = (bfr*)(P.ws + OFF_DPOOL);
    const int total = NTOK * 160;
    for (int idx = blockIdx.x * NTHREADS + ltid(); idx < total; idx += gridDim.x * NTHREADS) {
        const int tok = idx / 160, ch = idx % 160;
        const int col = 1024 + ch * 8;
        const int t = tok & (SEQ - 1);
        const bfr* row = u + (size_t)tok * EVEN_IN;
        float cur[8];
        unpack8(*(const uint4*)(row + col), cur);
        if (col < 1792) {
            float prv[8], m[8];
            if (t > 0) unpack8(*(const uint4*)(row - EVEN_IN + col), prv);
            else {
#pragma unroll
                for (int j = 0; j < 8; ++j) prv[j] = 0.f;
            }
            const float4 m0 = *(const float4*)(mu + col), m1 = *(const float4*)(mu + col + 4);
            const float mm[8] = {m0.x, m0.y, m0.z, m0.w, m1.x, m1.y, m1.z, m1.w};
#pragma unroll
            for (int j = 0; j < 8; ++j) m[j] = cur[j] + (prv[j] - cur[j]) * mm[j];
            if (col < 1536) {
                *(uint4*)(mv + (size_t)tok * 512 + (col - 1024)) = pack8(m);
            } else if (col < 1600) {
#pragma unroll
                for (int j = 0; j < 8; ++j) m[j] = ftanh(m[j]);
                *(uint4*)(S + (size_t)tok * 256 + (col - 1536)) = pack8(m);
            } else if (col < 1664) {
                *(uint4*)(S + (size_t)tok * 256 + 64 + (col - 1600)) = pack8(m);
            } else {
#pragma unroll
                for (int j = 0; j < 8; ++j) m[j] = sigmoidf_(m[j]);
                *(uint4*)(S + (size_t)tok * 256 + 128 + (col - 1664)) = pack8(m);
            }
        } else {
            const int gi = (col - 1792) >> 7;
            const int win = 2 << gi;
            const int nw = (t + 1 < win) ? (t + 1) : win;
            float acc[8];
#pragma unroll
            for (int j = 0; j < 8; ++j) acc[j] = cur[j];
#define POOL_WIN(W) { uint4 pv[W - 1]; _Pragma("unroll") for (int s = 1; s < W; ++s) pv[s - 1] = *(const uint4*)(row - (size_t)(s < nw ? s : 0) * EVEN_IN + col); \
                      _Pragma("unroll") for (int s = 1; s < W; ++s) { float pq[8]; unpack8(pv[s - 1], pq); const float wgt = s < nw ? 1.f : 0.f; \
                          _Pragma("unroll") for (int j = 0; j < 8; ++j) acc[j] += wgt * pq[j]; } }
            if (gi == 0) POOL_WIN(2) else if (gi == 1) POOL_WIN(4) else if (gi == 2) POOL_WIN(8) else POOL_WIN(16)
#undef POOL_WIN
            const float inv = frcp((float)nw);
#pragma unroll
            for (int j = 0; j < 8; ++j) acc[j] = acc[j] * inv - cur[j];
            *(uint4*)(dpool + (size_t)tok * 512 + (col - 1792)) = pack8(acc);
        }
    }
}

DI void phase_e2b(char* lds, const Ctx& P, int li) {
    const bfr* S = (const bfr*)(P.ws + OFF_S);
    const int njobs = (li == 1) ? 20 : 16;
    for (int t = blockIdx.x; t < 256 * njobs; t += gridDim.x) {
        const int mt = t / njobs, j = t % njobs;
        const int job = j >> 2, nt = j & 3;
        const int m0 = mt * 128;
        if (job == 0) {
            RowLoader A(S, m0, 256), B((const bfr*)(P.ws + OFF_W2T) + (size_t)li * 512 * 64, nt * 128, 64);
            const float* w0 = P.in[I_W0] + li * 512;
            float* dlog = (float*)(P.ws + OFF_DLOG);
            gemm_tile(lds, 1, A, B, [&](const float* stg) __attribute__((always_inline)) {
                epi_rows8(stg, [&](int r, int c0, const float (&v)[8]) __attribute__((always_inline)) {
                    float o[8];
#pragma unroll
                    for (int q = 0; q < 8; ++q) {
                        const float z = -(w0[nt * 128 + c0 + q] + v[q]);
                        o[q] = -fexp(-fsoftplus(z) - 0.5f);
                    }
                    float* d = dlog + (size_t)(m0 + r) * 512 + nt * 128 + c0;
                    *(float4*)d = make_float4(o[0], o[1], o[2], o[3]); *(float4*)(d + 4) = make_float4(o[4], o[5], o[6], o[7]);
                });
            });
        } else if (job == 1) {
            RowLoader A(S + 64, m0, 256), B((const bfr*)(P.ws + OFF_A2T) + (size_t)li * 512 * 64, nt * 128, 64);
            const float* a0 = P.in[I_A0] + li * 512;
            bfr* ab = (bfr*)(P.ws + OFF_ABUF);
            gemm_tile(lds, 1, A, B, [&](const float* stg) __attribute__((always_inline)) {
                epi_rows8(stg, [&](int r, int c0, const float (&v)[8]) __attribute__((always_inline)) {
                    float o[8];
#pragma unroll
                    for (int q = 0; q < 8; ++q) o[q] = sigmoidf_(a0[nt * 128 + c0 + q] + v[q]);
                    *(uint4*)(ab + (size_t)(m0 + r) * 512 + nt * 128 + c0) = pack8(o);
                });
            });
        } else if (job == 2) {
            RowLoader A(S + 128, m0, 256), B((const bfr*)(P.ws + OFF_G2T) + (size_t)li * 512 * 128, nt * 128, 128);
            bfr* gb = (bfr*)(P.ws + OFF_GBUF);
            gemm_tile(lds, 2, A, B, [&](const float* stg) __attribute__((always_inline)) {
                epi_rows8(stg, [&](int r, int c0, const float (&v)[8]) __attribute__((always_inline)) {
                    *(uint4*)(gb + (size_t)(m0 + r) * 512 + nt * 128 + c0) = pack8(v);
                });
            });
        } else if (job == 3) {
            RowLoader A((const bfr*)(P.ws + OFF_DPOOL) + nt * 128, m0, 512), B((const bfr*)(P.ws + OFF_POOLT) + (size_t)(li * 4 + nt) * 128 * 128, 0, 128);
            const float* ps = P.in[I_POOLS] + li * 512 + nt * 128;
            bfr* am = (bfr*)(P.ws + OFF_AMIX);
            gemm_tile(lds, 2, A, B, [&](const float* stg) __attribute__((always_inline)) {
                epi_rows8(stg, [&](int r, int c0, const float (&v)[8]) __attribute__((always_inline)) {
                    float o[8];
#pragma unroll
                    for (int q = 0; q < 8; ++q) o[q] = v[q] * ps[c0 + q];
                    *(uint4*)(am + (size_t)(m0 + r) * 1024 + 512 + nt * 128 + c0) = pack8(o);
                });
            });
        } else {
            RowLoader A((const bfr*)(P.ws + OFF_MV2), m0, 512), B((const bfr*)(P.ws + OFF_V12T), nt * 128, 512);
            const float* v0 = P.in[I_V0];
            bfr* vg = (bfr*)(P.ws + OFF_VGATE);
            gemm_tile(lds, 8, A, B, [&](const float* stg) __attribute__((always_inline)) {
                epi_rows8(stg, [&](int r, int c0, const float (&v)[8]) __attribute__((always_inline)) {
                    float o[8];
#pragma unroll
                    for (int q = 0; q < 8; ++q) o[q] = sigmoidf_(v0[nt * 128 + c0 + q] + v[q]);
                    *(uint4*)(vg + (size_t)(m0 + r) * 512 + nt * 128 + c0) = pack8(o);
                });
            });
        }
    }
}

constexpr int RW_TC = 16;
constexpr int RW_BUF = (5 * RW_TC * 64 + RW_TC * 16 + RW_TC * 16) * 4;
DI void phase_e3(char* lds, const Ctx& P, int li) {
    const bfr* u = (const bfr*)(P.ws + OFF_U);
    const float* mu = P.in[I_MU] + (size_t)li * 1792;
    const float* dlog = (const float*)(P.ws + OFF_DLOG);
    const bfr* ab = (const bfr*)(P.ws + OFF_ABUF);
    const bfr* vg = (const bfr*)(P.ws + OFF_VGATE);
    const bfr* vf = (const bfr*)(P.ws + OFF_VFIRST);
    float* yout = (float*)(P.ws + OFF_Y);
    float* bonus = (float*)(P.ws + OFF_BONUS);
    const int tid = ltid(), lane = tid & 63, wave = tid >> 6;
    const int pstep = tid >> 4, pc0 = (tid & 15) * 4;
    for (int item = blockIdx.x; item < 512; item += gridDim.x) {
        const int bh = item >> 2, qtr = item & 3;
        const int b = bh >> 3, h = bh & 7;
        const int i0 = qtr * 16;
        float c_mur[4], c_muk[4], c_muv[4], c_kk[4], c_ka[4], c_rk[4];
#pragma unroll
        for (int j = 0; j < 4; ++j) {
            const int c = h * 64 + pc0 + j;
            c_mur[j] = mu[c]; c_muk[j] = mu[512 + c]; c_muv[j] = mu[1024 + c];
            c_kk[j] = P.in[I_KK][li * 512 + c]; c_ka[j] = P.in[I_KA][li * 512 + c]; c_rk[j] = P.in[I_RK][li * 512 + c];
        }
        float S0 = 0.f, S1 = 0.f, S2 = 0.f, S3 = 0.f;
        const int rloc = wave * 4 + (lane >> 4);
        const int j0 = (lane & 15) * 4;
        const bool mine = ((pc0 >> 4) == qtr);
        uint2 g_ur, g_uk, g_uv, g_pr, g_pk, g_pv, g_a, g_vg, g_vf; float4 g_d;
#define E3_GLOAD(c_) do { const int t_ = (c_) * RW_TC + pstep; const size_t tok_ = (size_t)b * SEQ + t_; \
            const bfr* row_ = u + tok_ * EVEN_IN + h * 64 + pc0; const bfr* prow_ = row_ - (t_ > 0 ? EVEN_IN : 0); \
            g_ur = *(const uint2*)(row_); g_uk = *(const uint2*)(row_ + 512); g_uv = *(const uint2*)(row_ + 1024); \
            g_pr = *(const uint2*)(prow_); g_pk = *(const uint2*)(prow_ + 512); g_pv = *(const uint2*)(prow_ + 1024); \
            const size_t o_ = tok_ * 512 + h * 64 + pc0; \
            g_a = *(const uint2*)(ab + o_); g_d = *(const float4*)(dlog + o_); \
            if (li == 1) { g_vg = *(const uint2*)(vg + o_); g_vf = *(const uint2*)(vf + o_); } } while (0)
#define E3_PREP(c_, buf_) do { const int t_ = (c_) * RW_TC + pstep; const size_t o_ = ((size_t)b * SEQ + t_) * 512 + h * 64 + pc0; \
            float* sw_ = (float*)(lds + (buf_) * RW_BUF); float* sa_ = sw_ + RW_TC * 64; float* sb_ = sa_ + RW_TC * 64; float* sk_ = sb_ + RW_TC * 64; \
            float* sr_ = sk_ + RW_TC * 64; float* sv_ = sr_ + RW_TC * 64; \
            const float pz_ = t_ > 0 ? 1.f : 0.f; \
            const float ur_[4] = {bflo(g_ur.x), bfhi(g_ur.x), bflo(g_ur.y), bfhi(g_ur.y)}, uk_[4] = {bflo(g_uk.x), bfhi(g_uk.x), bflo(g_uk.y), bfhi(g_uk.y)}; \
            const float uv_[4] = {bflo(g_uv.x), bfhi(g_uv.x), bflo(g_uv.y), bfhi(g_uv.y)}; \
            const float pr_[4] = {bflo(g_pr.x), bfhi(g_pr.x), bflo(g_pr.y), bfhi(g_pr.y)}, pk_[4] = {bflo(g_pk.x), bfhi(g_pk.x), bflo(g_pk.y), bfhi(g_pk.y)}; \
            const float pv_[4] = {bflo(g_pv.x), bfhi(g_pv.x), bflo(g_pv.y), bfhi(g_pv.y)}; \
            const float av_[4] = {bflo(g_a.x), bfhi(g_a.x), bflo(g_a.y), bfhi(g_a.y)}; \
            const float dl_[4] = {g_d.x, g_d.y, g_d.z, g_d.w}; \
            float gv_[4] = {0.f, 0.f, 0.f, 0.f}, fv_[4] = {0.f, 0.f, 0.f, 0.f}; \
            if (li == 1) { gv_[0] = bflo(g_vg.x); gv_[1] = bfhi(g_vg.x); gv_[2] = bflo(g_vg.y); gv_[3] = bfhi(g_vg.y); \
                           fv_[0] = bflo(g_vf.x); fv_[1] = bfhi(g_vf.x); fv_[2] = bflo(g_vf.y); fv_[3] = bfhi(g_vf.y); } \
            float kkr_[4], kmod_[4], rr_[4], vv_[4]; float ssq_ = 0.f, bsum_ = 0.f; \
            _Pragma("unroll") for (int j = 0; j < 4; ++j) { \
                rr_[j] = ur_[j] + (pz_ * pr_[j] - ur_[j]) * c_mur[j]; \
                const float k_ = uk_[j] + (pz_ * pk_[j] - uk_[j]) * c_muk[j]; \
                float v_ = uv_[j] + (pz_ * pv_[j] - uv_[j]) * c_muv[j]; \
                if (li == 1) v_ = v_ + (fv_[j] - v_) * gv_[j]; \
                vv_[j] = v_; kkr_[j] = k_ * c_kk[j]; ssq_ += kkr_[j] * kkr_[j]; \
                kmod_[j] = k_ * (1.0f + (av_[j] - 1.0f) * c_ka[j]); bsum_ += rr_[j] * kmod_[j] * c_rk[j]; } \
            ssq_ = row16_sum(ssq_); bsum_ = row16_sum(bsum_); \
            const float inv_ = frcp(fmaxf(sqrtf(ssq_), 1e-12f)); \
            float4 w4_, a4_, b4_; \
            w4_.x = fexp(dl_[0]); w4_.y = fexp(dl_[1]); w4_.z = fexp(dl_[2]); w4_.w = fexp(dl_[3]); \
            a4_.x = -kkr_[0] * inv_; a4_.y = -kkr_[1] * inv_; a4_.z = -kkr_[2] * inv_; a4_.w = -kkr_[3] * inv_; \
            b4_.x = -a4_.x * av_[0]; b4_.y = -a4_.y * av_[1]; b4_.z = -a4_.z * av_[2]; b4_.w = -a4_.w * av_[3]; \
            *(float4*)(sw_ + pstep * 64 + pc0) = w4_; *(float4*)(sa_ + pstep * 64 + pc0) = a4_; *(float4*)(sb_ + pstep * 64 + pc0) = b4_; \
            *(float4*)(sk_ + pstep * 64 + pc0) = make_float4(kmod_[0], kmod_[1], kmod_[2], kmod_[3]); \
            *(float4*)(sr_ + pstep * 64 + pc0) = make_float4(rr_[0], rr_[1], rr_[2], rr_[3]); \
            if (mine) { *(float4*)(sv_ + pstep * 16 + (pc0 & 15)) = make_float4(vv_[0], vv_[1], vv_[2], vv_[3]); \
                        *(float4*)(bonus + o_) = make_float4(bsum_ * vv_[0], bsum_ * vv_[1], bsum_ * vv_[2], bsum_ * vv_[3]); } } while (0)
        __syncthreads();
        E3_GLOAD(0);
        E3_PREP(0, 0);
        __syncthreads();
        constexpr int NCH = SEQ / RW_TC;
#pragma unroll 1
        for (int c = 0; c < NCH; ++c) {
            const int buf = c & 1;
            if (c + 1 < NCH) E3_GLOAD(c + 1);
            {
                const float* s_w = (const float*)(lds + buf * RW_BUF); const float* s_a = s_w + RW_TC * 64; const float* s_b = s_a + RW_TC * 64;
                const float* s_k = s_b + RW_TC * 64; const float* s_r = s_k + RW_TC * 64; const float* s_v = s_r + RW_TC * 64;
                float* s_y = (float*)(s_v + RW_TC * 16);
                float4 na4 = *(const float4*)(s_a + j0), nw4 = *(const float4*)(s_w + j0), nb4 = *(const float4*)(s_b + j0);
                float4 nk4 = *(const float4*)(s_k + j0), nr4 = *(const float4*)(s_r + j0);
                float nvi = s_v[rloc];
#pragma unroll 1
                for (int sg = 0; sg < RW_TC; sg += 4) {
                    float yv[4];
#pragma unroll
                    for (int q = 0; q < 4; ++q) {
                        const int sn = (sg + q + 1) & (RW_TC - 1);
                        const float4 a4 = na4, w4 = nw4, b4 = nb4, k4 = nk4, r4 = nr4; const float vi = nvi;
                        na4 = *(const float4*)(s_a + sn * 64 + j0); nw4 = *(const float4*)(s_w + sn * 64 + j0); nb4 = *(const float4*)(s_b + sn * 64 + j0);
                        nk4 = *(const float4*)(s_k + sn * 64 + j0); nr4 = *(const float4*)(s_r + sn * 64 + j0); nvi = s_v[sn * 16 + rloc];
                        float sa = dot4n(S0, S1, S2, S3, a4);
                        sa = row16_sum(sa);
                        rw_upd(S0, w4.x, sa, b4.x, vi, k4.x);
                        rw_upd(S1, w4.y, sa, b4.y, vi, k4.y);
                        rw_upd(S2, w4.z, sa, b4.z, vi, k4.z);
                        rw_upd(S3, w4.w, sa, b4.w, vi, k4.w);
                        const float y = dot4n(S0, S1, S2, S3, r4);
                        yv[q] = row16_sum(y);
                    }
                    const int ls = lane & 3;
                    const float yo = ls == 0 ? yv[0] : (ls == 1 ? yv[1] : (ls == 2 ? yv[2] : yv[3]));
                    if ((lane & 15) < 4) s_y[(sg + ls) * 16 + rloc] = yo;
                }
            }
            if (c + 1 < NCH) E3_PREP(c + 1, buf ^ 1);
            __syncthreads();
            {
                const float* s_y = (const float*)(lds + buf * RW_BUF) + 5 * RW_TC * 64 + RW_TC * 16;
                const int s = tid >> 4, r = tid & 15;
                yout[((size_t)b * SEQ + c * RW_TC + s) * 512 + h * 64 + i0 + r] = s_y[tid];
            }
        }
#undef E3_GLOAD
#undef E3_PREP
    }
}

DI void phase_e4(const Ctx& P, int li) {
    const float* y = (const float*)(P.ws + OFF_Y);
    const float* bonus = (const float*)(P.ws + OFF_BONUS);
    const bfr* gb = (const bfr*)(P.ws + OFF_GBUF);
    const float* lng = P.in[I_LNG] + li * 512;
    const float* lnb = P.in[I_LNB] + li * 512;
    bfr* am = (bfr*)(P.ws + OFF_AMIX);
    const int total = NTOK * 64;
    for (int idx = blockIdx.x * NTHREADS + ltid(); idx < total; idx += gridDim.x * NTHREADS) {
        const int tok = idx >> 6, c = (idx & 63) * 8;
        const size_t o = (size_t)tok * 512 + c;
        const float4 y0 = *(const float4*)(y + o), y1 = *(const float4*)(y + o + 4);
        float v[8] = {y0.x, y0.y, y0.z, y0.w, y1.x, y1.y, y1.z, y1.w};
        float s = 0.f;
#pragma unroll
        for (int j = 0; j < 8; ++j) s += v[j];
        s += __shfl_xor(s, 1); s += __shfl_xor(s, 2); s += __shfl_xor(s, 4);
        const float mean = s * (1.0f / 64.0f);
        float q = 0.f;
#pragma unroll
        for (int j = 0; j < 8; ++j) { v[j] -= mean; q += v[j] * v[j]; }
        q += __shfl_xor(q, 1); q += __shfl_xor(q, 2); q += __shfl_xor(q, 4);
        const float rstd = rsqrtf(q * (1.0f / 64.0f) + 64e-5f);
        const float4 b0 = *(const float4*)(bonus + o), b1 = *(const float4*)(bonus + o + 4);
        const float bo[8] = {b0.x, b0.y, b0.z, b0.w, b1.x, b1.y, b1.z, b1.w};
        float gv[8];
        unpack8(*(const uint4*)(gb + o), gv);
        float out[8];
#pragma unroll
        for (int j = 0; j < 8; ++j) out[j] = (v[j] * rstd * lng[c + j] + lnb[c + j] + bo[j]) * gv[j];
        *(uint4*)(am + (size_t)tok * 1024 + c) = pack8(out);
    }
}

DI void phase_wout(char* lds, const Ctx& P, const bfr* w, float* x) {
    const bfr* am = (const bfr*)(P.ws + OFF_AMIX);
    for (int t = blockIdx.x; t < 256 * 4; t += gridDim.x) {
        int mt, nt; tile_remap(t, 256, 4, mt, nt);
        RowLoader2 A(am, mt * 128, 1024), B(w, nt * 256, 1024);
        gemm_tile256(lds, 32, A, B, [&](const float* stg, int p) __attribute__((always_inline)) {
            epi2_rows8_pre<F8>(stg, p,
                [&](int r, int c0) __attribute__((always_inline)) -> F8 {
                    const float* d = x + (size_t)(mt * 128 + r) * DM + nt * 256 + c0;
                    F8 o; o.a = *(const float4*)d; o.b = *(const float4*)(d + 4); return o; },
                [&](int r, int c0, const float (&v)[8], const F8& o) __attribute__((always_inline)) {
                    float* d = x + (size_t)(mt * 128 + r) * DM + nt * 256 + c0;
                    *(float4*)d = make_float4(o.a.x + v[0], o.a.y + v[1], o.a.z + v[2], o.a.w + v[3]);
                    *(float4*)(d + 4) = make_float4(o.b.x + v[4], o.b.y + v[5], o.b.z + v[6], o.b.w + v[7]);
                });
        });
    }
}
DI void phase_o1(char* lds, const Ctx& P, int li) {
    const bfr* hb = (const bfr*)(P.ws + OFF_HB);
    const bfr* w = (const bfr*)(P.ws + OFF_WINO) + (size_t)li * 2048 * 1024;
    bfr* qk = (bfr*)(P.ws + OFF_U);
    bfr* vT = (bfr*)(P.ws + OFF_VT);
    bfr* us5 = (bfr*)(P.ws + OFF_US5);
    for (int t = blockIdx.x; t < 256 * 8; t += gridDim.x) {
        int mt, nt; tile_remap(t, 256, 8, mt, nt);
        const int m0 = mt * 128;
        RowLoader2 A(hb, m0, 1024), B(w, nt * 256, 1024);
        gemm_tile256(lds, 32, A, B, [&](const float* stg, int p) __attribute__((always_inline)) {
            if (nt < 4) {
                epi2_rows8(stg, p, [&](int r, int gc, const float (&v)[8]) __attribute__((always_inline)) {
                    *(uint4*)(qk + (size_t)(m0 + r) * 1024 + nt * 256 + gc) = pack8(v);
                });
            } else if (nt < 6) {
                const int b = m0 >> 11, tq = m0 & (SEQ - 1);
                const int tid0 = ltid();
#pragma unroll
                for (int it = 0; it < 8; ++it) {
                    const int idx = it * NTHREADS + tid0;
                    const int cs = idx & 127, rg = idx >> 7;
                    const int vc = (nt - 4) * 256 + g2_col(cs, p);
                    float v[8];
#pragma unroll
                    for (int j = 0; j < 8; ++j) v[j] = stg[(rg * 8 + j) * STG_LD + cs];
                    *(uint4*)(vT + ((size_t)(b * 4 + (vc >> 7)) * 128 + (vc & 127)) * SEQ + tq + rg * 8) = pack8(v);
                }
            } else {
                epi2_rows8(stg, p, [&](int r, int gc, const float (&v)[8]) __attribute__((always_inline)) {
                    const int cc = (nt - 6) * 256 + gc;
                    *(uint4*)(us5 + ((size_t)(cc >> 4) * NTOK + m0 + r) * 16 + (cc & 15)) = pack8(v);
                });
            }
        });
    }
}

DI void phase_o2(char* lds, const Ctx& P, int li) {
    const bfr* qk = (const bfr*)(P.ws + OFF_U);
    bfr* qn = (bfr*)(P.ws + OFF_QN);
    bfr* kn = (bfr*)(P.ws + OFF_KN);
    const float* gq = P.in[I_QN] + li * 64;
    const float* gk = P.in[I_KN] + li * 64;
    const bfr* us5 = (const bfr*)(P.ws + OFF_US5);
    const bfr* bl = (const bfr*)(P.ws + OFF_S5BL) + (size_t)li * 32 * 128 * 512;
    float* xloc = (float*)(P.ws + OFF_XLOC);
    for (int t = blockIdx.x; t < 256; t += gridDim.x) {
        const int g = t >> 3, mt = t & 7;
        RowLoader A(us5 + (size_t)g * NTOK * 16, mt * 128, 512), B(bl + (size_t)g * 128 * 512, 0, 512);
        gemm_tile(lds, 8, A, B, [&](const float* stg) __attribute__((always_inline)) {
            epi_rows8(stg, [&](int r, int c0, const float (&v)[8]) __attribute__((always_inline)) {
                float* d = xloc + ((size_t)g * 1024 + mt * 128 + r) * 128 + c0;
                *(float4*)d = make_float4(v[0], v[1], v[2], v[3]); *(float4*)(d + 4) = make_float4(v[4], v[5], v[6], v[7]);
            });
        });
    }
    const int total = NTOK * 16 * 8;
    for (int idx = blockIdx.x * NTHREADS + ltid(); idx < total; idx += gridDim.x * NTHREADS) {
        const int l8 = idx & 7, item = idx >> 3;
        const int hm = item & 7, which = (item >> 3) & 1, tok = item >> 4;
        const int d0 = l8 * 4;
        const bfr* src = qk + (size_t)tok * 1024 + which * 512 + hm * 64;
        const uint2 ua = *(const uint2*)(src + d0), ub = *(const uint2*)(src + 32 + d0);
        float x1[4] = {bflo(ua.x), bfhi(ua.x), bflo(ua.y), bfhi(ua.y)};
        float x2[4] = {bflo(ub.x), bfhi(ub.x), bflo(ub.y), bfhi(ub.y)};
        float ss = 0.f;
#pragma unroll
        for (int j = 0; j < 4; ++j) ss += x1[j] * x1[j] + x2[j] * x2[j];
        ss += __shfl_xor(ss, 1); ss += __shfl_xor(ss, 2); ss += __shfl_xor(ss, 4);
        const float rs = rsqrtf(ss * (1.0f / 64.0f) + 1e-6f);
        const float* gg = which ? gk : gq;
        const float scl = which ? 1.0f : (0.125f * 1.4426950408889634f);
        const int t = tok & (SEQ - 1);
        float o1[4], o2[4];
#pragma unroll
        for (int j = 0; j < 4; ++j) {
            const int i = d0 + j;
            const float invf = exp2f(-(float)i * (13.287712379549449f / 32.0f));
            const float ang = (float)t * invf;
            float sn, cs;
            sincosf(ang, &sn, &cs);
            const float a = x1[j] * rs * gg[i], b2 = x2[j] * rs * gg[32 + i];
            o1[j] = (a * cs - b2 * sn) * scl;
            o2[j] = (b2 * cs + a * sn) * scl;
        }
        bfr* dst = (which ? kn : qn) + (size_t)tok * 512 + hm * 64;
        *(uint2*)(dst + d0) = make_uint2(pk2(o1[0], o1[1]), pk2(o1[2], o1[3]));
        *(uint2*)(dst + 32 + d0) = make_uint2(pk2(o2[0], o2[1]), pk2(o2[2], o2[3]));
    }
}

DI void s5_scan(const Ctx& P, int li) {
    const float* xloc = (const float*)(P.ws + OFF_XLOC);
    bfr* xin = (bfr*)(P.ws + OFF_XIN);
    const float* l32 = (const float*)(P.ws + OFF_S5L32) + (size_t)li * 32 * 128;
    for (int idx = blockIdx.x * NTHREADS + ltid(); idx < 32 * 16 * 64; idx += gridDim.x * NTHREADS) {
        const int p = idx & 63, b = (idx >> 6) & 15, g = idx >> 10;
        const float lr = l32[g * 128 + 2 * p], lim = l32[g * 128 + 2 * p + 1];
        float xr = 0.f, xi = 0.f;
        for (int ch = 0; ch < 64; ++ch) {
            const size_t o = ((size_t)g * 1024 + b * 64 + ch) * 128 + 2 * p;
            *(unsigned*)(xin + o) = pk2(xr, xi);
            const float2 a = *(const float2*)(xloc + o);
            const float nr = lr * xr - lim * xi + a.x, ni = lr * xi + lim * xr + a.y;
            xr = nr; xi = ni;
        }
    }
}

DI void attn_item(char* lds, const Ctx& P, int b, int h, int qt, float lam, float lam_init, const float* subln) {
    const bfr* qn = (const bfr*)(P.ws + OFF_QN);
    const bfr* kn = (const bfr*)(P.ws + OFF_KN);
    const bfr* vT = (const bfr*)(P.ws + OFF_VT) + (size_t)(b * 4 + h) * 128 * SEQ;
    bfr* am = (bfr*)(P.ws + OFF_AMIX);
    const int tid = ltid(), lane = tid & 63, wave = tid >> 6;
    const int m = wave >> 1, qw = (wave & 1) * 32;
    const int q0 = qt * 64 + qw;
    const int ln = lane & 31, hf = lane >> 5;
    bf16x8 qf[4];
    {
        const bfr* qp = qn + ((size_t)b * SEQ + q0 + ln) * 512 + h * 128 + m * 64 + hf * 8;
#pragma unroll
        for (int ks = 0; ks < 4; ++ks) qf[ks] = *(const bf16x8*)(qp + ks * 16);
    }
    f32x16 o[4];
#pragma unroll
    for (int d = 0; d < 4; ++d)
#pragma unroll
        for (int r = 0; r < 16; ++r) o[d][r] = 0.f;
    float mrun = -INFINITY, lrun = 0.f;
    const int nkt = qt + 1;
    const int lrow = tid >> 3, lcol = (tid & 7) * 8;
    const bfr* kbase = kn + ((size_t)b * SEQ) * 512 + h * 128;
    unsigned ko = (unsigned)(lrow * 512 + lcol) * 2u, vo = (unsigned)(lrow * SEQ + lcol) * 2u;
    asm volatile("" : "+v"(ko), "+v"(vo));
    uint4 rk0, rk1, rk2, rk3, rv0, rv1, rv2, rv3;
#define ATT_GLOAD(kt_) do { const char* kp_ = (const char*)(kbase + (size_t)(kt_) * (64 * 512)); const char* vp_ = (const char*)(vT + (kt_) * 64); \
        rk0 = *(const uint4*)(kp_ + ko); rk1 = *(const uint4*)(kp_ + 32 * 512 * 2 + ko); rk2 = *(const uint4*)(kp_ + 64 * 2 + ko); rk3 = *(const uint4*)(kp_ + 32 * 512 * 2 + 64 * 2 + ko); \
        rv0 = *(const uint4*)(vp_ + vo); rv1 = *(const uint4*)(vp_ + 32 * SEQ * 2 + vo); rv2 = *(const uint4*)(vp_ + 64 * SEQ * 2 + vo); rv3 = *(const uint4*)(vp_ + 96 * SEQ * 2 + vo); } while (0)
#define ATT_S1(base_, i_, RK, RV) { *(uint4*)((base_) + (32 * (i_)) * LDA * 2) = RK; \
        *(uint4*)((base_) + TILE_B + (32 * (i_)) * LDA * 2) = RV; }
#define ATT_LSTORE(buf_) do { char* base_ = lds + (buf_) * (2 * TILE_B) + s_off; ATT_S1(base_, 0, rk0, rv0) ATT_S1(base_, 1, rk1, rv1) ATT_S1(base_, 2, rk2, rv2) ATT_S1(base_, 3, rk3, rv3) } while (0)
    int k_off = ((m * 64 + ln) * LDA + hf * 8) * 2;
    int v_off = TILE_B + (ln * LDA + 4 * hf) * 2;
    int s_off = (lrow * LDA + lcol) * 2;
    asm volatile("" : "+v"(k_off), "+v"(v_off), "+v"(s_off));
    ATT_GLOAD(0); ATT_LSTORE(0);
    __syncthreads();
    int buf = 0;
#pragma unroll 1
    for (int kt = 0; kt < nkt; ++kt) {
        const bool more = (kt + 1 < nkt);
        const char* ks_ = lds + buf * (2 * TILE_B) + k_off;
        const char* vs_ = lds + buf * (2 * TILE_B) + v_off;
        if (kt * 64 <= q0 + 31) {
            f32x16 s[2];
#pragma unroll
            for (int kb = 0; kb < 2; ++kb) {
#pragma unroll
                for (int r = 0; r < 16; ++r) s[kb][r] = 0.f;
#pragma unroll
                for (int ks = 0; ks < 4; ++ks) {
                    const bf16x8 kf = *(const bf16x8*)(ks_ + ((kb * 32) * LDA + ks * 16) * 2);
                    s[kb] = MFMA32(kf, qf[ks], s[kb]);
                }
            }
            const int qpos = q0 + ln;
            if (kt * 64 + 63 > q0) {
#pragma unroll
                for (int kb = 0; kb < 2; ++kb)
#pragma unroll
                    for (int r = 0; r < 16; ++r) {
                        const int key = kt * 64 + kb * 32 + (r & 3) + 8 * (r >> 2) + 4 * hf;
                        if (key > qpos) s[kb][r] = -INFINITY;
                    }
            }
            float mx = s[0][0];
#pragma unroll
            for (int kb = 0; kb < 2; ++kb)
#pragma unroll
                for (int r = 0; r < 16; ++r) mx = fmaxf(mx, s[kb][r]);
            mx = fmaxf(mx, __shfl_xor(mx, 32));
            const float mnew = fmaxf(mrun, mx);
            const float alpha = __builtin_amdgcn_exp2f(mrun - mnew);
            mrun = mnew;
            float rsum = 0.f;
#pragma unroll
            for (int kb = 0; kb < 2; ++kb)
#pragma unroll
                for (int r = 0; r < 16; ++r) { const float p = __builtin_amdgcn_exp2f(s[kb][r] - mnew); s[kb][r] = p; rsum += p; }
            lrun = lrun * alpha + rsum;
#pragma unroll
            for (int d = 0; d < 4; ++d)
#pragma unroll
                for (int r = 0; r < 16; ++r) o[d][r] *= alpha;
            __builtin_amdgcn_sched_barrier(0);
            if (more) ATT_GLOAD(kt + 1);
#pragma unroll
            for (int kb = 0; kb < 2; ++kb)
#pragma unroll
                for (int st = 0; st < 2; ++st) {
                    const uint4 pp = make_uint4(pk2(s[kb][8 * st + 0], s[kb][8 * st + 1]), pk2(s[kb][8 * st + 2], s[kb][8 * st + 3]),
                                                pk2(s[kb][8 * st + 4], s[kb][8 * st + 5]), pk2(s[kb][8 * st + 6], s[kb][8 * st + 7]));
                    const bf16x8 pf = __builtin_bit_cast(bf16x8, pp);
                    const int kc = kb * 32 + 16 * st;
#pragma unroll
                    for (int d = 0; d < 4; ++d) {
                        const uint2 v0 = *(const uint2*)(vs_ + ((d * 32) * LDA + kc) * 2);
                        const uint2 v1 = *(const uint2*)(vs_ + ((d * 32) * LDA + kc + 8) * 2);
                        const bf16x8 vf = __builtin_bit_cast(bf16x8, make_uint4(v0.x, v0.y, v1.x, v1.y));
                        o[d] = MFMA32(vf, pf, o[d]);
                    }
                }
        }
        else if (more) ATT_GLOAD(kt + 1);
        if (more) ATT_LSTORE(buf ^ 1);
        __syncthreads();
        buf ^= 1;
    }
    const float ltot = lrun + __shfl_xor(lrun, 32);
    const float linv = 1.0f / ltot;
    float* ob = (float*)lds;
    int o_off = (m * 64 + qw + ln) * 129 + 4 * hf;
    asm volatile("" : "+v"(o_off));
#pragma unroll
    for (int d = 0; d < 4; ++d)
#pragma unroll
        for (int r = 0; r < 16; ++r) ob[o_off + d * 32 + (r & 3) + 8 * (r >> 2)] = o[d][r] * linv;
    __syncthreads();
#pragma unroll
    for (int it = 0; it < 4; ++it) {
        const int idx = it * NTHREADS + tid;
        const int q = idx >> 4, c0 = (idx & 15) * 8;
        float v[8];
        float ss = 0.f;
        int r_off = q * 129 + c0;
        asm volatile("" : "+v"(r_off));
#pragma unroll
        for (int j = 0; j < 8; ++j) { v[j] = ob[r_off + j] - lam * ob[r_off + 64 * 129 + j]; ss += v[j] * v[j]; }
        ss = row16_sum(ss);
        const float rs = rsqrtf(ss * (1.0f / 128.0f) + 1e-5f) * (1.0f - lam_init);
#pragma unroll
        for (int j = 0; j < 8; ++j) v[j] = v[j] * rs * subln[c0 + j];
        *(uint4*)(am + ((size_t)b * SEQ + qt * 64 + q) * 1024 + h * 128 + c0) = pack8(v);
    }
    __syncthreads();
}

DI void phase_o3(char* lds, const Ctx& P, int li, int layer) {
    s5_scan(P, li);
    float lam;
    {
        const int j = ltid() & 63;
        const float s1 = wave_sum(P.in[I_LQ1][li * 64 + j] * P.in[I_LK1][li * 64 + j]);
        const float s2 = wave_sum(P.in[I_LQ2][li * 64 + j] * P.in[I_LK2][li * 64 + j]);
        const float lam_init0 = 0.8f - 0.6f * __expf(-0.3f * (float)layer);
        lam = __expf(s1) - __expf(s2) + lam_init0;
    }
    const float lam_init = 0.8f - 0.6f * __expf(-0.3f * (float)layer);
    const float* subln = P.in[I_SUBLN] + li * 128;
    for (int item = blockIdx.x; item < 1024; item += gridDim.x) {
        const int bh = item >> 4, pr = item & 15;
        for (int half = 0; half < 2; ++half) attn_item(lds, P, bh >> 2, bh & 3, half ? 31 - pr : pr, lam, lam_init, subln);
    }
}

DI void phase_o4(char* lds, const Ctx& P, int li) {
    const bfr* us5 = (const bfr*)(P.ws + OFF_US5);
    const bfr* xin = (const bfr*)(P.ws + OFF_XIN);
    const bfr* gt = (const bfr*)(P.ws + OFF_S5GT) + (size_t)li * 32 * 512 * 640;
    const float* dsk = P.in[I_S5D] + li * 512;
    bfr* zb = (bfr*)(P.ws + OFF_ZBUF);
    for (int t = blockIdx.x; t < 1024; t += gridDim.x) {
        const int g = t >> 5, mt = (t >> 2) & 7, nt = t & 3;
        const int nloc = 2 * (nt + 1);
        const bfr* ag = us5 + (size_t)g * NTOK * 16;
        const bfr* xg = xin + (size_t)g * 1024 * 128;
        const int tq = ltid();
        const int arow = mt * 128 + (tq >> 3), acol = gt_lcol(tq);
        auto aptr = [&](int i, int kt) __attribute__((always_inline)) -> const bfr* {
            return (kt < nloc) ? ag + (size_t)(arow + 32 * i) * 512 + kt * 64 + acol
                               : xg + (size_t)(arow + 32 * i) * 128 + (kt - nloc) * 64 + acol;
        };
        const bfr* bg = gt + (size_t)g * 512 * 640 + (size_t)(nt * 128 + (tq >> 3)) * 640 + acol;
        auto bptr = [&](int i, int kt) __attribute__((always_inline)) -> const bfr* {
            return bg + (size_t)(32 * i) * 640 + ((kt < nloc) ? kt : (8 + kt - nloc)) * 64;
        };
        gemm_tile(lds, nloc + 2, aptr, bptr, [&](const float* stg) __attribute__((always_inline)) {
            epi_rows8_pre<uint4>(stg,
                [&](int r, int c0) __attribute__((always_inline)) -> uint4 {
                    const int n = nt * 128 + c0;
                    return *(const uint4*)(ag + ((size_t)(mt * 128 + r) * 32 + (n >> 4)) * 16 + (n & 15)); },
                [&](int r, int c0, const float (&v)[8], const uint4& up) __attribute__((always_inline)) {
                    const int cb = mt * 128 + r;
                    const int n = nt * 128 + c0, tt = n >> 4, c1 = n & 15;
                    const size_t tok = (size_t)cb * 32 + tt;
                    float uu[8], z[8];
                    unpack8(up, uu);
#pragma unroll
                    for (int j = 0; j < 8; ++j) {
                        const float y = v[j] + dsk[g * 16 + c1 + j] * uu[j];
                        const float inner = 0.7978845608028654f * (y + 0.044715f * y * y * y);
                        z[j] = 0.5f * y * (1.0f + ftanh(inner));
                    }
                    *(uint4*)(zb + tok * 512 + g * 16 + c1) = pack8(z);
                });
        });
    }
}

DI void phase_o5(char* lds, const Ctx& P, int li) {
    const bfr* zb = (const bfr*)(P.ws + OFF_ZBUF);
    const bfr* w = (const bfr*)(P.ws + OFF_GLUT) + (size_t)li * 512 * 512;
    bfr* am = (bfr*)(P.ws + OFF_AMIX);
    for (int t = blockIdx.x; t < 1024; t += gridDim.x) {
        int mt, nt; tile_remap(t, 256, 4, mt, nt);
        RowLoader A(zb, mt * 128, 512), B(w, nt * 128, 512);
        gemm_tile(lds, 8, A, B, [&](const float* stg) __attribute__((always_inline)) {
            epi_rows8_pre<uint4>(stg,
                [&](int r, int c0) __attribute__((always_inline)) -> uint4 { return *(const uint4*)(zb + (size_t)(mt * 128 + r) * 512 + nt * 128 + c0); },
                [&](int r, int c0, const float (&v)[8], const uint4& zp) __attribute__((always_inline)) {
                    float zz[8], o[8];
                    unpack8(zp, zz);
#pragma unroll
                    for (int j = 0; j < 8; ++j) o[j] = zz[j] * sigmoidf_(v[j]);
                    *(uint4*)(am + (size_t)(mt * 128 + r) * 1024 + 512 + nt * 128 + c0) = pack8(o);
                });
        });
    }
}
DI void phase_router(char* lds, const Ctx& P, int layer) {
    const float* x = P.out;
    bfr* hb = (bfr*)(P.ws + OFF_HB);
    bfr* hlo = (bfr*)(P.ws + OFF_HLO);
    const bfr* rhi = (const bfr*)(P.ws + OFF_RHI) + (size_t)layer * 128 * 1024;
    const bfr* rlo = (const bfr*)(P.ws + OFF_RLO) + (size_t)layer * 128 * 1024;
    int* gcnt = (int*)(P.ws + OFF_CNT) + layer * 64;
    int* stok = (int*)(P.ws + OFF_TOK);
    float* sgate = (float*)(P.ws + OFF_GATE);
    int* lcnt = (int*)(lds + LDS_AUX);
    int* lbase = lcnt + 64;
    const float* bg = P.in[I_MBG] + layer * 4;
    const float* be = P.in[I_MBE] + layer * 32;
    const int tid = ltid();
    for (int u = blockIdx.x; u < 256; u += gridDim.x) {
        const int m0 = u * 128;
        norm_rows(x, P.in[I_NFFN] + (size_t)layer * DM, hb, hlo, nullptr, m0, 128);
        __syncthreads();
        const size_t roff = (size_t)(m0 + (tid >> 3)) * 1024 + gt_lcol(tid);
        const size_t boff = (size_t)(tid >> 3) * 1024 + gt_lcol(tid);
        auto aptr = [&](int i, int kt) __attribute__((always_inline)) -> const bfr* { return (kt < 32 ? hb : hlo) + roff + (size_t)(32 * i) * 1024 + (kt & 15) * 64; };
        auto bptr = [&](int i, int kt) __attribute__((always_inline)) -> const bfr* { return ((kt >= 16 && kt < 32) ? rlo : rhi) + boff + (size_t)(32 * i) * 1024 + (kt & 15) * 64; };
        gemm_tile(lds, 48, aptr, bptr, [&](const float* stg) __attribute__((always_inline)) {
            if (tid < 64) lcnt[tid] = 0;
            __syncthreads();
            int seg0 = 0, seg1 = 0, p0 = 0, p1 = 0;
            float g0 = 0.f, g1 = 0.f;
            if (tid < 128) {
                const float* row = stg + tid * STG_LD;
                float gl[4];
#pragma unroll
                for (int j = 0; j < 4; ++j) gl[j] = row[32 + j] + bg[j];
                int gt = 0; float gm = gl[0];
#pragma unroll
                for (int j = 1; j < 4; ++j) if (gl[j] > gm) { gm = gl[j]; gt = j; }
                float gs = 0.f;
#pragma unroll
                for (int j = 0; j < 4; ++j) gs += __expf(gl[j] - gm);
                const float gw = 1.0f / gs;
                float l1 = -INFINITY, l2 = -INFINITY; int j1 = 0, j2 = 0;
                for (int j = 0; j < 8; ++j) {
                    const float v = row[gt * 8 + j] + be[gt * 8 + j];
                    if (v > l1) { l2 = l1; j2 = j1; l1 = v; j1 = j; }
                    else if (v > l2) { l2 = v; j2 = j; }
                }
                const float w1 = 1.0f / (1.0f + __expf(l2 - l1));
                g0 = gw * w1; g1 = gw * (1.0f - w1);
                seg0 = gt * 8 + j1; seg1 = 32 + gt * 8 + j2;
                p0 = atomicAdd(&lcnt[seg0], 1);
                p1 = atomicAdd(&lcnt[seg1], 1);
            }
            __syncthreads();
            if (tid < 64) { const int c = lcnt[tid]; lbase[tid] = c ? atomicAdd(&gcnt[tid], c) : 0; }
            __syncthreads();
            if (tid < 128) {
                const int q0 = lbase[seg0] + p0, q1 = lbase[seg1] + p1;
                stok[(size_t)seg0 * NTOK + q0] = m0 + tid; sgate[(size_t)seg0 * NTOK + q0] = g0;
                stok[(size_t)seg1 * NTOK + q1] = m0 + tid; sgate[(size_t)seg1 * NTOK + q1] = g1;
            }
        });
    }
}

DI void moe_tables(char* lds, const Ctx& P, int layer) {
    int* cnt = (int*)(lds + LDS_AUX); int* rb0 = cnt + 64; int* hoff = rb0 + 65;
    const int* gcnt = (const int*)(P.ws + OFF_CNT) + layer * 64;
    const int tid = ltid();
    if (tid < 64) cnt[tid] = gcnt[tid];
    __syncthreads();
    if (tid == 0) {
        int acc = 0;
        for (int s = 0; s < 64; ++s) { rb0[s] = acc; hoff[s] = acc * 128; acc += (cnt[s] + 127) >> 7; }
        rb0[64] = acc;
    }
    __syncthreads();
}
DI int moe_find_seg(const int* rb0, int rbi) { int s = 0; while (rb0[s + 1] <= rbi) ++s; return s; }

DI void phase_moe_up(char* lds, const Ctx& P, int layer) {
    moe_tables(lds, P, layer);
    const int* cnt = (const int*)(lds + LDS_AUX); const int* rb0 = cnt + 64; const int* hoff = rb0 + 65;
    const bfr* hb = (const bfr*)(P.ws + OFF_HB);
    const bfr* wgu = (const bfr*)(P.ws + OFF_MWGU);
    const int* stok = (const int*)(P.ws + OFF_TOK);
    bfr* hid = (bfr*)(P.ws + OFF_HID);
    const int ntiles = rb0[64] * 4;
    for (int t = blockIdx.x; t < ntiles; t += gridDim.x) {
        int rbi, nt; tile_remap(t, rb0[64], 4, rbi, nt);
        const int seg = moe_find_seg(rb0, rbi);
        const int rb = rbi - rb0[seg], e = seg & 31, c = cnt[seg];
        const bfr* ap0; const bfr* ap1;
        const int tq = ltid();
        {
            int p0 = rb * 128 + (tq >> 2); p0 = p0 < c ? p0 : c - 1;
            int p1 = rb * 128 + (tq >> 2) + 64; p1 = p1 < c ? p1 : c - 1;
            ap0 = hb + (size_t)stok[(size_t)seg * NTOK + p0] * 1024 + gt2_lcol(tq);
            ap1 = hb + (size_t)stok[(size_t)seg * NTOK + p1] * 1024 + gt2_lcol(tq);
        }
        auto aptr = [&](int i, int kt) __attribute__((always_inline)) -> const bfr* { return (i ? ap1 : ap0) + kt * 32; };
        RowLoader2 B(wgu + (size_t)e * 1024 * 1024, nt * 256, 1024);
        const size_t hrow0 = (size_t)hoff[seg] + rb * 128;
        gemm_tile256(lds, 32, aptr, B, [&](const float* stg, int p) __attribute__((always_inline)) {
            epi2_rows8(stg, p, [&](int r, int gc, const float (&v)[8]) __attribute__((always_inline)) {
                float o[4];
#pragma unroll
                for (int j = 0; j < 4; ++j) o[j] = v[j] * sigmoidf_(v[j]) * v[4 + j];
                *(uint2*)(hid + (hrow0 + r) * 512 + ((nt * 256 + gc) >> 1)) = make_uint2(pk2(o[0], o[1]), pk2(o[2], o[3]));
            });
        });
    }
}

DI void phase_moe_down(char* lds, const Ctx& P, int layer, int k, float* x) {
    moe_tables(lds, P, layer);
    const int* cnt = (const int*)(lds + LDS_AUX); const int* rb0 = cnt + 64; const int* hoff = rb0 + 65;
    const bfr* hid = (const bfr*)(P.ws + OFF_HID);
    const bfr* wd = (const bfr*)(P.ws + OFF_MWD);
    const int* stok = (const int*)(P.ws + OFF_TOK);
    const float* sgate = (const float*)(P.ws + OFF_GATE);
    const int rbA = rb0[k * 32], rbB = rb0[k * 32 + 32];
    const int ntiles = (rbB - rbA) * 8;
    for (int t = blockIdx.x; t < ntiles; t += gridDim.x) {
        int rbi, nt; tile_remap(t, rbB - rbA, 8, rbi, nt); rbi += rbA;
        const int seg = moe_find_seg(rb0, rbi);
        const int rb = rbi - rb0[seg], e = seg & 31, c = cnt[seg];
        RowLoader A(hid, hoff[seg] + rb * 128, 512), B(wd + (size_t)e * 1024 * 512, nt * 128, 512);
        int* ltok = (int*)(lds + LDS_AUX + 1024); float* lgate = (float*)(lds + LDS_AUX + 1536);
        {
            const int tq = ltid();
            if (tq < 128) {
                const int p = rb * 128 + tq;
                ltok[tq] = p < c ? stok[(size_t)seg * NTOK + p] : -1;
                lgate[tq] = p < c ? sgate[(size_t)seg * NTOK + p] : 0.f;
            }
        }
        gemm_tile(lds, 8, A, B, [&](const float* stg) __attribute__((always_inline)) {
            epi_rows8_pre<F8>(stg,
                [&](int r, int c0) __attribute__((always_inline)) -> F8 {
                    int tok = ltok[r]; tok = tok < 0 ? 0 : tok;
                    const float* d = x + (size_t)tok * DM + nt * 128 + c0;
                    F8 o; o.a = *(const float4*)d; o.b = *(const float4*)(d + 4);
                    return o; },
                [&](int r, int c0, const float (&v)[8], const F8& o) __attribute__((always_inline)) {
                    const int tok = ltok[r];
                    if (tok >= 0) {
                        const float gt = lgate[r];
                        float* d = x + (size_t)tok * DM + nt * 128 + c0;
                        *(float4*)d = make_float4(o.a.x + gt * v[0], o.a.y + gt * v[1], o.a.z + gt * v[2], o.a.w + gt * v[3]);
                        *(float4*)(d + 4) = make_float4(o.b.x + gt * v[4], o.b.y + gt * v[5], o.b.z + gt * v[6], o.b.w + gt * v[7]);
                    }
                });
        });
    }
}
constexpr int PH_PER_LAYER = 11;
constexpr int N_PHASES = 1 + 4 * PH_PER_LAYER;

DI void phase_prologue(char* lds, const Ctx& P) {
    for (int u = blockIdx.x; u < 64; u += gridDim.x) s5_tables(lds, P, u >> 5, u & 31);
    const bool excl = gridDim.x >= 128;
    if (excl && blockIdx.x < 64) return;
    unsigned base = 0;
    const int wk = excl ? (int)blockIdx.x - 64 : (int)blockIdx.x, nw = excl ? (int)gridDim.x - 64 : (int)gridDim.x;
    for (int i = 0; i < 2; ++i) {
        cvt_matrix(lds, P.in[I_EWIN] + (size_t)i * 1024 * 2304, 1024, 2304, (bfr*)(P.ws + OFF_WINE) + (size_t)i * 2304 * 1024, 1024, 0, wk, nw, base);
        cvt_matrix(lds, P.in[I_EWOUT] + (size_t)i * 1024 * 1024, 1024, 1024, (bfr*)(P.ws + OFF_WOUTE) + (size_t)i * 1024 * 1024, 1024, 0, wk, nw, base);
        cvt_matrix(lds, P.in[I_OWIN] + (size_t)i * 1024 * 2048, 1024, 2048, (bfr*)(P.ws + OFF_WINO) + (size_t)i * 2048 * 1024, 1024, 0, wk, nw, base);
        cvt_matrix(lds, P.in[I_OWOUT] + (size_t)i * 1024 * 1024, 1024, 1024, (bfr*)(P.ws + OFF_WOUTO) + (size_t)i * 1024 * 1024, 1024, 0, wk, nw, base);
        cvt_matrix(lds, P.in[I_W2] + (size_t)i * 64 * 512, 64, 512, (bfr*)(P.ws + OFF_W2T) + (size_t)i * 512 * 64, 64, 0, wk, nw, base);
        cvt_matrix(lds, P.in[I_A2] + (size_t)i * 64 * 512, 64, 512, (bfr*)(P.ws + OFF_A2T) + (size_t)i * 512 * 64, 64, 0, wk, nw, base);
        cvt_matrix(lds, P.in[I_G2] + (size_t)i * 128 * 512, 128, 512, (bfr*)(P.ws + OFF_G2T) + (size_t)i * 512 * 128, 128, 0, wk, nw, base);
        for (int g = 0; g < 4; ++g)
            cvt_matrix(lds, P.in[I_POOLW] + (size_t)(i * 4 + g) * 128 * 128, 128, 128, (bfr*)(P.ws + OFF_POOLT) + (size_t)(i * 4 + g) * 128 * 128, 128, 0, wk, nw, base);
        cvt_matrix(lds, P.in[I_WGLU] + (size_t)i * 512 * 512, 512, 512, (bfr*)(P.ws + OFF_GLUT) + (size_t)i * 512 * 512, 512, 0, wk, nw, base);
    }
    const int gtid = wk * NTHREADS + ltid(), gsz = nw * NTHREADS;
    {
        bfr* rhi = (bfr*)(P.ws + OFF_RHI); bfr* rlo = (bfr*)(P.ws + OFF_RLO);
        for (int idx = gtid; idx < 4 * 128 * 1024; idx += gsz) {
            const int k = idx & 1023, n = (idx >> 10) & 127, l = idx >> 17;
            float w = 0.f;
            if (n < 32) w = P.in[I_MWE][((size_t)l * 1024 + k) * 32 + n];
            else if (n < 36) w = P.in[I_MWG][((size_t)l * 1024 + k) * 4 + (n - 32)];
            const bfr h = f2bf(w);
            rhi[idx] = h; rlo[idx] = f2bf(w - bf2f(h));
        }
    }
    {
        bfr* v12 = (bfr*)(P.ws + OFF_V12T);
        const float* v1 = P.in[I_V1]; const float* v2 = P.in[I_V2];
        for (int idx = gtid; idx < 512 * 512; idx += gsz) {
            const int k = idx & 511, n = idx >> 9;
            float s = 0.f;
            for (int r = 0; r < 32; ++r) s += v1[k * 32 + r] * v2[r * 512 + n];
            v12[idx] = f2bf(s);
        }
    }
    for (int tt = wk; tt < 512; tt += nw)
        norm_rows(P.in[I_X], P.in[I_NMIX], (bfr*)(P.ws + OFF_HB), nullptr, P.out, tt * 64, 64);
}

DI Ctx mkctx(unsigned char* ws, float* out) {
    size_t z = 0;
    asm volatile("" : "+s"(z));
    Ctx c;
    c.in.p = (KArgPtr)__builtin_amdgcn_kernarg_segment_ptr() + z;
    c.ws = ws + z; c.out = (float*)((char*)out + z);
    return c;
}
__global__ void __launch_bounds__(NTHREADS, 2) fwd_kernel(Params PA) {
    extern __shared__ __attribute__((aligned(16))) char lds[];
    if (threadIdx.x == 0) *(uint4*)(lds + LDS_BYTES - 16) = make_uint4(0u, 0u, 0u, 0u);
    __syncthreads();
    XcdBarrier bar = xcd_barrier_post((unsigned*)(PA.ws + OFF_BAR), (volatile LAS unsigned*)(lds + LDS_BYTES - 16));
    const int lo = PA.ph_lo, hi = PA.ph_hi;
#ifndef DUP_PH
#define DUP_PH (-1)
#endif
#define DUPX(k, call) do { call; if (DUP_PH == (k)) { __syncthreads(); call; } } while (0)
#define RUNS(id) ((id) >= lo && (id) < hi)
#define P mkctx(PA.ws, PA.out)
#define SEAM(id) do { if ((id) > lo && (id) < hi) xcd_barrier(bar); } while (0)
    if (RUNS(0)) DUPX(100, phase_prologue(lds, P));
    for (int layer = 0; layer < 4; ++layer) {
        const int base = 1 + layer * PH_PER_LAYER;
        const int li = layer >> 1;
        if ((layer & 1) == 0) {
            SEAM(base + 0); if (RUNS(base + 0)) { DUPX(0, phase_e1(lds, P, li)); if (DUP_PH == 30) phase_e1(lds, P, li, 16, OFF_EV); if (DUP_PH == 31) phase_e1(lds, P, li, 2, OFF_EV); if (DUP_PH == 32) phase_e1(lds, P, li, 32, OFF_EV); if (DUP_PH == 33) phase_e1(lds, P, li, 32, OFF_EV, 1); if (DUP_PH == 34) phase_e1(lds, P, li, 32, OFF_EV, 2); }
            SEAM(base + 1); if (RUNS(base + 1)) DUPX(1, phase_e2a(P, li));
            SEAM(base + 2); if (RUNS(base + 2)) DUPX(2, phase_e2b(lds, P, li));
            SEAM(base + 3); if (RUNS(base + 3)) DUPX(3, phase_e3(lds, P, li));
            SEAM(base + 4); if (RUNS(base + 4)) DUPX(4, phase_e4(P, li));
            SEAM(base + 5); if (RUNS(base + 5)) { phase_wout(lds, P, (const bfr*)(P.ws + OFF_WOUTE) + (size_t)li * 1024 * 1024, P.out); if (DUP_PH == 5) phase_wout(lds, P, (const bfr*)(P.ws + OFF_WOUTE) + (size_t)li * 1024 * 1024, (float*)(P.ws + OFF_EV)); }
        } else {
            SEAM(base + 0); if (RUNS(base + 0)) DUPX(10, phase_o1(lds, P, li));
            SEAM(base + 1); if (RUNS(base + 1)) DUPX(11, phase_o2(lds, P, li));
            SEAM(base + 2); if (RUNS(base + 2)) DUPX(12, phase_o3(lds, P, li, layer));
            SEAM(base + 3); if (RUNS(base + 3)) DUPX(13, phase_o4(lds, P, li));
            SEAM(base + 4); if (RUNS(base + 4)) DUPX(14, phase_o5(lds, P, li));
            SEAM(base + 5); if (RUNS(base + 5)) { phase_wout(lds, P, (const bfr*)(P.ws + OFF_WOUTO) + (size_t)li * 1024 * 1024, P.out); if (DUP_PH == 5) phase_wout(lds, P, (const bfr*)(P.ws + OFF_WOUTO) + (size_t)li * 1024 * 1024, (float*)(P.ws + OFF_EV)); }
        }
        SEAM(base + 6);
        if (RUNS(base + 6)) {
            phase_router(lds, P, layer);
            const bool split = gridDim.x >= 512;
            DUPX(6, moe_convert(lds, P, layer, split ? (int)blockIdx.x - 256 : (int)blockIdx.x, split ? (int)gridDim.x - 256 : (int)gridDim.x));
        }
        SEAM(base + 7); if (RUNS(base + 7)) DUPX(7, phase_moe_up(lds, P, layer));
        SEAM(base + 8); if (RUNS(base + 8)) { phase_moe_down(lds, P, layer, 0, P.out); if (DUP_PH == 8) phase_moe_down(lds, P, layer, 0, (float*)(P.ws + OFF_EV)); }
        SEAM(base + 9); if (RUNS(base + 9)) phase_moe_down(lds, P, layer, 1, P.out);
        SEAM(base + 10);
        if (RUNS(base + 10) && layer < 3) {
            for (int rep = 0; rep < (DUP_PH == 20 ? 2 : 1); ++rep)
            for (int tt = blockIdx.x; tt < 512; tt += gridDim.x)
                norm_rows(P.out, P.in[I_NMIX] + (size_t)(layer + 1) * DM, (bfr*)(P.ws + OFF_HB), nullptr, nullptr, tt * 64, 64);
        }
    }
#undef P
#undef RUNS
#undef SEAM
}

#ifndef N_LAUNCH_SPLIT
#define N_LAUNCH_SPLIT 0
#endif
extern "C" void kernel_launch(void* const* d_in, const int* in_sizes, int n_in, void* d_out, int out_size, void* d_ws, size_t ws_size, hipStream_t stream) {
    static int grid = 0;
    if (grid == 0) {
        if (n_in != N_INPUTS || out_size != NTOK * DM || ws_size < WS_NEEDED) {
            fprintf(stderr, "kernel_launch: unexpected shapes: n_in %d out %d ws %zu (need %zu)\n", n_in, out_size, ws_size, (size_t)WS_NEEDED);
            grid = -1; return;
        }
        int dev = 0, cus = 0, per_cu = 0;
        (void)hipGetDevice(&dev);
        (void)hipDeviceGetAttribute(&cus, hipDeviceAttributeMultiprocessorCount, dev);
        if (hipFuncSetAttribute((const void*)fwd_kernel, hipFuncAttributeMaxDynamicSharedMemorySize, LDS_BYTES) != hipSuccess) { fprintf(stderr, "kernel_launch: hipFuncSetAttribute failed\n"); grid = -1; return; }
        if (hipOccupancyMaxActiveBlocksPerMultiprocessor(&per_cu, (const void*)fwd_kernel, NTHREADS, LDS_BYTES) != hipSuccess) per_cu = 1;
        (void)hipGetLastError();
        if (per_cu < 1) per_cu = 1;
        if (per_cu > 2) per_cu = 2;
        if (cus <= 0) cus = 256;
        grid = cus * per_cu;
    }
    if (grid < 0) return;
    (void)hipMemsetAsync(d_ws, 0, OFF_ZERO_END, stream);
    Params p{};
    for (int i = 0; i < N_INPUTS; ++i) p.in[i] = (const float*)d_in[i];
    p.out = (float*)d_out; p.ws = (unsigned char*)d_ws;
#if N_LAUNCH_SPLIT
    for (int ph = 0; ph < N_PHASES - 1; ++ph) {
        p.ph_lo = ph; p.ph_hi = ph + 1;
        hipLaunchKernelGGL(fwd_kernel, dim3(grid), dim3(NTHREADS), LDS_BYTES, stream, p);
    }
#else
    p.ph_lo = 0; p.ph_hi = N_PHASES;
    hipLaunchKernelGGL(fwd_kernel, dim3(grid), dim3(NTHREADS), LDS_BYTES, stream, p);
#endif
}
```

```cpp
#include <hip/hip_runtime.h>
#include <stdint.h>
#include <stdio.h>

typedef unsigned short bfr;
typedef __attribute__((ext_vector_type(8))) short bf16x8;
typedef __attribute__((ext_vector_type(16))) float f32x16;
typedef __attribute__((ext_vector_type(2))) __bf16 bf16x2_t;
#define DI __device__ __forceinline__
#define MFMA32(a, b, c) __builtin_amdgcn_mfma_f32_32x32x16_bf16((a), (b), (c), 0, 0, 0)

constexpr int NTOK = 32768, DM = 1024, SEQ = 2048, NB = 16;
constexpr int EVEN_IN = 2304, ODD_IN = 2048;
constexpr int NTHREADS = 256;
constexpr int LDS_BYTES = 81920;

enum { I_X = 0, I_NMIX, I_NFFN, I_EWIN, I_MU, I_W0, I_W2, I_A0, I_A2, I_G2, I_KK, I_KA, I_RK, I_LNG, I_LNB, I_V0, I_V1, I_V2,
       I_POOLW, I_POOLS, I_EWOUT, I_OWIN, I_QN, I_KN, I_LQ1, I_LK1, I_LQ2, I_LK2, I_SUBLN, I_ARE, I_AIM, I_LSTEP, I_BRE, I_BIM,
       I_CRE, I_CIM, I_S5D, I_WGLU, I_OWOUT, I_MWG, I_MBG, I_MWE, I_MBE, I_MWGATE, I_MWUP, I_MWDOWN, N_INPUTS };

constexpr size_t al256(size_t x) { return (x + 255) & ~(size_t)255; }
constexpr size_t OFF_BAR   = 0;
constexpr size_t OFF_CNT   = 16384;
constexpr size_t OFF_ZERO_END = 32768;
constexpr size_t OFF_WINE  = 65536;
constexpr size_t OFF_WOUTE = OFF_WINE  + (size_t)2 * 2304 * 1024 * 2;
constexpr size_t OFF_WINO  = OFF_WOUTE + (size_t)2 * 1024 * 1024 * 2;
constexpr size_t OFF_WOUTO = OFF_WINO  + (size_t)2 * 2048 * 1024 * 2;
constexpr size_t OFF_W2T   = OFF_WOUTO + (size_t)2 * 1024 * 1024 * 2;
constexpr size_t OFF_A2T   = OFF_W2T   + (size_t)2 * 512 * 64 * 2;
constexpr size_t OFF_G2T   = OFF_A2T   + (size_t)2 * 512 * 64 * 2;
constexpr size_t OFF_V12T  = OFF_G2T   + (size_t)2 * 512 * 128 * 2;
constexpr size_t OFF_POOLT = OFF_V12T  + (size_t)512 * 512 * 2;
constexpr size_t OFF_GLUT  = OFF_POOLT + (size_t)2 * 4 * 128 * 128 * 2;
constexpr size_t OFF_RHI   = OFF_GLUT  + (size_t)2 * 512 * 512 * 2;
constexpr size_t OFF_RLO   = OFF_RHI   + (size_t)4 * 128 * 1024 * 2;
constexpr size_t OFF_S5GT  = OFF_RLO   + (size_t)4 * 128 * 1024 * 2;
constexpr size_t OFF_S5BL  = OFF_S5GT  + (size_t)2 * 32 * 512 * 640 * 2;
constexpr size_t OFF_S5L32 = OFF_S5BL  + (size_t)2 * 32 * 128 * 512 * 2;
constexpr size_t OFF_MWGU  = al256(OFF_S5L32 + (size_t)2 * 32 * 64 * 2 * 4);
constexpr size_t OFF_MWD   = OFF_MWGU  + (size_t)32 * 1024 * 1024 * 2;
constexpr size_t OFF_HB    = OFF_MWD   + (size_t)32 * 1024 * 512 * 2;
constexpr size_t OFF_U     = OFF_HB    + (size_t)NTOK * 1024 * 2;
constexpr size_t OFF_US5   = OFF_U     + (size_t)NTOK * 1024 * 2;
constexpr size_t OFF_AMIX  = OFF_U     + (size_t)NTOK * 2304 * 2;
constexpr size_t OFF_VFIRST= OFF_AMIX  + (size_t)NTOK * 1024 * 2;
constexpr size_t OFF_TOK   = OFF_VFIRST+ (size_t)NTOK * 512 * 2;
constexpr size_t OFF_GATE  = OFF_TOK   + (size_t)64 * NTOK * 4;
constexpr size_t OFF_HID   = OFF_GATE  + (size_t)64 * NTOK * 4;
constexpr size_t OFF_HLO   = OFF_HID;
constexpr size_t OFF_EV    = OFF_HID   + (size_t)73728 * 512 * 2;
constexpr size_t OFF_S     = OFF_EV;
constexpr size_t OFF_MV2   = OFF_S     + (size_t)NTOK * 256 * 2;
constexpr size_t OFF_DLOG  = OFF_MV2   + (size_t)NTOK * 512 * 2;
constexpr size_t OFF_ABUF  = OFF_DLOG  + (size_t)NTOK * 512 * 4;
constexpr size_t OFF_GBUF  = OFF_ABUF  + (size_t)NTOK * 512 * 2;
constexpr size_t OFF_VGATE = OFF_GBUF  + (size_t)NTOK * 512 * 2;
constexpr size_t OFF_Y     = OFF_VGATE + (size_t)NTOK * 512 * 2;
constexpr size_t OFF_DPOOL = OFF_Y;
constexpr size_t OFF_BONUS = OFF_Y     + (size_t)NTOK * 512 * 4;
constexpr size_t OFF_EV_END= OFF_BONUS + (size_t)NTOK * 512 * 4;
constexpr size_t OFF_QN    = OFF_EV;
constexpr size_t OFF_KN    = OFF_QN    + (size_t)NTOK * 512 * 2;
constexpr size_t OFF_VT    = OFF_KN    + (size_t)NTOK * 512 * 2;
constexpr size_t OFF_XLOC  = OFF_VT    + (size_t)NTOK * 512 * 2;
constexpr size_t OFF_XIN   = OFF_XLOC  + (size_t)32 * 1024 * 128 * 4;
constexpr size_t OFF_ZBUF  = OFF_XIN   + (size_t)32 * 1024 * 128 * 2;
constexpr size_t OFF_OD_END= OFF_ZBUF  + (size_t)NTOK * 512 * 2;
constexpr size_t WS_NEEDED = OFF_EV_END > OFF_OD_END ? OFF_EV_END : OFF_OD_END;

struct Params {
    const float* in[N_INPUTS];
    float* out;
    unsigned char* ws;
    int ph_lo, ph_hi;
};
typedef const __attribute__((address_space(4))) char* KArgPtr;
struct InTab {
    KArgPtr p;
    DI const float* operator[](int i) const {
        const float* q = *(const float* const __attribute__((address_space(4)))*)(p + 8 * i);
        return (const float*)(const __attribute__((address_space(1))) float*)q;
    }
};
struct Ctx { InTab in; unsigned char* ws; float* out; };

DI unsigned pk2(float a, float b) { bf16x2_t v; v[0] = (__bf16)a; v[1] = (__bf16)b; return __builtin_bit_cast(unsigned, v); }
DI bfr f2bf(float a) { return (bfr)(pk2(a, 0.f) & 0xffffu); }
DI float bf2f(bfr b) { return __uint_as_float(((unsigned)b) << 16); }
DI float bflo(unsigned u) { return __uint_as_float(u << 16); }
DI float bfhi(unsigned u) { return __uint_as_float(u & 0xffff0000u); }
DI uint4 pack8(const float (&v)[8]) { return make_uint4(pk2(v[0], v[1]), pk2(v[2], v[3]), pk2(v[4], v[5]), pk2(v[6], v[7])); }
DI void unpack8(uint4 u, float (&v)[8]) { v[0] = bflo(u.x); v[1] = bfhi(u.x); v[2] = bflo(u.y); v[3] = bfhi(u.y); v[4] = bflo(u.z); v[5] = bfhi(u.z); v[6] = bflo(u.w); v[7] = bfhi(u.w); }
DI float frcp(float x) { return __builtin_amdgcn_rcpf(x); }
DI float fexp(float x) { return __builtin_amdgcn_exp2f(x * 1.4426950408889634f); }
DI float sigmoidf_(float x) { return frcp(1.0f + fexp(-x)); }
DI float ftanh(float x) { return 2.0f * frcp(1.0f + fexp(-2.0f * x)) - 1.0f; }
DI float fsoftplus(float z) { return z > 20.0f ? z : __logf(1.0f + fexp(z)); }
template <int CTRL> DI float dpp_f(float x) { return __builtin_bit_cast(float, __builtin_amdgcn_update_dpp(0, __builtin_bit_cast(int, x), CTRL, 0xf, 0xf, false)); }
DI float row16_sum(float s) {
    s += dpp_f<0x128>(s); s += dpp_f<0x124>(s); s += dpp_f<0x122>(s); s += dpp_f<0x121>(s); return s; }
DI int ltid() { int t = threadIdx.x; asm volatile("" : "+v"(t)); return t; }
DI float dot4n(float s0, float s1, float s2, float s3, const float4& a) {
    float d;
    asm("v_mul_f32 %0, %1, %5\n\tv_fma_f32 %0, %2, %6, %0\n\tv_fma_f32 %0, %3, %7, %0\n\tv_fma_f32 %0, %4, %8, %0\n\ts_nop 1"
        : "=&v"(d) : "v"(s0), "v"(s1), "v"(s2), "v"(s3), "v"(a.x), "v"(a.y), "v"(a.z), "v"(a.w));
    return d;
}
DI void rw_upd(float& S, float w, float sa, float b, float vi, float k) {
    float t;
    asm("v_mul_f32 %1, %4, %5\n\tv_fma_f32 %1, %2, %3, %1\n\tv_fma_f32 %0, %0, %6, %1"
        : "+v"(S), "=&v"(t) : "v"(sa), "v"(b), "v"(vi), "v"(k), "v"(w));
}
DI float wave_sum(float s) { s = row16_sum(s); s += __shfl_xor(s, 16); s += __shfl_xor(s, 32); return s; }
#define XB_TMO      128
#define XB_XCNT(j)  (256  + 64 * (j))
#define XB_XSUB(j)  (1280 + 64 * (j))
#define XB_XGEN(j)  (2304 + 64 * (j))
#define XB_TOP      3328
#define XB_TOPGEN   3392
#define XCD_BAR_WORDS 3456
#define XB_SPIN_CAP (1u << 18)
#define LAS __attribute__((address_space(3)))

__device__ __forceinline__ unsigned xb_ld(unsigned* p)              { return __hip_atomic_load(p, __ATOMIC_RELAXED, __HIP_MEMORY_SCOPE_AGENT); }
__device__ __forceinline__ unsigned xb_add(unsigned* p, unsigned v) { return __hip_atomic_fetch_add(p, v, __ATOMIC_RELAXED, __HIP_MEMORY_SCOPE_AGENT); }
__device__ __forceinline__ unsigned xb_xcc_id() { return (unsigned)__builtin_amdgcn_s_getreg((3 << 11) | 20) & 0xFu; }
#define XB_SPIN(cond, bar) do { unsigned _sp = 0; while (cond) { __builtin_amdgcn_s_sleep(1); \
    if ((++_sp & 255u) == 0u) { if (xb_ld(&(bar)[XB_TMO])) break; if (_sp > XB_SPIN_CAP) { atomicAdd(&(bar)[XB_TMO], 1u); break; } } } } while (0)

struct XcdBarrier {
    unsigned* bar; unsigned x;
    volatile LAS unsigned* st;
};
__device__ __forceinline__ XcdBarrier xcd_barrier_post(unsigned* bar, volatile LAS unsigned* st) {
    XcdBarrier b; b.bar = bar; b.x = xb_xcc_id(); b.st = st;
    if (threadIdx.x == 0) (void)xb_add(&bar[XB_XCNT(b.x)], 1u);
    return b;
}
__device__ __forceinline__ void xcd_barrier_complete(unsigned* bar, unsigned x, unsigned& nloc, unsigned& nx) {
    const unsigned G = gridDim.x * gridDim.y * gridDim.z;
    unsigned sum, cnt, mine, sp = 0u;
    for (;;) {
        sum = 0u; cnt = 0u; mine = 0u;
#pragma unroll
        for (unsigned j = 0; j < 16; ++j) { const unsigned c = xb_ld(&bar[XB_XCNT(j)]); sum += c; cnt += (c > 0u) ? 1u : 0u; mine = (j == x) ? c : mine; }
        if (sum == G) break;
        __builtin_amdgcn_s_sleep(1);
        if ((++sp & 255u) == 0u) { if (xb_ld(&bar[XB_TMO])) break; if (sp > XB_SPIN_CAP) { atomicAdd(&bar[XB_TMO], 1u); break; } }
    }
    nloc = mine > 0u ? mine : 1u; nx = cnt > 0u ? cnt : 1u;
}
__device__ __forceinline__ void xcd_barrier(const XcdBarrier& b) {
    asm volatile("s_waitcnt vmcnt(0)" ::: "memory");
    __syncthreads();
    if (threadIdx.x == 0) {
        unsigned* bar = b.bar;
        __builtin_amdgcn_s_waitcnt(0);
        unsigned nloc = b.st[0], nx = b.st[1];
        if (nloc == 0u) { xcd_barrier_complete(bar, b.x, nloc, nx); b.st[0] = nloc; b.st[1] = nx; }
        const unsigned old = xb_add(&bar[XB_XSUB(b.x)], 1u);
        const unsigned gen = old / nloc;
        if (old + 1u == (gen + 1u) * nloc) {
            __builtin_amdgcn_fence(__ATOMIC_RELEASE, "agent");
            asm volatile("s_waitcnt vmcnt(0)" ::: "memory");
            const unsigned og = xb_add(&bar[XB_TOP], 1u);
            const unsigned tg = og / nx;
            if (og + 1u == (tg + 1u) * nx) xb_add(&bar[XB_TOPGEN], 1u);
            else XB_SPIN(xb_ld(&bar[XB_TOPGEN]) == tg, bar);
            __builtin_amdgcn_fence(__ATOMIC_ACQUIRE, "agent");
            xb_add(&bar[XB_XGEN(b.x)], 1u);
            asm volatile("s_waitcnt vmcnt(0)" ::: "memory");
        } else {
            XB_SPIN(xb_ld(&bar[XB_XGEN(b.x)]) == gen, bar);
            __builtin_amdgcn_fence(__ATOMIC_ACQUIRE, "agent");
            asm volatile("s_waitcnt vmcnt(0)" ::: "memory");
        }
    }
    __syncthreads();
}

constexpr int LDA = 72;
constexpr int TILE_B = 128 * LDA * 2;
constexpr int GT_TILE = 128 * 128;
constexpr int STG_LD = 132;
constexpr int LDS_AUX = 73728;
typedef const __attribute__((address_space(1))) unsigned* GPtrU;
typedef __attribute__((address_space(3))) unsigned* LPtrU;
DI int gt_lcol(int t) { return (((t & 7) ^ ((t >> 4) & 7)) * 8); }

template <class AF, class BF, class EF>
DI void gemm_tile(char* lds, int nk, AF aptr, BF bptr, EF epi) {
    const int tid = ltid(), lane = tid & 63, wave = tid >> 6;
    const int wr = wave >> 1, wc = wave & 1;
    f32x16 acc00, acc01, acc10, acc11;
#pragma unroll
    for (int r = 0; r < 16; ++r) { acc00[r] = 0.f; acc01[r] = 0.f; acc10[r] = 0.f; acc11[r] = 0.f; }
#define GT_DMA(kt_, base_) do { char* db_ = (base_) + tid * 16; _Pragma("unroll") for (int i_ = 0; i_ < 4; ++i_) { \
        __builtin_amdgcn_global_load_lds((GPtrU)aptr(i_, kt_), (LPtrU)(db_ + i_ * 4096), 16, 0, 0); \
        __builtin_amdgcn_global_load_lds((GPtrU)bptr(i_, kt_), (LPtrU)(db_ + GT_TILE + i_ * 4096), 16, 0, 0); } } while (0)
#define GT_FRAG(cb_, off_) (*(const bf16x8*)((cb_) + (off_)))
#define GT_COMPUTE(base_) do { const char* cb_ = (base_); \
        { const bf16x8 a0 = GT_FRAG(cb_, ao0), a1 = GT_FRAG(cb_, ao0 + 4096), b0 = GT_FRAG(cb_, bo0), b1 = GT_FRAG(cb_, bo0 + 4096); \
          acc00 = MFMA32(a0, b0, acc00); acc01 = MFMA32(a0, b1, acc01); acc10 = MFMA32(a1, b0, acc10); acc11 = MFMA32(a1, b1, acc11); } \
        { const bf16x8 a0 = GT_FRAG(cb_, ao1), a1 = GT_FRAG(cb_, ao1 + 4096), b0 = GT_FRAG(cb_, bo1), b1 = GT_FRAG(cb_, bo1 + 4096); \
          acc00 = MFMA32(a0, b0, acc00); acc01 = MFMA32(a0, b1, acc01); acc10 = MFMA32(a1, b0, acc10); acc11 = MFMA32(a1, b1, acc11); } \
        { const bf16x8 a0 = GT_FRAG(cb_, ao2), a1 = GT_FRAG(cb_, ao2 + 4096), b0 = GT_FRAG(cb_, bo2), b1 = GT_FRAG(cb_, bo2 + 4096); \
          acc00 = MFMA32(a0, b0, acc00); acc01 = MFMA32(a0, b1, acc01); acc10 = MFMA32(a1, b0, acc10); acc11 = MFMA32(a1, b1, acc11); } \
        { const bf16x8 a0 = GT_FRAG(cb_, ao3), a1 = GT_FRAG(cb_, ao3 + 4096), b0 = GT_FRAG(cb_, bo3), b1 = GT_FRAG(cb_, bo3 + 4096); \
          acc00 = MFMA32(a0, b0, acc00); acc01 = MFMA32(a0, b1, acc01); acc10 = MFMA32(a1, b0, acc10); acc11 = MFMA32(a1, b1, acc11); } } while (0)
    const int ln = lane & 31, hf = lane >> 5, sw = (ln >> 1) & 7;
    int ao0 = wr * 8192 + ln * 128 + ((0 + hf) ^ sw) * 16, ao1 = wr * 8192 + ln * 128 + ((2 + hf) ^ sw) * 16;
    int ao2 = wr * 8192 + ln * 128 + ((4 + hf) ^ sw) * 16, ao3 = wr * 8192 + ln * 128 + ((6 + hf) ^ sw) * 16;
    int bo0 = GT_TILE + wc * 8192 + ln * 128 + ((0 + hf) ^ sw) * 16, bo1 = GT_TILE + wc * 8192 + ln * 128 + ((2 + hf) ^ sw) * 16;
    int bo2 = GT_TILE + wc * 8192 + ln * 128 + ((4 + hf) ^ sw) * 16, bo3 = GT_TILE + wc * 8192 + ln * 128 + ((6 + hf) ^ sw) * 16;
    asm volatile("" : "+v"(ao0), "+v"(ao1), "+v"(ao2), "+v"(ao3), "+v"(bo0), "+v"(bo1), "+v"(bo2), "+v"(bo3));
    GT_DMA(0, lds);
    asm volatile("s_waitcnt vmcnt(0)" ::: "memory");
    __syncthreads();
    int buf = 0;
#pragma unroll 1
    for (int kt = 0; kt < nk - 1; ++kt) {
        GT_DMA(kt + 1, lds + (buf ^ 1) * (2 * GT_TILE));
        GT_COMPUTE(lds + buf * (2 * GT_TILE));
        asm volatile("s_waitcnt vmcnt(0)" ::: "memory");
        __syncthreads();
        buf ^= 1;
    }
    GT_COMPUTE(lds + buf * (2 * GT_TILE));
    __syncthreads();
#undef GT_DMA
#undef GT_FRAG
#undef GT_COMPUTE
    float* stg = (float*)lds;
    int w_off = (wr * 64 + 4 * (lane >> 5)) * STG_LD + wc * 64 + (lane & 31);
    asm volatile("" : "+v"(w_off));
#pragma unroll
    for (int r = 0; r < 16; ++r) {
        const int ro = ((r & 3) + 8 * (r >> 2)) * STG_LD;
        stg[w_off + ro] = acc00[r];
        stg[w_off + ro + 32] = acc01[r];
        stg[w_off + ro + 32 * STG_LD] = acc10[r];
        stg[w_off + ro + 32 * STG_LD + 32] = acc11[r];
    }
    __syncthreads();
    epi((const float*)stg);
    __syncthreads();
}
constexpr int G2_STAGE = 128 * 64 + 256 * 64;
DI int gt2_lcol(int t) { return (((t & 3) ^ ((t >> 4) & 3)) * 8); }
DI int g2_col(int cs, int p) { return (cs >> 6) * 128 + p * 64 + (cs & 63); }
template <class AF, class BF, class EF>
DI void gemm_tile256(char* lds, int nk, AF aptr, BF bptr, EF epi, int probe = 0) {
    const int tid = ltid(), lane = tid & 63, wave = tid >> 6;
    const int wr = wave >> 1, wc = wave & 1;
    f32x16 c00, c01, c02, c03, c10, c11, c12, c13;
#pragma unroll
    for (int r = 0; r < 16; ++r) { c00[r] = 0.f; c01[r] = 0.f; c02[r] = 0.f; c03[r] = 0.f; c10[r] = 0.f; c11[r] = 0.f; c12[r] = 0.f; c13[r] = 0.f; }
#define G2_DMA(kt_, base_) do { char* db_ = (base_) + tid * 16; \
        __builtin_amdgcn_global_load_lds((GPtrU)aptr(0, kt_), (LPtrU)(db_), 16, 0, 0); \
        __builtin_amdgcn_global_load_lds((GPtrU)aptr(1, kt_), (LPtrU)(db_ + 4096), 16, 0, 0); \
        __builtin_amdgcn_global_load_lds((GPtrU)bptr(0, kt_), (LPtrU)(db_ + 8192), 16, 0, 0); \
        __builtin_amdgcn_global_load_lds((GPtrU)bptr(1, kt_), (LPtrU)(db_ + 12288), 16, 0, 0); \
        __builtin_amdgcn_global_load_lds((GPtrU)bptr(2, kt_), (LPtrU)(db_ + 16384), 16, 0, 0); \
        __builtin_amdgcn_global_load_lds((GPtrU)bptr(3, kt_), (LPtrU)(db_ + 20480), 16, 0, 0); } while (0)
#define G2_FR(cb_, off_) (*(const bf16x8*)((cb_) + (off_)))
#define G2_KS(cb_, ao_, bo_) do { const bf16x8 a0 = G2_FR(cb_, ao_), a1 = G2_FR(cb_, ao_ + 2048); \
        const bf16x8 b0 = G2_FR(cb_, bo_), b1 = G2_FR(cb_, bo_ + 2048), b2 = G2_FR(cb_, bo_ + 4096), b3 = G2_FR(cb_, bo_ + 6144); \
        c00 = MFMA32(a0, b0, c00); c01 = MFMA32(a0, b1, c01); c02 = MFMA32(a0, b2, c02); c03 = MFMA32(a0, b3, c03); \
        c10 = MFMA32(a1, b0, c10); c11 = MFMA32(a1, b1, c11); c12 = MFMA32(a1, b2, c12); c13 = MFMA32(a1, b3, c13); } while (0)
    const int ln = lane & 31, hf = lane >> 5, sw = (ln >> 2) & 3;
    int ao0 = (wr * 64 + ln) * 64 + ((0 + hf) ^ sw) * 16, ao1 = (wr * 64 + ln) * 64 + ((2 + hf) ^ sw) * 16;
    int bo0 = 8192 + (wc * 128 + ln) * 64 + ((0 + hf) ^ sw) * 16, bo1 = 8192 + (wc * 128 + ln) * 64 + ((2 + hf) ^ sw) * 16;
    asm volatile("" : "+v"(ao0), "+v"(ao1), "+v"(bo0), "+v"(bo1));
    G2_DMA(0, lds);
    if (nk > 1) G2_DMA(1, lds + G2_STAGE);
    int st = 0;
#pragma unroll 1
    for (int kt = 0; kt < nk; ++kt) {
        if (probe != 1) {
        if (kt + 1 < nk) asm volatile("s_waitcnt vmcnt(6)" ::: "memory"); else asm volatile("s_waitcnt vmcnt(0)" ::: "memory");
        __builtin_amdgcn_s_barrier();
        }
        asm volatile("" ::: "memory");
        const char* cb = lds + st * G2_STAGE;
        G2_KS(cb, ao0, bo0);
        __builtin_amdgcn_sched_barrier(0);
        if (kt + 2 < nk && probe == 0) { const int s2 = st >= 1 ? st - 1 : 2; G2_DMA(kt + 2, lds + s2 * G2_STAGE); }
        __builtin_amdgcn_sched_barrier(0);
        G2_KS(cb, ao1, bo1);
        st = st == 2 ? 0 : st + 1;
    }
    __syncthreads();
#undef G2_DMA
#undef G2_FR
#undef G2_KS
    float* stg = (float*)lds;
    int w_off = (wr * 64 + 4 * (lane >> 5)) * STG_LD + wc * 64 + (lane & 31);
    asm volatile("" : "+v"(w_off));
#define G2_STAGE_OUT(x00_, x01_, x10_, x11_) do { _Pragma("unroll") for (int r = 0; r < 16; ++r) { const int ro = ((r & 3) + 8 * (r >> 2)) * STG_LD; \
        stg[w_off + ro] = x00_[r]; stg[w_off + ro + 32] = x01_[r]; stg[w_off + ro + 32 * STG_LD] = x10_[r]; stg[w_off + ro + 32 * STG_LD + 32] = x11_[r]; } } while (0)
    G2_STAGE_OUT(c00, c01, c10, c11);
    __syncthreads();
    epi((const float*)stg, 0);
    __syncthreads();
    G2_STAGE_OUT(c02, c03, c12, c13);
    __syncthreads();
    epi((const float*)stg, 1);
    __syncthreads();
#undef G2_STAGE_OUT
}
struct RowLoader2 {
    const bfr* p; size_t ld;
    DI RowLoader2(const bfr* base, int row0, size_t ld_) : ld(ld_) { const int t = ltid(); p = base + (size_t)(row0 + (t >> 2)) * ld_ + gt2_lcol(t); }
    DI const bfr* operator()(int i, int kt) const { return p + (size_t)(64 * i) * ld + kt * 32; }
};
template <class F> DI void epi_rows8(const float* stg, F f) {
    const int tid0 = ltid();
#pragma unroll
    for (int it = 0; it < 8; ++it) {
        const int idx = it * NTHREADS + tid0;
        const int r = idx >> 4, c0 = (idx & 15) * 8;
        const float4 p = *(const float4*)(stg + r * STG_LD + c0);
        const float4 q = *(const float4*)(stg + r * STG_LD + c0 + 4);
        const float v[8] = {p.x, p.y, p.z, p.w, q.x, q.y, q.z, q.w};
        f(r, c0, v);
    }
}
template <class T, class L, class F> DI void epi_rows8_pre(const float* stg, L loadf, F f) {
    const int tid0 = ltid();
    T pre[8];
#pragma unroll
    for (int it = 0; it < 8; ++it) { const int idx = it * NTHREADS + tid0; pre[it] = loadf(idx >> 4, (idx & 15) * 8); }
#pragma unroll
    for (int it = 0; it < 8; ++it) {
        const int idx = it * NTHREADS + tid0;
        const int r = idx >> 4, c0 = (idx & 15) * 8;
        const float4 p = *(const float4*)(stg + r * STG_LD + c0);
        const float4 q = *(const float4*)(stg + r * STG_LD + c0 + 4);
        const float v[8] = {p.x, p.y, p.z, p.w, q.x, q.y, q.z, q.w};
        f(r, c0, v, pre[it]);
    }
}
struct F8 { float4 a, b; };
template <class F> DI void epi2_rows8(const float* stg, int p, F f) {
    epi_rows8(stg, [&](int r, int c0, const float (&v)[8]) __attribute__((always_inline)) { f(r, g2_col(c0, p), v); });
}
template <class T, class L, class F> DI void epi2_rows8_pre(const float* stg, int p, L loadf, F f) {
    epi_rows8_pre<T>(stg, [&](int r, int c0) __attribute__((always_inline)) -> T { return loadf(r, g2_col(c0, p)); },
                     [&](int r, int c0, const float (&v)[8], const T& o) __attribute__((always_inline)) { f(r, g2_col(c0, p), v, o); });
}
DI void tile_remap(int L, int nM, int nN, int& pm, int& pn) {
    const int ntiles = nM * nN;
    int w = L;
    if ((ntiles & 7) == 0) w = (L & 7) * (ntiles >> 3) + (L >> 3);
    const int nig = 8 * nN, gid = w / nig, fm = gid * 8, rem = w - gid * nig;
    const int gsz = (nM - fm) < 8 ? (nM - fm) : 8;
    pm = fm + rem % gsz; pn = rem / gsz;
}
struct RowLoader {
    const bfr* p; size_t ld;
    DI RowLoader(const bfr* base, int row0, size_t ld_) : ld(ld_) { const int t = ltid(); p = base + (size_t)(row0 + (t >> 3)) * ld_ + gt_lcol(t); }
    DI const bfr* operator()(int i, int kt) const { return p + (size_t)(32 * i) * ld + kt * 64; }
};
DI int cvt_rowmap(int n, int mode) { return mode == 0 ? n : ((n >> 2) * 8 + (n & 3) + (mode == 2 ? 4 : 0)); }
DI void cvt_tile(char* lds, const float* __restrict__ src, int N, bfr* __restrict__ dst, int ldd, int k0, int n0, int mode) {
    float* t = (float*)lds;
    const int tid = ltid();
    const int r = tid >> 4, c = (tid & 15) * 4;
#pragma unroll
    for (int i = 0; i < 4; ++i) {
        const float4 v = *(const float4*)(src + (size_t)(k0 + r + 16 * i) * N + n0 + c);
        float* d = t + (r + 16 * i) * 65 + c;
        d[0] = v.x; d[1] = v.y; d[2] = v.z; d[3] = v.w;
    }
    __syncthreads();
#pragma unroll
    for (int i = 0; i < 2; ++i) {
        const int idx = tid + i * 256;
        const int n = idx & 63, kg = idx >> 6;
        float v[8];
#pragma unroll
        for (int j = 0; j < 8; ++j) v[j] = t[(kg * 8 + j) * 65 + n];
        *(uint4*)(dst + (size_t)cvt_rowmap(n0 + n, mode) * ldd + k0 + kg * 8) = pack8(v);
    }
    __syncthreads();
}
DI void cvt_matrix(char* lds, const float* src, int K, int N, bfr* dst, int ldd, int mode, int worker, int nworkers, unsigned& base) {
    if (worker < 0) return;
    const int ntn = N >> 6, ntiles = (K >> 6) * ntn;
    int t0 = (int)(((unsigned)worker + (unsigned)nworkers - (base % (unsigned)nworkers)) % (unsigned)nworkers);
    for (int t = t0; t < ntiles; t += nworkers) cvt_tile(lds, src, N, dst, ldd, (t / ntn) * 64, (t % ntn) * 64, mode);
    base += (unsigned)ntiles;
}
DI void moe_convert(char* lds, const Ctx& P, int layer, int worker, int nworkers) {
    unsigned base = 0;
    bfr* wgu = (bfr*)(P.ws + OFF_MWGU); bfr* wd = (bfr*)(P.ws + OFF_MWD);
    for (int e = 0; e < 32; ++e) {
        const size_t we = (size_t)(layer * 32 + e);
        cvt_matrix(lds, P.in[I_MWGATE] + we * 1024 * 512, 1024, 512, wgu + (size_t)e * 1024 * 1024, 1024, 1, worker, nworkers, base);
        cvt_matrix(lds, P.in[I_MWUP]   + we * 1024 * 512, 1024, 512, wgu + (size_t)e * 1024 * 1024, 1024, 2, worker, nworkers, base);
        cvt_matrix(lds, P.in[I_MWDOWN] + we * 512 * 1024, 512, 1024, wd  + (size_t)e * 1024 * 512,  512,  0, worker, nworkers, base);
    }
}

DI void s5_tables(char* lds, const Ctx& P, int i, int g) {
    float2* pw = (float2*)lds;
    float2* bb = pw + 64 * 33;
    float2* cm = bb + 64 * 16;
    float*  kt = (float*)(cm + 16 * 64);
    const int tid = ltid();
    const size_t gp = (size_t)(i * 32 + g) * 64;
    for (int idx = tid; idx < 64 * 33; idx += NTHREADS) {
        const int p = idx / 33, tau = idx % 33;
        const float re = fminf(P.in[I_ARE][gp + p], -1e-4f), im = P.in[I_AIM][gp + p];
        const float st = expf(P.in[I_LSTEP][gp + p]);
        const float mag = expf(re * st * (float)tau);
        const double angd = (double)im * (double)st * (double)tau;
        const double red = angd - 6.283185307179586 * floor(angd * 0.15915494309189535);
        float sn, cs; sincosf((float)red, &sn, &cs);
        pw[idx] = make_float2(mag * cs, mag * sn);
    }
    for (int idx = tid; idx < 64 * 16; idx += NTHREADS) {
        const int p = idx >> 4, c = idx & 15;
        const double re = fmin((double)P.in[I_ARE][gp + p], -1e-4), im = (double)P.in[I_AIM][gp + p];
        const double st = exp((double)P.in[I_LSTEP][gp + p]);
        const double mag = exp(re * st), lr = mag * cos(im * st) - 1.0, li = mag * sin(im * st);
        const double den = re * re + im * im;
        const double fr = (lr * re + li * im) / den, fi = (li * re - lr * im) / den;
        const double br = (double)P.in[I_BRE][(gp + p) * 16 + c], bi = (double)P.in[I_BIM][(gp + p) * 16 + c];
        bb[idx] = make_float2((float)(fr * br - fi * bi), (float)(fr * bi + fi * br));
        const int cc = idx >> 6, pp = idx & 63;
        cm[idx] = make_float2(P.in[I_CRE][((size_t)(i * 32 + g) * 16 + cc) * 64 + pp], P.in[I_CIM][((size_t)(i * 32 + g) * 16 + cc) * 64 + pp]);
    }
    __syncthreads();
    for (int idx = tid; idx < 32 * 256; idx += NTHREADS) {
        const int tau = idx >> 8, c1 = (idx >> 4) & 15, c = idx & 15;
        float s = 0.f;
        for (int p = 0; p < 64; ++p) {
            const float2 a = cm[c1 * 64 + p], w = pw[p * 33 + tau], b = bb[p * 16 + c];
            const float tr = a.x * w.x - a.y * w.y, ti = a.x * w.y + a.y * w.x;
            s += tr * b.x - ti * b.y;
        }
        kt[idx] = s;
    }
    __syncthreads();
    bfr* gt = (bfr*)(P.ws + OFF_S5GT) + (size_t)(i * 32 + g) * 512 * 640;
    for (int idx = tid; idx < 512 * 80; idx += NTHREADS) {
        const int n = idx / 80, ch = idx % 80;
        const int t = n >> 4, c1 = n & 15;
        float v[8];
        if (ch < 64) {
            const int s = ch >> 1, c0 = (ch & 1) * 8;
#pragma unroll
            for (int j = 0; j < 8; ++j) v[j] = (t >= s) ? kt[((t - s) * 16 + c1) * 16 + c0 + j] : 0.f;
        } else {
            const int p0 = (ch - 64) * 4;
#pragma unroll
            for (int j = 0; j < 4; ++j) {
                const float2 a = cm[c1 * 64 + p0 + j], w = pw[(p0 + j) * 33 + t + 1];
                v[2 * j] = a.x * w.x - a.y * w.y;
                v[2 * j + 1] = -(a.x * w.y + a.y * w.x);
            }
        }
        *(uint4*)(gt + (size_t)n * 640 + ch * 8) = pack8(v);
    }
    bfr* bl = (bfr*)(P.ws + OFF_S5BL) + (size_t)(i * 32 + g) * 128 * 512;
    for (int idx = tid; idx < 128 * 64; idx += NTHREADS) {
        const int n = idx >> 6, ch = idx & 63;
        const int p = n >> 1, ri = n & 1, s = ch >> 1, c0 = (ch & 1) * 8;
        const float2 w = pw[p * 33 + 31 - s];
        float v[8];
#pragma unroll
        for (int j = 0; j < 8; ++j) { const float2 b = bb[p * 16 + c0 + j]; v[j] = ri ? (w.x * b.y + w.y * b.x) : (w.x * b.x - w.y * b.y); }
        *(uint4*)(bl + (size_t)n * 512 + ch * 8) = pack8(v);
    }
    float* l32 = (float*)(P.ws + OFF_S5L32) + (size_t)(i * 32 + g) * 128;
    if (tid < 64) { l32[2 * tid] = pw[tid * 33 + 32].x; l32[2 * tid + 1] = pw[tid * 33 + 32].y; }
    __syncthreads();
}

DI void norm_rows(const float* __restrict__ x, const float* __restrict__ g, bfr* __restrict__ hb, bfr* __restrict__ hlo, float* __restrict__ xcopy, int tok0, int ntok) {
    const int tid_ = ltid();
    const int lane = tid_ & 63, wave = tid_ >> 6;
    for (int tk = wave; tk < ntok; tk += 4) {
        const size_t tok = (size_t)(tok0 + tk);
        float4 v[4];
        float ss = 0.f;
#pragma unroll
        for (int i = 0; i < 4; ++i) {
            v[i] = *(const float4*)(x + tok * DM + i * 256 + lane * 4);
            ss += v[i].x * v[i].x + v[i].y * v[i].y + v[i].z * v[i].z + v[i].w * v[i].w;
        }
        ss = wave_sum(ss);
        const float rs = rsqrtf(ss * (1.0f / DM) + 1e-6f);
#pragma unroll
        for (int i = 0; i < 4; ++i) {
            const float4 gg = *(const float4*)(g + i * 256 + lane * 4);
            const float h0 = v[i].x * rs * gg.x, h1 = v[i].y * rs * gg.y, h2 = v[i].z * rs * gg.z, h3 = v[i].w * rs * gg.w;
            const unsigned p0 = pk2(h0, h1), p1 = pk2(h2, h3);
            *(uint2*)(hb + tok * DM + i * 256 + lane * 4) = make_uint2(p0, p1);
            if (hlo) {
                const unsigned q0 = pk2(h0 - bflo(p0), h1 - bfhi(p0)), q1 = pk2(h2 - bflo(p1), h3 - bfhi(p1));
                *(uint2*)(hlo + tok * DM + i * 256 + lane * 4) = make_uint2(q0, q1);
            }
            if (xcopy) *(float4*)(xcopy + tok * DM + i * 256 + lane * 4) = v[i];
        }
    }
}
DI void phase_e1(char* lds, const Ctx& P, int li) {
    const bfr* hb = (const bfr*)(P.ws + OFF_HB);
    const bfr* w = (const bfr*)(P.ws + OFF_WINE) + (size_t)li * 2304 * 1024;
    bfr* u = (bfr*)(P.ws + OFF_U);
    for (int t = blockIdx.x; t < 256 * 18; t += gridDim.x) {
        int mt, nt; tile_remap(t, 256, 18, mt, nt);
        RowLoader A(hb, mt * 128, 1024), B(w, nt * 128, 1024);
        gemm_tile(lds, 16, A, B, [&](const float* stg) __attribute__((always_inline)) {
            epi_rows8(stg, [&](int r, int c0, const float (&v)[8]) __attribute__((always_inline)) {
                *(uint4*)(u + (size_t)(mt * 128 + r) * EVEN_IN + nt * 128 + c0) = pack8(v);
            });
        });
    }
}

DI void phase_e2a(const Ctx& P, int li) {
    const bfr* u = (const bfr*)(P.ws + OFF_U);
    const float* mu = P.in[I_MU] + (size_t)li * 1792;
    bfr* S = (bfr*)(P.ws + OFF_S);
    bfr* mv = (bfr*)(P.ws + (li == 0 ? OFF_VFIRST : OFF_MV2));
    bfr* dpool = (bfr*)(P.ws + OFF_DPOOL);
    const int total = NTOK * 160;
    for (int idx = blockIdx.x * NTHREADS + ltid(); idx < total; idx += gridDim.x * NTHREADS) {
        const int tok = idx / 160, ch = idx % 160;
        const int col = 1024 + ch * 8;
        const int t = tok & (SEQ - 1);
        const bfr* row = u + (size_t)tok * EVEN_IN;
        float cur[8];
        unpack8(*(const uint4*)(row + col), cur);
        if (col < 1792) {
            float prv[8], m[8];
            if (t > 0) unpack8(*(const uint4*)(row - EVEN_IN + col), prv);
            else {
#pragma unroll
                for (int j = 0; j < 8; ++j) prv[j] = 0.f;
            }
            const float4 m0 = *(const float4*)(mu + col), m1 = *(const float4*)(mu + col + 4);
            const float mm[8] = {m0.x, m0.y, m0.z, m0.w, m1.x, m1.y, m1.z, m1.w};
#pragma unroll
            for (int j = 0; j < 8; ++j) m[j] = cur[j] + (prv[j] - cur[j]) * mm[j];
            if (col < 1536) {
                *(uint4*)(mv + (size_t)tok * 512 + (col - 1024)) = pack8(m);
            } else if (col < 1600) {
#pragma unroll
                for (int j = 0; j < 8; ++j) m[j] = ftanh(m[j]);
                *(uint4*)(S + (size_t)tok * 256 + (col - 1536)) = pack8(m);
            } else if (col < 1664) {
                *(uint4*)(S + (size_t)tok * 256 + 64 + (col - 1600)) = pack8(m);
            } else {
#pragma unroll
                for (int j = 0; j < 8; ++j) m[j] = sigmoidf_(m[j]);
                *(uint4*)(S + (size_t)tok * 256 + 128 + (col - 1664)) = pack8(m);
            }
        } else {
            const int gi = (col - 1792) >> 7;
            const int win = 2 << gi;
            const int nw = (t + 1 < win) ? (t + 1) : win;
            float acc[8];
#pragma unroll
            for (int j = 0; j < 8; ++j) acc[j] = cur[j];
#define POOL_WIN(W) { uint4 pv[W - 1]; _Pragma("unroll") for (int s = 1; s < W; ++s) pv[s - 1] = *(const uint4*)(row - (size_t)(s < nw ? s : 0) * EVEN_IN + col); \
                      _Pragma("unroll") for (int s = 1; s < W; ++s) { float pq[8]; unpack8(pv[s - 1], pq); const float wgt = s < nw ? 1.f : 0.f; \
                          _Pragma("unroll") for (int j = 0; j < 8; ++j) acc[j] += wgt * pq[j]; } }
            if (gi == 0) POOL_WIN(2) else if (gi == 1) POOL_WIN(4) else if (gi == 2) POOL_WIN(8) else POOL_WIN(16)
#undef POOL_WIN
            const float inv = frcp((float)nw);
#pragma unroll
            for (int j = 0; j < 8; ++j) acc[j] = acc[j] * inv - cur[j];
            *(uint4*)(dpool + (size_t)tok * 512 + (col - 1792)) = pack8(acc);
        }
    }
}

DI void phase_e2b(char* lds, const Ctx& P, int li) {
    const bfr* S = (const bfr*)(P.ws + OFF_S);
    const int njobs = (li == 1) ? 20 : 16;
    for (int t = blockIdx.x; t < 256 * njobs; t += gridDim.x) {
        const int mt = t / njobs, j = t % njobs;
        const int job = j >> 2, nt = j & 3;
        const int m0 = mt * 128;
        if (job == 0) {
            RowLoader A(S, m0, 256), B((const bfr*)(P.ws + OFF_W2T) + (size_t)li * 512 * 64, nt * 128, 64);
            const float* w0 = P.in[I_W0] + li * 512;
            float* dlog = (float*)(P.ws + OFF_DLOG);
            gemm_tile(lds, 1, A, B, [&](const float* stg) __attribute__((always_inline)) {
                epi_rows8(stg, [&](int r, int c0, const float (&v)[8]) __attribute__((always_inline)) {
                    float o[8];
#pragma unroll
                    for (int q = 0; q < 8; ++q) {
                        const float z = -(w0[nt * 128 + c0 + q] + v[q]);
                        o[q] = -fexp(-fsoftplus(z) - 0.5f);
                    }
                    float* d = dlog + (size_t)(m0 + r) * 512 + nt * 128 + c0;
                    *(float4*)d = make_float4(o[0], o[1], o[2], o[3]); *(float4*)(d + 4) = make_float4(o[4], o[5], o[6], o[7]);
                });
            });
        } else if (job == 1) {
            RowLoader A(S + 64, m0, 256), B((const bfr*)(P.ws + OFF_A2T) + (size_t)li * 512 * 64, nt * 128, 64);
            const float* a0 = P.in[I_A0] + li * 512;
            bfr* ab = (bfr*)(P.ws + OFF_ABUF);
            gemm_tile(lds, 1, A, B, [&](const float* stg) __attribute__((always_inline)) {
                epi_rows8(stg, [&](int r, int c0, const float (&v)[8]) __attribute__((always_inline)) {
                    float o[8];
#pragma unroll
                    for (int q = 0; q < 8; ++q) o[q] = sigmoidf_(a0[nt * 128 + c0 + q] + v[q]);
                    *(uint4*)(ab + (size_t)(m0 + r) * 512 + nt * 128 + c0) = pack8(o);
                });
            });
        } else if (job == 2) {
            RowLoader A(S + 128, m0, 256), B((const bfr*)(P.ws + OFF_G2T) + (size_t)li * 512 * 128, nt * 128, 128);
            bfr* gb = (bfr*)(P.ws + OFF_GBUF);
            gemm_tile(lds, 2, A, B, [&](const float* stg) __attribute__((always_inline)) {
                epi_rows8(stg, [&](int r, int c0, const float (&v)[8]) __attribute__((always_inline)) {
                    *(uint4*)(gb + (size_t)(m0 + r) * 512 + nt * 128 + c0) = pack8(v);
                });
            });
        } else if (job == 3) {
            RowLoader A((const bfr*)(P.ws + OFF_DPOOL) + nt * 128, m0, 512), B((const bfr*)(P.ws + OFF_POOLT) + (size_t)(li * 4 + nt) * 128 * 128, 0, 128);
            const float* ps = P.in[I_POOLS] + li * 512 + nt * 128;
            bfr* am = (bfr*)(P.ws + OFF_AMIX);
            gemm_tile(lds, 2, A, B, [&](const float* stg) __attribute__((always_inline)) {
                epi_rows8(stg, [&](int r, int c0, const float (&v)[8]) __attribute__((always_inline)) {
                    float o[8];
#pragma unroll
                    for (int q = 0; q < 8; ++q) o[q] = v[q] * ps[c0 + q];
                    *(uint4*)(am + (size_t)(m0 + r) * 1024 + 512 + nt * 128 + c0) = pack8(o);
                });
            });
        } else {
            RowLoader A((const bfr*)(P.ws + OFF_MV2), m0, 512), B((const bfr*)(P.ws + OFF_V12T), nt * 128, 512);
            const float* v0 = P.in[I_V0];
            bfr* vg = (bfr*)(P.ws + OFF_VGATE);
            gemm_tile(lds, 8, A, B, [&](const float* stg) __attribute__((always_inline)) {
                epi_rows8(stg, [&](int r, int c0, const float (&v)[8]) __attribute__((always_inline)) {
                    float o[8];
#pragma unroll
                    for (int q = 0; q < 8; ++q) o[q] = sigmoidf_(v0[nt * 128 + c0 + q] + v[q]);
                    *(uint4*)(vg + (size_t)(m0 + r) * 512 + nt * 128 + c0) = pack8(o);
                });
            });
        }
    }
}

constexpr int RW_TC = 16;
constexpr int RW_BUF = (5 * RW_TC * 64 + RW_TC * 16 + RW_TC * 16) * 4;
DI void phase_e3(char* lds, const Ctx& P, int li, int probe = 0) {
    const bfr* u = (const bfr*)(P.ws + OFF_U);
    const float* mu = P.in[I_MU] + (size_t)li * 1792;
    const float* dlog = (const float*)(P.ws + OFF_DLOG);
    const bfr* ab = (const bfr*)(P.ws + OFF_ABUF);
    const bfr* vg = (const bfr*)(P.ws + OFF_VGATE);
    const bfr* vf = (const bfr*)(P.ws + OFF_VFIRST);
    float* yout = (float*)(P.ws + (probe ? OFF_HID : OFF_Y));
    float* bonus = (float*)(P.ws + (probe ? OFF_HID : OFF_BONUS));
    const int tid = ltid(), lane = tid & 63, wave = tid >> 6;
    const int pstep = tid >> 4, pc0 = (tid & 15) * 4;
    for (int item = blockIdx.x; item < 512; item += gridDim.x) {
        const int bh = item >> 2, qtr = item & 3;
        const int b = bh >> 3, h = bh & 7;
        const int i0 = qtr * 16;
        float c_mur[4], c_muk[4], c_muv[4], c_kk[4], c_ka[4], c_rk[4];
#pragma unroll
        for (int j = 0; j < 4; ++j) {
            const int c = h * 64 + pc0 + j;
            c_mur[j] = mu[c]; c_muk[j] = mu[512 + c]; c_muv[j] = mu[1024 + c];
            c_kk[j] = P.in[I_KK][li * 512 + c]; c_ka[j] = P.in[I_KA][li * 512 + c]; c_rk[j] = P.in[I_RK][li * 512 + c];
        }
        float S0 = 0.f, S1 = 0.f, S2 = 0.f, S3 = 0.f;
        const int rloc = wave * 4 + (lane >> 4);
        const int j0 = (lane & 15) * 4;
        const bool mine = ((pc0 >> 4) == qtr);
        uint2 g_ur, g_uk, g_uv, g_pr, g_pk, g_pv, g_a, g_vg, g_vf; float4 g_d;
#define E3_GLOAD(c_) do { const int t_ = (c_) * RW_TC + pstep; const size_t tok_ = (size_t)b * SEQ + t_; \
            const bfr* row_ = u + tok_ * EVEN_IN + h * 64 + pc0; const bfr* prow_ = row_ - (t_ > 0 ? EVEN_IN : 0); \
            g_ur = *(const uint2*)(row_); g_uk = *(const uint2*)(row_ + 512); g_uv = *(const uint2*)(row_ + 1024); \
            g_pr = *(const uint2*)(prow_); g_pk = *(const uint2*)(prow_ + 512); g_pv = *(const uint2*)(prow_ + 1024); \
            const size_t o_ = tok_ * 512 + h * 64 + pc0; \
            g_a = *(const uint2*)(ab + o_); g_d = *(const float4*)(dlog + o_); \
            if (li == 1) { g_vg = *(const uint2*)(vg + o_); g_vf = *(const uint2*)(vf + o_); } } while (0)
#define E3_PREP(c_, buf_) do { const int t_ = (c_) * RW_TC + pstep; const size_t o_ = ((size_t)b * SEQ + t_) * 512 + h * 64 + pc0; \
            float* sw_ = (float*)(lds + (buf_) * RW_BUF); float* sa_ = sw_ + RW_TC * 64; float* sb_ = sa_ + RW_TC * 64; float* sk_ = sb_ + RW_TC * 64; \
            float* sr_ = sk_ + RW_TC * 64; float* sv_ = sr_ + RW_TC * 64; \
            const float pz_ = t_ > 0 ? 1.f : 0.f; \
            const float ur_[4] = {bflo(g_ur.x), bfhi(g_ur.x), bflo(g_ur.y), bfhi(g_ur.y)}, uk_[4] = {bflo(g_uk.x), bfhi(g_uk.x), bflo(g_uk.y), bfhi(g_uk.y)}; \
            const float uv_[4] = {bflo(g_uv.x), bfhi(g_uv.x), bflo(g_uv.y), bfhi(g_uv.y)}; \
            const float pr_[4] = {bflo(g_pr.x), bfhi(g_pr.x), bflo(g_pr.y), bfhi(g_pr.y)}, pk_[4] = {bflo(g_pk.x), bfhi(g_pk.x), bflo(g_pk.y), bfhi(g_pk.y)}; \
            const float pv_[4] = {bflo(g_pv.x), bfhi(g_pv.x), bflo(g_pv.y), bfhi(g_pv.y)}; \
            const float av_[4] = {bflo(g_a.x), bfhi(g_a.x), bflo(g_a.y), bfhi(g_a.y)}; \
            const float dl_[4] = {g_d.x, g_d.y, g_d.z, g_d.w}; \
            float gv_[4] = {0.f, 0.f, 0.f, 0.f}, fv_[4] = {0.f, 0.f, 0.f, 0.f}; \
            if (li == 1) { gv_[0] = bflo(g_vg.x); gv_[1] = bfhi(g_vg.x); gv_[2] = bflo(g_vg.y); gv_[3] = bfhi(g_vg.y); \
                           fv_[0] = bflo(g_vf.x); fv_[1] = bfhi(g_vf.x); fv_[2] = bflo(g_vf.y); fv_[3] = bfhi(g_vf.y); } \
            float kkr_[4], kmod_[4], rr_[4], vv_[4]; float ssq_ = 0.f, bsum_ = 0.f; \
            _Pragma("unroll") for (int j = 0; j < 4; ++j) { \
                rr_[j] = ur_[j] + (pz_ * pr_[j] - ur_[j]) * c_mur[j]; \
                const float k_ = uk_[j] + (pz_ * pk_[j] - uk_[j]) * c_muk[j]; \
                float v_ = uv_[j] + (pz_ * pv_[j] - uv_[j]) * c_muv[j]; \
                if (li == 1) v_ = v_ + (fv_[j] - v_) * gv_[j]; \
                vv_[j] = v_; kkr_[j] = k_ * c_kk[j]; ssq_ += kkr_[j] * kkr_[j]; \
                kmod_[j] = k_ * (1.0f + (av_[j] - 1.0f) * c_ka[j]); bsum_ += rr_[j] * kmod_[j] * c_rk[j]; } \
            ssq_ = row16_sum(ssq_); bsum_ = row16_sum(bsum_); \
            const float inv_ = frcp(fmaxf(sqrtf(ssq_), 1e-12f)); \
            float4 w4_, a4_, b4_; \
            w4_.x = fexp(dl_[0]); w4_.y = fexp(dl_[1]); w4_.z = fexp(dl_[2]); w4_.w = fexp(dl_[3]); \
            a4_.x = -kkr_[0] * inv_; a4_.y = -kkr_[1] * inv_; a4_.z = -kkr_[2] * inv_; a4_.w = -kkr_[3] * inv_; \
            b4_.x = -a4_.x * av_[0]; b4_.y = -a4_.y * av_[1]; b4_.z = -a4_.z * av_[2]; b4_.w = -a4_.w * av_[3]; \
            *(float4*)(sw_ + pstep * 64 + pc0) = w4_; *(float4*)(sa_ + pstep * 64 + pc0) = a4_; *(float4*)(sb_ + pstep * 64 + pc0) = b4_; \
            *(float4*)(sk_ + pstep * 64 + pc0) = make_float4(kmod_[0], kmod_[1], kmod_[2], kmod_[3]); \
            *(float4*)(sr_ + pstep * 64 + pc0) = make_float4(rr_[0], rr_[1], rr_[2], rr_[3]); \
            if (mine) { *(float4*)(sv_ + pstep * 16 + (pc0 & 15)) = make_float4(vv_[0], vv_[1], vv_[2], vv_[3]); \
                        *(float4*)(bonus + o_) = make_float4(bsum_ * vv_[0], bsum_ * vv_[1], bsum_ * vv_[2], bsum_ * vv_[3]); } } while (0)
        __syncthreads();
        E3_GLOAD(0);
        E3_PREP(0, 0);
        __syncthreads();
        constexpr int NCH = SEQ / RW_TC;
#pragma unroll 1
        for (int c = 0; c < NCH; ++c) {
            const int buf = c & 1;
            if (c + 1 < NCH && probe != 2) E3_GLOAD(c + 1);
            if (probe != 1) {
                const float* s_w = (const float*)(lds + buf * RW_BUF); const float* s_a = s_w + RW_TC * 64; const float* s_b = s_a + RW_TC * 64;
                const float* s_k = s_b + RW_TC * 64; const float* s_r = s_k + RW_TC * 64; const float* s_v = s_r + RW_TC * 64;
                float* s_y = (float*)(s_v + RW_TC * 16);
                float4 na4 = *(const float4*)(s_a + j0), nw4 = *(const float4*)(s_w + j0), nb4 = *(const float4*)(s_b + j0);
                float4 nk4 = *(const float4*)(s_k + j0), nr4 = *(const float4*)(s_r + j0);
                float nvi = s_v[rloc];
#pragma unroll 1
                for (int sg = 0; sg < RW_TC; sg += 4) {
                    float yv[4];
#pragma unroll
                    for (int q = 0; q < 4; ++q) {
                        const int sn = (sg + q + 1) & (RW_TC - 1);
                        const float4 a4 = na4, w4 = nw4, b4 = nb4, k4 = nk4, r4 = nr4; const float vi = nvi;
                        na4 = *(const float4*)(s_a + sn * 64 + j0); nw4 = *(const float4*)(s_w + sn * 64 + j0); nb4 = *(const float4*)(s_b + sn * 64 + j0);
                        nk4 = *(const float4*)(s_k + sn * 64 + j0); nr4 = *(const float4*)(s_r + sn * 64 + j0); nvi = s_v[sn * 16 + rloc];
                        float sa = dot4n(S0, S1, S2, S3, a4);
                        sa = row16_sum(sa);
                        rw_upd(S0, w4.x, sa, b4.x, vi, k4.x);
                        rw_upd(S1, w4.y, sa, b4.y, vi, k4.y);
                        rw_upd(S2, w4.z, sa, b4.z, vi, k4.z);
                        rw_upd(S3, w4.w, sa, b4.w, vi, k4.w);
                        const float y = dot4n(S0, S1, S2, S3, r4);
                        yv[q] = row16_sum(y);
                    }
                    const int ls = lane & 3;
                    const float yo = ls == 0 ? yv[0] : (ls == 1 ? yv[1] : (ls == 2 ? yv[2] : yv[3]));
                    if ((lane & 15) < 4) s_y[(sg + ls) * 16 + rloc] = yo;
                }
            }
            if (c + 1 < NCH && probe != 2) E3_PREP(c + 1, buf ^ 1);
            __syncthreads();
            {
                const float* s_y = (const float*)(lds + buf * RW_BUF) + 5 * RW_TC * 64 + RW_TC * 16;
                const int s = tid >> 4, r = tid & 15;
                yout[((size_t)b * SEQ + c * RW_TC + s) * 512 + h * 64 + i0 + r] = s_y[tid];
            }
        }
#undef E3_GLOAD
#undef E3_PREP
    }
}

DI void phase_e4(const Ctx& P, int li) {
    const float* y = (const float*)(P.ws + OFF_Y);
    const float* bonus = (const float*)(P.ws + OFF_BONUS);
    const bfr* gb = (const bfr*)(P.ws + OFF_GBUF);
    const float* lng = P.in[I_LNG] + li * 512;
    const float* lnb = P.in[I_LNB] + li * 512;
    bfr* am = (bfr*)(P.ws + OFF_AMIX);
    const int total = NTOK * 64;
    for (int idx = blockIdx.x * NTHREADS + ltid(); idx < total; idx += gridDim.x * NTHREADS) {
        const int tok = idx >> 6, c = (idx & 63) * 8;
        const size_t o = (size_t)tok * 512 + c;
        const float4 y0 = *(const float4*)(y + o), y1 = *(const float4*)(y + o + 4);
        float v[8] = {y0.x, y0.y, y0.z, y0.w, y1.x, y1.y, y1.z, y1.w};
        float s = 0.f;
#pragma unroll
        for (int j = 0; j < 8; ++j) s += v[j];
        s += __shfl_xor(s, 1); s += __shfl_xor(s, 2); s += __shfl_xor(s, 4);
        const float mean = s * (1.0f / 64.0f);
        float q = 0.f;
#pragma unroll
        for (int j = 0; j < 8; ++j) { v[j] -= mean; q += v[j] * v[j]; }
        q += __shfl_xor(q, 1); q += __shfl_xor(q, 2); q += __shfl_xor(q, 4);
        const float rstd = rsqrtf(q * (1.0f / 64.0f) + 64e-5f);
        const float4 b0 = *(const float4*)(bonus + o), b1 = *(const float4*)(bonus + o + 4);
        const float bo[8] = {b0.x, b0.y, b0.z, b0.w, b1.x, b1.y, b1.z, b1.w};
        float gv[8];
        unpack8(*(const uint4*)(gb + o), gv);
        float out[8];
#pragma unroll
        for (int j = 0; j < 8; ++j) out[j] = (v[j] * rstd * lng[c + j] + lnb[c + j] + bo[j]) * gv[j];
        *(uint4*)(am + (size_t)tok * 1024 + c) = pack8(out);
    }
}

DI void phase_wout(char* lds, const Ctx& P, const bfr* w, float* x) {
    const bfr* am = (const bfr*)(P.ws + OFF_AMIX);
    for (int t = blockIdx.x; t < 256 * 4; t += gridDim.x) {
        int mt, nt; tile_remap(t, 256, 4, mt, nt);
        RowLoader2 A(am, mt * 128, 1024), B(w, nt * 256, 1024);
        gemm_tile256(lds, 32, A, B, [&](const float* stg, int p) __attribute__((always_inline)) {
            epi2_rows8_pre<F8>(stg, p,
                [&](int r, int c0) __attribute__((always_inline)) -> F8 {
                    const float* d = x + (size_t)(mt * 128 + r) * DM + nt * 256 + c0;
                    F8 o; o.a = *(const float4*)d; o.b = *(const float4*)(d + 4); return o; },
                [&](int r, int c0, const float (&v)[8], const F8& o) __attribute__((always_inline)) {
                    float* d = x + (size_t)(mt * 128 + r) * DM + nt * 256 + c0;
                    *(float4*)d = make_float4(o.a.x + v[0], o.a.y + v[1], o.a.z + v[2], o.a.w + v[3]);
                    *(float4*)(d + 4) = make_float4(o.b.x + v[4], o.b.y + v[5], o.b.z + v[6], o.b.w + v[7]);
                });
        });
    }
}
DI void phase_o1(char* lds, const Ctx& P, int li) {
    const bfr* hb = (const bfr*)(P.ws + OFF_HB);
    const bfr* w = (const bfr*)(P.ws + OFF_WINO) + (size_t)li * 2048 * 1024;
    bfr* qk = (bfr*)(P.ws + OFF_U);
    bfr* vT = (bfr*)(P.ws + OFF_VT);
    bfr* us5 = (bfr*)(P.ws + OFF_US5);
    for (int t = blockIdx.x; t < 256 * 8; t += gridDim.x) {
        int mt, nt; tile_remap(t, 256, 8, mt, nt);
        const int m0 = mt * 128;
        RowLoader2 A(hb, m0, 1024), B(w, nt * 256, 1024);
        gemm_tile256(lds, 32, A, B, [&](const float* stg, int p) __attribute__((always_inline)) {
            if (nt < 4) {
                epi2_rows8(stg, p, [&](int r, int gc, const float (&v)[8]) __attribute__((always_inline)) {
                    *(uint4*)(qk + (size_t)(m0 + r) * 1024 + nt * 256 + gc) = pack8(v);
                });
            } else if (nt < 6) {
                const int b = m0 >> 11, tq = m0 & (SEQ - 1);
                const int tid0 = ltid();
#pragma unroll
                for (int it = 0; it < 8; ++it) {
                    const int idx = it * NTHREADS + tid0;
                    const int cs = idx & 127, rg = idx >> 7;
                    const int vc = (nt - 4) * 256 + g2_col(cs, p);
                    float v[8];
#pragma unroll
                    for (int j = 0; j < 8; ++j) v[j] = stg[(rg * 8 + j) * STG_LD + cs];
                    *(uint4*)(vT + ((size_t)(b * 4 + (vc >> 7)) * 128 + (vc & 127)) * SEQ + tq + rg * 8) = pack8(v);
                }
            } else {
                epi2_rows8(stg, p, [&](int r, int gc, const float (&v)[8]) __attribute__((always_inline)) {
                    const int cc = (nt - 6) * 256 + gc;
                    *(uint4*)(us5 + ((size_t)(cc >> 4) * NTOK + m0 + r) * 16 + (cc & 15)) = pack8(v);
                });
            }
        });
    }
}

DI void phase_o2(char* lds, const Ctx& P, int li) {
    const bfr* qk = (const bfr*)(P.ws + OFF_U);
    bfr* qn = (bfr*)(P.ws + OFF_QN);
    bfr* kn = (bfr*)(P.ws + OFF_KN);
    const float* gq = P.in[I_QN] + li * 64;
    const float* gk = P.in[I_KN] + li * 64;
    const bfr* us5 = (const bfr*)(P.ws + OFF_US5);
    const bfr* bl = (const bfr*)(P.ws + OFF_S5BL) + (size_t)li * 32 * 128 * 512;
    float* xloc = (float*)(P.ws + OFF_XLOC);
    for (int t = blockIdx.x; t < 256; t += gridDim.x) {
        const int g = t >> 3, mt = t & 7;
        RowLoader A(us5 + (size_t)g * NTOK * 16, mt * 128, 512), B(bl + (size_t)g * 128 * 512, 0, 512);
        gemm_tile(lds, 8, A, B, [&](const float* stg) __attribute__((always_inline)) {
            epi_rows8(stg, [&](int r, int c0, const float (&v)[8]) __attribute__((always_inline)) {
                float* d = xloc + ((size_t)g * 1024 + mt * 128 + r) * 128 + c0;
                *(float4*)d = make_float4(v[0], v[1], v[2], v[3]); *(float4*)(d + 4) = make_float4(v[4], v[5], v[6], v[7]);
            });
        });
    }
    const int total = NTOK * 16 * 8;
    for (int idx = blockIdx.x * NTHREADS + ltid(); idx < total; idx += gridDim.x * NTHREADS) {
        const int l8 = idx & 7, item = idx >> 3;
        const int hm = item & 7, which = (item >> 3) & 1, tok = item >> 4;
        const int d0 = l8 * 4;
        const bfr* src = qk + (size_t)tok * 1024 + which * 512 + hm * 64;
        const uint2 ua = *(const uint2*)(src + d0), ub = *(const uint2*)(src + 32 + d0);
        float x1[4] = {bflo(ua.x), bfhi(ua.x), bflo(ua.y), bfhi(ua.y)};
        float x2[4] = {bflo(ub.x), bfhi(ub.x), bflo(ub.y), bfhi(ub.y)};
        float ss = 0.f;
#pragma unroll
        for (int j = 0; j < 4; ++j) ss += x1[j] * x1[j] + x2[j] * x2[j];
        ss += __shfl_xor(ss, 1); ss += __shfl_xor(ss, 2); ss += __shfl_xor(ss, 4);
        const float rs = rsqrtf(ss * (1.0f / 64.0f) + 1e-6f);
        const float* gg = which ? gk : gq;
        const float scl = which ? 1.0f : (0.125f * 1.4426950408889634f);
        const int t = tok & (SEQ - 1);
        float o1[4], o2[4];
#pragma unroll
        for (int j = 0; j < 4; ++j) {
            const int i = d0 + j;
            const float invf = exp2f(-(float)i * (13.287712379549449f / 32.0f));
            const float ang = (float)t * invf;
            float sn, cs;
            sincosf(ang, &sn, &cs);
            const float a = x1[j] * rs * gg[i], b2 = x2[j] * rs * gg[32 + i];
            o1[j] = (a * cs - b2 * sn) * scl;
            o2[j] = (b2 * cs + a * sn) * scl;
        }
        bfr* dst = (which ? kn : qn) + (size_t)tok * 512 + hm * 64;
        *(uint2*)(dst + d0) = make_uint2(pk2(o1[0], o1[1]), pk2(o1[2], o1[3]));
        *(uint2*)(dst + 32 + d0) = make_uint2(pk2(o2[0], o2[1]), pk2(o2[2], o2[3]));
    }
}

DI void s5_scan(const Ctx& P, int li) {
    const float* xloc = (const float*)(P.ws + OFF_XLOC);
    bfr* xin = (bfr*)(P.ws + OFF_XIN);
    const float* l32 = (const float*)(P.ws + OFF_S5L32) + (size_t)li * 32 * 128;
    for (int idx = blockIdx.x * NTHREADS + ltid(); idx < 32 * 16 * 64; idx += gridDim.x * NTHREADS) {
        const int p = idx & 63, b = (idx >> 6) & 15, g = idx >> 10;
        const float lr = l32[g * 128 + 2 * p], lim = l32[g * 128 + 2 * p + 1];
        float xr = 0.f, xi = 0.f;
        for (int ch = 0; ch < 64; ++ch) {
            const size_t o = ((size_t)g * 1024 + b * 64 + ch) * 128 + 2 * p;
            *(unsigned*)(xin + o) = pk2(xr, xi);
            const float2 a = *(const float2*)(xloc + o);
            const float nr = lr * xr - lim * xi + a.x, ni = lr * xi + lim * xr + a.y;
            xr = nr; xi = ni;
        }
    }
}

DI void attn_item(char* lds, const Ctx& P, int b, int h, int qt, float lam, float lam_init, const float* subln) {
    const bfr* qn = (const bfr*)(P.ws + OFF_QN);
    const bfr* kn = (const bfr*)(P.ws + OFF_KN);
    const bfr* vT = (const bfr*)(P.ws + OFF_VT) + (size_t)(b * 4 + h) * 128 * SEQ;
    bfr* am = (bfr*)(P.ws + OFF_AMIX);
    const int tid = ltid(), lane = tid & 63, wave = tid >> 6;
    const int m = wave >> 1, qw = (wave & 1) * 32;
    const int q0 = qt * 64 + qw;
    const int ln = lane & 31, hf = lane >> 5;
    bf16x8 qf[4];
    {
        const bfr* qp = qn + ((size_t)b * SEQ + q0 + ln) * 512 + h * 128 + m * 64 + hf * 8;
#pragma unroll
        for (int ks = 0; ks < 4; ++ks) qf[ks] = *(const bf16x8*)(qp + ks * 16);
    }
    f32x16 o[4];
#pragma unroll
    for (int d = 0; d < 4; ++d)
#pragma unroll
        for (int r = 0; r < 16; ++r) o[d][r] = 0.f;
    float mrun = -INFINITY, lrun = 0.f;
    const int nkt = qt + 1;
    const int lrow = tid >> 3, lcol = (tid & 7) * 8;
    const bfr* kbase = kn + ((size_t)b * SEQ) * 512 + h * 128;
    unsigned ko = (unsigned)(lrow * 512 + lcol) * 2u, vo = (unsigned)(lrow * SEQ + lcol) * 2u;
    asm volatile("" : "+v"(ko), "+v"(vo));
    uint4 rk0, rk1, rk2, rk3, rv0, rv1, rv2, rv3;
#define ATT_GLOAD(kt_) do { const char* kp_ = (const char*)(kbase + (size_t)(kt_) * (64 * 512)); const char* vp_ = (const char*)(vT + (kt_) * 64); \
        rk0 = *(const uint4*)(kp_ + ko); rk1 = *(const uint4*)(kp_ + 32 * 512 * 2 + ko); rk2 = *(const uint4*)(kp_ + 64 * 2 + ko); rk3 = *(const uint4*)(kp_ + 32 * 512 * 2 + 64 * 2 + ko); \
        rv0 = *(const uint4*)(vp_ + vo); rv1 = *(const uint4*)(vp_ + 32 * SEQ * 2 + vo); rv2 = *(const uint4*)(vp_ + 64 * SEQ * 2 + vo); rv3 = *(const uint4*)(vp_ + 96 * SEQ * 2 + vo); } while (0)
#define ATT_S1(base_, i_, RK, RV) { *(uint4*)((base_) + (32 * (i_)) * LDA * 2) = RK; \
        *(uint4*)((base_) + TILE_B + (32 * (i_)) * LDA * 2) = RV; }
#define ATT_LSTORE(buf_) do { char* base_ = lds + (buf_) * (2 * TILE_B) + s_off; ATT_S1(base_, 0, rk0, rv0) ATT_S1(base_, 1, rk1, rv1) ATT_S1(base_, 2, rk2, rv2) ATT_S1(base_, 3, rk3, rv3) } while (0)
    int k_off = ((m * 64 + ln) * LDA + hf * 8) * 2;
    int v_off = TILE_B + (ln * LDA + 4 * hf) * 2;
    int s_off = (lrow * LDA + lcol) * 2;
    asm volatile("" : "+v"(k_off), "+v"(v_off), "+v"(s_off));
    ATT_GLOAD(0); ATT_LSTORE(0);
    __syncthreads();
    int buf = 0;
#pragma unroll 1
    for (int kt = 0; kt < nkt; ++kt) {
        const bool more = (kt + 1 < nkt);
        const char* ks_ = lds + buf * (2 * TILE_B) + k_off;
        const char* vs_ = lds + buf * (2 * TILE_B) + v_off;
        if (kt * 64 <= q0 + 31) {
            f32x16 s[2];
#pragma unroll
            for (int kb = 0; kb < 2; ++kb) {
#pragma unroll
                for (int r = 0; r < 16; ++r) s[kb][r] = 0.f;
#pragma unroll
                for (int ks = 0; ks < 4; ++ks) {
                    const bf16x8 kf = *(const bf16x8*)(ks_ + ((kb * 32) * LDA + ks * 16) * 2);
                    s[kb] = MFMA32(kf, qf[ks], s[kb]);
                }
            }
            const int qpos = q0 + ln;
            if (kt * 64 + 63 > q0) {
#pragma unroll
                for (int kb = 0; kb < 2; ++kb)
#pragma unroll
                    for (int r = 0; r < 16; ++r) {
                        const int key = kt * 64 + kb * 32 + (r & 3) + 8 * (r >> 2) + 4 * hf;
                        if (key > qpos) s[kb][r] = -INFINITY;
                    }
            }
            float mx = s[0][0];
#pragma unroll
            for (int kb = 0; kb < 2; ++kb)
#pragma unroll
                for (int r = 0; r < 16; ++r) mx = fmaxf(mx, s[kb][r]);
            mx = fmaxf(mx, __shfl_xor(mx, 32));
            const float mnew = fmaxf(mrun, mx);
            const float alpha = __builtin_amdgcn_exp2f(mrun - mnew);
            mrun = mnew;
            float rsum = 0.f;
#pragma unroll
            for (int kb = 0; kb < 2; ++kb)
#pragma unroll
                for (int r = 0; r < 16; ++r) { const float p = __builtin_amdgcn_exp2f(s[kb][r] - mnew); s[kb][r] = p; rsum += p; }
            lrun = lrun * alpha + rsum;
#pragma unroll
            for (int d = 0; d < 4; ++d)
#pragma unroll
                for (int r = 0; r < 16; ++r) o[d][r] *= alpha;
            __builtin_amdgcn_sched_barrier(0);
            if (more) ATT_GLOAD(kt + 1);
#pragma unroll
            for (int kb = 0; kb < 2; ++kb)
#pragma unroll
                for (int st = 0; st < 2; ++st) {
                    const uint4 pp = make_uint4(pk2(s[kb][8 * st + 0], s[kb][8 * st + 1]), pk2(s[kb][8 * st + 2], s[kb][8 * st + 3]),
                                                pk2(s[kb][8 * st + 4], s[kb][8 * st + 5]), pk2(s[kb][8 * st + 6], s[kb][8 * st + 7]));
                    const bf16x8 pf = __builtin_bit_cast(bf16x8, pp);
                    const int kc = kb * 32 + 16 * st;
#pragma unroll
                    for (int d = 0; d < 4; ++d) {
                        const uint2 v0 = *(const uint2*)(vs_ + ((d * 32) * LDA + kc) * 2);
                        const uint2 v1 = *(const uint2*)(vs_ + ((d * 32) * LDA + kc + 8) * 2);
                        const bf16x8 vf = __builtin_bit_cast(bf16x8, make_uint4(v0.x, v0.y, v1.x, v1.y));
                        o[d] = MFMA32(vf, pf, o[d]);
                    }
                }
        }
        else if (more) ATT_GLOAD(kt + 1);
        if (more) ATT_LSTORE(buf ^ 1);
        __syncthreads();
        buf ^= 1;
    }
    const float ltot = lrun + __shfl_xor(lrun, 32);
    const float linv = 1.0f / ltot;
    float* ob = (float*)lds;
    int o_off = (m * 64 + qw + ln) * 129 + 4 * hf;
    asm volatile("" : "+v"(o_off));
#pragma unroll
    for (int d = 0; d < 4; ++d)
#pragma unroll
        for (int r = 0; r < 16; ++r) ob[o_off + d * 32 + (r & 3) + 8 * (r >> 2)] = o[d][r] * linv;
    __syncthreads();
#pragma unroll
    for (int it = 0; it < 4; ++it) {
        const int idx = it * NTHREADS + tid;
        const int q = idx >> 4, c0 = (idx & 15) * 8;
        float v[8];
        float ss = 0.f;
        int r_off = q * 129 + c0;
        asm volatile("" : "+v"(r_off));
#pragma unroll
        for (int j = 0; j < 8; ++j) { v[j] = ob[r_off + j] - lam * ob[r_off + 64 * 129 + j]; ss += v[j] * v[j]; }
        ss = row16_sum(ss);
        const float rs = rsqrtf(ss * (1.0f / 128.0f) + 1e-5f) * (1.0f - lam_init);
#pragma unroll
        for (int j = 0; j < 8; ++j) v[j] = v[j] * rs * subln[c0 + j];
        *(uint4*)(am + ((size_t)b * SEQ + qt * 64 + q) * 1024 + h * 128 + c0) = pack8(v);
    }
    __syncthreads();
}

DI void phase_o3(char* lds, const Ctx& P, int li, int layer) {
    s5_scan(P, li);
    float lam;
    {
        const int j = ltid() & 63;
        const float s1 = wave_sum(P.in[I_LQ1][li * 64 + j] * P.in[I_LK1][li * 64 + j]);
        const float s2 = wave_sum(P.in[I_LQ2][li * 64 + j] * P.in[I_LK2][li * 64 + j]);
        const float lam_init0 = 0.8f - 0.6f * __expf(-0.3f * (float)layer);
        lam = __expf(s1) - __expf(s2) + lam_init0;
    }
    const float lam_init = 0.8f - 0.6f * __expf(-0.3f * (float)layer);
    const float* subln = P.in[I_SUBLN] + li * 128;
    for (int item = blockIdx.x; item < 1024; item += gridDim.x) {
        const int bh = item >> 4, pr = item & 15;
        for (int half = 0; half < 2; ++half) attn_item(lds, P, bh >> 2, bh & 3, half ? 31 - pr : pr, lam, lam_init, subln);
    }
}

DI void phase_o4(char* lds, const Ctx& P, int li) {
    const bfr* us5 = (const bfr*)(P.ws + OFF_US5);
    const bfr* xin = (const bfr*)(P.ws + OFF_XIN);
    const bfr* gt = (const bfr*)(P.ws + OFF_S5GT) + (size_t)li * 32 * 512 * 640;
    const float* dsk = P.in[I_S5D] + li * 512;
    bfr* zb = (bfr*)(P.ws + OFF_ZBUF);
    for (int t = blockIdx.x; t < 1024; t += gridDim.x) {
        const int g = t >> 5, mt = (t >> 2) & 7, nt = t & 3;
        const int nloc = 2 * (nt + 1);
        const bfr* ag = us5 + (size_t)g * NTOK * 16;
        const bfr* xg = xin + (size_t)g * 1024 * 128;
        const int tq = ltid();
        const int arow = mt * 128 + (tq >> 3), acol = gt_lcol(tq);
        auto aptr = [&](int i, int kt) __attribute__((always_inline)) -> const bfr* {
            return (kt < nloc) ? ag + (size_t)(arow + 32 * i) * 512 + kt * 64 + acol
                               : xg + (size_t)(arow + 32 * i) * 128 + (kt - nloc) * 64 + acol;
        };
        const bfr* bg = gt + (size_t)g * 512 * 640 + (size_t)(nt * 128 + (tq >> 3)) * 640 + acol;
        auto bptr = [&](int i, int kt) __attribute__((always_inline)) -> const bfr* {
            return bg + (size_t)(32 * i) * 640 + ((kt < nloc) ? kt : (8 + kt - nloc)) * 64;
        };
        gemm_tile(lds, nloc + 2, aptr, bptr, [&](const float* stg) __attribute__((always_inline)) {
            epi_rows8_pre<uint4>(stg,
                [&](int r, int c0) __attribute__((always_inline)) -> uint4 {
                    const int n = nt * 128 + c0;
                    return *(const uint4*)(ag + ((size_t)(mt * 128 + r) * 32 + (n >> 4)) * 16 + (n & 15)); },
                [&](int r, int c0, const float (&v)[8], const uint4& up) __attribute__((always_inline)) {
                    const int cb = mt * 128 + r;
                    const int n = nt * 128 + c0, tt = n >> 4, c1 = n & 15;
                    const size_t tok = (size_t)cb * 32 + tt;
                    float uu[8], z[8];
                    unpack8(up, uu);
#pragma unroll
                    for (int j = 0; j < 8; ++j) {
                        const float y = v[j] + dsk[g * 16 + c1 + j] * uu[j];
                        const float inner = 0.7978845608028654f * (y + 0.044715f * y * y * y);
                        z[j] = 0.5f * y * (1.0f + ftanh(inner));
                    }
                    *(uint4*)(zb + tok * 512 + g * 16 + c1) = pack8(z);
                });
        });
    }
}

DI void phase_o5(char* lds, const Ctx& P, int li) {
    const bfr* zb = (const bfr*)(P.ws + OFF_ZBUF);
    const bfr* w = (const bfr*)(P.ws + OFF_GLUT) + (size_t)li * 512 * 512;
    bfr* am = (bfr*)(P.ws + OFF_AMIX);
    for (int t = blockIdx.x; t < 1024; t += gridDim.x) {
        int mt, nt; tile_remap(t, 256, 4, mt, nt);
        RowLoader A(zb, mt * 128, 512), B(w, nt * 128, 512);
        gemm_tile(lds, 8, A, B, [&](const float* stg) __attribute__((always_inline)) {
            epi_rows8_pre<uint4>(stg,
                [&](int r, int c0) __attribute__((always_inline)) -> uint4 { return *(const uint4*)(zb + (size_t)(mt * 128 + r) * 512 + nt * 128 + c0); },
                [&](int r, int c0, const float (&v)[8], const uint4& zp) __attribute__((always_inline)) {
                    float zz[8], o[8];
                    unpack8(zp, zz);
#pragma unroll
                    for (int j = 0; j < 8; ++j) o[j] = zz[j] * sigmoidf_(v[j]);
                    *(uint4*)(am + (size_t)(mt * 128 + r) * 1024 + 512 + nt * 128 + c0) = pack8(o);
                });
        });
    }
}
DI void phase_router(char* lds, const Ctx& P, int layer) {
    const float* x = P.out;
    bfr* hb = (bfr*)(P.ws + OFF_HB);
    bfr* hlo = (bfr*)(P.ws + OFF_HLO);
    const bfr* rhi = (const bfr*)(P.ws + OFF_RHI) + (size_t)layer * 128 * 1024;
    const bfr* rlo = (const bfr*)(P.ws + OFF_RLO) + (size_t)layer * 128 * 1024;
    int* gcnt = (int*)(P.ws + OFF_CNT) + layer * 64;
    int* stok = (int*)(P.ws + OFF_TOK);
    float* sgate = (float*)(P.ws + OFF_GATE);
    int* lcnt = (int*)(lds + LDS_AUX);
    int* lbase = lcnt + 64;
    const float* bg = P.in[I_MBG] + layer * 4;
    const float* be = P.in[I_MBE] + layer * 32;
    const int tid = ltid();
    for (int u = blockIdx.x; u < 256; u += gridDim.x) {
        const int m0 = u * 128;
        norm_rows(x, P.in[I_NFFN] + (size_t)layer * DM, hb, hlo, nullptr, m0, 128);
        __syncthreads();
        const size_t roff = (size_t)(m0 + (tid >> 3)) * 1024 + gt_lcol(tid);
        const size_t boff = (size_t)(tid >> 3) * 1024 + gt_lcol(tid);
        auto aptr = [&](int i, int kt) __attribute__((always_inline)) -> const bfr* { return (kt < 32 ? hb : hlo) + roff + (size_t)(32 * i) * 1024 + (kt & 15) * 64; };
        auto bptr = [&](int i, int kt) __attribute__((always_inline)) -> const bfr* { return ((kt >= 16 && kt < 32) ? rlo : rhi) + boff + (size_t)(32 * i) * 1024 + (kt & 15) * 64; };
        gemm_tile(lds, 48, aptr, bptr, [&](const float* stg) __attribute__((always_inline)) {
            if (tid < 64) lcnt[tid] = 0;
            __syncthreads();
            int seg0 = 0, seg1 = 0, p0 = 0, p1 = 0;
            float g0 = 0.f, g1 = 0.f;
            if (tid < 128) {
                const float* row = stg + tid * STG_LD;
                float gl[4];
#pragma unroll
                for (int j = 0; j < 4; ++j) gl[j] = row[32 + j] + bg[j];
                int gt = 0; float gm = gl[0];
#pragma unroll
                for (int j = 1; j < 4; ++j) if (gl[j] > gm) { gm = gl[j]; gt = j; }
                float gs = 0.f;
#pragma unroll
                for (int j = 0; j < 4; ++j) gs += __expf(gl[j] - gm);
                const float gw = 1.0f / gs;
                float l1 = -INFINITY, l2 = -INFINITY; int j1 = 0, j2 = 0;
                for (int j = 0; j < 8; ++j) {
                    const float v = row[gt * 8 + j] + be[gt * 8 + j];
                    if (v > l1) { l2 = l1; j2 = j1; l1 = v; j1 = j; }
                    else if (v > l2) { l2 = v; j2 = j; }
                }
                const float w1 = 1.0f / (1.0f + __expf(l2 - l1));
                g0 = gw * w1; g1 = gw * (1.0f - w1);
                seg0 = gt * 8 + j1; seg1 = 32 + gt * 8 + j2;
                p0 = atomicAdd(&lcnt[seg0], 1);
                p1 = atomicAdd(&lcnt[seg1], 1);
            }
            __syncthreads();
            if (tid < 64) { const int c = lcnt[tid]; lbase[tid] = c ? atomicAdd(&gcnt[tid], c) : 0; }
            __syncthreads();
            if (tid < 128) {
                const int q0 = lbase[seg0] + p0, q1 = lbase[seg1] + p1;
                stok[(size_t)seg0 * NTOK + q0] = m0 + tid; sgate[(size_t)seg0 * NTOK + q0] = g0;
                stok[(size_t)seg1 * NTOK + q1] = m0 + tid; sgate[(size_t)seg1 * NTOK + q1] = g1;
            }
        });
    }
}

DI void moe_tables(char* lds, const Ctx& P, int layer) {
    int* cnt = (int*)(lds + LDS_AUX); int* rb0 = cnt + 64; int* hoff = rb0 + 65;
    const int* gcnt = (const int*)(P.ws + OFF_CNT) + layer * 64;
    const int tid = ltid();
    if (tid < 64) cnt[tid] = gcnt[tid];
    __syncthreads();
    if (tid == 0) {
        int acc = 0;
        for (int s = 0; s < 64; ++s) { rb0[s] = acc; hoff[s] = acc * 128; acc += (cnt[s] + 127) >> 7; }
        rb0[64] = acc;
    }
    __syncthreads();
}
DI int moe_find_seg(const int* rb0, int rbi) { int s = 0; while (rb0[s + 1] <= rbi) ++s; return s; }

DI void phase_moe_up(char* lds, const Ctx& P, int layer) {
    moe_tables(lds, P, layer);
    const int* cnt = (const int*)(lds + LDS_AUX); const int* rb0 = cnt + 64; const int* hoff = rb0 + 65;
    const bfr* hb = (const bfr*)(P.ws + OFF_HB);
    const bfr* wgu = (const bfr*)(P.ws + OFF_MWGU);
    const int* stok = (const int*)(P.ws + OFF_TOK);
    bfr* hid = (bfr*)(P.ws + OFF_HID);
    const int ntiles = rb0[64] * 8;
    for (int t = blockIdx.x; t < ntiles; t += gridDim.x) {
        int rbi, nt; tile_remap(t, rb0[64], 8, rbi, nt);
        const int seg = moe_find_seg(rb0, rbi);
        const int rb = rbi - rb0[seg], e = seg & 31, c = cnt[seg];
        const bfr* ap[4];
        const int tq = ltid();
#pragma unroll
        for (int i = 0; i < 4; ++i) {
            int p = rb * 128 + (tq >> 3) + 32 * i; p = p < c ? p : c - 1;
            ap[i] = hb + (size_t)stok[(size_t)seg * NTOK + p] * 1024 + gt_lcol(tq);
        }
        auto aptr = [&](int i, int kt) __attribute__((always_inline)) -> const bfr* { return ap[i] + kt * 64; };
        RowLoader B(wgu + (size_t)e * 1024 * 1024, nt * 128, 1024);
        const size_t hrow0 = (size_t)hoff[seg] + rb * 128;
        gemm_tile(lds, 16, aptr, B, [&](const float* stg) __attribute__((always_inline)) {
            epi_rows8(stg, [&](int r, int c0, const float (&v)[8]) __attribute__((always_inline)) {
                float o[4];
#pragma unroll
                for (int j = 0; j < 4; ++j) o[j] = v[j] * sigmoidf_(v[j]) * v[4 + j];
                *(uint2*)(hid + (hrow0 + r) * 512 + ((nt * 128 + c0) >> 1)) = make_uint2(pk2(o[0], o[1]), pk2(o[2], o[3]));
            });
        });
    }
}

DI void phase_moe_down(char* lds, const Ctx& P, int layer, int k, float* x) {
    moe_tables(lds, P, layer);
    const int* cnt = (const int*)(lds + LDS_AUX); const int* rb0 = cnt + 64; const int* hoff = rb0 + 65;
    const bfr* hid = (const bfr*)(P.ws + OFF_HID);
    const bfr* wd = (const bfr*)(P.ws + OFF_MWD);
    const int* stok = (const int*)(P.ws + OFF_TOK);
    const float* sgate = (const float*)(P.ws + OFF_GATE);
    const int rbA = rb0[k * 32], rbB = rb0[k * 32 + 32];
    const int ntiles = (rbB - rbA) * 8;
    for (int t = blockIdx.x; t < ntiles; t += gridDim.x) {
        int rbi, nt; tile_remap(t, rbB - rbA, 8, rbi, nt); rbi += rbA;
        const int seg = moe_find_seg(rb0, rbi);
        const int rb = rbi - rb0[seg], e = seg & 31, c = cnt[seg];
        RowLoader A(hid, hoff[seg] + rb * 128, 512), B(wd + (size_t)e * 1024 * 512, nt * 128, 512);
        int* ltok = (int*)(lds + LDS_AUX + 1024); float* lgate = (float*)(lds + LDS_AUX + 1536);
        {
            const int tq = ltid();
            if (tq < 128) {
                const int p = rb * 128 + tq;
                ltok[tq] = p < c ? stok[(size_t)seg * NTOK + p] : -1;
                lgate[tq] = p < c ? sgate[(size_t)seg * NTOK + p] : 0.f;
            }
        }
        gemm_tile(lds, 8, A, B, [&](const float* stg) __attribute__((always_inline)) {
            epi_rows8_pre<F8>(stg,
                [&](int r, int c0) __attribute__((always_inline)) -> F8 {
                    int tok = ltok[r]; tok = tok < 0 ? 0 : tok;
                    const float* d = x + (size_t)tok * DM + nt * 128 + c0;
                    F8 o; o.a = *(const float4*)d; o.b = *(const float4*)(d + 4);
                    return o; },
                [&](int r, int c0, const float (&v)[8], const F8& o) __attribute__((always_inline)) {
                    const int tok = ltok[r];
                    if (tok >= 0) {
                        const float gt = lgate[r];
                        float* d = x + (size_t)tok * DM + nt * 128 + c0;
                        *(float4*)d = make_float4(o.a.x + gt * v[0], o.a.y + gt * v[1], o.a.z + gt * v[2], o.a.w + gt * v[3]);
                        *(float4*)(d + 4) = make_float4(o.b.x + gt * v[4], o.b.y + gt * v[5], o.b.z + gt * v[6], o.b.w + gt * v[7]);
                    }
                });
        });
    }
}
constexpr int PH_PER_LAYER = 11;
constexpr int N_PHASES = 1 + 4 * PH_PER_LAYER;

DI void phase_prologue(char* lds, const Ctx& P) {
    for (int u = blockIdx.x; u < 64; u += gridDim.x) s5_tables(lds, P, u >> 5, u & 31);
    const bool excl = gridDim.x >= 128;
    if (excl && blockIdx.x < 64) return;
    unsigned base = 0;
    const int wk = excl ? (int)blockIdx.x - 64 : (int)blockIdx.x, nw = excl ? (int)gridDim.x - 64 : (int)gridDim.x;
    for (int i = 0; i < 2; ++i) {
        cvt_matrix(lds, P.in[I_EWIN] + (size_t)i * 1024 * 2304, 1024, 2304, (bfr*)(P.ws + OFF_WINE) + (size_t)i * 2304 * 1024, 1024, 0, wk, nw, base);
        cvt_matrix(lds, P.in[I_EWOUT] + (size_t)i * 1024 * 1024, 1024, 1024, (bfr*)(P.ws + OFF_WOUTE) + (size_t)i * 1024 * 1024, 1024, 0, wk, nw, base);
        cvt_matrix(lds, P.in[I_OWIN] + (size_t)i * 1024 * 2048, 1024, 2048, (bfr*)(P.ws + OFF_WINO) + (size_t)i * 2048 * 1024, 1024, 0, wk, nw, base);
        cvt_matrix(lds, P.in[I_OWOUT] + (size_t)i * 1024 * 1024, 1024, 1024, (bfr*)(P.ws + OFF_WOUTO) + (size_t)i * 1024 * 1024, 1024, 0, wk, nw, base);
        cvt_matrix(lds, P.in[I_W2] + (size_t)i * 64 * 512, 64, 512, (bfr*)(P.ws + OFF_W2T) + (size_t)i * 512 * 64, 64, 0, wk, nw, base);
        cvt_matrix(lds, P.in[I_A2] + (size_t)i * 64 * 512, 64, 512, (bfr*)(P.ws + OFF_A2T) + (size_t)i * 512 * 64, 64, 0, wk, nw, base);
        cvt_matrix(lds, P.in[I_G2] + (size_t)i * 128 * 512, 128, 512, (bfr*)(P.ws + OFF_G2T) + (size_t)i * 512 * 128, 128, 0, wk, nw, base);
        for (int g = 0; g < 4; ++g)
            cvt_matrix(lds, P.in[I_POOLW] + (size_t)(i * 4 + g) * 128 * 128, 128, 128, (bfr*)(P.ws + OFF_POOLT) + (size_t)(i * 4 + g) * 128 * 128, 128, 0, wk, nw, base);
        cvt_matrix(lds, P.in[I_WGLU] + (size_t)i * 512 * 512, 512, 512, (bfr*)(P.ws + OFF_GLUT) + (size_t)i * 512 * 512, 512, 0, wk, nw, base);
    }
    const int gtid = wk * NTHREADS + ltid(), gsz = nw * NTHREADS;
    {
        bfr* rhi = (bfr*)(P.ws + OFF_RHI); bfr* rlo = (bfr*)(P.ws + OFF_RLO);
        for (int idx = gtid; idx < 4 * 128 * 1024; idx += gsz) {
            const int k = idx & 1023, n = (idx >> 10) & 127, l = idx >> 17;
            float w = 0.f;
            if (n < 32) w = P.in[I_MWE][((size_t)l * 1024 + k) * 32 + n];
            else if (n < 36) w = P.in[I_MWG][((size_t)l * 1024 + k) * 4 + (n - 32)];
            const bfr h = f2bf(w);
            rhi[idx] = h; rlo[idx] = f2bf(w - bf2f(h));
        }
    }
    {
        bfr* v12 = (bfr*)(P.ws + OFF_V12T);
        const float* v1 = P.in[I_V1]; const float* v2 = P.in[I_V2];
        for (int idx = gtid; idx < 512 * 512; idx += gsz) {
            const int k = idx & 511, n = idx >> 9;
            float s = 0.f;
            for (int r = 0; r < 32; ++r) s += v1[k * 32 + r] * v2[r * 512 + n];
            v12[idx] = f2bf(s);
        }
    }
    for (int tt = wk; tt < 512; tt += nw)
        norm_rows(P.in[I_X], P.in[I_NMIX], (bfr*)(P.ws + OFF_HB), nullptr, P.out, tt * 64, 64);
}

DI Ctx mkctx(unsigned char* ws, float* out) {
    size_t z = 0;
    asm volatile("" : "+s"(z));
    Ctx c;
    c.in.p = (KArgPtr)__builtin_amdgcn_kernarg_segment_ptr() + z;
    c.ws = ws + z; c.out = (float*)((char*)out + z);
    return c;
}
__global__ void __launch_bounds__(NTHREADS, 2) fwd_kernel(Params PA) {
    extern __shared__ __attribute__((aligned(16))) char lds[];
    if (threadIdx.x == 0) *(uint4*)(lds + LDS_BYTES - 16) = make_uint4(0u, 0u, 0u, 0u);
    __syncthreads();
    XcdBarrier bar = xcd_barrier_post((unsigned*)(PA.ws + OFF_BAR), (volatile LAS unsigned*)(lds + LDS_BYTES - 16));
    const int lo = PA.ph_lo, hi = PA.ph_hi;
#ifndef DUP_PH
#define DUP_PH (-1)
#endif
#define DUPX(k, call) do { call; if (DUP_PH == (k)) { __syncthreads(); call; } } while (0)
#define RUNS(id) ((id) >= lo && (id) < hi)
#define P mkctx(PA.ws, PA.out)
#define SEAM(id) do { if ((id) > lo && (id) < hi) xcd_barrier(bar); } while (0)
    if (RUNS(0)) DUPX(100, phase_prologue(lds, P));
    for (int layer = 0; layer < 4; ++layer) {
        const int base = 1 + layer * PH_PER_LAYER;
        const int li = layer >> 1;
        if ((layer & 1) == 0) {
            SEAM(base + 0); if (RUNS(base + 0)) DUPX(0, phase_e1(lds, P, li));
            SEAM(base + 1); if (RUNS(base + 1)) DUPX(1, phase_e2a(P, li));
            SEAM(base + 2); if (RUNS(base + 2)) DUPX(2, phase_e2b(lds, P, li));
            SEAM(base + 3); if (RUNS(base + 3)) { phase_e3(lds, P, li); if (DUP_PH == 3) phase_e3(lds, P, li, 3); if (DUP_PH == 41) phase_e3(lds, P, li, 1); if (DUP_PH == 42) phase_e3(lds, P, li, 2); }
            SEAM(base + 4); if (RUNS(base + 4)) DUPX(4, phase_e4(P, li));
            SEAM(base + 5); if (RUNS(base + 5)) { phase_wout(lds, P, (const bfr*)(P.ws + OFF_WOUTE) + (size_t)li * 1024 * 1024, P.out); if (DUP_PH == 5) phase_wout(lds, P, (const bfr*)(P.ws + OFF_WOUTE) + (size_t)li * 1024 * 1024, (float*)(P.ws + OFF_EV)); }
        } else {
            SEAM(base + 0); if (RUNS(base + 0)) DUPX(10, phase_o1(lds, P, li));
            SEAM(base + 1); if (RUNS(base + 1)) DUPX(11, phase_o2(lds, P, li));
            SEAM(base + 2); if (RUNS(base + 2)) DUPX(12, phase_o3(lds, P, li, layer));
            SEAM(base + 3); if (RUNS(base + 3)) DUPX(13, phase_o4(lds, P, li));
            SEAM(base + 4); if (RUNS(base + 4)) DUPX(14, phase_o5(lds, P, li));
            SEAM(base + 5); if (RUNS(base + 5)) { phase_wout(lds, P, (const bfr*)(P.ws + OFF_WOUTO) + (size_t)li * 1024 * 1024, P.out); if (DUP_PH == 5) phase_wout(lds, P, (const bfr*)(P.ws + OFF_WOUTO) + (size_t)li * 1024 * 1024, (float*)(P.ws + OFF_EV)); }
        }
        SEAM(base + 6);
        if (RUNS(base + 6)) {
            phase_router(lds, P, layer);
            const bool split = gridDim.x >= 512;
            DUPX(6, moe_convert(lds, P, layer, split ? (int)blockIdx.x - 256 : (int)blockIdx.x, split ? (int)gridDim.x - 256 : (int)gridDim.x));
        }
        SEAM(base + 7); if (RUNS(base + 7)) DUPX(7, phase_moe_up(lds, P, layer));
        SEAM(base + 8); if (RUNS(base + 8)) { phase_moe_down(lds, P, layer, 0, P.out); if (DUP_PH == 8) phase_moe_down(lds, P, layer, 0, (float*)(P.ws + OFF_EV)); }
        SEAM(base + 9); if (RUNS(base + 9)) phase_moe_down(lds, P, layer, 1, P.out);
        SEAM(base + 10);
        if (RUNS(base + 10) && layer < 3) {
            for (int rep = 0; rep < (DUP_PH == 20 ? 2 : 1); ++rep)
            for (int tt = blockIdx.x; tt < 512; tt += gridDim.x)
                norm_rows(P.out, P.in[I_NMIX] + (size_t)(layer + 1) * DM, (bfr*)(P.ws + OFF_HB), nullptr, nullptr, tt * 64, 64);
        }
    }
#undef P
#undef RUNS
#undef SEAM
}

#ifndef N_LAUNCH_SPLIT
#define N_LAUNCH_SPLIT 0
#endif
extern "C" void kernel_launch(void* const* d_in, const int* in_sizes, int n_in, void* d_out, int out_size, void* d_ws, size_t ws_size, hipStream_t stream) {
    static int grid = 0;
    if (grid == 0) {
        if (n_in != N_INPUTS || out_size != NTOK * DM || ws_size < WS_NEEDED) {
            fprintf(stderr, "kernel_launch: unexpected shapes: n_in %d out %d ws %zu (need %zu)\n", n_in, out_size, ws_size, (size_t)WS_NEEDED);
            grid = -1; return;
        }
        int dev = 0, cus = 0, per_cu = 0;
        (void)hipGetDevice(&dev);
        (void)hipDeviceGetAttribute(&cus, hipDeviceAttributeMultiprocessorCount, dev);
        if (hipFuncSetAttribute((const void*)fwd_kernel, hipFuncAttributeMaxDynamicSharedMemorySize, LDS_BYTES) != hipSuccess) { fprintf(stderr, "kernel_launch: hipFuncSetAttribute failed\n"); grid = -1; return; }
        if (hipOccupancyMaxActiveBlocksPerMultiprocessor(&per_cu, (const void*)fwd_kernel, NTHREADS, LDS_BYTES) != hipSuccess) per_cu = 1;
        (void)hipGetLastError();
        if (per_cu < 1) per_cu = 1;
        if (per_cu > 2) per_cu = 2;
        if (cus <= 0) cus = 256;
        grid = cus * per_cu;
    }
    if (grid < 0) return;
    (void)hipMemsetAsync(d_ws, 0, OFF_ZERO_END, stream);
    Params p{};
    for (int i = 0; i < N_INPUTS; ++i) p.in[i] = (const float*)d_in[i];
    p.out = (float*)d_out; p.ws = (unsigned char*)d_ws;
#if N_LAUNCH_SPLIT
    for (int ph = 0; ph < N_PHASES - 1; ++ph) {
        p.ph_lo = ph; p.ph_hi = ph + 1;
        hipLaunchKernelGGL(fwd_kernel, dim3(grid), dim3(NTHREADS), LDS_BYTES, stream, p);
    }
#else
    p.ph_lo = 0; p.ph_hi = N_PHASES;
    hipLaunchKernelGGL(fwd_kernel, dim3(grid), dim3(NTHREADS), LDS_BYTES, stream, p);
#endif
}
```

```cpp
#include <hip/hip_runtime.h>
#include <stdint.h>
#include <stdio.h>

typedef unsigned short bfr;
typedef __attribute__((ext_vector_type(8))) short bf16x8;
typedef __attribute__((ext_vector_type(16))) float f32x16;
typedef __attribute__((ext_vector_type(2))) __bf16 bf16x2_t;
#define DI __device__ __forceinline__
#define MFMA32(a, b, c) __builtin_amdgcn_mfma_f32_32x32x16_bf16((a), (b), (c), 0, 0, 0)

constexpr int NTOK = 32768, DM = 1024, SEQ = 2048, NB = 16;
constexpr int EVEN_IN = 2304, ODD_IN = 2048;
constexpr int NTHREADS = 512;
constexpr int NWAVES = NTHREADS / 64;
constexpr int LDS_BYTES = 161792;

enum { I_X = 0, I_NMIX, I_NFFN, I_EWIN, I_MU, I_W0, I_W2, I_A0, I_A2, I_G2, I_KK, I_KA, I_RK, I_LNG, I_LNB, I_V0, I_V1, I_V2,
       I_POOLW, I_POOLS, I_EWOUT, I_OWIN, I_QN, I_KN, I_LQ1, I_LK1, I_LQ2, I_LK2, I_SUBLN, I_ARE, I_AIM, I_LSTEP, I_BRE, I_BIM,
       I_CRE, I_CIM, I_S5D, I_WGLU, I_OWOUT, I_MWG, I_MBG, I_MWE, I_MBE, I_MWGATE, I_MWUP, I_MWDOWN, N_INPUTS };

constexpr size_t al256(size_t x) { return (x + 255) & ~(size_t)255; }
constexpr size_t OFF_BAR   = 0;
constexpr size_t OFF_CNT   = 16384;
constexpr size_t OFF_ZERO_END = 32768;
constexpr size_t OFF_WINE  = 65536;
constexpr size_t OFF_WOUTE = OFF_WINE  + (size_t)2 * 2304 * 1024 * 2;
constexpr size_t OFF_WINO  = OFF_WOUTE + (size_t)2 * 1024 * 1024 * 2;
constexpr size_t OFF_WOUTO = OFF_WINO  + (size_t)2 * 2048 * 1024 * 2;
constexpr size_t OFF_W2T   = OFF_WOUTO + (size_t)2 * 1024 * 1024 * 2;
constexpr size_t OFF_A2T   = OFF_W2T   + (size_t)2 * 512 * 64 * 2;
constexpr size_t OFF_G2T   = OFF_A2T   + (size_t)2 * 512 * 64 * 2;
constexpr size_t OFF_V12T  = OFF_G2T   + (size_t)2 * 512 * 128 * 2;
constexpr size_t OFF_POOLT = OFF_V12T  + (size_t)512 * 512 * 2;
constexpr size_t OFF_GLUT  = OFF_POOLT + (size_t)2 * 4 * 128 * 128 * 2;
constexpr size_t OFF_RHI   = OFF_GLUT  + (size_t)2 * 512 * 512 * 2;
constexpr size_t OFF_RLO   = OFF_RHI   + (size_t)4 * 128 * 1024 * 2;
constexpr size_t OFF_S5GT  = OFF_RLO   + (size_t)4 * 128 * 1024 * 2;
constexpr size_t OFF_S5BL  = OFF_S5GT  + (size_t)2 * 32 * 512 * 640 * 2;
constexpr size_t OFF_S5L32 = OFF_S5BL  + (size_t)2 * 32 * 128 * 512 * 2;
constexpr size_t OFF_MWGU  = al256(OFF_S5L32 + (size_t)2 * 32 * 64 * 2 * 4);
constexpr size_t OFF_MWD   = OFF_MWGU  + (size_t)32 * 1024 * 1024 * 2;
constexpr size_t OFF_HB    = OFF_MWD   + (size_t)32 * 1024 * 512 * 2;
constexpr size_t OFF_U     = OFF_HB    + (size_t)NTOK * 1024 * 2;
constexpr size_t OFF_US5   = OFF_U     + (size_t)NTOK * 1024 * 2;
constexpr size_t OFF_AMIX  = OFF_U     + (size_t)NTOK * 2304 * 2;
constexpr size_t OFF_VFIRST= OFF_AMIX  + (size_t)NTOK * 1024 * 2;
constexpr size_t OFF_TOK   = OFF_VFIRST+ (size_t)NTOK * 512 * 2;
constexpr size_t OFF_GATE  = OFF_TOK   + (size_t)64 * NTOK * 4;
constexpr size_t OFF_HID   = OFF_GATE  + (size_t)64 * NTOK * 4;
constexpr size_t OFF_HLO   = OFF_HID;
constexpr size_t OFF_EV    = OFF_HID   + (size_t)81920 * 512 * 2;
constexpr size_t OFF_S     = OFF_EV;
constexpr size_t OFF_MV2   = OFF_S     + (size_t)NTOK * 256 * 2;
constexpr size_t OFF_DLOG  = OFF_MV2   + (size_t)NTOK * 512 * 2;
constexpr size_t OFF_ABUF  = OFF_DLOG  + (size_t)NTOK * 512 * 4;
constexpr size_t OFF_GBUF  = OFF_ABUF  + (size_t)NTOK * 512 * 2;
constexpr size_t OFF_VGATE = OFF_GBUF  + (size_t)NTOK * 512 * 2;
constexpr size_t OFF_Y     = OFF_VGATE + (size_t)NTOK * 512 * 2;
constexpr size_t OFF_DPOOL = OFF_Y;
constexpr size_t OFF_BONUS = OFF_Y     + (size_t)NTOK * 512 * 4;
constexpr size_t OFF_EV_END= OFF_BONUS + (size_t)NTOK * 512 * 4;
constexpr size_t OFF_QN    = OFF_EV;
constexpr size_t OFF_KN    = OFF_QN    + (size_t)NTOK * 512 * 2;
constexpr size_t OFF_VT    = OFF_KN    + (size_t)NTOK * 512 * 2;
constexpr size_t OFF_XLOC  = OFF_VT    + (size_t)NTOK * 512 * 2;
constexpr size_t OFF_XIN   = OFF_XLOC  + (size_t)32 * 1024 * 128 * 4;
constexpr size_t OFF_ZBUF  = OFF_XIN   + (size_t)32 * 1024 * 128 * 2;
constexpr size_t OFF_OD_END= OFF_ZBUF  + (size_t)NTOK * 512 * 2;
constexpr size_t WS_NEEDED = OFF_EV_END > OFF_OD_END ? OFF_EV_END : OFF_OD_END;

struct Params {
    const float* in[N_INPUTS];
    float* out;
    unsigned char* ws;
    int ph_lo, ph_hi;
};
typedef const __attribute__((address_space(4))) char* KArgPtr;
struct InTab {
    KArgPtr p;
    DI const float* operator[](int i) const {
        const float* q = *(const float* const __attribute__((address_space(4)))*)(p + 8 * i);
        return (const float*)(const __attribute__((address_space(1))) float*)q;
    }
};
struct Ctx { InTab in; unsigned char* ws; float* out; };

DI unsigned pk2(float a, float b) { bf16x2_t v; v[0] = (__bf16)a; v[1] = (__bf16)b; return __builtin_bit_cast(unsigned, v); }
DI bfr f2bf(float a) { return (bfr)(pk2(a, 0.f) & 0xffffu); }
DI float bf2f(bfr b) { return __uint_as_float(((unsigned)b) << 16); }
DI float bflo(unsigned u) { return __uint_as_float(u << 16); }
DI float bfhi(unsigned u) { return __uint_as_float(u & 0xffff0000u); }
DI uint4 pack8(const float (&v)[8]) { return make_uint4(pk2(v[0], v[1]), pk2(v[2], v[3]), pk2(v[4], v[5]), pk2(v[6], v[7])); }
DI void unpack8(uint4 u, float (&v)[8]) { v[0] = bflo(u.x); v[1] = bfhi(u.x); v[2] = bflo(u.y); v[3] = bfhi(u.y); v[4] = bflo(u.z); v[5] = bfhi(u.z); v[6] = bflo(u.w); v[7] = bfhi(u.w); }
DI float frcp(float x) { return __builtin_amdgcn_rcpf(x); }
DI float fexp(float x) { return __builtin_amdgcn_exp2f(x * 1.4426950408889634f); }
DI float sigmoidf_(float x) { return frcp(1.0f + fexp(-x)); }
DI float ftanh(float x) { return 2.0f * frcp(1.0f + fexp(-2.0f * x)) - 1.0f; }
DI float fsoftplus(float z) { return z > 20.0f ? z : __logf(1.0f + fexp(z)); }
template <int CTRL> DI float dpp_f(float x) { return __builtin_bit_cast(float, __builtin_amdgcn_update_dpp(0, __builtin_bit_cast(int, x), CTRL, 0xf, 0xf, false)); }
DI float row16_sum(float s) {
    s += dpp_f<0x128>(s); s += dpp_f<0x124>(s); s += dpp_f<0x122>(s); s += dpp_f<0x121>(s); return s; }
DI int ltid() { int t = threadIdx.x; asm volatile("" : "+v"(t)); return t; }
DI float dot4n(float s0, float s1, float s2, float s3, const float4& a) {
    float d;
    asm("v_mul_f32 %0, %1, %5\n\tv_fma_f32 %0, %2, %6, %0\n\tv_fma_f32 %0, %3, %7, %0\n\tv_fma_f32 %0, %4, %8, %0\n\ts_nop 1"
        : "=&v"(d) : "v"(s0), "v"(s1), "v"(s2), "v"(s3), "v"(a.x), "v"(a.y), "v"(a.z), "v"(a.w));
    return d;
}
DI void rw_upd(float& S, float w, float sa, float b, float vi, float k) {
    float t;
    asm("v_mul_f32 %1, %4, %5\n\tv_fma_f32 %1, %2, %3, %1\n\tv_fma_f32 %0, %0, %6, %1"
        : "+v"(S), "=&v"(t) : "v"(sa), "v"(b), "v"(vi), "v"(k), "v"(w));
}
DI float wave_sum(float s) { s = row16_sum(s); s += __shfl_xor(s, 16); s += __shfl_xor(s, 32); return s; }
#define XB_TMO      128
#define XB_XCNT(j)  (256  + 64 * (j))
#define XB_XSUB(j)  (1280 + 64 * (j))
#define XB_XGEN(j)  (2304 + 64 * (j))
#define XB_TOP      3328
#define XB_TOPGEN   3392
#define XCD_BAR_WORDS 3456
#define XB_SPIN_CAP (1u << 18)
#define LAS __attribute__((address_space(3)))

__device__ __forceinline__ unsigned xb_ld(unsigned* p)              { return __hip_atomic_load(p, __ATOMIC_RELAXED, __HIP_MEMORY_SCOPE_AGENT); }
__device__ __forceinline__ unsigned xb_add(unsigned* p, unsigned v) { return __hip_atomic_fetch_add(p, v, __ATOMIC_RELAXED, __HIP_MEMORY_SCOPE_AGENT); }
__device__ __forceinline__ unsigned xb_xcc_id() { return (unsigned)__builtin_amdgcn_s_getreg((3 << 11) | 20) & 0xFu; }
#define XB_SPIN(cond, bar) do { unsigned _sp = 0; while (cond) { __builtin_amdgcn_s_sleep(1); \
    if ((++_sp & 255u) == 0u) { if (xb_ld(&(bar)[XB_TMO])) break; if (_sp > XB_SPIN_CAP) { atomicAdd(&(bar)[XB_TMO], 1u); break; } } } } while (0)

struct XcdBarrier {
    unsigned* bar; unsigned x;
    volatile LAS unsigned* st;
};
__device__ __forceinline__ XcdBarrier xcd_barrier_post(unsigned* bar, volatile LAS unsigned* st) {
    XcdBarrier b; b.bar = bar; b.x = xb_xcc_id(); b.st = st;
    if (threadIdx.x == 0) (void)xb_add(&bar[XB_XCNT(b.x)], 1u);
    return b;
}
__device__ __forceinline__ void xcd_barrier_complete(unsigned* bar, unsigned x, unsigned& nloc, unsigned& nx) {
    const unsigned G = gridDim.x * gridDim.y * gridDim.z;
    unsigned sum, cnt, mine, sp = 0u;
    for (;;) {
        sum = 0u; cnt = 0u; mine = 0u;
#pragma unroll
        for (unsigned j = 0; j < 16; ++j) { const unsigned c = xb_ld(&bar[XB_XCNT(j)]); sum += c; cnt += (c > 0u) ? 1u : 0u; mine = (j == x) ? c : mine; }
        if (sum == G) break;
        __builtin_amdgcn_s_sleep(1);
        if ((++sp & 255u) == 0u) { if (xb_ld(&bar[XB_TMO])) break; if (sp > XB_SPIN_CAP) { atomicAdd(&bar[XB_TMO], 1u); break; } }
    }
    nloc = mine > 0u ? mine : 1u; nx = cnt > 0u ? cnt : 1u;
}
__device__ __forceinline__ void xcd_barrier(const XcdBarrier& b) {
    asm volatile("s_waitcnt vmcnt(0)" ::: "memory");
    __syncthreads();
    if (threadIdx.x == 0) {
        unsigned* bar = b.bar;
        __builtin_amdgcn_s_waitcnt(0);
        unsigned nloc = b.st[0], nx = b.st[1];
        if (nloc == 0u) { xcd_barrier_complete(bar, b.x, nloc, nx); b.st[0] = nloc; b.st[1] = nx; }
        const unsigned old = xb_add(&bar[XB_XSUB(b.x)], 1u);
        const unsigned gen = old / nloc;
        if (old + 1u == (gen + 1u) * nloc) {
            __builtin_amdgcn_fence(__ATOMIC_RELEASE, "agent");
            asm volatile("s_waitcnt vmcnt(0)" ::: "memory");
            const unsigned og = xb_add(&bar[XB_TOP], 1u);
            const unsigned tg = og / nx;
            if (og + 1u == (tg + 1u) * nx) xb_add(&bar[XB_TOPGEN], 1u);
            else XB_SPIN(xb_ld(&bar[XB_TOPGEN]) == tg, bar);
            __builtin_amdgcn_fence(__ATOMIC_ACQUIRE, "agent");
            xb_add(&bar[XB_XGEN(b.x)], 1u);
            asm volatile("s_waitcnt vmcnt(0)" ::: "memory");
        } else {
            XB_SPIN(xb_ld(&bar[XB_XGEN(b.x)]) == gen, bar);
            __builtin_amdgcn_fence(__ATOMIC_ACQUIRE, "agent");
            asm volatile("s_waitcnt vmcnt(0)" ::: "memory");
        }
    }
    __syncthreads();
}

constexpr int LDA = 72;
constexpr int TILE_B = 128 * LDA * 2;
constexpr int STG_LD = 132;
constexpr int LDS_AUX = 139264;
typedef const __attribute__((address_space(1))) unsigned* GPtrU;
typedef __attribute__((address_space(3))) unsigned* LPtrU;
DI int gt_lcol(int t) { return (((t & 7) ^ ((t >> 4) & 7)) * 8); }

template <int WR, int WC, int MI, int NI, class AF, class BF, class EF>
DI void gemm8(char* lds, int nk, AF aptr, BF bptr, EF epi) {
    static_assert(WR * WC == NWAVES && WR * MI * 32 == 256, "wave grid");
    constexpr int NT = WC * NI * 32, A_BYTES = 256 * 128, STAGE = A_BYTES + NT * 128, NB = NT / 64, NP = NT / 128;
    const int tid = ltid(), lane = tid & 63, wave = tid >> 6;
    const int wr = wave / WC, wc = wave % WC;
    f32x16 acc[MI][NI];
#pragma unroll
    for (int a = 0; a < MI; ++a)
#pragma unroll
        for (int b = 0; b < NI; ++b)
#pragma unroll
            for (int r = 0; r < 16; ++r) acc[a][b][r] = 0.f;
#define G8_DMA(kt_, base_) do { char* db_ = (base_) + tid * 16; \
        _Pragma("unroll") for (int i_ = 0; i_ < 4; ++i_) __builtin_amdgcn_global_load_lds((GPtrU)aptr(i_, kt_), (LPtrU)(db_ + i_ * 8192), 16, 0, 0); \
        _Pragma("unroll") for (int i_ = 0; i_ < NB; ++i_) __builtin_amdgcn_global_load_lds((GPtrU)bptr(i_, kt_), (LPtrU)(db_ + A_BYTES + i_ * 8192), 16, 0, 0); } while (0)
#define G8_KS(cb_, ao_, bo_) do { bf16x8 af_[MI], bf_[NI]; \
        _Pragma("unroll") for (int m_ = 0; m_ < MI; ++m_) af_[m_] = *(const bf16x8*)((cb_) + (ao_) + m_ * 4096); \
        _Pragma("unroll") for (int n_ = 0; n_ < NI; ++n_) bf_[n_] = *(const bf16x8*)((cb_) + (bo_) + n_ * 4096); \
        _Pragma("unroll") for (int m_ = 0; m_ < MI; ++m_) _Pragma("unroll") for (int n_ = 0; n_ < NI; ++n_) acc[m_][n_] = MFMA32(af_[m_], bf_[n_], acc[m_][n_]); } while (0)
    const int ln = lane & 31, hf = lane >> 5, sw = (ln >> 1) & 7;
    const int arow = (wr * MI * 32 + ln) * 128, brow = A_BYTES + (wc * NI * 32 + ln) * 128;
    int ao0 = arow + ((0 + hf) ^ sw) * 16, ao1 = arow + ((2 + hf) ^ sw) * 16, ao2 = arow + ((4 + hf) ^ sw) * 16, ao3 = arow + ((6 + hf) ^ sw) * 16;
    int bo0 = brow + ((0 + hf) ^ sw) * 16, bo1 = brow + ((2 + hf) ^ sw) * 16, bo2 = brow + ((4 + hf) ^ sw) * 16, bo3 = brow + ((6 + hf) ^ sw) * 16;
    asm volatile("" : "+v"(ao0), "+v"(ao1), "+v"(ao2), "+v"(ao3), "+v"(bo0), "+v"(bo1), "+v"(bo2), "+v"(bo3));
    G8_DMA(0, lds);
    asm volatile("s_waitcnt vmcnt(0)" ::: "memory");
    __syncthreads();
    int buf = 0;
#pragma unroll 1
    for (int kt = 0; kt < nk - 1; ++kt) {
        G8_DMA(kt + 1, lds + (buf ^ 1) * STAGE);
        const char* cb = lds + buf * STAGE;
        G8_KS(cb, ao0, bo0); G8_KS(cb, ao1, bo1); G8_KS(cb, ao2, bo2); G8_KS(cb, ao3, bo3);
        asm volatile("s_waitcnt vmcnt(0)" ::: "memory");
        __syncthreads();
        buf ^= 1;
    }
    {
        const char* cb = lds + buf * STAGE;
        G8_KS(cb, ao0, bo0); G8_KS(cb, ao1, bo1); G8_KS(cb, ao2, bo2); G8_KS(cb, ao3, bo3);
    }
    __syncthreads();
#undef G8_DMA
#undef G8_KS
    float* stg = (float*)lds;
    int w_off = (wr * MI * 32 + 4 * (lane >> 5)) * STG_LD + ((wc * NI * 32) & 127) + (lane & 31);
    asm volatile("" : "+v"(w_off));
#pragma unroll
    for (int p = 0; p < NP; ++p) {
        if (((wc * NI * 32) >> 7) == p) {
#pragma unroll
            for (int m = 0; m < MI; ++m)
#pragma unroll
                for (int n = 0; n < NI; ++n)
#pragma unroll
                    for (int r = 0; r < 16; ++r)
                        stg[w_off + (m * 32 + (r & 3) + 8 * (r >> 2)) * STG_LD + n * 32] = acc[m][n][r];
        }
        __syncthreads();
        epi((const float*)stg, p);
        __syncthreads();
    }
}
template <class F> DI void epi_rows8(const float* stg, F f) {
    const int tid0 = ltid();
#pragma unroll
    for (int it = 0; it < 8; ++it) {
        const int idx = it * NTHREADS + tid0;
        const int r = idx >> 4, c0 = (idx & 15) * 8;
        const float4 p = *(const float4*)(stg + r * STG_LD + c0);
        const float4 q = *(const float4*)(stg + r * STG_LD + c0 + 4);
        const float v[8] = {p.x, p.y, p.z, p.w, q.x, q.y, q.z, q.w};
        f(r, c0, v);
    }
}
template <class T, class L, class F> DI void epi_rows8_pre(const float* stg, L loadf, F f) {
    const int tid0 = ltid();
    constexpr int BATCH = sizeof(T) > 16 ? 2 : 4;
#pragma unroll
    for (int h = 0; h < 8 / BATCH; ++h) {
        T pre[BATCH];
#pragma unroll
        for (int it = 0; it < BATCH; ++it) { const int idx = (h * BATCH + it) * NTHREADS + tid0; pre[it] = loadf(idx >> 4, (idx & 15) * 8); }
#pragma unroll
        for (int it = 0; it < BATCH; ++it) {
            const int idx = (h * BATCH + it) * NTHREADS + tid0;
            const int r = idx >> 4, c0 = (idx & 15) * 8;
            const float4 p = *(const float4*)(stg + r * STG_LD + c0);
            const float4 q = *(const float4*)(stg + r * STG_LD + c0 + 4);
            const float v[8] = {p.x, p.y, p.z, p.w, q.x, q.y, q.z, q.w};
            f(r, c0, v, pre[it]);
        }
    }
}
struct F8 { float4 a, b; };
DI void tile_remap(int L, int nM, int nN, int& pm, int& pn) {
    const int ntiles = nM * nN;
    int w = L;
    if ((ntiles & 7) == 0) w = (L & 7) * (ntiles >> 3) + (L >> 3);
    const int nig = 8 * nN, gid = w / nig, fm = gid * 8, rem = w - gid * nig;
    const int gsz = (nM - fm) < 8 ? (nM - fm) : 8;
    pm = fm + rem % gsz; pn = rem / gsz;
}
struct RowLoader {
    const bfr* p; size_t ld;
    DI RowLoader(const bfr* base, int row0, size_t ld_) : ld(ld_) { const int t = ltid(); p = base + (size_t)(row0 + (t >> 3)) * ld_ + gt_lcol(t); }
    DI const bfr* operator()(int i, int kt) const { return p + (size_t)(64 * i) * ld + kt * 64; }
};
#define GEMM256 gemm8<2, 4, 4, 2>
#define GEMM128 gemm8<4, 2, 2, 2>
struct G4 { char* lds; int tid; int vb; int nvb; volatile LAS unsigned* cnt; };
constexpr int G4_LDS = 77824;
constexpr int G4_AUX = 73728;
constexpr int G4_TILE = 128 * 128;
DI G4 g4_make(char* lds) {
    G4 g; const int t = ltid(); const int grp = t >> 8;
    g.lds = lds + grp * G4_LDS; g.tid = t & 255; g.vb = blockIdx.x * 2 + grp; g.nvb = gridDim.x * 2;
    g.cnt = (volatile LAS unsigned*)(lds + LDS_BYTES - 32) + grp;
    return g;
}
DI void g4_bar(const G4& G) {
    asm volatile("s_waitcnt vmcnt(0) lgkmcnt(0)" ::: "memory");
    unsigned target = 0;
    if ((G.tid & 63) == 0) {
        const unsigned old = __hip_atomic_fetch_add((LAS unsigned*)G.cnt, 1u, __ATOMIC_RELAXED, __HIP_MEMORY_SCOPE_WORKGROUP);
        target = (old & ~3u) + 4u;
    }
    target = __builtin_amdgcn_readfirstlane(target);
    while ((int)(*G.cnt - target) < 0) __builtin_amdgcn_s_sleep(1);
    asm volatile("" ::: "memory");
}
template <class F> DI void g4_epi_rows8(const G4& G, const float* stg, F f) {
#pragma unroll
    for (int it = 0; it < 8; ++it) {
        const int idx = it * 256 + G.tid;
        const int r = idx >> 4, c0 = (idx & 15) * 8;
        const float4 p = *(const float4*)(stg + r * STG_LD + c0);
        const float4 q = *(const float4*)(stg + r * STG_LD + c0 + 4);
        const float v[8] = {p.x, p.y, p.z, p.w, q.x, q.y, q.z, q.w};
        f(r, c0, v);
    }
}
template <class T, class L, class F> DI void g4_epi_rows8_pre(const G4& G, const float* stg, L loadf, F f) {
    T pre[8];
#pragma unroll
    for (int it = 0; it < 8; ++it) { const int idx = it * 256 + G.tid; pre[it] = loadf(idx >> 4, (idx & 15) * 8); }
#pragma unroll
    for (int it = 0; it < 8; ++it) {
        const int idx = it * 256 + G.tid;
        const int r = idx >> 4, c0 = (idx & 15) * 8;
        const float4 p = *(const float4*)(stg + r * STG_LD + c0);
        const float4 q = *(const float4*)(stg + r * STG_LD + c0 + 4);
        const float v[8] = {p.x, p.y, p.z, p.w, q.x, q.y, q.z, q.w};
        f(r, c0, v, pre[it]);
    }
}
struct G4RowLoader {
    const bfr* p; size_t ld;
    DI G4RowLoader(const G4& G, const bfr* base, int row0, size_t ld_) : ld(ld_) { p = base + (size_t)(row0 + (G.tid >> 3)) * ld_ + gt_lcol(G.tid); }
    DI const bfr* operator()(int i, int kt) const { return p + (size_t)(32 * i) * ld + kt * 64; }
};
template <class AF, class BF, class EF>
DI void g4_gemm_tile(const G4& G, char* lds, int nk, AF aptr, BF bptr, EF epi) {
    const int tid = G.tid, lane = tid & 63, wave = tid >> 6;
    const int wr = wave >> 1, wc = wave & 1;
    f32x16 acc00, acc01, acc10, acc11;
#pragma unroll
    for (int r = 0; r < 16; ++r) { acc00[r] = 0.f; acc01[r] = 0.f; acc10[r] = 0.f; acc11[r] = 0.f; }
#define GT_DMA(kt_, base_) do { char* db_ = (base_) + tid * 16; _Pragma("unroll") for (int i_ = 0; i_ < 4; ++i_) { \
        __builtin_amdgcn_global_load_lds((GPtrU)aptr(i_, kt_), (LPtrU)(db_ + i_ * 4096), 16, 0, 0); \
        __builtin_amdgcn_global_load_lds((GPtrU)bptr(i_, kt_), (LPtrU)(db_ + G4_TILE + i_ * 4096), 16, 0, 0); } } while (0)
#define GT_FRAG(cb_, off_) (*(const bf16x8*)((cb_) + (off_)))
#define GT_COMPUTE(base_) do { const char* cb_ = (base_); \
        { const bf16x8 a0 = GT_FRAG(cb_, ao0), a1 = GT_FRAG(cb_, ao0 + 4096), b0 = GT_FRAG(cb_, bo0), b1 = GT_FRAG(cb_, bo0 + 4096); \
          acc00 = MFMA32(a0, b0, acc00); acc01 = MFMA32(a0, b1, acc01); acc10 = MFMA32(a1, b0, acc10); acc11 = MFMA32(a1, b1, acc11); } \
        { const bf16x8 a0 = GT_FRAG(cb_, ao1), a1 = GT_FRAG(cb_, ao1 + 4096), b0 = GT_FRAG(cb_, bo1), b1 = GT_FRAG(cb_, bo1 + 4096); \
          acc00 = MFMA32(a0, b0, acc00); acc01 = MFMA32(a0, b1, acc01); acc10 = MFMA32(a1, b0, acc10); acc11 = MFMA32(a1, b1, acc11); } \
        { const bf16x8 a0 = GT_FRAG(cb_, ao2), a1 = GT_FRAG(cb_, ao2 + 4096), b0 = GT_FRAG(cb_, bo2), b1 = GT_FRAG(cb_, bo2 + 4096); \
          acc00 = MFMA32(a0, b0, acc00); acc01 = MFMA32(a0, b1, acc01); acc10 = MFMA32(a1, b0, acc10); acc11 = MFMA32(a1, b1, acc11); } \
        { const bf16x8 a0 = GT_FRAG(cb_, ao3), a1 = GT_FRAG(cb_, ao3 + 4096), b0 = GT_FRAG(cb_, bo3), b1 = GT_FRAG(cb_, bo3 + 4096); \
          acc00 = MFMA32(a0, b0, acc00); acc01 = MFMA32(a0, b1, acc01); acc10 = MFMA32(a1, b0, acc10); acc11 = MFMA32(a1, b1, acc11); } } while (0)
    const int ln = lane & 31, hf = lane >> 5, sw = (ln >> 1) & 7;
    int ao0 = wr * 8192 + ln * 128 + ((0 + hf) ^ sw) * 16, ao1 = wr * 8192 + ln * 128 + ((2 + hf) ^ sw) * 16;
    int ao2 = wr * 8192 + ln * 128 + ((4 + hf) ^ sw) * 16, ao3 = wr * 8192 + ln * 128 + ((6 + hf) ^ sw) * 16;
    int bo0 = G4_TILE + wc * 8192 + ln * 128 + ((0 + hf) ^ sw) * 16, bo1 = G4_TILE + wc * 8192 + ln * 128 + ((2 + hf) ^ sw) * 16;
    int bo2 = G4_TILE + wc * 8192 + ln * 128 + ((4 + hf) ^ sw) * 16, bo3 = G4_TILE + wc * 8192 + ln * 128 + ((6 + hf) ^ sw) * 16;
    asm volatile("" : "+v"(ao0), "+v"(ao1), "+v"(ao2), "+v"(ao3), "+v"(bo0), "+v"(bo1), "+v"(bo2), "+v"(bo3));
    GT_DMA(0, lds);
    asm volatile("s_waitcnt vmcnt(0)" ::: "memory");
    g4_bar(G);
    int buf = 0;
#pragma unroll 1
    for (int kt = 0; kt < nk - 1; ++kt) {
        GT_DMA(kt + 1, lds + (buf ^ 1) * (2 * G4_TILE));
        GT_COMPUTE(lds + buf * (2 * G4_TILE));
        asm volatile("s_waitcnt vmcnt(0)" ::: "memory");
        g4_bar(G);
        buf ^= 1;
    }
    GT_COMPUTE(lds + buf * (2 * G4_TILE));
    g4_bar(G);
#undef GT_DMA
#undef GT_FRAG
#undef GT_COMPUTE
    float* stg = (float*)lds;
    int w_off = (wr * 64 + 4 * (lane >> 5)) * STG_LD + wc * 64 + (lane & 31);
    asm volatile("" : "+v"(w_off));
#pragma unroll
    for (int r = 0; r < 16; ++r) {
        const int ro = ((r & 3) + 8 * (r >> 2)) * STG_LD;
        stg[w_off + ro] = acc00[r];
        stg[w_off + ro + 32] = acc01[r];
        stg[w_off + ro + 32 * STG_LD] = acc10[r];
        stg[w_off + ro + 32 * STG_LD + 32] = acc11[r];
    }
    g4_bar(G);
    epi((const float*)stg);
    g4_bar(G);
}

DI void g4_attn_item(const G4& G, char* lds, const Ctx& P, int b, int h, int qt, float lam, float lam_init, const float* subln) {
    const bfr* qn = (const bfr*)(P.ws + OFF_QN);
    const bfr* kn = (const bfr*)(P.ws + OFF_KN);
    const bfr* vT = (const bfr*)(P.ws + OFF_VT) + (size_t)(b * 4 + h) * 128 * SEQ;
    bfr* am = (bfr*)(P.ws + OFF_AMIX);
    const int tid = G.tid, lane = tid & 63, wave = tid >> 6;
    const int m = wave >> 1, qw = (wave & 1) * 32;
    const int q0 = qt * 64 + qw;
    const int ln = lane & 31, hf = lane >> 5;
    bf16x8 qf[4];
    {
        const bfr* qp = qn + ((size_t)b * SEQ + q0 + ln) * 512 + h * 128 + m * 64 + hf * 8;
#pragma unroll
        for (int ks = 0; ks < 4; ++ks) qf[ks] = *(const bf16x8*)(qp + ks * 16);
    }
    f32x16 o[4];
#pragma unroll
    for (int d = 0; d < 4; ++d)
#pragma unroll
        for (int r = 0; r < 16; ++r) o[d][r] = 0.f;
    float mrun = -INFINITY, lrun = 0.f;
    const int nkt = qt + 1;
    const int lrow = tid >> 3, lcol = (tid & 7) * 8;
    const bfr* kbase = kn + ((size_t)b * SEQ) * 512 + h * 128;
    unsigned ko = (unsigned)(lrow * 512 + lcol) * 2u, vo = (unsigned)(lrow * SEQ + lcol) * 2u;
    asm volatile("" : "+v"(ko), "+v"(vo));
    uint4 rk0, rk1, rk2, rk3, rv0, rv1, rv2, rv3;
#define ATT_GLOAD(kt_) do { const char* kp_ = (const char*)(kbase + (size_t)(kt_) * (64 * 512)); const char* vp_ = (const char*)(vT + (kt_) * 64); \
        rk0 = *(const uint4*)(kp_ + ko); rk1 = *(const uint4*)(kp_ + 32 * 512 * 2 + ko); rk2 = *(const uint4*)(kp_ + 64 * 2 + ko); rk3 = *(const uint4*)(kp_ + 32 * 512 * 2 + 64 * 2 + ko); \
        rv0 = *(const uint4*)(vp_ + vo); rv1 = *(const uint4*)(vp_ + 32 * SEQ * 2 + vo); rv2 = *(const uint4*)(vp_ + 64 * SEQ * 2 + vo); rv3 = *(const uint4*)(vp_ + 96 * SEQ * 2 + vo); } while (0)
#define ATT_S1(base_, i_, RK, RV) { *(uint4*)((base_) + (32 * (i_)) * LDA * 2) = RK; \
        *(uint4*)((base_) + TILE_B + (32 * (i_)) * LDA * 2) = RV; }
#define ATT_LSTORE(buf_) do { char* base_ = lds + (buf_) * (2 * TILE_B) + s_off; ATT_S1(base_, 0, rk0, rv0) ATT_S1(base_, 1, rk1, rv1) ATT_S1(base_, 2, rk2, rv2) ATT_S1(base_, 3, rk3, rv3) } while (0)
    int k_off = ((m * 64 + ln) * LDA + hf * 8) * 2;
    int v_off = TILE_B + (ln * LDA + 4 * hf) * 2;
    int s_off = (lrow * LDA + lcol) * 2;
    asm volatile("" : "+v"(k_off), "+v"(v_off), "+v"(s_off));
    ATT_GLOAD(0); ATT_LSTORE(0);
    g4_bar(G);
    int buf = 0;
#pragma unroll 1
    for (int kt = 0; kt < nkt; ++kt) {
        const bool more = (kt + 1 < nkt);
        const char* ks_ = lds + buf * (2 * TILE_B) + k_off;
        const char* vs_ = lds + buf * (2 * TILE_B) + v_off;
        if (kt * 64 <= q0 + 31) {
            f32x16 s[2];
#pragma unroll
            for (int kb = 0; kb < 2; ++kb) {
#pragma unroll
                for (int r = 0; r < 16; ++r) s[kb][r] = 0.f;
#pragma unroll
                for (int ks = 0; ks < 4; ++ks) {
                    const bf16x8 kf = *(const bf16x8*)(ks_ + ((kb * 32) * LDA + ks * 16) * 2);
                    s[kb] = MFMA32(kf, qf[ks], s[kb]);
                }
            }
            const int qpos = q0 + ln;
            if (kt * 64 + 63 > q0) {
#pragma unroll
                for (int kb = 0; kb < 2; ++kb)
#pragma unroll
                    for (int r = 0; r < 16; ++r) {
                        const int key = kt * 64 + kb * 32 + (r & 3) + 8 * (r >> 2) + 4 * hf;
                        if (key > qpos) s[kb][r] = -INFINITY;
                    }
            }
            float mx = s[0][0];
#pragma unroll
            for (int kb = 0; kb < 2; ++kb)
#pragma unroll
                for (int r = 0; r < 16; ++r) mx = fmaxf(mx, s[kb][r]);
            mx = fmaxf(mx, __shfl_xor(mx, 32));
            const float mnew = fmaxf(mrun, mx);
            const float alpha = __builtin_amdgcn_exp2f(mrun - mnew);
            mrun = mnew;
            float rsum = 0.f;
#pragma unroll
            for (int kb = 0; kb < 2; ++kb)
#pragma unroll
                for (int r = 0; r < 16; ++r) { const float p = __builtin_amdgcn_exp2f(s[kb][r] - mnew); s[kb][r] = p; rsum += p; }
            lrun = lrun * alpha + rsum;
#pragma unroll
            for (int d = 0; d < 4; ++d)
#pragma unroll
                for (int r = 0; r < 16; ++r) o[d][r] *= alpha;
            __builtin_amdgcn_sched_barrier(0);
            if (more) ATT_GLOAD(kt + 1);
#pragma unroll
            for (int kb = 0; kb < 2; ++kb)
#pragma unroll
                for (int st = 0; st < 2; ++st) {
                    const uint4 pp = make_uint4(pk2(s[kb][8 * st + 0], s[kb][8 * st + 1]), pk2(s[kb][8 * st + 2], s[kb][8 * st + 3]),
                                                pk2(s[kb][8 * st + 4], s[kb][8 * st + 5]), pk2(s[kb][8 * st + 6], s[kb][8 * st + 7]));
                    const bf16x8 pf = __builtin_bit_cast(bf16x8, pp);
                    const int kc = kb * 32 + 16 * st;
#pragma unroll
                    for (int d = 0; d < 4; ++d) {
                        const uint2 v0 = *(const uint2*)(vs_ + ((d * 32) * LDA + kc) * 2);
                        const uint2 v1 = *(const uint2*)(vs_ + ((d * 32) * LDA + kc + 8) * 2);
                        const bf16x8 vf = __builtin_bit_cast(bf16x8, make_uint4(v0.x, v0.y, v1.x, v1.y));
                        o[d] = MFMA32(vf, pf, o[d]);
                    }
                }
        }
        else if (more) ATT_GLOAD(kt + 1);
        if (more) ATT_LSTORE(buf ^ 1);
        g4_bar(G);
        buf ^= 1;
    }
    const float ltot = lrun + __shfl_xor(lrun, 32);
    const float linv = 1.0f / ltot;
    float* ob = (float*)lds;
    int o_off = (m * 64 + qw + ln) * 129 + 4 * hf;
    asm volatile("" : "+v"(o_off));
#pragma unroll
    for (int d = 0; d < 4; ++d)
#pragma unroll
        for (int r = 0; r < 16; ++r) ob[o_off + d * 32 + (r & 3) + 8 * (r >> 2)] = o[d][r] * linv;
    g4_bar(G);
#pragma unroll
    for (int it = 0; it < 4; ++it) {
        const int idx = it * 256 + tid;
        const int q = idx >> 4, c0 = (idx & 15) * 8;
        float v[8];
        float ss = 0.f;
        int r_off = q * 129 + c0;
        asm volatile("" : "+v"(r_off));
#pragma unroll
        for (int j = 0; j < 8; ++j) { v[j] = ob[r_off + j] - lam * ob[r_off + 64 * 129 + j]; ss += v[j] * v[j]; }
        ss = row16_sum(ss);
        const float rs = rsqrtf(ss * (1.0f / 128.0f) + 1e-5f) * (1.0f - lam_init);
#pragma unroll
        for (int j = 0; j < 8; ++j) v[j] = v[j] * rs * subln[c0 + j];
        *(uint4*)(am + ((size_t)b * SEQ + qt * 64 + q) * 1024 + h * 128 + c0) = pack8(v);
    }
    g4_bar(G);
}

#undef ATT_GLOAD
#undef ATT_S1
#undef ATT_LSTORE
#undef ATT_OFF
#undef ATT_G1
DI int cvt_rowmap(int n, int mode) { return mode == 0 ? n : ((n >> 2) * 8 + (n & 3) + (mode == 2 ? 4 : 0)); }
DI void cvt_tile(char* lds, const float* __restrict__ src, int N, bfr* __restrict__ dst, int ldd, int k0, int n0, int mode) {
    float* t = (float*)lds;
    const int tid = ltid();
    const int r = tid >> 5, c = (tid & 31) * 4;
#pragma unroll
    for (int i = 0; i < 4; ++i) {
        const float4 v = *(const float4*)(src + (size_t)(k0 + r + 16 * i) * N + n0 + c);
        float* d = t + (r + 16 * i) * 129 + c;
        d[0] = v.x; d[1] = v.y; d[2] = v.z; d[3] = v.w;
    }
    __syncthreads();
#pragma unroll
    for (int i = 0; i < 2; ++i) {
        const int idx = tid + i * NTHREADS;
        const int n = idx & 127, kg = idx >> 7;
        float v[8];
#pragma unroll
        for (int j = 0; j < 8; ++j) v[j] = t[(kg * 8 + j) * 129 + n];
        *(uint4*)(dst + (size_t)cvt_rowmap(n0 + n, mode) * ldd + k0 + kg * 8) = pack8(v);
    }
    __syncthreads();
}
DI void cvt_matrix(char* lds, const float* src, int K, int N, bfr* dst, int ldd, int mode, int worker, int nworkers, unsigned& base) {
    if (worker < 0) return;
    const int ntn = N >> 7, ntiles = (K >> 6) * ntn;
    int t0 = (int)(((unsigned)worker + (unsigned)nworkers - (base % (unsigned)nworkers)) % (unsigned)nworkers);
    for (int t = t0; t < ntiles; t += nworkers) cvt_tile(lds, src, N, dst, ldd, (t / ntn) * 64, (t % ntn) * 128, mode);
    base += (unsigned)ntiles;
}
DI void moe_convert(char* lds, const Ctx& P, int layer, int worker, int nworkers) {
    unsigned base = 0;
    bfr* wgu = (bfr*)(P.ws + OFF_MWGU); bfr* wd = (bfr*)(P.ws + OFF_MWD);
    for (int e = 0; e < 32; ++e) {
        const size_t we = (size_t)(layer * 32 + e);
        cvt_matrix(lds, P.in[I_MWGATE] + we * 1024 * 512, 1024, 512, wgu + (size_t)e * 1024 * 1024, 1024, 1, worker, nworkers, base);
        cvt_matrix(lds, P.in[I_MWUP]   + we * 1024 * 512, 1024, 512, wgu + (size_t)e * 1024 * 1024, 1024, 2, worker, nworkers, base);
        cvt_matrix(lds, P.in[I_MWDOWN] + we * 512 * 1024, 512, 1024, wd  + (size_t)e * 1024 * 512,  512,  0, worker, nworkers, base);
    }
}

DI void s5_tables(char* lds, const Ctx& P, int i, int g) {
    float2* pw = (float2*)lds;
    float2* bb = pw + 64 * 33;
    float2* cm = bb + 64 * 16;
    float*  kt = (float*)(cm + 16 * 64);
    const int tid = ltid();
    const size_t gp = (size_t)(i * 32 + g) * 64;
    for (int idx = tid; idx < 64 * 33; idx += NTHREADS) {
        const int p = idx / 33, tau = idx % 33;
        const float re = fminf(P.in[I_ARE][gp + p], -1e-4f), im = P.in[I_AIM][gp + p];
        const float st = expf(P.in[I_LSTEP][gp + p]);
        const float mag = expf(re * st * (float)tau);
        const double angd = (double)im * (double)st * (double)tau;
        const double red = angd - 6.283185307179586 * floor(angd * 0.15915494309189535);
        float sn, cs; sincosf((float)red, &sn, &cs);
        pw[idx] = make_float2(mag * cs, mag * sn);
    }
    for (int idx = tid; idx < 64 * 16; idx += NTHREADS) {
        const int p = idx >> 4, c = idx & 15;
        const double re = fmin((double)P.in[I_ARE][gp + p], -1e-4), im = (double)P.in[I_AIM][gp + p];
        const double st = exp((double)P.in[I_LSTEP][gp + p]);
        const double mag = exp(re * st), lr = mag * cos(im * st) - 1.0, li = mag * sin(im * st);
        const double den = re * re + im * im;
        const double fr = (lr * re + li * im) / den, fi = (li * re - lr * im) / den;
        const double br = (double)P.in[I_BRE][(gp + p) * 16 + c], bi = (double)P.in[I_BIM][(gp + p) * 16 + c];
        bb[idx] = make_float2((float)(fr * br - fi * bi), (float)(fr * bi + fi * br));
        const int cc = idx >> 6, pp = idx & 63;
        cm[idx] = make_float2(P.in[I_CRE][((size_t)(i * 32 + g) * 16 + cc) * 64 + pp], P.in[I_CIM][((size_t)(i * 32 + g) * 16 + cc) * 64 + pp]);
    }
    __syncthreads();
    for (int idx = tid; idx < 32 * 256; idx += NTHREADS) {
        const int tau = idx >> 8, c1 = (idx >> 4) & 15, c = idx & 15;
        float s = 0.f;
        for (int p = 0; p < 64; ++p) {
            const float2 a = cm[c1 * 64 + p], w = pw[p * 33 + tau], b = bb[p * 16 + c];
            const float tr = a.x * w.x - a.y * w.y, ti = a.x * w.y + a.y * w.x;
            s += tr * b.x - ti * b.y;
        }
        kt[idx] = s;
    }
    __syncthreads();
    bfr* gt = (bfr*)(P.ws + OFF_S5GT) + (size_t)(i * 32 + g) * 512 * 640;
    for (int idx = tid; idx < 512 * 80; idx += NTHREADS) {
        const int n = idx / 80, ch = idx % 80;
        const int t = n >> 4, c1 = n & 15;
        float v[8];
        if (ch < 64) {
            const int s = ch >> 1, c0 = (ch & 1) * 8;
#pragma unroll
            for (int j = 0; j < 8; ++j) v[j] = (t >= s) ? kt[((t - s) * 16 + c1) * 16 + c0 + j] : 0.f;
        } else {
            const int p0 = (ch - 64) * 4;
#pragma unroll
            for (int j = 0; j < 4; ++j) {
                const float2 a = cm[c1 * 64 + p0 + j], w = pw[(p0 + j) * 33 + t + 1];
                v[2 * j] = a.x * w.x - a.y * w.y;
                v[2 * j + 1] = -(a.x * w.y + a.y * w.x);
            }
        }
        *(uint4*)(gt + (size_t)n * 640 + ch * 8) = pack8(v);
    }
    bfr* bl = (bfr*)(P.ws + OFF_S5BL) + (size_t)(i * 32 + g) * 128 * 512;
    for (int idx = tid; idx < 128 * 64; idx += NTHREADS) {
        const int n = idx >> 6, ch = idx & 63;
        const int p = n >> 1, ri = n & 1, s = ch >> 1, c0 = (ch & 1) * 8;
        const float2 w = pw[p * 33 + 31 - s];
        float v[8];
#pragma unroll
        for (int j = 0; j < 8; ++j) { const float2 b = bb[p * 16 + c0 + j]; v[j] = ri ? (w.x * b.y + w.y * b.x) : (w.x * b.x - w.y * b.y); }
        *(uint4*)(bl + (size_t)n * 512 + ch * 8) = pack8(v);
    }
    float* l32 = (float*)(P.ws + OFF_S5L32) + (size_t)(i * 32 + g) * 128;
    if (tid < 64) { l32[2 * tid] = pw[tid * 33 + 32].x; l32[2 * tid + 1] = pw[tid * 33 + 32].y; }
    __syncthreads();
}

DI void norm_rows(const float* __restrict__ x, const float* __restrict__ g, bfr* __restrict__ hb, bfr* __restrict__ hlo, float* __restrict__ xcopy, int tok0, int ntok) {
    const int tid_ = ltid();
    const int lane = tid_ & 63, wave = tid_ >> 6;
    for (int tk = wave; tk < ntok; tk += NWAVES) {
        const size_t tok = (size_t)(tok0 + tk);
        float4 v[4];
        float ss = 0.f;
#pragma unroll
        for (int i = 0; i < 4; ++i) {
            v[i] = *(const float4*)(x + tok * DM + i * 256 + lane * 4);
            ss += v[i].x * v[i].x + v[i].y * v[i].y + v[i].z * v[i].z + v[i].w * v[i].w;
        }
        ss = wave_sum(ss);
        const float rs = rsqrtf(ss * (1.0f / DM) + 1e-6f);
#pragma unroll
        for (int i = 0; i < 4; ++i) {
            const float4 gg = *(const float4*)(g + i * 256 + lane * 4);
            const float h0 = v[i].x * rs * gg.x, h1 = v[i].y * rs * gg.y, h2 = v[i].z * rs * gg.z, h3 = v[i].w * rs * gg.w;
            const unsigned p0 = pk2(h0, h1), p1 = pk2(h2, h3);
            *(uint2*)(hb + tok * DM + i * 256 + lane * 4) = make_uint2(p0, p1);
            if (hlo) {
                const unsigned q0 = pk2(h0 - bflo(p0), h1 - bfhi(p0)), q1 = pk2(h2 - bflo(p1), h3 - bfhi(p1));
                *(uint2*)(hlo + tok * DM + i * 256 + lane * 4) = make_uint2(q0, q1);
            }
            if (xcopy) *(float4*)(xcopy + tok * DM + i * 256 + lane * 4) = v[i];
        }
    }
}
DI void phase_e1(char* lds, const Ctx& P, int li) {
    const bfr* hb = (const bfr*)(P.ws + OFF_HB);
    const bfr* w = (const bfr*)(P.ws + OFF_WINE) + (size_t)li * 2304 * 1024;
    bfr* u = (bfr*)(P.ws + OFF_U);
    for (int t = blockIdx.x; t < 128 * 9; t += gridDim.x) {
        int mt, nt; tile_remap(t, 128, 9, mt, nt);
        RowLoader A(hb, mt * 256, 1024), B(w, nt * 256, 1024);
        GEMM256(lds, 16, A, B, [&](const float* stg, int p) __attribute__((always_inline)) {
            epi_rows8(stg, [&](int r, int c0, const float (&v)[8]) __attribute__((always_inline)) {
                *(uint4*)(u + (size_t)(mt * 256 + r) * EVEN_IN + nt * 256 + p * 128 + c0) = pack8(v);
            });
        });
    }
}

DI void phase_e2a(const Ctx& P, int li) {
    const bfr* u = (const bfr*)(P.ws + OFF_U);
    const float* mu = P.in[I_MU] + (size_t)li * 1792;
    bfr* S = (bfr*)(P.ws + OFF_S);
    bfr* mv = (bfr*)(P.ws + (li == 0 ? OFF_VFIRST : OFF_MV2));
    bfr* dpool = (bfr*)(P.ws + OFF_DPOOL);
    const int total = NTOK * 160;
    for (int idx = blockIdx.x * NTHREADS + ltid(); idx < total; idx += gridDim.x * NTHREADS) {
        const int tok = idx / 160, ch = idx % 160;
        const int col = 1024 + ch * 8;
        const int t = tok & (SEQ - 1);
        const bfr* row = u + (size_t)tok * EVEN_IN;
        float cur[8];
        unpack8(*(const uint4*)(row + col), cur);
        if (col < 1792) {
            float prv[8], m[8];
            if (t > 0) unpack8(*(const uint4*)(row - EVEN_IN + col), prv);
            else {
#pragma unroll
                for (int j = 0; j < 8; ++j) prv[j] = 0.f;
            }
            const float4 m0 = *(const float4*)(mu + col), m1 = *(const float4*)(mu + col + 4);
            const float mm[8] = {m0.x, m0.y, m0.z, m0.w, m1.x, m1.y, m1.z, m1.w};
#pragma unroll
            for (int j = 0; j < 8; ++j) m[j] = cur[j] + (prv[j] - cur[j]) * mm[j];
            if (col < 1536) {
                *(uint4*)(mv + (size_t)tok * 512 + (col - 1024)) = pack8(m);
            } else if (col < 1600) {
#pragma unroll
                for (int j = 0; j < 8; ++j) m[j] = ftanh(m[j]);
                *(uint4*)(S + (size_t)tok * 256 + (col - 1536)) = pack8(m);
            } else if (col < 1664) {
                *(uint4*)(S + (size_t)tok * 256 + 64 + (col - 1600)) = pack8(m);
            } else {
#pragma unroll
                for (int j = 0; j < 8; ++j) m[j] = sigmoidf_(m[j]);
                *(uint4*)(S + (size_t)tok * 256 + 128 + (col - 1664)) = pack8(m);
            }
        } else {
            const int gi = (col - 1792) >> 7;
            const int win = 2 << gi;
            const int nw = (t + 1 < win) ? (t + 1) : win;
            float acc[8];
#pragma unroll
            for (int j = 0; j < 8; ++j) acc[j] = cur[j];
#define POOL_WIN(W) { uint4 pv[W - 1]; _Pragma("unroll") for (int s = 1; s < W; ++s) pv[s - 1] = *(const uint4*)(row - (size_t)(s < nw ? s : 0) * EVEN_IN + col); \
                      _Pragma("unroll") for (int s = 1; s < W; ++s) { float pq[8]; unpack8(pv[s - 1], pq); const float wgt = s < nw ? 1.f : 0.f; \
                          _Pragma("unroll") for (int j = 0; j < 8; ++j) acc[j] += wgt * pq[j]; } }
            if (gi == 0) POOL_WIN(2) else if (gi == 1) POOL_WIN(4) else if (gi == 2) POOL_WIN(8) else POOL_WIN(16)
#undef POOL_WIN
            const float inv = frcp((float)nw);
#pragma unroll
            for (int j = 0; j < 8; ++j) acc[j] = acc[j] * inv - cur[j];
            *(uint4*)(dpool + (size_t)tok * 512 + (col - 1792)) = pack8(acc);
        }
    }
}

DI void phase_e2b(char* lds, const Ctx& P, int li) {
    const bfr* S = (const bfr*)(P.ws + OFF_S);
    const int njobs = (li == 1) ? 20 : 16;
    for (int t = blockIdx.x; t < 128 * njobs; t += gridDim.x) {
        const int mt = t / njobs, j = t % njobs;
        const int job = j >> 2, nt = j & 3;
        const int m0 = mt * 256;
        if (job == 0) {
            RowLoader A(S, m0, 256), B((const bfr*)(P.ws + OFF_W2T) + (size_t)li * 512 * 64, nt * 128, 64);
            const float* w0 = P.in[I_W0] + li * 512;
            float* dlog = (float*)(P.ws + OFF_DLOG);
            GEMM128(lds, 1, A, B, [&](const float* stg, int) __attribute__((always_inline)) {
                epi_rows8(stg, [&](int r, int c0, const float (&v)[8]) __attribute__((always_inline)) {
                    float o[8];
#pragma unroll
                    for (int q = 0; q < 8; ++q) {
                        const float z = -(w0[nt * 128 + c0 + q] + v[q]);
                        o[q] = -fexp(-fsoftplus(z) - 0.5f);
                    }
                    float* d = dlog + (size_t)(m0 + r) * 512 + nt * 128 + c0;
                    *(float4*)d = make_float4(o[0], o[1], o[2], o[3]); *(float4*)(d + 4) = make_float4(o[4], o[5], o[6], o[7]);
                });
            });
        } else if (job == 1) {
            RowLoader A(S + 64, m0, 256), B((const bfr*)(P.ws + OFF_A2T) + (size_t)li * 512 * 64, nt * 128, 64);
            const float* a0 = P.in[I_A0] + li * 512;
            bfr* ab = (bfr*)(P.ws + OFF_ABUF);
            GEMM128(lds, 1, A, B, [&](const float* stg, int) __attribute__((always_inline)) {
                epi_rows8(stg, [&](int r, int c0, const float (&v)[8]) __attribute__((always_inline)) {
                    float o[8];
#pragma unroll
                    for (int q = 0; q < 8; ++q) o[q] = sigmoidf_(a0[nt * 128 + c0 + q] + v[q]);
                    *(uint4*)(ab + (size_t)(m0 + r) * 512 + nt * 128 + c0) = pack8(o);
                });
            });
        } else if (job == 2) {
            RowLoader A(S + 128, m0, 256), B((const bfr*)(P.ws + OFF_G2T) + (size_t)li * 512 * 128, nt * 128, 128);
            bfr* gb = (bfr*)(P.ws + OFF_GBUF);
            GEMM128(lds, 2, A, B, [&](const float* stg, int) __attribute__((always_inline)) {
                epi_rows8(stg, [&](int r, int c0, const float (&v)[8]) __attribute__((always_inline)) {
                    *(uint4*)(gb + (size_t)(m0 + r) * 512 + nt * 128 + c0) = pack8(v);
                });
            });
        } else if (job == 3) {
            RowLoader A((const bfr*)(P.ws + OFF_DPOOL) + nt * 128, m0, 512), B((const bfr*)(P.ws + OFF_POOLT) + (size_t)(li * 4 + nt) * 128 * 128, 0, 128);
            const float* ps = P.in[I_POOLS] + li * 512 + nt * 128;
            bfr* am = (bfr*)(P.ws + OFF_AMIX);
            GEMM128(lds, 2, A, B, [&](const float* stg, int) __attribute__((always_inline)) {
                epi_rows8(stg, [&](int r, int c0, const float (&v)[8]) __attribute__((always_inline)) {
                    float o[8];
#pragma unroll
                    for (int q = 0; q < 8; ++q) o[q] = v[q] * ps[c0 + q];
                    *(uint4*)(am + (size_t)(m0 + r) * 1024 + 512 + nt * 128 + c0) = pack8(o);
                });
            });
        } else {
            RowLoader A((const bfr*)(P.ws + OFF_MV2), m0, 512), B((const bfr*)(P.ws + OFF_V12T), nt * 128, 512);
            const float* v0 = P.in[I_V0];
            bfr* vg = (bfr*)(P.ws + OFF_VGATE);
            GEMM128(lds, 8, A, B, [&](const float* stg, int) __attribute__((always_inline)) {
                epi_rows8(stg, [&](int r, int c0, const float (&v)[8]) __attribute__((always_inline)) {
                    float o[8];
#pragma unroll
                    for (int q = 0; q < 8; ++q) o[q] = sigmoidf_(v0[nt * 128 + c0 + q] + v[q]);
                    *(uint4*)(vg + (size_t)(m0 + r) * 512 + nt * 128 + c0) = pack8(o);
                });
            });
        }
    }
}

constexpr int RW_TC = 32;
constexpr int RW_ROWS = 32;
constexpr int RW_BUF = (5 * RW_TC * 64 + RW_TC * RW_ROWS + RW_TC * RW_ROWS) * 4;
DI void phase_e3(char* lds, const Ctx& P, int li, int probe = 0) {
    const bfr* u = (const bfr*)(P.ws + OFF_U);
    const float* mu = P.in[I_MU] + (size_t)li * 1792;
    const float* dlog = (const float*)(P.ws + OFF_DLOG);
    const bfr* ab = (const bfr*)(P.ws + OFF_ABUF);
    const bfr* vg = (const bfr*)(P.ws + OFF_VGATE);
    const bfr* vf = (const bfr*)(P.ws + OFF_VFIRST);
    float* yout = (float*)(P.ws + (probe ? OFF_HID : OFF_Y));
    float* bonus = (float*)(P.ws + (probe ? OFF_HID : OFF_BONUS));
    const int tid = ltid(), lane = tid & 63, wave = tid >> 6;
    const int pstep = tid >> 4, pc0 = (tid & 15) * 4;
    for (int item = blockIdx.x; item < 256; item += gridDim.x) {
        const int bh = item >> 1, qtr = item & 1;
        const int b = bh >> 3, h = bh & 7;
        const int i0 = qtr * RW_ROWS;
        float c_mur[4], c_muk[4], c_muv[4], c_kk[4], c_ka[4], c_rk[4];
#pragma unroll
        for (int j = 0; j < 4; ++j) {
            const int c = h * 64 + pc0 + j;
            c_mur[j] = mu[c]; c_muk[j] = mu[512 + c]; c_muv[j] = mu[1024 + c];
            c_kk[j] = P.in[I_KK][li * 512 + c]; c_ka[j] = P.in[I_KA][li * 512 + c]; c_rk[j] = P.in[I_RK][li * 512 + c];
        }
        float S0 = 0.f, S1 = 0.f, S2 = 0.f, S3 = 0.f;
        const int rloc = wave * 4 + (lane >> 4);
        const int j0 = (lane & 15) * 4;
        const bool mine = ((pc0 >> 5) == qtr);
        uint2 g_ur, g_uk, g_uv, g_pr, g_pk, g_pv, g_a, g_vg, g_vf; float4 g_d;
#define E3_GLOAD(c_) do { const int t_ = (c_) * RW_TC + pstep; const size_t tok_ = (size_t)b * SEQ + t_; \
            const bfr* row_ = u + tok_ * EVEN_IN + h * 64 + pc0; const bfr* prow_ = row_ - (t_ > 0 ? EVEN_IN : 0); \
            g_ur = *(const uint2*)(row_); g_uk = *(const uint2*)(row_ + 512); g_uv = *(const uint2*)(row_ + 1024); \
            g_pr = *(const uint2*)(prow_); g_pk = *(const uint2*)(prow_ + 512); g_pv = *(const uint2*)(prow_ + 1024); \
            const size_t o_ = tok_ * 512 + h * 64 + pc0; \
            g_a = *(const uint2*)(ab + o_); g_d = *(const float4*)(dlog + o_); \
            if (li == 1) { g_vg = *(const uint2*)(vg + o_); g_vf = *(const uint2*)(vf + o_); } } while (0)
#define E3_PREP(c_, buf_) do { const int t_ = (c_) * RW_TC + pstep; const size_t o_ = ((size_t)b * SEQ + t_) * 512 + h * 64 + pc0; \
            float* sw_ = (float*)(lds + (buf_) * RW_BUF); float* sa_ = sw_ + RW_TC * 64; float* sb_ = sa_ + RW_TC * 64; float* sk_ = sb_ + RW_TC * 64; \
            float* sr_ = sk_ + RW_TC * 64; float* sv_ = sr_ + RW_TC * 64; \
            const float pz_ = t_ > 0 ? 1.f : 0.f; \
            const float ur_[4] = {bflo(g_ur.x), bfhi(g_ur.x), bflo(g_ur.y), bfhi(g_ur.y)}, uk_[4] = {bflo(g_uk.x), bfhi(g_uk.x), bflo(g_uk.y), bfhi(g_uk.y)}; \
            const float uv_[4] = {bflo(g_uv.x), bfhi(g_uv.x), bflo(g_uv.y), bfhi(g_uv.y)}; \
            const float pr_[4] = {bflo(g_pr.x), bfhi(g_pr.x), bflo(g_pr.y), bfhi(g_pr.y)}, pk_[4] = {bflo(g_pk.x), bfhi(g_pk.x), bflo(g_pk.y), bfhi(g_pk.y)}; \
            const float pv_[4] = {bflo(g_pv.x), bfhi(g_pv.x), bflo(g_pv.y), bfhi(g_pv.y)}; \
            const float av_[4] = {bflo(g_a.x), bfhi(g_a.x), bflo(g_a.y), bfhi(g_a.y)}; \
            const float dl_[4] = {g_d.x, g_d.y, g_d.z, g_d.w}; \
            float gv_[4] = {0.f, 0.f, 0.f, 0.f}, fv_[4] = {0.f, 0.f, 0.f, 0.f}; \
            if (li == 1) { gv_[0] = bflo(g_vg.x); gv_[1] = bfhi(g_vg.x); gv_[2] = bflo(g_vg.y); gv_[3] = bfhi(g_vg.y); \
                           fv_[0] = bflo(g_vf.x); fv_[1] = bfhi(g_vf.x); fv_[2] = bflo(g_vf.y); fv_[3] = bfhi(g_vf.y); } \
            float kkr_[4], kmod_[4], rr_[4], vv_[4]; float ssq_ = 0.f, bsum_ = 0.f; \
            _Pragma("unroll") for (int j = 0; j < 4; ++j) { \
                rr_[j] = ur_[j] + (pz_ * pr_[j] - ur_[j]) * c_mur[j]; \
                const float k_ = uk_[j] + (pz_ * pk_[j] - uk_[j]) * c_muk[j]; \
                float v_ = uv_[j] + (pz_ * pv_[j] - uv_[j]) * c_muv[j]; \
                if (li == 1) v_ = v_ + (fv_[j] - v_) * gv_[j]; \
                vv_[j] = v_; kkr_[j] = k_ * c_kk[j]; ssq_ += kkr_[j] * kkr_[j]; \
                kmod_[j] = k_ * (1.0f + (av_[j] - 1.0f) * c_ka[j]); bsum_ += rr_[j] * kmod_[j] * c_rk[j]; } \
            ssq_ = row16_sum(ssq_); bsum_ = row16_sum(bsum_); \
            const float inv_ = frcp(fmaxf(sqrtf(ssq_), 1e-12f)); \
            float4 w4_, a4_, b4_; \
            w4_.x = fexp(dl_[0]); w4_.y = fexp(dl_[1]); w4_.z = fexp(dl_[2]); w4_.w = fexp(dl_[3]); \
            a4_.x = -kkr_[0] * inv_; a4_.y = -kkr_[1] * inv_; a4_.z = -kkr_[2] * inv_; a4_.w = -kkr_[3] * inv_; \
            b4_.x = -a4_.x * av_[0]; b4_.y = -a4_.y * av_[1]; b4_.z = -a4_.z * av_[2]; b4_.w = -a4_.w * av_[3]; \
            *(float4*)(sw_ + pstep * 64 + pc0) = w4_; *(float4*)(sa_ + pstep * 64 + pc0) = a4_; *(float4*)(sb_ + pstep * 64 + pc0) = b4_; \
            *(float4*)(sk_ + pstep * 64 + pc0) = make_float4(kmod_[0], kmod_[1], kmod_[2], kmod_[3]); \
            *(float4*)(sr_ + pstep * 64 + pc0) = make_float4(rr_[0], rr_[1], rr_[2], rr_[3]); \
            if (mine) { *(float4*)(sv_ + pstep * RW_ROWS + (pc0 & 31)) = make_float4(vv_[0], vv_[1], vv_[2], vv_[3]); \
                        *(float4*)(bonus + o_) = make_float4(bsum_ * vv_[0], bsum_ * vv_[1], bsum_ * vv_[2], bsum_ * vv_[3]); } } while (0)
        __syncthreads();
        E3_GLOAD(0);
        E3_PREP(0, 0);
        __syncthreads();
        constexpr int NCH = SEQ / RW_TC;
#pragma unroll 1
        for (int c = 0; c < NCH; ++c) {
            const int buf = c & 1;
            if (c + 1 < NCH && probe != 2) E3_GLOAD(c + 1);
            if (probe != 1) {
                const float* s_w = (const float*)(lds + buf * RW_BUF); const float* s_a = s_w + RW_TC * 64; const float* s_b = s_a + RW_TC * 64;
                const float* s_k = s_b + RW_TC * 64; const float* s_r = s_k + RW_TC * 64; const float* s_v = s_r + RW_TC * 64;
                float* s_y = (float*)(s_v + RW_TC * RW_ROWS);
                float4 na4 = *(const float4*)(s_a + j0), nw4 = *(const float4*)(s_w + j0), nb4 = *(const float4*)(s_b + j0);
                float4 nk4 = *(const float4*)(s_k + j0), nr4 = *(const float4*)(s_r + j0);
                float nvi = s_v[rloc];
#pragma unroll 1
                for (int sg = 0; sg < RW_TC; sg += 4) {
                    float yv[4];
#pragma unroll
                    for (int q = 0; q < 4; ++q) {
                        const int sn = (sg + q + 1) & (RW_TC - 1);
                        const float4 a4 = na4, w4 = nw4, b4 = nb4, k4 = nk4, r4 = nr4; const float vi = nvi;
                        na4 = *(const float4*)(s_a + sn * 64 + j0); nw4 = *(const float4*)(s_w + sn * 64 + j0); nb4 = *(const float4*)(s_b + sn * 64 + j0);
                        nk4 = *(const float4*)(s_k + sn * 64 + j0); nr4 = *(const float4*)(s_r + sn * 64 + j0); nvi = s_v[sn * RW_ROWS + rloc];
                        float sa = dot4n(S0, S1, S2, S3, a4);
                        sa = row16_sum(sa);
                        rw_upd(S0, w4.x, sa, b4.x, vi, k4.x);
                        rw_upd(S1, w4.y, sa, b4.y, vi, k4.y);
                        rw_upd(S2, w4.z, sa, b4.z, vi, k4.z);
                        rw_upd(S3, w4.w, sa, b4.w, vi, k4.w);
                        const float y = dot4n(S0, S1, S2, S3, r4);
                        yv[q] = row16_sum(y);
                    }
                    const int ls = lane & 3;
                    const float yo = ls == 0 ? yv[0] : (ls == 1 ? yv[1] : (ls == 2 ? yv[2] : yv[3]));
                    if ((lane & 15) < 4) s_y[(sg + ls) * RW_ROWS + rloc] = yo;
                }
            }
            if (c + 1 < NCH && probe != 2) E3_PREP(c + 1, buf ^ 1);
            __syncthreads();
            {
                const float* s_y = (const float*)(lds + buf * RW_BUF) + 5 * RW_TC * 64 + RW_TC * RW_ROWS;
#pragma unroll
                for (int q = 0; q < RW_TC * RW_ROWS / NTHREADS; ++q) {
                    const int idx = q * NTHREADS + tid;
                    const int s = idx >> 5, r = idx & 31;
                    yout[((size_t)b * SEQ + c * RW_TC + s) * 512 + h * 64 + i0 + r] = s_y[idx];
                }
            }
        }
#undef E3_GLOAD
#undef E3_PREP
    }
}

DI void phase_e4(const Ctx& P, int li) {
    const float* y = (const float*)(P.ws + OFF_Y);
    const float* bonus = (const float*)(P.ws + OFF_BONUS);
    const bfr* gb = (const bfr*)(P.ws + OFF_GBUF);
    const float* lng = P.in[I_LNG] + li * 512;
    const float* lnb = P.in[I_LNB] + li * 512;
    bfr* am = (bfr*)(P.ws + OFF_AMIX);
    const int total = NTOK * 64;
    for (int idx = blockIdx.x * NTHREADS + ltid(); idx < total; idx += gridDim.x * NTHREADS) {
        const int tok = idx >> 6, c = (idx & 63) * 8;
        const size_t o = (size_t)tok * 512 + c;
        const float4 y0 = *(const float4*)(y + o), y1 = *(const float4*)(y + o + 4);
        float v[8] = {y0.x, y0.y, y0.z, y0.w, y1.x, y1.y, y1.z, y1.w};
        float s = 0.f;
#pragma unroll
        for (int j = 0; j < 8; ++j) s += v[j];
        s += __shfl_xor(s, 1); s += __shfl_xor(s, 2); s += __shfl_xor(s, 4);
        const float mean = s * (1.0f / 64.0f);
        float q = 0.f;
#pragma unroll
        for (int j = 0; j < 8; ++j) { v[j] -= mean; q += v[j] * v[j]; }
        q += __shfl_xor(q, 1); q += __shfl_xor(q, 2); q += __shfl_xor(q, 4);
        const float rstd = rsqrtf(q * (1.0f / 64.0f) + 64e-5f);
        const float4 b0 = *(const float4*)(bonus + o), b1 = *(const float4*)(bonus + o + 4);
        const float bo[8] = {b0.x, b0.y, b0.z, b0.w, b1.x, b1.y, b1.z, b1.w};
        float gv[8];
        unpack8(*(const uint4*)(gb + o), gv);
        float out[8];
#pragma unroll
        for (int j = 0; j < 8; ++j) out[j] = (v[j] * rstd * lng[c + j] + lnb[c + j] + bo[j]) * gv[j];
        *(uint4*)(am + (size_t)tok * 1024 + c) = pack8(out);
    }
}

DI void phase_wout(char* lds, const Ctx& P, const bfr* w, float* x) {
    const bfr* am = (const bfr*)(P.ws + OFF_AMIX);
    for (int t = blockIdx.x; t < 128 * 4; t += gridDim.x) {
        int mt, nt; tile_remap(t, 128, 4, mt, nt);
        RowLoader A(am, mt * 256, 1024), B(w, nt * 256, 1024);
        GEMM256(lds, 16, A, B, [&](const float* stg, int p) __attribute__((always_inline)) {
            epi_rows8_pre<F8>(stg,
                [&](int r, int c0) __attribute__((always_inline)) -> F8 {
                    const float* d = x + (size_t)(mt * 256 + r) * DM + nt * 256 + p * 128 + c0;
                    F8 o; o.a = *(const float4*)d; o.b = *(const float4*)(d + 4); return o; },
                [&](int r, int c0, const float (&v)[8], const F8& o) __attribute__((always_inline)) {
                    float* d = x + (size_t)(mt * 256 + r) * DM + nt * 256 + p * 128 + c0;
                    *(float4*)d = make_float4(o.a.x + v[0], o.a.y + v[1], o.a.z + v[2], o.a.w + v[3]);
                    *(float4*)(d + 4) = make_float4(o.b.x + v[4], o.b.y + v[5], o.b.z + v[6], o.b.w + v[7]);
                });
        });
    }
}
DI void phase_o1(char* lds, const Ctx& P, int li) {
    const bfr* hb = (const bfr*)(P.ws + OFF_HB);
    const bfr* w = (const bfr*)(P.ws + OFF_WINO) + (size_t)li * 2048 * 1024;
    bfr* qk = (bfr*)(P.ws + OFF_U);
    bfr* vT = (bfr*)(P.ws + OFF_VT);
    bfr* us5 = (bfr*)(P.ws + OFF_US5);
    for (int t = blockIdx.x; t < 128 * 8; t += gridDim.x) {
        int mt, nt; tile_remap(t, 128, 8, mt, nt);
        const int m0 = mt * 256;
        RowLoader A(hb, m0, 1024), B(w, nt * 256, 1024);
        GEMM256(lds, 16, A, B, [&](const float* stg, int p) __attribute__((always_inline)) {
            if (nt < 4) {
                epi_rows8(stg, [&](int r, int c0, const float (&v)[8]) __attribute__((always_inline)) {
                    *(uint4*)(qk + (size_t)(m0 + r) * 1024 + nt * 256 + p * 128 + c0) = pack8(v);
                });
            } else if (nt < 6) {
                const int b = m0 >> 11, tq = m0 & (SEQ - 1);
                bfr* dst = vT + ((size_t)(b * 4 + (nt - 4) * 2 + p) * 128) * SEQ + tq;
                const int tid0 = ltid();
#pragma unroll
                for (int it = 0; it < 8; ++it) {
                    const int idx = it * NTHREADS + tid0;
                    const int dv = idx & 127, rg = idx >> 7;
                    float v[8];
#pragma unroll
                    for (int j = 0; j < 8; ++j) v[j] = stg[(rg * 8 + j) * STG_LD + dv];
                    *(uint4*)(dst + (size_t)dv * SEQ + rg * 8) = pack8(v);
                }
            } else {
                epi_rows8(stg, [&](int r, int c0, const float (&v)[8]) __attribute__((always_inline)) {
                    const int cc = (nt - 6) * 256 + p * 128 + c0;
                    *(uint4*)(us5 + ((size_t)(cc >> 4) * NTOK + m0 + r) * 16 + (cc & 15)) = pack8(v);
                });
            }
        });
    }
}

DI void phase_o2(char* lds, const Ctx& P, int li) {
    const bfr* qk = (const bfr*)(P.ws + OFF_U);
    bfr* qn = (bfr*)(P.ws + OFF_QN);
    bfr* kn = (bfr*)(P.ws + OFF_KN);
    const float* gq = P.in[I_QN] + li * 64;
    const float* gk = P.in[I_KN] + li * 64;
    const bfr* us5 = (const bfr*)(P.ws + OFF_US5);
    const bfr* bl = (const bfr*)(P.ws + OFF_S5BL) + (size_t)li * 32 * 128 * 512;
    float* xloc = (float*)(P.ws + OFF_XLOC);
    for (int t = blockIdx.x; t < 128; t += gridDim.x) {
        const int g = t >> 2, mt = t & 3;
        RowLoader A(us5 + (size_t)g * NTOK * 16, mt * 256, 512), B(bl + (size_t)g * 128 * 512, 0, 512);
        GEMM128(lds, 8, A, B, [&](const float* stg, int) __attribute__((always_inline)) {
            epi_rows8(stg, [&](int r, int c0, const float (&v)[8]) __attribute__((always_inline)) {
                float* d = xloc + ((size_t)g * 1024 + mt * 256 + r) * 128 + c0;
                *(float4*)d = make_float4(v[0], v[1], v[2], v[3]); *(float4*)(d + 4) = make_float4(v[4], v[5], v[6], v[7]);
            });
        });
    }
    const int total = NTOK * 16 * 8;
    for (int idx = blockIdx.x * NTHREADS + ltid(); idx < total; idx += gridDim.x * NTHREADS) {
        const int l8 = idx & 7, item = idx >> 3;
        const int hm = item & 7, which = (item >> 3) & 1, tok = item >> 4;
        const int d0 = l8 * 4;
        const bfr* src = qk + (size_t)tok * 1024 + which * 512 + hm * 64;
        const uint2 ua = *(const uint2*)(src + d0), ub = *(const uint2*)(src + 32 + d0);
        float x1[4] = {bflo(ua.x), bfhi(ua.x), bflo(ua.y), bfhi(ua.y)};
        float x2[4] = {bflo(ub.x), bfhi(ub.x), bflo(ub.y), bfhi(ub.y)};
        float ss = 0.f;
#pragma unroll
        for (int j = 0; j < 4; ++j) ss += x1[j] * x1[j] + x2[j] * x2[j];
        ss += __shfl_xor(ss, 1); ss += __shfl_xor(ss, 2); ss += __shfl_xor(ss, 4);
        const float rs = rsqrtf(ss * (1.0f / 64.0f) + 1e-6f);
        const float* gg = which ? gk : gq;
        const float scl = which ? 1.0f : (0.125f * 1.4426950408889634f);
        const int t = tok & (SEQ - 1);
        float o1[4], o2[4];
#pragma unroll
        for (int j = 0; j < 4; ++j) {
            const int i = d0 + j;
            const float invf = exp2f(-(float)i * (13.287712379549449f / 32.0f));
            const float ang = (float)t * invf;
            float sn, cs;
            sincosf(ang, &sn, &cs);
            const float a = x1[j] * rs * gg[i], b2 = x2[j] * rs * gg[32 + i];
            o1[j] = (a * cs - b2 * sn) * scl;
            o2[j] = (b2 * cs + a * sn) * scl;
        }
        bfr* dst = (which ? kn : qn) + (size_t)tok * 512 + hm * 64;
        *(uint2*)(dst + d0) = make_uint2(pk2(o1[0], o1[1]), pk2(o1[2], o1[3]));
        *(uint2*)(dst + 32 + d0) = make_uint2(pk2(o2[0], o2[1]), pk2(o2[2], o2[3]));
    }
}

DI void s5_scan(const Ctx& P, int li) {
    const float* xloc = (const float*)(P.ws + OFF_XLOC);
    bfr* xin = (bfr*)(P.ws + OFF_XIN);
    const float* l32 = (const float*)(P.ws + OFF_S5L32) + (size_t)li * 32 * 128;
    for (int idx = blockIdx.x * NTHREADS + ltid(); idx < 32 * 16 * 64; idx += gridDim.x * NTHREADS) {
        const int p = idx & 63, b = (idx >> 6) & 15, g = idx >> 10;
        const float lr = l32[g * 128 + 2 * p], lim = l32[g * 128 + 2 * p + 1];
        float xr = 0.f, xi = 0.f;
        for (int ch = 0; ch < 64; ++ch) {
            const size_t o = ((size_t)g * 1024 + b * 64 + ch) * 128 + 2 * p;
            *(unsigned*)(xin + o) = pk2(xr, xi);
            const float2 a = *(const float2*)(xloc + o);
            const float nr = lr * xr - lim * xi + a.x, ni = lr * xi + lim * xr + a.y;
            xr = nr; xi = ni;
        }
    }
}

DI void attn_item(char* lds, const Ctx& P, int b, int h, int qt, float lam, float lam_init, const float* subln) {
    const bfr* qn = (const bfr*)(P.ws + OFF_QN);
    const bfr* kn = (const bfr*)(P.ws + OFF_KN);
    const bfr* vT = (const bfr*)(P.ws + OFF_VT) + (size_t)(b * 4 + h) * 128 * SEQ;
    bfr* am = (bfr*)(P.ws + OFF_AMIX);
    const int tid = ltid(), lane = tid & 63, wave = tid >> 6;
    const int m = wave >> 2, qw = (wave & 3) * 32;
    const int q0 = qt * 128 + qw;
    const int ln = lane & 31, hf = lane >> 5;
    bf16x8 qf[4];
    {
        const bfr* qp = qn + ((size_t)b * SEQ + q0 + ln) * 512 + h * 128 + m * 64 + hf * 8;
#pragma unroll
        for (int ks = 0; ks < 4; ++ks) qf[ks] = *(const bf16x8*)(qp + ks * 16);
    }
    f32x16 o[4];
#pragma unroll
    for (int d = 0; d < 4; ++d)
#pragma unroll
        for (int r = 0; r < 16; ++r) o[d][r] = 0.f;
    float mrun = -INFINITY, lrun = 0.f;
    const int nkt = 2 * (qt + 1);
    const int lrow = tid >> 3, lcol = (tid & 7) * 8;
    const bfr* kbase = kn + ((size_t)b * SEQ) * 512 + h * 128;
    unsigned ko = (unsigned)(lrow * 512 + lcol) * 2u, vo = (unsigned)(lrow * SEQ + lcol) * 2u;
    asm volatile("" : "+v"(ko), "+v"(vo));
    uint4 rk0, rk1, rv0, rv1;
#define ATT_GLOAD(kt_) do { const char* kp_ = (const char*)(kbase + (size_t)(kt_) * (64 * 512)); const char* vp_ = (const char*)(vT + (kt_) * 64); \
        rk0 = *(const uint4*)(kp_ + ko); rk1 = *(const uint4*)(kp_ + 64 * 2 + ko); \
        rv0 = *(const uint4*)(vp_ + vo); rv1 = *(const uint4*)(vp_ + 64 * SEQ * 2 + vo); } while (0)
#define ATT_S1(base_, i_, RK, RV) { *(uint4*)((base_) + (64 * (i_)) * LDA * 2) = RK; \
        *(uint4*)((base_) + TILE_B + (64 * (i_)) * LDA * 2) = RV; }
#define ATT_LSTORE(buf_) do { char* base_ = lds + (buf_) * (2 * TILE_B) + s_off; ATT_S1(base_, 0, rk0, rv0) ATT_S1(base_, 1, rk1, rv1) } while (0)
    int k_off = ((m * 64 + ln) * LDA + hf * 8) * 2;
    int v_off = TILE_B + (ln * LDA + 4 * hf) * 2;
    int s_off = (lrow * LDA + lcol) * 2;
    asm volatile("" : "+v"(k_off), "+v"(v_off), "+v"(s_off));
    ATT_GLOAD(0); ATT_LSTORE(0);
    __syncthreads();
    int buf = 0;
#pragma unroll 1
    for (int kt = 0; kt < nkt; ++kt) {
        const bool more = (kt + 1 < nkt);
        const char* ks_ = lds + buf * (2 * TILE_B) + k_off;
        const char* vs_ = lds + buf * (2 * TILE_B) + v_off;
        if (kt * 64 <= q0 + 31) {
            f32x16 s[2];
#pragma unroll
            for (int kb = 0; kb < 2; ++kb) {
#pragma unroll
                for (int r = 0; r < 16; ++r) s[kb][r] = 0.f;
#pragma unroll
                for (int ks = 0; ks < 4; ++ks) {
                    const bf16x8 kf = *(const bf16x8*)(ks_ + ((kb * 32) * LDA + ks * 16) * 2);
                    s[kb] = MFMA32(kf, qf[ks], s[kb]);
                }
            }
            const int qpos = q0 + ln;
            if (kt * 64 + 63 > q0) {
#pragma unroll
                for (int kb = 0; kb < 2; ++kb)
#pragma unroll
                    for (int r = 0; r < 16; ++r) {
                        const int key = kt * 64 + kb * 32 + (r & 3) + 8 * (r >> 2) + 4 * hf;
                        if (key > qpos) s[kb][r] = -INFINITY;
                    }
            }
            float mx = s[0][0];
#pragma unroll
            for (int kb = 0; kb < 2; ++kb)
#pragma unroll
                for (int r = 0; r < 16; ++r) mx = fmaxf(mx, s[kb][r]);
            mx = fmaxf(mx, __shfl_xor(mx, 32));
            const float mnew = fmaxf(mrun, mx);
            const float alpha = __builtin_amdgcn_exp2f(mrun - mnew);
            mrun = mnew;
            float rsum = 0.f;
#pragma unroll
            for (int kb = 0; kb < 2; ++kb)
#pragma unroll
                for (int r = 0; r < 16; ++r) { const float p = __builtin_amdgcn_exp2f(s[kb][r] - mnew); s[kb][r] = p; rsum += p; }
            lrun = lrun * alpha + rsum;
#pragma unroll
            for (int d = 0; d < 4; ++d)
#pragma unroll
                for (int r = 0; r < 16; ++r) o[d][r] *= alpha;
            __builtin_amdgcn_sched_barrier(0);
            if (more) ATT_GLOAD(kt + 1);
#pragma unroll
            for (int kb = 0; kb < 2; ++kb)
#pragma unroll
                for (int st = 0; st < 2; ++st) {
                    const uint4 pp = make_uint4(pk2(s[kb][8 * st + 0], s[kb][8 * st + 1]), pk2(s[kb][8 * st + 2], s[kb][8 * st + 3]),
                                                pk2(s[kb][8 * st + 4], s[kb][8 * st + 5]), pk2(s[kb][8 * st + 6], s[kb][8 * st + 7]));
                    const bf16x8 pf = __builtin_bit_cast(bf16x8, pp);
                    const int kc = kb * 32 + 16 * st;
#pragma unroll
                    for (int d = 0; d < 4; ++d) {
                        const uint2 v0 = *(const uint2*)(vs_ + ((d * 32) * LDA + kc) * 2);
                        const uint2 v1 = *(const uint2*)(vs_ + ((d * 32) * LDA + kc + 8) * 2);
                        const bf16x8 vf = __builtin_bit_cast(bf16x8, make_uint4(v0.x, v0.y, v1.x, v1.y));
                        o[d] = MFMA32(vf, pf, o[d]);
                    }
                }
        }
        else if (more) ATT_GLOAD(kt + 1);
        if (more) ATT_LSTORE(buf ^ 1);
        __syncthreads();
        buf ^= 1;
    }
    const float ltot = lrun + __shfl_xor(lrun, 32);
    const float linv = 1.0f / ltot;
    float* ob = (float*)lds;
    int o_off = (m * 128 + qw + ln) * 129 + 4 * hf;
    asm volatile("" : "+v"(o_off));
#pragma unroll
    for (int d = 0; d < 4; ++d)
#pragma unroll
        for (int r = 0; r < 16; ++r) ob[o_off + d * 32 + (r & 3) + 8 * (r >> 2)] = o[d][r] * linv;
    __syncthreads();
#pragma unroll
    for (int it = 0; it < 4; ++it) {
        const int idx = it * NTHREADS + tid;
        const int q = idx >> 4, c0 = (idx & 15) * 8;
        float v[8];
        float ss = 0.f;
        int r_off = q * 129 + c0;
        asm volatile("" : "+v"(r_off));
#pragma unroll
        for (int j = 0; j < 8; ++j) { v[j] = ob[r_off + j] - lam * ob[r_off + 128 * 129 + j]; ss += v[j] * v[j]; }
        ss = row16_sum(ss);
        const float rs = rsqrtf(ss * (1.0f / 128.0f) + 1e-5f) * (1.0f - lam_init);
#pragma unroll
        for (int j = 0; j < 8; ++j) v[j] = v[j] * rs * subln[c0 + j];
        *(uint4*)(am + ((size_t)b * SEQ + qt * 128 + q) * 1024 + h * 128 + c0) = pack8(v);
    }
    __syncthreads();
}

DI void phase_o3(char* lds, const Ctx& P, int li, int layer) {
    s5_scan(P, li);
    float lam;
    {
        const int j = ltid() & 63;
        const float s1 = wave_sum(P.in[I_LQ1][li * 64 + j] * P.in[I_LK1][li * 64 + j]);
        const float s2 = wave_sum(P.in[I_LQ2][li * 64 + j] * P.in[I_LK2][li * 64 + j]);
        const float lam_init0 = 0.8f - 0.6f * __expf(-0.3f * (float)layer);
        lam = __expf(s1) - __expf(s2) + lam_init0;
    }
    const float lam_init = 0.8f - 0.6f * __expf(-0.3f * (float)layer);
    const float* subln = P.in[I_SUBLN] + li * 128;
    for (int item = blockIdx.x; item < 512; item += gridDim.x) {
        const int bh = item >> 3, pr = item & 7;
        for (int half = 0; half < 2; ++half) attn_item(lds, P, bh >> 2, bh & 3, half ? 15 - pr : pr, lam, lam_init, subln);
    }
}

DI void phase_o4(char* lds, const Ctx& P, int li) {
    const bfr* us5 = (const bfr*)(P.ws + OFF_US5);
    const bfr* xin = (const bfr*)(P.ws + OFF_XIN);
    const bfr* gt = (const bfr*)(P.ws + OFF_S5GT) + (size_t)li * 32 * 512 * 640;
    const float* dsk = P.in[I_S5D] + li * 512;
    bfr* zb = (bfr*)(P.ws + OFF_ZBUF);
    for (int t = blockIdx.x; t < 512; t += gridDim.x) {
        const int g = t >> 4, mt = (t >> 2) & 3, nt = t & 3;
        const int nloc = 2 * (nt + 1);
        const bfr* ag = us5 + (size_t)g * NTOK * 16;
        const bfr* xg = xin + (size_t)g * 1024 * 128;
        const int tq = ltid();
        const int arow = mt * 256 + (tq >> 3), acol = gt_lcol(tq);
        auto aptr = [&](int i, int kt) __attribute__((always_inline)) -> const bfr* {
            return (kt < nloc) ? ag + (size_t)(arow + 64 * i) * 512 + kt * 64 + acol
                               : xg + (size_t)(arow + 64 * i) * 128 + (kt - nloc) * 64 + acol;
        };
        const bfr* bg = gt + (size_t)g * 512 * 640 + (size_t)(nt * 128 + (tq >> 3)) * 640 + acol;
        auto bptr = [&](int i, int kt) __attribute__((always_inline)) -> const bfr* {
            return bg + (size_t)(64 * i) * 640 + ((kt < nloc) ? kt : (8 + kt - nloc)) * 64;
        };
        GEMM128(lds, nloc + 2, aptr, bptr, [&](const float* stg, int) __attribute__((always_inline)) {
            epi_rows8_pre<uint4>(stg,
                [&](int r, int c0) __attribute__((always_inline)) -> uint4 {
                    const int n = nt * 128 + c0;
                    return *(const uint4*)(ag + ((size_t)(mt * 256 + r) * 32 + (n >> 4)) * 16 + (n & 15)); },
                [&](int r, int c0, const float (&v)[8], const uint4& up) __attribute__((always_inline)) {
                    const int cb = mt * 256 + r;
                    const int n = nt * 128 + c0, tt = n >> 4, c1 = n & 15;
                    const size_t tok = (size_t)cb * 32 + tt;
                    float uu[8], z[8];
                    unpack8(up, uu);
#pragma unroll
                    for (int j = 0; j < 8; ++j) {
                        const float y = v[j] + dsk[g * 16 + c1 + j] * uu[j];
                        const float inner = 0.7978845608028654f * (y + 0.044715f * y * y * y);
                        z[j] = 0.5f * y * (1.0f + ftanh(inner));
                    }
                    *(uint4*)(zb + tok * 512 + g * 16 + c1) = pack8(z);
                });
        });
    }
}

DI void phase_o5(char* lds, const Ctx& P, int li) {
    const bfr* zb = (const bfr*)(P.ws + OFF_ZBUF);
    const bfr* w = (const bfr*)(P.ws + OFF_GLUT) + (size_t)li * 512 * 512;
    bfr* am = (bfr*)(P.ws + OFF_AMIX);
    for (int t = blockIdx.x; t < 512; t += gridDim.x) {
        int mt, nt; tile_remap(t, 128, 4, mt, nt);
        RowLoader A(zb, mt * 256, 512), B(w, nt * 128, 512);
        GEMM128(lds, 8, A, B, [&](const float* stg, int) __attribute__((always_inline)) {
            epi_rows8_pre<uint4>(stg,
                [&](int r, int c0) __attribute__((always_inline)) -> uint4 { return *(const uint4*)(zb + (size_t)(mt * 256 + r) * 512 + nt * 128 + c0); },
                [&](int r, int c0, const float (&v)[8], const uint4& zp) __attribute__((always_inline)) {
                    float zz[8], o[8];
                    unpack8(zp, zz);
#pragma unroll
                    for (int j = 0; j < 8; ++j) o[j] = zz[j] * sigmoidf_(v[j]);
                    *(uint4*)(am + (size_t)(mt * 256 + r) * 1024 + 512 + nt * 128 + c0) = pack8(o);
                });
        });
    }
}
DI void phase_router(char* lds, const Ctx& P, int layer) {
    const float* x = P.out;
    bfr* hb = (bfr*)(P.ws + OFF_HB);
    bfr* hlo = (bfr*)(P.ws + OFF_HLO);
    const bfr* rhi = (const bfr*)(P.ws + OFF_RHI) + (size_t)layer * 128 * 1024;
    const bfr* rlo = (const bfr*)(P.ws + OFF_RLO) + (size_t)layer * 128 * 1024;
    int* gcnt = (int*)(P.ws + OFF_CNT) + layer * 64;
    int* stok = (int*)(P.ws + OFF_TOK);
    float* sgate = (float*)(P.ws + OFF_GATE);
    int* lcnt = (int*)(lds + LDS_AUX);
    int* lbase = lcnt + 64;
    const float* bg = P.in[I_MBG] + layer * 4;
    const float* be = P.in[I_MBE] + layer * 32;
    const int tid = ltid();
    for (int u = blockIdx.x; u < 128; u += gridDim.x) {
        const int m0 = u * 256;
        norm_rows(x, P.in[I_NFFN] + (size_t)layer * DM, hb, hlo, nullptr, m0, 256);
        __syncthreads();
        const size_t roff = (size_t)(m0 + (tid >> 3)) * 1024 + gt_lcol(tid);
        const size_t boff = (size_t)(tid >> 3) * 1024 + gt_lcol(tid);
        auto aptr = [&](int i, int kt) __attribute__((always_inline)) -> const bfr* { return (kt < 32 ? hb : hlo) + roff + (size_t)(64 * i) * 1024 + (kt & 15) * 64; };
        auto bptr = [&](int i, int kt) __attribute__((always_inline)) -> const bfr* { return ((kt >= 16 && kt < 32) ? rlo : rhi) + boff + (size_t)(64 * i) * 1024 + (kt & 15) * 64; };
        GEMM128(lds, 48, aptr, bptr, [&](const float* stg, int) __attribute__((always_inline)) {
            if (tid < 64) lcnt[tid] = 0;
            __syncthreads();
            int seg0 = 0, seg1 = 0, p0 = 0, p1 = 0;
            float g0 = 0.f, g1 = 0.f;
            if (tid < 256) {
                const float* row = stg + tid * STG_LD;
                float gl[4];
#pragma unroll
                for (int j = 0; j < 4; ++j) gl[j] = row[32 + j] + bg[j];
                int gt = 0; float gm = gl[0];
#pragma unroll
                for (int j = 1; j < 4; ++j) if (gl[j] > gm) { gm = gl[j]; gt = j; }
                float gs = 0.f;
#pragma unroll
                for (int j = 0; j < 4; ++j) gs += __expf(gl[j] - gm);
                const float gw = 1.0f / gs;
                float l1 = -INFINITY, l2 = -INFINITY; int j1 = 0, j2 = 0;
                for (int j = 0; j < 8; ++j) {
                    const float v = row[gt * 8 + j] + be[gt * 8 + j];
                    if (v > l1) { l2 = l1; j2 = j1; l1 = v; j1 = j; }
                    else if (v > l2) { l2 = v; j2 = j; }
                }
                const float w1 = 1.0f / (1.0f + __expf(l2 - l1));
                g0 = gw * w1; g1 = gw * (1.0f - w1);
                seg0 = gt * 8 + j1; seg1 = 32 + gt * 8 + j2;
                p0 = atomicAdd(&lcnt[seg0], 1);
                p1 = atomicAdd(&lcnt[seg1], 1);
            }
            __syncthreads();
            if (tid < 64) { const int c = lcnt[tid]; lbase[tid] = c ? atomicAdd(&gcnt[tid], c) : 0; }
            __syncthreads();
            if (tid < 256) {
                const int q0 = lbase[seg0] + p0, q1 = lbase[seg1] + p1;
                stok[(size_t)seg0 * NTOK + q0] = m0 + tid; sgate[(size_t)seg0 * NTOK + q0] = g0;
                stok[(size_t)seg1 * NTOK + q1] = m0 + tid; sgate[(size_t)seg1 * NTOK + q1] = g1;
            }
        });
    }
}

DI void moe_tables(char* lds, const Ctx& P, int layer) {
    int* cnt = (int*)(lds + LDS_AUX); int* rb0 = cnt + 64; int* hoff = rb0 + 65;
    const int* gcnt = (const int*)(P.ws + OFF_CNT) + layer * 64;
    const int tid = ltid();
    if (tid < 64) cnt[tid] = gcnt[tid];
    __syncthreads();
    if (tid == 0) {
        int acc = 0;
        for (int s = 0; s < 64; ++s) { rb0[s] = acc; hoff[s] = acc * 256; acc += (cnt[s] + 255) >> 8; }
        rb0[64] = acc;
    }
    __syncthreads();
}
DI int moe_find_seg(const int* rb0, int rbi) { int s = 0; while (rb0[s + 1] <= rbi) ++s; return s; }

DI void phase_moe_up(char* lds, const Ctx& P, int layer) {
    moe_tables(lds, P, layer);
    const int* cnt = (const int*)(lds + LDS_AUX); const int* rb0 = cnt + 64; const int* hoff = rb0 + 65;
    const bfr* hb = (const bfr*)(P.ws + OFF_HB);
    const bfr* wgu = (const bfr*)(P.ws + OFF_MWGU);
    const int* stok = (const int*)(P.ws + OFF_TOK);
    bfr* hid = (bfr*)(P.ws + OFF_HID);
    const int ntiles = rb0[64] * 4;
    for (int t = blockIdx.x; t < ntiles; t += gridDim.x) {
        int rbi, nt; tile_remap(t, rb0[64], 4, rbi, nt);
        const int seg = moe_find_seg(rb0, rbi);
        const int rb = rbi - rb0[seg], e = seg & 31, c = cnt[seg];
        const bfr* ap[4];
        const int tq = ltid();
#pragma unroll
        for (int i = 0; i < 4; ++i) {
            int p = rb * 256 + (tq >> 3) + 64 * i; p = p < c ? p : c - 1;
            ap[i] = hb + (size_t)stok[(size_t)seg * NTOK + p] * 1024 + gt_lcol(tq);
        }
        auto aptr = [&](int i, int kt) __attribute__((always_inline)) -> const bfr* { return ap[i] + kt * 64; };
        RowLoader B(wgu + (size_t)e * 1024 * 1024, nt * 256, 1024);
        const size_t hrow0 = (size_t)hoff[seg] + rb * 256;
        GEMM256(lds, 16, aptr, B, [&](const float* stg, int p) __attribute__((always_inline)) {
            epi_rows8(stg, [&](int r, int c0, const float (&v)[8]) __attribute__((always_inline)) {
                float o[4];
#pragma unroll
                for (int j = 0; j < 4; ++j) o[j] = v[j] * sigmoidf_(v[j]) * v[4 + j];
                *(uint2*)(hid + (hrow0 + r) * 512 + ((nt * 256 + p * 128 + c0) >> 1)) = make_uint2(pk2(o[0], o[1]), pk2(o[2], o[3]));
            });
        });
    }
}

DI void phase_moe_down(char* lds, const Ctx& P, int layer, int k, float* x) {
    const G4 G = g4_make(lds);
    int* cnt = (int*)(G.lds + G4_AUX); int* rb0 = cnt + 64; int* hoff = rb0 + 65;
    {
        const int* gcnt = (const int*)(P.ws + OFF_CNT) + layer * 64;
        if (G.tid < 64) cnt[G.tid] = gcnt[G.tid];
        g4_bar(G);
        if (G.tid == 0) {
            int acc = 0, hacc = 0;
            for (int s = 0; s < 64; ++s) { rb0[s] = acc; hoff[s] = hacc; acc += (cnt[s] + 127) >> 7; hacc += ((cnt[s] + 255) >> 8) * 256; }
            rb0[64] = acc;
        }
        g4_bar(G);
    }
    const bfr* hid = (const bfr*)(P.ws + OFF_HID);
    const bfr* wd = (const bfr*)(P.ws + OFF_MWD);
    const int* stok = (const int*)(P.ws + OFF_TOK);
    const float* sgate = (const float*)(P.ws + OFF_GATE);
    const int rbA = rb0[k * 32], rbB = rb0[k * 32 + 32];
    const int ntiles = (rbB - rbA) * 8;
    for (int t = G.vb; t < ntiles; t += G.nvb) {
        int rbi, nt; tile_remap(t, rbB - rbA, 8, rbi, nt); rbi += rbA;
        const int seg = moe_find_seg(rb0, rbi);
        const int rb = rbi - rb0[seg], e = seg & 31, c = cnt[seg];
        G4RowLoader A(G, hid, hoff[seg] + rb * 128, 512), B(G, wd + (size_t)e * 1024 * 512, nt * 128, 512);
        int* ltok = (int*)(G.lds + G4_AUX + 1024); float* lgate = (float*)(G.lds + G4_AUX + 1536);
        if (G.tid < 128) {
            const int p = rb * 128 + G.tid;
            ltok[G.tid] = p < c ? stok[(size_t)seg * NTOK + p] : -1;
            lgate[G.tid] = p < c ? sgate[(size_t)seg * NTOK + p] : 0.f;
        }
        g4_gemm_tile(G, G.lds, 8, A, B, [&](const float* stg) __attribute__((always_inline)) {
            g4_epi_rows8_pre<F8>(G, stg,
                [&](int r, int c0) __attribute__((always_inline)) -> F8 {
                    int tok = ltok[r]; tok = tok < 0 ? 0 : tok;
                    const float* d = x + (size_t)tok * DM + nt * 128 + c0;
                    F8 o; o.a = *(const float4*)d; o.b = *(const float4*)(d + 4);
                    return o; },
                [&](int r, int c0, const float (&v)[8], const F8& o) __attribute__((always_inline)) {
                    const int tok = ltok[r];
                    if (tok >= 0) {
                        const float gt = lgate[r];
                        float* d = x + (size_t)tok * DM + nt * 128 + c0;
                        *(float4*)d = make_float4(o.a.x + gt * v[0], o.a.y + gt * v[1], o.a.z + gt * v[2], o.a.w + gt * v[3]);
                        *(float4*)(d + 4) = make_float4(o.b.x + gt * v[4], o.b.y + gt * v[5], o.b.z + gt * v[6], o.b.w + gt * v[7]);
                    }
                });
        });
    }
}
constexpr int PH_PER_LAYER = 11;
constexpr int N_PHASES = 1 + 4 * PH_PER_LAYER;

DI void phase_prologue(char* lds, const Ctx& P) {
    for (int u = blockIdx.x; u < 64; u += gridDim.x) s5_tables(lds, P, u >> 5, u & 31);
    const bool excl = gridDim.x >= 128;
    if (excl && blockIdx.x < 64) return;
    unsigned base = 0;
    const int wk = excl ? (int)blockIdx.x - 64 : (int)blockIdx.x, nw = excl ? (int)gridDim.x - 64 : (int)gridDim.x;
    for (int i = 0; i < 2; ++i) {
        cvt_matrix(lds, P.in[I_EWIN] + (size_t)i * 1024 * 2304, 1024, 2304, (bfr*)(P.ws + OFF_WINE) + (size_t)i * 2304 * 1024, 1024, 0, wk, nw, base);
        cvt_matrix(lds, P.in[I_EWOUT] + (size_t)i * 1024 * 1024, 1024, 1024, (bfr*)(P.ws + OFF_WOUTE) + (size_t)i * 1024 * 1024, 1024, 0, wk, nw, base);
        cvt_matrix(lds, P.in[I_OWIN] + (size_t)i * 1024 * 2048, 1024, 2048, (bfr*)(P.ws + OFF_WINO) + (size_t)i * 2048 * 1024, 1024, 0, wk, nw, base);
        cvt_matrix(lds, P.in[I_OWOUT] + (size_t)i * 1024 * 1024, 1024, 1024, (bfr*)(P.ws + OFF_WOUTO) + (size_t)i * 1024 * 1024, 1024, 0, wk, nw, base);
        cvt_matrix(lds, P.in[I_W2] + (size_t)i * 64 * 512, 64, 512, (bfr*)(P.ws + OFF_W2T) + (size_t)i * 512 * 64, 64, 0, wk, nw, base);
        cvt_matrix(lds, P.in[I_A2] + (size_t)i * 64 * 512, 64, 512, (bfr*)(P.ws + OFF_A2T) + (size_t)i * 512 * 64, 64, 0, wk, nw, base);
        cvt_matrix(lds, P.in[I_G2] + (size_t)i * 128 * 512, 128, 512, (bfr*)(P.ws + OFF_G2T) + (size_t)i * 512 * 128, 128, 0, wk, nw, base);
        for (int g = 0; g < 4; ++g)
            cvt_matrix(lds, P.in[I_POOLW] + (size_t)(i * 4 + g) * 128 * 128, 128, 128, (bfr*)(P.ws + OFF_POOLT) + (size_t)(i * 4 + g) * 128 * 128, 128, 0, wk, nw, base);
        cvt_matrix(lds, P.in[I_WGLU] + (size_t)i * 512 * 512, 512, 512, (bfr*)(P.ws + OFF_GLUT) + (size_t)i * 512 * 512, 512, 0, wk, nw, base);
    }
    const int gtid = wk * NTHREADS + ltid(), gsz = nw * NTHREADS;
    {
        bfr* rhi = (bfr*)(P.ws + OFF_RHI); bfr* rlo = (bfr*)(P.ws + OFF_RLO);
        for (int idx = gtid; idx < 4 * 128 * 1024; idx += gsz) {
            const int k = idx & 1023, n = (idx >> 10) & 127, l = idx >> 17;
            float w = 0.f;
            if (n < 32) w = P.in[I_MWE][((size_t)l * 1024 + k) * 32 + n];
            else if (n < 36) w = P.in[I_MWG][((size_t)l * 1024 + k) * 4 + (n - 32)];
            const bfr h = f2bf(w);
            rhi[idx] = h; rlo[idx] = f2bf(w - bf2f(h));
        }
    }
    {
        bfr* v12 = (bfr*)(P.ws + OFF_V12T);
        const float* v1 = P.in[I_V1]; const float* v2 = P.in[I_V2];
        for (int idx = gtid; idx < 512 * 512; idx += gsz) {
            const int k = idx & 511, n = idx >> 9;
            float s = 0.f;
            for (int r = 0; r < 32; ++r) s += v1[k * 32 + r] * v2[r * 512 + n];
            v12[idx] = f2bf(s);
        }
    }
    for (int tt = wk; tt < 512; tt += nw)
        norm_rows(P.in[I_X], P.in[I_NMIX], (bfr*)(P.ws + OFF_HB), nullptr, P.out, tt * 64, 64);
}

DI Ctx mkctx(unsigned char* ws, float* out) {
    size_t z = 0;
    asm volatile("" : "+s"(z));
    Ctx c;
    c.in.p = (KArgPtr)__builtin_amdgcn_kernarg_segment_ptr() + z;
    c.ws = ws + z; c.out = (float*)((char*)out + z);
    return c;
}
__global__ void __launch_bounds__(NTHREADS, 2) fwd_kernel(Params PA) {
    extern __shared__ __attribute__((aligned(16))) char lds[];
    if (threadIdx.x == 0) { *(uint4*)(lds + LDS_BYTES - 16) = make_uint4(0u, 0u, 0u, 0u); *(uint4*)(lds + LDS_BYTES - 32) = make_uint4(0u, 0u, 0u, 0u); }
    __syncthreads();
    XcdBarrier bar = xcd_barrier_post((unsigned*)(PA.ws + OFF_BAR), (volatile LAS unsigned*)(lds + LDS_BYTES - 16));
    const int lo = PA.ph_lo, hi = PA.ph_hi;
#ifndef DUP_PH
#define DUP_PH (-1)
#endif
#define DUPX(k, call) do { call; if (DUP_PH == (k)) { __syncthreads(); call; } } while (0)
#define RUNS(id) ((id) >= lo && (id) < hi)
#define P mkctx(PA.ws, PA.out)
#define SEAM(id) do { if ((id) > lo && (id) < hi) xcd_barrier(bar); } while (0)
    if (RUNS(0)) DUPX(100, phase_prologue(lds, P));
    for (int layer = 0; layer < 4; ++layer) {
        const int base = 1 + layer * PH_PER_LAYER;
        const int li = layer >> 1;
        if ((layer & 1) == 0) {
            SEAM(base + 0); if (RUNS(base + 0)) DUPX(0, phase_e1(lds, P, li));
            SEAM(base + 1); if (RUNS(base + 1)) DUPX(1, phase_e2a(P, li));
            SEAM(base + 2); if (RUNS(base + 2)) DUPX(2, phase_e2b(lds, P, li));
            SEAM(base + 3); if (RUNS(base + 3)) { phase_e3(lds, P, li); if (DUP_PH == 3) phase_e3(lds, P, li, 3); if (DUP_PH == 41) phase_e3(lds, P, li, 1); if (DUP_PH == 42) phase_e3(lds, P, li, 2); }
            SEAM(base + 4); if (RUNS(base + 4)) DUPX(4, phase_e4(P, li));
            SEAM(base + 5); if (RUNS(base + 5)) { phase_wout(lds, P, (const bfr*)(P.ws + OFF_WOUTE) + (size_t)li * 1024 * 1024, P.out); if (DUP_PH == 5) phase_wout(lds, P, (const bfr*)(P.ws + OFF_WOUTE) + (size_t)li * 1024 * 1024, (float*)(P.ws + OFF_EV)); }
        } else {
            SEAM(base + 0); if (RUNS(base + 0)) DUPX(10, phase_o1(lds, P, li));
            SEAM(base + 1); if (RUNS(base + 1)) DUPX(11, phase_o2(lds, P, li));
            SEAM(base + 2); if (RUNS(base + 2)) DUPX(12, phase_o3(lds, P, li, layer));
            SEAM(base + 3); if (RUNS(base + 3)) DUPX(13, phase_o4(lds, P, li));
            SEAM(base + 4); if (RUNS(base + 4)) DUPX(14, phase_o5(lds, P, li));
            SEAM(base + 5); if (RUNS(base + 5)) { phase_wout(lds, P, (const bfr*)(P.ws + OFF_WOUTO) + (size_t)li * 1024 * 1024, P.out); if (DUP_PH == 5) phase_wout(lds, P, (const bfr*)(P.ws + OFF_WOUTO) + (size_t)li * 1024 * 1024, (float*)(P.ws + OFF_EV)); }
        }
        SEAM(base + 6);
        if (RUNS(base + 6)) {
            phase_router(lds, P, layer);
            const bool split = gridDim.x >= 256;
            DUPX(6, moe_convert(lds, P, layer, split ? (int)blockIdx.x - 128 : (int)blockIdx.x, split ? (int)gridDim.x - 128 : (int)gridDim.x));
        }
        SEAM(base + 7); if (RUNS(base + 7)) DUPX(7, phase_moe_up(lds, P, layer));
        SEAM(base + 8); if (RUNS(base + 8)) { phase_moe_down(lds, P, layer, 0, P.out); if (DUP_PH == 8) phase_moe_down(lds, P, layer, 0, (float*)(P.ws + OFF_EV)); }
        SEAM(base + 9); if (RUNS(base + 9)) phase_moe_down(lds, P, layer, 1, P.out);
        SEAM(base + 10);
        if (RUNS(base + 10) && layer < 3) {
            for (int rep = 0; rep < (DUP_PH == 20 ? 2 : 1); ++rep)
            for (int tt = blockIdx.x; tt < 512; tt += gridDim.x)
                norm_rows(P.out, P.in[I_NMIX] + (size_t)(layer + 1) * DM, (bfr*)(P.ws + OFF_HB), nullptr, nullptr, tt * 64, 64);
        }
    }
#undef P
#undef RUNS
#undef SEAM
}

#ifndef N_LAUNCH_SPLIT
#define N_LAUNCH_SPLIT 0
#endif
extern "C" void kernel_launch(void* const* d_in, const int* in_sizes, int n_in, void* d_out, int out_size, void* d_ws, size_t ws_size, hipStream_t stream) {
    static int grid = 0;
    if (grid == 0) {
        if (n_in != N_INPUTS || out_size != NTOK * DM || ws_size < WS_NEEDED) {
            fprintf(stderr, "kernel_launch: unexpected shapes: n_in %d out %d ws %zu (need %zu)\n", n_in, out_size, ws_size, (size_t)WS_NEEDED);
            grid = -1; return;
        }
        int dev = 0, cus = 0, per_cu = 0;
        (void)hipGetDevice(&dev);
        (void)hipDeviceGetAttribute(&cus, hipDeviceAttributeMultiprocessorCount, dev);
        if (hipFuncSetAttribute((const void*)fwd_kernel, hipFuncAttributeMaxDynamicSharedMemorySize, LDS_BYTES) != hipSuccess) { fprintf(stderr, "kernel_launch: hipFuncSetAttribute failed\n"); grid = -1; return; }
        if (hipOccupancyMaxActiveBlocksPerMultiprocessor(&per_cu, (const void*)fwd_kernel, NTHREADS, LDS_BYTES) != hipSuccess) per_cu = 1;
        (void)hipGetLastError();
        if (per_cu < 1) per_cu = 1;
        if (per_cu > 1) per_cu = 1;
        if (cus <= 0) cus = 256;
        grid = cus * per_cu;
    }
    if (grid < 0) return;
    (void)hipMemsetAsync(d_ws, 0, OFF_ZERO_END, stream);
    Params p{};
    for (int i = 0; i < N_INPUTS; ++i) p.in[i] = (const float*)d_in[i];
    p.out = (float*)d_out; p.ws = (unsigned char*)d_ws;
#if N_LAUNCH_SPLIT
    for (int ph = 0; ph < N_PHASES - 1; ++ph) {
        p.ph_lo = ph; p.ph_hi = ph + 1;
        hipLaunchKernelGGL(fwd_kernel, dim3(grid), dim3(NTHREADS), LDS_BYTES, stream, p);
    }
#else
    p.ph_lo = 0; p.ph_hi = N_PHASES;
    hipLaunchKernelGGL(fwd_kernel, dim3(grid), dim3(NTHREADS), LDS_BYTES, stream, p);
#endif
}
```

```cpp
#include <hip/hip_runtime.h>
#include <stdint.h>
#include <stdio.h>

typedef unsigned short bfr;
typedef __attribute__((ext_vector_type(8))) short bf16x8;
typedef __attribute__((ext_vector_type(16))) float f32x16;
typedef __attribute__((ext_vector_type(2))) __bf16 bf16x2_t;
#define DI __device__ __forceinline__
#define MFMA32(a, b, c) __builtin_amdgcn_mfma_f32_32x32x16_bf16((a), (b), (c), 0, 0, 0)

constexpr int NTOK = 32768, DM = 1024, SEQ = 2048, NB = 16;
constexpr int EVEN_IN = 2304, ODD_IN = 2048;
constexpr int NTHREADS = 512;
constexpr int NWAVES = NTHREADS / 64;
constexpr int LDS_BYTES = 161792;

enum { I_X = 0, I_NMIX, I_NFFN, I_EWIN, I_MU, I_W0, I_W2, I_A0, I_A2, I_G2, I_KK, I_KA, I_RK, I_LNG, I_LNB, I_V0, I_V1, I_V2,
       I_POOLW, I_POOLS, I_EWOUT, I_OWIN, I_QN, I_KN, I_LQ1, I_LK1, I_LQ2, I_LK2, I_SUBLN, I_ARE, I_AIM, I_LSTEP, I_BRE, I_BIM,
       I_CRE, I_CIM, I_S5D, I_WGLU, I_OWOUT, I_MWG, I_MBG, I_MWE, I_MBE, I_MWGATE, I_MWUP, I_MWDOWN, N_INPUTS };

constexpr size_t al256(size_t x) { return (x + 255) & ~(size_t)255; }
constexpr size_t OFF_BAR   = 0;
constexpr size_t OFF_CNT   = 16384;
constexpr size_t OFF_ZERO_END = 32768;
constexpr size_t OFF_WINE  = 65536;
constexpr size_t OFF_WOUTE = OFF_WINE  + (size_t)2 * 2304 * 1024 * 2;
constexpr size_t OFF_WINO  = OFF_WOUTE + (size_t)2 * 1024 * 1024 * 2;
constexpr size_t OFF_WOUTO = OFF_WINO  + (size_t)2 * 2048 * 1024 * 2;
constexpr size_t OFF_W2T   = OFF_WOUTO + (size_t)2 * 1024 * 1024 * 2;
constexpr size_t OFF_A2T   = OFF_W2T   + (size_t)2 * 512 * 64 * 2;
constexpr size_t OFF_G2T   = OFF_A2T   + (size_t)2 * 512 * 64 * 2;
constexpr size_t OFF_V12T  = OFF_G2T   + (size_t)2 * 512 * 128 * 2;
constexpr size_t OFF_POOLT = OFF_V12T  + (size_t)512 * 512 * 2;
constexpr size_t OFF_GLUT  = OFF_POOLT + (size_t)2 * 4 * 128 * 128 * 2;
constexpr size_t OFF_RHI   = OFF_GLUT  + (size_t)2 * 512 * 512 * 2;
constexpr size_t OFF_RLO   = OFF_RHI   + (size_t)4 * 128 * 1024 * 2;
constexpr size_t OFF_S5GT  = OFF_RLO   + (size_t)4 * 128 * 1024 * 2;
constexpr size_t OFF_S5BL  = OFF_S5GT  + (size_t)2 * 32 * 512 * 640 * 2;
constexpr size_t OFF_S5L32 = OFF_S5BL  + (size_t)2 * 32 * 128 * 512 * 2;
constexpr size_t OFF_MWGU  = al256(OFF_S5L32 + (size_t)2 * 32 * 64 * 2 * 4);
constexpr size_t OFF_MWD   = OFF_MWGU  + (size_t)32 * 1024 * 1024 * 2;
constexpr size_t OFF_HB    = OFF_MWD   + (size_t)32 * 1024 * 512 * 2;
constexpr size_t OFF_U     = OFF_HB    + (size_t)NTOK * 1024 * 2;
constexpr size_t OFF_US5   = OFF_U     + (size_t)NTOK * 1024 * 2;
constexpr size_t OFF_AMIX  = OFF_U     + (size_t)NTOK * 2304 * 2;
constexpr size_t OFF_VFIRST= OFF_AMIX  + (size_t)NTOK * 1024 * 2;
constexpr size_t OFF_TOK   = OFF_VFIRST+ (size_t)NTOK * 512 * 2;
constexpr size_t OFF_GATE  = OFF_TOK   + (size_t)64 * NTOK * 4;
constexpr size_t OFF_HID   = OFF_GATE  + (size_t)64 * NTOK * 4;
constexpr size_t OFF_HLO   = OFF_HID;
constexpr size_t OFF_EV    = OFF_HID   + (size_t)81920 * 512 * 2;
constexpr size_t OFF_S     = OFF_EV;
constexpr size_t OFF_MV2   = OFF_S     + (size_t)NTOK * 256 * 2;
constexpr size_t OFF_DLOG  = OFF_MV2   + (size_t)NTOK * 512 * 2;
constexpr size_t OFF_ABUF  = OFF_DLOG  + (size_t)NTOK * 512 * 4;
constexpr size_t OFF_GBUF  = OFF_ABUF  + (size_t)NTOK * 512 * 2;
constexpr size_t OFF_VGATE = OFF_GBUF  + (size_t)NTOK * 512 * 2;
constexpr size_t OFF_Y     = OFF_VGATE + (size_t)NTOK * 512 * 2;
constexpr size_t OFF_DPOOL = OFF_Y;
constexpr size_t OFF_BONUS = OFF_Y     + (size_t)NTOK * 512 * 4;
constexpr size_t OFF_EV_END= OFF_BONUS + (size_t)NTOK * 512 * 4;
constexpr size_t OFF_QN    = OFF_EV;
constexpr size_t OFF_KN    = OFF_QN    + (size_t)NTOK * 512 * 2;
constexpr size_t OFF_VT    = OFF_KN    + (size_t)NTOK * 512 * 2;
constexpr size_t OFF_XLOC  = OFF_VT    + (size_t)NTOK * 512 * 2;
constexpr size_t OFF_XIN   = OFF_XLOC  + (size_t)32 * 1024 * 128 * 4;
constexpr size_t OFF_ZBUF  = OFF_XIN   + (size_t)32 * 1024 * 128 * 2;
constexpr size_t OFF_OD_END= OFF_ZBUF  + (size_t)NTOK * 512 * 2;
constexpr size_t WS_NEEDED = OFF_EV_END > OFF_OD_END ? OFF_EV_END : OFF_OD_END;

struct Params {
    const float* in[N_INPUTS];
    float* out;
    unsigned char* ws;
    int ph_lo, ph_hi;
};
typedef const __attribute__((address_space(4))) char* KArgPtr;
struct InTab {
    KArgPtr p;
    DI const float* operator[](int i) const {
        const float* q = *(const float* const __attribute__((address_space(4)))*)(p + 8 * i);
        return (const float*)(const __attribute__((address_space(1))) float*)q;
    }
};
struct Ctx { InTab in; unsigned char* ws; float* out; };

DI unsigned pk2(float a, float b) { bf16x2_t v; v[0] = (__bf16)a; v[1] = (__bf16)b; return __builtin_bit_cast(unsigned, v); }
DI bfr f2bf(float a) { return (bfr)(pk2(a, 0.f) & 0xffffu); }
DI float bf2f(bfr b) { return __uint_as_float(((unsigned)b) << 16); }
DI float bflo(unsigned u) { return __uint_as_float(u << 16); }
DI float bfhi(unsigned u) { return __uint_as_float(u & 0xffff0000u); }
DI uint4 pack8(const float (&v)[8]) { return make_uint4(pk2(v[0], v[1]), pk2(v[2], v[3]), pk2(v[4], v[5]), pk2(v[6], v[7])); }
DI void unpack8(uint4 u, float (&v)[8]) { v[0] = bflo(u.x); v[1] = bfhi(u.x); v[2] = bflo(u.y); v[3] = bfhi(u.y); v[4] = bflo(u.z); v[5] = bfhi(u.z); v[6] = bflo(u.w); v[7] = bfhi(u.w); }
DI float frcp(float x) { return __builtin_amdgcn_rcpf(x); }
DI float fexp(float x) { return __builtin_amdgcn_exp2f(x * 1.4426950408889634f); }
DI float sigmoidf_(float x) { return frcp(1.0f + fexp(-x)); }
DI float ftanh(float x) { return 2.0f * frcp(1.0f + fexp(-2.0f * x)) - 1.0f; }
DI float fsoftplus(float z) { return z > 20.0f ? z : __logf(1.0f + fexp(z)); }
template <int CTRL> DI float dpp_f(float x) { return __builtin_bit_cast(float, __builtin_amdgcn_update_dpp(0, __builtin_bit_cast(int, x), CTRL, 0xf, 0xf, false)); }
DI float row16_sum(float s) {
    s += dpp_f<0x128>(s); s += dpp_f<0x124>(s); s += dpp_f<0x122>(s); s += dpp_f<0x121>(s); return s; }
DI int ltid() { int t = threadIdx.x; asm volatile("" : "+v"(t)); return t; }
DI float dot4n(float s0, float s1, float s2, float s3, const float4& a) {
    float d;
    asm("v_mul_f32 %0, %1, %5\n\tv_fma_f32 %0, %2, %6, %0\n\tv_fma_f32 %0, %3, %7, %0\n\tv_fma_f32 %0, %4, %8, %0\n\ts_nop 1"
        : "=&v"(d) : "v"(s0), "v"(s1), "v"(s2), "v"(s3), "v"(a.x), "v"(a.y), "v"(a.z), "v"(a.w));
    return d;
}
DI void rw_upd(float& S, float w, float sa, float b, float vi, float k) {
    float t;
    asm("v_mul_f32 %1, %4, %5\n\tv_fma_f32 %1, %2, %3, %1\n\tv_fma_f32 %0, %0, %6, %1"
        : "+v"(S), "=&v"(t) : "v"(sa), "v"(b), "v"(vi), "v"(k), "v"(w));
}
DI float wave_sum(float s) { s = row16_sum(s); s += __shfl_xor(s, 16); s += __shfl_xor(s, 32); return s; }
#define XB_TMO      128
#define XB_XCNT(j)  (256  + 64 * (j))
#define XB_XSUB(j)  (1280 + 64 * (j))
#define XB_XGEN(j)  (2304 + 64 * (j))
#define XB_TOP      3328
#define XB_TOPGEN   3392
#define XCD_BAR_WORDS 3456
#define XB_SPIN_CAP (1u << 18)
#define LAS __attribute__((address_space(3)))

__device__ __forceinline__ unsigned xb_ld(unsigned* p)              { return __hip_atomic_load(p, __ATOMIC_RELAXED, __HIP_MEMORY_SCOPE_AGENT); }
__device__ __forceinline__ unsigned xb_add(unsigned* p, unsigned v) { return __hip_atomic_fetch_add(p, v, __ATOMIC_RELAXED, __HIP_MEMORY_SCOPE_AGENT); }
__device__ __forceinline__ unsigned xb_xcc_id() { return (unsigned)__builtin_amdgcn_s_getreg((3 << 11) | 20) & 0xFu; }
#define XB_SPIN(cond, bar) do { unsigned _sp = 0; while (cond) { __builtin_amdgcn_s_sleep(1); \
    if ((++_sp & 255u) == 0u) { if (xb_ld(&(bar)[XB_TMO])) break; if (_sp > XB_SPIN_CAP) { atomicAdd(&(bar)[XB_TMO], 1u); break; } } } } while (0)

struct XcdBarrier {
    unsigned* bar; unsigned x;
    volatile LAS unsigned* st;
};
__device__ __forceinline__ XcdBarrier xcd_barrier_post(unsigned* bar, volatile LAS unsigned* st) {
    XcdBarrier b; b.bar = bar; b.x = xb_xcc_id(); b.st = st;
    if (threadIdx.x == 0) (void)xb_add(&bar[XB_XCNT(b.x)], 1u);
    return b;
}
__device__ __forceinline__ void xcd_barrier_complete(unsigned* bar, unsigned x, unsigned& nloc, unsigned& nx) {
    const unsigned G = gridDim.x * gridDim.y * gridDim.z;
    unsigned sum, cnt, mine, sp = 0u;
    for (;;) {
        sum = 0u; cnt = 0u; mine = 0u;
#pragma unroll
        for (unsigned j = 0; j < 16; ++j) { const unsigned c = xb_ld(&bar[XB_XCNT(j)]); sum += c; cnt += (c > 0u) ? 1u : 0u; mine = (j == x) ? c : mine; }
        if (sum == G) break;
        __builtin_amdgcn_s_sleep(1);
        if ((++sp & 255u) == 0u) { if (xb_ld(&bar[XB_TMO])) break; if (sp > XB_SPIN_CAP) { atomicAdd(&bar[XB_TMO], 1u); break; } }
    }
    nloc = mine > 0u ? mine : 1u; nx = cnt > 0u ? cnt : 1u;
}
__device__ __forceinline__ void xcd_barrier(const XcdBarrier& b) {
    asm volatile("s_waitcnt vmcnt(0)" ::: "memory");
    __syncthreads();
    if (threadIdx.x == 0) {
        unsigned* bar = b.bar;
        __builtin_amdgcn_s_waitcnt(0);
        unsigned nloc = b.st[0], nx = b.st[1];
        if (nloc == 0u) { xcd_barrier_complete(bar, b.x, nloc, nx); b.st[0] = nloc; b.st[1] = nx; }
        const unsigned old = xb_add(&bar[XB_XSUB(b.x)], 1u);
        const unsigned gen = old / nloc;
        if (old + 1u == (gen + 1u) * nloc) {
            __builtin_amdgcn_fence(__ATOMIC_RELEASE, "agent");
            asm volatile("s_waitcnt vmcnt(0)" ::: "memory");
            const unsigned og = xb_add(&bar[XB_TOP], 1u);
            const unsigned tg = og / nx;
            if (og + 1u == (tg + 1u) * nx) xb_add(&bar[XB_TOPGEN], 1u);
            else XB_SPIN(xb_ld(&bar[XB_TOPGEN]) == tg, bar);
            __builtin_amdgcn_fence(__ATOMIC_ACQUIRE, "agent");
            xb_add(&bar[XB_XGEN(b.x)], 1u);
            asm volatile("s_waitcnt vmcnt(0)" ::: "memory");
        } else {
            XB_SPIN(xb_ld(&bar[XB_XGEN(b.x)]) == gen, bar);
            __builtin_amdgcn_fence(__ATOMIC_ACQUIRE, "agent");
            asm volatile("s_waitcnt vmcnt(0)" ::: "memory");
        }
    }
    __syncthreads();
}

constexpr int LDA = 72;
constexpr int TILE_B = 128 * LDA * 2;
constexpr int STG_LD = 132;
constexpr int LDS_AUX = 139264;
typedef const __attribute__((address_space(1))) unsigned* GPtrU;
typedef __attribute__((address_space(3))) unsigned* LPtrU;
DI int gt_lcol(int t) { return (((t & 7) ^ ((t >> 4) & 7)) * 8); }

template <int WR, int WC, int MI, int NI, class AF, class BF, class EF>
DI void gemm8(char* lds, int nk, AF aptr, BF bptr, EF epi) {
    static_assert(WR * WC == NWAVES && WR * MI * 32 == 256, "wave grid");
    constexpr int NT = WC * NI * 32, A_BYTES = 256 * 128, STAGE = A_BYTES + NT * 128, NB = NT / 64, NP = NT / 128;
    const int tid = ltid(), lane = tid & 63, wave = tid >> 6;
    const int wr = wave / WC, wc = wave % WC;
    f32x16 acc[MI][NI];
#pragma unroll
    for (int a = 0; a < MI; ++a)
#pragma unroll
        for (int b = 0; b < NI; ++b)
#pragma unroll
            for (int r = 0; r < 16; ++r) acc[a][b][r] = 0.f;
#define G8_DMA(kt_, base_) do { char* db_ = (base_) + tid * 16; \
        _Pragma("unroll") for (int i_ = 0; i_ < 4; ++i_) __builtin_amdgcn_global_load_lds((GPtrU)aptr(i_, kt_), (LPtrU)(db_ + i_ * 8192), 16, 0, 0); \
        _Pragma("unroll") for (int i_ = 0; i_ < NB; ++i_) __builtin_amdgcn_global_load_lds((GPtrU)bptr(i_, kt_), (LPtrU)(db_ + A_BYTES + i_ * 8192), 16, 0, 0); } while (0)
#define G8_KS(cb_, ao_, bo_) do { bf16x8 af_[MI], bf_[NI]; \
        _Pragma("unroll") for (int m_ = 0; m_ < MI; ++m_) af_[m_] = *(const bf16x8*)((cb_) + (ao_) + m_ * 4096); \
        _Pragma("unroll") for (int n_ = 0; n_ < NI; ++n_) bf_[n_] = *(const bf16x8*)((cb_) + (bo_) + n_ * 4096); \
        _Pragma("unroll") for (int m_ = 0; m_ < MI; ++m_) _Pragma("unroll") for (int n_ = 0; n_ < NI; ++n_) acc[m_][n_] = MFMA32(af_[m_], bf_[n_], acc[m_][n_]); } while (0)
    const int ln = lane & 31, hf = lane >> 5, sw = (ln >> 1) & 7;
    const int arow = (wr * MI * 32 + ln) * 128, brow = A_BYTES + (wc * NI * 32 + ln) * 128;
    int ao0 = arow + ((0 + hf) ^ sw) * 16, ao1 = arow + ((2 + hf) ^ sw) * 16, ao2 = arow + ((4 + hf) ^ sw) * 16, ao3 = arow + ((6 + hf) ^ sw) * 16;
    int bo0 = brow + ((0 + hf) ^ sw) * 16, bo1 = brow + ((2 + hf) ^ sw) * 16, bo2 = brow + ((4 + hf) ^ sw) * 16, bo3 = brow + ((6 + hf) ^ sw) * 16;
    asm volatile("" : "+v"(ao0), "+v"(ao1), "+v"(ao2), "+v"(ao3), "+v"(bo0), "+v"(bo1), "+v"(bo2), "+v"(bo3));
    G8_DMA(0, lds);
    asm volatile("s_waitcnt vmcnt(0)" ::: "memory");
    __syncthreads();
    int buf = 0;
#pragma unroll 1
    for (int kt = 0; kt < nk - 1; ++kt) {
        G8_DMA(kt + 1, lds + (buf ^ 1) * STAGE);
        const char* cb = lds + buf * STAGE;
        G8_KS(cb, ao0, bo0); G8_KS(cb, ao1, bo1); G8_KS(cb, ao2, bo2); G8_KS(cb, ao3, bo3);
        asm volatile("s_waitcnt vmcnt(0)" ::: "memory");
        __syncthreads();
        buf ^= 1;
    }
    {
        const char* cb = lds + buf * STAGE;
        G8_KS(cb, ao0, bo0); G8_KS(cb, ao1, bo1); G8_KS(cb, ao2, bo2); G8_KS(cb, ao3, bo3);
    }
    __syncthreads();
#undef G8_DMA
#undef G8_KS
    float* stg = (float*)lds;
    int w_off = (wr * MI * 32 + 4 * (lane >> 5)) * STG_LD + ((wc * NI * 32) & 127) + (lane & 31);
    asm volatile("" : "+v"(w_off));
#pragma unroll
    for (int p = 0; p < NP; ++p) {
        if (((wc * NI * 32) >> 7) == p) {
#pragma unroll
            for (int m = 0; m < MI; ++m)
#pragma unroll
                for (int n = 0; n < NI; ++n)
#pragma unroll
                    for (int r = 0; r < 16; ++r)
                        stg[w_off + (m * 32 + (r & 3) + 8 * (r >> 2)) * STG_LD + n * 32] = acc[m][n][r];
        }
        __syncthreads();
        epi((const float*)stg, p);
        __syncthreads();
    }
}
template <class F> DI void epi_rows8(const float* stg, F f) {
    const int tid0 = ltid();
#pragma unroll
    for (int it = 0; it < 8; ++it) {
        const int idx = it * NTHREADS + tid0;
        const int r = idx >> 4, c0 = (idx & 15) * 8;
        const float4 p = *(const float4*)(stg + r * STG_LD + c0);
        const float4 q = *(const float4*)(stg + r * STG_LD + c0 + 4);
        const float v[8] = {p.x, p.y, p.z, p.w, q.x, q.y, q.z, q.w};
        f(r, c0, v);
    }
}
template <class T, class L, class F> DI void epi_rows8_pre(const float* stg, L loadf, F f) {
    const int tid0 = ltid();
    constexpr int BATCH = sizeof(T) > 16 ? 2 : 4;
#pragma unroll
    for (int h = 0; h < 8 / BATCH; ++h) {
        T pre[BATCH];
#pragma unroll
        for (int it = 0; it < BATCH; ++it) { const int idx = (h * BATCH + it) * NTHREADS + tid0; pre[it] = loadf(idx >> 4, (idx & 15) * 8); }
#pragma unroll
        for (int it = 0; it < BATCH; ++it) {
            const int idx = (h * BATCH + it) * NTHREADS + tid0;
            const int r = idx >> 4, c0 = (idx & 15) * 8;
            const float4 p = *(const float4*)(stg + r * STG_LD + c0);
            const float4 q = *(const float4*)(stg + r * STG_LD + c0 + 4);
            const float v[8] = {p.x, p.y, p.z, p.w, q.x, q.y, q.z, q.w};
            f(r, c0, v, pre[it]);
        }
    }
}
struct F8 { float4 a, b; };
DI void tile_remap(int L, int nM, int nN, int& pm, int& pn) {
    const int ntiles = nM * nN;
    int w = L;
    if ((ntiles & 7) == 0) w = (L & 7) * (ntiles >> 3) + (L >> 3);
    const int nig = 8 * nN, gid = w / nig, fm = gid * 8, rem = w - gid * nig;
    const int gsz = (nM - fm) < 8 ? (nM - fm) : 8;
    pm = fm + rem % gsz; pn = rem / gsz;
}
struct RowLoader {
    const bfr* p; size_t ld;
    DI RowLoader(const bfr* base, int row0, size_t ld_) : ld(ld_) { const int t = ltid(); p = base + (size_t)(row0 + (t >> 3)) * ld_ + gt_lcol(t); }
    DI const bfr* operator()(int i, int kt) const { return p + (size_t)(64 * i) * ld + kt * 64; }
};
#define GEMM256 gemm8<2, 4, 4, 2>
#define GEMM128 gemm8<4, 2, 2, 2>
struct G4 { char* lds; int tid; int vb; int nvb; volatile LAS unsigned* cnt; };
constexpr int G4_LDS = 77824;
constexpr int G4_AUX = 73728;
constexpr int G4_TILE = 128 * 128;
DI G4 g4_make(char* lds) {
    G4 g; const int t = ltid(); const int grp = t >> 8;
    g.lds = lds + grp * G4_LDS; g.tid = t & 255; g.vb = blockIdx.x * 2 + grp; g.nvb = gridDim.x * 2;
    g.cnt = (volatile LAS unsigned*)(lds + LDS_BYTES - 32) + grp;
    return g;
}
DI void g4_bar(const G4& G) {
    asm volatile("s_waitcnt lgkmcnt(0)" ::: "memory");
    unsigned target = 0;
    if ((G.tid & 63) == 0) {
        const unsigned old = __hip_atomic_fetch_add((LAS unsigned*)G.cnt, 1u, __ATOMIC_RELAXED, __HIP_MEMORY_SCOPE_WORKGROUP);
        target = (old & ~3u) + 4u;
    }
    target = __builtin_amdgcn_readfirstlane(target);
    while ((int)(*G.cnt - target) < 0) __builtin_amdgcn_s_sleep(1);
    asm volatile("" ::: "memory");
}
template <class F> DI void g4_epi_rows8(const G4& G, const float* stg, F f) {
#pragma unroll
    for (int it = 0; it < 8; ++it) {
        const int idx = it * 256 + G.tid;
        const int r = idx >> 4, c0 = (idx & 15) * 8;
        const float4 p = *(const float4*)(stg + r * STG_LD + c0);
        const float4 q = *(const float4*)(stg + r * STG_LD + c0 + 4);
        const float v[8] = {p.x, p.y, p.z, p.w, q.x, q.y, q.z, q.w};
        f(r, c0, v);
    }
}
template <class T, class L, class F> DI void g4_epi_rows8_pre(const G4& G, const float* stg, L loadf, F f) {
    T pre[8];
#pragma unroll
    for (int it = 0; it < 8; ++it) { const int idx = it * 256 + G.tid; pre[it] = loadf(idx >> 4, (idx & 15) * 8); }
#pragma unroll
    for (int it = 0; it < 8; ++it) {
        const int idx = it * 256 + G.tid;
        const int r = idx >> 4, c0 = (idx & 15) * 8;
        const float4 p = *(const float4*)(stg + r * STG_LD + c0);
        const float4 q = *(const float4*)(stg + r * STG_LD + c0 + 4);
        const float v[8] = {p.x, p.y, p.z, p.w, q.x, q.y, q.z, q.w};
        f(r, c0, v, pre[it]);
    }
}
struct G4RowLoader {
    const bfr* p; size_t ld;
    DI G4RowLoader(const G4& G, const bfr* base, int row0, size_t ld_) : ld(ld_) { p = base + (size_t)(row0 + (G.tid >> 3)) * ld_ + gt_lcol(G.tid); }
    DI const bfr* operator()(int i, int kt) const { return p + (size_t)(32 * i) * ld + kt * 64; }
};
template <class AF, class BF, class EF>
DI void g4_gemm_tile(const G4& G, char* lds, int nk, AF aptr, BF bptr, EF epi) {
    const int tid = G.tid, lane = tid & 63, wave = tid >> 6;
    const int wr = wave >> 1, wc = wave & 1;
    f32x16 acc00, acc01, acc10, acc11;
#pragma unroll
    for (int r = 0; r < 16; ++r) { acc00[r] = 0.f; acc01[r] = 0.f; acc10[r] = 0.f; acc11[r] = 0.f; }
#define GT_DMA(kt_, base_) do { char* db_ = (base_) + tid * 16; _Pragma("unroll") for (int i_ = 0; i_ < 4; ++i_) { \
        __builtin_amdgcn_global_load_lds((GPtrU)aptr(i_, kt_), (LPtrU)(db_ + i_ * 4096), 16, 0, 0); \
        __builtin_amdgcn_global_load_lds((GPtrU)bptr(i_, kt_), (LPtrU)(db_ + G4_TILE + i_ * 4096), 16, 0, 0); } } while (0)
#define GT_FRAG(cb_, off_) (*(const bf16x8*)((cb_) + (off_)))
#define GT_COMPUTE(base_) do { const char* cb_ = (base_); \
        { const bf16x8 a0 = GT_FRAG(cb_, ao0), a1 = GT_FRAG(cb_, ao0 + 4096), b0 = GT_FRAG(cb_, bo0), b1 = GT_FRAG(cb_, bo0 + 4096); \
          acc00 = MFMA32(a0, b0, acc00); acc01 = MFMA32(a0, b1, acc01); acc10 = MFMA32(a1, b0, acc10); acc11 = MFMA32(a1, b1, acc11); } \
        { const bf16x8 a0 = GT_FRAG(cb_, ao1), a1 = GT_FRAG(cb_, ao1 + 4096), b0 = GT_FRAG(cb_, bo1), b1 = GT_FRAG(cb_, bo1 + 4096); \
          acc00 = MFMA32(a0, b0, acc00); acc01 = MFMA32(a0, b1, acc01); acc10 = MFMA32(a1, b0, acc10); acc11 = MFMA32(a1, b1, acc11); } \
        { const bf16x8 a0 = GT_FRAG(cb_, ao2), a1 = GT_FRAG(cb_, ao2 + 4096), b0 = GT_FRAG(cb_, bo2), b1 = GT_FRAG(cb_, bo2 + 4096); \
          acc00 = MFMA32(a0, b0, acc00); acc01 = MFMA32(a0, b1, acc01); acc10 = MFMA32(a1, b0, acc10); acc11 = MFMA32(a1, b1, acc11); } \
        { const bf16x8 a0 = GT_FRAG(cb_, ao3), a1 = GT_FRAG(cb_, ao3 + 4096), b0 = GT_FRAG(cb_, bo3), b1 = GT_FRAG(cb_, bo3 + 4096); \
          acc00 = MFMA32(a0, b0, acc00); acc01 = MFMA32(a0, b1, acc01); acc10 = MFMA32(a1, b0, acc10); acc11 = MFMA32(a1, b1, acc11); } } while (0)
    const int ln = lane & 31, hf = lane >> 5, sw = (ln >> 1) & 7;
    int ao0 = wr * 8192 + ln * 128 + ((0 + hf) ^ sw) * 16, ao1 = wr * 8192 + ln * 128 + ((2 + hf) ^ sw) * 16;
    int ao2 = wr * 8192 + ln * 128 + ((4 + hf) ^ sw) * 16, ao3 = wr * 8192 + ln * 128 + ((6 + hf) ^ sw) * 16;
    int bo0 = G4_TILE + wc * 8192 + ln * 128 + ((0 + hf) ^ sw) * 16, bo1 = G4_TILE + wc * 8192 + ln * 128 + ((2 + hf) ^ sw) * 16;
    int bo2 = G4_TILE + wc * 8192 + ln * 128 + ((4 + hf) ^ sw) * 16, bo3 = G4_TILE + wc * 8192 + ln * 128 + ((6 + hf) ^ sw) * 16;
    asm volatile("" : "+v"(ao0), "+v"(ao1), "+v"(ao2), "+v"(ao3), "+v"(bo0), "+v"(bo1), "+v"(bo2), "+v"(bo3));
    GT_DMA(0, lds);
    asm volatile("s_waitcnt vmcnt(0)" ::: "memory");
    g4_bar(G);
    int buf = 0;
#pragma unroll 1
    for (int kt = 0; kt < nk - 1; ++kt) {
        GT_DMA(kt + 1, lds + (buf ^ 1) * (2 * G4_TILE));
        GT_COMPUTE(lds + buf * (2 * G4_TILE));
        asm volatile("s_waitcnt vmcnt(0)" ::: "memory");
        g4_bar(G);
        buf ^= 1;
    }
    GT_COMPUTE(lds + buf * (2 * G4_TILE));
    g4_bar(G);
#undef GT_DMA
#undef GT_FRAG
#undef GT_COMPUTE
    float* stg = (float*)lds;
    int w_off = (wr * 64 + 4 * (lane >> 5)) * STG_LD + wc * 64 + (lane & 31);
    asm volatile("" : "+v"(w_off));
#pragma unroll
    for (int r = 0; r < 16; ++r) {
        const int ro = ((r & 3) + 8 * (r >> 2)) * STG_LD;
        stg[w_off + ro] = acc00[r];
        stg[w_off + ro + 32] = acc01[r];
        stg[w_off + ro + 32 * STG_LD] = acc10[r];
        stg[w_off + ro + 32 * STG_LD + 32] = acc11[r];
    }
    g4_bar(G);
    epi((const float*)stg);
    g4_bar(G);
}

DI void g4_attn_item(const G4& G, char* lds, const Ctx& P, int b, int h, int qt, float lam, float lam_init, const float* subln) {
    const bfr* qn = (const bfr*)(P.ws + OFF_QN);
    const bfr* kn = (const bfr*)(P.ws + OFF_KN);
    const bfr* vT = (const bfr*)(P.ws + OFF_VT) + (size_t)(b * 4 + h) * 128 * SEQ;
    bfr* am = (bfr*)(P.ws + OFF_AMIX);
    const int tid = G.tid, lane = tid & 63, wave = tid >> 6;
    const int m = wave >> 1, qw = (wave & 1) * 32;
    const int q0 = qt * 64 + qw;
    const int ln = lane & 31, hf = lane >> 5;
    bf16x8 qf[4];
    {
        const bfr* qp = qn + ((size_t)b * SEQ + q0 + ln) * 512 + h * 128 + m * 64 + hf * 8;
#pragma unroll
        for (int ks = 0; ks < 4; ++ks) qf[ks] = *(const bf16x8*)(qp + ks * 16);
    }
    f32x16 o[4];
#pragma unroll
    for (int d = 0; d < 4; ++d)
#pragma unroll
        for (int r = 0; r < 16; ++r) o[d][r] = 0.f;
    float mrun = -INFINITY, lrun = 0.f;
    const int nkt = qt + 1;
    const int lrow = tid >> 3, lcol = (tid & 7) * 8;
    const bfr* kbase = kn + ((size_t)b * SEQ) * 512 + h * 128;
    unsigned ko = (unsigned)(lrow * 512 + lcol) * 2u, vo = (unsigned)(lrow * SEQ + lcol) * 2u;
    asm volatile("" : "+v"(ko), "+v"(vo));
    uint4 rk0, rk1, rk2, rk3, rv0, rv1, rv2, rv3;
#define ATT_GLOAD(kt_) do { const char* kp_ = (const char*)(kbase + (size_t)(kt_) * (64 * 512)); const char* vp_ = (const char*)(vT + (kt_) * 64); \
        rk0 = *(const uint4*)(kp_ + ko); rk1 = *(const uint4*)(kp_ + 32 * 512 * 2 + ko); rk2 = *(const uint4*)(kp_ + 64 * 2 + ko); rk3 = *(const uint4*)(kp_ + 32 * 512 * 2 + 64 * 2 + ko); \
        rv0 = *(const uint4*)(vp_ + vo); rv1 = *(const uint4*)(vp_ + 32 * SEQ * 2 + vo); rv2 = *(const uint4*)(vp_ + 64 * SEQ * 2 + vo); rv3 = *(const uint4*)(vp_ + 96 * SEQ * 2 + vo); } while (0)
#define ATT_S1(base_, i_, RK, RV) { *(uint4*)((base_) + (32 * (i_)) * LDA * 2) = RK; \
        *(uint4*)((base_) + TILE_B + (32 * (i_)) * LDA * 2) = RV; }
#define ATT_LSTORE(buf_) do { char* base_ = lds + (buf_) * (2 * TILE_B) + s_off; ATT_S1(base_, 0, rk0, rv0) ATT_S1(base_, 1, rk1, rv1) ATT_S1(base_, 2, rk2, rv2) ATT_S1(base_, 3, rk3, rv3) } while (0)
    int k_off = ((m * 64 + ln) * LDA + hf * 8) * 2;
    int v_off = TILE_B + (ln * LDA + 4 * hf) * 2;
    int s_off = (lrow * LDA + lcol) * 2;
    asm volatile("" : "+v"(k_off), "+v"(v_off), "+v"(s_off));
    ATT_GLOAD(0); ATT_LSTORE(0);
    g4_bar(G);
    int buf = 0;
#pragma unroll 1
    for (int kt = 0; kt < nkt; ++kt) {
        const bool more = (kt + 1 < nkt);
        const char* ks_ = lds + buf * (2 * TILE_B) + k_off;
        const char* vs_ = lds + buf * (2 * TILE_B) + v_off;
        if (kt * 64 <= q0 + 31) {
            f32x16 s[2];
#pragma unroll
            for (int kb = 0; kb < 2; ++kb) {
#pragma unroll
                for (int r = 0; r < 16; ++r) s[kb][r] = 0.f;
#pragma unroll
                for (int ks = 0; ks < 4; ++ks) {
                    const bf16x8 kf = *(const bf16x8*)(ks_ + ((kb * 32) * LDA + ks * 16) * 2);
                    s[kb] = MFMA32(kf, qf[ks], s[kb]);
                }
            }
            const int qpos = q0 + ln;
            if (kt * 64 + 63 > q0) {
#pragma unroll
                for (int kb = 0; kb < 2; ++kb)
#pragma unroll
                    for (int r = 0; r < 16; ++r) {
                        const int key = kt * 64 + kb * 32 + (r & 3) + 8 * (r >> 2) + 4 * hf;
                        if (key > qpos) s[kb][r] = -INFINITY;
                    }
            }
            float mx = s[0][0];
#pragma unroll
            for (int kb = 0; kb < 2; ++kb)
#pragma unroll
                for (int r = 0; r < 16; ++r) mx = fmaxf(mx, s[kb][r]);
            mx = fmaxf(mx, __shfl_xor(mx, 32));
            const float mnew = fmaxf(mrun, mx);
            const float alpha = __builtin_amdgcn_exp2f(mrun - mnew);
            mrun = mnew;
            float rsum = 0.f;
#pragma unroll
            for (int kb = 0; kb < 2; ++kb)
#pragma unroll
                for (int r = 0; r < 16; ++r) { const float p = __builtin_amdgcn_exp2f(s[kb][r] - mnew); s[kb][r] = p; rsum += p; }
            lrun = lrun * alpha + rsum;
#pragma unroll
            for (int d = 0; d < 4; ++d)
#pragma unroll
                for (int r = 0; r < 16; ++r) o[d][r] *= alpha;
            __builtin_amdgcn_sched_barrier(0);
            if (more) ATT_GLOAD(kt + 1);
#pragma unroll
            for (int kb = 0; kb < 2; ++kb)
#pragma unroll
                for (int st = 0; st < 2; ++st) {
                    const uint4 pp = make_uint4(pk2(s[kb][8 * st + 0], s[kb][8 * st + 1]), pk2(s[kb][8 * st + 2], s[kb][8 * st + 3]),
                                                pk2(s[kb][8 * st + 4], s[kb][8 * st + 5]), pk2(s[kb][8 * st + 6], s[kb][8 * st + 7]));
                    const bf16x8 pf = __builtin_bit_cast(bf16x8, pp);
                    const int kc = kb * 32 + 16 * st;
#pragma unroll
                    for (int d = 0; d < 4; ++d) {
                        const uint2 v0 = *(const uint2*)(vs_ + ((d * 32) * LDA + kc) * 2);
                        const uint2 v1 = *(const uint2*)(vs_ + ((d * 32) * LDA + kc + 8) * 2);
                        const bf16x8 vf = __builtin_bit_cast(bf16x8, make_uint4(v0.x, v0.y, v1.x, v1.y));
                        o[d] = MFMA32(vf, pf, o[d]);
                    }
                }
        }
        else if (more) ATT_GLOAD(kt + 1);
        if (more) ATT_LSTORE(buf ^ 1);
        g4_bar(G);
        buf ^= 1;
    }
    const float ltot = lrun + __shfl_xor(lrun, 32);
    const float linv = 1.0f / ltot;
    float* ob = (float*)lds;
    int o_off = (m * 64 + qw + ln) * 129 + 4 * hf;
    asm volatile("" : "+v"(o_off));
#pragma unroll
    for (int d = 0; d < 4; ++d)
#pragma unroll
        for (int r = 0; r < 16; ++r) ob[o_off + d * 32 + (r & 3) + 8 * (r >> 2)] = o[d][r] * linv;
    g4_bar(G);
#pragma unroll
    for (int it = 0; it < 4; ++it) {
        const int idx = it * 256 + tid;
        const int q = idx >> 4, c0 = (idx & 15) * 8;
        float v[8];
        float ss = 0.f;
        int r_off = q * 129 + c0;
        asm volatile("" : "+v"(r_off));
#pragma unroll
        for (int j = 0; j < 8; ++j) { v[j] = ob[r_off + j] - lam * ob[r_off + 64 * 129 + j]; ss += v[j] * v[j]; }
        ss = row16_sum(ss);
        const float rs = rsqrtf(ss * (1.0f / 128.0f) + 1e-5f) * (1.0f - lam_init);
#pragma unroll
        for (int j = 0; j < 8; ++j) v[j] = v[j] * rs * subln[c0 + j];
        *(uint4*)(am + ((size_t)b * SEQ + qt * 64 + q) * 1024 + h * 128 + c0) = pack8(v);
    }
    g4_bar(G);
}

#undef ATT_GLOAD
#undef ATT_S1
#undef ATT_LSTORE
#undef ATT_OFF
#undef ATT_G1
DI int cvt_rowmap(int n, int mode) { return mode == 0 ? n : ((n >> 2) * 8 + (n & 3) + (mode == 2 ? 4 : 0)); }
DI void cvt_tile(char* lds, const float* __restrict__ src, int N, bfr* __restrict__ dst, int ldd, int k0, int n0, int mode) {
    float* t = (float*)lds;
    const int tid = ltid();
    const int r = tid >> 5, c = (tid & 31) * 4;
#pragma unroll
    for (int i = 0; i < 4; ++i) {
        const float4 v = *(const float4*)(src + (size_t)(k0 + r + 16 * i) * N + n0 + c);
        float* d = t + (r + 16 * i) * 129 + c;
        d[0] = v.x; d[1] = v.y; d[2] = v.z; d[3] = v.w;
    }
    __syncthreads();
#pragma unroll
    for (int i = 0; i < 2; ++i) {
        const int idx = tid + i * NTHREADS;
        const int n = idx & 127, kg = idx >> 7;
        float v[8];
#pragma unroll
        for (int j = 0; j < 8; ++j) v[j] = t[(kg * 8 + j) * 129 + n];
        *(uint4*)(dst + (size_t)cvt_rowmap(n0 + n, mode) * ldd + k0 + kg * 8) = pack8(v);
    }
    __syncthreads();
}
DI void cvt_matrix(char* lds, const float* src, int K, int N, bfr* dst, int ldd, int mode, int worker, int nworkers, unsigned& base) {
    if (worker < 0) return;
    const int ntn = N >> 7, ntiles = (K >> 6) * ntn;
    int t0 = (int)(((unsigned)worker + (unsigned)nworkers - (base % (unsigned)nworkers)) % (unsigned)nworkers);
    for (int t = t0; t < ntiles; t += nworkers) cvt_tile(lds, src, N, dst, ldd, (t / ntn) * 64, (t % ntn) * 128, mode);
    base += (unsigned)ntiles;
}
DI void moe_convert(char* lds, const Ctx& P, int layer, int worker, int nworkers) {
    unsigned base = 0;
    bfr* wgu = (bfr*)(P.ws + OFF_MWGU); bfr* wd = (bfr*)(P.ws + OFF_MWD);
    for (int e = 0; e < 32; ++e) {
        const size_t we = (size_t)(layer * 32 + e);
        cvt_matrix(lds, P.in[I_MWGATE] + we * 1024 * 512, 1024, 512, wgu + (size_t)e * 1024 * 1024, 1024, 1, worker, nworkers, base);
        cvt_matrix(lds, P.in[I_MWUP]   + we * 1024 * 512, 1024, 512, wgu + (size_t)e * 1024 * 1024, 1024, 2, worker, nworkers, base);
        cvt_matrix(lds, P.in[I_MWDOWN] + we * 512 * 1024, 512, 1024, wd  + (size_t)e * 1024 * 512,  512,  0, worker, nworkers, base);
    }
}

DI void s5_tables(char* lds, const Ctx& P, int i, int g) {
    float2* pw = (float2*)lds;
    float2* bb = pw + 64 * 33;
    float2* cm = bb + 64 * 16;
    float*  kt = (float*)(cm + 16 * 64);
    const int tid = ltid();
    const size_t gp = (size_t)(i * 32 + g) * 64;
    for (int idx = tid; idx < 64 * 33; idx += NTHREADS) {
        const int p = idx / 33, tau = idx % 33;
        const float re = fminf(P.in[I_ARE][gp + p], -1e-4f), im = P.in[I_AIM][gp + p];
        const float st = expf(P.in[I_LSTEP][gp + p]);
        const float mag = expf(re * st * (float)tau);
        const double angd = (double)im * (double)st * (double)tau;
        const double red = angd - 6.283185307179586 * floor(angd * 0.15915494309189535);
        float sn, cs; sincosf((float)red, &sn, &cs);
        pw[idx] = make_float2(mag * cs, mag * sn);
    }
    for (int idx = tid; idx < 64 * 16; idx += NTHREADS) {
        const int p = idx >> 4, c = idx & 15;
        const double re = fmin((double)P.in[I_ARE][gp + p], -1e-4), im = (double)P.in[I_AIM][gp + p];
        const double st = exp((double)P.in[I_LSTEP][gp + p]);
        const double mag = exp(re * st), lr = mag * cos(im * st) - 1.0, li = mag * sin(im * st);
        const double den = re * re + im * im;
        const double fr = (lr * re + li * im) / den, fi = (li * re - lr * im) / den;
        const double br = (double)P.in[I_BRE][(gp + p) * 16 + c], bi = (double)P.in[I_BIM][(gp + p) * 16 + c];
        bb[idx] = make_float2((float)(fr * br - fi * bi), (float)(fr * bi + fi * br));
        const int cc = idx >> 6, pp = idx & 63;
        cm[idx] = make_float2(P.in[I_CRE][((size_t)(i * 32 + g) * 16 + cc) * 64 + pp], P.in[I_CIM][((size_t)(i * 32 + g) * 16 + cc) * 64 + pp]);
    }
    __syncthreads();
    for (int idx = tid; idx < 32 * 256; idx += NTHREADS) {
        const int tau = idx >> 8, c1 = (idx >> 4) & 15, c = idx & 15;
        float s = 0.f;
        for (int p = 0; p < 64; ++p) {
            const float2 a = cm[c1 * 64 + p], w = pw[p * 33 + tau], b = bb[p * 16 + c];
            const float tr = a.x * w.x - a.y * w.y, ti = a.x * w.y + a.y * w.x;
            s += tr * b.x - ti * b.y;
        }
        kt[idx] = s;
    }
    __syncthreads();
    bfr* gt = (bfr*)(P.ws + OFF_S5GT) + (size_t)(i * 32 + g) * 512 * 640;
    for (int idx = tid; idx < 512 * 80; idx += NTHREADS) {
        const int n = idx / 80, ch = idx % 80;
        const int t = n >> 4, c1 = n & 15;
        float v[8];
        if (ch < 64) {
            const int s = ch >> 1, c0 = (ch & 1) * 8;
#pragma unroll
            for (int j = 0; j < 8; ++j) v[j] = (t >= s) ? kt[((t - s) * 16 + c1) * 16 + c0 + j] : 0.f;
        } else {
            const int p0 = (ch - 64) * 4;
#pragma unroll
            for (int j = 0; j < 4; ++j) {
                const float2 a = cm[c1 * 64 + p0 + j], w = pw[(p0 + j) * 33 + t + 1];
                v[2 * j] = a.x * w.x - a.y * w.y;
                v[2 * j + 1] = -(a.x * w.y + a.y * w.x);
            }
        }
        *(uint4*)(gt + (size_t)n * 640 + ch * 8) = pack8(v);
    }
    bfr* bl = (bfr*)(P.ws + OFF_S5BL) + (size_t)(i * 32 + g) * 128 * 512;
    for (int idx = tid; idx < 128 * 64; idx += NTHREADS) {
        const int n = idx >> 6, ch = idx & 63;
        const int p = n >> 1, ri = n & 1, s = ch >> 1, c0 = (ch & 1) * 8;
        const float2 w = pw[p * 33 + 31 - s];
        float v[8];
#pragma unroll
        for (int j = 0; j < 8; ++j) { const float2 b = bb[p * 16 + c0 + j]; v[j] = ri ? (w.x * b.y + w.y * b.x) : (w.x * b.x - w.y * b.y); }
        *(uint4*)(bl + (size_t)n * 512 + ch * 8) = pack8(v);
    }
    float* l32 = (float*)(P.ws + OFF_S5L32) + (size_t)(i * 32 + g) * 128;
    if (tid < 64) { l32[2 * tid] = pw[tid * 33 + 32].x; l32[2 * tid + 1] = pw[tid * 33 + 32].y; }
    __syncthreads();
}

DI void norm_rows(const float* __restrict__ x, const float* __restrict__ g, bfr* __restrict__ hb, bfr* __restrict__ hlo, float* __restrict__ xcopy, int tok0, int ntok) {
    const int tid_ = ltid();
    const int lane = tid_ & 63, wave = tid_ >> 6;
    for (int tk = wave; tk < ntok; tk += NWAVES) {
        const size_t tok = (size_t)(tok0 + tk);
        float4 v[4];
        float ss = 0.f;
#pragma unroll
        for (int i = 0; i < 4; ++i) {
            v[i] = *(const float4*)(x + tok * DM + i * 256 + lane * 4);
            ss += v[i].x * v[i].x + v[i].y * v[i].y + v[i].z * v[i].z + v[i].w * v[i].w;
        }
        ss = wave_sum(ss);
        const float rs = rsqrtf(ss * (1.0f / DM) + 1e-6f);
#pragma unroll
        for (int i = 0; i < 4; ++i) {
            const float4 gg = *(const float4*)(g + i * 256 + lane * 4);
            const float h0 = v[i].x * rs * gg.x, h1 = v[i].y * rs * gg.y, h2 = v[i].z * rs * gg.z, h3 = v[i].w * rs * gg.w;
            const unsigned p0 = pk2(h0, h1), p1 = pk2(h2, h3);
            *(uint2*)(hb + tok * DM + i * 256 + lane * 4) = make_uint2(p0, p1);
            if (hlo) {
                const unsigned q0 = pk2(h0 - bflo(p0), h1 - bfhi(p0)), q1 = pk2(h2 - bflo(p1), h3 - bfhi(p1));
                *(uint2*)(hlo + tok * DM + i * 256 + lane * 4) = make_uint2(q0, q1);
            }
            if (xcopy) *(float4*)(xcopy + tok * DM + i * 256 + lane * 4) = v[i];
        }
    }
}
DI void phase_e1(char* lds, const Ctx& P, int li) {
    const bfr* hb = (const bfr*)(P.ws + OFF_HB);
    const bfr* w = (const bfr*)(P.ws + OFF_WINE) + (size_t)li * 2304 * 1024;
    bfr* u = (bfr*)(P.ws + OFF_U);
    for (int t = blockIdx.x; t < 128 * 9; t += gridDim.x) {
        int mt, nt; tile_remap(t, 128, 9, mt, nt);
        RowLoader A(hb, mt * 256, 1024), B(w, nt * 256, 1024);
        GEMM256(lds, 16, A, B, [&](const float* stg, int p) __attribute__((always_inline)) {
            epi_rows8(stg, [&](int r, int c0, const float (&v)[8]) __attribute__((always_inline)) {
                *(uint4*)(u + (size_t)(mt * 256 + r) * EVEN_IN + nt * 256 + p * 128 + c0) = pack8(v);
            });
        });
    }
}

DI void phase_e2a(const Ctx& P, int li) {
    const bfr* u = (const bfr*)(P.ws + OFF_U);
    const float* mu = P.in[I_MU] + (size_t)li * 1792;
    bfr* S = (bfr*)(P.ws + OFF_S);
    bfr* mv = (bfr*)(P.ws + (li == 0 ? OFF_VFIRST : OFF_MV2));
    bfr* dpool = (bfr*)(P.ws + OFF_DPOOL);
    const int total = NTOK * 160;
    for (int idx = blockIdx.x * NTHREADS + ltid(); idx < total; idx += gridDim.x * NTHREADS) {
        const int tok = idx / 160, ch = idx % 160;
        const int col = 1024 + ch * 8;
        const int t = tok & (SEQ - 1);
        const bfr* row = u + (size_t)tok * EVEN_IN;
        float cur[8];
        unpack8(*(const uint4*)(row + col), cur);
        if (col < 1792) {
            float prv[8], m[8];
            if (t > 0) unpack8(*(const uint4*)(row - EVEN_IN + col), prv);
            else {
#pragma unroll
                for (int j = 0; j < 8; ++j) prv[j] = 0.f;
            }
            const float4 m0 = *(const float4*)(mu + col), m1 = *(const float4*)(mu + col + 4);
            const float mm[8] = {m0.x, m0.y, m0.z, m0.w, m1.x, m1.y, m1.z, m1.w};
#pragma unroll
            for (int j = 0; j < 8; ++j) m[j] = cur[j] + (prv[j] - cur[j]) * mm[j];
            if (col < 1536) {
                *(uint4*)(mv + (size_t)tok * 512 + (col - 1024)) = pack8(m);
            } else if (col < 1600) {
#pragma unroll
                for (int j = 0; j < 8; ++j) m[j] = ftanh(m[j]);
                *(uint4*)(S + (size_t)tok * 256 + (col - 1536)) = pack8(m);
            } else if (col < 1664) {
                *(uint4*)(S + (size_t)tok * 256 + 64 + (col - 1600)) = pack8(m);
            } else {
#pragma unroll
                for (int j = 0; j < 8; ++j) m[j] = sigmoidf_(m[j]);
                *(uint4*)(S + (size_t)tok * 256 + 128 + (col - 1664)) = pack8(m);
            }
        } else {
            const int gi = (col - 1792) >> 7;
            const int win = 2 << gi;
            const int nw = (t + 1 < win) ? (t + 1) : win;
            float acc[8];
#pragma unroll
            for (int j = 0; j < 8; ++j) acc[j] = cur[j];
#define POOL_WIN(W) { uint4 pv[W - 1]; _Pragma("unroll") for (int s = 1; s < W; ++s) pv[s - 1] = *(const uint4*)(row - (size_t)(s < nw ? s : 0) * EVEN_IN + col); \
                      _Pragma("unroll") for (int s = 1; s < W; ++s) { float pq[8]; unpack8(pv[s - 1], pq); const float wgt = s < nw ? 1.f : 0.f; \
                          _Pragma("unroll") for (int j = 0; j < 8; ++j) acc[j] += wgt * pq[j]; } }
            if (gi == 0) POOL_WIN(2) else if (gi == 1) POOL_WIN(4) else if (gi == 2) POOL_WIN(8) else POOL_WIN(16)
#undef POOL_WIN
            const float inv = frcp((float)nw);
#pragma unroll
            for (int j = 0; j < 8; ++j) acc[j] = acc[j] * inv - cur[j];
            *(uint4*)(dpool + (size_t)tok * 512 + (col - 1792)) = pack8(acc);
        }
    }
}

DI void phase_e2b(char* lds, const Ctx& P, int li) {
    const bfr* S = (const bfr*)(P.ws + OFF_S);
    const int njobs = (li == 1) ? 20 : 16;
    for (int t = blockIdx.x; t < 128 * njobs; t += gridDim.x) {
        const int mt = t / njobs, j = t % njobs;
        const int job = j >> 2, nt = j & 3;
        const int m0 = mt * 256;
        if (job == 0) {
            RowLoader A(S, m0, 256), B((const bfr*)(P.ws + OFF_W2T) + (size_t)li * 512 * 64, nt * 128, 64);
            const float* w0 = P.in[I_W0] + li * 512;
            float* dlog = (float*)(P.ws + OFF_DLOG);
            GEMM128(lds, 1, A, B, [&](const float* stg, int) __attribute__((always_inline)) {
                epi_rows8(stg, [&](int r, int c0, const float (&v)[8]) __attribute__((always_inline)) {
                    float o[8];
#pragma unroll
                    for (int q = 0; q < 8; ++q) {
                        const float z = -(w0[nt * 128 + c0 + q] + v[q]);
                        o[q] = -fexp(-fsoftplus(z) - 0.5f);
                    }
                    float* d = dlog + (size_t)(m0 + r) * 512 + nt * 128 + c0;
                    *(float4*)d = make_float4(o[0], o[1], o[2], o[3]); *(float4*)(d + 4) = make_float4(o[4], o[5], o[6], o[7]);
                });
            });
        } else if (job == 1) {
            RowLoader A(S + 64, m0, 256), B((const bfr*)(P.ws + OFF_A2T) + (size_t)li * 512 * 64, nt * 128, 64);
            const float* a0 = P.in[I_A0] + li * 512;
            bfr* ab = (bfr*)(P.ws + OFF_ABUF);
            GEMM128(lds, 1, A, B, [&](const float* stg, int) __attribute__((always_inline)) {
                epi_rows8(stg, [&](int r, int c0, const float (&v)[8]) __attribute__((always_inline)) {
                    float o[8];
#pragma unroll
                    for (int q = 0; q < 8; ++q) o[q] = sigmoidf_(a0[nt * 128 + c0 + q] + v[q]);
                    *(uint4*)(ab + (size_t)(m0 + r) * 512 + nt * 128 + c0) = pack8(o);
                });
            });
        } else if (job == 2) {
            RowLoader A(S + 128, m0, 256), B((const bfr*)(P.ws + OFF_G2T) + (size_t)li * 512 * 128, nt * 128, 128);
            bfr* gb = (bfr*)(P.ws + OFF_GBUF);
            GEMM128(lds, 2, A, B, [&](const float* stg, int) __attribute__((always_inline)) {
                epi_rows8(stg, [&](int r, int c0, const float (&v)[8]) __attribute__((always_inline)) {
                    *(uint4*)(gb + (size_t)(m0 + r) * 512 + nt * 128 + c0) = pack8(v);
                });
            });
        } else if (job == 3) {
            RowLoader A((const bfr*)(P.ws + OFF_DPOOL) + nt * 128, m0, 512), B((const bfr*)(P.ws + OFF_POOLT) + (size_t)(li * 4 + nt) * 128 * 128, 0, 128);
            const float* ps = P.in[I_POOLS] + li * 512 + nt * 128;
            bfr* am = (bfr*)(P.ws + OFF_AMIX);
            GEMM128(lds, 2, A, B, [&](const float* stg, int) __attribute__((always_inline)) {
                epi_rows8(stg, [&](int r, int c0, const float (&v)[8]) __attribute__((always_inline)) {
                    float o[8];
#pragma unroll
                    for (int q = 0; q < 8; ++q) o[q] = v[q] * ps[c0 + q];
                    *(uint4*)(am + (size_t)(m0 + r) * 1024 + 512 + nt * 128 + c0) = pack8(o);
                });
            });
        } else {
            RowLoader A((const bfr*)(P.ws + OFF_MV2), m0, 512), B((const bfr*)(P.ws + OFF_V12T), nt * 128, 512);
            const float* v0 = P.in[I_V0];
            bfr* vg = (bfr*)(P.ws + OFF_VGATE);
            GEMM128(lds, 8, A, B, [&](const float* stg, int) __attribute__((always_inline)) {
                epi_rows8(stg, [&](int r, int c0, const float (&v)[8]) __attribute__((always_inline)) {
                    float o[8];
#pragma unroll
                    for (int q = 0; q < 8; ++q) o[q] = sigmoidf_(v0[nt * 128 + c0 + q] + v[q]);
                    *(uint4*)(vg + (size_t)(m0 + r) * 512 + nt * 128 + c0) = pack8(o);
                });
            });
        }
    }
}

constexpr int RW_TC = 32;
constexpr int RW_ROWS = 32;
constexpr int RW_BUF = (5 * RW_TC * 64 + RW_TC * RW_ROWS + RW_TC * RW_ROWS) * 4;
DI void phase_e3(char* lds, const Ctx& P, int li, int probe = 0) {
    const bfr* u = (const bfr*)(P.ws + OFF_U);
    const float* mu = P.in[I_MU] + (size_t)li * 1792;
    const float* dlog = (const float*)(P.ws + OFF_DLOG);
    const bfr* ab = (const bfr*)(P.ws + OFF_ABUF);
    const bfr* vg = (const bfr*)(P.ws + OFF_VGATE);
    const bfr* vf = (const bfr*)(P.ws + OFF_VFIRST);
    float* yout = (float*)(P.ws + (probe ? OFF_HID : OFF_Y));
    float* bonus = (float*)(P.ws + (probe ? OFF_HID : OFF_BONUS));
    const int tid = ltid(), lane = tid & 63, wave = tid >> 6;
    const int pstep = tid >> 4, pc0 = (tid & 15) * 4;
    for (int item = blockIdx.x; item < 256; item += gridDim.x) {
        const int bh = item >> 1, qtr = item & 1;
        const int b = bh >> 3, h = bh & 7;
        const int i0 = qtr * RW_ROWS;
        float c_mur[4], c_muk[4], c_muv[4], c_kk[4], c_ka[4], c_rk[4];
#pragma unroll
        for (int j = 0; j < 4; ++j) {
            const int c = h * 64 + pc0 + j;
            c_mur[j] = mu[c]; c_muk[j] = mu[512 + c]; c_muv[j] = mu[1024 + c];
            c_kk[j] = P.in[I_KK][li * 512 + c]; c_ka[j] = P.in[I_KA][li * 512 + c]; c_rk[j] = P.in[I_RK][li * 512 + c];
        }
        float S0 = 0.f, S1 = 0.f, S2 = 0.f, S3 = 0.f;
        const int rloc = wave * 4 + (lane >> 4);
        const int j0 = (lane & 15) * 4;
        const bool mine = ((pc0 >> 5) == qtr);
        uint2 g_ur, g_uk, g_uv, g_pr, g_pk, g_pv, g_a, g_vg, g_vf; float4 g_d;
#define E3_GLOAD(c_) do { const int t_ = (c_) * RW_TC + pstep; const size_t tok_ = (size_t)b * SEQ + t_; \
            const bfr* row_ = u + tok_ * EVEN_IN + h * 64 + pc0; const bfr* prow_ = row_ - (t_ > 0 ? EVEN_IN : 0); \
            g_ur = *(const uint2*)(row_); g_uk = *(const uint2*)(row_ + 512); g_uv = *(const uint2*)(row_ + 1024); \
            g_pr = *(const uint2*)(prow_); g_pk = *(const uint2*)(prow_ + 512); g_pv = *(const uint2*)(prow_ + 1024); \
            const size_t o_ = tok_ * 512 + h * 64 + pc0; \
            g_a = *(const uint2*)(ab + o_); g_d = *(const float4*)(dlog + o_); \
            if (li == 1) { g_vg = *(const uint2*)(vg + o_); g_vf = *(const uint2*)(vf + o_); } } while (0)
#define E3_PREP(c_, buf_) do { const int t_ = (c_) * RW_TC + pstep; const size_t o_ = ((size_t)b * SEQ + t_) * 512 + h * 64 + pc0; \
            float* sw_ = (float*)(lds + (buf_) * RW_BUF); float* sa_ = sw_ + RW_TC * 64; float* sb_ = sa_ + RW_TC * 64; float* sk_ = sb_ + RW_TC * 64; \
            float* sr_ = sk_ + RW_TC * 64; float* sv_ = sr_ + RW_TC * 64; \
            const float pz_ = t_ > 0 ? 1.f : 0.f; \
            const float ur_[4] = {bflo(g_ur.x), bfhi(g_ur.x), bflo(g_ur.y), bfhi(g_ur.y)}, uk_[4] = {bflo(g_uk.x), bfhi(g_uk.x), bflo(g_uk.y), bfhi(g_uk.y)}; \
            const float uv_[4] = {bflo(g_uv.x), bfhi(g_uv.x), bflo(g_uv.y), bfhi(g_uv.y)}; \
            const float pr_[4] = {bflo(g_pr.x), bfhi(g_pr.x), bflo(g_pr.y), bfhi(g_pr.y)}, pk_[4] = {bflo(g_pk.x), bfhi(g_pk.x), bflo(g_pk.y), bfhi(g_pk.y)}; \
            const float pv_[4] = {bflo(g_pv.x), bfhi(g_pv.x), bflo(g_pv.y), bfhi(g_pv.y)}; \
            const float av_[4] = {bflo(g_a.x), bfhi(g_a.x), bflo(g_a.y), bfhi(g_a.y)}; \
            const float dl_[4] = {g_d.x, g_d.y, g_d.z, g_d.w}; \
            float gv_[4] = {0.f, 0.f, 0.f, 0.f}, fv_[4] = {0.f, 0.f, 0.f, 0.f}; \
            if (li == 1) { gv_[0] = bflo(g_vg.x); gv_[1] = bfhi(g_vg.x); gv_[2] = bflo(g_vg.y); gv_[3] = bfhi(g_vg.y); \
                           fv_[0] = bflo(g_vf.x); fv_[1] = bfhi(g_vf.x); fv_[2] = bflo(g_vf.y); fv_[3] = bfhi(g_vf.y); } \
            float kkr_[4], kmod_[4], rr_[4], vv_[4]; float ssq_ = 0.f, bsum_ = 0.f; \
            _Pragma("unroll") for (int j = 0; j < 4; ++j) { \
                rr_[j] = ur_[j] + (pz_ * pr_[j] - ur_[j]) * c_mur[j]; \
                const float k_ = uk_[j] + (pz_ * pk_[j] - uk_[j]) * c_muk[j]; \
                float v_ = uv_[j] + (pz_ * pv_[j] - uv_[j]) * c_muv[j]; \
                if (li == 1) v_ = v_ + (fv_[j] - v_) * gv_[j]; \
                vv_[j] = v_; kkr_[j] = k_ * c_kk[j]; ssq_ += kkr_[j] * kkr_[j]; \
                kmod_[j] = k_ * (1.0f + (av_[j] - 1.0f) * c_ka[j]); bsum_ += rr_[j] * kmod_[j] * c_rk[j]; } \
            ssq_ = row16_sum(ssq_); bsum_ = row16_sum(bsum_); \
            const float inv_ = frcp(fmaxf(sqrtf(ssq_), 1e-12f)); \
            float4 w4_, a4_, b4_; \
            w4_.x = fexp(dl_[0]); w4_.y = fexp(dl_[1]); w4_.z = fexp(dl_[2]); w4_.w = fexp(dl_[3]); \
            a4_.x = -kkr_[0] * inv_; a4_.y = -kkr_[1] * inv_; a4_.z = -kkr_[2] * inv_; a4_.w = -kkr_[3] * inv_; \
            b4_.x = -a4_.x * av_[0]; b4_.y = -a4_.y * av_[1]; b4_.z = -a4_.z * av_[2]; b4_.w = -a4_.w * av_[3]; \
            *(float4*)(sw_ + pstep * 64 + pc0) = w4_; *(float4*)(sa_ + pstep * 64 + pc0) = a4_; *(float4*)(sb_ + pstep * 64 + pc0) = b4_; \
            *(float4*)(sk_ + pstep * 64 + pc0) = make_float4(kmod_[0], kmod_[1], kmod_[2], kmod_[3]); \
            *(float4*)(sr_ + pstep * 64 + pc0) = make_float4(rr_[0], rr_[1], rr_[2], rr_[3]); \
            if (mine) { *(float4*)(sv_ + pstep * RW_ROWS + (pc0 & 31)) = make_float4(vv_[0], vv_[1], vv_[2], vv_[3]); \
                        *(float4*)(bonus + o_) = make_float4(bsum_ * vv_[0], bsum_ * vv_[1], bsum_ * vv_[2], bsum_ * vv_[3]); } } while (0)
        __syncthreads();
        E3_GLOAD(0);
        E3_PREP(0, 0);
        __syncthreads();
        constexpr int NCH = SEQ / RW_TC;
#pragma unroll 1
        for (int c = 0; c < NCH; ++c) {
            const int buf = c & 1;
            if (c + 1 < NCH && probe != 2) E3_GLOAD(c + 1);
            if (probe != 1) {
                const float* s_w = (const float*)(lds + buf * RW_BUF); const float* s_a = s_w + RW_TC * 64; const float* s_b = s_a + RW_TC * 64;
                const float* s_k = s_b + RW_TC * 64; const float* s_r = s_k + RW_TC * 64; const float* s_v = s_r + RW_TC * 64;
                float* s_y = (float*)(s_v + RW_TC * RW_ROWS);
                float4 na4 = *(const float4*)(s_a + j0), nw4 = *(const float4*)(s_w + j0), nb4 = *(const float4*)(s_b + j0);
                float4 nk4 = *(const float4*)(s_k + j0), nr4 = *(const float4*)(s_r + j0);
                float nvi = s_v[rloc];
#pragma unroll 1
                for (int sg = 0; sg < RW_TC; sg += 4) {
                    float yv[4];
#pragma unroll
                    for (int q = 0; q < 4; ++q) {
                        const int sn = (sg + q + 1) & (RW_TC - 1);
                        const float4 a4 = na4, w4 = nw4, b4 = nb4, k4 = nk4, r4 = nr4; const float vi = nvi;
                        na4 = *(const float4*)(s_a + sn * 64 + j0); nw4 = *(const float4*)(s_w + sn * 64 + j0); nb4 = *(const float4*)(s_b + sn * 64 + j0);
                        nk4 = *(const float4*)(s_k + sn * 64 + j0); nr4 = *(const float4*)(s_r + sn * 64 + j0); nvi = s_v[sn * RW_ROWS + rloc];
                        float sa = dot4n(S0, S1, S2, S3, a4);
                        sa = row16_sum(sa);
                        rw_upd(S0, w4.x, sa, b4.x, vi, k4.x);
                        rw_upd(S1, w4.y, sa, b4.y, vi, k4.y);
                        rw_upd(S2, w4.z, sa, b4.z, vi, k4.z);
                        rw_upd(S3, w4.w, sa, b4.w, vi, k4.w);
                        const float y = dot4n(S0, S1, S2, S3, r4);
                        yv[q] = row16_sum(y);
                    }
                    const int ls = lane & 3;
                    const float yo = ls == 0 ? yv[0] : (ls == 1 ? yv[1] : (ls == 2 ? yv[2] : yv[3]));
                    if ((lane & 15) < 4) s_y[(sg + ls) * RW_ROWS + rloc] = yo;
                }
            }
            if (c + 1 < NCH && probe != 2) E3_PREP(c + 1, buf ^ 1);
            __syncthreads();
            {
                const float* s_y = (const float*)(lds + buf * RW_BUF) + 5 * RW_TC * 64 + RW_TC * RW_ROWS;
#pragma unroll
                for (int q = 0; q < RW_TC * RW_ROWS / NTHREADS; ++q) {
                    const int idx = q * NTHREADS + tid;
                    const int s = idx >> 5, r = idx & 31;
                    yout[((size_t)b * SEQ + c * RW_TC + s) * 512 + h * 64 + i0 + r] = s_y[idx];
                }
            }
        }
#undef E3_GLOAD
#undef E3_PREP
    }
}

DI void phase_e4(const Ctx& P, int li) {
    const float* y = (const float*)(P.ws + OFF_Y);
    const float* bonus = (const float*)(P.ws + OFF_BONUS);
    const bfr* gb = (const bfr*)(P.ws + OFF_GBUF);
    const float* lng = P.in[I_LNG] + li * 512;
    const float* lnb = P.in[I_LNB] + li * 512;
    bfr* am = (bfr*)(P.ws + OFF_AMIX);
    const int total = NTOK * 64;
    for (int idx = blockIdx.x * NTHREADS + ltid(); idx < total; idx += gridDim.x * NTHREADS) {
        const int tok = idx >> 6, c = (idx & 63) * 8;
        const size_t o = (size_t)tok * 512 + c;
        const float4 y0 = *(const float4*)(y + o), y1 = *(const float4*)(y + o + 4);
        float v[8] = {y0.x, y0.y, y0.z, y0.w, y1.x, y1.y, y1.z, y1.w};
        float s = 0.f;
#pragma unroll
        for (int j = 0; j < 8; ++j) s += v[j];
        s += __shfl_xor(s, 1); s += __shfl_xor(s, 2); s += __shfl_xor(s, 4);
        const float mean = s * (1.0f / 64.0f);
        float q = 0.f;
#pragma unroll
        for (int j = 0; j < 8; ++j) { v[j] -= mean; q += v[j] * v[j]; }
        q += __shfl_xor(q, 1); q += __shfl_xor(q, 2); q += __shfl_xor(q, 4);
        const float rstd = rsqrtf(q * (1.0f / 64.0f) + 64e-5f);
        const float4 b0 = *(const float4*)(bonus + o), b1 = *(const float4*)(bonus + o + 4);
        const float bo[8] = {b0.x, b0.y, b0.z, b0.w, b1.x, b1.y, b1.z, b1.w};
        float gv[8];
        unpack8(*(const uint4*)(gb + o), gv);
        float out[8];
#pragma unroll
        for (int j = 0; j < 8; ++j) out[j] = (v[j] * rstd * lng[c + j] + lnb[c + j] + bo[j]) * gv[j];
        *(uint4*)(am + (size_t)tok * 1024 + c) = pack8(out);
    }
}

DI void phase_wout(char* lds, const Ctx& P, const bfr* w, float* x) {
    const bfr* am = (const bfr*)(P.ws + OFF_AMIX);
    for (int t = blockIdx.x; t < 128 * 4; t += gridDim.x) {
        int mt, nt; tile_remap(t, 128, 4, mt, nt);
        RowLoader A(am, mt * 256, 1024), B(w, nt * 256, 1024);
        GEMM256(lds, 16, A, B, [&](const float* stg, int p) __attribute__((always_inline)) {
            epi_rows8_pre<F8>(stg,
                [&](int r, int c0) __attribute__((always_inline)) -> F8 {
                    const float* d = x + (size_t)(mt * 256 + r) * DM + nt * 256 + p * 128 + c0;
                    F8 o; o.a = *(const float4*)d; o.b = *(const float4*)(d + 4); return o; },
                [&](int r, int c0, const float (&v)[8], const F8& o) __attribute__((always_inline)) {
                    float* d = x + (size_t)(mt * 256 + r) * DM + nt * 256 + p * 128 + c0;
                    *(float4*)d = make_float4(o.a.x + v[0], o.a.y + v[1], o.a.z + v[2], o.a.w + v[3]);
                    *(float4*)(d + 4) = make_float4(o.b.x + v[4], o.b.y + v[5], o.b.z + v[6], o.b.w + v[7]);
                });
        });
    }
}
constexpr int RC_L = 32;
constexpr int RC_NCH = SEQ / RC_L;
constexpr int RC_RM = 72;
constexpr int RC_TR = 40;
constexpr int RC_OFF_LG  = 0;
constexpr int RC_OFF_AH  = 8192;
constexpr int RC_OFF_AHT = RC_OFF_AH + 4 * 32 * RC_RM * 2;
constexpr int RC_TRB = 64 * RC_TR * 2 + 8 * 16;
constexpr int RC_OFF_FA  = RC_OFF_AHT + 4 * RC_TRB;
constexpr int RC_OFF_MA  = RC_OFF_FA + 2 * 32 * RC_TR * 2;
constexpr int RC_OFF_W2T = RC_OFF_MA + 4 * 32 * RC_TR * 2;
constexpr int RC_OFF_GL  = RC_OFF_W2T + RC_TRB;
constexpr int RC_LDS_END = RC_OFF_GL + 256;
static_assert(RC_LDS_END <= G4_AUX, "chunk scratch must fit a 4-wave group's LDS");
constexpr size_t OFF_RCG = OFF_HID;
constexpr size_t OFF_RCH = OFF_HB;
constexpr size_t OFF_RCQ = OFF_EV_END;
constexpr size_t OFF_RCZ = OFF_RCQ + (size_t)8192 * 4096;
constexpr size_t OFF_RC_END = OFF_RCZ + (size_t)8192 * 4096;

DI int rc_tro(int c) { return c * (RC_TR * 2) + (c >> 3) * 16; }
DI bf16x8 rc_ld16(const char* p) { return *(const bf16x8*)p; }
DI bf16x8 rc_ld8x2(const char* p) {
    const uint2 a = *(const uint2*)p, b = *(const uint2*)(p + 16);
    return __builtin_bit_cast(bf16x8, make_uint4(a.x, a.y, b.x, b.y));
}
DI bf16x8 rc_pack(const f32x16& x, int s) {
    return __builtin_bit_cast(bf16x8, make_uint4(pk2(x[8 * s], x[8 * s + 1]), pk2(x[8 * s + 2], x[8 * s + 3]), pk2(x[8 * s + 4], x[8 * s + 5]), pk2(x[8 * s + 6], x[8 * s + 7])));
}
DI f32x16 rc_zero() { f32x16 z; _Pragma("unroll") for (int r = 0; r < 16; ++r) z[r] = 0.f; return z; }

DI void phase_r1(char* lds0, const Ctx& P, int li, int probe = 0) {
    const G4 G = g4_make(lds0);
    char* lds = G.lds;
    const int tid = G.tid, lane = tid & 63, wave = tid >> 6;
    const int ln = lane & 31, hf = lane >> 5;
    const bfr* u = (const bfr*)(P.ws + OFF_U);
    const float* mu = P.in[I_MU] + (size_t)li * 1792;
    const float* dlog = (const float*)(P.ws + OFF_DLOG);
    const bfr* ab = (const bfr*)(P.ws + OFF_ABUF);
    const bfr* vg = (const bfr*)(P.ws + OFF_VGATE);
    const bfr* vf = (const bfr*)(P.ws + OFF_VFIRST);
    float* bonus = (float*)(P.ws + OFF_BONUS);
    bfr* gG = (bfr*)(P.ws + OFF_RCG); bfr* gH = (bfr*)(P.ws + OFF_RCH); bfr* gQ = (bfr*)(P.ws + OFF_RCQ); bfr* gZ = (bfr*)(P.ws + OFF_RCZ);
    char* s_rm = lds + RC_OFF_AH;
    char* s_tr = lds + RC_OFF_AHT;
    char* s_im = lds + RC_OFF_FA;
    char* s_ma = lds + RC_OFF_MA;
    char* s_w2t = lds + RC_OFF_W2T;
    float* s_gl = (float*)(lds + RC_OFF_GL);
    constexpr int RMB = 32 * RC_RM * 2, TRB = RC_TRB, MAB = 32 * RC_TR * 2;
    const int ps = tid >> 3, pc0 = (tid & 7) * 8;
    float* s_cst = (float*)(lds + G4_AUX);
    float* s_tot = s_cst + 6 * 64;
    {
        const int h0 = (G.vb >> 6) & 7;
        if (tid < 64) {
            s_cst[0 * 64 + tid] = mu[h0 * 64 + tid]; s_cst[1 * 64 + tid] = mu[512 + h0 * 64 + tid]; s_cst[2 * 64 + tid] = mu[1024 + h0 * 64 + tid];
            s_cst[3 * 64 + tid] = P.in[I_KK][li * 512 + h0 * 64 + tid]; s_cst[4 * 64 + tid] = P.in[I_KA][li * 512 + h0 * 64 + tid]; s_cst[5 * 64 + tid] = P.in[I_RK][li * 512 + h0 * 64 + tid];
        }
        g4_bar(G);
    }
    uint4 g_ur, g_pr, g_uk, g_pk, g_uv, g_pv, g_a, g_vg, g_vf; float4 g_d0, g_d1;
#define RC_PREF(item_) do { const int bh_ = (item_) >> 6, c_ = (item_) & 63; const int t_ = c_ * RC_L + ps; const size_t tok_ = (size_t)(bh_ >> 3) * SEQ + t_; \
        const bfr* row_ = u + tok_ * EVEN_IN + (bh_ & 7) * 64 + pc0; const bfr* prow_ = row_ - (t_ > 0 ? EVEN_IN : 0); const size_t o_ = tok_ * 512 + (bh_ & 7) * 64 + pc0; \
        g_ur = *(const uint4*)row_; g_uk = *(const uint4*)(row_ + 512); g_uv = *(const uint4*)(row_ + 1024); \
        g_pr = *(const uint4*)prow_; g_pk = *(const uint4*)(prow_ + 512); g_pv = *(const uint4*)(prow_ + 1024); \
        g_a = *(const uint4*)(ab + o_); g_d0 = *(const float4*)(dlog + o_); g_d1 = *(const float4*)(dlog + o_ + 4); \
        if (li == 1) { g_vg = *(const uint4*)(vg + o_); g_vf = *(const uint4*)(vf + o_); } } while (0)
    if (G.vb < 128 * RC_NCH) RC_PREF(G.vb);
    for (int item = G.vb; item < 128 * RC_NCH; item += G.nvb) {
        const int bh = item >> 6, c = item & 63;
        const int b = bh >> 3, h = bh & 7;
        float lg[8], dl_[8];
        {
            float a_[8], b_[8], k_[8], r_[8], v_[8];
            const int t = c * RC_L + ps;
            const size_t tok = (size_t)b * SEQ + t;
            const float pz = t > 0 ? 1.f : 0.f;
            const size_t o512 = tok * 512 + h * 64 + pc0;
            float av[8];
            unpack8(g_a, av);
            float c8[8], m8[8], x8[8], y8[8];
#define RC_LD8(dst_, src_) { const float4 x0_ = *(const float4*)(src_), x1_ = *(const float4*)((src_) + 4); dst_[0] = x0_.x; dst_[1] = x0_.y; dst_[2] = x0_.z; dst_[3] = x0_.w; dst_[4] = x1_.x; dst_[5] = x1_.y; dst_[6] = x1_.z; dst_[7] = x1_.w; }
            unpack8(g_ur, x8); unpack8(g_pr, y8); RC_LD8(m8, s_cst + 0 * 64 + pc0)
#pragma unroll
            for (int j = 0; j < 8; ++j) r_[j] = x8[j] + (pz * y8[j] - x8[j]) * m8[j];
            unpack8(g_uk, x8); unpack8(g_pk, y8); RC_LD8(m8, s_cst + 1 * 64 + pc0)
            float kx[8], kkr[8]; float ssq = 0.f, bsum = 0.f;
            RC_LD8(c8, s_cst + 3 * 64 + pc0)
#pragma unroll
            for (int j = 0; j < 8; ++j) { kx[j] = x8[j] + (pz * y8[j] - x8[j]) * m8[j]; kkr[j] = kx[j] * c8[j]; ssq += kkr[j] * kkr[j]; }
            RC_LD8(c8, s_cst + 4 * 64 + pc0)
#pragma unroll
            for (int j = 0; j < 8; ++j) k_[j] = kx[j] * (1.0f + (av[j] - 1.0f) * c8[j]);
            RC_LD8(c8, s_cst + 5 * 64 + pc0)
#pragma unroll
            for (int j = 0; j < 8; ++j) bsum += r_[j] * k_[j] * c8[j];
            unpack8(g_uv, x8); unpack8(g_pv, y8); RC_LD8(m8, s_cst + 2 * 64 + pc0)
#pragma unroll
            for (int j = 0; j < 8; ++j) v_[j] = x8[j] + (pz * y8[j] - x8[j]) * m8[j];
            if (li == 1) {
                unpack8(g_vg, x8); unpack8(g_vf, y8);
#pragma unroll
                for (int j = 0; j < 8; ++j) v_[j] = v_[j] + (y8[j] - v_[j]) * x8[j];
            }
#undef RC_LD8
            ssq += __shfl_xor(ssq, 1); ssq += __shfl_xor(ssq, 2); ssq += __shfl_xor(ssq, 4);
            bsum += __shfl_xor(bsum, 1); bsum += __shfl_xor(bsum, 2); bsum += __shfl_xor(bsum, 4);
            const float inv = frcp(fmaxf(sqrtf(ssq), 1e-12f));
#pragma unroll
            for (int j = 0; j < 8; ++j) { const float kk = kkr[j] * inv; a_[j] = -kk; b_[j] = kk * av[j]; }
            float* bp = bonus + o512;
            *(float4*)bp = make_float4(bsum * v_[0], bsum * v_[1], bsum * v_[2], bsum * v_[3]);
            *(float4*)(bp + 4) = make_float4(bsum * v_[4], bsum * v_[5], bsum * v_[6], bsum * v_[7]);
#pragma unroll
            for (int j = 0; j < 8; ++j) *(bfr*)(s_tr + 3 * TRB + rc_tro(pc0 + j) + ps * 2) = f2bf(v_[j]);
            dl_[0] = g_d0.x; dl_[1] = g_d0.y; dl_[2] = g_d0.z; dl_[3] = g_d0.w; dl_[4] = g_d1.x; dl_[5] = g_d1.y; dl_[6] = g_d1.z; dl_[7] = g_d1.w;
#pragma unroll
            for (int j = 0; j < 8; ++j) lg[j] = dl_[j];
#pragma unroll
            for (int d = 8; d < 64; d <<= 1) {
#pragma unroll
                for (int j = 0; j < 8; ++j) { const float o = __shfl_up(lg[j], d); lg[j] += (lane >= d) ? o : 0.f; }
            }
            *(uint4*)(s_rm + 0 * RMB + (ps * RC_RM + pc0) * 2) = pack8(a_);
            *(uint4*)(s_rm + 1 * RMB + (ps * RC_RM + pc0) * 2) = pack8(b_);
            *(uint4*)(s_rm + 2 * RMB + (ps * RC_RM + pc0) * 2) = pack8(k_);
            *(uint4*)(s_rm + 3 * RMB + (ps * RC_RM + pc0) * 2) = pack8(r_);
            if ((lane >> 3) == 7) { *(float4*)(s_tot + wave * 64 + pc0) = make_float4(lg[0], lg[1], lg[2], lg[3]); *(float4*)(s_tot + wave * 64 + pc0 + 4) = make_float4(lg[4], lg[5], lg[6], lg[7]); }
        }
        g4_bar(G);
        {
#pragma unroll
            for (int w2 = 0; w2 < 3; ++w2) {
                if (w2 < wave) {
                    const float4 e0 = *(const float4*)(s_tot + w2 * 64 + pc0), e1 = *(const float4*)(s_tot + w2 * 64 + pc0 + 4);
                    lg[0] += e0.x; lg[1] += e0.y; lg[2] += e0.z; lg[3] += e0.w; lg[4] += e1.x; lg[5] += e1.y; lg[6] += e1.z; lg[7] += e1.w;
                }
            }
            float ah[8], bhh[8], kh[8], rh[8];
            unpack8(*(const uint4*)(s_rm + 0 * RMB + (ps * RC_RM + pc0) * 2), ah);
            unpack8(*(const uint4*)(s_rm + 1 * RMB + (ps * RC_RM + pc0) * 2), bhh);
            unpack8(*(const uint4*)(s_rm + 2 * RMB + (ps * RC_RM + pc0) * 2), kh);
            unpack8(*(const uint4*)(s_rm + 3 * RMB + (ps * RC_RM + pc0) * 2), rh);
#pragma unroll
            for (int j = 0; j < 8; ++j) {
                const float ep = fexp(lg[j]), em = fexp(-lg[j]), ep1 = fexp(lg[j] - dl_[j]);
                ah[j] *= ep1; bhh[j] *= em; kh[j] *= em; rh[j] *= ep;
                if (ps == RC_L - 1) s_gl[pc0 + j] = ep;
            }
            *(uint4*)(s_rm + 0 * RMB + (ps * RC_RM + pc0) * 2) = pack8(ah);
            *(uint4*)(s_rm + 1 * RMB + (ps * RC_RM + pc0) * 2) = pack8(bhh);
            *(uint4*)(s_rm + 2 * RMB + (ps * RC_RM + pc0) * 2) = pack8(kh);
            *(uint4*)(s_rm + 3 * RMB + (ps * RC_RM + pc0) * 2) = pack8(rh);
#pragma unroll
            for (int j = 0; j < 8; ++j) {
                *(bfr*)(s_tr + 0 * TRB + rc_tro(pc0 + j) + ps * 2) = f2bf(ah[j]);
                *(bfr*)(s_tr + 1 * TRB + rc_tro(pc0 + j) + ps * 2) = f2bf(bhh[j]);
                *(bfr*)(s_tr + 2 * TRB + rc_tro(pc0 + j) + ps * 2) = f2bf(kh[j]);
            }
        }
        if (item + G.nvb < 128 * RC_NCH) RC_PREF(item + G.nvb);
        g4_bar(G);
        if (probe < 3) {
            const char* xa = s_rm + (wave < 2 ? 0 : 3) * RMB;
            const char* xb = s_rm + ((wave & 1) ? 2 : 1) * RMB;
            f32x16 acc = rc_zero();
#pragma unroll
            for (int ks = 0; ks < 4; ++ks)
                acc = MFMA32(rc_ld16(xa + (ln * RC_RM + ks * 16 + hf * 8) * 2), rc_ld16(xb + (ln * RC_RM + ks * 16 + hf * 8) * 2), acc);
#pragma unroll
            for (int r = 0; r < 16; ++r) {
                const int t = (r & 3) + 8 * (r >> 2) + 4 * hf;
                const bool keep = (wave < 2) ? (ln < t) : (ln <= t);
                acc[r] = keep ? acc[r] : 0.f;
                if (wave != 0) *(bfr*)(s_ma + (wave - 1) * MAB + (t * RC_TR + ln) * 2) = f2bf(acc[r]);
            }
            if (wave == 0 && probe < 2) {
                f32x16 Ap = acc, Pa = acc;
#pragma unroll
                for (int r = 0; r < 16; ++r) { const int t = (r & 3) + 8 * (r >> 2) + 4 * hf; Pa[r] += (t == ln) ? 1.f : 0.f; }
                char* imA = s_im; char* imH = s_im + MAB;
#pragma unroll 1
                for (int it = 0; it < 4; ++it) {
#pragma unroll
                    for (int r = 0; r < 16; ++r) {
                        const int t = (r & 3) + 8 * (r >> 2) + 4 * hf;
                        *(bfr*)(imA + (t * RC_TR + ln) * 2) = f2bf(Ap[r]);
                        *(bfr*)(imH + (t * RC_TR + ln) * 2) = f2bf(Pa[r]);
                    }
                    const bf16x8 a0 = rc_pack(Ap, 0), a1 = rc_pack(Ap, 1);
                    const int ro = (ln * RC_TR + 4 * hf) * 2;
                    f32x16 An = rc_zero();
                    An = MFMA32(rc_ld8x2(imA + ro), a0, An);
                    An = MFMA32(rc_ld8x2(imA + ro + 32), a1, An);
                    Ap = An;
                    const bf16x8 b0 = rc_pack(Ap, 0), b1 = rc_pack(Ap, 1);
                    Pa = MFMA32(rc_ld8x2(imH + ro), b0, Pa); Pa = MFMA32(rc_ld8x2(imH + ro + 32), b1, Pa);
                }
#pragma unroll
                for (int r = 0; r < 16; ++r) { const int t = (r & 3) + 8 * (r >> 2) + 4 * hf; *(bfr*)(s_ma + 3 * MAB + (t * RC_TR + ln) * 2) = f2bf(Pa[r]); }
            } else if (wave == 1) {
#pragma unroll
                for (int it = 0; it < 2; ++it) {
                    f32x16 w2 = rc_zero();
#pragma unroll
                    for (int ks = 0; ks < 2; ++ks)
                        w2 = MFMA32(rc_ld16(s_ma + 0 * MAB + (ln * RC_TR + ks * 16 + hf * 8) * 2), rc_ld16(s_tr + 3 * TRB + rc_tro(it * 32 + ln) + (ks * 16 + hf * 8) * 2), w2);
#pragma unroll
                    for (int q = 0; q < 4; ++q)
                        *(uint2*)(s_w2t + rc_tro(it * 32 + ln) + (8 * q + 4 * hf) * 2) = make_uint2(pk2(w2[4 * q], w2[4 * q + 1]), pk2(w2[4 * q + 2], w2[4 * q + 3]));
                }
            }
        }
        g4_bar(G);
        if (probe < 1) {
            const int hp = wave & 1;
            const size_t chunk = (size_t)bh * RC_NCH + c;
            const char* tm = s_ma + 3 * MAB;
            const char* bsrc = (wave < 2) ? (s_tr + 0 * TRB) : s_w2t;
            f32x16 X = rc_zero();
#pragma unroll
            for (int ks = 0; ks < 2; ++ks)
                X = MFMA32(rc_ld16(tm + (ln * RC_TR + ks * 16 + hf * 8) * 2), rc_ld16(bsrc + rc_tro(hp * 32 + ln) + (ks * 16 + hf * 8) * 2), X);
            const bf16x8 xf0 = rc_pack(X, 0), xf1 = rc_pack(X, 1);
            const char* arb = s_ma + 1 * MAB; const char* ark = s_ma + 2 * MAB;
            if (wave < 2) {
#pragma unroll
                for (int jt = 0; jt < 2; ++jt) {
                    f32x16 acc = rc_zero();
                    const char* bp = s_tr + 1 * TRB + rc_tro(jt * 32 + ln) + 8 * hf;
                    acc = MFMA32(xf0, rc_ld8x2(bp), acc);
                    acc = MFMA32(xf1, rc_ld8x2(bp + 32), acc);
                    const int j = jt * 32 + ln;
                    const float gl = s_gl[j];
                    bfr* dst = gG + chunk * 4096 + (size_t)j * 64 + hp * 32 + 4 * hf;
#pragma unroll
                    for (int q = 0; q < 4; ++q) {
                        float o[4];
#pragma unroll
                        for (int e = 0; e < 4; ++e) { const int jp = hp * 32 + 8 * q + 4 * hf + e; o[e] = gl * (acc[4 * q + e] + (jp == j ? 1.f : 0.f)); }
                        *(uint2*)(dst + 8 * q) = make_uint2(pk2(o[0], o[1]), pk2(o[2], o[3]));
                    }
                }
                {
                    f32x16 acc = rc_zero();
                    const char* bp = arb + (ln * RC_TR + 4 * hf) * 2;
                    acc = MFMA32(xf0, rc_ld8x2(bp), acc);
                    acc = MFMA32(xf1, rc_ld8x2(bp + 32), acc);
                    bfr* dst = gQ + chunk * 2048 + (size_t)ln * 64 + hp * 32 + 4 * hf;
                    const char* rsrc = s_rm + 3 * RMB + (ln * RC_RM + hp * 32 + 4 * hf) * 2;
#pragma unroll
                    for (int q = 0; q < 4; ++q) {
                        const uint2 rr = *(const uint2*)(rsrc + 16 * q);
                        *(uint2*)(dst + 8 * q) = make_uint2(pk2(acc[4 * q] + bflo(rr.x), acc[4 * q + 1] + bfhi(rr.x)), pk2(acc[4 * q + 2] + bflo(rr.y), acc[4 * q + 3] + bfhi(rr.y)));
                    }
                }
            } else {
#pragma unroll
                for (int jt = 0; jt < 2; ++jt) {
                    f32x16 acc = rc_zero();
                    const char* ap = s_tr + 1 * TRB + rc_tro(jt * 32 + ln) + 8 * hf;
                    acc = MFMA32(rc_ld8x2(ap), xf0, acc);
                    acc = MFMA32(rc_ld8x2(ap + 32), xf1, acc);
#pragma unroll
                    for (int ks = 0; ks < 2; ++ks)
                        acc = MFMA32(rc_ld16(s_tr + 2 * TRB + rc_tro(jt * 32 + ln) + (ks * 16 + hf * 8) * 2), rc_ld16(s_tr + 3 * TRB + rc_tro(hp * 32 + ln) + (ks * 16 + hf * 8) * 2), acc);
                    bfr* dst = gH + chunk * 4096 + (size_t)(hp * 32 + ln) * 64 + jt * 32 + 4 * hf;
#pragma unroll
                    for (int q = 0; q < 4; ++q) {
                        const float4 gl = *(const float4*)(s_gl + jt * 32 + 8 * q + 4 * hf);
                        *(uint2*)(dst + 8 * q) = make_uint2(pk2(gl.x * acc[4 * q], gl.y * acc[4 * q + 1]), pk2(gl.z * acc[4 * q + 2], gl.w * acc[4 * q + 3]));
                    }
                }
                {
                    f32x16 acc = rc_zero();
                    const char* bp = arb + (ln * RC_TR + 4 * hf) * 2;
                    acc = MFMA32(xf0, rc_ld8x2(bp), acc);
                    acc = MFMA32(xf1, rc_ld8x2(bp + 32), acc);
#pragma unroll
                    for (int ks = 0; ks < 2; ++ks)
                        acc = MFMA32(rc_ld16(s_tr + 3 * TRB + rc_tro(hp * 32 + ln) + (ks * 16 + hf * 8) * 2), rc_ld16(ark + (ln * RC_TR + ks * 16 + hf * 8) * 2), acc);
                    bfr* dst = gZ + chunk * 2048 + (size_t)ln * 64 + hp * 32 + 4 * hf;
#pragma unroll
                    for (int q = 0; q < 4; ++q) *(uint2*)(dst + 8 * q) = make_uint2(pk2(acc[4 * q], acc[4 * q + 1]), pk2(acc[4 * q + 2], acc[4 * q + 3]));
                }
            }
        }
        g4_bar(G);
    }
}

DI bf16x8 rc_join(uint2 a, uint2 b) { return __builtin_bit_cast(bf16x8, make_uint4(a.x, a.y, b.x, b.y)); }
struct RcG { uint2 g[16]; };
DI void rc_load_g(RcG& f, const bfr* Gc, int ln, int hf) {
#pragma unroll
    for (int x = 0; x < 4; ++x) {
        const int o = (x >> 1) * 32 + (x & 1) * 16 + 4 * hf;
        f.g[4 * x] = *(const uint2*)(Gc + (size_t)ln * 64 + o);            f.g[4 * x + 1] = *(const uint2*)(Gc + (size_t)ln * 64 + o + 8);
        f.g[4 * x + 2] = *(const uint2*)(Gc + (size_t)(32 + ln) * 64 + o); f.g[4 * x + 3] = *(const uint2*)(Gc + (size_t)(32 + ln) * 64 + o + 8);
    }
}
DI void phase_r2(const Ctx& P) {
    const int tid = ltid(), lane = tid & 63, wave = tid >> 6;
    const int ln = lane & 31, hf = lane >> 5;
    const bfr* gG = (const bfr*)(P.ws + OFF_RCG); const bfr* gH = (const bfr*)(P.ws + OFF_RCH); const bfr* gQ = (const bfr*)(P.ws + OFF_RCQ); const bfr* gZ = (const bfr*)(P.ws + OFF_RCZ);
    float* yout = (float*)(P.ws + OFF_Y);
    if (wave != 0) return;
#define RC_LOAD_ALL(GV, QV, HV, ZV, ch_) do { const bfr* Hc_ = gH + (ch_) * 4096; const bfr* Qc_ = gQ + (ch_) * 2048; const bfr* Zc_ = gZ + (ch_) * 2048; \
        rc_load_g(GV, gG + (ch_) * 4096, ln, hf); \
        _Pragma("unroll") for (int x = 0; x < 4; ++x) { const int o_ = (x >> 1) * 32 + (x & 1) * 16 + 4 * hf; \
            QV[2 * x] = *(const uint2*)(Qc_ + (size_t)ln * 64 + o_); QV[2 * x + 1] = *(const uint2*)(Qc_ + (size_t)ln * 64 + o_ + 8); } \
        _Pragma("unroll") for (int q = 0; q < 4; ++q) { ZV[q] = *(const uint2*)(Zc_ + (size_t)ln * 64 + ic * 32 + 4 * hf + 8 * q); \
            HV[q] = *(const uint2*)(Hc_ + (size_t)(ic * 32 + ln) * 64 + 4 * hf + 8 * q); HV[4 + q] = *(const uint2*)(Hc_ + (size_t)(ic * 32 + ln) * 64 + 32 + 4 * hf + 8 * q); } } while (0)
#define RC_STEP(GV, QV, HV, ZV, c_) do { \
        bf16x8 mh[2][2]; \
        _Pragma("unroll") for (int ks = 0; ks < 2; ++ks) { mh[0][ks] = rc_pack(M0, ks); mh[1][ks] = rc_pack(M1, ks); } \
        f32x16 n0 = rc_zero(), n1 = rc_zero(), ya = rc_zero(); \
        _Pragma("unroll") for (int x = 0; x < 4; ++x) { \
            const bf16x8 g0 = rc_join(GV.g[4 * x], GV.g[4 * x + 1]), g1 = rc_join(GV.g[4 * x + 2], GV.g[4 * x + 3]); \
            n0 = MFMA32(g0, mh[x >> 1][x & 1], n0); n1 = MFMA32(g1, mh[x >> 1][x & 1], n1); \
            ya = MFMA32(mh[x >> 1][x & 1], rc_join(QV[2 * x], QV[2 * x + 1]), ya); } \
        float* yp = yout + ((size_t)b * SEQ + (c_) * RC_L + ln) * 512 + h * 64 + ic * 32 + 4 * hf; \
        _Pragma("unroll") for (int q = 0; q < 4; ++q) { const uint2 zz = ZV[q]; \
            *(float4*)(yp + 8 * q) = make_float4(ya[4 * q] + bflo(zz.x), ya[4 * q + 1] + bfhi(zz.x), ya[4 * q + 2] + bflo(zz.y), ya[4 * q + 3] + bfhi(zz.y)); } \
        _Pragma("unroll") for (int q = 0; q < 4; ++q) { const uint2 h0 = HV[q], h1 = HV[4 + q]; \
            M0[4 * q] = n0[4 * q] + bflo(h0.x); M0[4 * q + 1] = n0[4 * q + 1] + bfhi(h0.x); M0[4 * q + 2] = n0[4 * q + 2] + bflo(h0.y); M0[4 * q + 3] = n0[4 * q + 3] + bfhi(h0.y); \
            M1[4 * q] = n1[4 * q] + bflo(h1.x); M1[4 * q + 1] = n1[4 * q + 1] + bfhi(h1.x); M1[4 * q + 2] = n1[4 * q + 2] + bflo(h1.y); M1[4 * q + 3] = n1[4 * q + 3] + bfhi(h1.y); } } while (0)
    for (int item = blockIdx.x; item < 256; item += gridDim.x) {
        const int bh = item >> 1, ic = item & 1;
        const int b = bh >> 3, h = bh & 7;
        f32x16 M0 = rc_zero(), M1 = rc_zero();
        const size_t ch0 = (size_t)bh * RC_NCH;
        RcG gA, gB; uint2 qA[8], hA[8], zA[4], qB[8], hB[8], zB[4];
        RC_LOAD_ALL(gA, qA, hA, zA, ch0);
#pragma unroll 1
        for (int c = 0; c < RC_NCH; c += 2) {
            RC_LOAD_ALL(gB, qB, hB, zB, ch0 + c + 1);
            RC_STEP(gA, qA, hA, zA, c);
            RC_LOAD_ALL(gA, qA, hA, zA, ch0 + (c + 2 < RC_NCH ? c + 2 : c));
            RC_STEP(gB, qB, hB, zB, c + 1);
        }
    }
#undef RC_LOAD_ALL
#undef RC_STEP
}
DI void phase_o1(char* lds, const Ctx& P, int li) {
    const bfr* hb = (const bfr*)(P.ws + OFF_HB);
    const bfr* w = (const bfr*)(P.ws + OFF_WINO) + (size_t)li * 2048 * 1024;
    bfr* qk = (bfr*)(P.ws + OFF_U);
    bfr* vT = (bfr*)(P.ws + OFF_VT);
    bfr* us5 = (bfr*)(P.ws + OFF_US5);
    for (int t = blockIdx.x; t < 128 * 8; t += gridDim.x) {
        int mt, nt; tile_remap(t, 128, 8, mt, nt);
        const int m0 = mt * 256;
        RowLoader A(hb, m0, 1024), B(w, nt * 256, 1024);
        GEMM256(lds, 16, A, B, [&](const float* stg, int p) __attribute__((always_inline)) {
            if (nt < 4) {
                epi_rows8(stg, [&](int r, int c0, const float (&v)[8]) __attribute__((always_inline)) {
                    *(uint4*)(qk + (size_t)(m0 + r) * 1024 + nt * 256 + p * 128 + c0) = pack8(v);
                });
            } else if (nt < 6) {
                const int b = m0 >> 11, tq = m0 & (SEQ - 1);
                bfr* dst = vT + ((size_t)(b * 4 + (nt - 4) * 2 + p) * 128) * SEQ + tq;
                const int tid0 = ltid();
#pragma unroll
                for (int it = 0; it < 8; ++it) {
                    const int idx = it * NTHREADS + tid0;
                    const int dv = idx & 127, rg = idx >> 7;
                    float v[8];
#pragma unroll
                    for (int j = 0; j < 8; ++j) v[j] = stg[(rg * 8 + j) * STG_LD + dv];
                    *(uint4*)(dst + (size_t)dv * SEQ + rg * 8) = pack8(v);
                }
            } else {
                epi_rows8(stg, [&](int r, int c0, const float (&v)[8]) __attribute__((always_inline)) {
                    const int cc = (nt - 6) * 256 + p * 128 + c0;
                    *(uint4*)(us5 + ((size_t)(cc >> 4) * NTOK + m0 + r) * 16 + (cc & 15)) = pack8(v);
                });
            }
        });
    }
}

DI void phase_o2(char* lds, const Ctx& P, int li) {
    const bfr* qk = (const bfr*)(P.ws + OFF_U);
    bfr* qn = (bfr*)(P.ws + OFF_QN);
    bfr* kn = (bfr*)(P.ws + OFF_KN);
    const float* gq = P.in[I_QN] + li * 64;
    const float* gk = P.in[I_KN] + li * 64;
    const bfr* us5 = (const bfr*)(P.ws + OFF_US5);
    const bfr* bl = (const bfr*)(P.ws + OFF_S5BL) + (size_t)li * 32 * 128 * 512;
    float* xloc = (float*)(P.ws + OFF_XLOC);
    for (int t = blockIdx.x; t < 128; t += gridDim.x) {
        const int g = t >> 2, mt = t & 3;
        RowLoader A(us5 + (size_t)g * NTOK * 16, mt * 256, 512), B(bl + (size_t)g * 128 * 512, 0, 512);
        GEMM128(lds, 8, A, B, [&](const float* stg, int) __attribute__((always_inline)) {
            epi_rows8(stg, [&](int r, int c0, const float (&v)[8]) __attribute__((always_inline)) {
                float* d = xloc + ((size_t)g * 1024 + mt * 256 + r) * 128 + c0;
                *(float4*)d = make_float4(v[0], v[1], v[2], v[3]); *(float4*)(d + 4) = make_float4(v[4], v[5], v[6], v[7]);
            });
        });
    }
    const int total = NTOK * 16 * 8;
    for (int idx = blockIdx.x * NTHREADS + ltid(); idx < total; idx += gridDim.x * NTHREADS) {
        const int l8 = idx & 7, item = idx >> 3;
        const int hm = item & 7, which = (item >> 3) & 1, tok = item >> 4;
        const int d0 = l8 * 4;
        const bfr* src = qk + (size_t)tok * 1024 + which * 512 + hm * 64;
        const uint2 ua = *(const uint2*)(src + d0), ub = *(const uint2*)(src + 32 + d0);
        float x1[4] = {bflo(ua.x), bfhi(ua.x), bflo(ua.y), bfhi(ua.y)};
        float x2[4] = {bflo(ub.x), bfhi(ub.x), bflo(ub.y), bfhi(ub.y)};
        float ss = 0.f;
#pragma unroll
        for (int j = 0; j < 4; ++j) ss += x1[j] * x1[j] + x2[j] * x2[j];
        ss += __shfl_xor(ss, 1); ss += __shfl_xor(ss, 2); ss += __shfl_xor(ss, 4);
        const float rs = rsqrtf(ss * (1.0f / 64.0f) + 1e-6f);
        const float* gg = which ? gk : gq;
        const float scl = which ? 1.0f : (0.125f * 1.4426950408889634f);
        const int t = tok & (SEQ - 1);
        float o1[4], o2[4];
#pragma unroll
        for (int j = 0; j < 4; ++j) {
            const int i = d0 + j;
            const float invf = exp2f(-(float)i * (13.287712379549449f / 32.0f));
            const float ang = (float)t * invf;
            float sn, cs;
            sincosf(ang, &sn, &cs);
            const float a = x1[j] * rs * gg[i], b2 = x2[j] * rs * gg[32 + i];
            o1[j] = (a * cs - b2 * sn) * scl;
            o2[j] = (b2 * cs + a * sn) * scl;
        }
        bfr* dst = (which ? kn : qn) + (size_t)tok * 512 + hm * 64;
        *(uint2*)(dst + d0) = make_uint2(pk2(o1[0], o1[1]), pk2(o1[2], o1[3]));
        *(uint2*)(dst + 32 + d0) = make_uint2(pk2(o2[0], o2[1]), pk2(o2[2], o2[3]));
    }
}

DI void s5_scan(const Ctx& P, int li) {
    const float* xloc = (const float*)(P.ws + OFF_XLOC);
    bfr* xin = (bfr*)(P.ws + OFF_XIN);
    const float* l32 = (const float*)(P.ws + OFF_S5L32) + (size_t)li * 32 * 128;
    for (int idx = blockIdx.x * NTHREADS + ltid(); idx < 32 * 16 * 64; idx += gridDim.x * NTHREADS) {
        const int p = idx & 63, b = (idx >> 6) & 15, g = idx >> 10;
        const float lr = l32[g * 128 + 2 * p], lim = l32[g * 128 + 2 * p + 1];
        float xr = 0.f, xi = 0.f;
        for (int ch = 0; ch < 64; ++ch) {
            const size_t o = ((size_t)g * 1024 + b * 64 + ch) * 128 + 2 * p;
            *(unsigned*)(xin + o) = pk2(xr, xi);
            const float2 a = *(const float2*)(xloc + o);
            const float nr = lr * xr - lim * xi + a.x, ni = lr * xi + lim * xr + a.y;
            xr = nr; xi = ni;
        }
    }
}

DI void attn_item(char* lds, const Ctx& P, int b, int h, int qt, float lam, float lam_init, const float* subln) {
    const bfr* qn = (const bfr*)(P.ws + OFF_QN);
    const bfr* kn = (const bfr*)(P.ws + OFF_KN);
    const bfr* vT = (const bfr*)(P.ws + OFF_VT) + (size_t)(b * 4 + h) * 128 * SEQ;
    bfr* am = (bfr*)(P.ws + OFF_AMIX);
    const int tid = ltid(), lane = tid & 63, wave = tid >> 6;
    const int m = wave >> 2, qw = (wave & 3) * 32;
    const int q0 = qt * 128 + qw;
    const int ln = lane & 31, hf = lane >> 5;
    bf16x8 qf[4];
    {
        const bfr* qp = qn + ((size_t)b * SEQ + q0 + ln) * 512 + h * 128 + m * 64 + hf * 8;
#pragma unroll
        for (int ks = 0; ks < 4; ++ks) qf[ks] = *(const bf16x8*)(qp + ks * 16);
    }
    f32x16 o[4];
#pragma unroll
    for (int d = 0; d < 4; ++d)
#pragma unroll
        for (int r = 0; r < 16; ++r) o[d][r] = 0.f;
    float mrun = -INFINITY, lrun = 0.f;
    const int nkt = 2 * (qt + 1);
    const int lrow = tid >> 3, lcol = (tid & 7) * 8;
    const bfr* kbase = kn + ((size_t)b * SEQ) * 512 + h * 128;
    unsigned ko = (unsigned)(lrow * 512 + lcol) * 2u, vo = (unsigned)(lrow * SEQ + lcol) * 2u;
    asm volatile("" : "+v"(ko), "+v"(vo));
    uint4 rk0, rk1, rv0, rv1;
#define ATT_GLOAD(kt_) do { const char* kp_ = (const char*)(kbase + (size_t)(kt_) * (64 * 512)); const char* vp_ = (const char*)(vT + (kt_) * 64); \
        rk0 = *(const uint4*)(kp_ + ko); rk1 = *(const uint4*)(kp_ + 64 * 2 + ko); \
        rv0 = *(const uint4*)(vp_ + vo); rv1 = *(const uint4*)(vp_ + 64 * SEQ * 2 + vo); } while (0)
#define ATT_S1(base_, i_, RK, RV) { *(uint4*)((base_) + (64 * (i_)) * LDA * 2) = RK; \
        *(uint4*)((base_) + TILE_B + (64 * (i_)) * LDA * 2) = RV; }
#define ATT_LSTORE(buf_) do { char* base_ = lds + (buf_) * (2 * TILE_B) + s_off; ATT_S1(base_, 0, rk0, rv0) ATT_S1(base_, 1, rk1, rv1) } while (0)
    int k_off = ((m * 64 + ln) * LDA + hf * 8) * 2;
    int v_off = TILE_B + (ln * LDA + 4 * hf) * 2;
    int s_off = (lrow * LDA + lcol) * 2;
    asm volatile("" : "+v"(k_off), "+v"(v_off), "+v"(s_off));
    ATT_GLOAD(0); ATT_LSTORE(0);
    __syncthreads();
    int buf = 0;
#pragma unroll 1
    for (int kt = 0; kt < nkt; ++kt) {
        const bool more = (kt + 1 < nkt);
        const char* ks_ = lds + buf * (2 * TILE_B) + k_off;
        const char* vs_ = lds + buf * (2 * TILE_B) + v_off;
        if (kt * 64 <= q0 + 31) {
            f32x16 s[2];
#pragma unroll
            for (int kb = 0; kb < 2; ++kb) {
#pragma unroll
                for (int r = 0; r < 16; ++r) s[kb][r] = 0.f;
#pragma unroll
                for (int ks = 0; ks < 4; ++ks) {
                    const bf16x8 kf = *(const bf16x8*)(ks_ + ((kb * 32) * LDA + ks * 16) * 2);
                    s[kb] = MFMA32(kf, qf[ks], s[kb]);
                }
            }
            const int qpos = q0 + ln;
            if (kt * 64 + 63 > q0) {
#pragma unroll
                for (int kb = 0; kb < 2; ++kb)
#pragma unroll
                    for (int r = 0; r < 16; ++r) {
                        const int key = kt * 64 + kb * 32 + (r & 3) + 8 * (r >> 2) + 4 * hf;
                        if (key > qpos) s[kb][r] = -INFINITY;
                    }
            }
            float mx = s[0][0];
#pragma unroll
            for (int kb = 0; kb < 2; ++kb)
#pragma unroll
                for (int r = 0; r < 16; ++r) mx = fmaxf(mx, s[kb][r]);
            mx = fmaxf(mx, __shfl_xor(mx, 32));
            const float mnew = fmaxf(mrun, mx);
            const float alpha = __builtin_amdgcn_exp2f(mrun - mnew);
            mrun = mnew;
            float rsum = 0.f;
#pragma unroll
            for (int kb = 0; kb < 2; ++kb)
#pragma unroll
                for (int r = 0; r < 16; ++r) { const float p = __builtin_amdgcn_exp2f(s[kb][r] - mnew); s[kb][r] = p; rsum += p; }
            lrun = lrun * alpha + rsum;
#pragma unroll
            for (int d = 0; d < 4; ++d)
#pragma unroll
                for (int r = 0; r < 16; ++r) o[d][r] *= alpha;
            __builtin_amdgcn_sched_barrier(0);
            if (more) ATT_GLOAD(kt + 1);
#pragma unroll
            for (int kb = 0; kb < 2; ++kb)
#pragma unroll
                for (int st = 0; st < 2; ++st) {
                    const uint4 pp = make_uint4(pk2(s[kb][8 * st + 0], s[kb][8 * st + 1]), pk2(s[kb][8 * st + 2], s[kb][8 * st + 3]),
                                                pk2(s[kb][8 * st + 4], s[kb][8 * st + 5]), pk2(s[kb][8 * st + 6], s[kb][8 * st + 7]));
                    const bf16x8 pf = __builtin_bit_cast(bf16x8, pp);
                    const int kc = kb * 32 + 16 * st;
#pragma unroll
                    for (int d = 0; d < 4; ++d) {
                        const uint2 v0 = *(const uint2*)(vs_ + ((d * 32) * LDA + kc) * 2);
                        const uint2 v1 = *(const uint2*)(vs_ + ((d * 32) * LDA + kc + 8) * 2);
                        const bf16x8 vf = __builtin_bit_cast(bf16x8, make_uint4(v0.x, v0.y, v1.x, v1.y));
                        o[d] = MFMA32(vf, pf, o[d]);
                    }
                }
        }
        else if (more) ATT_GLOAD(kt + 1);
        if (more) ATT_LSTORE(buf ^ 1);
        __syncthreads();
        buf ^= 1;
    }
    const float ltot = lrun + __shfl_xor(lrun, 32);
    const float linv = 1.0f / ltot;
    float* ob = (float*)lds;
    int o_off = (m * 128 + qw + ln) * 129 + 4 * hf;
    asm volatile("" : "+v"(o_off));
#pragma unroll
    for (int d = 0; d < 4; ++d)
#pragma unroll
        for (int r = 0; r < 16; ++r) ob[o_off + d * 32 + (r & 3) + 8 * (r >> 2)] = o[d][r] * linv;
    __syncthreads();
#pragma unroll
    for (int it = 0; it < 4; ++it) {
        const int idx = it * NTHREADS + tid;
        const int q = idx >> 4, c0 = (idx & 15) * 8;
        float v[8];
        float ss = 0.f;
        int r_off = q * 129 + c0;
        asm volatile("" : "+v"(r_off));
#pragma unroll
        for (int j = 0; j < 8; ++j) { v[j] = ob[r_off + j] - lam * ob[r_off + 128 * 129 + j]; ss += v[j] * v[j]; }
        ss = row16_sum(ss);
        const float rs = rsqrtf(ss * (1.0f / 128.0f) + 1e-5f) * (1.0f - lam_init);
#pragma unroll
        for (int j = 0; j < 8; ++j) v[j] = v[j] * rs * subln[c0 + j];
        *(uint4*)(am + ((size_t)b * SEQ + qt * 128 + q) * 1024 + h * 128 + c0) = pack8(v);
    }
    __syncthreads();
}

DI void phase_o3(char* lds, const Ctx& P, int li, int layer) {
    s5_scan(P, li);
    float lam;
    {
        const int j = ltid() & 63;
        const float s1 = wave_sum(P.in[I_LQ1][li * 64 + j] * P.in[I_LK1][li * 64 + j]);
        const float s2 = wave_sum(P.in[I_LQ2][li * 64 + j] * P.in[I_LK2][li * 64 + j]);
        const float lam_init0 = 0.8f - 0.6f * __expf(-0.3f * (float)layer);
        lam = __expf(s1) - __expf(s2) + lam_init0;
    }
    const float lam_init = 0.8f - 0.6f * __expf(-0.3f * (float)layer);
    const float* subln = P.in[I_SUBLN] + li * 128;
    for (int item = blockIdx.x; item < 512; item += gridDim.x) {
        const int bh = item >> 3, pr = item & 7;
        for (int half = 0; half < 2; ++half) attn_item(lds, P, bh >> 2, bh & 3, half ? 15 - pr : pr, lam, lam_init, subln);
    }
}

DI void phase_o4(char* lds, const Ctx& P, int li) {
    const bfr* us5 = (const bfr*)(P.ws + OFF_US5);
    const bfr* xin = (const bfr*)(P.ws + OFF_XIN);
    const bfr* gt = (const bfr*)(P.ws + OFF_S5GT) + (size_t)li * 32 * 512 * 640;
    const float* dsk = P.in[I_S5D] + li * 512;
    bfr* zb = (bfr*)(P.ws + OFF_ZBUF);
    for (int t = blockIdx.x; t < 512; t += gridDim.x) {
        const int g = t >> 4, mt = (t >> 2) & 3, nt = t & 3;
        const int nloc = 2 * (nt + 1);
        const bfr* ag = us5 + (size_t)g * NTOK * 16;
        const bfr* xg = xin + (size_t)g * 1024 * 128;
        const int tq = ltid();
        const int arow = mt * 256 + (tq >> 3), acol = gt_lcol(tq);
        auto aptr = [&](int i, int kt) __attribute__((always_inline)) -> const bfr* {
            return (kt < nloc) ? ag + (size_t)(arow + 64 * i) * 512 + kt * 64 + acol
                               : xg + (size_t)(arow + 64 * i) * 128 + (kt - nloc) * 64 + acol;
        };
        const bfr* bg = gt + (size_t)g * 512 * 640 + (size_t)(nt * 128 + (tq >> 3)) * 640 + acol;
        auto bptr = [&](int i, int kt) __attribute__((always_inline)) -> const bfr* {
            return bg + (size_t)(64 * i) * 640 + ((kt < nloc) ? kt : (8 + kt - nloc)) * 64;
        };
        GEMM128(lds, nloc + 2, aptr, bptr, [&](const float* stg, int) __attribute__((always_inline)) {
            epi_rows8_pre<uint4>(stg,
                [&](int r, int c0) __attribute__((always_inline)) -> uint4 {
                    const int n = nt * 128 + c0;
                    return *(const uint4*)(ag + ((size_t)(mt * 256 + r) * 32 + (n >> 4)) * 16 + (n & 15)); },
                [&](int r, int c0, const float (&v)[8], const uint4& up) __attribute__((always_inline)) {
                    const int cb = mt * 256 + r;
                    const int n = nt * 128 + c0, tt = n >> 4, c1 = n & 15;
                    const size_t tok = (size_t)cb * 32 + tt;
                    float uu[8], z[8];
                    unpack8(up, uu);
#pragma unroll
                    for (int j = 0; j < 8; ++j) {
                        const float y = v[j] + dsk[g * 16 + c1 + j] * uu[j];
                        const float inner = 0.7978845608028654f * (y + 0.044715f * y * y * y);
                        z[j] = 0.5f * y * (1.0f + ftanh(inner));
                    }
                    *(uint4*)(zb + tok * 512 + g * 16 + c1) = pack8(z);
                });
        });
    }
}

DI void phase_o5(char* lds, const Ctx& P, int li) {
    const bfr* zb = (const bfr*)(P.ws + OFF_ZBUF);
    const bfr* w = (const bfr*)(P.ws + OFF_GLUT) + (size_t)li * 512 * 512;
    bfr* am = (bfr*)(P.ws + OFF_AMIX);
    for (int t = blockIdx.x; t < 512; t += gridDim.x) {
        int mt, nt; tile_remap(t, 128, 4, mt, nt);
        RowLoader A(zb, mt * 256, 512), B(w, nt * 128, 512);
        GEMM128(lds, 8, A, B, [&](const float* stg, int) __attribute__((always_inline)) {
            epi_rows8_pre<uint4>(stg,
                [&](int r, int c0) __attribute__((always_inline)) -> uint4 { return *(const uint4*)(zb + (size_t)(mt * 256 + r) * 512 + nt * 128 + c0); },
                [&](int r, int c0, const float (&v)[8], const uint4& zp) __attribute__((always_inline)) {
                    float zz[8], o[8];
                    unpack8(zp, zz);
#pragma unroll
                    for (int j = 0; j < 8; ++j) o[j] = zz[j] * sigmoidf_(v[j]);
                    *(uint4*)(am + (size_t)(mt * 256 + r) * 1024 + 512 + nt * 128 + c0) = pack8(o);
                });
        });
    }
}
DI void phase_router(char* lds, const Ctx& P, int layer) {
    const float* x = P.out;
    bfr* hb = (bfr*)(P.ws + OFF_HB);
    bfr* hlo = (bfr*)(P.ws + OFF_HLO);
    const bfr* rhi = (const bfr*)(P.ws + OFF_RHI) + (size_t)layer * 128 * 1024;
    const bfr* rlo = (const bfr*)(P.ws + OFF_RLO) + (size_t)layer * 128 * 1024;
    int* gcnt = (int*)(P.ws + OFF_CNT) + layer * 64;
    int* stok = (int*)(P.ws + OFF_TOK);
    float* sgate = (float*)(P.ws + OFF_GATE);
    int* lcnt = (int*)(lds + LDS_AUX);
    int* lbase = lcnt + 64;
    const float* bg = P.in[I_MBG] + layer * 4;
    const float* be = P.in[I_MBE] + layer * 32;
    const int tid = ltid();
    for (int u = blockIdx.x; u < 128; u += gridDim.x) {
        const int m0 = u * 256;
        norm_rows(x, P.in[I_NFFN] + (size_t)layer * DM, hb, hlo, nullptr, m0, 256);
        __syncthreads();
        const size_t roff = (size_t)(m0 + (tid >> 3)) * 1024 + gt_lcol(tid);
        const size_t boff = (size_t)(tid >> 3) * 1024 + gt_lcol(tid);
        auto aptr = [&](int i, int kt) __attribute__((always_inline)) -> const bfr* { return (kt < 32 ? hb : hlo) + roff + (size_t)(64 * i) * 1024 + (kt & 15) * 64; };
        auto bptr = [&](int i, int kt) __attribute__((always_inline)) -> const bfr* { return ((kt >= 16 && kt < 32) ? rlo : rhi) + boff + (size_t)(64 * i) * 1024 + (kt & 15) * 64; };
        GEMM128(lds, 48, aptr, bptr, [&](const float* stg, int) __attribute__((always_inline)) {
            if (tid < 64) lcnt[tid] = 0;
            __syncthreads();
            int seg0 = 0, seg1 = 0, p0 = 0, p1 = 0;
            float g0 = 0.f, g1 = 0.f;
            if (tid < 256) {
                const float* row = stg + tid * STG_LD;
                float gl[4];
#pragma unroll
                for (int j = 0; j < 4; ++j) gl[j] = row[32 + j] + bg[j];
                int gt = 0; float gm = gl[0];
#pragma unroll
                for (int j = 1; j < 4; ++j) if (gl[j] > gm) { gm = gl[j]; gt = j; }
                float gs = 0.f;
#pragma unroll
                for (int j = 0; j < 4; ++j) gs += __expf(gl[j] - gm);
                const float gw = 1.0f / gs;
                float l1 = -INFINITY, l2 = -INFINITY; int j1 = 0, j2 = 0;
                for (int j = 0; j < 8; ++j) {
                    const float v = row[gt * 8 + j] + be[gt * 8 + j];
                    if (v > l1) { l2 = l1; j2 = j1; l1 = v; j1 = j; }
                    else if (v > l2) { l2 = v; j2 = j; }
                }
                const float w1 = 1.0f / (1.0f + __expf(l2 - l1));
                g0 = gw * w1; g1 = gw * (1.0f - w1);
                seg0 = gt * 8 + j1; seg1 = 32 + gt * 8 + j2;
                p0 = atomicAdd(&lcnt[seg0], 1);
                p1 = atomicAdd(&lcnt[seg1], 1);
            }
            __syncthreads();
            if (tid < 64) { const int c = lcnt[tid]; lbase[tid] = c ? atomicAdd(&gcnt[tid], c) : 0; }
            __syncthreads();
            if (tid < 256) {
                const int q0 = lbase[seg0] + p0, q1 = lbase[seg1] + p1;
                stok[(size_t)seg0 * NTOK + q0] = m0 + tid; sgate[(size_t)seg0 * NTOK + q0] = g0;
                stok[(size_t)seg1 * NTOK + q1] = m0 + tid; sgate[(size_t)seg1 * NTOK + q1] = g1;
            }
        });
    }
}

DI void moe_tables(char* lds, const Ctx& P, int layer) {
    int* cnt = (int*)(lds + LDS_AUX); int* rb0 = cnt + 64; int* hoff = rb0 + 65;
    const int* gcnt = (const int*)(P.ws + OFF_CNT) + layer * 64;
    const int tid = ltid();
    if (tid < 64) cnt[tid] = gcnt[tid];
    __syncthreads();
    if (tid == 0) {
        int acc = 0;
        for (int s = 0; s < 64; ++s) { rb0[s] = acc; hoff[s] = acc * 256; acc += (cnt[s] + 255) >> 8; }
        rb0[64] = acc;
    }
    __syncthreads();
}
DI int moe_find_seg(const int* rb0, int rbi) { int s = 0; while (rb0[s + 1] <= rbi) ++s; return s; }

DI void phase_moe_up(char* lds, const Ctx& P, int layer) {
    moe_tables(lds, P, layer);
    const int* cnt = (const int*)(lds + LDS_AUX); const int* rb0 = cnt + 64; const int* hoff = rb0 + 65;
    const bfr* hb = (const bfr*)(P.ws + OFF_HB);
    const bfr* wgu = (const bfr*)(P.ws + OFF_MWGU);
    const int* stok = (const int*)(P.ws + OFF_TOK);
    bfr* hid = (bfr*)(P.ws + OFF_HID);
    const int ntiles = rb0[64] * 4;
    for (int t = blockIdx.x; t < ntiles; t += gridDim.x) {
        int rbi, nt; tile_remap(t, rb0[64], 4, rbi, nt);
        const int seg = moe_find_seg(rb0, rbi);
        const int rb = rbi - rb0[seg], e = seg & 31, c = cnt[seg];
        const bfr* ap[4];
        const int tq = ltid();
#pragma unroll
        for (int i = 0; i < 4; ++i) {
            int p = rb * 256 + (tq >> 3) + 64 * i; p = p < c ? p : c - 1;
            ap[i] = hb + (size_t)stok[(size_t)seg * NTOK + p] * 1024 + gt_lcol(tq);
        }
        auto aptr = [&](int i, int kt) __attribute__((always_inline)) -> const bfr* { return ap[i] + kt * 64; };
        RowLoader B(wgu + (size_t)e * 1024 * 1024, nt * 256, 1024);
        const size_t hrow0 = (size_t)hoff[seg] + rb * 256;
        GEMM256(lds, 16, aptr, B, [&](const float* stg, int p) __attribute__((always_inline)) {
            epi_rows8(stg, [&](int r, int c0, const float (&v)[8]) __attribute__((always_inline)) {
                float o[4];
#pragma unroll
                for (int j = 0; j < 4; ++j) o[j] = v[j] * sigmoidf_(v[j]) * v[4 + j];
                *(uint2*)(hid + (hrow0 + r) * 512 + ((nt * 256 + p * 128 + c0) >> 1)) = make_uint2(pk2(o[0], o[1]), pk2(o[2], o[3]));
            });
        });
    }
}

DI void phase_moe_down(char* lds, const Ctx& P, int layer, int k, float* x) {
    const G4 G = g4_make(lds);
    int* cnt = (int*)(G.lds + G4_AUX); int* rb0 = cnt + 64; int* hoff = rb0 + 65;
    {
        const int* gcnt = (const int*)(P.ws + OFF_CNT) + layer * 64;
        if (G.tid < 64) cnt[G.tid] = gcnt[G.tid];
        g4_bar(G);
        if (G.tid == 0) {
            int acc = 0, hacc = 0;
            for (int s = 0; s < 64; ++s) { rb0[s] = acc; hoff[s] = hacc; acc += (cnt[s] + 127) >> 7; hacc += ((cnt[s] + 255) >> 8) * 256; }
            rb0[64] = acc;
        }
        g4_bar(G);
    }
    const bfr* hid = (const bfr*)(P.ws + OFF_HID);
    const bfr* wd = (const bfr*)(P.ws + OFF_MWD);
    const int* stok = (const int*)(P.ws + OFF_TOK);
    const float* sgate = (const float*)(P.ws + OFF_GATE);
    const int rbA = rb0[k * 32], rbB = rb0[k * 32 + 32];
    const int ntiles = (rbB - rbA) * 8;
    for (int t = G.vb; t < ntiles; t += G.nvb) {
        int rbi, nt; tile_remap(t, rbB - rbA, 8, rbi, nt); rbi += rbA;
        const int seg = moe_find_seg(rb0, rbi);
        const int rb = rbi - rb0[seg], e = seg & 31, c = cnt[seg];
        G4RowLoader A(G, hid, hoff[seg] + rb * 128, 512), B(G, wd + (size_t)e * 1024 * 512, nt * 128, 512);
        int* ltok = (int*)(G.lds + G4_AUX + 1024); float* lgate = (float*)(G.lds + G4_AUX + 1536);
        if (G.tid < 128) {
            const int p = rb * 128 + G.tid;
            ltok[G.tid] = p < c ? stok[(size_t)seg * NTOK + p] : -1;
            lgate[G.tid] = p < c ? sgate[(size_t)seg * NTOK + p] : 0.f;
        }
        g4_gemm_tile(G, G.lds, 8, A, B, [&](const float* stg) __attribute__((always_inline)) {
            g4_epi_rows8_pre<F8>(G, stg,
                [&](int r, int c0) __attribute__((always_inline)) -> F8 {
                    int tok = ltok[r]; tok = tok < 0 ? 0 : tok;
                    const float* d = x + (size_t)tok * DM + nt * 128 + c0;
                    F8 o; o.a = *(const float4*)d; o.b = *(const float4*)(d + 4);
                    return o; },
                [&](int r, int c0, const float (&v)[8], const F8& o) __attribute__((always_inline)) {
                    const int tok = ltok[r];
                    if (tok >= 0) {
                        const float gt = lgate[r];
                        float* d = x + (size_t)tok * DM + nt * 128 + c0;
                        *(float4*)d = make_float4(o.a.x + gt * v[0], o.a.y + gt * v[1], o.a.z + gt * v[2], o.a.w + gt * v[3]);
                        *(float4*)(d + 4) = make_float4(o.b.x + gt * v[4], o.b.y + gt * v[5], o.b.z + gt * v[6], o.b.w + gt * v[7]);
                    }
                });
        });
    }
}
constexpr int PH_PER_LAYER = 11;
constexpr int N_PHASES = 1 + 4 * PH_PER_LAYER;

DI void phase_prologue(char* lds, const Ctx& P) {
    for (int u = blockIdx.x; u < 64; u += gridDim.x) s5_tables(lds, P, u >> 5, u & 31);
    const bool excl = gridDim.x >= 128;
    if (excl && blockIdx.x < 64) return;
    unsigned base = 0;
    const int wk = excl ? (int)blockIdx.x - 64 : (int)blockIdx.x, nw = excl ? (int)gridDim.x - 64 : (int)gridDim.x;
    for (int i = 0; i < 2; ++i) {
        cvt_matrix(lds, P.in[I_EWIN] + (size_t)i * 1024 * 2304, 1024, 2304, (bfr*)(P.ws + OFF_WINE) + (size_t)i * 2304 * 1024, 1024, 0, wk, nw, base);
        cvt_matrix(lds, P.in[I_EWOUT] + (size_t)i * 1024 * 1024, 1024, 1024, (bfr*)(P.ws + OFF_WOUTE) + (size_t)i * 1024 * 1024, 1024, 0, wk, nw, base);
        cvt_matrix(lds, P.in[I_OWIN] + (size_t)i * 1024 * 2048, 1024, 2048, (bfr*)(P.ws + OFF_WINO) + (size_t)i * 2048 * 1024, 1024, 0, wk, nw, base);
        cvt_matrix(lds, P.in[I_OWOUT] + (size_t)i * 1024 * 1024, 1024, 1024, (bfr*)(P.ws + OFF_WOUTO) + (size_t)i * 1024 * 1024, 1024, 0, wk, nw, base);
        cvt_matrix(lds, P.in[I_W2] + (size_t)i * 64 * 512, 64, 512, (bfr*)(P.ws + OFF_W2T) + (size_t)i * 512 * 64, 64, 0, wk, nw, base);
        cvt_matrix(lds, P.in[I_A2] + (size_t)i * 64 * 512, 64, 512, (bfr*)(P.ws + OFF_A2T) + (size_t)i * 512 * 64, 64, 0, wk, nw, base);
        cvt_matrix(lds, P.in[I_G2] + (size_t)i * 128 * 512, 128, 512, (bfr*)(P.ws + OFF_G2T) + (size_t)i * 512 * 128, 128, 0, wk, nw, base);
        for (int g = 0; g < 4; ++g)
            cvt_matrix(lds, P.in[I_POOLW] + (size_t)(i * 4 + g) * 128 * 128, 128, 128, (bfr*)(P.ws + OFF_POOLT) + (size_t)(i * 4 + g) * 128 * 128, 128, 0, wk, nw, base);
        cvt_matrix(lds, P.in[I_WGLU] + (size_t)i * 512 * 512, 512, 512, (bfr*)(P.ws + OFF_GLUT) + (size_t)i * 512 * 512, 512, 0, wk, nw, base);
    }
    const int gtid = wk * NTHREADS + ltid(), gsz = nw * NTHREADS;
    {
        bfr* rhi = (bfr*)(P.ws + OFF_RHI); bfr* rlo = (bfr*)(P.ws + OFF_RLO);
        for (int idx = gtid; idx < 4 * 128 * 1024; idx += gsz) {
            const int k = idx & 1023, n = (idx >> 10) & 127, l = idx >> 17;
            float w = 0.f;
            if (n < 32) w = P.in[I_MWE][((size_t)l * 1024 + k) * 32 + n];
            else if (n < 36) w = P.in[I_MWG][((size_t)l * 1024 + k) * 4 + (n - 32)];
            const bfr h = f2bf(w);
            rhi[idx] = h; rlo[idx] = f2bf(w - bf2f(h));
        }
    }
    {
        bfr* v12 = (bfr*)(P.ws + OFF_V12T);
        const float* v1 = P.in[I_V1]; const float* v2 = P.in[I_V2];
        for (int idx = gtid; idx < 512 * 512; idx += gsz) {
            const int k = idx & 511, n = idx >> 9;
            float s = 0.f;
            for (int r = 0; r < 32; ++r) s += v1[k * 32 + r] * v2[r * 512 + n];
            v12[idx] = f2bf(s);
        }
    }
    for (int tt = wk; tt < 512; tt += nw)
        norm_rows(P.in[I_X], P.in[I_NMIX], (bfr*)(P.ws + OFF_HB), nullptr, P.out, tt * 64, 64);
}

DI Ctx mkctx(unsigned char* ws, float* out) {
    size_t z = 0;
    asm volatile("" : "+s"(z));
    Ctx c;
    c.in.p = (KArgPtr)__builtin_amdgcn_kernarg_segment_ptr() + z;
    c.ws = ws + z; c.out = (float*)((char*)out + z);
    return c;
}
__global__ void __launch_bounds__(NTHREADS, 2) fwd_kernel(Params PA) {
    extern __shared__ __attribute__((aligned(16))) char lds[];
    if (threadIdx.x == 0) { *(uint4*)(lds + LDS_BYTES - 16) = make_uint4(0u, 0u, 0u, 0u); *(uint4*)(lds + LDS_BYTES - 32) = make_uint4(0u, 0u, 0u, 0u); }
    __syncthreads();
    XcdBarrier bar = xcd_barrier_post((unsigned*)(PA.ws + OFF_BAR), (volatile LAS unsigned*)(lds + LDS_BYTES - 16));
    const int lo = PA.ph_lo, hi = PA.ph_hi;
#ifndef RWKV_CHUNKED
#define RWKV_CHUNKED 1
#endif
#ifndef DUP_PH
#define DUP_PH (-1)
#endif
#define DUPX(k, call) do { call; if (DUP_PH == (k)) { __syncthreads(); call; } } while (0)
#define RUNS(id) ((id) >= lo && (id) < hi)
#define P mkctx(PA.ws, PA.out)
#define SEAM(id) do { if ((id) > lo && (id) < hi) xcd_barrier(bar); } while (0)
    if (RUNS(0)) DUPX(100, phase_prologue(lds, P));
    for (int layer = 0; layer < 4; ++layer) {
        const int base = 1 + layer * PH_PER_LAYER;
        const int li = layer >> 1;
        if ((layer & 1) == 0) {
            SEAM(base + 0); if (RUNS(base + 0)) DUPX(0, phase_e1(lds, P, li));
            SEAM(base + 1); if (RUNS(base + 1)) DUPX(1, phase_e2a(P, li));
            SEAM(base + 2); if (RUNS(base + 2)) DUPX(2, phase_e2b(lds, P, li));
#if RWKV_CHUNKED
            SEAM(base + 3); if (RUNS(base + 3)) { DUPX(43, phase_r1(lds, P, li)); if (DUP_PH >= 45 && DUP_PH <= 47) phase_r1(lds, P, li, DUP_PH - 44); xcd_barrier(bar); DUPX(44, phase_r2(P)); }
#else
            SEAM(base + 3); if (RUNS(base + 3)) { phase_e3(lds, P, li); if (DUP_PH == 3) phase_e3(lds, P, li, 3); }
#endif
            SEAM(base + 4); if (RUNS(base + 4)) DUPX(4, phase_e4(P, li));
            SEAM(base + 5); if (RUNS(base + 5)) { phase_wout(lds, P, (const bfr*)(P.ws + OFF_WOUTE) + (size_t)li * 1024 * 1024, P.out); if (DUP_PH == 5) phase_wout(lds, P, (const bfr*)(P.ws + OFF_WOUTE) + (size_t)li * 1024 * 1024, (float*)(P.ws + OFF_EV)); }
        } else {
            SEAM(base + 0); if (RUNS(base + 0)) DUPX(10, phase_o1(lds, P, li));
            SEAM(base + 1); if (RUNS(base + 1)) DUPX(11, phase_o2(lds, P, li));
            SEAM(base + 2); if (RUNS(base + 2)) DUPX(12, phase_o3(lds, P, li, layer));
            SEAM(base + 3); if (RUNS(base + 3)) DUPX(13, phase_o4(lds, P, li));
            SEAM(base + 4); if (RUNS(base + 4)) DUPX(14, phase_o5(lds, P, li));
            SEAM(base + 5); if (RUNS(base + 5)) { phase_wout(lds, P, (const bfr*)(P.ws + OFF_WOUTO) + (size_t)li * 1024 * 1024, P.out); if (DUP_PH == 5) phase_wout(lds, P, (const bfr*)(P.ws + OFF_WOUTO) + (size_t)li * 1024 * 1024, (float*)(P.ws + OFF_EV)); }
        }
        SEAM(base + 6);
        if (RUNS(base + 6)) {
            phase_router(lds, P, layer);
            const bool split = gridDim.x >= 256;
            DUPX(6, moe_convert(lds, P, layer, split ? (int)blockIdx.x - 128 : (int)blockIdx.x, split ? (int)gridDim.x - 128 : (int)gridDim.x));
        }
        SEAM(base + 7); if (RUNS(base + 7)) DUPX(7, phase_moe_up(lds, P, layer));
        SEAM(base + 8); if (RUNS(base + 8)) { phase_moe_down(lds, P, layer, 0, P.out); if (DUP_PH == 8) phase_moe_down(lds, P, layer, 0, (float*)(P.ws + OFF_EV)); }
        SEAM(base + 9); if (RUNS(base + 9)) phase_moe_down(lds, P, layer, 1, P.out);
        SEAM(base + 10);
        if (RUNS(base + 10) && layer < 3) {
            for (int rep = 0; rep < (DUP_PH == 20 ? 2 : 1); ++rep)
            for (int tt = blockIdx.x; tt < 512; tt += gridDim.x)
                norm_rows(P.out, P.in[I_NMIX] + (size_t)(layer + 1) * DM, (bfr*)(P.ws + OFF_HB), nullptr, nullptr, tt * 64, 64);
        }
    }
#undef P
#undef RUNS
#undef SEAM
}

#ifndef N_LAUNCH_SPLIT
#define N_LAUNCH_SPLIT 0
#endif
extern "C" void kernel_launch(void* const* d_in, const int* in_sizes, int n_in, void* d_out, int out_size, void* d_ws, size_t ws_size, hipStream_t stream) {
    static int grid = 0;
    if (grid == 0) {
        if (n_in != N_INPUTS || out_size != NTOK * DM || ws_size < WS_NEEDED || ws_size < OFF_RC_END) {
            fprintf(stderr, "kernel_launch: unexpected shapes: n_in %d out %d ws %zu (need %zu)\n", n_in, out_size, ws_size, (size_t)WS_NEEDED);
            grid = -1; return;
        }
        int dev = 0, cus = 0, per_cu = 0;
        (void)hipGetDevice(&dev);
        (void)hipDeviceGetAttribute(&cus, hipDeviceAttributeMultiprocessorCount, dev);
        if (hipFuncSetAttribute((const void*)fwd_kernel, hipFuncAttributeMaxDynamicSharedMemorySize, LDS_BYTES) != hipSuccess) { fprintf(stderr, "kernel_launch: hipFuncSetAttribute failed\n"); grid = -1; return; }
        if (hipOccupancyMaxActiveBlocksPerMultiprocessor(&per_cu, (const void*)fwd_kernel, NTHREADS, LDS_BYTES) != hipSuccess) per_cu = 1;
        (void)hipGetLastError();
        if (per_cu < 1) per_cu = 1;
        if (per_cu > 1) per_cu = 1;
        if (cus <= 0) cus = 256;
        grid = cus * per_cu;
    }
    if (grid < 0) return;
    (void)hipMemsetAsync(d_ws, 0, OFF_ZERO_END, stream);
    Params p{};
    for (int i = 0; i < N_INPUTS; ++i) p.in[i] = (const float*)d_in[i];
    p.out = (float*)d_out; p.ws = (unsigned char*)d_ws;
#if N_LAUNCH_SPLIT
    for (int ph = 0; ph < N_PHASES - 1; ++ph) {
        p.ph_lo = ph; p.ph_hi = ph + 1;
        hipLaunchKernelGGL(fwd_kernel, dim3(grid), dim3(NTHREADS), LDS_BYTES, stream, p);
    }
#else
    p.ph_lo = 0; p.ph_hi = N_PHASES;
    hipLaunchKernelGGL(fwd_kernel, dim3(grid), dim3(NTHREADS), LDS_BYTES, stream, p);
#endif
}
```

```cpp
#include <hip/hip_runtime.h>
#include <stdint.h>
#include <stdio.h>

typedef unsigned short bfr;
typedef __attribute__((ext_vector_type(8))) short bf16x8;
typedef __attribute__((ext_vector_type(16))) float f32x16;
typedef __attribute__((ext_vector_type(2))) __bf16 bf16x2_t;
#define DI __device__ __forceinline__
#define MFMA32(a, b, c) __builtin_amdgcn_mfma_f32_32x32x16_bf16((a), (b), (c), 0, 0, 0)

constexpr int NTOK = 32768, DM = 1024, SEQ = 2048, NB = 16;
constexpr int EVEN_IN = 2304, ODD_IN = 2048;
constexpr int NTHREADS = 512;
constexpr int NWAVES = NTHREADS / 64;
constexpr int LDS_BYTES = 161792;

enum { I_X = 0, I_NMIX, I_NFFN, I_EWIN, I_MU, I_W0, I_W2, I_A0, I_A2, I_G2, I_KK, I_KA, I_RK, I_LNG, I_LNB, I_V0, I_V1, I_V2,
       I_POOLW, I_POOLS, I_EWOUT, I_OWIN, I_QN, I_KN, I_LQ1, I_LK1, I_LQ2, I_LK2, I_SUBLN, I_ARE, I_AIM, I_LSTEP, I_BRE, I_BIM,
       I_CRE, I_CIM, I_S5D, I_WGLU, I_OWOUT, I_MWG, I_MBG, I_MWE, I_MBE, I_MWGATE, I_MWUP, I_MWDOWN, N_INPUTS };

constexpr size_t al256(size_t x) { return (x + 255) & ~(size_t)255; }
constexpr size_t OFF_BAR   = 0;
constexpr size_t OFF_CNT   = 16384;
constexpr size_t OFF_ZERO_END = 32768;
constexpr size_t OFF_WINE  = 65536;
constexpr size_t OFF_WOUTE = OFF_WINE  + (size_t)2 * 2304 * 1024 * 2;
constexpr size_t OFF_WINO  = OFF_WOUTE + (size_t)2 * 1024 * 1024 * 2;
constexpr size_t OFF_WOUTO = OFF_WINO  + (size_t)2 * 2048 * 1024 * 2;
constexpr size_t OFF_W2T   = OFF_WOUTO + (size_t)2 * 1024 * 1024 * 2;
constexpr size_t OFF_A2T   = OFF_W2T   + (size_t)2 * 512 * 64 * 2;
constexpr size_t OFF_G2T   = OFF_A2T   + (size_t)2 * 512 * 64 * 2;
constexpr size_t OFF_V12T  = OFF_G2T   + (size_t)2 * 512 * 128 * 2;
constexpr size_t OFF_POOLT = OFF_V12T  + (size_t)512 * 512 * 2;
constexpr size_t OFF_GLUT  = OFF_POOLT + (size_t)2 * 4 * 128 * 128 * 2;
constexpr size_t OFF_RHI   = OFF_GLUT  + (size_t)2 * 512 * 512 * 2;
constexpr size_t OFF_RLO   = OFF_RHI   + (size_t)4 * 128 * 1024 * 2;
constexpr size_t OFF_S5GT  = OFF_RLO   + (size_t)4 * 128 * 1024 * 2;
constexpr size_t OFF_S5BL  = OFF_S5GT  + (size_t)2 * 32 * 512 * 640 * 2;
constexpr size_t OFF_S5L32 = OFF_S5BL  + (size_t)2 * 32 * 128 * 512 * 2;
constexpr size_t OFF_MWGU  = al256(OFF_S5L32 + (size_t)2 * 32 * 64 * 2 * 4);
constexpr size_t OFF_MWD   = OFF_MWGU  + (size_t)32 * 1024 * 1024 * 2;
constexpr size_t OFF_HB    = OFF_MWD   + (size_t)32 * 1024 * 512 * 2;
constexpr size_t OFF_U     = OFF_HB    + (size_t)NTOK * 1024 * 2;
constexpr size_t OFF_US5   = OFF_U     + (size_t)NTOK * 1024 * 2;
constexpr size_t OFF_AMIX  = OFF_U     + (size_t)NTOK * 2304 * 2;
constexpr size_t OFF_VFIRST= OFF_AMIX  + (size_t)NTOK * 1024 * 2;
constexpr size_t OFF_TOK   = OFF_VFIRST+ (size_t)NTOK * 512 * 2;
constexpr size_t OFF_GATE  = OFF_TOK   + (size_t)64 * NTOK * 4;
constexpr size_t OFF_HID   = OFF_GATE  + (size_t)64 * NTOK * 4;
constexpr size_t OFF_HLO   = OFF_HID;
constexpr size_t OFF_EV    = OFF_HID   + (size_t)81920 * 512 * 2;
constexpr size_t OFF_S     = OFF_EV;
constexpr size_t OFF_MV2   = OFF_S     + (size_t)NTOK * 256 * 2;
constexpr size_t OFF_DLOG  = OFF_MV2   + (size_t)NTOK * 512 * 2;
constexpr size_t OFF_ABUF  = OFF_DLOG  + (size_t)NTOK * 512 * 4;
constexpr size_t OFF_GBUF  = OFF_ABUF  + (size_t)NTOK * 512 * 2;
constexpr size_t OFF_VGATE = OFF_GBUF  + (size_t)NTOK * 512 * 2;
constexpr size_t OFF_Y     = OFF_VGATE + (size_t)NTOK * 512 * 2;
constexpr size_t OFF_DPOOL = OFF_Y;
constexpr size_t OFF_BONUS = OFF_Y     + (size_t)NTOK * 512 * 4;
constexpr size_t OFF_EV_END= OFF_BONUS + (size_t)NTOK * 512 * 4;
constexpr size_t OFF_Y0    = OFF_EV;
constexpr size_t OFF_TSLOT = OFF_Y0    + (size_t)40960 * 1024 * 2;
static_assert(OFF_TSLOT + (size_t)NTOK * 4 <= OFF_EV_END, "MoE scratch must fit the mixer scratch region");
constexpr size_t OFF_QN    = OFF_EV;
constexpr size_t OFF_KN    = OFF_QN    + (size_t)NTOK * 512 * 2;
constexpr size_t OFF_VT    = OFF_KN    + (size_t)NTOK * 512 * 2;
constexpr size_t OFF_XLOC  = OFF_VT    + (size_t)NTOK * 512 * 2;
constexpr size_t OFF_XIN   = OFF_XLOC  + (size_t)32 * 1024 * 128 * 4;
constexpr size_t OFF_ZBUF  = OFF_XIN   + (size_t)32 * 1024 * 128 * 2;
constexpr size_t OFF_OD_END= OFF_ZBUF  + (size_t)NTOK * 512 * 2;
constexpr size_t WS_NEEDED = OFF_EV_END > OFF_OD_END ? OFF_EV_END : OFF_OD_END;

struct Params {
    const float* in[N_INPUTS];
    float* out;
    unsigned char* ws;
    int ph_lo, ph_hi;
};
typedef const __attribute__((address_space(4))) char* KArgPtr;
struct InTab {
    KArgPtr p;
    DI const float* operator[](int i) const {
        const float* q = *(const float* const __attribute__((address_space(4)))*)(p + 8 * i);
        return (const float*)(const __attribute__((address_space(1))) float*)q;
    }
};
struct Ctx { InTab in; unsigned char* ws; float* out; };

DI unsigned pk2(float a, float b) { bf16x2_t v; v[0] = (__bf16)a; v[1] = (__bf16)b; return __builtin_bit_cast(unsigned, v); }
DI bfr f2bf(float a) { return (bfr)(pk2(a, 0.f) & 0xffffu); }
DI float bf2f(bfr b) { return __uint_as_float(((unsigned)b) << 16); }
DI float bflo(unsigned u) { return __uint_as_float(u << 16); }
DI float bfhi(unsigned u) { return __uint_as_float(u & 0xffff0000u); }
DI uint4 pack8(const float (&v)[8]) { return make_uint4(pk2(v[0], v[1]), pk2(v[2], v[3]), pk2(v[4], v[5]), pk2(v[6], v[7])); }
DI void unpack8(uint4 u, float (&v)[8]) { v[0] = bflo(u.x); v[1] = bfhi(u.x); v[2] = bflo(u.y); v[3] = bfhi(u.y); v[4] = bflo(u.z); v[5] = bfhi(u.z); v[6] = bflo(u.w); v[7] = bfhi(u.w); }
DI float frcp(float x) { return __builtin_amdgcn_rcpf(x); }
DI float fexp(float x) { return __builtin_amdgcn_exp2f(x * 1.4426950408889634f); }
DI float sigmoidf_(float x) { return frcp(1.0f + fexp(-x)); }
DI float ftanh(float x) { return 2.0f * frcp(1.0f + fexp(-2.0f * x)) - 1.0f; }
DI float fsoftplus(float z) { return z > 20.0f ? z : __logf(1.0f + fexp(z)); }
template <int CTRL> DI float dpp_f(float x) { return __builtin_bit_cast(float, __builtin_amdgcn_update_dpp(0, __builtin_bit_cast(int, x), CTRL, 0xf, 0xf, false)); }
DI float row16_sum(float s) {
    s += dpp_f<0x128>(s); s += dpp_f<0x124>(s); s += dpp_f<0x122>(s); s += dpp_f<0x121>(s); return s; }
DI int ltid() { int t = threadIdx.x; asm volatile("" : "+v"(t)); return t; }
DI float dot4n(float s0, float s1, float s2, float s3, const float4& a) {
    float d;
    asm("v_mul_f32 %0, %1, %5\n\tv_fma_f32 %0, %2, %6, %0\n\tv_fma_f32 %0, %3, %7, %0\n\tv_fma_f32 %0, %4, %8, %0\n\ts_nop 1"
        : "=&v"(d) : "v"(s0), "v"(s1), "v"(s2), "v"(s3), "v"(a.x), "v"(a.y), "v"(a.z), "v"(a.w));
    return d;
}
DI void rw_upd(float& S, float w, float sa, float b, float vi, float k) {
    float t;
    asm("v_mul_f32 %1, %4, %5\n\tv_fma_f32 %1, %2, %3, %1\n\tv_fma_f32 %0, %0, %6, %1"
        : "+v"(S), "=&v"(t) : "v"(sa), "v"(b), "v"(vi), "v"(k), "v"(w));
}
DI float wave_sum(float s) { s = row16_sum(s); s += __shfl_xor(s, 16); s += __shfl_xor(s, 32); return s; }
#define XB_TMO      128
#define XB_XCNT(j)  (256  + 64 * (j))
#define XB_XSUB(j)  (1280 + 64 * (j))
#define XB_XGEN(j)  (2304 + 64 * (j))
#define XB_TOP      3328
#define XB_TOPGEN   3392
#define XCD_BAR_WORDS 3456
#define XB_SPIN_CAP (1u << 18)
#define LAS __attribute__((address_space(3)))

__device__ __forceinline__ unsigned xb_ld(unsigned* p)              { return __hip_atomic_load(p, __ATOMIC_RELAXED, __HIP_MEMORY_SCOPE_AGENT); }
__device__ __forceinline__ unsigned xb_add(unsigned* p, unsigned v) { return __hip_atomic_fetch_add(p, v, __ATOMIC_RELAXED, __HIP_MEMORY_SCOPE_AGENT); }
__device__ __forceinline__ unsigned xb_xcc_id() { return (unsigned)__builtin_amdgcn_s_getreg((3 << 11) | 20) & 0xFu; }
#define XB_SPIN(cond, bar) do { unsigned _sp = 0; while (cond) { __builtin_amdgcn_s_sleep(1); \
    if ((++_sp & 255u) == 0u) { if (xb_ld(&(bar)[XB_TMO])) break; if (_sp > XB_SPIN_CAP) { atomicAdd(&(bar)[XB_TMO], 1u); break; } } } } while (0)

struct XcdBarrier {
    unsigned* bar; unsigned x;
    volatile LAS unsigned* st;
};
__device__ __forceinline__ XcdBarrier xcd_barrier_post(unsigned* bar, volatile LAS unsigned* st) {
    XcdBarrier b; b.bar = bar; b.x = xb_xcc_id(); b.st = st;
    if (threadIdx.x == 0) (void)xb_add(&bar[XB_XCNT(b.x)], 1u);
    return b;
}
__device__ __forceinline__ void xcd_barrier_complete(unsigned* bar, unsigned x, unsigned& nloc, unsigned& nx) {
    const unsigned G = gridDim.x * gridDim.y * gridDim.z;
    unsigned sum, cnt, mine, sp = 0u;
    for (;;) {
        sum = 0u; cnt = 0u; mine = 0u;
#pragma unroll
        for (unsigned j = 0; j < 16; ++j) { const unsigned c = xb_ld(&bar[XB_XCNT(j)]); sum += c; cnt += (c > 0u) ? 1u : 0u; mine = (j == x) ? c : mine; }
        if (sum == G) break;
        __builtin_amdgcn_s_sleep(1);
        if ((++sp & 255u) == 0u) { if (xb_ld(&bar[XB_TMO])) break; if (sp > XB_SPIN_CAP) { atomicAdd(&bar[XB_TMO], 1u); break; } }
    }
    nloc = mine > 0u ? mine : 1u; nx = cnt > 0u ? cnt : 1u;
}
__device__ __forceinline__ void xcd_barrier(const XcdBarrier& b) {
    asm volatile("s_waitcnt vmcnt(0)" ::: "memory");
    __syncthreads();
    if (threadIdx.x == 0) {
        unsigned* bar = b.bar;
        __builtin_amdgcn_s_waitcnt(0);
        unsigned nloc = b.st[0], nx = b.st[1];
        if (nloc == 0u) { xcd_barrier_complete(bar, b.x, nloc, nx); b.st[0] = nloc; b.st[1] = nx; }
        const unsigned old = xb_add(&bar[XB_XSUB(b.x)], 1u);
        const unsigned gen = old / nloc;
        if (old + 1u == (gen + 1u) * nloc) {
            __builtin_amdgcn_fence(__ATOMIC_RELEASE, "agent");
            asm volatile("s_waitcnt vmcnt(0)" ::: "memory");
            const unsigned og = xb_add(&bar[XB_TOP], 1u);
            const unsigned tg = og / nx;
            if (og + 1u == (tg + 1u) * nx) xb_add(&bar[XB_TOPGEN], 1u);
            else XB_SPIN(xb_ld(&bar[XB_TOPGEN]) == tg, bar);
            __builtin_amdgcn_fence(__ATOMIC_ACQUIRE, "agent");
            xb_add(&bar[XB_XGEN(b.x)], 1u);
            asm volatile("s_waitcnt vmcnt(0)" ::: "memory");
        } else {
            XB_SPIN(xb_ld(&bar[XB_XGEN(b.x)]) == gen, bar);
            __builtin_amdgcn_fence(__ATOMIC_ACQUIRE, "agent");
            asm volatile("s_waitcnt vmcnt(0)" ::: "memory");
        }
    }
    __syncthreads();
}

constexpr int LDA = 72;
constexpr int TILE_B = 128 * LDA * 2;
constexpr int STG_LD = 132;
constexpr int LDS_AUX = 139264;
typedef const __attribute__((address_space(1))) unsigned* GPtrU;
typedef __attribute__((address_space(3))) unsigned* LPtrU;
DI int gt_lcol(int t) { return (((t & 7) ^ ((t >> 4) & 7)) * 8); }

template <int WR, int WC, int MI, int NI, class AF, class BF, class EF>
DI void gemm8(char* lds, int nk, AF aptr, BF bptr, EF epi) {
    static_assert(WR * WC == NWAVES && WR * MI * 32 == 256, "wave grid");
    constexpr int NT = WC * NI * 32, A_BYTES = 256 * 128, STAGE = A_BYTES + NT * 128, NB = NT / 64, NP = NT / 128;
    const int tid = ltid(), lane = tid & 63, wave = tid >> 6;
    const int wr = wave / WC, wc = wave % WC;
    f32x16 acc[MI][NI];
#pragma unroll
    for (int a = 0; a < MI; ++a)
#pragma unroll
        for (int b = 0; b < NI; ++b)
#pragma unroll
            for (int r = 0; r < 16; ++r) acc[a][b][r] = 0.f;
#define G8_DMA(kt_, base_) do { char* db_ = (base_) + tid * 16; \
        _Pragma("unroll") for (int i_ = 0; i_ < 4; ++i_) __builtin_amdgcn_global_load_lds((GPtrU)aptr(i_, kt_), (LPtrU)(db_ + i_ * 8192), 16, 0, 0); \
        _Pragma("unroll") for (int i_ = 0; i_ < NB; ++i_) __builtin_amdgcn_global_load_lds((GPtrU)bptr(i_, kt_), (LPtrU)(db_ + A_BYTES + i_ * 8192), 16, 0, 0); } while (0)
#define G8_KS(cb_, ao_, bo_) do { bf16x8 af_[MI], bf_[NI]; \
        _Pragma("unroll") for (int m_ = 0; m_ < MI; ++m_) af_[m_] = *(const bf16x8*)((cb_) + (ao_) + m_ * 4096); \
        _Pragma("unroll") for (int n_ = 0; n_ < NI; ++n_) bf_[n_] = *(const bf16x8*)((cb_) + (bo_) + n_ * 4096); \
        _Pragma("unroll") for (int m_ = 0; m_ < MI; ++m_) _Pragma("unroll") for (int n_ = 0; n_ < NI; ++n_) acc[m_][n_] = MFMA32(af_[m_], bf_[n_], acc[m_][n_]); } while (0)
    const int ln = lane & 31, hf = lane >> 5, sw = (ln >> 1) & 7;
    const int arow = (wr * MI * 32 + ln) * 128, brow = A_BYTES + (wc * NI * 32 + ln) * 128;
    int ao0 = arow + ((0 + hf) ^ sw) * 16, ao1 = arow + ((2 + hf) ^ sw) * 16, ao2 = arow + ((4 + hf) ^ sw) * 16, ao3 = arow + ((6 + hf) ^ sw) * 16;
    int bo0 = brow + ((0 + hf) ^ sw) * 16, bo1 = brow + ((2 + hf) ^ sw) * 16, bo2 = brow + ((4 + hf) ^ sw) * 16, bo3 = brow + ((6 + hf) ^ sw) * 16;
    asm volatile("" : "+v"(ao0), "+v"(ao1), "+v"(ao2), "+v"(ao3), "+v"(bo0), "+v"(bo1), "+v"(bo2), "+v"(bo3));
    G8_DMA(0, lds);
    asm volatile("s_waitcnt vmcnt(0)" ::: "memory");
    __syncthreads();
    int buf = 0;
#pragma unroll 1
    for (int kt = 0; kt < nk - 1; ++kt) {
        G8_DMA(kt + 1, lds + (buf ^ 1) * STAGE);
        const char* cb = lds + buf * STAGE;
        G8_KS(cb, ao0, bo0); G8_KS(cb, ao1, bo1); G8_KS(cb, ao2, bo2); G8_KS(cb, ao3, bo3);
        asm volatile("s_waitcnt vmcnt(0)" ::: "memory");
        __syncthreads();
        buf ^= 1;
    }
    {
        const char* cb = lds + buf * STAGE;
        G8_KS(cb, ao0, bo0); G8_KS(cb, ao1, bo1); G8_KS(cb, ao2, bo2); G8_KS(cb, ao3, bo3);
    }
    __syncthreads();
#undef G8_DMA
#undef G8_KS
    float* stg = (float*)lds;
    int w_off = (wr * MI * 32 + 4 * (lane >> 5)) * STG_LD + ((wc * NI * 32) & 127) + (lane & 31);
    asm volatile("" : "+v"(w_off));
#pragma unroll
    for (int p = 0; p < NP; ++p) {
        if (((wc * NI * 32) >> 7) == p) {
#pragma unroll
            for (int m = 0; m < MI; ++m)
#pragma unroll
                for (int n = 0; n < NI; ++n)
#pragma unroll
                    for (int r = 0; r < 16; ++r)
                        stg[w_off + (m * 32 + (r & 3) + 8 * (r >> 2)) * STG_LD + n * 32] = acc[m][n][r];
        }
        __syncthreads();
        epi((const float*)stg, p);
        __syncthreads();
    }
}
template <class F> DI void epi_rows8(const float* stg, F f) {
    const int tid0 = ltid();
#pragma unroll
    for (int it = 0; it < 8; ++it) {
        const int idx = it * NTHREADS + tid0;
        const int r = idx >> 4, c0 = (idx & 15) * 8;
        const float4 p = *(const float4*)(stg + r * STG_LD + c0);
        const float4 q = *(const float4*)(stg + r * STG_LD + c0 + 4);
        const float v[8] = {p.x, p.y, p.z, p.w, q.x, q.y, q.z, q.w};
        f(r, c0, v);
    }
}
template <class T, class L, class F> DI void epi_rows8_pre(const float* stg, L loadf, F f) {
    const int tid0 = ltid();
    constexpr int BATCH = sizeof(T) > 16 ? 2 : 4;
#pragma unroll
    for (int h = 0; h < 8 / BATCH; ++h) {
        T pre[BATCH];
#pragma unroll
        for (int it = 0; it < BATCH; ++it) { const int idx = (h * BATCH + it) * NTHREADS + tid0; pre[it] = loadf(idx >> 4, (idx & 15) * 8); }
#pragma unroll
        for (int it = 0; it < BATCH; ++it) {
            const int idx = (h * BATCH + it) * NTHREADS + tid0;
            const int r = idx >> 4, c0 = (idx & 15) * 8;
            const float4 p = *(const float4*)(stg + r * STG_LD + c0);
            const float4 q = *(const float4*)(stg + r * STG_LD + c0 + 4);
            const float v[8] = {p.x, p.y, p.z, p.w, q.x, q.y, q.z, q.w};
            f(r, c0, v, pre[it]);
        }
    }
}
struct F8 { float4 a, b; };
DI void tile_remap(int L, int nM, int nN, int& pm, int& pn) {
    const int ntiles = nM * nN;
    int w = L;
    if ((ntiles & 7) == 0) w = (L & 7) * (ntiles >> 3) + (L >> 3);
    const int nig = 8 * nN, gid = w / nig, fm = gid * 8, rem = w - gid * nig;
    const int gsz = (nM - fm) < 8 ? (nM - fm) : 8;
    pm = fm + rem % gsz; pn = rem / gsz;
}
struct RowLoader {
    const bfr* p; size_t ld;
    DI RowLoader(const bfr* base, int row0, size_t ld_) : ld(ld_) { const int t = ltid(); p = base + (size_t)(row0 + (t >> 3)) * ld_ + gt_lcol(t); }
    DI const bfr* operator()(int i, int kt) const { return p + (size_t)(64 * i) * ld + kt * 64; }
};
#define GEMM256 gemm8<2, 4, 4, 2>
#define GEMM128 gemm8<4, 2, 2, 2>
struct G4 { char* lds; int tid; int vb; int nvb; volatile LAS unsigned* cnt; };
constexpr int G4_LDS = 77824;
constexpr int G4_AUX = 73728;
constexpr int G4_TILE = 128 * 128;
DI G4 g4_make(char* lds) {
    G4 g; const int t = ltid(); const int grp = t >> 8;
    g.lds = lds + grp * G4_LDS; g.tid = t & 255; g.vb = blockIdx.x * 2 + grp; g.nvb = gridDim.x * 2;
    g.cnt = (volatile LAS unsigned*)(lds + LDS_BYTES - 32) + grp;
    return g;
}
DI void g4_bar(const G4& G) {
    asm volatile("s_waitcnt lgkmcnt(0)" ::: "memory");
    unsigned target = 0;
    if ((G.tid & 63) == 0) {
        const unsigned old = __hip_atomic_fetch_add((LAS unsigned*)G.cnt, 1u, __ATOMIC_RELAXED, __HIP_MEMORY_SCOPE_WORKGROUP);
        target = (old & ~3u) + 4u;
    }
    target = __builtin_amdgcn_readfirstlane(target);
    while ((int)(*G.cnt - target) < 0) __builtin_amdgcn_s_sleep(1);
    asm volatile("" ::: "memory");
}
template <class F> DI void g4_epi_rows8(const G4& G, const float* stg, F f) {
#pragma unroll
    for (int it = 0; it < 8; ++it) {
        const int idx = it * 256 + G.tid;
        const int r = idx >> 4, c0 = (idx & 15) * 8;
        const float4 p = *(const float4*)(stg + r * STG_LD + c0);
        const float4 q = *(const float4*)(stg + r * STG_LD + c0 + 4);
        const float v[8] = {p.x, p.y, p.z, p.w, q.x, q.y, q.z, q.w};
        f(r, c0, v);
    }
}
template <class T, class L, class F> DI void g4_epi_rows8_pre(const G4& G, const float* stg, L loadf, F f) {
    T pre[8];
#pragma unroll
    for (int it = 0; it < 8; ++it) { const int idx = it * 256 + G.tid; pre[it] = loadf(idx >> 4, (idx & 15) * 8); }
#pragma unroll
    for (int it = 0; it < 8; ++it) {
        const int idx = it * 256 + G.tid;
        const int r = idx >> 4, c0 = (idx & 15) * 8;
        const float4 p = *(const float4*)(stg + r * STG_LD + c0);
        const float4 q = *(const float4*)(stg + r * STG_LD + c0 + 4);
        const float v[8] = {p.x, p.y, p.z, p.w, q.x, q.y, q.z, q.w};
        f(r, c0, v, pre[it]);
    }
}
struct G4RowLoader {
    const bfr* p; size_t ld;
    DI G4RowLoader(const G4& G, const bfr* base, int row0, size_t ld_) : ld(ld_) { p = base + (size_t)(row0 + (G.tid >> 3)) * ld_ + gt_lcol(G.tid); }
    DI const bfr* operator()(int i, int kt) const { return p + (size_t)(32 * i) * ld + kt * 64; }
};
template <class AF, class BF, class EF>
DI void g4_gemm_tile(const G4& G, char* lds, int nk, AF aptr, BF bptr, EF epi) {
    const int tid = G.tid, lane = tid & 63, wave = tid >> 6;
    const int wr = wave >> 1, wc = wave & 1;
    f32x16 acc00, acc01, acc10, acc11;
#pragma unroll
    for (int r = 0; r < 16; ++r) { acc00[r] = 0.f; acc01[r] = 0.f; acc10[r] = 0.f; acc11[r] = 0.f; }
#define GT_DMA(kt_, base_) do { char* db_ = (base_) + tid * 16; _Pragma("unroll") for (int i_ = 0; i_ < 4; ++i_) { \
        __builtin_amdgcn_global_load_lds((GPtrU)aptr(i_, kt_), (LPtrU)(db_ + i_ * 4096), 16, 0, 0); \
        __builtin_amdgcn_global_load_lds((GPtrU)bptr(i_, kt_), (LPtrU)(db_ + G4_TILE + i_ * 4096), 16, 0, 0); } } while (0)
#define GT_FRAG(cb_, off_) (*(const bf16x8*)((cb_) + (off_)))
#define GT_COMPUTE(base_) do { const char* cb_ = (base_); \
        { const bf16x8 a0 = GT_FRAG(cb_, ao0), a1 = GT_FRAG(cb_, ao0 + 4096), b0 = GT_FRAG(cb_, bo0), b1 = GT_FRAG(cb_, bo0 + 4096); \
          acc00 = MFMA32(a0, b0, acc00); acc01 = MFMA32(a0, b1, acc01); acc10 = MFMA32(a1, b0, acc10); acc11 = MFMA32(a1, b1, acc11); } \
        { const bf16x8 a0 = GT_FRAG(cb_, ao1), a1 = GT_FRAG(cb_, ao1 + 4096), b0 = GT_FRAG(cb_, bo1), b1 = GT_FRAG(cb_, bo1 + 4096); \
          acc00 = MFMA32(a0, b0, acc00); acc01 = MFMA32(a0, b1, acc01); acc10 = MFMA32(a1, b0, acc10); acc11 = MFMA32(a1, b1, acc11); } \
        { const bf16x8 a0 = GT_FRAG(cb_, ao2), a1 = GT_FRAG(cb_, ao2 + 4096), b0 = GT_FRAG(cb_, bo2), b1 = GT_FRAG(cb_, bo2 + 4096); \
          acc00 = MFMA32(a0, b0, acc00); acc01 = MFMA32(a0, b1, acc01); acc10 = MFMA32(a1, b0, acc10); acc11 = MFMA32(a1, b1, acc11); } \
        { const bf16x8 a0 = GT_FRAG(cb_, ao3), a1 = GT_FRAG(cb_, ao3 + 4096), b0 = GT_FRAG(cb_, bo3), b1 = GT_FRAG(cb_, bo3 + 4096); \
          acc00 = MFMA32(a0, b0, acc00); acc01 = MFMA32(a0, b1, acc01); acc10 = MFMA32(a1, b0, acc10); acc11 = MFMA32(a1, b1, acc11); } } while (0)
    const int ln = lane & 31, hf = lane >> 5, sw = (ln >> 1) & 7;
    int ao0 = wr * 8192 + ln * 128 + ((0 + hf) ^ sw) * 16, ao1 = wr * 8192 + ln * 128 + ((2 + hf) ^ sw) * 16;
    int ao2 = wr * 8192 + ln * 128 + ((4 + hf) ^ sw) * 16, ao3 = wr * 8192 + ln * 128 + ((6 + hf) ^ sw) * 16;
    int bo0 = G4_TILE + wc * 8192 + ln * 128 + ((0 + hf) ^ sw) * 16, bo1 = G4_TILE + wc * 8192 + ln * 128 + ((2 + hf) ^ sw) * 16;
    int bo2 = G4_TILE + wc * 8192 + ln * 128 + ((4 + hf) ^ sw) * 16, bo3 = G4_TILE + wc * 8192 + ln * 128 + ((6 + hf) ^ sw) * 16;
    asm volatile("" : "+v"(ao0), "+v"(ao1), "+v"(ao2), "+v"(ao3), "+v"(bo0), "+v"(bo1), "+v"(bo2), "+v"(bo3));
    GT_DMA(0, lds);
    asm volatile("s_waitcnt vmcnt(0)" ::: "memory");
    g4_bar(G);
    int buf = 0;
#pragma unroll 1
    for (int kt = 0; kt < nk - 1; ++kt) {
        GT_DMA(kt + 1, lds + (buf ^ 1) * (2 * G4_TILE));
        GT_COMPUTE(lds + buf * (2 * G4_TILE));
        asm volatile("s_waitcnt vmcnt(0)" ::: "memory");
        g4_bar(G);
        buf ^= 1;
    }
    GT_COMPUTE(lds + buf * (2 * G4_TILE));
    g4_bar(G);
#undef GT_DMA
#undef GT_FRAG
#undef GT_COMPUTE
    float* stg = (float*)lds;
    int w_off = (wr * 64 + 4 * (lane >> 5)) * STG_LD + wc * 64 + (lane & 31);
    asm volatile("" : "+v"(w_off));
#pragma unroll
    for (int r = 0; r < 16; ++r) {
        const int ro = ((r & 3) + 8 * (r >> 2)) * STG_LD;
        stg[w_off + ro] = acc00[r];
        stg[w_off + ro + 32] = acc01[r];
        stg[w_off + ro + 32 * STG_LD] = acc10[r];
        stg[w_off + ro + 32 * STG_LD + 32] = acc11[r];
    }
    g4_bar(G);
    epi((const float*)stg);
    g4_bar(G);
}

DI void g4_attn_item(const G4& G, char* lds, const Ctx& P, int b, int h, int qt, float lam, float lam_init, const float* subln) {
    const bfr* qn = (const bfr*)(P.ws + OFF_QN);
    const bfr* kn = (const bfr*)(P.ws + OFF_KN);
    const bfr* vT = (const bfr*)(P.ws + OFF_VT) + (size_t)(b * 4 + h) * 128 * SEQ;
    bfr* am = (bfr*)(P.ws + OFF_AMIX);
    const int tid = G.tid, lane = tid & 63, wave = tid >> 6;
    const int m = wave >> 1, qw = (wave & 1) * 32;
    const int q0 = qt * 64 + qw;
    const int ln = lane & 31, hf = lane >> 5;
    bf16x8 qf[4];
    {
        const bfr* qp = qn + ((size_t)b * SEQ + q0 + ln) * 512 + h * 128 + m * 64 + hf * 8;
#pragma unroll
        for (int ks = 0; ks < 4; ++ks) qf[ks] = *(const bf16x8*)(qp + ks * 16);
    }
    f32x16 o[4];
#pragma unroll
    for (int d = 0; d < 4; ++d)
#pragma unroll
        for (int r = 0; r < 16; ++r) o[d][r] = 0.f;
    float mrun = -INFINITY, lrun = 0.f;
    const int nkt = qt + 1;
    const int lrow = tid >> 3, lcol = (tid & 7) * 8;
    const bfr* kbase = kn + ((size_t)b * SEQ) * 512 + h * 128;
    unsigned ko = (unsigned)(lrow * 512 + lcol) * 2u, vo = (unsigned)(lrow * SEQ + lcol) * 2u;
    asm volatile("" : "+v"(ko), "+v"(vo));
    uint4 rk0, rk1, rk2, rk3, rv0, rv1, rv2, rv3;
#define ATT_GLOAD(kt_) do { const char* kp_ = (const char*)(kbase + (size_t)(kt_) * (64 * 512)); const char* vp_ = (const char*)(vT + (kt_) * 64); \
        rk0 = *(const uint4*)(kp_ + ko); rk1 = *(const uint4*)(kp_ + 32 * 512 * 2 + ko); rk2 = *(const uint4*)(kp_ + 64 * 2 + ko); rk3 = *(const uint4*)(kp_ + 32 * 512 * 2 + 64 * 2 + ko); \
        rv0 = *(const uint4*)(vp_ + vo); rv1 = *(const uint4*)(vp_ + 32 * SEQ * 2 + vo); rv2 = *(const uint4*)(vp_ + 64 * SEQ * 2 + vo); rv3 = *(const uint4*)(vp_ + 96 * SEQ * 2 + vo); } while (0)
#define ATT_S1(base_, i_, RK, RV) { *(uint4*)((base_) + (32 * (i_)) * LDA * 2) = RK; \
        *(uint4*)((base_) + TILE_B + (32 * (i_)) * LDA * 2) = RV; }
#define ATT_LSTORE(buf_) do { char* base_ = lds + (buf_) * (2 * TILE_B) + s_off; ATT_S1(base_, 0, rk0, rv0) ATT_S1(base_, 1, rk1, rv1) ATT_S1(base_, 2, rk2, rv2) ATT_S1(base_, 3, rk3, rv3) } while (0)
    int k_off = ((m * 64 + ln) * LDA + hf * 8) * 2;
    int v_off = TILE_B + (ln * LDA + 4 * hf) * 2;
    int s_off = (lrow * LDA + lcol) * 2;
    asm volatile("" : "+v"(k_off), "+v"(v_off), "+v"(s_off));
    ATT_GLOAD(0); ATT_LSTORE(0);
    g4_bar(G);
    int buf = 0;
#pragma unroll 1
    for (int kt = 0; kt < nkt; ++kt) {
        const bool more = (kt + 1 < nkt);
        const char* ks_ = lds + buf * (2 * TILE_B) + k_off;
        const char* vs_ = lds + buf * (2 * TILE_B) + v_off;
        if (kt * 64 <= q0 + 31) {
            f32x16 s[2];
#pragma unroll
            for (int kb = 0; kb < 2; ++kb) {
#pragma unroll
                for (int r = 0; r < 16; ++r) s[kb][r] = 0.f;
#pragma unroll
                for (int ks = 0; ks < 4; ++ks) {
                    const bf16x8 kf = *(const bf16x8*)(ks_ + ((kb * 32) * LDA + ks * 16) * 2);
                    s[kb] = MFMA32(kf, qf[ks], s[kb]);
                }
            }
            const int qpos = q0 + ln;
            if (kt * 64 + 63 > q0) {
#pragma unroll
                for (int kb = 0; kb < 2; ++kb)
#pragma unroll
                    for (int r = 0; r < 16; ++r) {
                        const int key = kt * 64 + kb * 32 + (r & 3) + 8 * (r >> 2) + 4 * hf;
                        if (key > qpos) s[kb][r] = -INFINITY;
                    }
            }
            float mx = s[0][0];
#pragma unroll
            for (int kb = 0; kb < 2; ++kb)
#pragma unroll
                for (int r = 0; r < 16; ++r) mx = fmaxf(mx, s[kb][r]);
            mx = fmaxf(mx, __shfl_xor(mx, 32));
            const float mnew = fmaxf(mrun, mx);
            const float alpha = __builtin_amdgcn_exp2f(mrun - mnew);
            mrun = mnew;
            float rsum = 0.f;
#pragma unroll
            for (int kb = 0; kb < 2; ++kb)
#pragma unroll
                for (int r = 0; r < 16; ++r) { const float p = __builtin_amdgcn_exp2f(s[kb][r] - mnew); s[kb][r] = p; rsum += p; }
            lrun = lrun * alpha + rsum;
#pragma unroll
            for (int d = 0; d < 4; ++d)
#pragma unroll
                for (int r = 0; r < 16; ++r) o[d][r] *= alpha;
            __builtin_amdgcn_sched_barrier(0);
            if (more) ATT_GLOAD(kt + 1);
#pragma unroll
            for (int kb = 0; kb < 2; ++kb)
#pragma unroll
                for (int st = 0; st < 2; ++st) {
                    const uint4 pp = make_uint4(pk2(s[kb][8 * st + 0], s[kb][8 * st + 1]), pk2(s[kb][8 * st + 2], s[kb][8 * st + 3]),
                                                pk2(s[kb][8 * st + 4], s[kb][8 * st + 5]), pk2(s[kb][8 * st + 6], s[kb][8 * st + 7]));
                    const bf16x8 pf = __builtin_bit_cast(bf16x8, pp);
                    const int kc = kb * 32 + 16 * st;
#pragma unroll
                    for (int d = 0; d < 4; ++d) {
                        const uint2 v0 = *(const uint2*)(vs_ + ((d * 32) * LDA + kc) * 2);
                        const uint2 v1 = *(const uint2*)(vs_ + ((d * 32) * LDA + kc + 8) * 2);
                        const bf16x8 vf = __builtin_bit_cast(bf16x8, make_uint4(v0.x, v0.y, v1.x, v1.y));
                        o[d] = MFMA32(vf, pf, o[d]);
                    }
                }
        }
        else if (more) ATT_GLOAD(kt + 1);
        if (more) ATT_LSTORE(buf ^ 1);
        g4_bar(G);
        buf ^= 1;
    }
    const float ltot = lrun + __shfl_xor(lrun, 32);
    const float linv = 1.0f / ltot;
    float* ob = (float*)lds;
    int o_off = (m * 64 + qw + ln) * 129 + 4 * hf;
    asm volatile("" : "+v"(o_off));
#pragma unroll
    for (int d = 0; d < 4; ++d)
#pragma unroll
        for (int r = 0; r < 16; ++r) ob[o_off + d * 32 + (r & 3) + 8 * (r >> 2)] = o[d][r] * linv;
    g4_bar(G);
#pragma unroll
    for (int it = 0; it < 4; ++it) {
        const int idx = it * 256 + tid;
        const int q = idx >> 4, c0 = (idx & 15) * 8;
        float v[8];
        float ss = 0.f;
        int r_off = q * 129 + c0;
        asm volatile("" : "+v"(r_off));
#pragma unroll
        for (int j = 0; j < 8; ++j) { v[j] = ob[r_off + j] - lam * ob[r_off + 64 * 129 + j]; ss += v[j] * v[j]; }
        ss = row16_sum(ss);
        const float rs = rsqrtf(ss * (1.0f / 128.0f) + 1e-5f) * (1.0f - lam_init);
#pragma unroll
        for (int j = 0; j < 8; ++j) v[j] = v[j] * rs * subln[c0 + j];
        *(uint4*)(am + ((size_t)b * SEQ + qt * 64 + q) * 1024 + h * 128 + c0) = pack8(v);
    }
    g4_bar(G);
}

#undef ATT_GLOAD
#undef ATT_S1
#undef ATT_LSTORE
#undef ATT_OFF
#undef ATT_G1
DI int cvt_rowmap(int n, int mode) { return mode == 0 ? n : ((n >> 2) * 8 + (n & 3) + (mode == 2 ? 4 : 0)); }
DI void cvt_tile(char* lds, const float* __restrict__ src, int N, bfr* __restrict__ dst, int ldd, int k0, int n0, int mode) {
    float* t = (float*)lds;
    const int tid = ltid();
    const int r = tid >> 5, c = (tid & 31) * 4;
#pragma unroll
    for (int i = 0; i < 4; ++i) {
        const float4 v = *(const float4*)(src + (size_t)(k0 + r + 16 * i) * N + n0 + c);
        float* d = t + (r + 16 * i) * 129 + c;
        d[0] = v.x; d[1] = v.y; d[2] = v.z; d[3] = v.w;
    }
    __syncthreads();
#pragma unroll
    for (int i = 0; i < 2; ++i) {
        const int idx = tid + i * NTHREADS;
        const int n = idx & 127, kg = idx >> 7;
        float v[8];
#pragma unroll
        for (int j = 0; j < 8; ++j) v[j] = t[(kg * 8 + j) * 129 + n];
        *(uint4*)(dst + (size_t)cvt_rowmap(n0 + n, mode) * ldd + k0 + kg * 8) = pack8(v);
    }
    __syncthreads();
}
DI void cvt_matrix(char* lds, const float* src, int K, int N, bfr* dst, int ldd, int mode, int worker, int nworkers, unsigned& base) {
    if (worker < 0) return;
    const int ntn = N >> 7, ntiles = (K >> 6) * ntn;
    int t0 = (int)(((unsigned)worker + (unsigned)nworkers - (base % (unsigned)nworkers)) % (unsigned)nworkers);
    for (int t = t0; t < ntiles; t += nworkers) cvt_tile(lds, src, N, dst, ldd, (t / ntn) * 64, (t % ntn) * 128, mode);
    base += (unsigned)ntiles;
}
struct CvtTile { const float* src; bfr* dst; int N, ldd, mode; };
DI CvtTile moe_cvt_tile(const Ctx& P, int layer, int t) {
    const int e = t / 192, r = t % 192, m = r >> 6, q = r & 63;
    const size_t we = (size_t)(layer * 32 + e);
    CvtTile c;
    if (m < 2) {
        const int k0 = (q >> 2) * 64, n0 = (q & 3) * 128;
        c.src = P.in[m == 0 ? I_MWGATE : I_MWUP] + we * 1024 * 512 + (size_t)k0 * 512 + n0; c.N = 512;
        c.dst = (bfr*)(P.ws + OFF_MWGU) + (size_t)e * 1024 * 1024 + k0; c.ldd = 1024; c.mode = 1 + m;
        c.dst += (size_t)0; c.mode |= (n0 << 8);
    } else {
        const int k0 = (q >> 3) * 64, n0 = (q & 7) * 128;
        c.src = P.in[I_MWDOWN] + we * 512 * 1024 + (size_t)k0 * 1024 + n0; c.N = 1024;
        c.dst = (bfr*)(P.ws + OFF_MWD) + (size_t)e * 1024 * 512 + k0; c.ldd = 512; c.mode = (n0 << 8);
    }
    return c;
}
DI void moe_convert_range(char* lds, const Ctx& P, int layer, int t_begin, int t_end) {
    if (t_begin >= t_end) return;
    float* tl = (float*)lds;
    const int tid = ltid();
    const int r = tid >> 5, c4 = (tid & 31) * 4;
    CvtTile cur = moe_cvt_tile(P, layer, t_begin);
    float4 v0, v1, v2, v3;
#define CVT_LOAD(ct_) do { const float* s_ = (ct_).src + (size_t)r * (ct_).N + c4; \
        v0 = *(const float4*)(s_); v1 = *(const float4*)(s_ + (size_t)16 * (ct_).N); v2 = *(const float4*)(s_ + (size_t)32 * (ct_).N); v3 = *(const float4*)(s_ + (size_t)48 * (ct_).N); } while (0)
    CVT_LOAD(cur);
    for (int t = t_begin; t < t_end; ++t) {
        { float* d = tl + r * 129 + c4;
          d[0] = v0.x; d[1] = v0.y; d[2] = v0.z; d[3] = v0.w; d += 16 * 129; d[0] = v1.x; d[1] = v1.y; d[2] = v1.z; d[3] = v1.w;
          d += 16 * 129; d[0] = v2.x; d[1] = v2.y; d[2] = v2.z; d[3] = v2.w; d += 16 * 129; d[0] = v3.x; d[1] = v3.y; d[2] = v3.z; d[3] = v3.w; }
        const CvtTile me = cur;
        if (t + 1 < t_end) { cur = moe_cvt_tile(P, layer, t + 1); CVT_LOAD(cur); }
        __syncthreads();
        const int mode = me.mode & 255, n0 = me.mode >> 8;
#pragma unroll
        for (int i = 0; i < 2; ++i) {
            const int idx = tid + i * NTHREADS;
            const int n = idx & 127, kg = idx >> 7;
            float v[8];
#pragma unroll
            for (int j = 0; j < 8; ++j) v[j] = tl[(kg * 8 + j) * 129 + n];
            *(uint4*)(me.dst + (size_t)cvt_rowmap(n0 + n, mode) * me.ldd + kg * 8) = pack8(v);
        }
        __syncthreads();
    }
#undef CVT_LOAD
}
DI void s5_tables(char* lds, const Ctx& P, int i, int g) {
    float2* pw = (float2*)lds;
    float2* bb = pw + 64 * 33;
    float2* cm = bb + 64 * 16;
    float*  kt = (float*)(cm + 16 * 64);
    const int tid = ltid();
    const size_t gp = (size_t)(i * 32 + g) * 64;
    for (int idx = tid; idx < 64 * 33; idx += NTHREADS) {
        const int p = idx / 33, tau = idx % 33;
        const float re = fminf(P.in[I_ARE][gp + p], -1e-4f), im = P.in[I_AIM][gp + p];
        const float st = expf(P.in[I_LSTEP][gp + p]);
        const float mag = expf(re * st * (float)tau);
        const double angd = (double)im * (double)st * (double)tau;
        const double red = angd - 6.283185307179586 * floor(angd * 0.15915494309189535);
        float sn, cs; sincosf((float)red, &sn, &cs);
        pw[idx] = make_float2(mag * cs, mag * sn);
    }
    for (int idx = tid; idx < 64 * 16; idx += NTHREADS) {
        const int p = idx >> 4, c = idx & 15;
        const double re = fmin((double)P.in[I_ARE][gp + p], -1e-4), im = (double)P.in[I_AIM][gp + p];
        const double st = exp((double)P.in[I_LSTEP][gp + p]);
        const double mag = exp(re * st), lr = mag * cos(im * st) - 1.0, li = mag * sin(im * st);
        const double den = re * re + im * im;
        const double fr = (lr * re + li * im) / den, fi = (li * re - lr * im) / den;
        const double br = (double)P.in[I_BRE][(gp + p) * 16 + c], bi = (double)P.in[I_BIM][(gp + p) * 16 + c];
        bb[idx] = make_float2((float)(fr * br - fi * bi), (float)(fr * bi + fi * br));
        const int cc = idx >> 6, pp = idx & 63;
        cm[idx] = make_float2(P.in[I_CRE][((size_t)(i * 32 + g) * 16 + cc) * 64 + pp], P.in[I_CIM][((size_t)(i * 32 + g) * 16 + cc) * 64 + pp]);
    }
    __syncthreads();
    for (int idx = tid; idx < 32 * 256; idx += NTHREADS) {
        const int tau = idx >> 8, c1 = (idx >> 4) & 15, c = idx & 15;
        float s = 0.f;
        for (int p = 0; p < 64; ++p) {
            const float2 a = cm[c1 * 64 + p], w = pw[p * 33 + tau], b = bb[p * 16 + c];
            const float tr = a.x * w.x - a.y * w.y, ti = a.x * w.y + a.y * w.x;
            s += tr * b.x - ti * b.y;
        }
        kt[idx] = s;
    }
    __syncthreads();
    bfr* gt = (bfr*)(P.ws + OFF_S5GT) + (size_t)(i * 32 + g) * 512 * 640;
    for (int idx = tid; idx < 512 * 80; idx += NTHREADS) {
        const int n = idx / 80, ch = idx % 80;
        const int t = n >> 4, c1 = n & 15;
        float v[8];
        if (ch < 64) {
            const int s = ch >> 1, c0 = (ch & 1) * 8;
#pragma unroll
            for (int j = 0; j < 8; ++j) v[j] = (t >= s) ? kt[((t - s) * 16 + c1) * 16 + c0 + j] : 0.f;
        } else {
            const int p0 = (ch - 64) * 4;
#pragma unroll
            for (int j = 0; j < 4; ++j) {
                const float2 a = cm[c1 * 64 + p0 + j], w = pw[(p0 + j) * 33 + t + 1];
                v[2 * j] = a.x * w.x - a.y * w.y;
                v[2 * j + 1] = -(a.x * w.y + a.y * w.x);
            }
        }
        *(uint4*)(gt + (size_t)n * 640 + ch * 8) = pack8(v);
    }
    bfr* bl = (bfr*)(P.ws + OFF_S5BL) + (size_t)(i * 32 + g) * 128 * 512;
    for (int idx = tid; idx < 128 * 64; idx += NTHREADS) {
        const int n = idx >> 6, ch = idx & 63;
        const int p = n >> 1, ri = n & 1, s = ch >> 1, c0 = (ch & 1) * 8;
        const float2 w = pw[p * 33 + 31 - s];
        float v[8];
#pragma unroll
        for (int j = 0; j < 8; ++j) { const float2 b = bb[p * 16 + c0 + j]; v[j] = ri ? (w.x * b.y + w.y * b.x) : (w.x * b.x - w.y * b.y); }
        *(uint4*)(bl + (size_t)n * 512 + ch * 8) = pack8(v);
    }
    float* l32 = (float*)(P.ws + OFF_S5L32) + (size_t)(i * 32 + g) * 128;
    if (tid < 64) { l32[2 * tid] = pw[tid * 33 + 32].x; l32[2 * tid + 1] = pw[tid * 33 + 32].y; }
    __syncthreads();
}

DI void norm_rows(const float* __restrict__ x, const float* __restrict__ g, bfr* __restrict__ hb, bfr* __restrict__ hlo, float* __restrict__ xcopy, int tok0, int ntok) {
    const int tid_ = ltid();
    const int lane = tid_ & 63, wave = tid_ >> 6;
    for (int tk = wave; tk < ntok; tk += NWAVES) {
        const size_t tok = (size_t)(tok0 + tk);
        float4 v[4];
        float ss = 0.f;
#pragma unroll
        for (int i = 0; i < 4; ++i) {
            v[i] = *(const float4*)(x + tok * DM + i * 256 + lane * 4);
            ss += v[i].x * v[i].x + v[i].y * v[i].y + v[i].z * v[i].z + v[i].w * v[i].w;
        }
        ss = wave_sum(ss);
        const float rs = rsqrtf(ss * (1.0f / DM) + 1e-6f);
#pragma unroll
        for (int i = 0; i < 4; ++i) {
            const float4 gg = *(const float4*)(g + i * 256 + lane * 4);
            const float h0 = v[i].x * rs * gg.x, h1 = v[i].y * rs * gg.y, h2 = v[i].z * rs * gg.z, h3 = v[i].w * rs * gg.w;
            const unsigned p0 = pk2(h0, h1), p1 = pk2(h2, h3);
            *(uint2*)(hb + tok * DM + i * 256 + lane * 4) = make_uint2(p0, p1);
            if (hlo) {
                const unsigned q0 = pk2(h0 - bflo(p0), h1 - bfhi(p0)), q1 = pk2(h2 - bflo(p1), h3 - bfhi(p1));
                *(uint2*)(hlo + tok * DM + i * 256 + lane * 4) = make_uint2(q0, q1);
            }
            if (xcopy) *(float4*)(xcopy + tok * DM + i * 256 + lane * 4) = v[i];
        }
    }
}
DI void phase_e1(char* lds, const Ctx& P, int li) {
    const bfr* hb = (const bfr*)(P.ws + OFF_HB);
    const bfr* w = (const bfr*)(P.ws + OFF_WINE) + (size_t)li * 2304 * 1024;
    bfr* u = (bfr*)(P.ws + OFF_U);
    const int ntiles = 128 * 9, G = gridDim.x;
    const int full = (ntiles / G) * G, rem = ntiles - full;
    const bool halves = rem > 0 && 2 * rem <= G;
    for (int t = blockIdx.x; t < (halves ? full : ntiles); t += G) {
        int mt, nt; tile_remap(t, 128, 9, mt, nt);
        RowLoader A(hb, mt * 256, 1024), B(w, nt * 256, 1024);
        GEMM256(lds, 16, A, B, [&](const float* stg, int p) __attribute__((always_inline)) {
            epi_rows8(stg, [&](int r, int c0, const float (&v)[8]) __attribute__((always_inline)) {
                *(uint4*)(u + (size_t)(mt * 256 + r) * EVEN_IN + nt * 256 + p * 128 + c0) = pack8(v);
            });
        });
    }
    if (halves && (int)blockIdx.x < 2 * rem) {
        int mt, nt; tile_remap(full + ((int)blockIdx.x >> 1), 128, 9, mt, nt);
        const int hc = (blockIdx.x & 1) * 128;
        RowLoader A(hb, mt * 256, 1024), B(w, nt * 256 + hc, 1024);
        GEMM128(lds, 16, A, B, [&](const float* stg, int) __attribute__((always_inline)) {
            epi_rows8(stg, [&](int r, int c0, const float (&v)[8]) __attribute__((always_inline)) {
                *(uint4*)(u + (size_t)(mt * 256 + r) * EVEN_IN + nt * 256 + hc + c0) = pack8(v);
            });
        });
    }
}

DI void phase_e2a(const Ctx& P, int li) {
    const bfr* u = (const bfr*)(P.ws + OFF_U);
    const float* mu = P.in[I_MU] + (size_t)li * 1792;
    bfr* S = (bfr*)(P.ws + OFF_S);
    bfr* mv = (bfr*)(P.ws + (li == 0 ? OFF_VFIRST : OFF_MV2));
    bfr* dpool = (bfr*)(P.ws + OFF_DPOOL);
    const int total = NTOK * 160;
    for (int idx = blockIdx.x * NTHREADS + ltid(); idx < total; idx += gridDim.x * NTHREADS) {
        const int tok = idx / 160, ch = idx % 160;
        const int col = 1024 + ch * 8;
        const int t = tok & (SEQ - 1);
        const bfr* row = u + (size_t)tok * EVEN_IN;
        float cur[8];
        unpack8(*(const uint4*)(row + col), cur);
        if (col < 1792) {
            float prv[8], m[8];
            if (t > 0) unpack8(*(const uint4*)(row - EVEN_IN + col), prv);
            else {
#pragma unroll
                for (int j = 0; j < 8; ++j) prv[j] = 0.f;
            }
            const float4 m0 = *(const float4*)(mu + col), m1 = *(const float4*)(mu + col + 4);
            const float mm[8] = {m0.x, m0.y, m0.z, m0.w, m1.x, m1.y, m1.z, m1.w};
#pragma unroll
            for (int j = 0; j < 8; ++j) m[j] = cur[j] + (prv[j] - cur[j]) * mm[j];
            if (col < 1536) {
                *(uint4*)(mv + (size_t)tok * 512 + (col - 1024)) = pack8(m);
            } else if (col < 1600) {
#pragma unroll
                for (int j = 0; j < 8; ++j) m[j] = ftanh(m[j]);
                *(uint4*)(S + (size_t)tok * 256 + (col - 1536)) = pack8(m);
            } else if (col < 1664) {
                *(uint4*)(S + (size_t)tok * 256 + 64 + (col - 1600)) = pack8(m);
            } else {
#pragma unroll
                for (int j = 0; j < 8; ++j) m[j] = sigmoidf_(m[j]);
                *(uint4*)(S + (size_t)tok * 256 + 128 + (col - 1664)) = pack8(m);
            }
        } else {
            const int gi = (col - 1792) >> 7;
            const int win = 2 << gi;
            const int nw = (t + 1 < win) ? (t + 1) : win;
            float acc[8];
#pragma unroll
            for (int j = 0; j < 8; ++j) acc[j] = cur[j];
#define POOL_WIN(W) { uint4 pv[W - 1]; _Pragma("unroll") for (int s = 1; s < W; ++s) pv[s - 1] = *(const uint4*)(row - (size_t)(s < nw ? s : 0) * EVEN_IN + col); \
                      _Pragma("unroll") for (int s = 1; s < W; ++s) { float pq[8]; unpack8(pv[s - 1], pq); const float wgt = s < nw ? 1.f : 0.f; \
                          _Pragma("unroll") for (int j = 0; j < 8; ++j) acc[j] += wgt * pq[j]; } }
            if (gi == 0) POOL_WIN(2) else if (gi == 1) POOL_WIN(4) else if (gi == 2) POOL_WIN(8) else POOL_WIN(16)
#undef POOL_WIN
            const float inv = frcp((float)nw);
#pragma unroll
            for (int j = 0; j < 8; ++j) acc[j] = acc[j] * inv - cur[j];
            *(uint4*)(dpool + (size_t)tok * 512 + (col - 1792)) = pack8(acc);
        }
    }
}

DI void phase_e2b(char* lds, const Ctx& P, int li) {
    const bfr* S = (const bfr*)(P.ws + OFF_S);
    const int njobs = (li == 1) ? 20 : 16;
    for (int t = blockIdx.x; t < 128 * njobs; t += gridDim.x) {
        const int mt = t / njobs, j = t % njobs;
        const int job = j >> 2, nt = j & 3;
        const int m0 = mt * 256;
        if (job == 0) {
            RowLoader A(S, m0, 256), B((const bfr*)(P.ws + OFF_W2T) + (size_t)li * 512 * 64, nt * 128, 64);
            const float* w0 = P.in[I_W0] + li * 512;
            float* dlog = (float*)(P.ws + OFF_DLOG);
            GEMM128(lds, 1, A, B, [&](const float* stg, int) __attribute__((always_inline)) {
                epi_rows8(stg, [&](int r, int c0, const float (&v)[8]) __attribute__((always_inline)) {
                    float o[8];
#pragma unroll
                    for (int q = 0; q < 8; ++q) {
                        const float z = -(w0[nt * 128 + c0 + q] + v[q]);
                        o[q] = -fexp(-fsoftplus(z) - 0.5f);
                    }
                    float* d = dlog + (size_t)(m0 + r) * 512 + nt * 128 + c0;
                    *(float4*)d = make_float4(o[0], o[1], o[2], o[3]); *(float4*)(d + 4) = make_float4(o[4], o[5], o[6], o[7]);
                });
            });
        } else if (job == 1) {
            RowLoader A(S + 64, m0, 256), B((const bfr*)(P.ws + OFF_A2T) + (size_t)li * 512 * 64, nt * 128, 64);
            const float* a0 = P.in[I_A0] + li * 512;
            bfr* ab = (bfr*)(P.ws + OFF_ABUF);
            GEMM128(lds, 1, A, B, [&](const float* stg, int) __attribute__((always_inline)) {
                epi_rows8(stg, [&](int r, int c0, const float (&v)[8]) __attribute__((always_inline)) {
                    float o[8];
#pragma unroll
                    for (int q = 0; q < 8; ++q) o[q] = sigmoidf_(a0[nt * 128 + c0 + q] + v[q]);
                    *(uint4*)(ab + (size_t)(m0 + r) * 512 + nt * 128 + c0) = pack8(o);
                });
            });
        } else if (job == 2) {
            RowLoader A(S + 128, m0, 256), B((const bfr*)(P.ws + OFF_G2T) + (size_t)li * 512 * 128, nt * 128, 128);
            bfr* gb = (bfr*)(P.ws + OFF_GBUF);
            GEMM128(lds, 2, A, B, [&](const float* stg, int) __attribute__((always_inline)) {
                epi_rows8(stg, [&](int r, int c0, const float (&v)[8]) __attribute__((always_inline)) {
                    *(uint4*)(gb + (size_t)(m0 + r) * 512 + nt * 128 + c0) = pack8(v);
                });
            });
        } else if (job == 3) {
            RowLoader A((const bfr*)(P.ws + OFF_DPOOL) + nt * 128, m0, 512), B((const bfr*)(P.ws + OFF_POOLT) + (size_t)(li * 4 + nt) * 128 * 128, 0, 128);
            const float* ps = P.in[I_POOLS] + li * 512 + nt * 128;
            bfr* am = (bfr*)(P.ws + OFF_AMIX);
            GEMM128(lds, 2, A, B, [&](const float* stg, int) __attribute__((always_inline)) {
                epi_rows8(stg, [&](int r, int c0, const float (&v)[8]) __attribute__((always_inline)) {
                    float o[8];
#pragma unroll
                    for (int q = 0; q < 8; ++q) o[q] = v[q] * ps[c0 + q];
                    *(uint4*)(am + (size_t)(m0 + r) * 1024 + 512 + nt * 128 + c0) = pack8(o);
                });
            });
        } else {
            RowLoader A((const bfr*)(P.ws + OFF_MV2), m0, 512), B((const bfr*)(P.ws + OFF_V12T), nt * 128, 512);
            const float* v0 = P.in[I_V0];
            bfr* vg = (bfr*)(P.ws + OFF_VGATE);
            GEMM128(lds, 8, A, B, [&](const float* stg, int) __attribute__((always_inline)) {
                epi_rows8(stg, [&](int r, int c0, const float (&v)[8]) __attribute__((always_inline)) {
                    float o[8];
#pragma unroll
                    for (int q = 0; q < 8; ++q) o[q] = sigmoidf_(v0[nt * 128 + c0 + q] + v[q]);
                    *(uint4*)(vg + (size_t)(m0 + r) * 512 + nt * 128 + c0) = pack8(o);
                });
            });
        }
    }
}

constexpr int RW_TC = 32;
constexpr int RW_ROWS = 32;
constexpr int RW_BUF = (5 * RW_TC * 64 + RW_TC * RW_ROWS + RW_TC * RW_ROWS) * 4;
DI void phase_e3(char* lds, const Ctx& P, int li, int probe = 0) {
    const bfr* u = (const bfr*)(P.ws + OFF_U);
    const float* mu = P.in[I_MU] + (size_t)li * 1792;
    const float* dlog = (const float*)(P.ws + OFF_DLOG);
    const bfr* ab = (const bfr*)(P.ws + OFF_ABUF);
    const bfr* vg = (const bfr*)(P.ws + OFF_VGATE);
    const bfr* vf = (const bfr*)(P.ws + OFF_VFIRST);
    float* yout = (float*)(P.ws + (probe ? OFF_HID : OFF_Y));
    float* bonus = (float*)(P.ws + (probe ? OFF_HID : OFF_BONUS));
    const int tid = ltid(), lane = tid & 63, wave = tid >> 6;
    const int pstep = tid >> 4, pc0 = (tid & 15) * 4;
    for (int item = blockIdx.x; item < 256; item += gridDim.x) {
        const int bh = item >> 1, qtr = item & 1;
        const int b = bh >> 3, h = bh & 7;
        const int i0 = qtr * RW_ROWS;
        float c_mur[4], c_muk[4], c_muv[4], c_kk[4], c_ka[4], c_rk[4];
#pragma unroll
        for (int j = 0; j < 4; ++j) {
            const int c = h * 64 + pc0 + j;
            c_mur[j] = mu[c]; c_muk[j] = mu[512 + c]; c_muv[j] = mu[1024 + c];
            c_kk[j] = P.in[I_KK][li * 512 + c]; c_ka[j] = P.in[I_KA][li * 512 + c]; c_rk[j] = P.in[I_RK][li * 512 + c];
        }
        float S0 = 0.f, S1 = 0.f, S2 = 0.f, S3 = 0.f;
        const int rloc = wave * 4 + (lane >> 4);
        const int j0 = (lane & 15) * 4;
        const bool mine = ((pc0 >> 5) == qtr);
        uint2 g_ur, g_uk, g_uv, g_pr, g_pk, g_pv, g_a, g_vg, g_vf; float4 g_d;
#define E3_GLOAD(c_) do { const int t_ = (c_) * RW_TC + pstep; const size_t tok_ = (size_t)b * SEQ + t_; \
            const bfr* row_ = u + tok_ * EVEN_IN + h * 64 + pc0; const bfr* prow_ = row_ - (t_ > 0 ? EVEN_IN : 0); \
            g_ur = *(const uint2*)(row_); g_uk = *(const uint2*)(row_ + 512); g_uv = *(const uint2*)(row_ + 1024); \
            g_pr = *(const uint2*)(prow_); g_pk = *(const uint2*)(prow_ + 512); g_pv = *(const uint2*)(prow_ + 1024); \
            const size_t o_ = tok_ * 512 + h * 64 + pc0; \
            g_a = *(const uint2*)(ab + o_); g_d = *(const float4*)(dlog + o_); \
            if (li == 1) { g_vg = *(const uint2*)(vg + o_); g_vf = *(const uint2*)(vf + o_); } } while (0)
#define E3_PREP(c_, buf_) do { const int t_ = (c_) * RW_TC + pstep; const size_t o_ = ((size_t)b * SEQ + t_) * 512 + h * 64 + pc0; \
            float* sw_ = (float*)(lds + (buf_) * RW_BUF); float* sa_ = sw_ + RW_TC * 64; float* sb_ = sa_ + RW_TC * 64; float* sk_ = sb_ + RW_TC * 64; \
            float* sr_ = sk_ + RW_TC * 64; float* sv_ = sr_ + RW_TC * 64; \
            const float pz_ = t_ > 0 ? 1.f : 0.f; \
            const float ur_[4] = {bflo(g_ur.x), bfhi(g_ur.x), bflo(g_ur.y), bfhi(g_ur.y)}, uk_[4] = {bflo(g_uk.x), bfhi(g_uk.x), bflo(g_uk.y), bfhi(g_uk.y)}; \
            const float uv_[4] = {bflo(g_uv.x), bfhi(g_uv.x), bflo(g_uv.y), bfhi(g_uv.y)}; \
            const float pr_[4] = {bflo(g_pr.x), bfhi(g_pr.x), bflo(g_pr.y), bfhi(g_pr.y)}, pk_[4] = {bflo(g_pk.x), bfhi(g_pk.x), bflo(g_pk.y), bfhi(g_pk.y)}; \
            const float pv_[4] = {bflo(g_pv.x), bfhi(g_pv.x), bflo(g_pv.y), bfhi(g_pv.y)}; \
            const float av_[4] = {bflo(g_a.x), bfhi(g_a.x), bflo(g_a.y), bfhi(g_a.y)}; \
            const float dl_[4] = {g_d.x, g_d.y, g_d.z, g_d.w}; \
            float gv_[4] = {0.f, 0.f, 0.f, 0.f}, fv_[4] = {0.f, 0.f, 0.f, 0.f}; \
            if (li == 1) { gv_[0] = bflo(g_vg.x); gv_[1] = bfhi(g_vg.x); gv_[2] = bflo(g_vg.y); gv_[3] = bfhi(g_vg.y); \
                           fv_[0] = bflo(g_vf.x); fv_[1] = bfhi(g_vf.x); fv_[2] = bflo(g_vf.y); fv_[3] = bfhi(g_vf.y); } \
            float kkr_[4], kmod_[4], rr_[4], vv_[4]; float ssq_ = 0.f, bsum_ = 0.f; \
            _Pragma("unroll") for (int j = 0; j < 4; ++j) { \
                rr_[j] = ur_[j] + (pz_ * pr_[j] - ur_[j]) * c_mur[j]; \
                const float k_ = uk_[j] + (pz_ * pk_[j] - uk_[j]) * c_muk[j]; \
                float v_ = uv_[j] + (pz_ * pv_[j] - uv_[j]) * c_muv[j]; \
                if (li == 1) v_ = v_ + (fv_[j] - v_) * gv_[j]; \
                vv_[j] = v_; kkr_[j] = k_ * c_kk[j]; ssq_ += kkr_[j] * kkr_[j]; \
                kmod_[j] = k_ * (1.0f + (av_[j] - 1.0f) * c_ka[j]); bsum_ += rr_[j] * kmod_[j] * c_rk[j]; } \
            ssq_ = row16_sum(ssq_); bsum_ = row16_sum(bsum_); \
            const float inv_ = frcp(fmaxf(sqrtf(ssq_), 1e-12f)); \
            float4 w4_, a4_, b4_; \
            w4_.x = fexp(dl_[0]); w4_.y = fexp(dl_[1]); w4_.z = fexp(dl_[2]); w4_.w = fexp(dl_[3]); \
            a4_.x = -kkr_[0] * inv_; a4_.y = -kkr_[1] * inv_; a4_.z = -kkr_[2] * inv_; a4_.w = -kkr_[3] * inv_; \
            b4_.x = -a4_.x * av_[0]; b4_.y = -a4_.y * av_[1]; b4_.z = -a4_.z * av_[2]; b4_.w = -a4_.w * av_[3]; \
            *(float4*)(sw_ + pstep * 64 + pc0) = w4_; *(float4*)(sa_ + pstep * 64 + pc0) = a4_; *(float4*)(sb_ + pstep * 64 + pc0) = b4_; \
            *(float4*)(sk_ + pstep * 64 + pc0) = make_float4(kmod_[0], kmod_[1], kmod_[2], kmod_[3]); \
            *(float4*)(sr_ + pstep * 64 + pc0) = make_float4(rr_[0], rr_[1], rr_[2], rr_[3]); \
            if (mine) { *(float4*)(sv_ + pstep * RW_ROWS + (pc0 & 31)) = make_float4(vv_[0], vv_[1], vv_[2], vv_[3]); \
                        *(float4*)(bonus + o_) = make_float4(bsum_ * vv_[0], bsum_ * vv_[1], bsum_ * vv_[2], bsum_ * vv_[3]); } } while (0)
        __syncthreads();
        E3_GLOAD(0);
        E3_PREP(0, 0);
        __syncthreads();
        constexpr int NCH = SEQ / RW_TC;
#pragma unroll 1
        for (int c = 0; c < NCH; ++c) {
            const int buf = c & 1;
            if (c + 1 < NCH && probe != 2) E3_GLOAD(c + 1);
            if (probe != 1) {
                const float* s_w = (const float*)(lds + buf * RW_BUF); const float* s_a = s_w + RW_TC * 64; const float* s_b = s_a + RW_TC * 64;
                const float* s_k = s_b + RW_TC * 64; const float* s_r = s_k + RW_TC * 64; const float* s_v = s_r + RW_TC * 64;
                float* s_y = (float*)(s_v + RW_TC * RW_ROWS);
                float4 na4 = *(const float4*)(s_a + j0), nw4 = *(const float4*)(s_w + j0), nb4 = *(const float4*)(s_b + j0);
                float4 nk4 = *(const float4*)(s_k + j0), nr4 = *(const float4*)(s_r + j0);
                float nvi = s_v[rloc];
#pragma unroll 1
                for (int sg = 0; sg < RW_TC; sg += 4) {
                    float yv[4];
#pragma unroll
                    for (int q = 0; q < 4; ++q) {
                        const int sn = (sg + q + 1) & (RW_TC - 1);
                        const float4 a4 = na4, w4 = nw4, b4 = nb4, k4 = nk4, r4 = nr4; const float vi = nvi;
                        na4 = *(const float4*)(s_a + sn * 64 + j0); nw4 = *(const float4*)(s_w + sn * 64 + j0); nb4 = *(const float4*)(s_b + sn * 64 + j0);
                        nk4 = *(const float4*)(s_k + sn * 64 + j0); nr4 = *(const float4*)(s_r + sn * 64 + j0); nvi = s_v[sn * RW_ROWS + rloc];
                        float sa = dot4n(S0, S1, S2, S3, a4);
                        sa = row16_sum(sa);
                        rw_upd(S0, w4.x, sa, b4.x, vi, k4.x);
                        rw_upd(S1, w4.y, sa, b4.y, vi, k4.y);
                        rw_upd(S2, w4.z, sa, b4.z, vi, k4.z);
                        rw_upd(S3, w4.w, sa, b4.w, vi, k4.w);
                        const float y = dot4n(S0, S1, S2, S3, r4);
                        yv[q] = row16_sum(y);
                    }
                    const int ls = lane & 3;
                    const float yo = ls == 0 ? yv[0] : (ls == 1 ? yv[1] : (ls == 2 ? yv[2] : yv[3]));
                    if ((lane & 15) < 4) s_y[(sg + ls) * RW_ROWS + rloc] = yo;
                }
            }
            if (c + 1 < NCH && probe != 2) E3_PREP(c + 1, buf ^ 1);
            __syncthreads();
            {
                const float* s_y = (const float*)(lds + buf * RW_BUF) + 5 * RW_TC * 64 + RW_TC * RW_ROWS;
#pragma unroll
                for (int q = 0; q < RW_TC * RW_ROWS / NTHREADS; ++q) {
                    const int idx = q * NTHREADS + tid;
                    const int s = idx >> 5, r = idx & 31;
                    yout[((size_t)b * SEQ + c * RW_TC + s) * 512 + h * 64 + i0 + r] = s_y[idx];
                }
            }
        }
#undef E3_GLOAD
#undef E3_PREP
    }
}

DI void phase_e4(const Ctx& P, int li) {
    const bfr* y = (const bfr*)(P.ws + OFF_Y);
    const bfr* bonus = (const bfr*)(P.ws + OFF_BONUS);
    const bfr* gb = (const bfr*)(P.ws + OFF_GBUF);
    const float* lng = P.in[I_LNG] + li * 512;
    const float* lnb = P.in[I_LNB] + li * 512;
    bfr* am = (bfr*)(P.ws + OFF_AMIX);
    const int total = NTOK * 64;
    for (int idx = blockIdx.x * NTHREADS + ltid(); idx < total; idx += gridDim.x * NTHREADS) {
        const int tok = idx >> 6, c = (idx & 63) * 8;
        const size_t o = (size_t)tok * 512 + c;
        float v[8], bo[8], gv[8];
        unpack8(*(const uint4*)(y + o), v);
        unpack8(*(const uint4*)(bonus + o), bo);
        unpack8(*(const uint4*)(gb + o), gv);
        float s = 0.f;
#pragma unroll
        for (int j = 0; j < 8; ++j) s += v[j];
        s += __shfl_xor(s, 1); s += __shfl_xor(s, 2); s += __shfl_xor(s, 4);
        const float mean = s * (1.0f / 64.0f);
        float q = 0.f;
#pragma unroll
        for (int j = 0; j < 8; ++j) { v[j] -= mean; q += v[j] * v[j]; }
        q += __shfl_xor(q, 1); q += __shfl_xor(q, 2); q += __shfl_xor(q, 4);
        const float rstd = rsqrtf(q * (1.0f / 64.0f) + 64e-5f);
        float out[8];
#pragma unroll
        for (int j = 0; j < 8; ++j) out[j] = (v[j] * rstd * lng[c + j] + lnb[c + j] + bo[j]) * gv[j];
        *(uint4*)(am + (size_t)tok * 1024 + c) = pack8(out);
    }
}

DI void phase_wout(char* lds, const Ctx& P, const bfr* w, float* x) {
    const bfr* am = (const bfr*)(P.ws + OFF_AMIX);
    for (int t = blockIdx.x; t < 128 * 4; t += gridDim.x) {
        int mt, nt; tile_remap(t, 128, 4, mt, nt);
        RowLoader A(am, mt * 256, 1024), B(w, nt * 256, 1024);
        GEMM256(lds, 16, A, B, [&](const float* stg, int p) __attribute__((always_inline)) {
            epi_rows8_pre<F8>(stg,
                [&](int r, int c0) __attribute__((always_inline)) -> F8 {
                    const float* d = x + (size_t)(mt * 256 + r) * DM + nt * 256 + p * 128 + c0;
                    F8 o; o.a = *(const float4*)d; o.b = *(const float4*)(d + 4); return o; },
                [&](int r, int c0, const float (&v)[8], const F8& o) __attribute__((always_inline)) {
                    float* d = x + (size_t)(mt * 256 + r) * DM + nt * 256 + p * 128 + c0;
                    *(float4*)d = make_float4(o.a.x + v[0], o.a.y + v[1], o.a.z + v[2], o.a.w + v[3]);
                    *(float4*)(d + 4) = make_float4(o.b.x + v[4], o.b.y + v[5], o.b.z + v[6], o.b.w + v[7]);
                });
        });
    }
}
constexpr int RC_L = 32;
constexpr int RC_NCH = SEQ / RC_L;
constexpr int RC_RM = 72;
constexpr int RC_TR = 40;
constexpr int RC_OFF_LG  = 0;
constexpr int RC_OFF_AH  = 8192;
constexpr int RC_OFF_AHT = RC_OFF_AH + 4 * 32 * RC_RM * 2;
constexpr int RC_TRB = 64 * RC_TR * 2 + 8 * 16;
constexpr int RC_OFF_FA  = RC_OFF_AHT + 4 * RC_TRB;
constexpr int RC_OFF_MA  = RC_OFF_FA + 2 * 32 * RC_TR * 2;
constexpr int RC_OFF_W2T = RC_OFF_MA + 4 * 32 * RC_TR * 2;
constexpr int RC_OFF_GL  = RC_OFF_W2T + RC_TRB;
constexpr int RC_LDS_END = RC_OFF_GL + 256;
static_assert(RC_LDS_END <= G4_AUX, "chunk scratch must fit a 4-wave group's LDS");
constexpr size_t OFF_RCG = OFF_HID;
constexpr size_t OFF_RCH = OFF_HB;
constexpr size_t OFF_RCQ = OFF_EV_END;
constexpr size_t OFF_RCZ = OFF_RCQ + (size_t)8192 * 4096;
constexpr size_t OFF_RC_END = OFF_RCZ + (size_t)8192 * 4096;

DI int rc_tro(int c) { return c * (RC_TR * 2) + (c >> 3) * 16; }
DI bf16x8 rc_ld16(const char* p) { return *(const bf16x8*)p; }
DI bf16x8 rc_ld8x2(const char* p) {
    const uint2 a = *(const uint2*)p, b = *(const uint2*)(p + 16);
    return __builtin_bit_cast(bf16x8, make_uint4(a.x, a.y, b.x, b.y));
}
DI bf16x8 rc_pack(const f32x16& x, int s) {
    return __builtin_bit_cast(bf16x8, make_uint4(pk2(x[8 * s], x[8 * s + 1]), pk2(x[8 * s + 2], x[8 * s + 3]), pk2(x[8 * s + 4], x[8 * s + 5]), pk2(x[8 * s + 6], x[8 * s + 7])));
}
DI f32x16 rc_zero() { f32x16 z; _Pragma("unroll") for (int r = 0; r < 16; ++r) z[r] = 0.f; return z; }

DI void phase_r1(char* lds0, const Ctx& P, int li, int probe = 0) {
    const G4 G = g4_make(lds0);
    char* lds = G.lds;
    const int tid = G.tid, lane = tid & 63, wave = tid >> 6;
    const int ln = lane & 31, hf = lane >> 5;
    const bfr* u = (const bfr*)(P.ws + OFF_U);
    const float* mu = P.in[I_MU] + (size_t)li * 1792;
    const float* dlog = (const float*)(P.ws + OFF_DLOG);
    const bfr* ab = (const bfr*)(P.ws + OFF_ABUF);
    const bfr* vg = (const bfr*)(P.ws + OFF_VGATE);
    const bfr* vf = (const bfr*)(P.ws + OFF_VFIRST);
    bfr* bonus = (bfr*)(P.ws + OFF_BONUS);
    bfr* gG = (bfr*)(P.ws + OFF_RCG); bfr* gH = (bfr*)(P.ws + OFF_RCH); bfr* gQ = (bfr*)(P.ws + OFF_RCQ); bfr* gZ = (bfr*)(P.ws + OFF_RCZ);
    char* s_rm = lds + RC_OFF_AH;
    char* s_tr = lds + RC_OFF_AHT;
    char* s_im = lds + RC_OFF_FA;
    char* s_ma = lds + RC_OFF_MA;
    char* s_w2t = lds + RC_OFF_W2T;
    float* s_gl = (float*)(lds + RC_OFF_GL);
    constexpr int RMB = 32 * RC_RM * 2, TRB = RC_TRB, MAB = 32 * RC_TR * 2;
    const int ps = tid >> 3, pc0 = (tid & 7) * 8;
    float* s_cst = (float*)(lds + G4_AUX);
    float* s_tot = s_cst + 6 * 64;
    {
        const int h0 = (G.vb >> 6) & 7;
        if (tid < 64) {
            s_cst[0 * 64 + tid] = mu[h0 * 64 + tid]; s_cst[1 * 64 + tid] = mu[512 + h0 * 64 + tid]; s_cst[2 * 64 + tid] = mu[1024 + h0 * 64 + tid];
            s_cst[3 * 64 + tid] = P.in[I_KK][li * 512 + h0 * 64 + tid]; s_cst[4 * 64 + tid] = P.in[I_KA][li * 512 + h0 * 64 + tid]; s_cst[5 * 64 + tid] = P.in[I_RK][li * 512 + h0 * 64 + tid];
        }
        g4_bar(G);
    }
    uint4 g_ur, g_pr, g_uk, g_pk, g_uv, g_pv, g_a, g_vg, g_vf; float4 g_d0, g_d1;
#define RC_PREF(item_) do { const int bh_ = (item_) >> 6, c_ = (item_) & 63; const int t_ = c_ * RC_L + ps; const size_t tok_ = (size_t)(bh_ >> 3) * SEQ + t_; \
        const bfr* row_ = u + tok_ * EVEN_IN + (bh_ & 7) * 64 + pc0; const bfr* prow_ = row_ - (t_ > 0 ? EVEN_IN : 0); const size_t o_ = tok_ * 512 + (bh_ & 7) * 64 + pc0; \
        g_ur = *(const uint4*)row_; g_uk = *(const uint4*)(row_ + 512); g_uv = *(const uint4*)(row_ + 1024); \
        g_pr = *(const uint4*)prow_; g_pk = *(const uint4*)(prow_ + 512); g_pv = *(const uint4*)(prow_ + 1024); \
        g_a = *(const uint4*)(ab + o_); g_d0 = *(const float4*)(dlog + o_); g_d1 = *(const float4*)(dlog + o_ + 4); \
        if (li == 1) { g_vg = *(const uint4*)(vg + o_); g_vf = *(const uint4*)(vf + o_); } } while (0)
    if (G.vb < 128 * RC_NCH) RC_PREF(G.vb);
    for (int item = G.vb; item < 128 * RC_NCH; item += G.nvb) {
        const int bh = item >> 6, c = item & 63;
        const int b = bh >> 3, h = bh & 7;
        float lg[8], dl_[8];
        {
            float a_[8], b_[8], k_[8], r_[8], v_[8];
            const int t = c * RC_L + ps;
            const size_t tok = (size_t)b * SEQ + t;
            const float pz = t > 0 ? 1.f : 0.f;
            const size_t o512 = tok * 512 + h * 64 + pc0;
            float av[8];
            unpack8(g_a, av);
            float c8[8], m8[8], x8[8], y8[8];
#define RC_LD8(dst_, src_) { const float4 x0_ = *(const float4*)(src_), x1_ = *(const float4*)((src_) + 4); dst_[0] = x0_.x; dst_[1] = x0_.y; dst_[2] = x0_.z; dst_[3] = x0_.w; dst_[4] = x1_.x; dst_[5] = x1_.y; dst_[6] = x1_.z; dst_[7] = x1_.w; }
            unpack8(g_ur, x8); unpack8(g_pr, y8); RC_LD8(m8, s_cst + 0 * 64 + pc0)
#pragma unroll
            for (int j = 0; j < 8; ++j) r_[j] = x8[j] + (pz * y8[j] - x8[j]) * m8[j];
            unpack8(g_uk, x8); unpack8(g_pk, y8); RC_LD8(m8, s_cst + 1 * 64 + pc0)
            float kx[8], kkr[8]; float ssq = 0.f, bsum = 0.f;
            RC_LD8(c8, s_cst + 3 * 64 + pc0)
#pragma unroll
            for (int j = 0; j < 8; ++j) { kx[j] = x8[j] + (pz * y8[j] - x8[j]) * m8[j]; kkr[j] = kx[j] * c8[j]; ssq += kkr[j] * kkr[j]; }
            RC_LD8(c8, s_cst + 4 * 64 + pc0)
#pragma unroll
            for (int j = 0; j < 8; ++j) k_[j] = kx[j] * (1.0f + (av[j] - 1.0f) * c8[j]);
            RC_LD8(c8, s_cst + 5 * 64 + pc0)
#pragma unroll
            for (int j = 0; j < 8; ++j) bsum += r_[j] * k_[j] * c8[j];
            unpack8(g_uv, x8); unpack8(g_pv, y8); RC_LD8(m8, s_cst + 2 * 64 + pc0)
#pragma unroll
            for (int j = 0; j < 8; ++j) v_[j] = x8[j] + (pz * y8[j] - x8[j]) * m8[j];
            if (li == 1) {
                unpack8(g_vg, x8); unpack8(g_vf, y8);
#pragma unroll
                for (int j = 0; j < 8; ++j) v_[j] = v_[j] + (y8[j] - v_[j]) * x8[j];
            }
#undef RC_LD8
            ssq += __shfl_xor(ssq, 1); ssq += __shfl_xor(ssq, 2); ssq += __shfl_xor(ssq, 4);
            bsum += __shfl_xor(bsum, 1); bsum += __shfl_xor(bsum, 2); bsum += __shfl_xor(bsum, 4);
            const float inv = frcp(fmaxf(sqrtf(ssq), 1e-12f));
#pragma unroll
            for (int j = 0; j < 8; ++j) { const float kk = kkr[j] * inv; a_[j] = -kk; b_[j] = kk * av[j]; }
            { float bo[8];
#pragma unroll
              for (int j = 0; j < 8; ++j) bo[j] = bsum * v_[j];
              *(uint4*)(bonus + o512) = pack8(bo); }
#pragma unroll
            for (int j = 0; j < 8; ++j) *(bfr*)(s_tr + 3 * TRB + rc_tro(pc0 + j) + ps * 2) = f2bf(v_[j]);
            dl_[0] = g_d0.x; dl_[1] = g_d0.y; dl_[2] = g_d0.z; dl_[3] = g_d0.w; dl_[4] = g_d1.x; dl_[5] = g_d1.y; dl_[6] = g_d1.z; dl_[7] = g_d1.w;
#pragma unroll
            for (int j = 0; j < 8; ++j) lg[j] = dl_[j];
#pragma unroll
            for (int d = 8; d < 64; d <<= 1) {
#pragma unroll
                for (int j = 0; j < 8; ++j) { const float o = __shfl_up(lg[j], d); lg[j] += (lane >= d) ? o : 0.f; }
            }
            *(uint4*)(s_rm + 0 * RMB + (ps * RC_RM + pc0) * 2) = pack8(a_);
            *(uint4*)(s_rm + 1 * RMB + (ps * RC_RM + pc0) * 2) = pack8(b_);
            *(uint4*)(s_rm + 2 * RMB + (ps * RC_RM + pc0) * 2) = pack8(k_);
            *(uint4*)(s_rm + 3 * RMB + (ps * RC_RM + pc0) * 2) = pack8(r_);
            if ((lane >> 3) == 7) { *(float4*)(s_tot + wave * 64 + pc0) = make_float4(lg[0], lg[1], lg[2], lg[3]); *(float4*)(s_tot + wave * 64 + pc0 + 4) = make_float4(lg[4], lg[5], lg[6], lg[7]); }
        }
        g4_bar(G);
        {
#pragma unroll
            for (int w2 = 0; w2 < 3; ++w2) {
                if (w2 < wave) {
                    const float4 e0 = *(const float4*)(s_tot + w2 * 64 + pc0), e1 = *(const float4*)(s_tot + w2 * 64 + pc0 + 4);
                    lg[0] += e0.x; lg[1] += e0.y; lg[2] += e0.z; lg[3] += e0.w; lg[4] += e1.x; lg[5] += e1.y; lg[6] += e1.z; lg[7] += e1.w;
                }
            }
            float ah[8], bhh[8], kh[8], rh[8];
            unpack8(*(const uint4*)(s_rm + 0 * RMB + (ps * RC_RM + pc0) * 2), ah);
            unpack8(*(const uint4*)(s_rm + 1 * RMB + (ps * RC_RM + pc0) * 2), bhh);
            unpack8(*(const uint4*)(s_rm + 2 * RMB + (ps * RC_RM + pc0) * 2), kh);
            unpack8(*(const uint4*)(s_rm + 3 * RMB + (ps * RC_RM + pc0) * 2), rh);
#pragma unroll
            for (int j = 0; j < 8; ++j) {
                const float ep = fexp(lg[j]), em = fexp(-lg[j]), ep1 = fexp(lg[j] - dl_[j]);
                ah[j] *= ep1; bhh[j] *= em; kh[j] *= em; rh[j] *= ep;
                if (ps == RC_L - 1) s_gl[pc0 + j] = ep;
            }
            *(uint4*)(s_rm + 0 * RMB + (ps * RC_RM + pc0) * 2) = pack8(ah);
            *(uint4*)(s_rm + 1 * RMB + (ps * RC_RM + pc0) * 2) = pack8(bhh);
            *(uint4*)(s_rm + 2 * RMB + (ps * RC_RM + pc0) * 2) = pack8(kh);
            *(uint4*)(s_rm + 3 * RMB + (ps * RC_RM + pc0) * 2) = pack8(rh);
#pragma unroll
            for (int j = 0; j < 8; ++j) {
                *(bfr*)(s_tr + 0 * TRB + rc_tro(pc0 + j) + ps * 2) = f2bf(ah[j]);
                *(bfr*)(s_tr + 1 * TRB + rc_tro(pc0 + j) + ps * 2) = f2bf(bhh[j]);
                *(bfr*)(s_tr + 2 * TRB + rc_tro(pc0 + j) + ps * 2) = f2bf(kh[j]);
            }
        }
        if (item + G.nvb < 128 * RC_NCH) RC_PREF(item + G.nvb);
        g4_bar(G);
        if (probe < 3) {
            const char* xa = s_rm + (wave < 2 ? 0 : 3) * RMB;
            const char* xb = s_rm + ((wave & 1) ? 2 : 1) * RMB;
            f32x16 acc = rc_zero();
#pragma unroll
            for (int ks = 0; ks < 4; ++ks)
                acc = MFMA32(rc_ld16(xa + (ln * RC_RM + ks * 16 + hf * 8) * 2), rc_ld16(xb + (ln * RC_RM + ks * 16 + hf * 8) * 2), acc);
#pragma unroll
            for (int r = 0; r < 16; ++r) {
                const int t = (r & 3) + 8 * (r >> 2) + 4 * hf;
                const bool keep = (wave < 2) ? (ln < t) : (ln <= t);
                acc[r] = keep ? acc[r] : 0.f;
                if (wave != 0) *(bfr*)(s_ma + (wave - 1) * MAB + (t * RC_TR + ln) * 2) = f2bf(acc[r]);
            }
            if (wave == 0 && probe < 2) {
                f32x16 Ap = acc, Pa = acc;
#pragma unroll
                for (int r = 0; r < 16; ++r) { const int t = (r & 3) + 8 * (r >> 2) + 4 * hf; Pa[r] += (t == ln) ? 1.f : 0.f; }
                char* imA = s_im; char* imH = s_im + MAB;
#pragma unroll 1
                for (int it = 0; it < 4; ++it) {
#pragma unroll
                    for (int r = 0; r < 16; ++r) {
                        const int t = (r & 3) + 8 * (r >> 2) + 4 * hf;
                        *(bfr*)(imA + (t * RC_TR + ln) * 2) = f2bf(Ap[r]);
                        *(bfr*)(imH + (t * RC_TR + ln) * 2) = f2bf(Pa[r]);
                    }
                    const bf16x8 a0 = rc_pack(Ap, 0), a1 = rc_pack(Ap, 1);
                    const int ro = (ln * RC_TR + 4 * hf) * 2;
                    f32x16 An = rc_zero();
                    An = MFMA32(rc_ld8x2(imA + ro), a0, An);
                    An = MFMA32(rc_ld8x2(imA + ro + 32), a1, An);
                    Ap = An;
                    const bf16x8 b0 = rc_pack(Ap, 0), b1 = rc_pack(Ap, 1);
                    Pa = MFMA32(rc_ld8x2(imH + ro), b0, Pa); Pa = MFMA32(rc_ld8x2(imH + ro + 32), b1, Pa);
                }
#pragma unroll
                for (int r = 0; r < 16; ++r) { const int t = (r & 3) + 8 * (r >> 2) + 4 * hf; *(bfr*)(s_ma + 3 * MAB + (t * RC_TR + ln) * 2) = f2bf(Pa[r]); }
            } else if (wave == 1) {
#pragma unroll
                for (int it = 0; it < 2; ++it) {
                    f32x16 w2 = rc_zero();
#pragma unroll
                    for (int ks = 0; ks < 2; ++ks)
                        w2 = MFMA32(rc_ld16(s_ma + 0 * MAB + (ln * RC_TR + ks * 16 + hf * 8) * 2), rc_ld16(s_tr + 3 * TRB + rc_tro(it * 32 + ln) + (ks * 16 + hf * 8) * 2), w2);
#pragma unroll
                    for (int q = 0; q < 4; ++q)
                        *(uint2*)(s_w2t + rc_tro(it * 32 + ln) + (8 * q + 4 * hf) * 2) = make_uint2(pk2(w2[4 * q], w2[4 * q + 1]), pk2(w2[4 * q + 2], w2[4 * q + 3]));
                }
            }
        }
        g4_bar(G);
        if (probe < 1) {
            const int hp = wave & 1;
            const size_t chunk = (size_t)bh * RC_NCH + c;
            const char* tm = s_ma + 3 * MAB;
            const char* bsrc = (wave < 2) ? (s_tr + 0 * TRB) : s_w2t;
            f32x16 X = rc_zero();
#pragma unroll
            for (int ks = 0; ks < 2; ++ks)
                X = MFMA32(rc_ld16(tm + (ln * RC_TR + ks * 16 + hf * 8) * 2), rc_ld16(bsrc + rc_tro(hp * 32 + ln) + (ks * 16 + hf * 8) * 2), X);
            const bf16x8 xf0 = rc_pack(X, 0), xf1 = rc_pack(X, 1);
            const char* arb = s_ma + 1 * MAB; const char* ark = s_ma + 2 * MAB;
            if (wave < 2) {
#pragma unroll
                for (int jt = 0; jt < 2; ++jt) {
                    f32x16 acc = rc_zero();
                    const char* bp = s_tr + 1 * TRB + rc_tro(jt * 32 + ln) + 8 * hf;
                    acc = MFMA32(xf0, rc_ld8x2(bp), acc);
                    acc = MFMA32(xf1, rc_ld8x2(bp + 32), acc);
                    const int j = jt * 32 + ln;
                    const float gl = s_gl[j];
                    bfr* dst = gG + chunk * 4096 + (size_t)j * 64 + hp * 32 + 4 * hf;
#pragma unroll
                    for (int q = 0; q < 4; ++q) {
                        float o[4];
#pragma unroll
                        for (int e = 0; e < 4; ++e) { const int jp = hp * 32 + 8 * q + 4 * hf + e; o[e] = gl * (acc[4 * q + e] + (jp == j ? 1.f : 0.f)); }
                        *(uint2*)(dst + 8 * q) = make_uint2(pk2(o[0], o[1]), pk2(o[2], o[3]));
                    }
                }
                {
                    f32x16 acc = rc_zero();
                    const char* bp = arb + (ln * RC_TR + 4 * hf) * 2;
                    acc = MFMA32(xf0, rc_ld8x2(bp), acc);
                    acc = MFMA32(xf1, rc_ld8x2(bp + 32), acc);
                    bfr* dst = gQ + chunk * 2048 + (size_t)ln * 64 + hp * 32 + 4 * hf;
                    const char* rsrc = s_rm + 3 * RMB + (ln * RC_RM + hp * 32 + 4 * hf) * 2;
#pragma unroll
                    for (int q = 0; q < 4; ++q) {
                        const uint2 rr = *(const uint2*)(rsrc + 16 * q);
                        *(uint2*)(dst + 8 * q) = make_uint2(pk2(acc[4 * q] + bflo(rr.x), acc[4 * q + 1] + bfhi(rr.x)), pk2(acc[4 * q + 2] + bflo(rr.y), acc[4 * q + 3] + bfhi(rr.y)));
                    }
                }
            } else {
#pragma unroll
                for (int jt = 0; jt < 2; ++jt) {
                    f32x16 acc = rc_zero();
                    const char* ap = s_tr + 1 * TRB + rc_tro(jt * 32 + ln) + 8 * hf;
                    acc = MFMA32(rc_ld8x2(ap), xf0, acc);
                    acc = MFMA32(rc_ld8x2(ap + 32), xf1, acc);
#pragma unroll
                    for (int ks = 0; ks < 2; ++ks)
                        acc = MFMA32(rc_ld16(s_tr + 2 * TRB + rc_tro(jt * 32 + ln) + (ks * 16 + hf * 8) * 2), rc_ld16(s_tr + 3 * TRB + rc_tro(hp * 32 + ln) + (ks * 16 + hf * 8) * 2), acc);
                    bfr* dst = gH + chunk * 4096 + (size_t)(hp * 32 + ln) * 64 + jt * 32 + 4 * hf;
#pragma unroll
                    for (int q = 0; q < 4; ++q) {
                        const float4 gl = *(const float4*)(s_gl + jt * 32 + 8 * q + 4 * hf);
                        *(uint2*)(dst + 8 * q) = make_uint2(pk2(gl.x * acc[4 * q], gl.y * acc[4 * q + 1]), pk2(gl.z * acc[4 * q + 2], gl.w * acc[4 * q + 3]));
                    }
                }
                {
                    f32x16 acc = rc_zero();
                    const char* bp = arb + (ln * RC_TR + 4 * hf) * 2;
                    acc = MFMA32(xf0, rc_ld8x2(bp), acc);
                    acc = MFMA32(xf1, rc_ld8x2(bp + 32), acc);
#pragma unroll
                    for (int ks = 0; ks < 2; ++ks)
                        acc = MFMA32(rc_ld16(s_tr + 3 * TRB + rc_tro(hp * 32 + ln) + (ks * 16 + hf * 8) * 2), rc_ld16(ark + (ln * RC_TR + ks * 16 + hf * 8) * 2), acc);
                    bfr* dst = gZ + chunk * 2048 + (size_t)ln * 64 + hp * 32 + 4 * hf;
#pragma unroll
                    for (int q = 0; q < 4; ++q) *(uint2*)(dst + 8 * q) = make_uint2(pk2(acc[4 * q], acc[4 * q + 1]), pk2(acc[4 * q + 2], acc[4 * q + 3]));
                }
            }
        }
        g4_bar(G);
    }
}

DI bf16x8 rc_join(uint2 a, uint2 b) { return __builtin_bit_cast(bf16x8, make_uint4(a.x, a.y, b.x, b.y)); }
struct RcG { uint2 g[16]; };
DI void rc_load_g(RcG& f, const bfr* Gc, int ln, int hf) {
#pragma unroll
    for (int x = 0; x < 4; ++x) {
        const int o = (x >> 1) * 32 + (x & 1) * 16 + 4 * hf;
        f.g[4 * x] = *(const uint2*)(Gc + (size_t)ln * 64 + o);            f.g[4 * x + 1] = *(const uint2*)(Gc + (size_t)ln * 64 + o + 8);
        f.g[4 * x + 2] = *(const uint2*)(Gc + (size_t)(32 + ln) * 64 + o); f.g[4 * x + 3] = *(const uint2*)(Gc + (size_t)(32 + ln) * 64 + o + 8);
    }
}
DI void phase_r2(const Ctx& P) {
    const int tid = ltid(), lane = tid & 63, wave = tid >> 6;
    const int ln = lane & 31, hf = lane >> 5;
    const bfr* gG = (const bfr*)(P.ws + OFF_RCG); const bfr* gH = (const bfr*)(P.ws + OFF_RCH); const bfr* gQ = (const bfr*)(P.ws + OFF_RCQ); const bfr* gZ = (const bfr*)(P.ws + OFF_RCZ);
    bfr* yout = (bfr*)(P.ws + OFF_Y);
    if (wave != 0) return;
#define RC_LOAD_ALL(GV, QV, HV, ZV, ch_) do { const bfr* Hc_ = gH + (ch_) * 4096; const bfr* Qc_ = gQ + (ch_) * 2048; const bfr* Zc_ = gZ + (ch_) * 2048; \
        rc_load_g(GV, gG + (ch_) * 4096, ln, hf); \
        _Pragma("unroll") for (int x = 0; x < 4; ++x) { const int o_ = (x >> 1) * 32 + (x & 1) * 16 + 4 * hf; \
            QV[2 * x] = *(const uint2*)(Qc_ + (size_t)ln * 64 + o_); QV[2 * x + 1] = *(const uint2*)(Qc_ + (size_t)ln * 64 + o_ + 8); } \
        _Pragma("unroll") for (int q = 0; q < 4; ++q) { ZV[q] = *(const uint2*)(Zc_ + (size_t)ln * 64 + ic * 32 + 4 * hf + 8 * q); \
            HV[q] = *(const uint2*)(Hc_ + (size_t)(ic * 32 + ln) * 64 + 4 * hf + 8 * q); HV[4 + q] = *(const uint2*)(Hc_ + (size_t)(ic * 32 + ln) * 64 + 32 + 4 * hf + 8 * q); } } while (0)
#define RC_STEP(GV, QV, HV, ZV, c_) do { \
        bf16x8 mh[2][2]; \
        _Pragma("unroll") for (int ks = 0; ks < 2; ++ks) { mh[0][ks] = rc_pack(M0, ks); mh[1][ks] = rc_pack(M1, ks); } \
        f32x16 n0 = rc_zero(), n1 = rc_zero(), ya = rc_zero(); \
        _Pragma("unroll") for (int x = 0; x < 4; ++x) { \
            const bf16x8 g0 = rc_join(GV.g[4 * x], GV.g[4 * x + 1]), g1 = rc_join(GV.g[4 * x + 2], GV.g[4 * x + 3]); \
            n0 = MFMA32(g0, mh[x >> 1][x & 1], n0); n1 = MFMA32(g1, mh[x >> 1][x & 1], n1); \
            ya = MFMA32(mh[x >> 1][x & 1], rc_join(QV[2 * x], QV[2 * x + 1]), ya); } \
        bfr* yp = yout + ((size_t)b * SEQ + (c_) * RC_L + ln) * 512 + h * 64 + ic * 32 + 4 * hf; \
        _Pragma("unroll") for (int q = 0; q < 4; ++q) { const uint2 zz = ZV[q]; \
            *(uint2*)(yp + 8 * q) = make_uint2(pk2(ya[4 * q] + bflo(zz.x), ya[4 * q + 1] + bfhi(zz.x)), pk2(ya[4 * q + 2] + bflo(zz.y), ya[4 * q + 3] + bfhi(zz.y))); } \
        _Pragma("unroll") for (int q = 0; q < 4; ++q) { const uint2 h0 = HV[q], h1 = HV[4 + q]; \
            M0[4 * q] = n0[4 * q] + bflo(h0.x); M0[4 * q + 1] = n0[4 * q + 1] + bfhi(h0.x); M0[4 * q + 2] = n0[4 * q + 2] + bflo(h0.y); M0[4 * q + 3] = n0[4 * q + 3] + bfhi(h0.y); \
            M1[4 * q] = n1[4 * q] + bflo(h1.x); M1[4 * q + 1] = n1[4 * q + 1] + bfhi(h1.x); M1[4 * q + 2] = n1[4 * q + 2] + bflo(h1.y); M1[4 * q + 3] = n1[4 * q + 3] + bfhi(h1.y); } } while (0)
    for (int item = blockIdx.x; item < 256; item += gridDim.x) {
        const int bh = item >> 1, ic = item & 1;
        const int b = bh >> 3, h = bh & 7;
        f32x16 M0 = rc_zero(), M1 = rc_zero();
        const size_t ch0 = (size_t)bh * RC_NCH;
        RcG gA, gB; uint2 qA[8], hA[8], zA[4], qB[8], hB[8], zB[4];
        RC_LOAD_ALL(gA, qA, hA, zA, ch0);
#pragma unroll 1
        for (int c = 0; c < RC_NCH; c += 2) {
            RC_LOAD_ALL(gB, qB, hB, zB, ch0 + c + 1);
            RC_STEP(gA, qA, hA, zA, c);
            RC_LOAD_ALL(gA, qA, hA, zA, ch0 + (c + 2 < RC_NCH ? c + 2 : c));
            RC_STEP(gB, qB, hB, zB, c + 1);
        }
    }
#undef RC_LOAD_ALL
#undef RC_STEP
}
DI void phase_o1(char* lds, const Ctx& P, int li) {
    const bfr* hb = (const bfr*)(P.ws + OFF_HB);
    const bfr* w = (const bfr*)(P.ws + OFF_WINO) + (size_t)li * 2048 * 1024;
    bfr* qk = (bfr*)(P.ws + OFF_U);
    bfr* vT = (bfr*)(P.ws + OFF_VT);
    bfr* us5 = (bfr*)(P.ws + OFF_US5);
    for (int t = blockIdx.x; t < 128 * 8; t += gridDim.x) {
        int mt, nt; tile_remap(t, 128, 8, mt, nt);
        const int m0 = mt * 256;
        RowLoader A(hb, m0, 1024), B(w, nt * 256, 1024);
        GEMM256(lds, 16, A, B, [&](const float* stg, int p) __attribute__((always_inline)) {
            if (nt < 4) {
                epi_rows8(stg, [&](int r, int c0, const float (&v)[8]) __attribute__((always_inline)) {
                    *(uint4*)(qk + (size_t)(m0 + r) * 1024 + nt * 256 + p * 128 + c0) = pack8(v);
                });
            } else if (nt < 6) {
                const int b = m0 >> 11, tq = m0 & (SEQ - 1);
                bfr* dst = vT + ((size_t)(b * 4 + (nt - 4) * 2 + p) * 128) * SEQ + tq;
                const int tid0 = ltid();
#pragma unroll
                for (int it = 0; it < 8; ++it) {
                    const int idx = it * NTHREADS + tid0;
                    const int dv = idx & 127, rg = idx >> 7;
                    float v[8];
#pragma unroll
                    for (int j = 0; j < 8; ++j) v[j] = stg[(rg * 8 + j) * STG_LD + dv];
                    *(uint4*)(dst + (size_t)dv * SEQ + rg * 8) = pack8(v);
                }
            } else {
                epi_rows8(stg, [&](int r, int c0, const float (&v)[8]) __attribute__((always_inline)) {
                    const int cc = (nt - 6) * 256 + p * 128 + c0;
                    *(uint4*)(us5 + ((size_t)(cc >> 4) * NTOK + m0 + r) * 16 + (cc & 15)) = pack8(v);
                });
            }
        });
    }
}

DI void phase_o2(char* lds, const Ctx& P, int li) {
    const bfr* qk = (const bfr*)(P.ws + OFF_U);
    bfr* qn = (bfr*)(P.ws + OFF_QN);
    bfr* kn = (bfr*)(P.ws + OFF_KN);
    const float* gq = P.in[I_QN] + li * 64;
    const float* gk = P.in[I_KN] + li * 64;
    const bfr* us5 = (const bfr*)(P.ws + OFF_US5);
    const bfr* bl = (const bfr*)(P.ws + OFF_S5BL) + (size_t)li * 32 * 128 * 512;
    float* xloc = (float*)(P.ws + OFF_XLOC);
    for (int t = blockIdx.x; t < 128; t += gridDim.x) {
        const int g = t >> 2, mt = t & 3;
        RowLoader A(us5 + (size_t)g * NTOK * 16, mt * 256, 512), B(bl + (size_t)g * 128 * 512, 0, 512);
        GEMM128(lds, 8, A, B, [&](const float* stg, int) __attribute__((always_inline)) {
            epi_rows8(stg, [&](int r, int c0, const float (&v)[8]) __attribute__((always_inline)) {
                float* d = xloc + ((size_t)g * 1024 + mt * 256 + r) * 128 + c0;
                *(float4*)d = make_float4(v[0], v[1], v[2], v[3]); *(float4*)(d + 4) = make_float4(v[4], v[5], v[6], v[7]);
            });
        });
    }
    const int total = NTOK * 16 * 8;
    for (int idx = blockIdx.x * NTHREADS + ltid(); idx < total; idx += gridDim.x * NTHREADS) {
        const int l8 = idx & 7, item = idx >> 3;
        const int hm = item & 7, which = (item >> 3) & 1, tok = item >> 4;
        const int d0 = l8 * 4;
        const bfr* src = qk + (size_t)tok * 1024 + which * 512 + hm * 64;
        const uint2 ua = *(const uint2*)(src + d0), ub = *(const uint2*)(src + 32 + d0);
        float x1[4] = {bflo(ua.x), bfhi(ua.x), bflo(ua.y), bfhi(ua.y)};
        float x2[4] = {bflo(ub.x), bfhi(ub.x), bflo(ub.y), bfhi(ub.y)};
        float ss = 0.f;
#pragma unroll
        for (int j = 0; j < 4; ++j) ss += x1[j] * x1[j] + x2[j] * x2[j];
        ss += __shfl_xor(ss, 1); ss += __shfl_xor(ss, 2); ss += __shfl_xor(ss, 4);
        const float rs = rsqrtf(ss * (1.0f / 64.0f) + 1e-6f);
        const float* gg = which ? gk : gq;
        const float scl = which ? 1.0f : (0.125f * 1.4426950408889634f);
        const int t = tok & (SEQ - 1);
        float o1[4], o2[4];
#pragma unroll
        for (int j = 0; j < 4; ++j) {
            const int i = d0 + j;
            const float invf = exp2f(-(float)i * (13.287712379549449f / 32.0f));
            const float ang = (float)t * invf;
            float sn, cs;
            sincosf(ang, &sn, &cs);
            const float a = x1[j] * rs * gg[i], b2 = x2[j] * rs * gg[32 + i];
            o1[j] = (a * cs - b2 * sn) * scl;
            o2[j] = (b2 * cs + a * sn) * scl;
        }
        bfr* dst = (which ? kn : qn) + (size_t)tok * 512 + hm * 64;
        *(uint2*)(dst + d0) = make_uint2(pk2(o1[0], o1[1]), pk2(o1[2], o1[3]));
        *(uint2*)(dst + 32 + d0) = make_uint2(pk2(o2[0], o2[1]), pk2(o2[2], o2[3]));
    }
}

DI void s5_scan(const Ctx& P, int li) {
    const float* xloc = (const float*)(P.ws + OFF_XLOC);
    bfr* xin = (bfr*)(P.ws + OFF_XIN);
    const float* l32 = (const float*)(P.ws + OFF_S5L32) + (size_t)li * 32 * 128;
    for (int idx = blockIdx.x * NTHREADS + ltid(); idx < 32 * 16 * 64; idx += gridDim.x * NTHREADS) {
        const int p = idx & 63, b = (idx >> 6) & 15, g = idx >> 10;
        const float lr = l32[g * 128 + 2 * p], lim = l32[g * 128 + 2 * p + 1];
        float xr = 0.f, xi = 0.f;
        for (int ch = 0; ch < 64; ++ch) {
            const size_t o = ((size_t)g * 1024 + b * 64 + ch) * 128 + 2 * p;
            *(unsigned*)(xin + o) = pk2(xr, xi);
            const float2 a = *(const float2*)(xloc + o);
            const float nr = lr * xr - lim * xi + a.x, ni = lr * xi + lim * xr + a.y;
            xr = nr; xi = ni;
        }
    }
}

DI void attn_item(char* lds, const Ctx& P, int b, int h, int qt, float lam, float lam_init, const float* subln) {
    const bfr* qn = (const bfr*)(P.ws + OFF_QN);
    const bfr* kn = (const bfr*)(P.ws + OFF_KN);
    const bfr* vT = (const bfr*)(P.ws + OFF_VT) + (size_t)(b * 4 + h) * 128 * SEQ;
    bfr* am = (bfr*)(P.ws + OFF_AMIX);
    const int tid = ltid(), lane = tid & 63, wave = tid >> 6;
    const int m = wave >> 2, qw = (wave & 3) * 32;
    const int q0 = qt * 128 + qw;
    const int ln = lane & 31, hf = lane >> 5;
    bf16x8 qf[4];
    {
        const bfr* qp = qn + ((size_t)b * SEQ + q0 + ln) * 512 + h * 128 + m * 64 + hf * 8;
#pragma unroll
        for (int ks = 0; ks < 4; ++ks) qf[ks] = *(const bf16x8*)(qp + ks * 16);
    }
    f32x16 o[4];
#pragma unroll
    for (int d = 0; d < 4; ++d)
#pragma unroll
        for (int r = 0; r < 16; ++r) o[d][r] = 0.f;
    float mrun = -INFINITY, lrun = 0.f;
    const int nkt = 2 * (qt + 1);
    const int lrow = tid >> 3, lcol = (tid & 7) * 8;
    const bfr* kbase = kn + ((size_t)b * SEQ) * 512 + h * 128;
    unsigned ko = (unsigned)(lrow * 512 + lcol) * 2u, vo = (unsigned)(lrow * SEQ + lcol) * 2u;
    asm volatile("" : "+v"(ko), "+v"(vo));
    uint4 rk0, rk1, rv0, rv1;
#define ATT_GLOAD(kt_) do { const char* kp_ = (const char*)(kbase + (size_t)(kt_) * (64 * 512)); const char* vp_ = (const char*)(vT + (kt_) * 64); \
        rk0 = *(const uint4*)(kp_ + ko); rk1 = *(const uint4*)(kp_ + 64 * 2 + ko); \
        rv0 = *(const uint4*)(vp_ + vo); rv1 = *(const uint4*)(vp_ + 64 * SEQ * 2 + vo); } while (0)
#define ATT_S1(base_, i_, RK, RV) { *(uint4*)((base_) + (64 * (i_)) * LDA * 2) = RK; \
        *(uint4*)((base_) + TILE_B + (64 * (i_)) * LDA * 2) = RV; }
#define ATT_LSTORE(buf_) do { char* base_ = lds + (buf_) * (2 * TILE_B) + s_off; ATT_S1(base_, 0, rk0, rv0) ATT_S1(base_, 1, rk1, rv1) } while (0)
    int k_off = ((m * 64 + ln) * LDA + hf * 8) * 2;
    int v_off = TILE_B + (ln * LDA + 4 * hf) * 2;
    int s_off = (lrow * LDA + lcol) * 2;
    asm volatile("" : "+v"(k_off), "+v"(v_off), "+v"(s_off));
    ATT_GLOAD(0); ATT_LSTORE(0);
    __syncthreads();
    int buf = 0;
#pragma unroll 1
    for (int kt = 0; kt < nkt; ++kt) {
        const bool more = (kt + 1 < nkt);
        const char* ks_ = lds + buf * (2 * TILE_B) + k_off;
        const char* vs_ = lds + buf * (2 * TILE_B) + v_off;
        if (kt * 64 <= q0 + 31) {
            f32x16 s[2];
#pragma unroll
            for (int kb = 0; kb < 2; ++kb) {
#pragma unroll
                for (int r = 0; r < 16; ++r) s[kb][r] = 0.f;
#pragma unroll
                for (int ks = 0; ks < 4; ++ks) {
                    const bf16x8 kf = *(const bf16x8*)(ks_ + ((kb * 32) * LDA + ks * 16) * 2);
                    s[kb] = MFMA32(kf, qf[ks], s[kb]);
                }
            }
            const int qpos = q0 + ln;
            if (kt * 64 + 63 > q0) {
#pragma unroll
                for (int kb = 0; kb < 2; ++kb)
#pragma unroll
                    for (int r = 0; r < 16; ++r) {
                        const int key = kt * 64 + kb * 32 + (r & 3) + 8 * (r >> 2) + 4 * hf;
                        if (key > qpos) s[kb][r] = -INFINITY;
                    }
            }
            float mx = s[0][0];
#pragma unroll
            for (int kb = 0; kb < 2; ++kb)
#pragma unroll
                for (int r = 0; r < 16; ++r) mx = fmaxf(mx, s[kb][r]);
            mx = fmaxf(mx, __shfl_xor(mx, 32));
            const float mnew = fmaxf(mrun, mx);
            const float alpha = __builtin_amdgcn_exp2f(mrun - mnew);
            mrun = mnew;
            float rsum = 0.f;
#pragma unroll
            for (int kb = 0; kb < 2; ++kb)
#pragma unroll
                for (int r = 0; r < 16; ++r) { const float p = __builtin_amdgcn_exp2f(s[kb][r] - mnew); s[kb][r] = p; rsum += p; }
            lrun = lrun * alpha + rsum;
#pragma unroll
            for (int d = 0; d < 4; ++d)
#pragma unroll
                for (int r = 0; r < 16; ++r) o[d][r] *= alpha;
            __builtin_amdgcn_sched_barrier(0);
            if (more) ATT_GLOAD(kt + 1);
#pragma unroll
            for (int kb = 0; kb < 2; ++kb)
#pragma unroll
                for (int st = 0; st < 2; ++st) {
                    const uint4 pp = make_uint4(pk2(s[kb][8 * st + 0], s[kb][8 * st + 1]), pk2(s[kb][8 * st + 2], s[kb][8 * st + 3]),
                                                pk2(s[kb][8 * st + 4], s[kb][8 * st + 5]), pk2(s[kb][8 * st + 6], s[kb][8 * st + 7]));
                    const bf16x8 pf = __builtin_bit_cast(bf16x8, pp);
                    const int kc = kb * 32 + 16 * st;
#pragma unroll
                    for (int d = 0; d < 4; ++d) {
                        const uint2 v0 = *(const uint2*)(vs_ + ((d * 32) * LDA + kc) * 2);
                        const uint2 v1 = *(const uint2*)(vs_ + ((d * 32) * LDA + kc + 8) * 2);
                        const bf16x8 vf = __builtin_bit_cast(bf16x8, make_uint4(v0.x, v0.y, v1.x, v1.y));
                        o[d] = MFMA32(vf, pf, o[d]);
                    }
                }
        }
        else if (more) ATT_GLOAD(kt + 1);
        if (more) ATT_LSTORE(buf ^ 1);
        __syncthreads();
        buf ^= 1;
    }
    const float ltot = lrun + __shfl_xor(lrun, 32);
    const float linv = 1.0f / ltot;
    float* ob = (float*)lds;
    int o_off = (m * 128 + qw + ln) * 129 + 4 * hf;
    asm volatile("" : "+v"(o_off));
#pragma unroll
    for (int d = 0; d < 4; ++d)
#pragma unroll
        for (int r = 0; r < 16; ++r) ob[o_off + d * 32 + (r & 3) + 8 * (r >> 2)] = o[d][r] * linv;
    __syncthreads();
#pragma unroll
    for (int it = 0; it < 4; ++it) {
        const int idx = it * NTHREADS + tid;
        const int q = idx >> 4, c0 = (idx & 15) * 8;
        float v[8];
        float ss = 0.f;
        int r_off = q * 129 + c0;
        asm volatile("" : "+v"(r_off));
#pragma unroll
        for (int j = 0; j < 8; ++j) { v[j] = ob[r_off + j] - lam * ob[r_off + 128 * 129 + j]; ss += v[j] * v[j]; }
        ss = row16_sum(ss);
        const float rs = rsqrtf(ss * (1.0f / 128.0f) + 1e-5f) * (1.0f - lam_init);
#pragma unroll
        for (int j = 0; j < 8; ++j) v[j] = v[j] * rs * subln[c0 + j];
        *(uint4*)(am + ((size_t)b * SEQ + qt * 128 + q) * 1024 + h * 128 + c0) = pack8(v);
    }
    __syncthreads();
}

DI void phase_o3(char* lds, const Ctx& P, int li, int layer) {
    s5_scan(P, li);
    float lam;
    {
        const int j = ltid() & 63;
        const float s1 = wave_sum(P.in[I_LQ1][li * 64 + j] * P.in[I_LK1][li * 64 + j]);
        const float s2 = wave_sum(P.in[I_LQ2][li * 64 + j] * P.in[I_LK2][li * 64 + j]);
        const float lam_init0 = 0.8f - 0.6f * __expf(-0.3f * (float)layer);
        lam = __expf(s1) - __expf(s2) + lam_init0;
    }
    const float lam_init = 0.8f - 0.6f * __expf(-0.3f * (float)layer);
    const float* subln = P.in[I_SUBLN] + li * 128;
    for (int item = blockIdx.x; item < 512; item += gridDim.x) {
        const int bh = item >> 3, pr = item & 7;
        for (int half = 0; half < 2; ++half) attn_item(lds, P, bh >> 2, bh & 3, half ? 15 - pr : pr, lam, lam_init, subln);
    }
}

DI void phase_o4(char* lds, const Ctx& P, int li) {
    const bfr* us5 = (const bfr*)(P.ws + OFF_US5);
    const bfr* xin = (const bfr*)(P.ws + OFF_XIN);
    const bfr* gt = (const bfr*)(P.ws + OFF_S5GT) + (size_t)li * 32 * 512 * 640;
    const float* dsk = P.in[I_S5D] + li * 512;
    bfr* zb = (bfr*)(P.ws + OFF_ZBUF);
    for (int t = blockIdx.x; t < 512; t += gridDim.x) {
        const int g = t >> 4, mt = (t >> 2) & 3, nt = t & 3;
        const int nloc = 2 * (nt + 1);
        const bfr* ag = us5 + (size_t)g * NTOK * 16;
        const bfr* xg = xin + (size_t)g * 1024 * 128;
        const int tq = ltid();
        const int arow = mt * 256 + (tq >> 3), acol = gt_lcol(tq);
        auto aptr = [&](int i, int kt) __attribute__((always_inline)) -> const bfr* {
            return (kt < nloc) ? ag + (size_t)(arow + 64 * i) * 512 + kt * 64 + acol
                               : xg + (size_t)(arow + 64 * i) * 128 + (kt - nloc) * 64 + acol;
        };
        const bfr* bg = gt + (size_t)g * 512 * 640 + (size_t)(nt * 128 + (tq >> 3)) * 640 + acol;
        auto bptr = [&](int i, int kt) __attribute__((always_inline)) -> const bfr* {
            return bg + (size_t)(64 * i) * 640 + ((kt < nloc) ? kt : (8 + kt - nloc)) * 64;
        };
        GEMM128(lds, nloc + 2, aptr, bptr, [&](const float* stg, int) __attribute__((always_inline)) {
            epi_rows8_pre<uint4>(stg,
                [&](int r, int c0) __attribute__((always_inline)) -> uint4 {
                    const int n = nt * 128 + c0;
                    return *(const uint4*)(ag + ((size_t)(mt * 256 + r) * 32 + (n >> 4)) * 16 + (n & 15)); },
                [&](int r, int c0, const float (&v)[8], const uint4& up) __attribute__((always_inline)) {
                    const int cb = mt * 256 + r;
                    const int n = nt * 128 + c0, tt = n >> 4, c1 = n & 15;
                    const size_t tok = (size_t)cb * 32 + tt;
                    float uu[8], z[8];
                    unpack8(up, uu);
#pragma unroll
                    for (int j = 0; j < 8; ++j) {
                        const float y = v[j] + dsk[g * 16 + c1 + j] * uu[j];
                        const float inner = 0.7978845608028654f * (y + 0.044715f * y * y * y);
                        z[j] = 0.5f * y * (1.0f + ftanh(inner));
                    }
                    *(uint4*)(zb + tok * 512 + g * 16 + c1) = pack8(z);
                });
        });
    }
}

DI void phase_o5(char* lds, const Ctx& P, int li) {
    const bfr* zb = (const bfr*)(P.ws + OFF_ZBUF);
    const bfr* w = (const bfr*)(P.ws + OFF_GLUT) + (size_t)li * 512 * 512;
    bfr* am = (bfr*)(P.ws + OFF_AMIX);
    for (int t = blockIdx.x; t < 512; t += gridDim.x) {
        int mt, nt; tile_remap(t, 128, 4, mt, nt);
        RowLoader A(zb, mt * 256, 512), B(w, nt * 128, 512);
        GEMM128(lds, 8, A, B, [&](const float* stg, int) __attribute__((always_inline)) {
            epi_rows8_pre<uint4>(stg,
                [&](int r, int c0) __attribute__((always_inline)) -> uint4 { return *(const uint4*)(zb + (size_t)(mt * 256 + r) * 512 + nt * 128 + c0); },
                [&](int r, int c0, const float (&v)[8], const uint4& zp) __attribute__((always_inline)) {
                    float zz[8], o[8];
                    unpack8(zp, zz);
#pragma unroll
                    for (int j = 0; j < 8; ++j) o[j] = zz[j] * sigmoidf_(v[j]);
                    *(uint4*)(am + (size_t)(mt * 256 + r) * 1024 + 512 + nt * 128 + c0) = pack8(o);
                });
        });
    }
}
DI void phase_router(char* lds, const Ctx& P, int layer) {
    const float* x = P.out;
    bfr* hb = (bfr*)(P.ws + OFF_HB);
    bfr* hlo = (bfr*)(P.ws + OFF_HLO);
    const bfr* rhi = (const bfr*)(P.ws + OFF_RHI) + (size_t)layer * 128 * 1024;
    const bfr* rlo = (const bfr*)(P.ws + OFF_RLO) + (size_t)layer * 128 * 1024;
    int* gcnt = (int*)(P.ws + OFF_CNT) + layer * 64;
    int* stok = (int*)(P.ws + OFF_TOK);
    float* sgate = (float*)(P.ws + OFF_GATE);
    int* tslot = (int*)(P.ws + OFF_TSLOT);
    int* lcnt = (int*)(lds + LDS_AUX);
    int* lbase = lcnt + 64;
    const float* bg = P.in[I_MBG] + layer * 4;
    const float* be = P.in[I_MBE] + layer * 32;
    const int tid = ltid();
    for (int u = blockIdx.x; u < 128; u += gridDim.x) {
        const int m0 = u * 256;
        norm_rows(x, P.in[I_NFFN] + (size_t)layer * DM, hb, hlo, nullptr, m0, 256);
        __syncthreads();
        const size_t roff = (size_t)(m0 + (tid >> 3)) * 1024 + gt_lcol(tid);
        const size_t boff = (size_t)(tid >> 3) * 1024 + gt_lcol(tid);
        auto aptr = [&](int i, int kt) __attribute__((always_inline)) -> const bfr* { return (kt < 32 ? hb : hlo) + roff + (size_t)(64 * i) * 1024 + (kt & 15) * 64; };
        auto bptr = [&](int i, int kt) __attribute__((always_inline)) -> const bfr* { return ((kt >= 16 && kt < 32) ? rlo : rhi) + boff + (size_t)(64 * i) * 1024 + (kt & 15) * 64; };
        GEMM128(lds, 48, aptr, bptr, [&](const float* stg, int) __attribute__((always_inline)) {
            if (tid < 64) lcnt[tid] = 0;
            __syncthreads();
            int seg0 = 0, seg1 = 0, p0 = 0, p1 = 0;
            float g0 = 0.f, g1 = 0.f;
            if (tid < 256) {
                const float* row = stg + tid * STG_LD;
                float gl[4];
#pragma unroll
                for (int j = 0; j < 4; ++j) gl[j] = row[32 + j] + bg[j];
                int gt = 0; float gm = gl[0];
#pragma unroll
                for (int j = 1; j < 4; ++j) if (gl[j] > gm) { gm = gl[j]; gt = j; }
                float gs = 0.f;
#pragma unroll
                for (int j = 0; j < 4; ++j) gs += __expf(gl[j] - gm);
                const float gw = 1.0f / gs;
                float l1 = -INFINITY, l2 = -INFINITY; int j1 = 0, j2 = 0;
                for (int j = 0; j < 8; ++j) {
                    const float v = row[gt * 8 + j] + be[gt * 8 + j];
                    if (v > l1) { l2 = l1; j2 = j1; l1 = v; j1 = j; }
                    else if (v > l2) { l2 = v; j2 = j; }
                }
                const float w1 = 1.0f / (1.0f + __expf(l2 - l1));
                g0 = gw * w1; g1 = gw * (1.0f - w1);
                seg0 = gt * 8 + j1; seg1 = 32 + gt * 8 + j2;
                p0 = atomicAdd(&lcnt[seg0], 1);
                p1 = atomicAdd(&lcnt[seg1], 1);
            }
            __syncthreads();
            if (tid < 64) { const int c = lcnt[tid]; lbase[tid] = c ? atomicAdd(&gcnt[tid], c) : 0; }
            __syncthreads();
            if (tid < 256) {
                const int q0 = lbase[seg0] + p0, q1 = lbase[seg1] + p1;
                stok[(size_t)seg0 * NTOK + q0] = m0 + tid; sgate[(size_t)seg0 * NTOK + q0] = g0;
                stok[(size_t)seg1 * NTOK + q1] = m0 + tid; sgate[(size_t)seg1 * NTOK + q1] = g1;
                tslot[m0 + tid] = seg0 * 32768 + q0;
            }
        });
    }
}

DI void moe_tables(char* lds, const Ctx& P, int layer) {
    int* cnt = (int*)(lds + LDS_AUX); int* rb0 = cnt + 64; int* hoff = rb0 + 65;
    const int* gcnt = (const int*)(P.ws + OFF_CNT) + layer * 64;
    const int tid = ltid();
    if (tid < 64) cnt[tid] = gcnt[tid];
    __syncthreads();
    if (tid == 0) {
        int acc = 0;
        for (int s = 0; s < 64; ++s) { rb0[s] = acc; hoff[s] = acc * 256; acc += (cnt[s] + 255) >> 8; }
        rb0[64] = acc;
    }
    __syncthreads();
}
DI int moe_find_seg(const int* rb0, int rbi) { int s = 0; while (rb0[s + 1] <= rbi) ++s; return s; }

DI void phase_moe_up(char* lds, const Ctx& P, int layer) {
    moe_tables(lds, P, layer);
    const int* cnt = (const int*)(lds + LDS_AUX); const int* rb0 = cnt + 64; const int* hoff = rb0 + 65;
    const bfr* hb = (const bfr*)(P.ws + OFF_HB);
    const bfr* wgu = (const bfr*)(P.ws + OFF_MWGU);
    const int* stok = (const int*)(P.ws + OFF_TOK);
    bfr* hid = (bfr*)(P.ws + OFF_HID);
    const int ntiles = rb0[64] * 4, G = gridDim.x;
    const int full = (ntiles / G) * G, rem = ntiles - full;
    const bool halves = rem > 0 && 2 * rem <= G;
    const int nwork = halves ? full + 2 * rem : ntiles;
    for (int wi = blockIdx.x; wi < nwork; wi += G) {
        const bool ishalf = halves && wi >= full;
        const int t = ishalf ? full + ((wi - full) >> 1) : wi;
        const int hc = ishalf ? ((wi - full) & 1) * 128 : 0;
        int rbi, nt; tile_remap(t, rb0[64], 4, rbi, nt);
        const int seg = moe_find_seg(rb0, rbi);
        const int rb = rbi - rb0[seg], e = seg & 31, c = cnt[seg];
        const bfr* ap[4];
        const int tq = ltid();
#pragma unroll
        for (int i = 0; i < 4; ++i) {
            int p = rb * 256 + (tq >> 3) + 64 * i; p = p < c ? p : c - 1;
            ap[i] = hb + (size_t)stok[(size_t)seg * NTOK + p] * 1024 + gt_lcol(tq);
        }
        auto aptr = [&](int i, int kt) __attribute__((always_inline)) -> const bfr* { return ap[i] + kt * 64; };
        const size_t hrow0 = (size_t)hoff[seg] + rb * 256;
        if (!ishalf) {
            RowLoader B(wgu + (size_t)e * 1024 * 1024, nt * 256, 1024);
            GEMM256(lds, 16, aptr, B, [&](const float* stg, int p) __attribute__((always_inline)) {
                epi_rows8(stg, [&](int r, int c0, const float (&v)[8]) __attribute__((always_inline)) {
                    float o[4];
#pragma unroll
                    for (int j = 0; j < 4; ++j) o[j] = v[j] * sigmoidf_(v[j]) * v[4 + j];
                    *(uint2*)(hid + (hrow0 + r) * 512 + ((nt * 256 + p * 128 + c0) >> 1)) = make_uint2(pk2(o[0], o[1]), pk2(o[2], o[3]));
                });
            });
        } else {
            RowLoader B(wgu + (size_t)e * 1024 * 1024, nt * 256 + hc, 1024);
            GEMM128(lds, 16, aptr, B, [&](const float* stg, int) __attribute__((always_inline)) {
                epi_rows8(stg, [&](int r, int c0, const float (&v)[8]) __attribute__((always_inline)) {
                    float o[4];
#pragma unroll
                    for (int j = 0; j < 4; ++j) o[j] = v[j] * sigmoidf_(v[j]) * v[4 + j];
                    *(uint2*)(hid + (hrow0 + r) * 512 + ((nt * 256 + hc + c0) >> 1)) = make_uint2(pk2(o[0], o[1]), pk2(o[2], o[3]));
                });
            });
        }
    }
}

struct F12 { float4 a, b; uint4 y; };
DI void phase_moe_down(char* lds, const Ctx& P, int layer, int k, float* x) {
    const G4 G = g4_make(lds);
    int* cnt = (int*)(G.lds + G4_AUX); int* rb0 = cnt + 64; int* hoff = rb0 + 65;
    {
        const int* gcnt = (const int*)(P.ws + OFF_CNT) + layer * 64;
        if (G.tid < 64) cnt[G.tid] = gcnt[G.tid];
        g4_bar(G);
        if (G.tid == 0) {
            int acc = 0, hacc = 0;
            for (int s = 0; s < 64; ++s) { rb0[s] = acc; hoff[s] = hacc; acc += (cnt[s] + 127) >> 7; hacc += ((cnt[s] + 255) >> 8) * 256; }
            rb0[64] = acc;
        }
        g4_bar(G);
    }
    const bfr* hid = (const bfr*)(P.ws + OFF_HID);
    const bfr* wd = (const bfr*)(P.ws + OFF_MWD);
    const int* stok = (const int*)(P.ws + OFF_TOK);
    const float* sgate = (const float*)(P.ws + OFF_GATE);
    const int* tslot = (const int*)(P.ws + OFF_TSLOT);
    bfr* y0 = (bfr*)(P.ws + OFF_Y0);
    const int rbA = rb0[k * 32], rbB = rb0[k * 32 + 32];
    const int ntiles = (rbB - rbA) * 8;
    for (int t = G.vb; t < ntiles; t += G.nvb) {
        int rbi, nt; tile_remap(t, rbB - rbA, 8, rbi, nt); rbi += rbA;
        const int seg = moe_find_seg(rb0, rbi);
        const int rb = rbi - rb0[seg], e = seg & 31, c = cnt[seg];
        const int hrow0 = hoff[seg] + rb * 128;
        G4RowLoader A(G, hid, hrow0, 512), B(G, wd + (size_t)e * 1024 * 512, nt * 128, 512);
        int* ltok = (int*)(G.lds + G4_AUX + 1024); float* lgate = (float*)(G.lds + G4_AUX + 1536); int* lrow = (int*)(G.lds + G4_AUX + 2048);
        if (G.tid < 128) {
            const int p = rb * 128 + G.tid;
            const int tok = p < c ? stok[(size_t)seg * NTOK + p] : -1;
            ltok[G.tid] = tok;
            lgate[G.tid] = p < c ? sgate[(size_t)seg * NTOK + p] : 0.f;
            int r0 = 0;
            if (k == 1 && tok >= 0) { const int ts = tslot[tok]; r0 = hoff[ts >> 15] + (ts & 32767); }
            lrow[G.tid] = r0;
        }
        if (k == 0) {
            g4_gemm_tile(G, G.lds, 8, A, B, [&](const float* stg) __attribute__((always_inline)) {
                g4_epi_rows8(G, stg, [&](int r, int c0, const float (&v)[8]) __attribute__((always_inline)) {
                    if (ltok[r] >= 0) {
                        const float gt = lgate[r];
                        float o[8];
#pragma unroll
                        for (int j = 0; j < 8; ++j) o[j] = gt * v[j];
                        *(uint4*)(y0 + (size_t)(hrow0 + r) * 1024 + nt * 128 + c0) = pack8(o);
                    }
                });
            });
        } else {
            g4_gemm_tile(G, G.lds, 8, A, B, [&](const float* stg) __attribute__((always_inline)) {
                g4_epi_rows8_pre<F12>(G, stg,
                    [&](int r, int c0) __attribute__((always_inline)) -> F12 {
                        int tok = ltok[r]; tok = tok < 0 ? 0 : tok;
                        const float* d = x + (size_t)tok * DM + nt * 128 + c0;
                        F12 o; o.a = *(const float4*)d; o.b = *(const float4*)(d + 4);
                        o.y = *(const uint4*)(y0 + (size_t)lrow[r] * 1024 + nt * 128 + c0);
                        return o; },
                    [&](int r, int c0, const float (&v)[8], const F12& o) __attribute__((always_inline)) {
                        const int tok = ltok[r];
                        if (tok >= 0) {
                            const float gt = lgate[r];
                            float yv[8];
                            unpack8(o.y, yv);
                            float* d = x + (size_t)tok * DM + nt * 128 + c0;
                            *(float4*)d = make_float4(o.a.x + gt * v[0] + yv[0], o.a.y + gt * v[1] + yv[1], o.a.z + gt * v[2] + yv[2], o.a.w + gt * v[3] + yv[3]);
                            *(float4*)(d + 4) = make_float4(o.b.x + gt * v[4] + yv[4], o.b.y + gt * v[5] + yv[5], o.b.z + gt * v[6] + yv[6], o.b.w + gt * v[7] + yv[7]);
                        }
                    });
            });
        }
    }
}
constexpr int PH_PER_LAYER = 11;
constexpr int N_PHASES = 1 + 4 * PH_PER_LAYER;

DI void phase_prologue(char* lds, const Ctx& P) {
    for (int u = blockIdx.x; u < 64; u += gridDim.x) s5_tables(lds, P, u >> 5, u & 31);
    const bool excl = gridDim.x >= 128;
    if (excl && blockIdx.x < 64) return;
    unsigned base = 0;
    const int wk = excl ? (int)blockIdx.x - 64 : (int)blockIdx.x, nw = excl ? (int)gridDim.x - 64 : (int)gridDim.x;
    for (int i = 0; i < 2; ++i) {
        cvt_matrix(lds, P.in[I_EWIN] + (size_t)i * 1024 * 2304, 1024, 2304, (bfr*)(P.ws + OFF_WINE) + (size_t)i * 2304 * 1024, 1024, 0, wk, nw, base);
        cvt_matrix(lds, P.in[I_EWOUT] + (size_t)i * 1024 * 1024, 1024, 1024, (bfr*)(P.ws + OFF_WOUTE) + (size_t)i * 1024 * 1024, 1024, 0, wk, nw, base);
        cvt_matrix(lds, P.in[I_OWIN] + (size_t)i * 1024 * 2048, 1024, 2048, (bfr*)(P.ws + OFF_WINO) + (size_t)i * 2048 * 1024, 1024, 0, wk, nw, base);
        cvt_matrix(lds, P.in[I_OWOUT] + (size_t)i * 1024 * 1024, 1024, 1024, (bfr*)(P.ws + OFF_WOUTO) + (size_t)i * 1024 * 1024, 1024, 0, wk, nw, base);
        cvt_matrix(lds, P.in[I_W2] + (size_t)i * 64 * 512, 64, 512, (bfr*)(P.ws + OFF_W2T) + (size_t)i * 512 * 64, 64, 0, wk, nw, base);
        cvt_matrix(lds, P.in[I_A2] + (size_t)i * 64 * 512, 64, 512, (bfr*)(P.ws + OFF_A2T) + (size_t)i * 512 * 64, 64, 0, wk, nw, base);
        cvt_matrix(lds, P.in[I_G2] + (size_t)i * 128 * 512, 128, 512, (bfr*)(P.ws + OFF_G2T) + (size_t)i * 512 * 128, 128, 0, wk, nw, base);
        for (int g = 0; g < 4; ++g)
            cvt_matrix(lds, P.in[I_POOLW] + (size_t)(i * 4 + g) * 128 * 128, 128, 128, (bfr*)(P.ws + OFF_POOLT) + (size_t)(i * 4 + g) * 128 * 128, 128, 0, wk, nw, base);
        cvt_matrix(lds, P.in[I_WGLU] + (size_t)i * 512 * 512, 512, 512, (bfr*)(P.ws + OFF_GLUT) + (size_t)i * 512 * 512, 512, 0, wk, nw, base);
    }
    const int gtid = wk * NTHREADS + ltid(), gsz = nw * NTHREADS;
    {
        bfr* rhi = (bfr*)(P.ws + OFF_RHI); bfr* rlo = (bfr*)(P.ws + OFF_RLO);
        for (int idx = gtid; idx < 4 * 128 * 1024; idx += gsz) {
            const int k = idx & 1023, n = (idx >> 10) & 127, l = idx >> 17;
            float w = 0.f;
            if (n < 32) w = P.in[I_MWE][((size_t)l * 1024 + k) * 32 + n];
            else if (n < 36) w = P.in[I_MWG][((size_t)l * 1024 + k) * 4 + (n - 32)];
            const bfr h = f2bf(w);
            rhi[idx] = h; rlo[idx] = f2bf(w - bf2f(h));
        }
    }
    {
        bfr* v12 = (bfr*)(P.ws + OFF_V12T);
        const float* v1 = P.in[I_V1]; const float* v2 = P.in[I_V2];
        for (int idx = gtid; idx < 512 * 512; idx += gsz) {
            const int k = idx & 511, n = idx >> 9;
            float s = 0.f;
            for (int r = 0; r < 32; ++r) s += v1[k * 32 + r] * v2[r * 512 + n];
            v12[idx] = f2bf(s);
        }
    }
    for (int tt = wk; tt < 512; tt += nw)
        norm_rows(P.in[I_X], P.in[I_NMIX], (bfr*)(P.ws + OFF_HB), nullptr, P.out, tt * 64, 64);
}

DI Ctx mkctx(unsigned char* ws, float* out) {
    size_t z = 0;
    asm volatile("" : "+s"(z));
    Ctx c;
    c.in.p = (KArgPtr)__builtin_amdgcn_kernarg_segment_ptr() + z;
    c.ws = ws + z; c.out = (float*)((char*)out + z);
    return c;
}
__global__ void __launch_bounds__(NTHREADS, 2) fwd_kernel(Params PA) {
    extern __shared__ __attribute__((aligned(16))) char lds[];
    if (threadIdx.x == 0) { *(uint4*)(lds + LDS_BYTES - 16) = make_uint4(0u, 0u, 0u, 0u); *(uint4*)(lds + LDS_BYTES - 32) = make_uint4(0u, 0u, 0u, 0u); }
    __syncthreads();
    XcdBarrier bar = xcd_barrier_post((unsigned*)(PA.ws + OFF_BAR), (volatile LAS unsigned*)(lds + LDS_BYTES - 16));
    const int lo = PA.ph_lo, hi = PA.ph_hi;
#ifndef RWKV_CHUNKED
#define RWKV_CHUNKED 1
#endif
#ifndef DUP_PH
#define DUP_PH (-1)
#endif
#define DUPX(k, call) do { call; if (DUP_PH == (k)) { __syncthreads(); call; } } while (0)
#define RUNS(id) ((id) >= lo && (id) < hi)
#define P mkctx(PA.ws, PA.out)
#define SEAM(id) do { if ((id) > lo && (id) < hi) xcd_barrier(bar); } while (0)
    if (RUNS(0)) DUPX(100, phase_prologue(lds, P));
    for (int layer = 0; layer < 4; ++layer) {
        const int base = 1 + layer * PH_PER_LAYER;
        const int li = layer >> 1;
        if ((layer & 1) == 0) {
            SEAM(base + 0); if (RUNS(base + 0)) DUPX(0, phase_e1(lds, P, li));
            SEAM(base + 1); if (RUNS(base + 1)) DUPX(1, phase_e2a(P, li));
            SEAM(base + 2); if (RUNS(base + 2)) DUPX(2, phase_e2b(lds, P, li));
#if RWKV_CHUNKED
            SEAM(base + 3); if (RUNS(base + 3)) { DUPX(43, phase_r1(lds, P, li)); if (DUP_PH >= 45 && DUP_PH <= 47) phase_r1(lds, P, li, DUP_PH - 44); xcd_barrier(bar); DUPX(44, phase_r2(P)); }
#else
            SEAM(base + 3); if (RUNS(base + 3)) { phase_e3(lds, P, li); if (DUP_PH == 3) phase_e3(lds, P, li, 3); }
#endif
            SEAM(base + 4); if (RUNS(base + 4)) DUPX(4, phase_e4(P, li));
            SEAM(base + 5); if (RUNS(base + 5)) { phase_wout(lds, P, (const bfr*)(P.ws + OFF_WOUTE) + (size_t)li * 1024 * 1024, P.out); if (DUP_PH == 5) phase_wout(lds, P, (const bfr*)(P.ws + OFF_WOUTE) + (size_t)li * 1024 * 1024, (float*)(P.ws + OFF_EV)); }
        } else {
            SEAM(base + 0); if (RUNS(base + 0)) DUPX(10, phase_o1(lds, P, li));
            SEAM(base + 1); if (RUNS(base + 1)) DUPX(11, phase_o2(lds, P, li));
            SEAM(base + 2); if (RUNS(base + 2)) DUPX(12, phase_o3(lds, P, li, layer));
            SEAM(base + 3); if (RUNS(base + 3)) DUPX(13, phase_o4(lds, P, li));
            SEAM(base + 4); if (RUNS(base + 4)) DUPX(14, phase_o5(lds, P, li));
            SEAM(base + 5); if (RUNS(base + 5)) { phase_wout(lds, P, (const bfr*)(P.ws + OFF_WOUTO) + (size_t)li * 1024 * 1024, P.out); if (DUP_PH == 5) phase_wout(lds, P, (const bfr*)(P.ws + OFF_WOUTO) + (size_t)li * 1024 * 1024, (float*)(P.ws + OFF_EV)); }
        }
        SEAM(base + 6);
        if (RUNS(base + 6)) {
            phase_router(lds, P, layer);
            if (gridDim.x >= 256) {
                const int b = blockIdx.x;
                const int per = 6144 / (int)gridDim.x;
                const int lo_n = per / 2, hi_n = per + per / 2;
                if (b < 128) moe_convert_range(lds, P, layer, (int)(gridDim.x - 128) * hi_n + b * lo_n, (int)(gridDim.x - 128) * hi_n + (b + 1) * lo_n);
                else { const int e1 = (b - 128 + 1) * hi_n; moe_convert_range(lds, P, layer, (b - 128) * hi_n, e1 < 6144 ? e1 : 6144); }
            } else {
                const int per = (6144 + (int)gridDim.x - 1) / (int)gridDim.x;
                const int t0 = blockIdx.x * per, t1 = t0 + per;
                moe_convert_range(lds, P, layer, t0 < 6144 ? t0 : 6144, t1 < 6144 ? t1 : 6144);
            }
        }
        SEAM(base + 7); if (RUNS(base + 7)) DUPX(7, phase_moe_up(lds, P, layer));
        SEAM(base + 8); if (RUNS(base + 8)) DUPX(8, phase_moe_down(lds, P, layer, 0, P.out));
        SEAM(base + 9); if (RUNS(base + 9)) phase_moe_down(lds, P, layer, 1, P.out);
        SEAM(base + 10);
        if (RUNS(base + 10) && layer < 3) {
            for (int rep = 0; rep < (DUP_PH == 20 ? 2 : 1); ++rep)
            for (int tt = blockIdx.x; tt < 512; tt += gridDim.x)
                norm_rows(P.out, P.in[I_NMIX] + (size_t)(layer + 1) * DM, (bfr*)(P.ws + OFF_HB), nullptr, nullptr, tt * 64, 64);
        }
    }
#undef P
#undef RUNS
#undef SEAM
}

#ifndef N_LAUNCH_SPLIT
#define N_LAUNCH_SPLIT 0
#endif
extern "C" void kernel_launch(void* const* d_in, const int* in_sizes, int n_in, void* d_out, int out_size, void* d_ws, size_t ws_size, hipStream_t stream) {
    static int grid = 0;
    if (grid == 0) {
        if (n_in != N_INPUTS || out_size != NTOK * DM || ws_size < WS_NEEDED || ws_size < OFF_RC_END) {
            fprintf(stderr, "kernel_launch: unexpected shapes: n_in %d out %d ws %zu (need %zu)\n", n_in, out_size, ws_size, (size_t)WS_NEEDED);
            grid = -1; return;
        }
        int dev = 0, cus = 0, per_cu = 0;
        (void)hipGetDevice(&dev);
        (void)hipDeviceGetAttribute(&cus, hipDeviceAttributeMultiprocessorCount, dev);
        if (hipFuncSetAttribute((const void*)fwd_kernel, hipFuncAttributeMaxDynamicSharedMemorySize, LDS_BYTES) != hipSuccess) { fprintf(stderr, "kernel_launch: hipFuncSetAttribute failed\n"); grid = -1; return; }
        if (hipOccupancyMaxActiveBlocksPerMultiprocessor(&per_cu, (const void*)fwd_kernel, NTHREADS, LDS_BYTES) != hipSuccess) per_cu = 1;
        (void)hipGetLastError();
        if (per_cu < 1) per_cu = 1;
        if (per_cu > 1) per_cu = 1;
        if (cus <= 0) cus = 256;
        grid = cus * per_cu;
    }
    if (grid < 0) return;
    (void)hipMemsetAsync(d_ws, 0, OFF_ZERO_END, stream);
    Params p{};
    for (int i = 0; i < N_INPUTS; ++i) p.in[i] = (const float*)d_in[i];
    p.out = (float*)d_out; p.ws = (unsigned char*)d_ws;
#if N_LAUNCH_SPLIT
    for (int ph = 0; ph < N_PHASES - 1; ++ph) {
        p.ph_lo = ph; p.ph_hi = ph + 1;
        hipLaunchKernelGGL(fwd_kernel, dim3(grid), dim3(NTHREADS), LDS_BYTES, stream, p);
    }
#else
    p.ph_lo = 0; p.ph_hi = N_PHASES;
    hipLaunchKernelGGL(fwd_kernel, dim3(grid), dim3(NTHREADS), LDS_BYTES, stream, p);
#endif
}
```

```cpp
#include <hip/hip_runtime.h>
#include <stdint.h>
#include <stdio.h>

typedef unsigned short bfr;
typedef __attribute__((ext_vector_type(8))) short bf16x8;
typedef __attribute__((ext_vector_type(16))) float f32x16;
typedef __attribute__((ext_vector_type(2))) __bf16 bf16x2_t;
#define DI __device__ __forceinline__
#define MFMA32(a, b, c) __builtin_amdgcn_mfma_f32_32x32x16_bf16((a), (b), (c), 0, 0, 0)

constexpr int NTOK = 32768, DM = 1024, SEQ = 2048, NB = 16;
constexpr int EVEN_IN = 2304, ODD_IN = 2048;
constexpr int NTHREADS = 512;
constexpr int NWAVES = NTHREADS / 64;
constexpr int LDS_BYTES = 161792;

enum { I_X = 0, I_NMIX, I_NFFN, I_EWIN, I_MU, I_W0, I_W2, I_A0, I_A2, I_G2, I_KK, I_KA, I_RK, I_LNG, I_LNB, I_V0, I_V1, I_V2,
       I_POOLW, I_POOLS, I_EWOUT, I_OWIN, I_QN, I_KN, I_LQ1, I_LK1, I_LQ2, I_LK2, I_SUBLN, I_ARE, I_AIM, I_LSTEP, I_BRE, I_BIM,
       I_CRE, I_CIM, I_S5D, I_WGLU, I_OWOUT, I_MWG, I_MBG, I_MWE, I_MBE, I_MWGATE, I_MWUP, I_MWDOWN, N_INPUTS };

constexpr size_t al256(size_t x) { return (x + 255) & ~(size_t)255; }
constexpr size_t OFF_BAR   = 0;
constexpr size_t OFF_CNT   = 16384;
constexpr size_t OFF_ZERO_END = 32768;
constexpr size_t OFF_WINE  = 65536;
constexpr size_t OFF_WOUTE = OFF_WINE  + (size_t)2 * 2304 * 1024 * 2;
constexpr size_t OFF_WINO  = OFF_WOUTE + (size_t)2 * 1024 * 1024 * 2;
constexpr size_t OFF_WOUTO = OFF_WINO  + (size_t)2 * 2048 * 1024 * 2;
constexpr size_t OFF_W2T   = OFF_WOUTO + (size_t)2 * 1024 * 1024 * 2;
constexpr size_t OFF_A2T   = OFF_W2T   + (size_t)2 * 512 * 64 * 2;
constexpr size_t OFF_G2T   = OFF_A2T   + (size_t)2 * 512 * 64 * 2;
constexpr size_t OFF_V12T  = OFF_G2T   + (size_t)2 * 512 * 128 * 2;
constexpr size_t OFF_POOLT = OFF_V12T  + (size_t)512 * 512 * 2;
constexpr size_t OFF_GLUT  = OFF_POOLT + (size_t)2 * 4 * 128 * 128 * 2;
constexpr size_t OFF_RHI   = OFF_GLUT  + (size_t)2 * 512 * 512 * 2;
constexpr size_t OFF_RLO   = OFF_RHI   + (size_t)4 * 128 * 1024 * 2;
constexpr size_t OFF_S5GT  = OFF_RLO   + (size_t)4 * 128 * 1024 * 2;
constexpr size_t OFF_S5BL  = OFF_S5GT  + (size_t)2 * 32 * 512 * 640 * 2;
constexpr size_t OFF_S5L32 = OFF_S5BL  + (size_t)2 * 32 * 128 * 512 * 2;
constexpr size_t OFF_MWGU  = al256(OFF_S5L32 + (size_t)2 * 32 * 64 * 2 * 4);
constexpr size_t OFF_MWD   = OFF_MWGU  + (size_t)32 * 1024 * 1024 * 2;
constexpr size_t OFF_HB    = OFF_MWD   + (size_t)32 * 1024 * 512 * 2;
constexpr size_t OFF_U     = OFF_HB    + (size_t)NTOK * 1024 * 2;
constexpr size_t OFF_US5   = OFF_U     + (size_t)NTOK * 1024 * 2;
constexpr size_t OFF_AMIX  = OFF_U     + (size_t)NTOK * 2304 * 2;
constexpr size_t OFF_VFIRST= OFF_AMIX  + (size_t)NTOK * 1024 * 2;
constexpr size_t OFF_TOK   = OFF_VFIRST+ (size_t)NTOK * 512 * 2;
constexpr size_t OFF_GATE  = OFF_TOK   + (size_t)64 * NTOK * 4;
constexpr size_t OFF_HID   = OFF_GATE  + (size_t)64 * NTOK * 4;
constexpr size_t OFF_HLO   = OFF_HID;
constexpr size_t OFF_EV    = OFF_HID   + (size_t)81920 * 512 * 2;
constexpr size_t OFF_S     = OFF_EV;
constexpr size_t OFF_MV2   = OFF_S     + (size_t)NTOK * 256 * 2;
constexpr size_t OFF_DLOG  = OFF_MV2   + (size_t)NTOK * 512 * 2;
constexpr size_t OFF_ABUF  = OFF_DLOG  + (size_t)NTOK * 512 * 4;
constexpr size_t OFF_GBUF  = OFF_ABUF  + (size_t)NTOK * 512 * 2;
constexpr size_t OFF_VGATE = OFF_GBUF  + (size_t)NTOK * 512 * 2;
constexpr size_t OFF_Y     = OFF_VGATE + (size_t)NTOK * 512 * 2;
constexpr size_t OFF_DPOOL = OFF_Y;
constexpr size_t OFF_BONUS = OFF_Y     + (size_t)NTOK * 512 * 4;
constexpr size_t OFF_EV_END= OFF_BONUS + (size_t)NTOK * 512 * 4;
constexpr size_t OFF_Y0    = OFF_EV;
constexpr size_t OFF_TSLOT = OFF_Y0    + (size_t)40960 * 1024 * 2;
static_assert(OFF_TSLOT + (size_t)NTOK * 4 <= OFF_EV_END, "MoE scratch must fit the mixer scratch region");
constexpr size_t OFF_QN    = OFF_EV;
constexpr size_t OFF_KN    = OFF_QN    + (size_t)NTOK * 512 * 2;
constexpr size_t OFF_VT    = OFF_KN    + (size_t)NTOK * 512 * 2;
constexpr size_t OFF_XLOC  = OFF_VT    + (size_t)NTOK * 512 * 2;
constexpr size_t OFF_XIN   = OFF_XLOC  + (size_t)32 * 1024 * 128 * 4;
constexpr size_t OFF_ZBUF  = OFF_XIN   + (size_t)32 * 1024 * 128 * 2;
constexpr size_t OFF_OD_END= OFF_ZBUF  + (size_t)NTOK * 512 * 2;
constexpr size_t WS_NEEDED = OFF_EV_END > OFF_OD_END ? OFF_EV_END : OFF_OD_END;

struct Params {
    const float* in[N_INPUTS];
    float* out;
    unsigned char* ws;
    int ph_lo, ph_hi;
};
typedef const __attribute__((address_space(4))) char* KArgPtr;
struct InTab {
    KArgPtr p;
    DI const float* operator[](int i) const {
        const float* q = *(const float* const __attribute__((address_space(4)))*)(p + 8 * i);
        return (const float*)(const __attribute__((address_space(1))) float*)q;
    }
};
struct Ctx { InTab in; unsigned char* ws; float* out; };

DI unsigned pk2(float a, float b) { bf16x2_t v; v[0] = (__bf16)a; v[1] = (__bf16)b; return __builtin_bit_cast(unsigned, v); }
DI bfr f2bf(float a) { return (bfr)(pk2(a, 0.f) & 0xffffu); }
DI float bf2f(bfr b) { return __uint_as_float(((unsigned)b) << 16); }
DI float bflo(unsigned u) { return __uint_as_float(u << 16); }
DI float bfhi(unsigned u) { return __uint_as_float(u & 0xffff0000u); }
DI uint4 pack8(const float (&v)[8]) { return make_uint4(pk2(v[0], v[1]), pk2(v[2], v[3]), pk2(v[4], v[5]), pk2(v[6], v[7])); }
DI void unpack8(uint4 u, float (&v)[8]) { v[0] = bflo(u.x); v[1] = bfhi(u.x); v[2] = bflo(u.y); v[3] = bfhi(u.y); v[4] = bflo(u.z); v[5] = bfhi(u.z); v[6] = bflo(u.w); v[7] = bfhi(u.w); }
DI float frcp(float x) { return __builtin_amdgcn_rcpf(x); }
DI float fexp(float x) { return __builtin_amdgcn_exp2f(x * 1.4426950408889634f); }
DI float sigmoidf_(float x) { return frcp(1.0f + fexp(-x)); }
DI float ftanh(float x) { return 2.0f * frcp(1.0f + fexp(-2.0f * x)) - 1.0f; }
DI float fsoftplus(float z) { return z > 20.0f ? z : __logf(1.0f + fexp(z)); }
template <int CTRL> DI float dpp_f(float x) { return __builtin_bit_cast(float, __builtin_amdgcn_update_dpp(0, __builtin_bit_cast(int, x), CTRL, 0xf, 0xf, false)); }
DI float row16_sum(float s) {
    s += dpp_f<0x128>(s); s += dpp_f<0x124>(s); s += dpp_f<0x122>(s); s += dpp_f<0x121>(s); return s; }
DI int ltid() { int t = threadIdx.x; asm volatile("" : "+v"(t)); return t; }
DI float dot4n(float s0, float s1, float s2, float s3, const float4& a) {
    float d;
    asm("v_mul_f32 %0, %1, %5\n\tv_fma_f32 %0, %2, %6, %0\n\tv_fma_f32 %0, %3, %7, %0\n\tv_fma_f32 %0, %4, %8, %0\n\ts_nop 1"
        : "=&v"(d) : "v"(s0), "v"(s1), "v"(s2), "v"(s3), "v"(a.x), "v"(a.y), "v"(a.z), "v"(a.w));
    return d;
}
DI void rw_upd(float& S, float w, float sa, float b, float vi, float k) {
    float t;
    asm("v_mul_f32 %1, %4, %5\n\tv_fma_f32 %1, %2, %3, %1\n\tv_fma_f32 %0, %0, %6, %1"
        : "+v"(S), "=&v"(t) : "v"(sa), "v"(b), "v"(vi), "v"(k), "v"(w));
}
DI float wave_sum(float s) { s = row16_sum(s); s += __shfl_xor(s, 16); s += __shfl_xor(s, 32); return s; }
#define XB_TMO      128
#define XB_XCNT(j)  (256  + 64 * (j))
#define XB_XSUB(j)  (1280 + 64 * (j))
#define XB_XGEN(j)  (2304 + 64 * (j))
#define XB_TOP      3328
#define XB_TOPGEN   3392
#define XCD_BAR_WORDS 3456
#define XB_SPIN_CAP (1u << 18)
#define LAS __attribute__((address_space(3)))

__device__ __forceinline__ unsigned xb_ld(unsigned* p)              { return __hip_atomic_load(p, __ATOMIC_RELAXED, __HIP_MEMORY_SCOPE_AGENT); }
__device__ __forceinline__ unsigned xb_add(unsigned* p, unsigned v) { return __hip_atomic_fetch_add(p, v, __ATOMIC_RELAXED, __HIP_MEMORY_SCOPE_AGENT); }
__device__ __forceinline__ unsigned xb_xcc_id() { return (unsigned)__builtin_amdgcn_s_getreg((3 << 11) | 20) & 0xFu; }
#define XB_SPIN(cond, bar) do { unsigned _sp = 0; while (cond) { __builtin_amdgcn_s_sleep(1); \
    if ((++_sp & 255u) == 0u) { if (xb_ld(&(bar)[XB_TMO])) break; if (_sp > XB_SPIN_CAP) { atomicAdd(&(bar)[XB_TMO], 1u); break; } } } } while (0)

struct XcdBarrier {
    unsigned* bar; unsigned x;
    volatile LAS unsigned* st;
};
__device__ __forceinline__ XcdBarrier xcd_barrier_post(unsigned* bar, volatile LAS unsigned* st) {
    XcdBarrier b; b.bar = bar; b.x = xb_xcc_id(); b.st = st;
    if (threadIdx.x == 0) (void)xb_add(&bar[XB_XCNT(b.x)], 1u);
    return b;
}
__device__ __forceinline__ void xcd_barrier_complete(unsigned* bar, unsigned x, unsigned& nloc, unsigned& nx) {
    const unsigned G = gridDim.x * gridDim.y * gridDim.z;
    unsigned sum, cnt, mine, sp = 0u;
    for (;;) {
        sum = 0u; cnt = 0u; mine = 0u;
#pragma unroll
        for (unsigned j = 0; j < 16; ++j) { const unsigned c = xb_ld(&bar[XB_XCNT(j)]); sum += c; cnt += (c > 0u) ? 1u : 0u; mine = (j == x) ? c : mine; }
        if (sum == G) break;
        __builtin_amdgcn_s_sleep(1);
        if ((++sp & 255u) == 0u) { if (xb_ld(&bar[XB_TMO])) break; if (sp > XB_SPIN_CAP) { atomicAdd(&bar[XB_TMO], 1u); break; } }
    }
    nloc = mine > 0u ? mine : 1u; nx = cnt > 0u ? cnt : 1u;
}
__device__ __forceinline__ void xcd_barrier(const XcdBarrier& b) {
    asm volatile("s_waitcnt vmcnt(0)" ::: "memory");
    __syncthreads();
    if (threadIdx.x == 0) {
        unsigned* bar = b.bar;
        __builtin_amdgcn_s_waitcnt(0);
        unsigned nloc = b.st[0], nx = b.st[1];
        if (nloc == 0u) { xcd_barrier_complete(bar, b.x, nloc, nx); b.st[0] = nloc; b.st[1] = nx; }
        const unsigned old = xb_add(&bar[XB_XSUB(b.x)], 1u);
        const unsigned gen = old / nloc;
        if (old + 1u == (gen + 1u) * nloc) {
            __builtin_amdgcn_fence(__ATOMIC_RELEASE, "agent");
            asm volatile("s_waitcnt vmcnt(0)" ::: "memory");
            const unsigned og = xb_add(&bar[XB_TOP], 1u);
            const unsigned tg = og / nx;
            if (og + 1u == (tg + 1u) * nx) xb_add(&bar[XB_TOPGEN], 1u);
            else XB_SPIN(xb_ld(&bar[XB_TOPGEN]) == tg, bar);
            __builtin_amdgcn_fence(__ATOMIC_ACQUIRE, "agent");
            xb_add(&bar[XB_XGEN(b.x)], 1u);
            asm volatile("s_waitcnt vmcnt(0)" ::: "memory");
        } else {
            XB_SPIN(xb_ld(&bar[XB_XGEN(b.x)]) == gen, bar);
            __builtin_amdgcn_fence(__ATOMIC_ACQUIRE, "agent");
            asm volatile("s_waitcnt vmcnt(0)" ::: "memory");
        }
    }
    __syncthreads();
}

constexpr int LDA = 72;
constexpr int TILE_B = 128 * LDA * 2;
constexpr int STG_LD = 132;
constexpr int LDS_AUX = 139264;
typedef const __attribute__((address_space(1))) unsigned* GPtrU;
typedef __attribute__((address_space(3))) unsigned* LPtrU;
DI int gt_lcol(int t) { return (((t & 7) ^ ((t >> 4) & 7)) * 8); }

template <int WR, int WC, int MI, int NI, class AF, class BF, class EF>
DI void gemm8(char* lds, int nk, AF aptr, BF bptr, EF epi) {
    static_assert(WR * WC == NWAVES && WR * MI * 32 == 256, "wave grid");
    constexpr int NT = WC * NI * 32, A_BYTES = 256 * 128, STAGE = A_BYTES + NT * 128, NB = NT / 64, NP = NT / 128;
    const int tid = ltid(), lane = tid & 63, wave = tid >> 6;
    const int wr = wave / WC, wc = wave % WC;
    f32x16 acc[MI][NI];
#pragma unroll
    for (int a = 0; a < MI; ++a)
#pragma unroll
        for (int b = 0; b < NI; ++b)
#pragma unroll
            for (int r = 0; r < 16; ++r) acc[a][b][r] = 0.f;
#define G8_DMA(kt_, base_) do { char* db_ = (base_) + tid * 16; \
        _Pragma("unroll") for (int i_ = 0; i_ < 4; ++i_) __builtin_amdgcn_global_load_lds((GPtrU)aptr(i_, kt_), (LPtrU)(db_ + i_ * 8192), 16, 0, 0); \
        _Pragma("unroll") for (int i_ = 0; i_ < NB; ++i_) __builtin_amdgcn_global_load_lds((GPtrU)bptr(i_, kt_), (LPtrU)(db_ + A_BYTES + i_ * 8192), 16, 0, 0); } while (0)
#define G8_KS(cb_, ao_, bo_) do { bf16x8 af_[MI], bf_[NI]; \
        _Pragma("unroll") for (int m_ = 0; m_ < MI; ++m_) af_[m_] = *(const bf16x8*)((cb_) + (ao_) + m_ * 4096); \
        _Pragma("unroll") for (int n_ = 0; n_ < NI; ++n_) bf_[n_] = *(const bf16x8*)((cb_) + (bo_) + n_ * 4096); \
        _Pragma("unroll") for (int m_ = 0; m_ < MI; ++m_) _Pragma("unroll") for (int n_ = 0; n_ < NI; ++n_) acc[m_][n_] = MFMA32(af_[m_], bf_[n_], acc[m_][n_]); } while (0)
    const int ln = lane & 31, hf = lane >> 5, sw = (ln >> 1) & 7;
    const int arow = (wr * MI * 32 + ln) * 128, brow = A_BYTES + (wc * NI * 32 + ln) * 128;
    int ao0 = arow + ((0 + hf) ^ sw) * 16, ao1 = arow + ((2 + hf) ^ sw) * 16, ao2 = arow + ((4 + hf) ^ sw) * 16, ao3 = arow + ((6 + hf) ^ sw) * 16;
    int bo0 = brow + ((0 + hf) ^ sw) * 16, bo1 = brow + ((2 + hf) ^ sw) * 16, bo2 = brow + ((4 + hf) ^ sw) * 16, bo3 = brow + ((6 + hf) ^ sw) * 16;
    asm volatile("" : "+v"(ao0), "+v"(ao1), "+v"(ao2), "+v"(ao3), "+v"(bo0), "+v"(bo1), "+v"(bo2), "+v"(bo3));
    G8_DMA(0, lds);
    asm volatile("s_waitcnt vmcnt(0)" ::: "memory");
    __syncthreads();
    int buf = 0;
#pragma unroll 1
    for (int kt = 0; kt < nk - 1; ++kt) {
        G8_DMA(kt + 1, lds + (buf ^ 1) * STAGE);
        const char* cb = lds + buf * STAGE;
        G8_KS(cb, ao0, bo0); G8_KS(cb, ao1, bo1); G8_KS(cb, ao2, bo2); G8_KS(cb, ao3, bo3);
        asm volatile("s_waitcnt vmcnt(0)" ::: "memory");
        __syncthreads();
        buf ^= 1;
    }
    {
        const char* cb = lds + buf * STAGE;
        G8_KS(cb, ao0, bo0); G8_KS(cb, ao1, bo1); G8_KS(cb, ao2, bo2); G8_KS(cb, ao3, bo3);
    }
    __syncthreads();
#undef G8_DMA
#undef G8_KS
    float* stg = (float*)lds;
    int w_off = (wr * MI * 32 + 4 * (lane >> 5)) * STG_LD + ((wc * NI * 32) & 127) + (lane & 31);
    asm volatile("" : "+v"(w_off));
#pragma unroll
    for (int p = 0; p < NP; ++p) {
        if (((wc * NI * 32) >> 7) == p) {
#pragma unroll
            for (int m = 0; m < MI; ++m)
#pragma unroll
                for (int n = 0; n < NI; ++n)
#pragma unroll
                    for (int r = 0; r < 16; ++r)
                        stg[w_off + (m * 32 + (r & 3) + 8 * (r >> 2)) * STG_LD + n * 32] = acc[m][n][r];
        }
        __syncthreads();
        epi((const float*)stg, p);
        __syncthreads();
    }
}
template <class F> DI void epi_rows8(const float* stg, F f) {
    const int tid0 = ltid();
#pragma unroll
    for (int it = 0; it < 8; ++it) {
        const int idx = it * NTHREADS + tid0;
        const int r = idx >> 4, c0 = (idx & 15) * 8;
        const float4 p = *(const float4*)(stg + r * STG_LD + c0);
        const float4 q = *(const float4*)(stg + r * STG_LD + c0 + 4);
        const float v[8] = {p.x, p.y, p.z, p.w, q.x, q.y, q.z, q.w};
        f(r, c0, v);
    }
}
template <class T, class L, class F> DI void epi_rows8_pre(const float* stg, L loadf, F f) {
    const int tid0 = ltid();
    constexpr int BATCH = sizeof(T) > 16 ? 2 : 4;
#pragma unroll
    for (int h = 0; h < 8 / BATCH; ++h) {
        T pre[BATCH];
#pragma unroll
        for (int it = 0; it < BATCH; ++it) { const int idx = (h * BATCH + it) * NTHREADS + tid0; pre[it] = loadf(idx >> 4, (idx & 15) * 8); }
#pragma unroll
        for (int it = 0; it < BATCH; ++it) {
            const int idx = (h * BATCH + it) * NTHREADS + tid0;
            const int r = idx >> 4, c0 = (idx & 15) * 8;
            const float4 p = *(const float4*)(stg + r * STG_LD + c0);
            const float4 q = *(const float4*)(stg + r * STG_LD + c0 + 4);
            const float v[8] = {p.x, p.y, p.z, p.w, q.x, q.y, q.z, q.w};
            f(r, c0, v, pre[it]);
        }
    }
}
struct F8 { float4 a, b; };
DI void tile_remap(int L, int nM, int nN, int& pm, int& pn) {
    const int ntiles = nM * nN;
    int w = L;
    if ((ntiles & 7) == 0) w = (L & 7) * (ntiles >> 3) + (L >> 3);
    const int nig = 8 * nN, gid = w / nig, fm = gid * 8, rem = w - gid * nig;
    const int gsz = (nM - fm) < 8 ? (nM - fm) : 8;
    pm = fm + rem % gsz; pn = rem / gsz;
}
struct RowLoader {
    const bfr* p; size_t ld;
    DI RowLoader(const bfr* base, int row0, size_t ld_) : ld(ld_) { const int t = ltid(); p = base + (size_t)(row0 + (t >> 3)) * ld_ + gt_lcol(t); }
    DI const bfr* operator()(int i, int kt) const { return p + (size_t)(64 * i) * ld + kt * 64; }
};
#define GEMM256 gemm8<2, 4, 4, 2>
#define GEMM128 gemm8<4, 2, 2, 2>
struct G4 { char* lds; int tid; int vb; int nvb; volatile LAS unsigned* cnt; };
constexpr int G4_LDS = 77824;
constexpr int G4_AUX = 73728;
constexpr int G4_TILE = 128 * 128;
DI G4 g4_make(char* lds) {
    G4 g; const int t = ltid(); const int grp = t >> 8;
    g.lds = lds + grp * G4_LDS; g.tid = t & 255; g.vb = blockIdx.x * 2 + grp; g.nvb = gridDim.x * 2;
    g.cnt = (volatile LAS unsigned*)(lds + LDS_BYTES - 32) + grp;
    return g;
}
DI void g4_bar(const G4& G) {
    asm volatile("s_waitcnt lgkmcnt(0)" ::: "memory");
    unsigned target = 0;
    if ((G.tid & 63) == 0) {
        const unsigned old = __hip_atomic_fetch_add((LAS unsigned*)G.cnt, 1u, __ATOMIC_RELAXED, __HIP_MEMORY_SCOPE_WORKGROUP);
        target = (old & ~3u) + 4u;
    }
    target = __builtin_amdgcn_readfirstlane(target);
    while ((int)(*G.cnt - target) < 0) __builtin_amdgcn_s_sleep(1);
    asm volatile("" ::: "memory");
}
template <class F> DI void g4_epi_rows8(const G4& G, const float* stg, F f) {
#pragma unroll
    for (int it = 0; it < 8; ++it) {
        const int idx = it * 256 + G.tid;
        const int r = idx >> 4, c0 = (idx & 15) * 8;
        const float4 p = *(const float4*)(stg + r * STG_LD + c0);
        const float4 q = *(const float4*)(stg + r * STG_LD + c0 + 4);
        const float v[8] = {p.x, p.y, p.z, p.w, q.x, q.y, q.z, q.w};
        f(r, c0, v);
    }
}
template <class T, class L, class F> DI void g4_epi_rows8_pre(const G4& G, const float* stg, L loadf, F f) {
    T pre[8];
#pragma unroll
    for (int it = 0; it < 8; ++it) { const int idx = it * 256 + G.tid; pre[it] = loadf(idx >> 4, (idx & 15) * 8); }
#pragma unroll
    for (int it = 0; it < 8; ++it) {
        const int idx = it * 256 + G.tid;
        const int r = idx >> 4, c0 = (idx & 15) * 8;
        const float4 p = *(const float4*)(stg + r * STG_LD + c0);
        const float4 q = *(const float4*)(stg + r * STG_LD + c0 + 4);
        const float v[8] = {p.x, p.y, p.z, p.w, q.x, q.y, q.z, q.w};
        f(r, c0, v, pre[it]);
    }
}
struct G4RowLoader {
    const bfr* p; size_t ld;
    DI G4RowLoader(const G4& G, const bfr* base, int row0, size_t ld_) : ld(ld_) { p = base + (size_t)(row0 + (G.tid >> 3)) * ld_ + gt_lcol(G.tid); }
    DI const bfr* operator()(int i, int kt) const { return p + (size_t)(32 * i) * ld + kt * 64; }
};
template <class AF, class BF, class EF>
DI void g4_gemm_tile(const G4& G, char* lds, int nk, AF aptr, BF bptr, EF epi) {
    const int tid = G.tid, lane = tid & 63, wave = tid >> 6;
    const int wr = wave >> 1, wc = wave & 1;
    f32x16 acc00, acc01, acc10, acc11;
#pragma unroll
    for (int r = 0; r < 16; ++r) { acc00[r] = 0.f; acc01[r] = 0.f; acc10[r] = 0.f; acc11[r] = 0.f; }
#define GT_DMA(kt_, base_) do { char* db_ = (base_) + tid * 16; _Pragma("unroll") for (int i_ = 0; i_ < 4; ++i_) { \
        __builtin_amdgcn_global_load_lds((GPtrU)aptr(i_, kt_), (LPtrU)(db_ + i_ * 4096), 16, 0, 0); \
        __builtin_amdgcn_global_load_lds((GPtrU)bptr(i_, kt_), (LPtrU)(db_ + G4_TILE + i_ * 4096), 16, 0, 0); } } while (0)
#define GT_FRAG(cb_, off_) (*(const bf16x8*)((cb_) + (off_)))
#define GT_COMPUTE(base_) do { const char* cb_ = (base_); \
        { const bf16x8 a0 = GT_FRAG(cb_, ao0), a1 = GT_FRAG(cb_, ao0 + 4096), b0 = GT_FRAG(cb_, bo0), b1 = GT_FRAG(cb_, bo0 + 4096); \
          acc00 = MFMA32(a0, b0, acc00); acc01 = MFMA32(a0, b1, acc01); acc10 = MFMA32(a1, b0, acc10); acc11 = MFMA32(a1, b1, acc11); } \
        { const bf16x8 a0 = GT_FRAG(cb_, ao1), a1 = GT_FRAG(cb_, ao1 + 4096), b0 = GT_FRAG(cb_, bo1), b1 = GT_FRAG(cb_, bo1 + 4096); \
          acc00 = MFMA32(a0, b0, acc00); acc01 = MFMA32(a0, b1, acc01); acc10 = MFMA32(a1, b0, acc10); acc11 = MFMA32(a1, b1, acc11); } \
        { const bf16x8 a0 = GT_FRAG(cb_, ao2), a1 = GT_FRAG(cb_, ao2 + 4096), b0 = GT_FRAG(cb_, bo2), b1 = GT_FRAG(cb_, bo2 + 4096); \
          acc00 = MFMA32(a0, b0, acc00); acc01 = MFMA32(a0, b1, acc01); acc10 = MFMA32(a1, b0, acc10); acc11 = MFMA32(a1, b1, acc11); } \
        { const bf16x8 a0 = GT_FRAG(cb_, ao3), a1 = GT_FRAG(cb_, ao3 + 4096), b0 = GT_FRAG(cb_, bo3), b1 = GT_FRAG(cb_, bo3 + 4096); \
          acc00 = MFMA32(a0, b0, acc00); acc01 = MFMA32(a0, b1, acc01); acc10 = MFMA32(a1, b0, acc10); acc11 = MFMA32(a1, b1, acc11); } } while (0)
    const int ln = lane & 31, hf = lane >> 5, sw = (ln >> 1) & 7;
    int ao0 = wr * 8192 + ln * 128 + ((0 + hf) ^ sw) * 16, ao1 = wr * 8192 + ln * 128 + ((2 + hf) ^ sw) * 16;
    int ao2 = wr * 8192 + ln * 128 + ((4 + hf) ^ sw) * 16, ao3 = wr * 8192 + ln * 128 + ((6 + hf) ^ sw) * 16;
    int bo0 = G4_TILE + wc * 8192 + ln * 128 + ((0 + hf) ^ sw) * 16, bo1 = G4_TILE + wc * 8192 + ln * 128 + ((2 + hf) ^ sw) * 16;
    int bo2 = G4_TILE + wc * 8192 + ln * 128 + ((4 + hf) ^ sw) * 16, bo3 = G4_TILE + wc * 8192 + ln * 128 + ((6 + hf) ^ sw) * 16;
    asm volatile("" : "+v"(ao0), "+v"(ao1), "+v"(ao2), "+v"(ao3), "+v"(bo0), "+v"(bo1), "+v"(bo2), "+v"(bo3));
    GT_DMA(0, lds);
    asm volatile("s_waitcnt vmcnt(0)" ::: "memory");
    g4_bar(G);
    int buf = 0;
#pragma unroll 1
    for (int kt = 0; kt < nk - 1; ++kt) {
        GT_DMA(kt + 1, lds + (buf ^ 1) * (2 * G4_TILE));
        GT_COMPUTE(lds + buf * (2 * G4_TILE));
        asm volatile("s_waitcnt vmcnt(0)" ::: "memory");
        g4_bar(G);
        buf ^= 1;
    }
    GT_COMPUTE(lds + buf * (2 * G4_TILE));
    g4_bar(G);
#undef GT_DMA
#undef GT_FRAG
#undef GT_COMPUTE
    float* stg = (float*)lds;
    int w_off = (wr * 64 + 4 * (lane >> 5)) * STG_LD + wc * 64 + (lane & 31);
    asm volatile("" : "+v"(w_off));
#pragma unroll
    for (int r = 0; r < 16; ++r) {
        const int ro = ((r & 3) + 8 * (r >> 2)) * STG_LD;
        stg[w_off + ro] = acc00[r];
        stg[w_off + ro + 32] = acc01[r];
        stg[w_off + ro + 32 * STG_LD] = acc10[r];
        stg[w_off + ro + 32 * STG_LD + 32] = acc11[r];
    }
    g4_bar(G);
    epi((const float*)stg);
    g4_bar(G);
}

DI void g4_attn_item(const G4& G, char* lds, const Ctx& P, int b, int h, int qt, float lam, float lam_init, const float* subln) {
    const bfr* qn = (const bfr*)(P.ws + OFF_QN);
    const bfr* kn = (const bfr*)(P.ws + OFF_KN);
    const bfr* vT = (const bfr*)(P.ws + OFF_VT) + (size_t)(b * 4 + h) * 128 * SEQ;
    bfr* am = (bfr*)(P.ws + OFF_AMIX);
    const int tid = G.tid, lane = tid & 63, wave = tid >> 6;
    const int m = wave >> 1, qw = (wave & 1) * 32;
    const int q0 = qt * 64 + qw;
    const int ln = lane & 31, hf = lane >> 5;
    bf16x8 qf[4];
    {
        const bfr* qp = qn + ((size_t)b * SEQ + q0 + ln) * 512 + h * 128 + m * 64 + hf * 8;
#pragma unroll
        for (int ks = 0; ks < 4; ++ks) qf[ks] = *(const bf16x8*)(qp + ks * 16);
    }
    f32x16 o[4];
#pragma unroll
    for (int d = 0; d < 4; ++d)
#pragma unroll
        for (int r = 0; r < 16; ++r) o[d][r] = 0.f;
    float mrun = -INFINITY, lrun = 0.f;
    const int nkt = qt + 1;
    const int lrow = tid >> 3, lcol = (tid & 7) * 8;
    const bfr* kbase = kn + ((size_t)b * SEQ) * 512 + h * 128;
    unsigned ko = (unsigned)(lrow * 512 + lcol) * 2u, vo = (unsigned)(lrow * SEQ + lcol) * 2u;
    asm volatile("" : "+v"(ko), "+v"(vo));
    uint4 rk0, rk1, rk2, rk3, rv0, rv1, rv2, rv3;
#define ATT_GLOAD(kt_) do { const char* kp_ = (const char*)(kbase + (size_t)(kt_) * (64 * 512)); const char* vp_ = (const char*)(vT + (kt_) * 64); \
        rk0 = *(const uint4*)(kp_ + ko); rk1 = *(const uint4*)(kp_ + 32 * 512 * 2 + ko); rk2 = *(const uint4*)(kp_ + 64 * 2 + ko); rk3 = *(const uint4*)(kp_ + 32 * 512 * 2 + 64 * 2 + ko); \
        rv0 = *(const uint4*)(vp_ + vo); rv1 = *(const uint4*)(vp_ + 32 * SEQ * 2 + vo); rv2 = *(const uint4*)(vp_ + 64 * SEQ * 2 + vo); rv3 = *(const uint4*)(vp_ + 96 * SEQ * 2 + vo); } while (0)
#define ATT_S1(base_, i_, RK, RV) { *(uint4*)((base_) + (32 * (i_)) * LDA * 2) = RK; \
        *(uint4*)((base_) + TILE_B + (32 * (i_)) * LDA * 2) = RV; }
#define ATT_LSTORE(buf_) do { char* base_ = lds + (buf_) * (2 * TILE_B) + s_off; ATT_S1(base_, 0, rk0, rv0) ATT_S1(base_, 1, rk1, rv1) ATT_S1(base_, 2, rk2, rv2) ATT_S1(base_, 3, rk3, rv3) } while (0)
    int k_off = ((m * 64 + ln) * LDA + hf * 8) * 2;
    int v_off = TILE_B + (ln * LDA + 4 * hf) * 2;
    int s_off = (lrow * LDA + lcol) * 2;
    asm volatile("" : "+v"(k_off), "+v"(v_off), "+v"(s_off));
    ATT_GLOAD(0); ATT_LSTORE(0);
    g4_bar(G);
    int buf = 0;
#pragma unroll 1
    for (int kt = 0; kt < nkt; ++kt) {
        const bool more = (kt + 1 < nkt);
        const char* ks_ = lds + buf * (2 * TILE_B) + k_off;
        const char* vs_ = lds + buf * (2 * TILE_B) + v_off;
        if (kt * 64 <= q0 + 31) {
            f32x16 s[2];
#pragma unroll
            for (int kb = 0; kb < 2; ++kb) {
#pragma unroll
                for (int r = 0; r < 16; ++r) s[kb][r] = 0.f;
#pragma unroll
                for (int ks = 0; ks < 4; ++ks) {
                    const bf16x8 kf = *(const bf16x8*)(ks_ + ((kb * 32) * LDA + ks * 16) * 2);
                    s[kb] = MFMA32(kf, qf[ks], s[kb]);
                }
            }
            const int qpos = q0 + ln;
            if (kt * 64 + 63 > q0) {
#pragma unroll
                for (int kb = 0; kb < 2; ++kb)
#pragma unroll
                    for (int r = 0; r < 16; ++r) {
                        const int key = kt * 64 + kb * 32 + (r & 3) + 8 * (r >> 2) + 4 * hf;
                        if (key > qpos) s[kb][r] = -INFINITY;
                    }
            }
            float mx = s[0][0];
#pragma unroll
            for (int kb = 0; kb < 2; ++kb)
#pragma unroll
                for (int r = 0; r < 16; ++r) mx = fmaxf(mx, s[kb][r]);
            mx = fmaxf(mx, __shfl_xor(mx, 32));
            const float mnew = fmaxf(mrun, mx);
            const float alpha = __builtin_amdgcn_exp2f(mrun - mnew);
            mrun = mnew;
            float rsum = 0.f;
#pragma unroll
            for (int kb = 0; kb < 2; ++kb)
#pragma unroll
                for (int r = 0; r < 16; ++r) { const float p = __builtin_amdgcn_exp2f(s[kb][r] - mnew); s[kb][r] = p; rsum += p; }
            lrun = lrun * alpha + rsum;
#pragma unroll
            for (int d = 0; d < 4; ++d)
#pragma unroll
                for (int r = 0; r < 16; ++r) o[d][r] *= alpha;
            __builtin_amdgcn_sched_barrier(0);
            if (more) ATT_GLOAD(kt + 1);
#pragma unroll
            for (int kb = 0; kb < 2; ++kb)
#pragma unroll
                for (int st = 0; st < 2; ++st) {
                    const uint4 pp = make_uint4(pk2(s[kb][8 * st + 0], s[kb][8 * st + 1]), pk2(s[kb][8 * st + 2], s[kb][8 * st + 3]),
                                                pk2(s[kb][8 * st + 4], s[kb][8 * st + 5]), pk2(s[kb][8 * st + 6], s[kb][8 * st + 7]));
                    const bf16x8 pf = __builtin_bit_cast(bf16x8, pp);
                    const int kc = kb * 32 + 16 * st;
#pragma unroll
                    for (int d = 0; d < 4; ++d) {
                        const uint2 v0 = *(const uint2*)(vs_ + ((d * 32) * LDA + kc) * 2);
                        const uint2 v1 = *(const uint2*)(vs_ + ((d * 32) * LDA + kc + 8) * 2);
                        const bf16x8 vf = __builtin_bit_cast(bf16x8, make_uint4(v0.x, v0.y, v1.x, v1.y));
                        o[d] = MFMA32(vf, pf, o[d]);
                    }
                }
        }
        else if (more) ATT_GLOAD(kt + 1);
        if (more) ATT_LSTORE(buf ^ 1);
        g4_bar(G);
        buf ^= 1;
    }
    const float ltot = lrun + __shfl_xor(lrun, 32);
    const float linv = 1.0f / ltot;
    float* ob = (float*)lds;
    int o_off = (m * 64 + qw + ln) * 129 + 4 * hf;
    asm volatile("" : "+v"(o_off));
#pragma unroll
    for (int d = 0; d < 4; ++d)
#pragma unroll
        for (int r = 0; r < 16; ++r) ob[o_off + d * 32 + (r & 3) + 8 * (r >> 2)] = o[d][r] * linv;
    g4_bar(G);
#pragma unroll
    for (int it = 0; it < 4; ++it) {
        const int idx = it * 256 + tid;
        const int q = idx >> 4, c0 = (idx & 15) * 8;
        float v[8];
        float ss = 0.f;
        int r_off = q * 129 + c0;
        asm volatile("" : "+v"(r_off));
#pragma unroll
        for (int j = 0; j < 8; ++j) { v[j] = ob[r_off + j] - lam * ob[r_off + 64 * 129 + j]; ss += v[j] * v[j]; }
        ss = row16_sum(ss);
        const float rs = rsqrtf(ss * (1.0f / 128.0f) + 1e-5f) * (1.0f - lam_init);
#pragma unroll
        for (int j = 0; j < 8; ++j) v[j] = v[j] * rs * subln[c0 + j];
        *(uint4*)(am + ((size_t)b * SEQ + qt * 64 + q) * 1024 + h * 128 + c0) = pack8(v);
    }
    g4_bar(G);
}

#undef ATT_GLOAD
#undef ATT_S1
#undef ATT_LSTORE
#undef ATT_OFF
#undef ATT_G1
DI int cvt_rowmap(int n, int mode) { return mode == 0 ? n : ((n >> 2) * 8 + (n & 3) + (mode == 2 ? 4 : 0)); }
DI void cvt_tile(char* lds, const float* __restrict__ src, int N, bfr* __restrict__ dst, int ldd, int k0, int n0, int mode) {
    float* t = (float*)lds;
    const int tid = ltid();
    const int r = tid >> 5, c = (tid & 31) * 4;
#pragma unroll
    for (int i = 0; i < 4; ++i) {
        const float4 v = *(const float4*)(src + (size_t)(k0 + r + 16 * i) * N + n0 + c);
        float* d = t + (r + 16 * i) * 129 + c;
        d[0] = v.x; d[1] = v.y; d[2] = v.z; d[3] = v.w;
    }
    __syncthreads();
#pragma unroll
    for (int i = 0; i < 2; ++i) {
        const int idx = tid + i * NTHREADS;
        const int n = idx & 127, kg = idx >> 7;
        float v[8];
#pragma unroll
        for (int j = 0; j < 8; ++j) v[j] = t[(kg * 8 + j) * 129 + n];
        *(uint4*)(dst + (size_t)cvt_rowmap(n0 + n, mode) * ldd + k0 + kg * 8) = pack8(v);
    }
    __syncthreads();
}
DI void cvt_matrix(char* lds, const float* src, int K, int N, bfr* dst, int ldd, int mode, int worker, int nworkers, unsigned& base) {
    if (worker < 0) return;
    const int ntn = N >> 7, ntiles = (K >> 6) * ntn;
    int t0 = (int)(((unsigned)worker + (unsigned)nworkers - (base % (unsigned)nworkers)) % (unsigned)nworkers);
    for (int t = t0; t < ntiles; t += nworkers) cvt_tile(lds, src, N, dst, ldd, (t / ntn) * 64, (t % ntn) * 128, mode);
    base += (unsigned)ntiles;
}
struct CvtTile { const float* src; bfr* dst; int N, ldd, mode; };
DI CvtTile moe_cvt_tile(const Ctx& P, int layer, int t) {
    const int e = t / 192, r = t % 192, m = r >> 6, q = r & 63;
    const size_t we = (size_t)(layer * 32 + e);
    CvtTile c;
    if (m < 2) {
        const int k0 = (q >> 2) * 64, n0 = (q & 3) * 128;
        c.src = P.in[m == 0 ? I_MWGATE : I_MWUP] + we * 1024 * 512 + (size_t)k0 * 512 + n0; c.N = 512;
        c.dst = (bfr*)(P.ws + OFF_MWGU) + (size_t)e * 1024 * 1024 + k0; c.ldd = 1024; c.mode = 1 + m;
        c.dst += (size_t)0; c.mode |= (n0 << 8);
    } else {
        const int k0 = (q >> 3) * 64, n0 = (q & 7) * 128;
        c.src = P.in[I_MWDOWN] + we * 512 * 1024 + (size_t)k0 * 1024 + n0; c.N = 1024;
        c.dst = (bfr*)(P.ws + OFF_MWD) + (size_t)e * 1024 * 512 + k0; c.ldd = 512; c.mode = (n0 << 8);
    }
    return c;
}
DI void moe_convert_range(char* lds, const Ctx& P, int layer, int t_begin, int t_end) {
    if (t_begin >= t_end) return;
    float* tl = (float*)lds;
    const int tid = ltid();
    const int r = tid >> 5, c4 = (tid & 31) * 4;
    CvtTile cur = moe_cvt_tile(P, layer, t_begin);
    float4 v0, v1, v2, v3;
#define CVT_LOAD(ct_) do { const float* s_ = (ct_).src + (size_t)r * (ct_).N + c4; \
        v0 = *(const float4*)(s_); v1 = *(const float4*)(s_ + (size_t)16 * (ct_).N); v2 = *(const float4*)(s_ + (size_t)32 * (ct_).N); v3 = *(const float4*)(s_ + (size_t)48 * (ct_).N); } while (0)
    CVT_LOAD(cur);
    for (int t = t_begin; t < t_end; ++t) {
        { float* d = tl + r * 129 + c4;
          d[0] = v0.x; d[1] = v0.y; d[2] = v0.z; d[3] = v0.w; d += 16 * 129; d[0] = v1.x; d[1] = v1.y; d[2] = v1.z; d[3] = v1.w;
          d += 16 * 129; d[0] = v2.x; d[1] = v2.y; d[2] = v2.z; d[3] = v2.w; d += 16 * 129; d[0] = v3.x; d[1] = v3.y; d[2] = v3.z; d[3] = v3.w; }
        const CvtTile me = cur;
        if (t + 1 < t_end) { cur = moe_cvt_tile(P, layer, t + 1); CVT_LOAD(cur); }
        __syncthreads();
        const int mode = me.mode & 255, n0 = me.mode >> 8;
#pragma unroll
        for (int i = 0; i < 2; ++i) {
            const int idx = tid + i * NTHREADS;
            const int n = idx & 127, kg = idx >> 7;
            float v[8];
#pragma unroll
            for (int j = 0; j < 8; ++j) v[j] = tl[(kg * 8 + j) * 129 + n];
            *(uint4*)(me.dst + (size_t)cvt_rowmap(n0 + n, mode) * me.ldd + kg * 8) = pack8(v);
        }
        __syncthreads();
    }
#undef CVT_LOAD
}
DI void s5_tables(char* lds, const Ctx& P, int i, int g) {
    float2* pw = (float2*)lds;
    float2* bb = pw + 64 * 33;
    float2* cm = bb + 64 * 16;
    float*  kt = (float*)(cm + 16 * 64);
    const int tid = ltid();
    const size_t gp = (size_t)(i * 32 + g) * 64;
    for (int idx = tid; idx < 64 * 33; idx += NTHREADS) {
        const int p = idx / 33, tau = idx % 33;
        const float re = fminf(P.in[I_ARE][gp + p], -1e-4f), im = P.in[I_AIM][gp + p];
        const float st = expf(P.in[I_LSTEP][gp + p]);
        const float mag = expf(re * st * (float)tau);
        const double angd = (double)im * (double)st * (double)tau;
        const double red = angd - 6.283185307179586 * floor(angd * 0.15915494309189535);
        float sn, cs; sincosf((float)red, &sn, &cs);
        pw[idx] = make_float2(mag * cs, mag * sn);
    }
    for (int idx = tid; idx < 64 * 16; idx += NTHREADS) {
        const int p = idx >> 4, c = idx & 15;
        const double re = fmin((double)P.in[I_ARE][gp + p], -1e-4), im = (double)P.in[I_AIM][gp + p];
        const double st = exp((double)P.in[I_LSTEP][gp + p]);
        const double mag = exp(re * st), lr = mag * cos(im * st) - 1.0, li = mag * sin(im * st);
        const double den = re * re + im * im;
        const double fr = (lr * re + li * im) / den, fi = (li * re - lr * im) / den;
        const double br = (double)P.in[I_BRE][(gp + p) * 16 + c], bi = (double)P.in[I_BIM][(gp + p) * 16 + c];
        bb[idx] = make_float2((float)(fr * br - fi * bi), (float)(fr * bi + fi * br));
        const int cc = idx >> 6, pp = idx & 63;
        cm[idx] = make_float2(P.in[I_CRE][((size_t)(i * 32 + g) * 16 + cc) * 64 + pp], P.in[I_CIM][((size_t)(i * 32 + g) * 16 + cc) * 64 + pp]);
    }
    __syncthreads();
    for (int idx = tid; idx < 32 * 256; idx += NTHREADS) {
        const int tau = idx >> 8, c1 = (idx >> 4) & 15, c = idx & 15;
        float s = 0.f;
        for (int p = 0; p < 64; ++p) {
            const float2 a = cm[c1 * 64 + p], w = pw[p * 33 + tau], b = bb[p * 16 + c];
            const float tr = a.x * w.x - a.y * w.y, ti = a.x * w.y + a.y * w.x;
            s += tr * b.x - ti * b.y;
        }
        kt[idx] = s;
    }
    __syncthreads();
    bfr* gt = (bfr*)(P.ws + OFF_S5GT) + (size_t)(i * 32 + g) * 512 * 640;
    for (int idx = tid; idx < 512 * 80; idx += NTHREADS) {
        const int n = idx / 80, ch = idx % 80;
        const int t = n >> 4, c1 = n & 15;
        float v[8];
        if (ch < 64) {
            const int s = ch >> 1, c0 = (ch & 1) * 8;
#pragma unroll
            for (int j = 0; j < 8; ++j) v[j] = (t >= s) ? kt[((t - s) * 16 + c1) * 16 + c0 + j] : 0.f;
        } else {
            const int p0 = (ch - 64) * 4;
#pragma unroll
            for (int j = 0; j < 4; ++j) {
                const float2 a = cm[c1 * 64 + p0 + j], w = pw[(p0 + j) * 33 + t + 1];
                v[2 * j] = a.x * w.x - a.y * w.y;
                v[2 * j + 1] = -(a.x * w.y + a.y * w.x);
            }
        }
        *(uint4*)(gt + (size_t)n * 640 + ch * 8) = pack8(v);
    }
    bfr* bl = (bfr*)(P.ws + OFF_S5BL) + (size_t)(i * 32 + g) * 128 * 512;
    for (int idx = tid; idx < 128 * 64; idx += NTHREADS) {
        const int n = idx >> 6, ch = idx & 63;
        const int p = n >> 1, ri = n & 1, s = ch >> 1, c0 = (ch & 1) * 8;
        const float2 w = pw[p * 33 + 31 - s];
        float v[8];
#pragma unroll
        for (int j = 0; j < 8; ++j) { const float2 b = bb[p * 16 + c0 + j]; v[j] = ri ? (w.x * b.y + w.y * b.x) : (w.x * b.x - w.y * b.y); }
        *(uint4*)(bl + (size_t)n * 512 + ch * 8) = pack8(v);
    }
    float* l32 = (float*)(P.ws + OFF_S5L32) + (size_t)(i * 32 + g) * 128;
    if (tid < 64) { l32[2 * tid] = pw[tid * 33 + 32].x; l32[2 * tid + 1] = pw[tid * 33 + 32].y; }
    __syncthreads();
}

DI void norm_rows(const float* __restrict__ x, const float* __restrict__ g, bfr* __restrict__ hb, bfr* __restrict__ hlo, float* __restrict__ xcopy, int tok0, int ntok) {
    const int tid_ = ltid();
    const int lane = tid_ & 63, wave = tid_ >> 6;
    for (int tk = wave; tk < ntok; tk += NWAVES) {
        const size_t tok = (size_t)(tok0 + tk);
        float4 v[4];
        float ss = 0.f;
#pragma unroll
        for (int i = 0; i < 4; ++i) {
            v[i] = *(const float4*)(x + tok * DM + i * 256 + lane * 4);
            ss += v[i].x * v[i].x + v[i].y * v[i].y + v[i].z * v[i].z + v[i].w * v[i].w;
        }
        ss = wave_sum(ss);
        const float rs = rsqrtf(ss * (1.0f / DM) + 1e-6f);
#pragma unroll
        for (int i = 0; i < 4; ++i) {
            const float4 gg = *(const float4*)(g + i * 256 + lane * 4);
            const float h0 = v[i].x * rs * gg.x, h1 = v[i].y * rs * gg.y, h2 = v[i].z * rs * gg.z, h3 = v[i].w * rs * gg.w;
            const unsigned p0 = pk2(h0, h1), p1 = pk2(h2, h3);
            *(uint2*)(hb + tok * DM + i * 256 + lane * 4) = make_uint2(p0, p1);
            if (hlo) {
                const unsigned q0 = pk2(h0 - bflo(p0), h1 - bfhi(p0)), q1 = pk2(h2 - bflo(p1), h3 - bfhi(p1));
                *(uint2*)(hlo + tok * DM + i * 256 + lane * 4) = make_uint2(q0, q1);
            }
            if (xcopy) *(float4*)(xcopy + tok * DM + i * 256 + lane * 4) = v[i];
        }
    }
}
DI void phase_e1(char* lds, const Ctx& P, int li) {
    const bfr* hb = (const bfr*)(P.ws + OFF_HB);
    const bfr* w = (const bfr*)(P.ws + OFF_WINE) + (size_t)li * 2304 * 1024;
    bfr* u = (bfr*)(P.ws + OFF_U);
    const int ntiles = 128 * 9, G = gridDim.x;
    const int full = (ntiles / G) * G, rem = ntiles - full;
    const bool halves = rem > 0 && 2 * rem <= G;
    for (int t = blockIdx.x; t < (halves ? full : ntiles); t += G) {
        int mt, nt; tile_remap(t, 128, 9, mt, nt);
        RowLoader A(hb, mt * 256, 1024), B(w, nt * 256, 1024);
        GEMM256(lds, 16, A, B, [&](const float* stg, int p) __attribute__((always_inline)) {
            epi_rows8(stg, [&](int r, int c0, const float (&v)[8]) __attribute__((always_inline)) {
                *(uint4*)(u + (size_t)(mt * 256 + r) * EVEN_IN + nt * 256 + p * 128 + c0) = pack8(v);
            });
        });
    }
    if (halves && (int)blockIdx.x < 2 * rem) {
        int mt, nt; tile_remap(full + ((int)blockIdx.x >> 1), 128, 9, mt, nt);
        const int hc = (blockIdx.x & 1) * 128;
        RowLoader A(hb, mt * 256, 1024), B(w, nt * 256 + hc, 1024);
        GEMM128(lds, 16, A, B, [&](const float* stg, int) __attribute__((always_inline)) {
            epi_rows8(stg, [&](int r, int c0, const float (&v)[8]) __attribute__((always_inline)) {
                *(uint4*)(u + (size_t)(mt * 256 + r) * EVEN_IN + nt * 256 + hc + c0) = pack8(v);
            });
        });
    }
}

DI void phase_e2a(const Ctx& P, int li) {
    const bfr* u = (const bfr*)(P.ws + OFF_U);
    const float* mu = P.in[I_MU] + (size_t)li * 1792;
    bfr* S = (bfr*)(P.ws + OFF_S);
    bfr* mv = (bfr*)(P.ws + (li == 0 ? OFF_VFIRST : OFF_MV2));
    bfr* dpool = (bfr*)(P.ws + OFF_DPOOL);
    const int total = NTOK * 160;
    for (int idx = blockIdx.x * NTHREADS + ltid(); idx < total; idx += gridDim.x * NTHREADS) {
        const int tok = idx / 160, ch = idx % 160;
        const int col = 1024 + ch * 8;
        const int t = tok & (SEQ - 1);
        const bfr* row = u + (size_t)tok * EVEN_IN;
        float cur[8];
        unpack8(*(const uint4*)(row + col), cur);
        if (col < 1792) {
            float prv[8], m[8];
            if (t > 0) unpack8(*(const uint4*)(row - EVEN_IN + col), prv);
            else {
#pragma unroll
                for (int j = 0; j < 8; ++j) prv[j] = 0.f;
            }
            const float4 m0 = *(const float4*)(mu + col), m1 = *(const float4*)(mu + col + 4);
            const float mm[8] = {m0.x, m0.y, m0.z, m0.w, m1.x, m1.y, m1.z, m1.w};
#pragma unroll
            for (int j = 0; j < 8; ++j) m[j] = cur[j] + (prv[j] - cur[j]) * mm[j];
            if (col < 1536) {
                *(uint4*)(mv + (size_t)tok * 512 + (col - 1024)) = pack8(m);
            } else if (col < 1600) {
#pragma unroll
                for (int j = 0; j < 8; ++j) m[j] = ftanh(m[j]);
                *(uint4*)(S + (size_t)tok * 256 + (col - 1536)) = pack8(m);
            } else if (col < 1664) {
                *(uint4*)(S + (size_t)tok * 256 + 64 + (col - 1600)) = pack8(m);
            } else {
#pragma unroll
                for (int j = 0; j < 8; ++j) m[j] = sigmoidf_(m[j]);
                *(uint4*)(S + (size_t)tok * 256 + 128 + (col - 1664)) = pack8(m);
            }
        } else {
            const int gi = (col - 1792) >> 7;
            const int win = 2 << gi;
            const int nw = (t + 1 < win) ? (t + 1) : win;
            float acc[8];
#pragma unroll
            for (int j = 0; j < 8; ++j) acc[j] = cur[j];
#define POOL_WIN(W) { uint4 pv[W - 1]; _Pragma("unroll") for (int s = 1; s < W; ++s) pv[s - 1] = *(const uint4*)(row - (size_t)(s < nw ? s : 0) * EVEN_IN + col); \
                      _Pragma("unroll") for (int s = 1; s < W; ++s) { float pq[8]; unpack8(pv[s - 1], pq); const float wgt = s < nw ? 1.f : 0.f; \
                          _Pragma("unroll") for (int j = 0; j < 8; ++j) acc[j] += wgt * pq[j]; } }
            if (gi == 0) POOL_WIN(2) else if (gi == 1) POOL_WIN(4) else if (gi == 2) POOL_WIN(8) else POOL_WIN(16)
#undef POOL_WIN
            const float inv = frcp((float)nw);
#pragma unroll
            for (int j = 0; j < 8; ++j) acc[j] = acc[j] * inv - cur[j];
            *(uint4*)(dpool + (size_t)tok * 512 + (col - 1792)) = pack8(acc);
        }
    }
}

DI void phase_e2b(char* lds, const Ctx& P, int li) {
    const bfr* S = (const bfr*)(P.ws + OFF_S);
    const int njobs = (li == 1) ? 20 : 16;
    for (int t = blockIdx.x; t < 128 * njobs; t += gridDim.x) {
        const int mt = t / njobs, j = t % njobs;
        const int job = j >> 2, nt = j & 3;
        const int m0 = mt * 256;
        if (job == 0) {
            RowLoader A(S, m0, 256), B((const bfr*)(P.ws + OFF_W2T) + (size_t)li * 512 * 64, nt * 128, 64);
            const float* w0 = P.in[I_W0] + li * 512;
            float* dlog = (float*)(P.ws + OFF_DLOG);
            GEMM128(lds, 1, A, B, [&](const float* stg, int) __attribute__((always_inline)) {
                epi_rows8(stg, [&](int r, int c0, const float (&v)[8]) __attribute__((always_inline)) {
                    float o[8];
#pragma unroll
                    for (int q = 0; q < 8; ++q) {
                        const float z = -(w0[nt * 128 + c0 + q] + v[q]);
                        o[q] = -fexp(-fsoftplus(z) - 0.5f);
                    }
                    float* d = dlog + (size_t)(m0 + r) * 512 + nt * 128 + c0;
                    *(float4*)d = make_float4(o[0], o[1], o[2], o[3]); *(float4*)(d + 4) = make_float4(o[4], o[5], o[6], o[7]);
                });
            });
        } else if (job == 1) {
            RowLoader A(S + 64, m0, 256), B((const bfr*)(P.ws + OFF_A2T) + (size_t)li * 512 * 64, nt * 128, 64);
            const float* a0 = P.in[I_A0] + li * 512;
            bfr* ab = (bfr*)(P.ws + OFF_ABUF);
            GEMM128(lds, 1, A, B, [&](const float* stg, int) __attribute__((always_inline)) {
                epi_rows8(stg, [&](int r, int c0, const float (&v)[8]) __attribute__((always_inline)) {
                    float o[8];
#pragma unroll
                    for (int q = 0; q < 8; ++q) o[q] = sigmoidf_(a0[nt * 128 + c0 + q] + v[q]);
                    *(uint4*)(ab + (size_t)(m0 + r) * 512 + nt * 128 + c0) = pack8(o);
                });
            });
        } else if (job == 2) {
            RowLoader A(S + 128, m0, 256), B((const bfr*)(P.ws + OFF_G2T) + (size_t)li * 512 * 128, nt * 128, 128);
            bfr* gb = (bfr*)(P.ws + OFF_GBUF);
            GEMM128(lds, 2, A, B, [&](const float* stg, int) __attribute__((always_inline)) {
                epi_rows8(stg, [&](int r, int c0, const float (&v)[8]) __attribute__((always_inline)) {
                    *(uint4*)(gb + (size_t)(m0 + r) * 512 + nt * 128 + c0) = pack8(v);
                });
            });
        } else if (job == 3) {
            RowLoader A((const bfr*)(P.ws + OFF_DPOOL) + nt * 128, m0, 512), B((const bfr*)(P.ws + OFF_POOLT) + (size_t)(li * 4 + nt) * 128 * 128, 0, 128);
            const float* ps = P.in[I_POOLS] + li * 512 + nt * 128;
            bfr* am = (bfr*)(P.ws + OFF_AMIX);
            GEMM128(lds, 2, A, B, [&](const float* stg, int) __attribute__((always_inline)) {
                epi_rows8(stg, [&](int r, int c0, const float (&v)[8]) __attribute__((always_inline)) {
                    float o[8];
#pragma unroll
                    for (int q = 0; q < 8; ++q) o[q] = v[q] * ps[c0 + q];
                    *(uint4*)(am + (size_t)(m0 + r) * 1024 + 512 + nt * 128 + c0) = pack8(o);
                });
            });
        } else {
            RowLoader A((const bfr*)(P.ws + OFF_MV2), m0, 512), B((const bfr*)(P.ws + OFF_V12T), nt * 128, 512);
            const float* v0 = P.in[I_V0];
            bfr* vg = (bfr*)(P.ws + OFF_VGATE);
            GEMM128(lds, 8, A, B, [&](const float* stg, int) __attribute__((always_inline)) {
                epi_rows8(stg, [&](int r, int c0, const float (&v)[8]) __attribute__((always_inline)) {
                    float o[8];
#pragma unroll
                    for (int q = 0; q < 8; ++q) o[q] = sigmoidf_(v0[nt * 128 + c0 + q] + v[q]);
                    *(uint4*)(vg + (size_t)(m0 + r) * 512 + nt * 128 + c0) = pack8(o);
                });
            });
        }
    }
}

constexpr int RW_TC = 32;
constexpr int RW_ROWS = 32;
constexpr int RW_BUF = (5 * RW_TC * 64 + RW_TC * RW_ROWS + RW_TC * RW_ROWS) * 4;
DI void phase_e3(char* lds, const Ctx& P, int li, int probe = 0) {
    const bfr* u = (const bfr*)(P.ws + OFF_U);
    const float* mu = P.in[I_MU] + (size_t)li * 1792;
    const float* dlog = (const float*)(P.ws + OFF_DLOG);
    const bfr* ab = (const bfr*)(P.ws + OFF_ABUF);
    const bfr* vg = (const bfr*)(P.ws + OFF_VGATE);
    const bfr* vf = (const bfr*)(P.ws + OFF_VFIRST);
    float* yout = (float*)(P.ws + (probe ? OFF_HID : OFF_Y));
    float* bonus = (float*)(P.ws + (probe ? OFF_HID : OFF_BONUS));
    const int tid = ltid(), lane = tid & 63, wave = tid >> 6;
    const int pstep = tid >> 4, pc0 = (tid & 15) * 4;
    for (int item = blockIdx.x; item < 256; item += gridDim.x) {
        const int bh = item >> 1, qtr = item & 1;
        const int b = bh >> 3, h = bh & 7;
        const int i0 = qtr * RW_ROWS;
        float c_mur[4], c_muk[4], c_muv[4], c_kk[4], c_ka[4], c_rk[4];
#pragma unroll
        for (int j = 0; j < 4; ++j) {
            const int c = h * 64 + pc0 + j;
            c_mur[j] = mu[c]; c_muk[j] = mu[512 + c]; c_muv[j] = mu[1024 + c];
            c_kk[j] = P.in[I_KK][li * 512 + c]; c_ka[j] = P.in[I_KA][li * 512 + c]; c_rk[j] = P.in[I_RK][li * 512 + c];
        }
        float S0 = 0.f, S1 = 0.f, S2 = 0.f, S3 = 0.f;
        const int rloc = wave * 4 + (lane >> 4);
        const int j0 = (lane & 15) * 4;
        const bool mine = ((pc0 >> 5) == qtr);
        uint2 g_ur, g_uk, g_uv, g_pr, g_pk, g_pv, g_a, g_vg, g_vf; float4 g_d;
#define E3_GLOAD(c_) do { const int t_ = (c_) * RW_TC + pstep; const size_t tok_ = (size_t)b * SEQ + t_; \
            const bfr* row_ = u + tok_ * EVEN_IN + h * 64 + pc0; const bfr* prow_ = row_ - (t_ > 0 ? EVEN_IN : 0); \
            g_ur = *(const uint2*)(row_); g_uk = *(const uint2*)(row_ + 512); g_uv = *(const uint2*)(row_ + 1024); \
            g_pr = *(const uint2*)(prow_); g_pk = *(const uint2*)(prow_ + 512); g_pv = *(const uint2*)(prow_ + 1024); \
            const size_t o_ = tok_ * 512 + h * 64 + pc0; \
            g_a = *(const uint2*)(ab + o_); g_d = *(const float4*)(dlog + o_); \
            if (li == 1) { g_vg = *(const uint2*)(vg + o_); g_vf = *(const uint2*)(vf + o_); } } while (0)
#define E3_PREP(c_, buf_) do { const int t_ = (c_) * RW_TC + pstep; const size_t o_ = ((size_t)b * SEQ + t_) * 512 + h * 64 + pc0; \
            float* sw_ = (float*)(lds + (buf_) * RW_BUF); float* sa_ = sw_ + RW_TC * 64; float* sb_ = sa_ + RW_TC * 64; float* sk_ = sb_ + RW_TC * 64; \
            float* sr_ = sk_ + RW_TC * 64; float* sv_ = sr_ + RW_TC * 64; \
            const float pz_ = t_ > 0 ? 1.f : 0.f; \
            const float ur_[4] = {bflo(g_ur.x), bfhi(g_ur.x), bflo(g_ur.y), bfhi(g_ur.y)}, uk_[4] = {bflo(g_uk.x), bfhi(g_uk.x), bflo(g_uk.y), bfhi(g_uk.y)}; \
            const float uv_[4] = {bflo(g_uv.x), bfhi(g_uv.x), bflo(g_uv.y), bfhi(g_uv.y)}; \
            const float pr_[4] = {bflo(g_pr.x), bfhi(g_pr.x), bflo(g_pr.y), bfhi(g_pr.y)}, pk_[4] = {bflo(g_pk.x), bfhi(g_pk.x), bflo(g_pk.y), bfhi(g_pk.y)}; \
            const float pv_[4] = {bflo(g_pv.x), bfhi(g_pv.x), bflo(g_pv.y), bfhi(g_pv.y)}; \
            const float av_[4] = {bflo(g_a.x), bfhi(g_a.x), bflo(g_a.y), bfhi(g_a.y)}; \
            const float dl_[4] = {g_d.x, g_d.y, g_d.z, g_d.w}; \
            float gv_[4] = {0.f, 0.f, 0.f, 0.f}, fv_[4] = {0.f, 0.f, 0.f, 0.f}; \
            if (li == 1) { gv_[0] = bflo(g_vg.x); gv_[1] = bfhi(g_vg.x); gv_[2] = bflo(g_vg.y); gv_[3] = bfhi(g_vg.y); \
                           fv_[0] = bflo(g_vf.x); fv_[1] = bfhi(g_vf.x); fv_[2] = bflo(g_vf.y); fv_[3] = bfhi(g_vf.y); } \
            float kkr_[4], kmod_[4], rr_[4], vv_[4]; float ssq_ = 0.f, bsum_ = 0.f; \
            _Pragma("unroll") for (int j = 0; j < 4; ++j) { \
                rr_[j] = ur_[j] + (pz_ * pr_[j] - ur_[j]) * c_mur[j]; \
                const float k_ = uk_[j] + (pz_ * pk_[j] - uk_[j]) * c_muk[j]; \
                float v_ = uv_[j] + (pz_ * pv_[j] - uv_[j]) * c_muv[j]; \
                if (li == 1) v_ = v_ + (fv_[j] - v_) * gv_[j]; \
                vv_[j] = v_; kkr_[j] = k_ * c_kk[j]; ssq_ += kkr_[j] * kkr_[j]; \
                kmod_[j] = k_ * (1.0f + (av_[j] - 1.0f) * c_ka[j]); bsum_ += rr_[j] * kmod_[j] * c_rk[j]; } \
            ssq_ = row16_sum(ssq_); bsum_ = row16_sum(bsum_); \
            const float inv_ = frcp(fmaxf(sqrtf(ssq_), 1e-12f)); \
            float4 w4_, a4_, b4_; \
            w4_.x = fexp(dl_[0]); w4_.y = fexp(dl_[1]); w4_.z = fexp(dl_[2]); w4_.w = fexp(dl_[3]); \
            a4_.x = -kkr_[0] * inv_; a4_.y = -kkr_[1] * inv_; a4_.z = -kkr_[2] * inv_; a4_.w = -kkr_[3] * inv_; \
            b4_.x = -a4_.x * av_[0]; b4_.y = -a4_.y * av_[1]; b4_.z = -a4_.z * av_[2]; b4_.w = -a4_.w * av_[3]; \
            *(float4*)(sw_ + pstep * 64 + pc0) = w4_; *(float4*)(sa_ + pstep * 64 + pc0) = a4_; *(float4*)(sb_ + pstep * 64 + pc0) = b4_; \
            *(float4*)(sk_ + pstep * 64 + pc0) = make_float4(kmod_[0], kmod_[1], kmod_[2], kmod_[3]); \
            *(float4*)(sr_ + pstep * 64 + pc0) = make_float4(rr_[0], rr_[1], rr_[2], rr_[3]); \
            if (mine) { *(float4*)(sv_ + pstep * RW_ROWS + (pc0 & 31)) = make_float4(vv_[0], vv_[1], vv_[2], vv_[3]); \
                        *(float4*)(bonus + o_) = make_float4(bsum_ * vv_[0], bsum_ * vv_[1], bsum_ * vv_[2], bsum_ * vv_[3]); } } while (0)
        __syncthreads();
        E3_GLOAD(0);
        E3_PREP(0, 0);
        __syncthreads();
        constexpr int NCH = SEQ / RW_TC;
#pragma unroll 1
        for (int c = 0; c < NCH; ++c) {
            const int buf = c & 1;
            if (c + 1 < NCH && probe != 2) E3_GLOAD(c + 1);
            if (probe != 1) {
                const float* s_w = (const float*)(lds + buf * RW_BUF); const float* s_a = s_w + RW_TC * 64; const float* s_b = s_a + RW_TC * 64;
                const float* s_k = s_b + RW_TC * 64; const float* s_r = s_k + RW_TC * 64; const float* s_v = s_r + RW_TC * 64;
                float* s_y = (float*)(s_v + RW_TC * RW_ROWS);
                float4 na4 = *(const float4*)(s_a + j0), nw4 = *(const float4*)(s_w + j0), nb4 = *(const float4*)(s_b + j0);
                float4 nk4 = *(const float4*)(s_k + j0), nr4 = *(const float4*)(s_r + j0);
                float nvi = s_v[rloc];
#pragma unroll 1
                for (int sg = 0; sg < RW_TC; sg += 4) {
                    float yv[4];
#pragma unroll
                    for (int q = 0; q < 4; ++q) {
                        const int sn = (sg + q + 1) & (RW_TC - 1);
                        const float4 a4 = na4, w4 = nw4, b4 = nb4, k4 = nk4, r4 = nr4; const float vi = nvi;
                        na4 = *(const float4*)(s_a + sn * 64 + j0); nw4 = *(const float4*)(s_w + sn * 64 + j0); nb4 = *(const float4*)(s_b + sn * 64 + j0);
                        nk4 = *(const float4*)(s_k + sn * 64 + j0); nr4 = *(const float4*)(s_r + sn * 64 + j0); nvi = s_v[sn * RW_ROWS + rloc];
                        float sa = dot4n(S0, S1, S2, S3, a4);
                        sa = row16_sum(sa);
                        rw_upd(S0, w4.x, sa, b4.x, vi, k4.x);
                        rw_upd(S1, w4.y, sa, b4.y, vi, k4.y);
                        rw_upd(S2, w4.z, sa, b4.z, vi, k4.z);
                        rw_upd(S3, w4.w, sa, b4.w, vi, k4.w);
                        const float y = dot4n(S0, S1, S2, S3, r4);
                        yv[q] = row16_sum(y);
                    }
                    const int ls = lane & 3;
                    const float yo = ls == 0 ? yv[0] : (ls == 1 ? yv[1] : (ls == 2 ? yv[2] : yv[3]));
                    if ((lane & 15) < 4) s_y[(sg + ls) * RW_ROWS + rloc] = yo;
                }
            }
            if (c + 1 < NCH && probe != 2) E3_PREP(c + 1, buf ^ 1);
            __syncthreads();
            {
                const float* s_y = (const float*)(lds + buf * RW_BUF) + 5 * RW_TC * 64 + RW_TC * RW_ROWS;
#pragma unroll
                for (int q = 0; q < RW_TC * RW_ROWS / NTHREADS; ++q) {
                    const int idx = q * NTHREADS + tid;
                    const int s = idx >> 5, r = idx & 31;
                    yout[((size_t)b * SEQ + c * RW_TC + s) * 512 + h * 64 + i0 + r] = s_y[idx];
                }
            }
        }
#undef E3_GLOAD
#undef E3_PREP
    }
}

DI void phase_e4(const Ctx& P, int li) {
    const bfr* y = (const bfr*)(P.ws + OFF_Y);
    const bfr* bonus = (const bfr*)(P.ws + OFF_BONUS);
    const bfr* gb = (const bfr*)(P.ws + OFF_GBUF);
    const float* lng = P.in[I_LNG] + li * 512;
    const float* lnb = P.in[I_LNB] + li * 512;
    bfr* am = (bfr*)(P.ws + OFF_AMIX);
    const int total = NTOK * 64;
    for (int idx = blockIdx.x * NTHREADS + ltid(); idx < total; idx += gridDim.x * NTHREADS) {
        const int tok = idx >> 6, c = (idx & 63) * 8;
        const size_t o = (size_t)tok * 512 + c;
        float v[8], bo[8], gv[8];
        unpack8(*(const uint4*)(y + o), v);
        unpack8(*(const uint4*)(bonus + o), bo);
        unpack8(*(const uint4*)(gb + o), gv);
        float s = 0.f;
#pragma unroll
        for (int j = 0; j < 8; ++j) s += v[j];
        s += __shfl_xor(s, 1); s += __shfl_xor(s, 2); s += __shfl_xor(s, 4);
        const float mean = s * (1.0f / 64.0f);
        float q = 0.f;
#pragma unroll
        for (int j = 0; j < 8; ++j) { v[j] -= mean; q += v[j] * v[j]; }
        q += __shfl_xor(q, 1); q += __shfl_xor(q, 2); q += __shfl_xor(q, 4);
        const float rstd = rsqrtf(q * (1.0f / 64.0f) + 64e-5f);
        float out[8];
#pragma unroll
        for (int j = 0; j < 8; ++j) out[j] = (v[j] * rstd * lng[c + j] + lnb[c + j] + bo[j]) * gv[j];
        *(uint4*)(am + (size_t)tok * 1024 + c) = pack8(out);
    }
}

DI void phase_wout(char* lds, const Ctx& P, const bfr* w, float* x) {
    const bfr* am = (const bfr*)(P.ws + OFF_AMIX);
    for (int t = blockIdx.x; t < 128 * 4; t += gridDim.x) {
        int mt, nt; tile_remap(t, 128, 4, mt, nt);
        RowLoader A(am, mt * 256, 1024), B(w, nt * 256, 1024);
        GEMM256(lds, 16, A, B, [&](const float* stg, int p) __attribute__((always_inline)) {
            epi_rows8_pre<F8>(stg,
                [&](int r, int c0) __attribute__((always_inline)) -> F8 {
                    const float* d = x + (size_t)(mt * 256 + r) * DM + nt * 256 + p * 128 + c0;
                    F8 o; o.a = *(const float4*)d; o.b = *(const float4*)(d + 4); return o; },
                [&](int r, int c0, const float (&v)[8], const F8& o) __attribute__((always_inline)) {
                    float* d = x + (size_t)(mt * 256 + r) * DM + nt * 256 + p * 128 + c0;
                    *(float4*)d = make_float4(o.a.x + v[0], o.a.y + v[1], o.a.z + v[2], o.a.w + v[3]);
                    *(float4*)(d + 4) = make_float4(o.b.x + v[4], o.b.y + v[5], o.b.z + v[6], o.b.w + v[7]);
                });
        });
    }
}
constexpr int RC_L = 32;
constexpr int RC_NCH = SEQ / RC_L;
constexpr int RC_RM = 72;
constexpr int RC_TR = 40;
constexpr int RC_OFF_LG  = 0;
constexpr int RC_OFF_AH  = 8192;
constexpr int RC_OFF_AHT = RC_OFF_AH + 4 * 32 * RC_RM * 2;
constexpr int RC_TRB = 64 * RC_TR * 2 + 8 * 16;
constexpr int RC_OFF_FA  = RC_OFF_AHT + 4 * RC_TRB;
constexpr int RC_OFF_MA  = RC_OFF_FA + 2 * 32 * RC_TR * 2;
constexpr int RC_OFF_W2T = RC_OFF_MA + 4 * 32 * RC_TR * 2;
constexpr int RC_OFF_GL  = RC_OFF_W2T + RC_TRB;
constexpr int RC_LDS_END = RC_OFF_GL + 256;
static_assert(RC_LDS_END <= G4_AUX, "chunk scratch must fit a 4-wave group's LDS");
constexpr size_t OFF_RCG = OFF_HID;
constexpr size_t OFF_RCH = OFF_HB;
constexpr size_t OFF_RCQ = OFF_EV_END;
constexpr size_t OFF_RCZ = OFF_RCQ + (size_t)8192 * 4096;
constexpr size_t OFF_RC_END = OFF_RCZ + (size_t)8192 * 4096;

DI int rc_tro(int c) { return c * (RC_TR * 2) + (c >> 3) * 16; }
DI bf16x8 rc_ld16(const char* p) { return *(const bf16x8*)p; }
DI bf16x8 rc_ld8x2(const char* p) {
    const uint2 a = *(const uint2*)p, b = *(const uint2*)(p + 16);
    return __builtin_bit_cast(bf16x8, make_uint4(a.x, a.y, b.x, b.y));
}
DI bf16x8 rc_pack(const f32x16& x, int s) {
    return __builtin_bit_cast(bf16x8, make_uint4(pk2(x[8 * s], x[8 * s + 1]), pk2(x[8 * s + 2], x[8 * s + 3]), pk2(x[8 * s + 4], x[8 * s + 5]), pk2(x[8 * s + 6], x[8 * s + 7])));
}
DI f32x16 rc_zero() { f32x16 z; _Pragma("unroll") for (int r = 0; r < 16; ++r) z[r] = 0.f; return z; }

DI void phase_r1(char* lds0, const Ctx& P, int li, int probe = 0) {
    const G4 G = g4_make(lds0);
    char* lds = G.lds;
    const int tid = G.tid, lane = tid & 63, wave = tid >> 6;
    const int ln = lane & 31, hf = lane >> 5;
    const bfr* u = (const bfr*)(P.ws + OFF_U);
    const float* mu = P.in[I_MU] + (size_t)li * 1792;
    const float* dlog = (const float*)(P.ws + OFF_DLOG);
    const bfr* ab = (const bfr*)(P.ws + OFF_ABUF);
    const bfr* vg = (const bfr*)(P.ws + OFF_VGATE);
    const bfr* vf = (const bfr*)(P.ws + OFF_VFIRST);
    bfr* bonus = (bfr*)(P.ws + OFF_BONUS);
    bfr* gG = (bfr*)(P.ws + OFF_RCG); bfr* gH = (bfr*)(P.ws + OFF_RCH); bfr* gQ = (bfr*)(P.ws + OFF_RCQ); bfr* gZ = (bfr*)(P.ws + OFF_RCZ);
    char* s_rm = lds + RC_OFF_AH;
    char* s_tr = lds + RC_OFF_AHT;
    char* s_im = lds + RC_OFF_FA;
    char* s_ma = lds + RC_OFF_MA;
    char* s_w2t = lds + RC_OFF_W2T;
    float* s_gl = (float*)(lds + RC_OFF_GL);
    constexpr int RMB = 32 * RC_RM * 2, TRB = RC_TRB, MAB = 32 * RC_TR * 2;
    const int ps = tid >> 3, pc0 = (tid & 7) * 8;
    float* s_cst = (float*)(lds + G4_AUX);
    float* s_tot = s_cst + 6 * 64;
    {
        const int h0 = (G.vb >> 6) & 7;
        if (tid < 64) {
            s_cst[0 * 64 + tid] = mu[h0 * 64 + tid]; s_cst[1 * 64 + tid] = mu[512 + h0 * 64 + tid]; s_cst[2 * 64 + tid] = mu[1024 + h0 * 64 + tid];
            s_cst[3 * 64 + tid] = P.in[I_KK][li * 512 + h0 * 64 + tid]; s_cst[4 * 64 + tid] = P.in[I_KA][li * 512 + h0 * 64 + tid]; s_cst[5 * 64 + tid] = P.in[I_RK][li * 512 + h0 * 64 + tid];
        }
        g4_bar(G);
    }
    uint4 g_ur, g_pr, g_uk, g_pk, g_uv, g_pv, g_a, g_vg, g_vf; float4 g_d0, g_d1;
#define RC_PREF(item_) do { const int bh_ = (item_) >> 6, c_ = (item_) & 63; const int t_ = c_ * RC_L + ps; const size_t tok_ = (size_t)(bh_ >> 3) * SEQ + t_; \
        const bfr* row_ = u + tok_ * EVEN_IN + (bh_ & 7) * 64 + pc0; const bfr* prow_ = row_ - (t_ > 0 ? EVEN_IN : 0); const size_t o_ = tok_ * 512 + (bh_ & 7) * 64 + pc0; \
        g_ur = *(const uint4*)row_; g_uk = *(const uint4*)(row_ + 512); g_uv = *(const uint4*)(row_ + 1024); \
        g_pr = *(const uint4*)prow_; g_pk = *(const uint4*)(prow_ + 512); g_pv = *(const uint4*)(prow_ + 1024); \
        g_a = *(const uint4*)(ab + o_); g_d0 = *(const float4*)(dlog + o_); g_d1 = *(const float4*)(dlog + o_ + 4); \
        if (li == 1) { g_vg = *(const uint4*)(vg + o_); g_vf = *(const uint4*)(vf + o_); } } while (0)
    if (G.vb < 128 * RC_NCH) RC_PREF(G.vb);
    for (int item = G.vb; item < 128 * RC_NCH; item += G.nvb) {
        const int bh = item >> 6, c = item & 63;
        const int b = bh >> 3, h = bh & 7;
        float lg[8], dl_[8];
        {
            float a_[8], b_[8], k_[8], r_[8], v_[8];
            const int t = c * RC_L + ps;
            const size_t tok = (size_t)b * SEQ + t;
            const float pz = t > 0 ? 1.f : 0.f;
            const size_t o512 = tok * 512 + h * 64 + pc0;
            float av[8];
            unpack8(g_a, av);
            float c8[8], m8[8], x8[8], y8[8];
#define RC_LD8(dst_, src_) { const float4 x0_ = *(const float4*)(src_), x1_ = *(const float4*)((src_) + 4); dst_[0] = x0_.x; dst_[1] = x0_.y; dst_[2] = x0_.z; dst_[3] = x0_.w; dst_[4] = x1_.x; dst_[5] = x1_.y; dst_[6] = x1_.z; dst_[7] = x1_.w; }
            unpack8(g_ur, x8); unpack8(g_pr, y8); RC_LD8(m8, s_cst + 0 * 64 + pc0)
#pragma unroll
            for (int j = 0; j < 8; ++j) r_[j] = x8[j] + (pz * y8[j] - x8[j]) * m8[j];
            unpack8(g_uk, x8); unpack8(g_pk, y8); RC_LD8(m8, s_cst + 1 * 64 + pc0)
            float kx[8], kkr[8]; float ssq = 0.f, bsum = 0.f;
            RC_LD8(c8, s_cst + 3 * 64 + pc0)
#pragma unroll
            for (int j = 0; j < 8; ++j) { kx[j] = x8[j] + (pz * y8[j] - x8[j]) * m8[j]; kkr[j] = kx[j] * c8[j]; ssq += kkr[j] * kkr[j]; }
            RC_LD8(c8, s_cst + 4 * 64 + pc0)
#pragma unroll
            for (int j = 0; j < 8; ++j) k_[j] = kx[j] * (1.0f + (av[j] - 1.0f) * c8[j]);
            RC_LD8(c8, s_cst + 5 * 64 + pc0)
#pragma unroll
            for (int j = 0; j < 8; ++j) bsum += r_[j] * k_[j] * c8[j];
            unpack8(g_uv, x8); unpack8(g_pv, y8); RC_LD8(m8, s_cst + 2 * 64 + pc0)
#pragma unroll
            for (int j = 0; j < 8; ++j) v_[j] = x8[j] + (pz * y8[j] - x8[j]) * m8[j];
            if (li == 1) {
                unpack8(g_vg, x8); unpack8(g_vf, y8);
#pragma unroll
                for (int j = 0; j < 8; ++j) v_[j] = v_[j] + (y8[j] - v_[j]) * x8[j];
            }
#undef RC_LD8
            ssq += __shfl_xor(ssq, 1); ssq += __shfl_xor(ssq, 2); ssq += __shfl_xor(ssq, 4);
            bsum += __shfl_xor(bsum, 1); bsum += __shfl_xor(bsum, 2); bsum += __shfl_xor(bsum, 4);
            const float inv = frcp(fmaxf(sqrtf(ssq), 1e-12f));
#pragma unroll
            for (int j = 0; j < 8; ++j) { const float kk = kkr[j] * inv; a_[j] = -kk; b_[j] = kk * av[j]; }
            { float bo[8];
#pragma unroll
              for (int j = 0; j < 8; ++j) bo[j] = bsum * v_[j];
              *(uint4*)(bonus + o512) = pack8(bo); }
#pragma unroll
            for (int j = 0; j < 8; ++j) *(bfr*)(s_tr + 3 * TRB + rc_tro(pc0 + j) + ps * 2) = f2bf(v_[j]);
            dl_[0] = g_d0.x; dl_[1] = g_d0.y; dl_[2] = g_d0.z; dl_[3] = g_d0.w; dl_[4] = g_d1.x; dl_[5] = g_d1.y; dl_[6] = g_d1.z; dl_[7] = g_d1.w;
#pragma unroll
            for (int j = 0; j < 8; ++j) lg[j] = dl_[j];
#pragma unroll
            for (int d = 8; d < 64; d <<= 1) {
#pragma unroll
                for (int j = 0; j < 8; ++j) { const float o = __shfl_up(lg[j], d); lg[j] += (lane >= d) ? o : 0.f; }
            }
            *(uint4*)(s_rm + 0 * RMB + (ps * RC_RM + pc0) * 2) = pack8(a_);
            *(uint4*)(s_rm + 1 * RMB + (ps * RC_RM + pc0) * 2) = pack8(b_);
            *(uint4*)(s_rm + 2 * RMB + (ps * RC_RM + pc0) * 2) = pack8(k_);
            *(uint4*)(s_rm + 3 * RMB + (ps * RC_RM + pc0) * 2) = pack8(r_);
            if ((lane >> 3) == 7) { *(float4*)(s_tot + wave * 64 + pc0) = make_float4(lg[0], lg[1], lg[2], lg[3]); *(float4*)(s_tot + wave * 64 + pc0 + 4) = make_float4(lg[4], lg[5], lg[6], lg[7]); }
        }
        g4_bar(G);
        {
#pragma unroll
            for (int w2 = 0; w2 < 3; ++w2) {
                if (w2 < wave) {
                    const float4 e0 = *(const float4*)(s_tot + w2 * 64 + pc0), e1 = *(const float4*)(s_tot + w2 * 64 + pc0 + 4);
                    lg[0] += e0.x; lg[1] += e0.y; lg[2] += e0.z; lg[3] += e0.w; lg[4] += e1.x; lg[5] += e1.y; lg[6] += e1.z; lg[7] += e1.w;
                }
            }
            float ah[8], bhh[8], kh[8], rh[8];
            unpack8(*(const uint4*)(s_rm + 0 * RMB + (ps * RC_RM + pc0) * 2), ah);
            unpack8(*(const uint4*)(s_rm + 1 * RMB + (ps * RC_RM + pc0) * 2), bhh);
            unpack8(*(const uint4*)(s_rm + 2 * RMB + (ps * RC_RM + pc0) * 2), kh);
            unpack8(*(const uint4*)(s_rm + 3 * RMB + (ps * RC_RM + pc0) * 2), rh);
#pragma unroll
            for (int j = 0; j < 8; ++j) {
                const float ep = fexp(lg[j]), em = fexp(-lg[j]), ep1 = fexp(lg[j] - dl_[j]);
                ah[j] *= ep1; bhh[j] *= em; kh[j] *= em; rh[j] *= ep;
                if (ps == RC_L - 1) s_gl[pc0 + j] = ep;
            }
            *(uint4*)(s_rm + 0 * RMB + (ps * RC_RM + pc0) * 2) = pack8(ah);
            *(uint4*)(s_rm + 1 * RMB + (ps * RC_RM + pc0) * 2) = pack8(bhh);
            *(uint4*)(s_rm + 2 * RMB + (ps * RC_RM + pc0) * 2) = pack8(kh);
            *(uint4*)(s_rm + 3 * RMB + (ps * RC_RM + pc0) * 2) = pack8(rh);
#pragma unroll
            for (int j = 0; j < 8; ++j) {
                *(bfr*)(s_tr + 0 * TRB + rc_tro(pc0 + j) + ps * 2) = f2bf(ah[j]);
                *(bfr*)(s_tr + 1 * TRB + rc_tro(pc0 + j) + ps * 2) = f2bf(bhh[j]);
                *(bfr*)(s_tr + 2 * TRB + rc_tro(pc0 + j) + ps * 2) = f2bf(kh[j]);
            }
        }
        if (item + G.nvb < 128 * RC_NCH) RC_PREF(item + G.nvb);
        g4_bar(G);
        if (probe < 3) {
            const char* xa = s_rm + (wave < 2 ? 0 : 3) * RMB;
            const char* xb = s_rm + ((wave & 1) ? 2 : 1) * RMB;
            f32x16 acc = rc_zero();
#pragma unroll
            for (int ks = 0; ks < 4; ++ks)
                acc = MFMA32(rc_ld16(xa + (ln * RC_RM + ks * 16 + hf * 8) * 2), rc_ld16(xb + (ln * RC_RM + ks * 16 + hf * 8) * 2), acc);
#pragma unroll
            for (int r = 0; r < 16; ++r) {
                const int t = (r & 3) + 8 * (r >> 2) + 4 * hf;
                const bool keep = (wave < 2) ? (ln < t) : (ln <= t);
                acc[r] = keep ? acc[r] : 0.f;
                if (wave != 0) *(bfr*)(s_ma + (wave - 1) * MAB + (t * RC_TR + ln) * 2) = f2bf(acc[r]);
            }
            if (wave == 0 && probe < 2) {
                f32x16 Ap = acc, Pa = acc;
#pragma unroll
                for (int r = 0; r < 16; ++r) { const int t = (r & 3) + 8 * (r >> 2) + 4 * hf; Pa[r] += (t == ln) ? 1.f : 0.f; }
                char* imA = s_im; char* imH = s_im + MAB;
#pragma unroll 1
                for (int it = 0; it < 4; ++it) {
#pragma unroll
                    for (int r = 0; r < 16; ++r) {
                        const int t = (r & 3) + 8 * (r >> 2) + 4 * hf;
                        *(bfr*)(imA + (t * RC_TR + ln) * 2) = f2bf(Ap[r]);
                        *(bfr*)(imH + (t * RC_TR + ln) * 2) = f2bf(Pa[r]);
                    }
                    const bf16x8 a0 = rc_pack(Ap, 0), a1 = rc_pack(Ap, 1);
                    const int ro = (ln * RC_TR + 4 * hf) * 2;
                    f32x16 An = rc_zero();
                    An = MFMA32(rc_ld8x2(imA + ro), a0, An);
                    An = MFMA32(rc_ld8x2(imA + ro + 32), a1, An);
                    Ap = An;
                    const bf16x8 b0 = rc_pack(Ap, 0), b1 = rc_pack(Ap, 1);
                    Pa = MFMA32(rc_ld8x2(imH + ro), b0, Pa); Pa = MFMA32(rc_ld8x2(imH + ro + 32), b1, Pa);
                }
#pragma unroll
                for (int r = 0; r < 16; ++r) { const int t = (r & 3) + 8 * (r >> 2) + 4 * hf; *(bfr*)(s_ma + 3 * MAB + (t * RC_TR + ln) * 2) = f2bf(Pa[r]); }
            } else if (wave == 1) {
#pragma unroll
                for (int it = 0; it < 2; ++it) {
                    f32x16 w2 = rc_zero();
#pragma unroll
                    for (int ks = 0; ks < 2; ++ks)
                        w2 = MFMA32(rc_ld16(s_ma + 0 * MAB + (ln * RC_TR + ks * 16 + hf * 8) * 2), rc_ld16(s_tr + 3 * TRB + rc_tro(it * 32 + ln) + (ks * 16 + hf * 8) * 2), w2);
#pragma unroll
                    for (int q = 0; q < 4; ++q)
                        *(uint2*)(s_w2t + rc_tro(it * 32 + ln) + (8 * q + 4 * hf) * 2) = make_uint2(pk2(w2[4 * q], w2[4 * q + 1]), pk2(w2[4 * q + 2], w2[4 * q + 3]));
                }
            }
        }
        g4_bar(G);
        if (probe < 1) {
            const int hp = wave & 1;
            const size_t chunk = (size_t)bh * RC_NCH + c;
            const char* tm = s_ma + 3 * MAB;
            const char* bsrc = (wave < 2) ? (s_tr + 0 * TRB) : s_w2t;
            f32x16 X = rc_zero();
#pragma unroll
            for (int ks = 0; ks < 2; ++ks)
                X = MFMA32(rc_ld16(tm + (ln * RC_TR + ks * 16 + hf * 8) * 2), rc_ld16(bsrc + rc_tro(hp * 32 + ln) + (ks * 16 + hf * 8) * 2), X);
            const bf16x8 xf0 = rc_pack(X, 0), xf1 = rc_pack(X, 1);
            const char* arb = s_ma + 1 * MAB; const char* ark = s_ma + 2 * MAB;
            if (wave < 2) {
#pragma unroll
                for (int jt = 0; jt < 2; ++jt) {
                    f32x16 acc = rc_zero();
                    const char* bp = s_tr + 1 * TRB + rc_tro(jt * 32 + ln) + 8 * hf;
                    acc = MFMA32(xf0, rc_ld8x2(bp), acc);
                    acc = MFMA32(xf1, rc_ld8x2(bp + 32), acc);
                    const int j = jt * 32 + ln;
                    const float gl = s_gl[j];
                    bfr* dst = gG + chunk * 4096 + (size_t)j * 64 + hp * 32 + 4 * hf;
#pragma unroll
                    for (int q = 0; q < 4; ++q) {
                        float o[4];
#pragma unroll
                        for (int e = 0; e < 4; ++e) { const int jp = hp * 32 + 8 * q + 4 * hf + e; o[e] = gl * (acc[4 * q + e] + (jp == j ? 1.f : 0.f)); }
                        *(uint2*)(dst + 8 * q) = make_uint2(pk2(o[0], o[1]), pk2(o[2], o[3]));
                    }
                }
                {
                    f32x16 acc = rc_zero();
                    const char* bp = arb + (ln * RC_TR + 4 * hf) * 2;
                    acc = MFMA32(xf0, rc_ld8x2(bp), acc);
                    acc = MFMA32(xf1, rc_ld8x2(bp + 32), acc);
                    bfr* dst = gQ + chunk * 2048 + (size_t)ln * 64 + hp * 32 + 4 * hf;
                    const char* rsrc = s_rm + 3 * RMB + (ln * RC_RM + hp * 32 + 4 * hf) * 2;
#pragma unroll
                    for (int q = 0; q < 4; ++q) {
                        const uint2 rr = *(const uint2*)(rsrc + 16 * q);
                        *(uint2*)(dst + 8 * q) = make_uint2(pk2(acc[4 * q] + bflo(rr.x), acc[4 * q + 1] + bfhi(rr.x)), pk2(acc[4 * q + 2] + bflo(rr.y), acc[4 * q + 3] + bfhi(rr.y)));
                    }
                }
            } else {
#pragma unroll
                for (int jt = 0; jt < 2; ++jt) {
                    f32x16 acc = rc_zero();
                    const char* ap = s_tr + 1 * TRB + rc_tro(jt * 32 + ln) + 8 * hf;
                    acc = MFMA32(rc_ld8x2(ap), xf0, acc);
                    acc = MFMA32(rc_ld8x2(ap + 32), xf1, acc);
#pragma unroll
                    for (int ks = 0; ks < 2; ++ks)
                        acc = MFMA32(rc_ld16(s_tr + 2 * TRB + rc_tro(jt * 32 + ln) + (ks * 16 + hf * 8) * 2), rc_ld16(s_tr + 3 * TRB + rc_tro(hp * 32 + ln) + (ks * 16 + hf * 8) * 2), acc);
                    bfr* dst = gH + chunk * 4096 + (size_t)(hp * 32 + ln) * 64 + jt * 32 + 4 * hf;
#pragma unroll
                    for (int q = 0; q < 4; ++q) {
                        const float4 gl = *(const float4*)(s_gl + jt * 32 + 8 * q + 4 * hf);
                        *(uint2*)(dst + 8 * q) = make_uint2(pk2(gl.x * acc[4 * q], gl.y * acc[4 * q + 1]), pk2(gl.z * acc[4 * q + 2], gl.w * acc[4 * q + 3]));
                    }
                }
                {
                    f32x16 acc = rc_zero();
                    const char* bp = arb + (ln * RC_TR + 4 * hf) * 2;
                    acc = MFMA32(xf0, rc_ld8x2(bp), acc);
                    acc = MFMA32(xf1, rc_ld8x2(bp + 32), acc);
#pragma unroll
                    for (int ks = 0; ks < 2; ++ks)
                        acc = MFMA32(rc_ld16(s_tr + 3 * TRB + rc_tro(hp * 32 + ln) + (ks * 16 + hf * 8) * 2), rc_ld16(ark + (ln * RC_TR + ks * 16 + hf * 8) * 2), acc);
                    bfr* dst = gZ + chunk * 2048 + (size_t)ln * 64 + hp * 32 + 4 * hf;
#pragma unroll
                    for (int q = 0; q < 4; ++q) *(uint2*)(dst + 8 * q) = make_uint2(pk2(acc[4 * q], acc[4 * q + 1]), pk2(acc[4 * q + 2], acc[4 * q + 3]));
                }
            }
        }
        g4_bar(G);
    }
}

DI bf16x8 rc_join(uint2 a, uint2 b) { return __builtin_bit_cast(bf16x8, make_uint4(a.x, a.y, b.x, b.y)); }
struct RcG { uint2 g[16]; };
DI void rc_load_g(RcG& f, const bfr* Gc, int ln, int hf) {
#pragma unroll
    for (int x = 0; x < 4; ++x) {
        const int o = (x >> 1) * 32 + (x & 1) * 16 + 4 * hf;
        f.g[4 * x] = *(const uint2*)(Gc + (size_t)ln * 64 + o);            f.g[4 * x + 1] = *(const uint2*)(Gc + (size_t)ln * 64 + o + 8);
        f.g[4 * x + 2] = *(const uint2*)(Gc + (size_t)(32 + ln) * 64 + o); f.g[4 * x + 3] = *(const uint2*)(Gc + (size_t)(32 + ln) * 64 + o + 8);
    }
}
DI void phase_r2(const Ctx& P) {
    const int tid = ltid(), lane = tid & 63, wave = tid >> 6;
    const int ln = lane & 31, hf = lane >> 5;
    const bfr* gG = (const bfr*)(P.ws + OFF_RCG); const bfr* gH = (const bfr*)(P.ws + OFF_RCH); const bfr* gQ = (const bfr*)(P.ws + OFF_RCQ); const bfr* gZ = (const bfr*)(P.ws + OFF_RCZ);
    bfr* yout = (bfr*)(P.ws + OFF_Y);
    if (wave != 0) return;
#define RC_LOAD_ALL(GV, QV, HV, ZV, ch_) do { const bfr* Hc_ = gH + (ch_) * 4096; const bfr* Qc_ = gQ + (ch_) * 2048; const bfr* Zc_ = gZ + (ch_) * 2048; \
        rc_load_g(GV, gG + (ch_) * 4096, ln, hf); \
        _Pragma("unroll") for (int x = 0; x < 4; ++x) { const int o_ = (x >> 1) * 32 + (x & 1) * 16 + 4 * hf; \
            QV[2 * x] = *(const uint2*)(Qc_ + (size_t)ln * 64 + o_); QV[2 * x + 1] = *(const uint2*)(Qc_ + (size_t)ln * 64 + o_ + 8); } \
        _Pragma("unroll") for (int q = 0; q < 4; ++q) { ZV[q] = *(const uint2*)(Zc_ + (size_t)ln * 64 + ic * 32 + 4 * hf + 8 * q); \
            HV[q] = *(const uint2*)(Hc_ + (size_t)(ic * 32 + ln) * 64 + 4 * hf + 8 * q); HV[4 + q] = *(const uint2*)(Hc_ + (size_t)(ic * 32 + ln) * 64 + 32 + 4 * hf + 8 * q); } } while (0)
#define RC_STEP(GV, QV, HV, ZV, c_) do { \
        bf16x8 mh[2][2]; \
        _Pragma("unroll") for (int ks = 0; ks < 2; ++ks) { mh[0][ks] = rc_pack(M0, ks); mh[1][ks] = rc_pack(M1, ks); } \
        f32x16 n0 = rc_zero(), n1 = rc_zero(), ya = rc_zero(); \
        _Pragma("unroll") for (int x = 0; x < 4; ++x) { \
            const bf16x8 g0 = rc_join(GV.g[4 * x], GV.g[4 * x + 1]), g1 = rc_join(GV.g[4 * x + 2], GV.g[4 * x + 3]); \
            n0 = MFMA32(g0, mh[x >> 1][x & 1], n0); n1 = MFMA32(g1, mh[x >> 1][x & 1], n1); \
            ya = MFMA32(mh[x >> 1][x & 1], rc_join(QV[2 * x], QV[2 * x + 1]), ya); } \
        bfr* yp = yout + ((size_t)b * SEQ + (c_) * RC_L + ln) * 512 + h * 64 + ic * 32 + 4 * hf; \
        _Pragma("unroll") for (int q = 0; q < 4; ++q) { const uint2 zz = ZV[q]; \
            *(uint2*)(yp + 8 * q) = make_uint2(pk2(ya[4 * q] + bflo(zz.x), ya[4 * q + 1] + bfhi(zz.x)), pk2(ya[4 * q + 2] + bflo(zz.y), ya[4 * q + 3] + bfhi(zz.y))); } \
        _Pragma("unroll") for (int q = 0; q < 4; ++q) { const uint2 h0 = HV[q], h1 = HV[4 + q]; \
            M0[4 * q] = n0[4 * q] + bflo(h0.x); M0[4 * q + 1] = n0[4 * q + 1] + bfhi(h0.x); M0[4 * q + 2] = n0[4 * q + 2] + bflo(h0.y); M0[4 * q + 3] = n0[4 * q + 3] + bfhi(h0.y); \
            M1[4 * q] = n1[4 * q] + bflo(h1.x); M1[4 * q + 1] = n1[4 * q + 1] + bfhi(h1.x); M1[4 * q + 2] = n1[4 * q + 2] + bflo(h1.y); M1[4 * q + 3] = n1[4 * q + 3] + bfhi(h1.y); } } while (0)
    for (int item = blockIdx.x; item < 256; item += gridDim.x) {
        const int bh = item >> 1, ic = item & 1;
        const int b = bh >> 3, h = bh & 7;
        f32x16 M0 = rc_zero(), M1 = rc_zero();
        const size_t ch0 = (size_t)bh * RC_NCH;
        RcG gA, gB; uint2 qA[8], hA[8], zA[4], qB[8], hB[8], zB[4];
        RC_LOAD_ALL(gA, qA, hA, zA, ch0);
#pragma unroll 1
        for (int c = 0; c < RC_NCH; c += 2) {
            RC_LOAD_ALL(gB, qB, hB, zB, ch0 + c + 1);
            RC_STEP(gA, qA, hA, zA, c);
            RC_LOAD_ALL(gA, qA, hA, zA, ch0 + (c + 2 < RC_NCH ? c + 2 : c));
            RC_STEP(gB, qB, hB, zB, c + 1);
        }
    }
#undef RC_LOAD_ALL
#undef RC_STEP
}
DI void phase_o1(char* lds, const Ctx& P, int li) {
    const bfr* hb = (const bfr*)(P.ws + OFF_HB);
    const bfr* w = (const bfr*)(P.ws + OFF_WINO) + (size_t)li * 2048 * 1024;
    bfr* qk = (bfr*)(P.ws + OFF_U);
    bfr* vT = (bfr*)(P.ws + OFF_VT);
    bfr* us5 = (bfr*)(P.ws + OFF_US5);
    for (int t = blockIdx.x; t < 128 * 8; t += gridDim.x) {
        int mt, nt; tile_remap(t, 128, 8, mt, nt);
        const int m0 = mt * 256;
        RowLoader A(hb, m0, 1024), B(w, nt * 256, 1024);
        GEMM256(lds, 16, A, B, [&](const float* stg, int p) __attribute__((always_inline)) {
            if (nt < 4) {
                epi_rows8(stg, [&](int r, int c0, const float (&v)[8]) __attribute__((always_inline)) {
                    *(uint4*)(qk + (size_t)(m0 + r) * 1024 + nt * 256 + p * 128 + c0) = pack8(v);
                });
            } else if (nt < 6) {
                const int b = m0 >> 11, tq = m0 & (SEQ - 1);
                bfr* dst = vT + ((size_t)(b * 4 + (nt - 4) * 2 + p) * 128) * SEQ + tq;
                const int tid0 = ltid();
#pragma unroll
                for (int it = 0; it < 8; ++it) {
                    const int idx = it * NTHREADS + tid0;
                    const int dv = idx & 127, rg = idx >> 7;
                    float v[8];
#pragma unroll
                    for (int j = 0; j < 8; ++j) v[j] = stg[(rg * 8 + j) * STG_LD + dv];
                    *(uint4*)(dst + (size_t)dv * SEQ + rg * 8) = pack8(v);
                }
            } else {
                epi_rows8(stg, [&](int r, int c0, const float (&v)[8]) __attribute__((always_inline)) {
                    const int cc = (nt - 6) * 256 + p * 128 + c0;
                    *(uint4*)(us5 + ((size_t)(cc >> 4) * NTOK + m0 + r) * 16 + (cc & 15)) = pack8(v);
                });
            }
        });
    }
}

DI void phase_o2(char* lds, const Ctx& P, int li) {
    const bfr* qk = (const bfr*)(P.ws + OFF_U);
    bfr* qn = (bfr*)(P.ws + OFF_QN);
    bfr* kn = (bfr*)(P.ws + OFF_KN);
    const float* gq = P.in[I_QN] + li * 64;
    const float* gk = P.in[I_KN] + li * 64;
    const bfr* us5 = (const bfr*)(P.ws + OFF_US5);
    const bfr* bl = (const bfr*)(P.ws + OFF_S5BL) + (size_t)li * 32 * 128 * 512;
    float* xloc = (float*)(P.ws + OFF_XLOC);
    for (int t = blockIdx.x; t < 128; t += gridDim.x) {
        const int g = t >> 2, mt = t & 3;
        RowLoader A(us5 + (size_t)g * NTOK * 16, mt * 256, 512), B(bl + (size_t)g * 128 * 512, 0, 512);
        GEMM128(lds, 8, A, B, [&](const float* stg, int) __attribute__((always_inline)) {
            epi_rows8(stg, [&](int r, int c0, const float (&v)[8]) __attribute__((always_inline)) {
                float* d = xloc + ((size_t)g * 1024 + mt * 256 + r) * 128 + c0;
                *(float4*)d = make_float4(v[0], v[1], v[2], v[3]); *(float4*)(d + 4) = make_float4(v[4], v[5], v[6], v[7]);
            });
        });
    }
    const int total = NTOK * 16 * 8;
    for (int idx = blockIdx.x * NTHREADS + ltid(); idx < total; idx += gridDim.x * NTHREADS) {
        const int l8 = idx & 7, item = idx >> 3;
        const int hm = item & 7, which = (item >> 3) & 1, tok = item >> 4;
        const int d0 = l8 * 4;
        const bfr* src = qk + (size_t)tok * 1024 + which * 512 + hm * 64;
        const uint2 ua = *(const uint2*)(src + d0), ub = *(const uint2*)(src + 32 + d0);
        float x1[4] = {bflo(ua.x), bfhi(ua.x), bflo(ua.y), bfhi(ua.y)};
        float x2[4] = {bflo(ub.x), bfhi(ub.x), bflo(ub.y), bfhi(ub.y)};
        float ss = 0.f;
#pragma unroll
        for (int j = 0; j < 4; ++j) ss += x1[j] * x1[j] + x2[j] * x2[j];
        ss += __shfl_xor(ss, 1); ss += __shfl_xor(ss, 2); ss += __shfl_xor(ss, 4);
        const float rs = rsqrtf(ss * (1.0f / 64.0f) + 1e-6f);
        const float* gg = which ? gk : gq;
        const float scl = which ? 1.0f : (0.125f * 1.4426950408889634f);
        const int t = tok & (SEQ - 1);
        float o1[4], o2[4];
#pragma unroll
        for (int j = 0; j < 4; ++j) {
            const int i = d0 + j;
            const float invf = exp2f(-(float)i * (13.287712379549449f / 32.0f));
            const float ang = (float)t * invf;
            float sn, cs;
            sincosf(ang, &sn, &cs);
            const float a = x1[j] * rs * gg[i], b2 = x2[j] * rs * gg[32 + i];
            o1[j] = (a * cs - b2 * sn) * scl;
            o2[j] = (b2 * cs + a * sn) * scl;
        }
        bfr* dst = (which ? kn : qn) + (size_t)tok * 512 + hm * 64;
        *(uint2*)(dst + d0) = make_uint2(pk2(o1[0], o1[1]), pk2(o1[2], o1[3]));
        *(uint2*)(dst + 32 + d0) = make_uint2(pk2(o2[0], o2[1]), pk2(o2[2], o2[3]));
    }
}

DI void s5_scan(const Ctx& P, int li) {
    const float* xloc = (const float*)(P.ws + OFF_XLOC);
    bfr* xin = (bfr*)(P.ws + OFF_XIN);
    const float* l32 = (const float*)(P.ws + OFF_S5L32) + (size_t)li * 32 * 128;
    for (int idx = blockIdx.x * NTHREADS + ltid(); idx < 32 * 16 * 64; idx += gridDim.x * NTHREADS) {
        const int p = idx & 63, b = (idx >> 6) & 15, g = idx >> 10;
        const float lr = l32[g * 128 + 2 * p], lim = l32[g * 128 + 2 * p + 1];
        float xr = 0.f, xi = 0.f;
        for (int ch = 0; ch < 64; ++ch) {
            const size_t o = ((size_t)g * 1024 + b * 64 + ch) * 128 + 2 * p;
            *(unsigned*)(xin + o) = pk2(xr, xi);
            const float2 a = *(const float2*)(xloc + o);
            const float nr = lr * xr - lim * xi + a.x, ni = lr * xi + lim * xr + a.y;
            xr = nr; xi = ni;
        }
    }
}

DI void attn_item(char* lds, const Ctx& P, int b, int h, int qt, float lam, float lam_init, const float* subln) {
    const bfr* qn = (const bfr*)(P.ws + OFF_QN);
    const bfr* kn = (const bfr*)(P.ws + OFF_KN);
    const bfr* vT = (const bfr*)(P.ws + OFF_VT) + (size_t)(b * 4 + h) * 128 * SEQ;
    bfr* am = (bfr*)(P.ws + OFF_AMIX);
    const int tid = ltid(), lane = tid & 63, wave = tid >> 6;
    const int m = wave >> 2, qw = (wave & 3) * 32;
    const int q0 = qt * 128 + qw;
    const int ln = lane & 31, hf = lane >> 5;
    bf16x8 qf[4];
    {
        const bfr* qp = qn + ((size_t)b * SEQ + q0 + ln) * 512 + h * 128 + m * 64 + hf * 8;
#pragma unroll
        for (int ks = 0; ks < 4; ++ks) qf[ks] = *(const bf16x8*)(qp + ks * 16);
    }
    f32x16 o[4];
#pragma unroll
    for (int d = 0; d < 4; ++d)
#pragma unroll
        for (int r = 0; r < 16; ++r) o[d][r] = 0.f;
    float mrun = 0.f, lrun = 0.f;
    const int nkt = 2 * (qt + 1);
    const int lrow = tid >> 3, lcol = (tid & 7) * 8;
    const bfr* kbase = kn + ((size_t)b * SEQ) * 512 + h * 128;
    unsigned ko = (unsigned)(lrow * 512 + lcol) * 2u, vo = (unsigned)(lrow * SEQ + lcol) * 2u;
    asm volatile("" : "+v"(ko), "+v"(vo));
    uint4 rk0, rk1, rv0, rv1;
#define ATT_GLOAD(kt_) do { const char* kp_ = (const char*)(kbase + (size_t)(kt_) * (64 * 512)); const char* vp_ = (const char*)(vT + (kt_) * 64); \
        rk0 = *(const uint4*)(kp_ + ko); rk1 = *(const uint4*)(kp_ + 64 * 2 + ko); \
        rv0 = *(const uint4*)(vp_ + vo); rv1 = *(const uint4*)(vp_ + 64 * SEQ * 2 + vo); } while (0)
#define ATT_S1(base_, i_, RK, RV) { *(uint4*)((base_) + (64 * (i_)) * LDA * 2) = RK; \
        *(uint4*)((base_) + TILE_B + (64 * (i_)) * LDA * 2) = RV; }
#define ATT_LSTORE(buf_) do { char* base_ = lds + (buf_) * (2 * TILE_B) + s_off; ATT_S1(base_, 0, rk0, rv0) ATT_S1(base_, 1, rk1, rv1) } while (0)
    int k_off = ((m * 64 + ln) * LDA + hf * 8) * 2;
    int v_off = TILE_B + (ln * LDA + 4 * hf) * 2;
    int s_off = (lrow * LDA + lcol) * 2;
    asm volatile("" : "+v"(k_off), "+v"(v_off), "+v"(s_off));
    ATT_GLOAD(0); ATT_LSTORE(0);
    __syncthreads();
    int buf = 0;
#pragma unroll 1
    for (int kt = 0; kt < nkt; ++kt) {
        const bool more = (kt + 1 < nkt);
        if (more) ATT_GLOAD(kt + 1);
        const char* ks_ = lds + buf * (2 * TILE_B) + k_off;
        const char* vs_ = lds + buf * (2 * TILE_B) + v_off;
        if (kt * 64 <= q0 + 31) {
            f32x16 s[2];
            const float negm = -mrun;
#pragma unroll
            for (int kb = 0; kb < 2; ++kb) {
#pragma unroll
                for (int r = 0; r < 16; ++r) s[kb][r] = negm;
#pragma unroll
                for (int ks = 0; ks < 4; ++ks) {
                    const bf16x8 kf = *(const bf16x8*)(ks_ + ((kb * 32) * LDA + ks * 16) * 2);
                    s[kb] = MFMA32(kf, qf[ks], s[kb]);
                }
            }
            const int qpos = q0 + ln;
            if (kt * 64 + 63 > q0) {
#pragma unroll
                for (int kb = 0; kb < 2; ++kb)
#pragma unroll
                    for (int r = 0; r < 16; ++r) {
                        const int key = kt * 64 + kb * 32 + (r & 3) + 8 * (r >> 2) + 4 * hf;
                        if (key > qpos) s[kb][r] = -INFINITY;
                    }
            }
            float mx = s[0][0];
#pragma unroll
            for (int kb = 0; kb < 2; ++kb)
#pragma unroll
                for (int r = 0; r < 16; ++r) mx = fmaxf(mx, s[kb][r]);
            mx = fmaxf(mx, __shfl_xor(mx, 32));
            if (kt == 0 || __any(mx > 8.0f)) {
                const float delta = (kt == 0 || mx > 8.0f) ? mx : 0.f;
                const float alpha = __builtin_amdgcn_exp2f(-delta);
                mrun += delta;
                lrun *= alpha;
#pragma unroll
                for (int kb = 0; kb < 2; ++kb)
#pragma unroll
                    for (int r = 0; r < 16; ++r) s[kb][r] -= delta;
#pragma unroll
                for (int d = 0; d < 4; ++d)
#pragma unroll
                    for (int r = 0; r < 16; ++r) o[d][r] *= alpha;
            }
            float rsum = 0.f;
#pragma unroll
            for (int kb = 0; kb < 2; ++kb)
#pragma unroll
                for (int r = 0; r < 16; ++r) { const float pv_ = __builtin_amdgcn_exp2f(s[kb][r]); s[kb][r] = pv_; rsum += pv_; }
            lrun += rsum;
#define ATT_VLD(V_, g_) do { _Pragma("unroll") for (int d_ = 0; d_ < 4; ++d_) { \
                V_[2 * d_] = *(const uint2*)(vs_ + ((d_ * 32) * LDA + 16 * (g_)) * 2); V_[2 * d_ + 1] = *(const uint2*)(vs_ + ((d_ * 32) * LDA + 16 * (g_) + 8) * 2); } } while (0)
#define ATT_PV(V_, g_) do { const int kb_ = (g_) >> 1, st_ = (g_) & 1; \
                const bf16x8 pf_ = __builtin_bit_cast(bf16x8, make_uint4(pk2(s[kb_][8 * st_ + 0], s[kb_][8 * st_ + 1]), pk2(s[kb_][8 * st_ + 2], s[kb_][8 * st_ + 3]), \
                                                                         pk2(s[kb_][8 * st_ + 4], s[kb_][8 * st_ + 5]), pk2(s[kb_][8 * st_ + 6], s[kb_][8 * st_ + 7]))); \
                _Pragma("unroll") for (int d_ = 0; d_ < 4; ++d_) \
                    o[d_] = MFMA32(__builtin_bit_cast(bf16x8, make_uint4(V_[2 * d_].x, V_[2 * d_].y, V_[2 * d_ + 1].x, V_[2 * d_ + 1].y)), pf_, o[d_]); } while (0)
            {
                uint2 va[8], vb[8];
                ATT_VLD(va, 0);
                ATT_VLD(vb, 1); ATT_PV(va, 0);
                ATT_VLD(va, 2); ATT_PV(vb, 1);
                ATT_VLD(vb, 3); ATT_PV(va, 2);
                ATT_PV(vb, 3);
            }
#undef ATT_VLD
#undef ATT_PV
        }
        if (more) ATT_LSTORE(buf ^ 1);
        __syncthreads();
        buf ^= 1;
    }
    const float ltot = lrun + __shfl_xor(lrun, 32);
    const float linv = 1.0f / ltot;
    float* ob = (float*)lds;
    int o_off = (m * 128 + qw + ln) * 129 + 4 * hf;
    asm volatile("" : "+v"(o_off));
#pragma unroll
    for (int d = 0; d < 4; ++d)
#pragma unroll
        for (int r = 0; r < 16; ++r) ob[o_off + d * 32 + (r & 3) + 8 * (r >> 2)] = o[d][r] * linv;
    __syncthreads();
#pragma unroll
    for (int it = 0; it < 4; ++it) {
        const int idx = it * NTHREADS + tid;
        const int q = idx >> 4, c0 = (idx & 15) * 8;
        float v[8];
        float ss = 0.f;
        int r_off = q * 129 + c0;
        asm volatile("" : "+v"(r_off));
#pragma unroll
        for (int j = 0; j < 8; ++j) { v[j] = ob[r_off + j] - lam * ob[r_off + 128 * 129 + j]; ss += v[j] * v[j]; }
        ss = row16_sum(ss);
        const float rs = rsqrtf(ss * (1.0f / 128.0f) + 1e-5f) * (1.0f - lam_init);
#pragma unroll
        for (int j = 0; j < 8; ++j) v[j] = v[j] * rs * subln[c0 + j];
        *(uint4*)(am + ((size_t)b * SEQ + qt * 128 + q) * 1024 + h * 128 + c0) = pack8(v);
    }
    __syncthreads();
}

DI void phase_o3(char* lds, const Ctx& P, int li, int layer) {
    s5_scan(P, li);
    float lam;
    {
        const int j = ltid() & 63;
        const float s1 = wave_sum(P.in[I_LQ1][li * 64 + j] * P.in[I_LK1][li * 64 + j]);
        const float s2 = wave_sum(P.in[I_LQ2][li * 64 + j] * P.in[I_LK2][li * 64 + j]);
        const float lam_init0 = 0.8f - 0.6f * __expf(-0.3f * (float)layer);
        lam = __expf(s1) - __expf(s2) + lam_init0;
    }
    const float lam_init = 0.8f - 0.6f * __expf(-0.3f * (float)layer);
    const float* subln = P.in[I_SUBLN] + li * 128;
    for (int item = blockIdx.x; item < 512; item += gridDim.x) {
        const int bh = item >> 3, pr = item & 7;
        for (int half = 0; half < 2; ++half) attn_item(lds, P, bh >> 2, bh & 3, half ? 15 - pr : pr, lam, lam_init, subln);
    }
}

DI void phase_o4(char* lds, const Ctx& P, int li) {
    const bfr* us5 = (const bfr*)(P.ws + OFF_US5);
    const bfr* xin = (const bfr*)(P.ws + OFF_XIN);
    const bfr* gt = (const bfr*)(P.ws + OFF_S5GT) + (size_t)li * 32 * 512 * 640;
    const float* dsk = P.in[I_S5D] + li * 512;
    bfr* zb = (bfr*)(P.ws + OFF_ZBUF);
    for (int t = blockIdx.x; t < 512; t += gridDim.x) {
        const int g = t >> 4, mt = (t >> 2) & 3, nt = t & 3;
        const int nloc = 2 * (nt + 1);
        const bfr* ag = us5 + (size_t)g * NTOK * 16;
        const bfr* xg = xin + (size_t)g * 1024 * 128;
        const int tq = ltid();
        const int arow = mt * 256 + (tq >> 3), acol = gt_lcol(tq);
        auto aptr = [&](int i, int kt) __attribute__((always_inline)) -> const bfr* {
            return (kt < nloc) ? ag + (size_t)(arow + 64 * i) * 512 + kt * 64 + acol
                               : xg + (size_t)(arow + 64 * i) * 128 + (kt - nloc) * 64 + acol;
        };
        const bfr* bg = gt + (size_t)g * 512 * 640 + (size_t)(nt * 128 + (tq >> 3)) * 640 + acol;
        auto bptr = [&](int i, int kt) __attribute__((always_inline)) -> const bfr* {
            return bg + (size_t)(64 * i) * 640 + ((kt < nloc) ? kt : (8 + kt - nloc)) * 64;
        };
        GEMM128(lds, nloc + 2, aptr, bptr, [&](const float* stg, int) __attribute__((always_inline)) {
            epi_rows8_pre<uint4>(stg,
                [&](int r, int c0) __attribute__((always_inline)) -> uint4 {
                    const int n = nt * 128 + c0;
                    return *(const uint4*)(ag + ((size_t)(mt * 256 + r) * 32 + (n >> 4)) * 16 + (n & 15)); },
                [&](int r, int c0, const float (&v)[8], const uint4& up) __attribute__((always_inline)) {
                    const int cb = mt * 256 + r;
                    const int n = nt * 128 + c0, tt = n >> 4, c1 = n & 15;
                    const size_t tok = (size_t)cb * 32 + tt;
                    float uu[8], z[8];
                    unpack8(up, uu);
#pragma unroll
                    for (int j = 0; j < 8; ++j) {
                        const float y = v[j] + dsk[g * 16 + c1 + j] * uu[j];
                        const float inner = 0.7978845608028654f * (y + 0.044715f * y * y * y);
                        z[j] = 0.5f * y * (1.0f + ftanh(inner));
                    }
                    *(uint4*)(zb + tok * 512 + g * 16 + c1) = pack8(z);
                });
        });
    }
}

DI void phase_o5(char* lds, const Ctx& P, int li) {
    const bfr* zb = (const bfr*)(P.ws + OFF_ZBUF);
    const bfr* w = (const bfr*)(P.ws + OFF_GLUT) + (size_t)li * 512 * 512;
    bfr* am = (bfr*)(P.ws + OFF_AMIX);
    for (int t = blockIdx.x; t < 512; t += gridDim.x) {
        int mt, nt; tile_remap(t, 128, 4, mt, nt);
        RowLoader A(zb, mt * 256, 512), B(w, nt * 128, 512);
        GEMM128(lds, 8, A, B, [&](const float* stg, int) __attribute__((always_inline)) {
            epi_rows8_pre<uint4>(stg,
                [&](int r, int c0) __attribute__((always_inline)) -> uint4 { return *(const uint4*)(zb + (size_t)(mt * 256 + r) * 512 + nt * 128 + c0); },
                [&](int r, int c0, const float (&v)[8], const uint4& zp) __attribute__((always_inline)) {
                    float zz[8], o[8];
                    unpack8(zp, zz);
#pragma unroll
                    for (int j = 0; j < 8; ++j) o[j] = zz[j] * sigmoidf_(v[j]);
                    *(uint4*)(am + (size_t)(mt * 256 + r) * 1024 + 512 + nt * 128 + c0) = pack8(o);
                });
        });
    }
}
DI void phase_router(char* lds, const Ctx& P, int layer) {
    const float* x = P.out;
    bfr* hb = (bfr*)(P.ws + OFF_HB);
    bfr* hlo = (bfr*)(P.ws + OFF_HLO);
    const bfr* rhi = (const bfr*)(P.ws + OFF_RHI) + (size_t)layer * 128 * 1024;
    const bfr* rlo = (const bfr*)(P.ws + OFF_RLO) + (size_t)layer * 128 * 1024;
    int* gcnt = (int*)(P.ws + OFF_CNT) + layer * 64;
    int* stok = (int*)(P.ws + OFF_TOK);
    float* sgate = (float*)(P.ws + OFF_GATE);
    int* tslot = (int*)(P.ws + OFF_TSLOT);
    int* lcnt = (int*)(lds + LDS_AUX);
    int* lbase = lcnt + 64;
    const float* bg = P.in[I_MBG] + layer * 4;
    const float* be = P.in[I_MBE] + layer * 32;
    const int tid = ltid();
    for (int u = blockIdx.x; u < 128; u += gridDim.x) {
        const int m0 = u * 256;
        norm_rows(x, P.in[I_NFFN] + (size_t)layer * DM, hb, hlo, nullptr, m0, 256);
        __syncthreads();
        const size_t roff = (size_t)(m0 + (tid >> 3)) * 1024 + gt_lcol(tid);
        const size_t boff = (size_t)(tid >> 3) * 1024 + gt_lcol(tid);
        auto aptr = [&](int i, int kt) __attribute__((always_inline)) -> const bfr* { return (kt < 32 ? hb : hlo) + roff + (size_t)(64 * i) * 1024 + (kt & 15) * 64; };
        auto bptr = [&](int i, int kt) __attribute__((always_inline)) -> const bfr* { return ((kt >= 16 && kt < 32) ? rlo : rhi) + boff + (size_t)(64 * i) * 1024 + (kt & 15) * 64; };
        GEMM128(lds, 48, aptr, bptr, [&](const float* stg, int) __attribute__((always_inline)) {
            if (tid < 64) lcnt[tid] = 0;
            __syncthreads();
            int seg0 = 0, seg1 = 0, p0 = 0, p1 = 0;
            float g0 = 0.f, g1 = 0.f;
            if (tid < 256) {
                const float* row = stg + tid * STG_LD;
                float gl[4];
#pragma unroll
                for (int j = 0; j < 4; ++j) gl[j] = row[32 + j] + bg[j];
                int gt = 0; float gm = gl[0];
#pragma unroll
                for (int j = 1; j < 4; ++j) if (gl[j] > gm) { gm = gl[j]; gt = j; }
                float gs = 0.f;
#pragma unroll
                for (int j = 0; j < 4; ++j) gs += __expf(gl[j] - gm);
                const float gw = 1.0f / gs;
                float l1 = -INFINITY, l2 = -INFINITY; int j1 = 0, j2 = 0;
                for (int j = 0; j < 8; ++j) {
                    const float v = row[gt * 8 + j] + be[gt * 8 + j];
                    if (v > l1) { l2 = l1; j2 = j1; l1 = v; j1 = j; }
                    else if (v > l2) { l2 = v; j2 = j; }
                }
                const float w1 = 1.0f / (1.0f + __expf(l2 - l1));
                g0 = gw * w1; g1 = gw * (1.0f - w1);
                seg0 = gt * 8 + j1; seg1 = 32 + gt * 8 + j2;
                p0 = atomicAdd(&lcnt[seg0], 1);
                p1 = atomicAdd(&lcnt[seg1], 1);
            }
            __syncthreads();
            if (tid < 64) { const int c = lcnt[tid]; lbase[tid] = c ? atomicAdd(&gcnt[tid], c) : 0; }
            __syncthreads();
            if (tid < 256) {
                const int q0 = lbase[seg0] + p0, q1 = lbase[seg1] + p1;
                stok[(size_t)seg0 * NTOK + q0] = m0 + tid; sgate[(size_t)seg0 * NTOK + q0] = g0;
                stok[(size_t)seg1 * NTOK + q1] = m0 + tid; sgate[(size_t)seg1 * NTOK + q1] = g1;
                tslot[m0 + tid] = seg0 * 32768 + q0;
            }
        });
    }
}

DI void moe_tables(char* lds, const Ctx& P, int layer) {
    int* cnt = (int*)(lds + LDS_AUX); int* rb0 = cnt + 64; int* hoff = rb0 + 65;
    const int* gcnt = (const int*)(P.ws + OFF_CNT) + layer * 64;
    const int tid = ltid();
    if (tid < 64) cnt[tid] = gcnt[tid];
    __syncthreads();
    if (tid == 0) {
        int acc = 0;
        for (int s = 0; s < 64; ++s) { rb0[s] = acc; hoff[s] = acc * 256; acc += (cnt[s] + 255) >> 8; }
        rb0[64] = acc;
    }
    __syncthreads();
}
DI int moe_find_seg(const int* rb0, int rbi) { int s = 0; while (rb0[s + 1] <= rbi) ++s; return s; }

DI void phase_moe_up(char* lds, const Ctx& P, int layer) {
    moe_tables(lds, P, layer);
    const int* cnt = (const int*)(lds + LDS_AUX); const int* rb0 = cnt + 64; const int* hoff = rb0 + 65;
    const bfr* hb = (const bfr*)(P.ws + OFF_HB);
    const bfr* wgu = (const bfr*)(P.ws + OFF_MWGU);
    const int* stok = (const int*)(P.ws + OFF_TOK);
    bfr* hid = (bfr*)(P.ws + OFF_HID);
    const int ntiles = rb0[64] * 4, G = gridDim.x;
    const int full = (ntiles / G) * G, rem = ntiles - full;
    const bool halves = rem > 0 && 2 * rem <= G;
    const int nwork = halves ? full + 2 * rem : ntiles;
    for (int wi = blockIdx.x; wi < nwork; wi += G) {
        const bool ishalf = halves && wi >= full;
        const int t = ishalf ? full + ((wi - full) >> 1) : wi;
        const int hc = ishalf ? ((wi - full) & 1) * 128 : 0;
        int rbi, nt; tile_remap(t, rb0[64], 4, rbi, nt);
        const int seg = moe_find_seg(rb0, rbi);
        const int rb = rbi - rb0[seg], e = seg & 31, c = cnt[seg];
        const bfr* ap[4];
        const int tq = ltid();
#pragma unroll
        for (int i = 0; i < 4; ++i) {
            int p = rb * 256 + (tq >> 3) + 64 * i; p = p < c ? p : c - 1;
            ap[i] = hb + (size_t)stok[(size_t)seg * NTOK + p] * 1024 + gt_lcol(tq);
        }
        auto aptr = [&](int i, int kt) __attribute__((always_inline)) -> const bfr* { return ap[i] + kt * 64; };
        const size_t hrow0 = (size_t)hoff[seg] + rb * 256;
        if (!ishalf) {
            RowLoader B(wgu + (size_t)e * 1024 * 1024, nt * 256, 1024);
            GEMM256(lds, 16, aptr, B, [&](const float* stg, int p) __attribute__((always_inline)) {
                epi_rows8(stg, [&](int r, int c0, const float (&v)[8]) __attribute__((always_inline)) {
                    float o[4];
#pragma unroll
                    for (int j = 0; j < 4; ++j) o[j] = v[j] * sigmoidf_(v[j]) * v[4 + j];
                    *(uint2*)(hid + (hrow0 + r) * 512 + ((nt * 256 + p * 128 + c0) >> 1)) = make_uint2(pk2(o[0], o[1]), pk2(o[2], o[3]));
                });
            });
        } else {
            RowLoader B(wgu + (size_t)e * 1024 * 1024, nt * 256 + hc, 1024);
            GEMM128(lds, 16, aptr, B, [&](const float* stg, int) __attribute__((always_inline)) {
                epi_rows8(stg, [&](int r, int c0, const float (&v)[8]) __attribute__((always_inline)) {
                    float o[4];
#pragma unroll
                    for (int j = 0; j < 4; ++j) o[j] = v[j] * sigmoidf_(v[j]) * v[4 + j];
                    *(uint2*)(hid + (hrow0 + r) * 512 + ((nt * 256 + hc + c0) >> 1)) = make_uint2(pk2(o[0], o[1]), pk2(o[2], o[3]));
                });
            });
        }
    }
}

struct F12 { float4 a, b; uint4 y; };
DI void phase_moe_down(char* lds, const Ctx& P, int layer, int k, float* x) {
    const G4 G = g4_make(lds);
    int* cnt = (int*)(G.lds + G4_AUX); int* rb0 = cnt + 64; int* hoff = rb0 + 65;
    {
        const int* gcnt = (const int*)(P.ws + OFF_CNT) + layer * 64;
        if (G.tid < 64) cnt[G.tid] = gcnt[G.tid];
        g4_bar(G);
        if (G.tid == 0) {
            int acc = 0, hacc = 0;
            for (int s = 0; s < 64; ++s) { rb0[s] = acc; hoff[s] = hacc; acc += (cnt[s] + 127) >> 7; hacc += ((cnt[s] + 255) >> 8) * 256; }
            rb0[64] = acc;
        }
        g4_bar(G);
    }
    const bfr* hid = (const bfr*)(P.ws + OFF_HID);
    const bfr* wd = (const bfr*)(P.ws + OFF_MWD);
    const int* stok = (const int*)(P.ws + OFF_TOK);
    const float* sgate = (const float*)(P.ws + OFF_GATE);
    const int* tslot = (const int*)(P.ws + OFF_TSLOT);
    bfr* y0 = (bfr*)(P.ws + OFF_Y0);
    const int rbA = rb0[k * 32], rbB = rb0[k * 32 + 32];
    const int ntiles = (rbB - rbA) * 8;
    for (int t = G.vb; t < ntiles; t += G.nvb) {
        int rbi, nt; tile_remap(t, rbB - rbA, 8, rbi, nt); rbi += rbA;
        const int seg = moe_find_seg(rb0, rbi);
        const int rb = rbi - rb0[seg], e = seg & 31, c = cnt[seg];
        const int hrow0 = hoff[seg] + rb * 128;
        G4RowLoader A(G, hid, hrow0, 512), B(G, wd + (size_t)e * 1024 * 512, nt * 128, 512);
        int* ltok = (int*)(G.lds + G4_AUX + 1024); float* lgate = (float*)(G.lds + G4_AUX + 1536); int* lrow = (int*)(G.lds + G4_AUX + 2048);
        if (G.tid < 128) {
            const int p = rb * 128 + G.tid;
            const int tok = p < c ? stok[(size_t)seg * NTOK + p] : -1;
            ltok[G.tid] = tok;
            lgate[G.tid] = p < c ? sgate[(size_t)seg * NTOK + p] : 0.f;
            int r0 = 0;
            if (k == 1 && tok >= 0) { const int ts = tslot[tok]; r0 = hoff[ts >> 15] + (ts & 32767); }
            lrow[G.tid] = r0;
        }
        if (k == 0) {
            g4_gemm_tile(G, G.lds, 8, A, B, [&](const float* stg) __attribute__((always_inline)) {
                g4_epi_rows8(G, stg, [&](int r, int c0, const float (&v)[8]) __attribute__((always_inline)) {
                    if (ltok[r] >= 0) {
                        const float gt = lgate[r];
                        float o[8];
#pragma unroll
                        for (int j = 0; j < 8; ++j) o[j] = gt * v[j];
                        *(uint4*)(y0 + (size_t)(hrow0 + r) * 1024 + nt * 128 + c0) = pack8(o);
                    }
                });
            });
        } else {
            g4_gemm_tile(G, G.lds, 8, A, B, [&](const float* stg) __attribute__((always_inline)) {
                g4_epi_rows8_pre<F12>(G, stg,
                    [&](int r, int c0) __attribute__((always_inline)) -> F12 {
                        int tok = ltok[r]; tok = tok < 0 ? 0 : tok;
                        const float* d = x + (size_t)tok * DM + nt * 128 + c0;
                        F12 o; o.a = *(const float4*)d; o.b = *(const float4*)(d + 4);
                        o.y = *(const uint4*)(y0 + (size_t)lrow[r] * 1024 + nt * 128 + c0);
                        return o; },
                    [&](int r, int c0, const float (&v)[8], const F12& o) __attribute__((always_inline)) {
                        const int tok = ltok[r];
                        if (tok >= 0) {
                            const float gt = lgate[r];
                            float yv[8];
                            unpack8(o.y, yv);
                            float* d = x + (size_t)tok * DM + nt * 128 + c0;
                            *(float4*)d = make_float4(o.a.x + gt * v[0] + yv[0], o.a.y + gt * v[1] + yv[1], o.a.z + gt * v[2] + yv[2], o.a.w + gt * v[3] + yv[3]);
                            *(float4*)(d + 4) = make_float4(o.b.x + gt * v[4] + yv[4], o.b.y + gt * v[5] + yv[5], o.b.z + gt * v[6] + yv[6], o.b.w + gt * v[7] + yv[7]);
                        }
                    });
            });
        }
    }
}
constexpr int PH_PER_LAYER = 11;
constexpr int N_PHASES = 1 + 4 * PH_PER_LAYER;

DI void phase_prologue(char* lds, const Ctx& P) {
    for (int u = blockIdx.x; u < 64; u += gridDim.x) s5_tables(lds, P, u >> 5, u & 31);
    const bool excl = gridDim.x >= 128;
    if (excl && blockIdx.x < 64) return;
    unsigned base = 0;
    const int wk = excl ? (int)blockIdx.x - 64 : (int)blockIdx.x, nw = excl ? (int)gridDim.x - 64 : (int)gridDim.x;
    for (int i = 0; i < 2; ++i) {
        cvt_matrix(lds, P.in[I_EWIN] + (size_t)i * 1024 * 2304, 1024, 2304, (bfr*)(P.ws + OFF_WINE) + (size_t)i * 2304 * 1024, 1024, 0, wk, nw, base);
        cvt_matrix(lds, P.in[I_EWOUT] + (size_t)i * 1024 * 1024, 1024, 1024, (bfr*)(P.ws + OFF_WOUTE) + (size_t)i * 1024 * 1024, 1024, 0, wk, nw, base);
        cvt_matrix(lds, P.in[I_OWIN] + (size_t)i * 1024 * 2048, 1024, 2048, (bfr*)(P.ws + OFF_WINO) + (size_t)i * 2048 * 1024, 1024, 0, wk, nw, base);
        cvt_matrix(lds, P.in[I_OWOUT] + (size_t)i * 1024 * 1024, 1024, 1024, (bfr*)(P.ws + OFF_WOUTO) + (size_t)i * 1024 * 1024, 1024, 0, wk, nw, base);
        cvt_matrix(lds, P.in[I_W2] + (size_t)i * 64 * 512, 64, 512, (bfr*)(P.ws + OFF_W2T) + (size_t)i * 512 * 64, 64, 0, wk, nw, base);
        cvt_matrix(lds, P.in[I_A2] + (size_t)i * 64 * 512, 64, 512, (bfr*)(P.ws + OFF_A2T) + (size_t)i * 512 * 64, 64, 0, wk, nw, base);
        cvt_matrix(lds, P.in[I_G2] + (size_t)i * 128 * 512, 128, 512, (bfr*)(P.ws + OFF_G2T) + (size_t)i * 512 * 128, 128, 0, wk, nw, base);
        for (int g = 0; g < 4; ++g)
            cvt_matrix(lds, P.in[I_POOLW] + (size_t)(i * 4 + g) * 128 * 128, 128, 128, (bfr*)(P.ws + OFF_POOLT) + (size_t)(i * 4 + g) * 128 * 128, 128, 0, wk, nw, base);
        cvt_matrix(lds, P.in[I_WGLU] + (size_t)i * 512 * 512, 512, 512, (bfr*)(P.ws + OFF_GLUT) + (size_t)i * 512 * 512, 512, 0, wk, nw, base);
    }
    const int gtid = wk * NTHREADS + ltid(), gsz = nw * NTHREADS;
    {
        bfr* rhi = (bfr*)(P.ws + OFF_RHI); bfr* rlo = (bfr*)(P.ws + OFF_RLO);
        for (int idx = gtid; idx < 4 * 128 * 1024; idx += gsz) {
            const int k = idx & 1023, n = (idx >> 10) & 127, l = idx >> 17;
            float w = 0.f;
            if (n < 32) w = P.in[I_MWE][((size_t)l * 1024 + k) * 32 + n];
            else if (n < 36) w = P.in[I_MWG][((size_t)l * 1024 + k) * 4 + (n - 32)];
            const bfr h = f2bf(w);
            rhi[idx] = h; rlo[idx] = f2bf(w - bf2f(h));
        }
    }
    {
        bfr* v12 = (bfr*)(P.ws + OFF_V12T);
        const float* v1 = P.in[I_V1]; const float* v2 = P.in[I_V2];
        for (int idx = gtid; idx < 512 * 512; idx += gsz) {
            const int k = idx & 511, n = idx >> 9;
            float s = 0.f;
            for (int r = 0; r < 32; ++r) s += v1[k * 32 + r] * v2[r * 512 + n];
            v12[idx] = f2bf(s);
        }
    }
    for (int tt = wk; tt < 512; tt += nw)
        norm_rows(P.in[I_X], P.in[I_NMIX], (bfr*)(P.ws + OFF_HB), nullptr, P.out, tt * 64, 64);
}

DI Ctx mkctx(unsigned char* ws, float* out) {
    size_t z = 0;
    asm volatile("" : "+s"(z));
    Ctx c;
    c.in.p = (KArgPtr)__builtin_amdgcn_kernarg_segment_ptr() + z;
    c.ws = ws + z; c.out = (float*)((char*)out + z);
    return c;
}
__global__ void __launch_bounds__(NTHREADS, 2) fwd_kernel(Params PA) {
    extern __shared__ __attribute__((aligned(16))) char lds[];
    if (threadIdx.x == 0) { *(uint4*)(lds + LDS_BYTES - 16) = make_uint4(0u, 0u, 0u, 0u); *(uint4*)(lds + LDS_BYTES - 32) = make_uint4(0u, 0u, 0u, 0u); }
    __syncthreads();
    XcdBarrier bar = xcd_barrier_post((unsigned*)(PA.ws + OFF_BAR), (volatile LAS unsigned*)(lds + LDS_BYTES - 16));
    const int lo = PA.ph_lo, hi = PA.ph_hi;
#ifndef RWKV_CHUNKED
#define RWKV_CHUNKED 1
#endif
#ifndef DUP_PH
#define DUP_PH (-1)
#endif
#define DUPX(k, call) do { call; if (DUP_PH == (k)) { __syncthreads(); call; } } while (0)
#define RUNS(id) ((id) >= lo && (id) < hi)
#define P mkctx(PA.ws, PA.out)
#define SEAM(id) do { if ((id) > lo && (id) < hi) xcd_barrier(bar); } while (0)
    if (RUNS(0)) DUPX(100, phase_prologue(lds, P));
    for (int layer = 0; layer < 4; ++layer) {
        const int base = 1 + layer * PH_PER_LAYER;
        const int li = layer >> 1;
        if ((layer & 1) == 0) {
            SEAM(base + 0); if (RUNS(base + 0)) DUPX(0, phase_e1(lds, P, li));
            SEAM(base + 1); if (RUNS(base + 1)) DUPX(1, phase_e2a(P, li));
            SEAM(base + 2); if (RUNS(base + 2)) DUPX(2, phase_e2b(lds, P, li));
#if RWKV_CHUNKED
            SEAM(base + 3); if (RUNS(base + 3)) { DUPX(43, phase_r1(lds, P, li)); if (DUP_PH >= 45 && DUP_PH <= 47) phase_r1(lds, P, li, DUP_PH - 44); xcd_barrier(bar); DUPX(44, phase_r2(P)); }
#else
            SEAM(base + 3); if (RUNS(base + 3)) { phase_e3(lds, P, li); if (DUP_PH == 3) phase_e3(lds, P, li, 3); }
#endif
            SEAM(base + 4); if (RUNS(base + 4)) DUPX(4, phase_e4(P, li));
            SEAM(base + 5); if (RUNS(base + 5)) { phase_wout(lds, P, (const bfr*)(P.ws + OFF_WOUTE) + (size_t)li * 1024 * 1024, P.out); if (DUP_PH == 5) phase_wout(lds, P, (const bfr*)(P.ws + OFF_WOUTE) + (size_t)li * 1024 * 1024, (float*)(P.ws + OFF_EV)); }
        } else {
            SEAM(base + 0); if (RUNS(base + 0)) DUPX(10, phase_o1(lds, P, li));
            SEAM(base + 1); if (RUNS(base + 1)) DUPX(11, phase_o2(lds, P, li));
            SEAM(base + 2); if (RUNS(base + 2)) DUPX(12, phase_o3(lds, P, li, layer));
            SEAM(base + 3); if (RUNS(base + 3)) DUPX(13, phase_o4(lds, P, li));
            SEAM(base + 4); if (RUNS(base + 4)) DUPX(14, phase_o5(lds, P, li));
            SEAM(base + 5); if (RUNS(base + 5)) { phase_wout(lds, P, (const bfr*)(P.ws + OFF_WOUTO) + (size_t)li * 1024 * 1024, P.out); if (DUP_PH == 5) phase_wout(lds, P, (const bfr*)(P.ws + OFF_WOUTO) + (size_t)li * 1024 * 1024, (float*)(P.ws + OFF_EV)); }
        }
        SEAM(base + 6);
        if (RUNS(base + 6)) {
            phase_router(lds, P, layer);
            if (gridDim.x >= 256) {
                const int b = blockIdx.x;
                const int per = 6144 / (int)gridDim.x;
                const int lo_n = per / 2, hi_n = per + per / 2;
                if (b < 128) moe_convert_range(lds, P, layer, (int)(gridDim.x - 128) * hi_n + b * lo_n, (int)(gridDim.x - 128) * hi_n + (b + 1) * lo_n);
                else { const int e1 = (b - 128 + 1) * hi_n; moe_convert_range(lds, P, layer, (b - 128) * hi_n, e1 < 6144 ? e1 : 6144); }
            } else {
                const int per = (6144 + (int)gridDim.x - 1) / (int)gridDim.x;
                const int t0 = blockIdx.x * per, t1 = t0 + per;
                moe_convert_range(lds, P, layer, t0 < 6144 ? t0 : 6144, t1 < 6144 ? t1 : 6144);
            }
        }
        SEAM(base + 7); if (RUNS(base + 7)) DUPX(7, phase_moe_up(lds, P, layer));
        SEAM(base + 8); if (RUNS(base + 8)) DUPX(8, phase_moe_down(lds, P, layer, 0, P.out));
        SEAM(base + 9); if (RUNS(base + 9)) phase_moe_down(lds, P, layer, 1, P.out);
        SEAM(base + 10);
        if (RUNS(base + 10) && layer < 3) {
            for (int rep = 0; rep < (DUP_PH == 20 ? 2 : 1); ++rep)
            for (int tt = blockIdx.x; tt < 512; tt += gridDim.x)
                norm_rows(P.out, P.in[I_NMIX] + (size_t)(layer + 1) * DM, (bfr*)(P.ws + OFF_HB), nullptr, nullptr, tt * 64, 64);
        }
    }
#undef P
#undef RUNS
#undef SEAM
}

#ifndef N_LAUNCH_SPLIT
#define N_LAUNCH_SPLIT 0
#endif
extern "C" void kernel_launch(void* const* d_in, const int* in_sizes, int n_in, void* d_out, int out_size, void* d_ws, size_t ws_size, hipStream_t stream) {
    static int grid = 0;
    if (grid == 0) {
        if (n_in != N_INPUTS || out_size != NTOK * DM || ws_size < WS_NEEDED || ws_size < OFF_RC_END) {
            fprintf(stderr, "kernel_launch: unexpected shapes: n_in %d out %d ws %zu (need %zu)\n", n_in, out_size, ws_size, (size_t)WS_NEEDED);
            grid = -1; return;
        }
        int dev = 0, cus = 0, per_cu = 0;
        (void)hipGetDevice(&dev);
        (void)hipDeviceGetAttribute(&cus, hipDeviceAttributeMultiprocessorCount, dev);
        if (hipFuncSetAttribute((const void*)fwd_kernel, hipFuncAttributeMaxDynamicSharedMemorySize, LDS_BYTES) != hipSuccess) { fprintf(stderr, "kernel_launch: hipFuncSetAttribute failed\n"); grid = -1; return; }
        if (hipOccupancyMaxActiveBlocksPerMultiprocessor(&per_cu, (const void*)fwd_kernel, NTHREADS, LDS_BYTES) != hipSuccess) per_cu = 1;
        (void)hipGetLastError();
        if (per_cu < 1) per_cu = 1;
        if (per_cu > 1) per_cu = 1;
        if (cus <= 0) cus = 256;
        grid = cus * per_cu;
    }
    if (grid < 0) return;
    (void)hipMemsetAsync(d_ws, 0, OFF_ZERO_END, stream);
    Params p{};
    for (int i = 0; i < N_INPUTS; ++i) p.in[i] = (const float*)d_in[i];
    p.out = (float*)d_out; p.ws = (unsigned char*)d_ws;
#if N_LAUNCH_SPLIT
    for (int ph = 0; ph < N_PHASES - 1; ++ph) {
        p.ph_lo = ph; p.ph_hi = ph + 1;
        hipLaunchKernelGGL(fwd_kernel, dim3(grid), dim3(NTHREADS), LDS_BYTES, stream, p);
    }
#else
    p.ph_lo = 0; p.ph_hi = N_PHASES;
    hipLaunchKernelGGL(fwd_kernel, dim3(grid), dim3(NTHREADS), LDS_BYTES, stream, p);
#endif
}
```

```cpp
#include <hip/hip_runtime.h>
#include <stdint.h>
#include <stdio.h>

typedef unsigned short bfr;
typedef __attribute__((ext_vector_type(8))) short bf16x8;
typedef __attribute__((ext_vector_type(16))) float f32x16;
typedef __attribute__((ext_vector_type(2))) __bf16 bf16x2_t;
#define DI __device__ __forceinline__
#define MFMA32(a, b, c) __builtin_amdgcn_mfma_f32_32x32x16_bf16((a), (b), (c), 0, 0, 0)

constexpr int NTOK = 32768, DM = 1024, SEQ = 2048, NB = 16;
constexpr int EVEN_IN = 2304, ODD_IN = 2048;
constexpr int NTHREADS = 512;
constexpr int NWAVES = NTHREADS / 64;
constexpr int LDS_BYTES = 161792;

enum { I_X = 0, I_NMIX, I_NFFN, I_EWIN, I_MU, I_W0, I_W2, I_A0, I_A2, I_G2, I_KK, I_KA, I_RK, I_LNG, I_LNB, I_V0, I_V1, I_V2,
       I_POOLW, I_POOLS, I_EWOUT, I_OWIN, I_QN, I_KN, I_LQ1, I_LK1, I_LQ2, I_LK2, I_SUBLN, I_ARE, I_AIM, I_LSTEP, I_BRE, I_BIM,
       I_CRE, I_CIM, I_S5D, I_WGLU, I_OWOUT, I_MWG, I_MBG, I_MWE, I_MBE, I_MWGATE, I_MWUP, I_MWDOWN, N_INPUTS };

constexpr size_t al256(size_t x) { return (x + 255) & ~(size_t)255; }
constexpr size_t OFF_BAR   = 0;
constexpr size_t OFF_CNT   = 16384;
constexpr size_t OFF_ZERO_END = 32768;
constexpr size_t OFF_WINE  = 65536;
constexpr size_t OFF_WOUTE = OFF_WINE  + (size_t)2 * 2304 * 1024 * 2;
constexpr size_t OFF_WINO  = OFF_WOUTE + (size_t)2 * 1024 * 1024 * 2;
constexpr size_t OFF_WOUTO = OFF_WINO  + (size_t)2 * 2048 * 1024 * 2;
constexpr size_t OFF_W2T   = OFF_WOUTO + (size_t)2 * 1024 * 1024 * 2;
constexpr size_t OFF_A2T   = OFF_W2T   + (size_t)2 * 512 * 64 * 2;
constexpr size_t OFF_G2T   = OFF_A2T   + (size_t)2 * 512 * 64 * 2;
constexpr size_t OFF_V12T  = OFF_G2T   + (size_t)2 * 512 * 128 * 2;
constexpr size_t OFF_POOLT = OFF_V12T  + (size_t)512 * 512 * 2;
constexpr size_t OFF_GLUT  = OFF_POOLT + (size_t)2 * 4 * 128 * 128 * 2;
constexpr size_t OFF_RHI   = OFF_GLUT  + (size_t)2 * 512 * 512 * 2;
constexpr size_t OFF_RLO   = OFF_RHI   + (size_t)4 * 128 * 1024 * 2;
constexpr size_t OFF_S5GT  = OFF_RLO   + (size_t)4 * 128 * 1024 * 2;
constexpr size_t OFF_S5BL  = OFF_S5GT  + (size_t)2 * 32 * 512 * 640 * 2;
constexpr size_t OFF_S5L32 = OFF_S5BL  + (size_t)2 * 32 * 128 * 512 * 2;
constexpr size_t OFF_MWGU  = al256(OFF_S5L32 + (size_t)2 * 32 * 64 * 2 * 4);
constexpr size_t OFF_MWD   = OFF_MWGU  + (size_t)32 * 1024 * 1024 * 2;
constexpr size_t OFF_HB    = OFF_MWD   + (size_t)32 * 1024 * 512 * 2;
constexpr size_t OFF_U     = OFF_HB    + (size_t)NTOK * 1024 * 2;
constexpr size_t OFF_US5   = OFF_U     + (size_t)NTOK * 1024 * 2;
constexpr size_t OFF_AMIX  = OFF_U     + (size_t)NTOK * 2304 * 2;
constexpr size_t OFF_VFIRST= OFF_AMIX  + (size_t)NTOK * 1024 * 2;
constexpr size_t OFF_TOK   = OFF_VFIRST+ (size_t)NTOK * 512 * 2;
constexpr size_t OFF_GATE  = OFF_TOK   + (size_t)64 * NTOK * 4;
constexpr size_t OFF_HID   = OFF_GATE  + (size_t)64 * NTOK * 4;
constexpr size_t OFF_HLO   = OFF_HID;
constexpr size_t OFF_EV    = OFF_HID   + (size_t)81920 * 512 * 2;
constexpr size_t OFF_S     = OFF_EV;
constexpr size_t OFF_MV2   = OFF_S     + (size_t)NTOK * 256 * 2;
constexpr size_t OFF_DLOG  = OFF_MV2   + (size_t)NTOK * 512 * 2;
constexpr size_t OFF_ABUF  = OFF_DLOG  + (size_t)NTOK * 512 * 4;
constexpr size_t OFF_GBUF  = OFF_ABUF  + (size_t)NTOK * 512 * 2;
constexpr size_t OFF_VGATE = OFF_GBUF  + (size_t)NTOK * 512 * 2;
constexpr size_t OFF_Y     = OFF_VGATE + (size_t)NTOK * 512 * 2;
constexpr size_t OFF_DPOOL = OFF_Y;
constexpr size_t OFF_BONUS = OFF_Y     + (size_t)NTOK * 512 * 4;
constexpr size_t OFF_EV_END= OFF_BONUS + (size_t)NTOK * 512 * 4;
constexpr size_t OFF_Y0    = OFF_EV;
constexpr size_t OFF_TSLOT = OFF_Y0    + (size_t)40960 * 1024 * 2;
static_assert(OFF_TSLOT + (size_t)NTOK * 4 <= OFF_EV_END, "MoE scratch must fit the mixer scratch region");
constexpr size_t OFF_QN    = OFF_EV;
constexpr size_t OFF_KN    = OFF_QN    + (size_t)NTOK * 512 * 2;
constexpr size_t OFF_VT    = OFF_KN    + (size_t)NTOK * 512 * 2;
constexpr size_t OFF_XLOC  = OFF_VT    + (size_t)NTOK * 512 * 2;
constexpr size_t OFF_XIN   = OFF_XLOC  + (size_t)32 * 1024 * 128 * 4;
constexpr size_t OFF_ZBUF  = OFF_XIN   + (size_t)32 * 1024 * 128 * 2;
constexpr size_t OFF_OD_END= OFF_ZBUF  + (size_t)NTOK * 512 * 2;
constexpr size_t WS_NEEDED = OFF_EV_END > OFF_OD_END ? OFF_EV_END : OFF_OD_END;

struct Params {
    const float* in[N_INPUTS];
    float* out;
    unsigned char* ws;
    int ph_lo, ph_hi;
};
typedef const __attribute__((address_space(4))) char* KArgPtr;
struct InTab {
    KArgPtr p;
    DI const float* operator[](int i) const {
        const float* q = *(const float* const __attribute__((address_space(4)))*)(p + 8 * i);
        return (const float*)(const __attribute__((address_space(1))) float*)q;
    }
};
struct Ctx { InTab in; unsigned char* ws; float* out; };

DI unsigned pk2(float a, float b) { bf16x2_t v; v[0] = (__bf16)a; v[1] = (__bf16)b; return __builtin_bit_cast(unsigned, v); }
DI bfr f2bf(float a) { return (bfr)(pk2(a, 0.f) & 0xffffu); }
DI float bf2f(bfr b) { return __uint_as_float(((unsigned)b) << 16); }
DI float bflo(unsigned u) { return __uint_as_float(u << 16); }
DI float bfhi(unsigned u) { return __uint_as_float(u & 0xffff0000u); }
DI uint4 pack8(const float (&v)[8]) { return make_uint4(pk2(v[0], v[1]), pk2(v[2], v[3]), pk2(v[4], v[5]), pk2(v[6], v[7])); }
DI void unpack8(uint4 u, float (&v)[8]) { v[0] = bflo(u.x); v[1] = bfhi(u.x); v[2] = bflo(u.y); v[3] = bfhi(u.y); v[4] = bflo(u.z); v[5] = bfhi(u.z); v[6] = bflo(u.w); v[7] = bfhi(u.w); }
DI float frcp(float x) { return __builtin_amdgcn_rcpf(x); }
DI float fexp(float x) { return __builtin_amdgcn_exp2f(x * 1.4426950408889634f); }
DI float sigmoidf_(float x) { return frcp(1.0f + fexp(-x)); }
DI float ftanh(float x) { return 2.0f * frcp(1.0f + fexp(-2.0f * x)) - 1.0f; }
DI float fsoftplus(float z) { return z > 20.0f ? z : __logf(1.0f + fexp(z)); }
template <int CTRL> DI float dpp_f(float x) { return __builtin_bit_cast(float, __builtin_amdgcn_update_dpp(0, __builtin_bit_cast(int, x), CTRL, 0xf, 0xf, false)); }
DI float row16_sum(float s) {
    s += dpp_f<0x128>(s); s += dpp_f<0x124>(s); s += dpp_f<0x122>(s); s += dpp_f<0x121>(s); return s; }
DI int ltid() { int t = threadIdx.x; asm volatile("" : "+v"(t)); return t; }
DI float dot4n(float s0, float s1, float s2, float s3, const float4& a) {
    float d;
    asm("v_mul_f32 %0, %1, %5\n\tv_fma_f32 %0, %2, %6, %0\n\tv_fma_f32 %0, %3, %7, %0\n\tv_fma_f32 %0, %4, %8, %0\n\ts_nop 1"
        : "=&v"(d) : "v"(s0), "v"(s1), "v"(s2), "v"(s3), "v"(a.x), "v"(a.y), "v"(a.z), "v"(a.w));
    return d;
}
DI void rw_upd(float& S, float w, float sa, float b, float vi, float k) {
    float t;
    asm("v_mul_f32 %1, %4, %5\n\tv_fma_f32 %1, %2, %3, %1\n\tv_fma_f32 %0, %0, %6, %1"
        : "+v"(S), "=&v"(t) : "v"(sa), "v"(b), "v"(vi), "v"(k), "v"(w));
}
DI float wave_sum(float s) { s = row16_sum(s); s += __shfl_xor(s, 16); s += __shfl_xor(s, 32); return s; }
#define XB_TMO      128
#define XB_XCNT(j)  (256  + 64 * (j))
#define XB_XSUB(j)  (1280 + 64 * (j))
#define XB_XGEN(j)  (2304 + 64 * (j))
#define XB_TOP      3328
#define XB_TOPGEN   3392
#define XCD_BAR_WORDS 3456
#define XB_SPIN_CAP (1u << 18)
#define LAS __attribute__((address_space(3)))

__device__ __forceinline__ unsigned xb_ld(unsigned* p)              { return __hip_atomic_load(p, __ATOMIC_RELAXED, __HIP_MEMORY_SCOPE_AGENT); }
__device__ __forceinline__ unsigned xb_add(unsigned* p, unsigned v) { return __hip_atomic_fetch_add(p, v, __ATOMIC_RELAXED, __HIP_MEMORY_SCOPE_AGENT); }
__device__ __forceinline__ unsigned xb_xcc_id() { return (unsigned)__builtin_amdgcn_s_getreg((3 << 11) | 20) & 0xFu; }
#define XB_SPIN(cond, bar) do { unsigned _sp = 0; while (cond) { __builtin_amdgcn_s_sleep(1); \
    if ((++_sp & 255u) == 0u) { if (xb_ld(&(bar)[XB_TMO])) break; if (_sp > XB_SPIN_CAP) { atomicAdd(&(bar)[XB_TMO], 1u); break; } } } } while (0)

struct XcdBarrier {
    unsigned* bar; unsigned x;
    volatile LAS unsigned* st;
};
__device__ __forceinline__ XcdBarrier xcd_barrier_post(unsigned* bar, volatile LAS unsigned* st) {
    XcdBarrier b; b.bar = bar; b.x = xb_xcc_id(); b.st = st;
    if (threadIdx.x == 0) (void)xb_add(&bar[XB_XCNT(b.x)], 1u);
    return b;
}
__device__ __forceinline__ void xcd_barrier_complete(unsigned* bar, unsigned x, unsigned& nloc, unsigned& nx) {
    const unsigned G = gridDim.x * gridDim.y * gridDim.z;
    unsigned sum, cnt, mine, sp = 0u;
    for (;;) {
        sum = 0u; cnt = 0u; mine = 0u;
#pragma unroll
        for (unsigned j = 0; j < 16; ++j) { const unsigned c = xb_ld(&bar[XB_XCNT(j)]); sum += c; cnt += (c > 0u) ? 1u : 0u; mine = (j == x) ? c : mine; }
        if (sum == G) break;
        __builtin_amdgcn_s_sleep(1);
        if ((++sp & 255u) == 0u) { if (xb_ld(&bar[XB_TMO])) break; if (sp > XB_SPIN_CAP) { atomicAdd(&bar[XB_TMO], 1u); break; } }
    }
    nloc = mine > 0u ? mine : 1u; nx = cnt > 0u ? cnt : 1u;
}
__device__ __forceinline__ void xcd_barrier(const XcdBarrier& b) {
    asm volatile("s_waitcnt vmcnt(0)" ::: "memory");
    __syncthreads();
    if (threadIdx.x == 0) {
        unsigned* bar = b.bar;
        __builtin_amdgcn_s_waitcnt(0);
        unsigned nloc = b.st[0], nx = b.st[1];
        if (nloc == 0u) { xcd_barrier_complete(bar, b.x, nloc, nx); b.st[0] = nloc; b.st[1] = nx; }
        const unsigned old = xb_add(&bar[XB_XSUB(b.x)], 1u);
        const unsigned gen = old / nloc;
        if (old + 1u == (gen + 1u) * nloc) {
            __builtin_amdgcn_fence(__ATOMIC_RELEASE, "agent");
            asm volatile("s_waitcnt vmcnt(0)" ::: "memory");
            const unsigned og = xb_add(&bar[XB_TOP], 1u);
            const unsigned tg = og / nx;
            if (og + 1u == (tg + 1u) * nx) xb_add(&bar[XB_TOPGEN], 1u);
            else XB_SPIN(xb_ld(&bar[XB_TOPGEN]) == tg, bar);
            __builtin_amdgcn_fence(__ATOMIC_ACQUIRE, "agent");
            xb_add(&bar[XB_XGEN(b.x)], 1u);
            asm volatile("s_waitcnt vmcnt(0)" ::: "memory");
        } else {
            XB_SPIN(xb_ld(&bar[XB_XGEN(b.x)]) == gen, bar);
            __builtin_amdgcn_fence(__ATOMIC_ACQUIRE, "agent");
            asm volatile("s_waitcnt vmcnt(0)" ::: "memory");
        }
    }
    __syncthreads();
}

constexpr int LDA = 72;
constexpr int TILE_B = 128 * LDA * 2;
constexpr int STG_LD = 132;
constexpr int LDS_AUX = 139264;
typedef const __attribute__((address_space(1))) unsigned* GPtrU;
typedef __attribute__((address_space(3))) unsigned* LPtrU;
DI int gt_lcol(int t) { return (((t & 7) ^ ((t >> 4) & 7)) * 8); }

template <int WR, int WC, int MI, int NI, class AF, class BF, class EF>
DI void gemm8(char* lds, int nk, AF aptr, BF bptr, EF epi) {
    static_assert(WR * WC == NWAVES && WR * MI * 32 == 256, "wave grid");
    constexpr int NT = WC * NI * 32, A_BYTES = 256 * 128, STAGE = A_BYTES + NT * 128, NB = NT / 64, NP = NT / 128;
    const int tid = ltid(), lane = tid & 63, wave = tid >> 6;
    const int wr = wave / WC, wc = wave % WC;
    f32x16 acc[MI][NI];
#pragma unroll
    for (int a = 0; a < MI; ++a)
#pragma unroll
        for (int b = 0; b < NI; ++b)
#pragma unroll
            for (int r = 0; r < 16; ++r) acc[a][b][r] = 0.f;
#define G8_DMA(kt_, base_) do { char* db_ = (base_) + tid * 16; \
        _Pragma("unroll") for (int i_ = 0; i_ < 4; ++i_) __builtin_amdgcn_global_load_lds((GPtrU)aptr(i_, kt_), (LPtrU)(db_ + i_ * 8192), 16, 0, 0); \
        _Pragma("unroll") for (int i_ = 0; i_ < NB; ++i_) __builtin_amdgcn_global_load_lds((GPtrU)bptr(i_, kt_), (LPtrU)(db_ + A_BYTES + i_ * 8192), 16, 0, 0); } while (0)
#define G8_KS(cb_, ao_, bo_) do { bf16x8 af_[MI], bf_[NI]; \
        _Pragma("unroll") for (int m_ = 0; m_ < MI; ++m_) af_[m_] = *(const bf16x8*)((cb_) + (ao_) + m_ * 4096); \
        _Pragma("unroll") for (int n_ = 0; n_ < NI; ++n_) bf_[n_] = *(const bf16x8*)((cb_) + (bo_) + n_ * 4096); \
        _Pragma("unroll") for (int m_ = 0; m_ < MI; ++m_) _Pragma("unroll") for (int n_ = 0; n_ < NI; ++n_) acc[m_][n_] = MFMA32(af_[m_], bf_[n_], acc[m_][n_]); } while (0)
    const int ln = lane & 31, hf = lane >> 5, sw = (ln >> 1) & 7;
    const int arow = (wr * MI * 32 + ln) * 128, brow = A_BYTES + (wc * NI * 32 + ln) * 128;
    int ao0 = arow + ((0 + hf) ^ sw) * 16, ao1 = arow + ((2 + hf) ^ sw) * 16, ao2 = arow + ((4 + hf) ^ sw) * 16, ao3 = arow + ((6 + hf) ^ sw) * 16;
    int bo0 = brow + ((0 + hf) ^ sw) * 16, bo1 = brow + ((2 + hf) ^ sw) * 16, bo2 = brow + ((4 + hf) ^ sw) * 16, bo3 = brow + ((6 + hf) ^ sw) * 16;
    asm volatile("" : "+v"(ao0), "+v"(ao1), "+v"(ao2), "+v"(ao3), "+v"(bo0), "+v"(bo1), "+v"(bo2), "+v"(bo3));
    G8_DMA(0, lds);
    asm volatile("s_waitcnt vmcnt(0)" ::: "memory");
    __syncthreads();
    int buf = 0;
#pragma unroll 1
    for (int kt = 0; kt < nk - 1; ++kt) {
        G8_DMA(kt + 1, lds + (buf ^ 1) * STAGE);
        const char* cb = lds + buf * STAGE;
        G8_KS(cb, ao0, bo0); G8_KS(cb, ao1, bo1); G8_KS(cb, ao2, bo2); G8_KS(cb, ao3, bo3);
        asm volatile("s_waitcnt vmcnt(0)" ::: "memory");
        __syncthreads();
        buf ^= 1;
    }
    {
        const char* cb = lds + buf * STAGE;
        G8_KS(cb, ao0, bo0); G8_KS(cb, ao1, bo1); G8_KS(cb, ao2, bo2); G8_KS(cb, ao3, bo3);
    }
    __syncthreads();
#undef G8_DMA
#undef G8_KS
    float* stg = (float*)lds;
    int w_off = (wr * MI * 32 + 4 * (lane >> 5)) * STG_LD + ((wc * NI * 32) & 127) + (lane & 31);
    asm volatile("" : "+v"(w_off));
#pragma unroll
    for (int p = 0; p < NP; ++p) {
        if (((wc * NI * 32) >> 7) == p) {
#pragma unroll
            for (int m = 0; m < MI; ++m)
#pragma unroll
                for (int n = 0; n < NI; ++n)
#pragma unroll
                    for (int r = 0; r < 16; ++r)
                        stg[w_off + (m * 32 + (r & 3) + 8 * (r >> 2)) * STG_LD + n * 32] = acc[m][n][r];
        }
        __syncthreads();
        epi((const float*)stg, p);
        __syncthreads();
    }
}
template <class F> DI void epi_rows8(const float* stg, F f) {
    const int tid0 = ltid();
#pragma unroll
    for (int it = 0; it < 8; ++it) {
        const int idx = it * NTHREADS + tid0;
        const int r = idx >> 4, c0 = (idx & 15) * 8;
        const float4 p = *(const float4*)(stg + r * STG_LD + c0);
        const float4 q = *(const float4*)(stg + r * STG_LD + c0 + 4);
        const float v[8] = {p.x, p.y, p.z, p.w, q.x, q.y, q.z, q.w};
        f(r, c0, v);
    }
}
template <class T, class L, class F> DI void epi_rows8_pre(const float* stg, L loadf, F f) {
    const int tid0 = ltid();
    constexpr int BATCH = sizeof(T) > 16 ? 2 : 4;
#pragma unroll
    for (int h = 0; h < 8 / BATCH; ++h) {
        T pre[BATCH];
#pragma unroll
        for (int it = 0; it < BATCH; ++it) { const int idx = (h * BATCH + it) * NTHREADS + tid0; pre[it] = loadf(idx >> 4, (idx & 15) * 8); }
#pragma unroll
        for (int it = 0; it < BATCH; ++it) {
            const int idx = (h * BATCH + it) * NTHREADS + tid0;
            const int r = idx >> 4, c0 = (idx & 15) * 8;
            const float4 p = *(const float4*)(stg + r * STG_LD + c0);
            const float4 q = *(const float4*)(stg + r * STG_LD + c0 + 4);
            const float v[8] = {p.x, p.y, p.z, p.w, q.x, q.y, q.z, q.w};
            f(r, c0, v, pre[it]);
        }
    }
}
struct F8 { float4 a, b; };
DI void tile_remap(int L, int nM, int nN, int& pm, int& pn) {
    const int ntiles = nM * nN;
    int w = L;
    if ((ntiles & 7) == 0) w = (L & 7) * (ntiles >> 3) + (L >> 3);
    constexpr int WGM = 4;
    const int nig = WGM * nN, gid = w / nig, fm = gid * WGM, rem = w - gid * nig;
    const int gsz = (nM - fm) < WGM ? (nM - fm) : WGM;
    pm = fm + rem % gsz; pn = rem / gsz;
}
struct RowLoader {
    const bfr* p; size_t ld;
    DI RowLoader(const bfr* base, int row0, size_t ld_) : ld(ld_) { const int t = ltid(); p = base + (size_t)(row0 + (t >> 3)) * ld_ + gt_lcol(t); }
    DI const bfr* operator()(int i, int kt) const { return p + (size_t)(64 * i) * ld + kt * 64; }
};
#define GEMM256 gemm8<2, 4, 4, 2>
#define GEMM128 gemm8<4, 2, 2, 2>
namespace p8 {
typedef float f32x4 __attribute__((ext_vector_type(4)));
constexpr int HTB = 128 * 64 * 2;
DI int lds_byte(int r, int c) { const int st = (r >> 4) * 2 + (c >> 5), rr = r & 15, cc = c & 31, ob = rr * 64 + cc * 2; return st * 1024 + (ob ^ (((ob >> 9) & 1) << 5)); }
DI void stage_rc(int b, int& R, int& C) { const int st = b / 1024, sb = b % 1024, swz = sb ^ (((sb >> 9) & 1) << 5); R = (st >> 1) * 16 + swz / 64; C = (st & 1) * 32 + (swz % 64) / 2; }
DI int perm32(int rho) { const int n = rho >> 4, i = rho & 15; return 8 * (i >> 2) + 4 * n + (i & 3); }
struct Unit { int pm, pn, x0, x1; };

template <bool PERM, bool GATHER, class Sched, class Epi>
DI void gemm_phase(char* lds_g, const int K, const Sched& S, const Epi& E) {
    LAS unsigned char* lds = (LAS unsigned char*)lds_g;
    const int tid = ltid(), wid = __builtin_amdgcn_readfirstlane(tid >> 6), lane = tid & 63, wr = wid >> 2, wc = wid & 3, fr = lane & 15, fq = lane >> 4;
    const int nt = K / 64;
    unsigned voffA[2][2], voffB[2], nvA[2][2];
    int sR[2], sC[2];
    const unsigned hstep = (unsigned)(128 * K * 2);
#pragma unroll
    for (int i = 0; i < 2; ++i) { int R, C; stage_rc(tid * 16 + i * 8192, R, C); const int Rb = PERM ? ((R & ~31) + perm32(R & 31)) : R; sR[i] = R; sC[i] = C;
        voffA[0][i] = (unsigned)(R * K + C) * 2u; voffA[1][i] = voffA[0][i] + hstep; voffB[i] = (unsigned)(Rb * K + C) * 2u; }
    const size_t kstep = 128;
    const unsigned ldsw = (unsigned)wid * 1024u;
    const int aoff = lds_byte(wr * 64 + fr, fq * 8), boff = lds_byte(wc * 32 + fr, fq * 8);
#define PG8_SA(b, h) (((b) * 2 + (h)) * p8::HTB)
#define PG8_SB(b, h) ((4 + (b) * 2 + (h)) * p8::HTB)
#define PG8_STAGE(bufoff, gbase, voff) do { _Pragma("unroll") for (int _i = 0; _i < 2; ++_i) \
        __builtin_amdgcn_global_load_lds((GPtrU)((const char*)(gbase) + (voff)[_i]), (LPtrU)(lds + (bufoff) + ldsw + _i * 8192), 16, 0, 0); } while (0)
#define PG8_STAGE_A(bufoff, gbase, h) PG8_STAGE(bufoff, gbase, voffA[h])
#define PG8_STAGE_B(bufoff, gbase, h) PG8_STAGE(bufoff, (gbase) + (h) * (size_t)hstep, voffB)
#define PG8_LDA(dst, b, h) do { _Pragma("unroll") for (int m = 0; m < 4; ++m) _Pragma("unroll") for (int k = 0; k < 2; ++k) dst[m][k] = *(const LAS bf16x8*)(lds + PG8_SA(b, h) + aoff + m * 2048 + k * 1024); } while (0)
#define PG8_LDB(dst, b, h) do { _Pragma("unroll") for (int n = 0; n < 2; ++n) _Pragma("unroll") for (int k = 0; k < 2; ++k) dst[n][k] = *(const LAS bf16x8*)(lds + PG8_SB(b, h) + boff + n * 2048 + k * 1024); } while (0)
#define PG8_MMA(ai, bj, At, Bt) do { __builtin_amdgcn_s_setprio(1); _Pragma("unroll") for (int m = 0; m < 4; ++m) _Pragma("unroll") for (int n = 0; n < 2; ++n) _Pragma("unroll") for (int k = 0; k < 2; ++k) \
        acc[ai][bj][m][n] = __builtin_amdgcn_mfma_f32_16x16x32_bf16(Bt[n][k], At[m][k], acc[ai][bj][m][n], 0, 0, 0); __builtin_amdgcn_s_setprio(0); } while (0)
#define PG8_WAIT_V(n) asm volatile("s_waitcnt vmcnt(" #n ")" ::: "memory")
#define PG8_WAIT_L(n) asm volatile("s_waitcnt lgkmcnt(" #n ")" ::: "memory")
#define PG8_BAR __builtin_amdgcn_s_barrier()
#define PG8_SCHED __builtin_amdgcn_sched_barrier(0)
    Unit cur, nxt; int ui = 0;
    if (!S.next(0, cur)) return;
    f32x4 acc[2][2][4][2];
#pragma unroll
    for (int a = 0; a < 2; ++a)
#pragma unroll
        for (int b = 0; b < 2; ++b)
#pragma unroll
            for (int m = 0; m < 4; ++m)
#pragma unroll
                for (int n = 0; n < 2; ++n) acc[a][b][m][n] = (f32x4){0.f, 0.f, 0.f, 0.f};
    bf16x8 At[4][2], B0[2][2], B1[2][2];
    const char* cA = S.a_base(cur); const char* cB = S.b_base(cur);
    if (GATHER) S.a_offs(0, cur, sR, sC, voffA);
    PG8_STAGE_B(PG8_SB(0, 0), cB, 0); PG8_STAGE_A(PG8_SA(0, 0), cA, 0); PG8_STAGE_B(PG8_SB(0, 1), cB, 1); PG8_STAGE_A(PG8_SA(0, 1), cA, 1);
    if (wr == 1) PG8_BAR;
    PG8_WAIT_V(4); PG8_BAR;
    PG8_STAGE_B(PG8_SB(1, 0), cB + kstep, 0); PG8_STAGE_A(PG8_SA(1, 0), cA + kstep, 0); PG8_STAGE_B(PG8_SB(1, 1), cB + kstep, 1);
    PG8_WAIT_V(6); PG8_BAR;
    for (;;) {
        const bool has_next = S.next(ui + 1, nxt);
        const char* nA = has_next ? S.a_base(nxt) : cA; const char* nB = has_next ? S.b_base(nxt) : cB;
        if (GATHER) {
            if (has_next) S.a_offs(ui + 1, nxt, sR, sC, nvA);
            else { nvA[0][0] = voffA[0][0]; nvA[0][1] = voffA[0][1]; nvA[1][0] = voffA[1][0]; nvA[1][1] = voffA[1][1]; }
        }
        for (int t = 0; t < nt; t += 2) {
            const bool last = (t == nt - 2);
            const char* a1 = cA + (size_t)(t + 1) * kstep;
            const char* a2 = last ? nA : cA + (size_t)(t + 2) * kstep; const char* b2 = last ? nB : cB + (size_t)(t + 2) * kstep;
            const char* a3 = a2 + kstep; const char* b3 = b2 + kstep;
            PG8_LDB(B0, 0, 0); PG8_SCHED; PG8_LDA(At, 0, 0); PG8_STAGE_A(PG8_SA(1, 1), a1, 1);
            if (GATHER && last) { voffA[0][0] = nvA[0][0]; voffA[0][1] = nvA[0][1]; voffA[1][0] = nvA[1][0]; voffA[1][1] = nvA[1][1]; }
            PG8_WAIT_L(8); PG8_BAR; PG8_WAIT_L(0); PG8_MMA(0, 0, At, B0); PG8_BAR; PG8_SCHED;
            PG8_LDB(B1, 0, 1); PG8_STAGE_B(PG8_SB(0, 0), b2, 0);
            PG8_BAR; PG8_WAIT_L(0); PG8_MMA(0, 1, At, B1); PG8_BAR;
            PG8_LDA(At, 0, 1); PG8_STAGE_A(PG8_SA(0, 0), a2, 0);
            PG8_BAR; PG8_WAIT_L(0); PG8_MMA(1, 0, At, B0); PG8_BAR; PG8_SCHED;
            PG8_STAGE_B(PG8_SB(0, 1), b2, 1);
            PG8_WAIT_V(6); PG8_BAR; PG8_MMA(1, 1, At, B1); PG8_BAR;
            PG8_LDB(B0, 1, 0); PG8_SCHED; PG8_LDA(At, 1, 0); PG8_STAGE_A(PG8_SA(0, 1), a2, 1);
            PG8_WAIT_L(8); PG8_BAR; PG8_WAIT_L(0); PG8_MMA(0, 0, At, B0); PG8_BAR; PG8_SCHED;
            PG8_LDB(B1, 1, 1); PG8_STAGE_B(PG8_SB(1, 0), b3, 0);
            PG8_BAR; PG8_WAIT_L(0); PG8_MMA(0, 1, At, B1); PG8_BAR;
            PG8_LDA(At, 1, 1); PG8_STAGE_A(PG8_SA(1, 0), a3, 0);
            PG8_BAR; PG8_WAIT_L(0); PG8_MMA(1, 0, At, B0); PG8_BAR; PG8_SCHED;
            PG8_STAGE_B(PG8_SB(1, 1), b3, 1);
            PG8_WAIT_V(6); PG8_BAR; PG8_MMA(1, 1, At, B1); PG8_BAR;
        }
        E(acc, cur, wr, wc, fr, fq);
        if (!has_next) break;
#pragma unroll
        for (int a = 0; a < 2; ++a)
#pragma unroll
            for (int b = 0; b < 2; ++b)
#pragma unroll
                for (int m = 0; m < 4; ++m)
#pragma unroll
                    for (int n = 0; n < 2; ++n) acc[a][b][m][n] = (f32x4){0.f, 0.f, 0.f, 0.f};
        cur = nxt; cA = nA; cB = nB; ++ui;
    }
    PG8_WAIT_V(0);
    if (wr == 0) PG8_BAR;
    PG8_BAR;
#undef PG8_SA
#undef PG8_SB
#undef PG8_STAGE
#undef PG8_STAGE_A
#undef PG8_STAGE_B
#undef PG8_LDA
#undef PG8_LDB
#undef PG8_MMA
#undef PG8_WAIT_V
#undef PG8_WAIT_L
#undef PG8_BAR
#undef PG8_SCHED
}
DI uint4 pack_bf8(const f32x4& v0, const f32x4& v1) { return make_uint4(pk2(v0[0], v0[1]), pk2(v0[2], v0[3]), pk2(v1[0], v1[1]), pk2(v1[2], v1[3])); }
struct PlainSched {
    const char* A; const char* B; int nM, nN, limit; size_t tstep;
    DI bool next(int i, Unit& u) const { const int L = i * (int)gridDim.x + (int)blockIdx.x; if (L >= limit) return false; tile_remap(L, nM, nN, u.pm, u.pn); u.x0 = 0; u.x1 = 0; return true; }
    DI const char* a_base(const Unit& u) const { return A + (size_t)u.pm * tstep; }
    DI const char* b_base(const Unit& u) const { return B + (size_t)u.pn * tstep; }
    DI void a_offs(int, const Unit&, const int (&)[2], const int (&)[2], unsigned (&)[2][2]) const {}
};
}
struct G4 { char* lds; int tid; int vb; int nvb; volatile LAS unsigned* cnt; };
constexpr int G4_LDS = 77824;
constexpr int G4_AUX = 73728;
constexpr int G4_TILE = 128 * 128;
DI G4 g4_make(char* lds) {
    G4 g; const int t = ltid(); const int grp = t >> 8;
    g.lds = lds + grp * G4_LDS; g.tid = t & 255; g.vb = blockIdx.x * 2 + grp; g.nvb = gridDim.x * 2;
    g.cnt = (volatile LAS unsigned*)(lds + LDS_BYTES - 32) + grp;
    return g;
}
DI void g4_bar(const G4& G) {
    asm volatile("s_waitcnt lgkmcnt(0)" ::: "memory");
    unsigned target = 0;
    if ((G.tid & 63) == 0) {
        const unsigned old = __hip_atomic_fetch_add((LAS unsigned*)G.cnt, 1u, __ATOMIC_RELAXED, __HIP_MEMORY_SCOPE_WORKGROUP);
        target = (old & ~3u) + 4u;
    }
    target = __builtin_amdgcn_readfirstlane(target);
    while ((int)(*G.cnt - target) < 0) __builtin_amdgcn_s_sleep(1);
    asm volatile("" ::: "memory");
}
template <class F> DI void g4_epi_rows8(const G4& G, const float* stg, F f) {
#pragma unroll
    for (int it = 0; it < 8; ++it) {
        const int idx = it * 256 + G.tid;
        const int r = idx >> 4, c0 = (idx & 15) * 8;
        const float4 p = *(const float4*)(stg + r * STG_LD + c0);
        const float4 q = *(const float4*)(stg + r * STG_LD + c0 + 4);
        const float v[8] = {p.x, p.y, p.z, p.w, q.x, q.y, q.z, q.w};
        f(r, c0, v);
    }
}
template <class T, class L, class F> DI void g4_epi_rows8_pre(const G4& G, const float* stg, L loadf, F f) {
    T pre[8];
#pragma unroll
    for (int it = 0; it < 8; ++it) { const int idx = it * 256 + G.tid; pre[it] = loadf(idx >> 4, (idx & 15) * 8); }
#pragma unroll
    for (int it = 0; it < 8; ++it) {
        const int idx = it * 256 + G.tid;
        const int r = idx >> 4, c0 = (idx & 15) * 8;
        const float4 p = *(const float4*)(stg + r * STG_LD + c0);
        const float4 q = *(const float4*)(stg + r * STG_LD + c0 + 4);
        const float v[8] = {p.x, p.y, p.z, p.w, q.x, q.y, q.z, q.w};
        f(r, c0, v, pre[it]);
    }
}
struct G4RowLoader {
    const bfr* p; size_t ld;
    DI G4RowLoader(const G4& G, const bfr* base, int row0, size_t ld_) : ld(ld_) { p = base + (size_t)(row0 + (G.tid >> 3)) * ld_ + gt_lcol(G.tid); }
    DI const bfr* operator()(int i, int kt) const { return p + (size_t)(32 * i) * ld + kt * 64; }
};
template <class AF, class BF, class EF>
DI void g4_gemm_tile(const G4& G, char* lds, int nk, AF aptr, BF bptr, EF epi) {
    const int tid = G.tid, lane = tid & 63, wave = tid >> 6;
    const int wr = wave >> 1, wc = wave & 1;
    f32x16 acc00, acc01, acc10, acc11;
#pragma unroll
    for (int r = 0; r < 16; ++r) { acc00[r] = 0.f; acc01[r] = 0.f; acc10[r] = 0.f; acc11[r] = 0.f; }
#define GT_DMA(kt_, base_) do { char* db_ = (base_) + tid * 16; _Pragma("unroll") for (int i_ = 0; i_ < 4; ++i_) { \
        __builtin_amdgcn_global_load_lds((GPtrU)aptr(i_, kt_), (LPtrU)(db_ + i_ * 4096), 16, 0, 0); \
        __builtin_amdgcn_global_load_lds((GPtrU)bptr(i_, kt_), (LPtrU)(db_ + G4_TILE + i_ * 4096), 16, 0, 0); } } while (0)
#define GT_FRAG(cb_, off_) (*(const bf16x8*)((cb_) + (off_)))
#define GT_COMPUTE(base_) do { const char* cb_ = (base_); \
        { const bf16x8 a0 = GT_FRAG(cb_, ao0), a1 = GT_FRAG(cb_, ao0 + 4096), b0 = GT_FRAG(cb_, bo0), b1 = GT_FRAG(cb_, bo0 + 4096); \
          acc00 = MFMA32(a0, b0, acc00); acc01 = MFMA32(a0, b1, acc01); acc10 = MFMA32(a1, b0, acc10); acc11 = MFMA32(a1, b1, acc11); } \
        { const bf16x8 a0 = GT_FRAG(cb_, ao1), a1 = GT_FRAG(cb_, ao1 + 4096), b0 = GT_FRAG(cb_, bo1), b1 = GT_FRAG(cb_, bo1 + 4096); \
          acc00 = MFMA32(a0, b0, acc00); acc01 = MFMA32(a0, b1, acc01); acc10 = MFMA32(a1, b0, acc10); acc11 = MFMA32(a1, b1, acc11); } \
        { const bf16x8 a0 = GT_FRAG(cb_, ao2), a1 = GT_FRAG(cb_, ao2 + 4096), b0 = GT_FRAG(cb_, bo2), b1 = GT_FRAG(cb_, bo2 + 4096); \
          acc00 = MFMA32(a0, b0, acc00); acc01 = MFMA32(a0, b1, acc01); acc10 = MFMA32(a1, b0, acc10); acc11 = MFMA32(a1, b1, acc11); } \
        { const bf16x8 a0 = GT_FRAG(cb_, ao3), a1 = GT_FRAG(cb_, ao3 + 4096), b0 = GT_FRAG(cb_, bo3), b1 = GT_FRAG(cb_, bo3 + 4096); \
          acc00 = MFMA32(a0, b0, acc00); acc01 = MFMA32(a0, b1, acc01); acc10 = MFMA32(a1, b0, acc10); acc11 = MFMA32(a1, b1, acc11); } } while (0)
    const int ln = lane & 31, hf = lane >> 5, sw = (ln >> 1) & 7;
    int ao0 = wr * 8192 + ln * 128 + ((0 + hf) ^ sw) * 16, ao1 = wr * 8192 + ln * 128 + ((2 + hf) ^ sw) * 16;
    int ao2 = wr * 8192 + ln * 128 + ((4 + hf) ^ sw) * 16, ao3 = wr * 8192 + ln * 128 + ((6 + hf) ^ sw) * 16;
    int bo0 = G4_TILE + wc * 8192 + ln * 128 + ((0 + hf) ^ sw) * 16, bo1 = G4_TILE + wc * 8192 + ln * 128 + ((2 + hf) ^ sw) * 16;
    int bo2 = G4_TILE + wc * 8192 + ln * 128 + ((4 + hf) ^ sw) * 16, bo3 = G4_TILE + wc * 8192 + ln * 128 + ((6 + hf) ^ sw) * 16;
    asm volatile("" : "+v"(ao0), "+v"(ao1), "+v"(ao2), "+v"(ao3), "+v"(bo0), "+v"(bo1), "+v"(bo2), "+v"(bo3));
    GT_DMA(0, lds);
    asm volatile("s_waitcnt vmcnt(0)" ::: "memory");
    g4_bar(G);
    int buf = 0;
#pragma unroll 1
    for (int kt = 0; kt < nk - 1; ++kt) {
        GT_DMA(kt + 1, lds + (buf ^ 1) * (2 * G4_TILE));
        GT_COMPUTE(lds + buf * (2 * G4_TILE));
        asm volatile("s_waitcnt vmcnt(0)" ::: "memory");
        g4_bar(G);
        buf ^= 1;
    }
    GT_COMPUTE(lds + buf * (2 * G4_TILE));
    g4_bar(G);
#undef GT_DMA
#undef GT_FRAG
#undef GT_COMPUTE
    float* stg = (float*)lds;
    int w_off = (wr * 64 + 4 * (lane >> 5)) * STG_LD + wc * 64 + (lane & 31);
    asm volatile("" : "+v"(w_off));
#pragma unroll
    for (int r = 0; r < 16; ++r) {
        const int ro = ((r & 3) + 8 * (r >> 2)) * STG_LD;
        stg[w_off + ro] = acc00[r];
        stg[w_off + ro + 32] = acc01[r];
        stg[w_off + ro + 32 * STG_LD] = acc10[r];
        stg[w_off + ro + 32 * STG_LD + 32] = acc11[r];
    }
    g4_bar(G);
    epi((const float*)stg);
    g4_bar(G);
}

DI void g4_attn_item(const G4& G, char* lds, const Ctx& P, int b, int h, int qt, float lam, float lam_init, const float* subln) {
    const bfr* qn = (const bfr*)(P.ws + OFF_QN);
    const bfr* kn = (const bfr*)(P.ws + OFF_KN);
    const bfr* vT = (const bfr*)(P.ws + OFF_VT) + (size_t)(b * 4 + h) * 128 * SEQ;
    bfr* am = (bfr*)(P.ws + OFF_AMIX);
    const int tid = G.tid, lane = tid & 63, wave = tid >> 6;
    const int m = wave >> 1, qw = (wave & 1) * 32;
    const int q0 = qt * 64 + qw;
    const int ln = lane & 31, hf = lane >> 5;
    bf16x8 qf[4];
    {
        const bfr* qp = qn + ((size_t)b * SEQ + q0 + ln) * 512 + h * 128 + m * 64 + hf * 8;
#pragma unroll
        for (int ks = 0; ks < 4; ++ks) qf[ks] = *(const bf16x8*)(qp + ks * 16);
    }
    f32x16 o[4];
#pragma unroll
    for (int d = 0; d < 4; ++d)
#pragma unroll
        for (int r = 0; r < 16; ++r) o[d][r] = 0.f;
    float mrun = -INFINITY, lrun = 0.f;
    const int nkt = qt + 1;
    const int lrow = tid >> 3, lcol = (tid & 7) * 8;
    const bfr* kbase = kn + ((size_t)b * SEQ) * 512 + h * 128;
    unsigned ko = (unsigned)(lrow * 512 + lcol) * 2u, vo = (unsigned)(lrow * SEQ + lcol) * 2u;
    asm volatile("" : "+v"(ko), "+v"(vo));
    uint4 rk0, rk1, rk2, rk3, rv0, rv1, rv2, rv3;
#define ATT_GLOAD(kt_) do { const char* kp_ = (const char*)(kbase + (size_t)(kt_) * (64 * 512)); const char* vp_ = (const char*)(vT + (kt_) * 64); \
        rk0 = *(const uint4*)(kp_ + ko); rk1 = *(const uint4*)(kp_ + 32 * 512 * 2 + ko); rk2 = *(const uint4*)(kp_ + 64 * 2 + ko); rk3 = *(const uint4*)(kp_ + 32 * 512 * 2 + 64 * 2 + ko); \
        rv0 = *(const uint4*)(vp_ + vo); rv1 = *(const uint4*)(vp_ + 32 * SEQ * 2 + vo); rv2 = *(const uint4*)(vp_ + 64 * SEQ * 2 + vo); rv3 = *(const uint4*)(vp_ + 96 * SEQ * 2 + vo); } while (0)
#define ATT_S1(base_, i_, RK, RV) { *(uint4*)((base_) + (32 * (i_)) * LDA * 2) = RK; \
        *(uint4*)((base_) + TILE_B + (32 * (i_)) * LDA * 2) = RV; }
#define ATT_LSTORE(buf_) do { char* base_ = lds + (buf_) * (2 * TILE_B) + s_off; ATT_S1(base_, 0, rk0, rv0) ATT_S1(base_, 1, rk1, rv1) ATT_S1(base_, 2, rk2, rv2) ATT_S1(base_, 3, rk3, rv3) } while (0)
    int k_off = ((m * 64 + ln) * LDA + hf * 8) * 2;
    int v_off = TILE_B + (ln * LDA + 4 * hf) * 2;
    int s_off = (lrow * LDA + lcol) * 2;
    asm volatile("" : "+v"(k_off), "+v"(v_off), "+v"(s_off));
    ATT_GLOAD(0); ATT_LSTORE(0);
    g4_bar(G);
    int buf = 0;
#pragma unroll 1
    for (int kt = 0; kt < nkt; ++kt) {
        const bool more = (kt + 1 < nkt);
        const char* ks_ = lds + buf * (2 * TILE_B) + k_off;
        const char* vs_ = lds + buf * (2 * TILE_B) + v_off;
        if (kt * 64 <= q0 + 31) {
            f32x16 s[2];
#pragma unroll
            for (int kb = 0; kb < 2; ++kb) {
#pragma unroll
                for (int r = 0; r < 16; ++r) s[kb][r] = 0.f;
#pragma unroll
                for (int ks = 0; ks < 4; ++ks) {
                    const bf16x8 kf = *(const bf16x8*)(ks_ + ((kb * 32) * LDA + ks * 16) * 2);
                    s[kb] = MFMA32(kf, qf[ks], s[kb]);
                }
            }
            const int qpos = q0 + ln;
            if (kt * 64 + 63 > q0) {
#pragma unroll
                for (int kb = 0; kb < 2; ++kb)
#pragma unroll
                    for (int r = 0; r < 16; ++r) {
                        const int key = kt * 64 + kb * 32 + (r & 3) + 8 * (r >> 2) + 4 * hf;
                        if (key > qpos) s[kb][r] = -INFINITY;
                    }
            }
            float mx = s[0][0];
#pragma unroll
            for (int kb = 0; kb < 2; ++kb)
#pragma unroll
                for (int r = 0; r < 16; ++r) mx = fmaxf(mx, s[kb][r]);
            mx = fmaxf(mx, __shfl_xor(mx, 32));
            const float mnew = fmaxf(mrun, mx);
            const float alpha = __builtin_amdgcn_exp2f(mrun - mnew);
            mrun = mnew;
            float rsum = 0.f;
#pragma unroll
            for (int kb = 0; kb < 2; ++kb)
#pragma unroll
                for (int r = 0; r < 16; ++r) { const float p = __builtin_amdgcn_exp2f(s[kb][r] - mnew); s[kb][r] = p; rsum += p; }
            lrun = lrun * alpha + rsum;
#pragma unroll
            for (int d = 0; d < 4; ++d)
#pragma unroll
                for (int r = 0; r < 16; ++r) o[d][r] *= alpha;
            __builtin_amdgcn_sched_barrier(0);
            if (more) ATT_GLOAD(kt + 1);
#pragma unroll
            for (int kb = 0; kb < 2; ++kb)
#pragma unroll
                for (int st = 0; st < 2; ++st) {
                    const uint4 pp = make_uint4(pk2(s[kb][8 * st + 0], s[kb][8 * st + 1]), pk2(s[kb][8 * st + 2], s[kb][8 * st + 3]),
                                                pk2(s[kb][8 * st + 4], s[kb][8 * st + 5]), pk2(s[kb][8 * st + 6], s[kb][8 * st + 7]));
                    const bf16x8 pf = __builtin_bit_cast(bf16x8, pp);
                    const int kc = kb * 32 + 16 * st;
#pragma unroll
                    for (int d = 0; d < 4; ++d) {
                        const uint2 v0 = *(const uint2*)(vs_ + ((d * 32) * LDA + kc) * 2);
                        const uint2 v1 = *(const uint2*)(vs_ + ((d * 32) * LDA + kc + 8) * 2);
                        const bf16x8 vf = __builtin_bit_cast(bf16x8, make_uint4(v0.x, v0.y, v1.x, v1.y));
                        o[d] = MFMA32(vf, pf, o[d]);
                    }
                }
        }
        else if (more) ATT_GLOAD(kt + 1);
        if (more) ATT_LSTORE(buf ^ 1);
        g4_bar(G);
        buf ^= 1;
    }
    const float ltot = lrun + __shfl_xor(lrun, 32);
    const float linv = 1.0f / ltot;
    float* ob = (float*)lds;
    int o_off = (m * 64 + qw + ln) * 129 + 4 * hf;
    asm volatile("" : "+v"(o_off));
#pragma unroll
    for (int d = 0; d < 4; ++d)
#pragma unroll
        for (int r = 0; r < 16; ++r) ob[o_off + d * 32 + (r & 3) + 8 * (r >> 2)] = o[d][r] * linv;
    g4_bar(G);
#pragma unroll
    for (int it = 0; it < 4; ++it) {
        const int idx = it * 256 + tid;
        const int q = idx >> 4, c0 = (idx & 15) * 8;
        float v[8];
        float ss = 0.f;
        int r_off = q * 129 + c0;
        asm volatile("" : "+v"(r_off));
#pragma unroll
        for (int j = 0; j < 8; ++j) { v[j] = ob[r_off + j] - lam * ob[r_off + 64 * 129 + j]; ss += v[j] * v[j]; }
        ss = row16_sum(ss);
        const float rs = rsqrtf(ss * (1.0f / 128.0f) + 1e-5f) * (1.0f - lam_init);
#pragma unroll
        for (int j = 0; j < 8; ++j) v[j] = v[j] * rs * subln[c0 + j];
        *(uint4*)(am + ((size_t)b * SEQ + qt * 64 + q) * 1024 + h * 128 + c0) = pack8(v);
    }
    g4_bar(G);
}

#undef ATT_GLOAD
#undef ATT_S1
#undef ATT_LSTORE
#undef ATT_OFF
#undef ATT_G1
DI int cvt_rowmap(int n, int mode) { return mode == 0 ? n : ((n >> 2) * 8 + (n & 3) + (mode == 2 ? 4 : 0)); }
DI void cvt_tile(char* lds, const float* __restrict__ src, int N, bfr* __restrict__ dst, int ldd, int k0, int n0, int mode) {
    float* t = (float*)lds;
    const int tid = ltid();
    const int r = tid >> 5, c = (tid & 31) * 4;
#pragma unroll
    for (int i = 0; i < 4; ++i) {
        const float4 v = *(const float4*)(src + (size_t)(k0 + r + 16 * i) * N + n0 + c);
        float* d = t + (r + 16 * i) * 129 + c;
        d[0] = v.x; d[1] = v.y; d[2] = v.z; d[3] = v.w;
    }
    __syncthreads();
#pragma unroll
    for (int i = 0; i < 2; ++i) {
        const int idx = tid + i * NTHREADS;
        const int n = idx & 127, kg = idx >> 7;
        float v[8];
#pragma unroll
        for (int j = 0; j < 8; ++j) v[j] = t[(kg * 8 + j) * 129 + n];
        *(uint4*)(dst + (size_t)cvt_rowmap(n0 + n, mode) * ldd + k0 + kg * 8) = pack8(v);
    }
    __syncthreads();
}
DI void cvt_matrix(char* lds, const float* src, int K, int N, bfr* dst, int ldd, int mode, int worker, int nworkers, unsigned& base) {
    if (worker < 0) return;
    const int ntn = N >> 7, ntiles = (K >> 6) * ntn;
    int t0 = (int)(((unsigned)worker + (unsigned)nworkers - (base % (unsigned)nworkers)) % (unsigned)nworkers);
    for (int t = t0; t < ntiles; t += nworkers) cvt_tile(lds, src, N, dst, ldd, (t / ntn) * 64, (t % ntn) * 128, mode);
    base += (unsigned)ntiles;
}
struct CvtTile { const float* src; bfr* dst; int N, ldd, mode; };
DI CvtTile moe_cvt_tile(const Ctx& P, int layer, int t) {
    const int e = t / 192, r = t % 192, m = r >> 6, q = r & 63;
    const size_t we = (size_t)(layer * 32 + e);
    CvtTile c;
    if (m < 2) {
        const int k0 = (q >> 2) * 64, n0 = (q & 3) * 128;
        c.src = P.in[m == 0 ? I_MWGATE : I_MWUP] + we * 1024 * 512 + (size_t)k0 * 512 + n0; c.N = 512;
        c.dst = (bfr*)(P.ws + OFF_MWGU) + (size_t)e * 1024 * 1024 + k0; c.ldd = 1024; c.mode = 1 + m;
        c.dst += (size_t)0; c.mode |= (n0 << 8);
    } else {
        const int k0 = (q >> 3) * 64, n0 = (q & 7) * 128;
        c.src = P.in[I_MWDOWN] + we * 512 * 1024 + (size_t)k0 * 1024 + n0; c.N = 1024;
        c.dst = (bfr*)(P.ws + OFF_MWD) + (size_t)e * 1024 * 512 + k0; c.ldd = 512; c.mode = (n0 << 8);
    }
    return c;
}
DI void moe_convert_range(char* lds, const Ctx& P, int layer, int t_begin, int t_end) {
    if (t_begin >= t_end) return;
    float* tl = (float*)lds;
    const int tid = ltid();
    const int r = tid >> 5, c4 = (tid & 31) * 4;
    CvtTile cur = moe_cvt_tile(P, layer, t_begin);
    float4 v0, v1, v2, v3;
#define CVT_LOAD(ct_) do { const float* s_ = (ct_).src + (size_t)r * (ct_).N + c4; \
        v0 = *(const float4*)(s_); v1 = *(const float4*)(s_ + (size_t)16 * (ct_).N); v2 = *(const float4*)(s_ + (size_t)32 * (ct_).N); v3 = *(const float4*)(s_ + (size_t)48 * (ct_).N); } while (0)
    CVT_LOAD(cur);
    for (int t = t_begin; t < t_end; ++t) {
        { float* d = tl + r * 129 + c4;
          d[0] = v0.x; d[1] = v0.y; d[2] = v0.z; d[3] = v0.w; d += 16 * 129; d[0] = v1.x; d[1] = v1.y; d[2] = v1.z; d[3] = v1.w;
          d += 16 * 129; d[0] = v2.x; d[1] = v2.y; d[2] = v2.z; d[3] = v2.w; d += 16 * 129; d[0] = v3.x; d[1] = v3.y; d[2] = v3.z; d[3] = v3.w; }
        const CvtTile me = cur;
        if (t + 1 < t_end) { cur = moe_cvt_tile(P, layer, t + 1); CVT_LOAD(cur); }
        __syncthreads();
        const int mode = me.mode & 255, n0 = me.mode >> 8;
#pragma unroll
        for (int i = 0; i < 2; ++i) {
            const int idx = tid + i * NTHREADS;
            const int n = idx & 127, kg = idx >> 7;
            float v[8];
#pragma unroll
            for (int j = 0; j < 8; ++j) v[j] = tl[(kg * 8 + j) * 129 + n];
            *(uint4*)(me.dst + (size_t)cvt_rowmap(n0 + n, mode) * me.ldd + kg * 8) = pack8(v);
        }
        __syncthreads();
    }
#undef CVT_LOAD
}
DI void s5_tables(char* lds, const Ctx& P, int i, int g) {
    float2* pw = (float2*)lds;
    float2* bb = pw + 64 * 33;
    float2* cm = bb + 64 * 16;
    float*  kt = (float*)(cm + 16 * 64);
    const int tid = ltid();
    const size_t gp = (size_t)(i * 32 + g) * 64;
    for (int idx = tid; idx < 64 * 33; idx += NTHREADS) {
        const int p = idx / 33, tau = idx % 33;
        const float re = fminf(P.in[I_ARE][gp + p], -1e-4f), im = P.in[I_AIM][gp + p];
        const float st = expf(P.in[I_LSTEP][gp + p]);
        const float mag = expf(re * st * (float)tau);
        const double angd = (double)im * (double)st * (double)tau;
        const double red = angd - 6.283185307179586 * floor(angd * 0.15915494309189535);
        float sn, cs; sincosf((float)red, &sn, &cs);
        pw[idx] = make_float2(mag * cs, mag * sn);
    }
    for (int idx = tid; idx < 64 * 16; idx += NTHREADS) {
        const int p = idx >> 4, c = idx & 15;
        const double re = fmin((double)P.in[I_ARE][gp + p], -1e-4), im = (double)P.in[I_AIM][gp + p];
        const double st = exp((double)P.in[I_LSTEP][gp + p]);
        const double mag = exp(re * st), lr = mag * cos(im * st) - 1.0, li = mag * sin(im * st);
        const double den = re * re + im * im;
        const double fr = (lr * re + li * im) / den, fi = (li * re - lr * im) / den;
        const double br = (double)P.in[I_BRE][(gp + p) * 16 + c], bi = (double)P.in[I_BIM][(gp + p) * 16 + c];
        bb[idx] = make_float2((float)(fr * br - fi * bi), (float)(fr * bi + fi * br));
        const int cc = idx >> 6, pp = idx & 63;
        cm[idx] = make_float2(P.in[I_CRE][((size_t)(i * 32 + g) * 16 + cc) * 64 + pp], P.in[I_CIM][((size_t)(i * 32 + g) * 16 + cc) * 64 + pp]);
    }
    __syncthreads();
    for (int idx = tid; idx < 32 * 256; idx += NTHREADS) {
        const int tau = idx >> 8, c1 = (idx >> 4) & 15, c = idx & 15;
        float s = 0.f;
        for (int p = 0; p < 64; ++p) {
            const float2 a = cm[c1 * 64 + p], w = pw[p * 33 + tau], b = bb[p * 16 + c];
            const float tr = a.x * w.x - a.y * w.y, ti = a.x * w.y + a.y * w.x;
            s += tr * b.x - ti * b.y;
        }
        kt[idx] = s;
    }
    __syncthreads();
    bfr* gt = (bfr*)(P.ws + OFF_S5GT) + (size_t)(i * 32 + g) * 512 * 640;
    for (int idx = tid; idx < 512 * 80; idx += NTHREADS) {
        const int n = idx / 80, ch = idx % 80;
        const int t = n >> 4, c1 = n & 15;
        float v[8];
        if (ch < 64) {
            const int s = ch >> 1, c0 = (ch & 1) * 8;
#pragma unroll
            for (int j = 0; j < 8; ++j) v[j] = (t >= s) ? kt[((t - s) * 16 + c1) * 16 + c0 + j] : 0.f;
        } else {
            const int p0 = (ch - 64) * 4;
#pragma unroll
            for (int j = 0; j < 4; ++j) {
                const float2 a = cm[c1 * 64 + p0 + j], w = pw[(p0 + j) * 33 + t + 1];
                v[2 * j] = a.x * w.x - a.y * w.y;
                v[2 * j + 1] = -(a.x * w.y + a.y * w.x);
            }
        }
        *(uint4*)(gt + (size_t)n * 640 + ch * 8) = pack8(v);
    }
    bfr* bl = (bfr*)(P.ws + OFF_S5BL) + (size_t)(i * 32 + g) * 128 * 512;
    for (int idx = tid; idx < 128 * 64; idx += NTHREADS) {
        const int n = idx >> 6, ch = idx & 63;
        const int p = n >> 1, ri = n & 1, s = ch >> 1, c0 = (ch & 1) * 8;
        const float2 w = pw[p * 33 + 31 - s];
        float v[8];
#pragma unroll
        for (int j = 0; j < 8; ++j) { const float2 b = bb[p * 16 + c0 + j]; v[j] = ri ? (w.x * b.y + w.y * b.x) : (w.x * b.x - w.y * b.y); }
        *(uint4*)(bl + (size_t)n * 512 + ch * 8) = pack8(v);
    }
    float* l32 = (float*)(P.ws + OFF_S5L32) + (size_t)(i * 32 + g) * 128;
    if (tid < 64) { l32[2 * tid] = pw[tid * 33 + 32].x; l32[2 * tid + 1] = pw[tid * 33 + 32].y; }
    __syncthreads();
}

DI void norm_rows(const float* __restrict__ x, const float* __restrict__ g, bfr* __restrict__ hb, bfr* __restrict__ hlo, float* __restrict__ xcopy, int tok0, int ntok) {
    const int tid_ = ltid();
    const int lane = tid_ & 63, wave = tid_ >> 6;
    for (int tk = wave; tk < ntok; tk += NWAVES) {
        const size_t tok = (size_t)(tok0 + tk);
        float4 v[4];
        float ss = 0.f;
#pragma unroll
        for (int i = 0; i < 4; ++i) {
            v[i] = *(const float4*)(x + tok * DM + i * 256 + lane * 4);
            ss += v[i].x * v[i].x + v[i].y * v[i].y + v[i].z * v[i].z + v[i].w * v[i].w;
        }
        ss = wave_sum(ss);
        const float rs = rsqrtf(ss * (1.0f / DM) + 1e-6f);
#pragma unroll
        for (int i = 0; i < 4; ++i) {
            const float4 gg = *(const float4*)(g + i * 256 + lane * 4);
            const float h0 = v[i].x * rs * gg.x, h1 = v[i].y * rs * gg.y, h2 = v[i].z * rs * gg.z, h3 = v[i].w * rs * gg.w;
            const unsigned p0 = pk2(h0, h1), p1 = pk2(h2, h3);
            *(uint2*)(hb + tok * DM + i * 256 + lane * 4) = make_uint2(p0, p1);
            if (hlo) {
                const unsigned q0 = pk2(h0 - bflo(p0), h1 - bfhi(p0)), q1 = pk2(h2 - bflo(p1), h3 - bfhi(p1));
                *(uint2*)(hlo + tok * DM + i * 256 + lane * 4) = make_uint2(q0, q1);
            }
            if (xcopy) *(float4*)(xcopy + tok * DM + i * 256 + lane * 4) = v[i];
        }
    }
}
DI void phase_e1(char* lds, const Ctx& P, int li) {
    const bfr* hb = (const bfr*)(P.ws + OFF_HB);
    const bfr* w = (const bfr*)(P.ws + OFF_WINE) + (size_t)li * 2304 * 1024;
    bfr* u = (bfr*)(P.ws + OFF_U);
    const int ntiles = 128 * 9, G = gridDim.x;
    const int full = (ntiles / G) * G, rem = ntiles - full;
    const bool halves = rem > 0 && 2 * rem <= G;
    {
        p8::PlainSched S{(const char*)hb, (const char*)w, 128, 9, halves ? full : ntiles, (size_t)256 * 1024 * 2};
        p8::gemm_phase<true, false>(lds, 1024, S, [&](const p8::f32x4 (&acc)[2][2][4][2], const p8::Unit& un, int wr, int wc, int fr, int fq) __attribute__((always_inline)) {
            bfr* o = u + (size_t)(un.pm * 256 + wr * 64 + fr) * EVEN_IN + un.pn * 256 + wc * 32 + 8 * fq;
#pragma unroll
            for (int ai = 0; ai < 2; ++ai)
#pragma unroll
                for (int m = 0; m < 4; ++m)
#pragma unroll
                    for (int bj = 0; bj < 2; ++bj)
                        *(uint4*)(o + (size_t)(ai * 128 + m * 16) * EVEN_IN + bj * 128) = p8::pack_bf8(acc[ai][bj][m][0], acc[ai][bj][m][1]);
        });
        __syncthreads();
    }
    if (halves && (int)blockIdx.x < 2 * rem) {
        int mt, nt; tile_remap(full + ((int)blockIdx.x >> 1), 128, 9, mt, nt);
        const int hc = (blockIdx.x & 1) * 128;
        RowLoader A(hb, mt * 256, 1024), B(w, nt * 256 + hc, 1024);
        GEMM128(lds, 16, A, B, [&](const float* stg, int) __attribute__((always_inline)) {
            epi_rows8(stg, [&](int r, int c0, const float (&v)[8]) __attribute__((always_inline)) {
                *(uint4*)(u + (size_t)(mt * 256 + r) * EVEN_IN + nt * 256 + hc + c0) = pack8(v);
            });
        });
    }
}

DI void phase_e2a(const Ctx& P, int li) {
    const bfr* u = (const bfr*)(P.ws + OFF_U);
    const float* mu = P.in[I_MU] + (size_t)li * 1792;
    bfr* S = (bfr*)(P.ws + OFF_S);
    bfr* mv = (bfr*)(P.ws + (li == 0 ? OFF_VFIRST : OFF_MV2));
    bfr* dpool = (bfr*)(P.ws + OFF_DPOOL);
    const int total = NTOK * 160;
    for (int idx = blockIdx.x * NTHREADS + ltid(); idx < total; idx += gridDim.x * NTHREADS) {
        const int tok = idx / 160, ch = idx % 160;
        const int col = 1024 + ch * 8;
        const int t = tok & (SEQ - 1);
        const bfr* row = u + (size_t)tok * EVEN_IN;
        float cur[8];
        unpack8(*(const uint4*)(row + col), cur);
        if (col < 1792) {
            float prv[8], m[8];
            if (t > 0) unpack8(*(const uint4*)(row - EVEN_IN + col), prv);
            else {
#pragma unroll
                for (int j = 0; j < 8; ++j) prv[j] = 0.f;
            }
            const float4 m0 = *(const float4*)(mu + col), m1 = *(const float4*)(mu + col + 4);
            const float mm[8] = {m0.x, m0.y, m0.z, m0.w, m1.x, m1.y, m1.z, m1.w};
#pragma unroll
            for (int j = 0; j < 8; ++j) m[j] = cur[j] + (prv[j] - cur[j]) * mm[j];
            if (col < 1536) {
                *(uint4*)(mv + (size_t)tok * 512 + (col - 1024)) = pack8(m);
            } else if (col < 1600) {
#pragma unroll
                for (int j = 0; j < 8; ++j) m[j] = ftanh(m[j]);
                *(uint4*)(S + (size_t)tok * 256 + (col - 1536)) = pack8(m);
            } else if (col < 1664) {
                *(uint4*)(S + (size_t)tok * 256 + 64 + (col - 1600)) = pack8(m);
            } else {
#pragma unroll
                for (int j = 0; j < 8; ++j) m[j] = sigmoidf_(m[j]);
                *(uint4*)(S + (size_t)tok * 256 + 128 + (col - 1664)) = pack8(m);
            }
        } else {
            const int gi = (col - 1792) >> 7;
            const int win = 2 << gi;
            const int nw = (t + 1 < win) ? (t + 1) : win;
            float acc[8];
#pragma unroll
            for (int j = 0; j < 8; ++j) acc[j] = cur[j];
#define POOL_WIN(W) { uint4 pv[W - 1]; _Pragma("unroll") for (int s = 1; s < W; ++s) pv[s - 1] = *(const uint4*)(row - (size_t)(s < nw ? s : 0) * EVEN_IN + col); \
                      _Pragma("unroll") for (int s = 1; s < W; ++s) { float pq[8]; unpack8(pv[s - 1], pq); const float wgt = s < nw ? 1.f : 0.f; \
                          _Pragma("unroll") for (int j = 0; j < 8; ++j) acc[j] += wgt * pq[j]; } }
            if (gi == 0) POOL_WIN(2) else if (gi == 1) POOL_WIN(4) else if (gi == 2) POOL_WIN(8) else POOL_WIN(16)
#undef POOL_WIN
            const float inv = frcp((float)nw);
#pragma unroll
            for (int j = 0; j < 8; ++j) acc[j] = acc[j] * inv - cur[j];
            *(uint4*)(dpool + (size_t)tok * 512 + (col - 1792)) = pack8(acc);
        }
    }
}

DI void phase_e2b(char* lds, const Ctx& P, int li) {
    const bfr* S = (const bfr*)(P.ws + OFF_S);
    const int njobs = (li == 1) ? 20 : 16;
    for (int t = blockIdx.x; t < 128 * njobs; t += gridDim.x) {
        const int mt = t / njobs, j = t % njobs;
        const int job = j >> 2, nt = j & 3;
        const int m0 = mt * 256;
        if (job == 0) {
            RowLoader A(S, m0, 256), B((const bfr*)(P.ws + OFF_W2T) + (size_t)li * 512 * 64, nt * 128, 64);
            const float* w0 = P.in[I_W0] + li * 512;
            float* dlog = (float*)(P.ws + OFF_DLOG);
            GEMM128(lds, 1, A, B, [&](const float* stg, int) __attribute__((always_inline)) {
                epi_rows8(stg, [&](int r, int c0, const float (&v)[8]) __attribute__((always_inline)) {
                    float o[8];
#pragma unroll
                    for (int q = 0; q < 8; ++q) {
                        const float z = -(w0[nt * 128 + c0 + q] + v[q]);
                        o[q] = -fexp(-fsoftplus(z) - 0.5f);
                    }
                    float* d = dlog + (size_t)(m0 + r) * 512 + nt * 128 + c0;
                    *(float4*)d = make_float4(o[0], o[1], o[2], o[3]); *(float4*)(d + 4) = make_float4(o[4], o[5], o[6], o[7]);
                });
            });
        } else if (job == 1) {
            RowLoader A(S + 64, m0, 256), B((const bfr*)(P.ws + OFF_A2T) + (size_t)li * 512 * 64, nt * 128, 64);
            const float* a0 = P.in[I_A0] + li * 512;
            bfr* ab = (bfr*)(P.ws + OFF_ABUF);
            GEMM128(lds, 1, A, B, [&](const float* stg, int) __attribute__((always_inline)) {
                epi_rows8(stg, [&](int r, int c0, const float (&v)[8]) __attribute__((always_inline)) {
                    float o[8];
#pragma unroll
                    for (int q = 0; q < 8; ++q) o[q] = sigmoidf_(a0[nt * 128 + c0 + q] + v[q]);
                    *(uint4*)(ab + (size_t)(m0 + r) * 512 + nt * 128 + c0) = pack8(o);
                });
            });
        } else if (job == 2) {
            RowLoader A(S + 128, m0, 256), B((const bfr*)(P.ws + OFF_G2T) + (size_t)li * 512 * 128, nt * 128, 128);
            bfr* gb = (bfr*)(P.ws + OFF_GBUF);
            GEMM128(lds, 2, A, B, [&](const float* stg, int) __attribute__((always_inline)) {
                epi_rows8(stg, [&](int r, int c0, const float (&v)[8]) __attribute__((always_inline)) {
                    *(uint4*)(gb + (size_t)(m0 + r) * 512 + nt * 128 + c0) = pack8(v);
                });
            });
        } else if (job == 3) {
            RowLoader A((const bfr*)(P.ws + OFF_DPOOL) + nt * 128, m0, 512), B((const bfr*)(P.ws + OFF_POOLT) + (size_t)(li * 4 + nt) * 128 * 128, 0, 128);
            const float* ps = P.in[I_POOLS] + li * 512 + nt * 128;
            bfr* am = (bfr*)(P.ws + OFF_AMIX);
            GEMM128(lds, 2, A, B, [&](const float* stg, int) __attribute__((always_inline)) {
                epi_rows8(stg, [&](int r, int c0, const float (&v)[8]) __attribute__((always_inline)) {
                    float o[8];
#pragma unroll
                    for (int q = 0; q < 8; ++q) o[q] = v[q] * ps[c0 + q];
                    *(uint4*)(am + (size_t)(m0 + r) * 1024 + 512 + nt * 128 + c0) = pack8(o);
                });
            });
        } else {
            RowLoader A((const bfr*)(P.ws + OFF_MV2), m0, 512), B((const bfr*)(P.ws + OFF_V12T), nt * 128, 512);
            const float* v0 = P.in[I_V0];
            bfr* vg = (bfr*)(P.ws + OFF_VGATE);
            GEMM128(lds, 8, A, B, [&](const float* stg, int) __attribute__((always_inline)) {
                epi_rows8(stg, [&](int r, int c0, const float (&v)[8]) __attribute__((always_inline)) {
                    float o[8];
#pragma unroll
                    for (int q = 0; q < 8; ++q) o[q] = sigmoidf_(v0[nt * 128 + c0 + q] + v[q]);
                    *(uint4*)(vg + (size_t)(m0 + r) * 512 + nt * 128 + c0) = pack8(o);
                });
            });
        }
    }
}

constexpr int RW_TC = 32;
constexpr int RW_ROWS = 32;
constexpr int RW_BUF = (5 * RW_TC * 64 + RW_TC * RW_ROWS + RW_TC * RW_ROWS) * 4;
DI void phase_e3(char* lds, const Ctx& P, int li, int probe = 0) {
    const bfr* u = (const bfr*)(P.ws + OFF_U);
    const float* mu = P.in[I_MU] + (size_t)li * 1792;
    const float* dlog = (const float*)(P.ws + OFF_DLOG);
    const bfr* ab = (const bfr*)(P.ws + OFF_ABUF);
    const bfr* vg = (const bfr*)(P.ws + OFF_VGATE);
    const bfr* vf = (const bfr*)(P.ws + OFF_VFIRST);
    float* yout = (float*)(P.ws + (probe ? OFF_HID : OFF_Y));
    float* bonus = (float*)(P.ws + (probe ? OFF_HID : OFF_BONUS));
    const int tid = ltid(), lane = tid & 63, wave = tid >> 6;
    const int pstep = tid >> 4, pc0 = (tid & 15) * 4;
    for (int item = blockIdx.x; item < 256; item += gridDim.x) {
        const int bh = item >> 1, qtr = item & 1;
        const int b = bh >> 3, h = bh & 7;
        const int i0 = qtr * RW_ROWS;
        float c_mur[4], c_muk[4], c_muv[4], c_kk[4], c_ka[4], c_rk[4];
#pragma unroll
        for (int j = 0; j < 4; ++j) {
            const int c = h * 64 + pc0 + j;
            c_mur[j] = mu[c]; c_muk[j] = mu[512 + c]; c_muv[j] = mu[1024 + c];
            c_kk[j] = P.in[I_KK][li * 512 + c]; c_ka[j] = P.in[I_KA][li * 512 + c]; c_rk[j] = P.in[I_RK][li * 512 + c];
        }
        float S0 = 0.f, S1 = 0.f, S2 = 0.f, S3 = 0.f;
        const int rloc = wave * 4 + (lane >> 4);
        const int j0 = (lane & 15) * 4;
        const bool mine = ((pc0 >> 5) == qtr);
        uint2 g_ur, g_uk, g_uv, g_pr, g_pk, g_pv, g_a, g_vg, g_vf; float4 g_d;
#define E3_GLOAD(c_) do { const int t_ = (c_) * RW_TC + pstep; const size_t tok_ = (size_t)b * SEQ + t_; \
            const bfr* row_ = u + tok_ * EVEN_IN + h * 64 + pc0; const bfr* prow_ = row_ - (t_ > 0 ? EVEN_IN : 0); \
            g_ur = *(const uint2*)(row_); g_uk = *(const uint2*)(row_ + 512); g_uv = *(const uint2*)(row_ + 1024); \
            g_pr = *(const uint2*)(prow_); g_pk = *(const uint2*)(prow_ + 512); g_pv = *(const uint2*)(prow_ + 1024); \
            const size_t o_ = tok_ * 512 + h * 64 + pc0; \
            g_a = *(const uint2*)(ab + o_); g_d = *(const float4*)(dlog + o_); \
            if (li == 1) { g_vg = *(const uint2*)(vg + o_); g_vf = *(const uint2*)(vf + o_); } } while (0)
#define E3_PREP(c_, buf_) do { const int t_ = (c_) * RW_TC + pstep; const size_t o_ = ((size_t)b * SEQ + t_) * 512 + h * 64 + pc0; \
            float* sw_ = (float*)(lds + (buf_) * RW_BUF); float* sa_ = sw_ + RW_TC * 64; float* sb_ = sa_ + RW_TC * 64; float* sk_ = sb_ + RW_TC * 64; \
            float* sr_ = sk_ + RW_TC * 64; float* sv_ = sr_ + RW_TC * 64; \
            const float pz_ = t_ > 0 ? 1.f : 0.f; \
            const float ur_[4] = {bflo(g_ur.x), bfhi(g_ur.x), bflo(g_ur.y), bfhi(g_ur.y)}, uk_[4] = {bflo(g_uk.x), bfhi(g_uk.x), bflo(g_uk.y), bfhi(g_uk.y)}; \
            const float uv_[4] = {bflo(g_uv.x), bfhi(g_uv.x), bflo(g_uv.y), bfhi(g_uv.y)}; \
            const float pr_[4] = {bflo(g_pr.x), bfhi(g_pr.x), bflo(g_pr.y), bfhi(g_pr.y)}, pk_[4] = {bflo(g_pk.x), bfhi(g_pk.x), bflo(g_pk.y), bfhi(g_pk.y)}; \
            const float pv_[4] = {bflo(g_pv.x), bfhi(g_pv.x), bflo(g_pv.y), bfhi(g_pv.y)}; \
            const float av_[4] = {bflo(g_a.x), bfhi(g_a.x), bflo(g_a.y), bfhi(g_a.y)}; \
            const float dl_[4] = {g_d.x, g_d.y, g_d.z, g_d.w}; \
            float gv_[4] = {0.f, 0.f, 0.f, 0.f}, fv_[4] = {0.f, 0.f, 0.f, 0.f}; \
            if (li == 1) { gv_[0] = bflo(g_vg.x); gv_[1] = bfhi(g_vg.x); gv_[2] = bflo(g_vg.y); gv_[3] = bfhi(g_vg.y); \
                           fv_[0] = bflo(g_vf.x); fv_[1] = bfhi(g_vf.x); fv_[2] = bflo(g_vf.y); fv_[3] = bfhi(g_vf.y); } \
            float kkr_[4], kmod_[4], rr_[4], vv_[4]; float ssq_ = 0.f, bsum_ = 0.f; \
            _Pragma("unroll") for (int j = 0; j < 4; ++j) { \
                rr_[j] = ur_[j] + (pz_ * pr_[j] - ur_[j]) * c_mur[j]; \
                const float k_ = uk_[j] + (pz_ * pk_[j] - uk_[j]) * c_muk[j]; \
                float v_ = uv_[j] + (pz_ * pv_[j] - uv_[j]) * c_muv[j]; \
                if (li == 1) v_ = v_ + (fv_[j] - v_) * gv_[j]; \
                vv_[j] = v_; kkr_[j] = k_ * c_kk[j]; ssq_ += kkr_[j] * kkr_[j]; \
                kmod_[j] = k_ * (1.0f + (av_[j] - 1.0f) * c_ka[j]); bsum_ += rr_[j] * kmod_[j] * c_rk[j]; } \
            ssq_ = row16_sum(ssq_); bsum_ = row16_sum(bsum_); \
            const float inv_ = frcp(fmaxf(sqrtf(ssq_), 1e-12f)); \
            float4 w4_, a4_, b4_; \
            w4_.x = fexp(dl_[0]); w4_.y = fexp(dl_[1]); w4_.z = fexp(dl_[2]); w4_.w = fexp(dl_[3]); \
            a4_.x = -kkr_[0] * inv_; a4_.y = -kkr_[1] * inv_; a4_.z = -kkr_[2] * inv_; a4_.w = -kkr_[3] * inv_; \
            b4_.x = -a4_.x * av_[0]; b4_.y = -a4_.y * av_[1]; b4_.z = -a4_.z * av_[2]; b4_.w = -a4_.w * av_[3]; \
            *(float4*)(sw_ + pstep * 64 + pc0) = w4_; *(float4*)(sa_ + pstep * 64 + pc0) = a4_; *(float4*)(sb_ + pstep * 64 + pc0) = b4_; \
            *(float4*)(sk_ + pstep * 64 + pc0) = make_float4(kmod_[0], kmod_[1], kmod_[2], kmod_[3]); \
            *(float4*)(sr_ + pstep * 64 + pc0) = make_float4(rr_[0], rr_[1], rr_[2], rr_[3]); \
            if (mine) { *(float4*)(sv_ + pstep * RW_ROWS + (pc0 & 31)) = make_float4(vv_[0], vv_[1], vv_[2], vv_[3]); \
                        *(float4*)(bonus + o_) = make_float4(bsum_ * vv_[0], bsum_ * vv_[1], bsum_ * vv_[2], bsum_ * vv_[3]); } } while (0)
        __syncthreads();
        E3_GLOAD(0);
        E3_PREP(0, 0);
        __syncthreads();
        constexpr int NCH = SEQ / RW_TC;
#pragma unroll 1
        for (int c = 0; c < NCH; ++c) {
            const int buf = c & 1;
            if (c + 1 < NCH && probe != 2) E3_GLOAD(c + 1);
            if (probe != 1) {
                const float* s_w = (const float*)(lds + buf * RW_BUF); const float* s_a = s_w + RW_TC * 64; const float* s_b = s_a + RW_TC * 64;
                const float* s_k = s_b + RW_TC * 64; const float* s_r = s_k + RW_TC * 64; const float* s_v = s_r + RW_TC * 64;
                float* s_y = (float*)(s_v + RW_TC * RW_ROWS);
                float4 na4 = *(const float4*)(s_a + j0), nw4 = *(const float4*)(s_w + j0), nb4 = *(const float4*)(s_b + j0);
                float4 nk4 = *(const float4*)(s_k + j0), nr4 = *(const float4*)(s_r + j0);
                float nvi = s_v[rloc];
#pragma unroll 1
                for (int sg = 0; sg < RW_TC; sg += 4) {
                    float yv[4];
#pragma unroll
                    for (int q = 0; q < 4; ++q) {
                        const int sn = (sg + q + 1) & (RW_TC - 1);
                        const float4 a4 = na4, w4 = nw4, b4 = nb4, k4 = nk4, r4 = nr4; const float vi = nvi;
                        na4 = *(const float4*)(s_a + sn * 64 + j0); nw4 = *(const float4*)(s_w + sn * 64 + j0); nb4 = *(const float4*)(s_b + sn * 64 + j0);
                        nk4 = *(const float4*)(s_k + sn * 64 + j0); nr4 = *(const float4*)(s_r + sn * 64 + j0); nvi = s_v[sn * RW_ROWS + rloc];
                        float sa = dot4n(S0, S1, S2, S3, a4);
                        sa = row16_sum(sa);
                        rw_upd(S0, w4.x, sa, b4.x, vi, k4.x);
                        rw_upd(S1, w4.y, sa, b4.y, vi, k4.y);
                        rw_upd(S2, w4.z, sa, b4.z, vi, k4.z);
                        rw_upd(S3, w4.w, sa, b4.w, vi, k4.w);
                        const float y = dot4n(S0, S1, S2, S3, r4);
                        yv[q] = row16_sum(y);
                    }
                    const int ls = lane & 3;
                    const float yo = ls == 0 ? yv[0] : (ls == 1 ? yv[1] : (ls == 2 ? yv[2] : yv[3]));
                    if ((lane & 15) < 4) s_y[(sg + ls) * RW_ROWS + rloc] = yo;
                }
            }
            if (c + 1 < NCH && probe != 2) E3_PREP(c + 1, buf ^ 1);
            __syncthreads();
            {
                const float* s_y = (const float*)(lds + buf * RW_BUF) + 5 * RW_TC * 64 + RW_TC * RW_ROWS;
#pragma unroll
                for (int q = 0; q < RW_TC * RW_ROWS / NTHREADS; ++q) {
                    const int idx = q * NTHREADS + tid;
                    const int s = idx >> 5, r = idx & 31;
                    yout[((size_t)b * SEQ + c * RW_TC + s) * 512 + h * 64 + i0 + r] = s_y[idx];
                }
            }
        }
#undef E3_GLOAD
#undef E3_PREP
    }
}

DI void phase_e4(const Ctx& P, int li) {
    const bfr* y = (const bfr*)(P.ws + OFF_Y);
    const bfr* bonus = (const bfr*)(P.ws + OFF_BONUS);
    const bfr* gb = (const bfr*)(P.ws + OFF_GBUF);
    const float* lng = P.in[I_LNG] + li * 512;
    const float* lnb = P.in[I_LNB] + li * 512;
    bfr* am = (bfr*)(P.ws + OFF_AMIX);
    const int total = NTOK * 64;
    for (int idx = blockIdx.x * NTHREADS + ltid(); idx < total; idx += gridDim.x * NTHREADS) {
        const int tok = idx >> 6, c = (idx & 63) * 8;
        const size_t o = (size_t)tok * 512 + c;
        float v[8], bo[8], gv[8];
        unpack8(*(const uint4*)(y + o), v);
        unpack8(*(const uint4*)(bonus + o), bo);
        unpack8(*(const uint4*)(gb + o), gv);
        float s = 0.f;
#pragma unroll
        for (int j = 0; j < 8; ++j) s += v[j];
        s += __shfl_xor(s, 1); s += __shfl_xor(s, 2); s += __shfl_xor(s, 4);
        const float mean = s * (1.0f / 64.0f);
        float q = 0.f;
#pragma unroll
        for (int j = 0; j < 8; ++j) { v[j] -= mean; q += v[j] * v[j]; }
        q += __shfl_xor(q, 1); q += __shfl_xor(q, 2); q += __shfl_xor(q, 4);
        const float rstd = rsqrtf(q * (1.0f / 64.0f) + 64e-5f);
        float out[8];
#pragma unroll
        for (int j = 0; j < 8; ++j) out[j] = (v[j] * rstd * lng[c + j] + lnb[c + j] + bo[j]) * gv[j];
        *(uint4*)(am + (size_t)tok * 1024 + c) = pack8(out);
    }
}

DI void phase_wout(char* lds, const Ctx& P, const bfr* w, float* x) {
    const bfr* am = (const bfr*)(P.ws + OFF_AMIX);
    p8::PlainSched S{(const char*)am, (const char*)w, 128, 4, 512, (size_t)256 * 1024 * 2};
    p8::gemm_phase<false, false>(lds, 1024, S, [&](const p8::f32x4 (&acc)[2][2][4][2], const p8::Unit& un, int wr, int wc, int fr, int fq) __attribute__((always_inline)) {
        float* o = x + (size_t)(un.pm * 256 + wr * 64 + fr) * DM + un.pn * 256 + wc * 32 + 4 * fq;
#pragma unroll
        for (int ai = 0; ai < 2; ++ai) {
            p8::f32x4 xv[4][2][2];
#pragma unroll
            for (int m = 0; m < 4; ++m)
#pragma unroll
                for (int bj = 0; bj < 2; ++bj)
#pragma unroll
                    for (int n = 0; n < 2; ++n) xv[m][bj][n] = *(const p8::f32x4*)(o + (size_t)(ai * 128 + m * 16) * DM + bj * 128 + n * 16);
#pragma unroll
            for (int m = 0; m < 4; ++m)
#pragma unroll
                for (int bj = 0; bj < 2; ++bj)
#pragma unroll
                    for (int n = 0; n < 2; ++n) *(p8::f32x4*)(o + (size_t)(ai * 128 + m * 16) * DM + bj * 128 + n * 16) = xv[m][bj][n] + acc[ai][bj][m][n];
        }
    });
    __syncthreads();
}
constexpr int RC_L = 32;
constexpr int RC_NCH = SEQ / RC_L;
constexpr int RC_RM = 72;
constexpr int RC_TR = 40;
constexpr int RC_OFF_LG  = 0;
constexpr int RC_OFF_AH  = 8192;
constexpr int RC_OFF_AHT = RC_OFF_AH + 4 * 32 * RC_RM * 2;
constexpr int RC_TRB = 64 * RC_TR * 2 + 8 * 16;
constexpr int RC_OFF_FA  = RC_OFF_AHT + 4 * RC_TRB;
constexpr int RC_OFF_MA  = RC_OFF_FA + 2 * 32 * RC_TR * 2;
constexpr int RC_OFF_W2T = RC_OFF_MA + 4 * 32 * RC_TR * 2;
constexpr int RC_OFF_GL  = RC_OFF_W2T + RC_TRB;
constexpr int RC_LDS_END = RC_OFF_GL + 256;
static_assert(RC_LDS_END <= G4_AUX, "chunk scratch must fit a 4-wave group's LDS");
constexpr size_t OFF_RCG = OFF_HID;
constexpr size_t OFF_RCH = OFF_HB;
constexpr size_t OFF_RCQ = OFF_EV_END;
constexpr size_t OFF_RCZ = OFF_RCQ + (size_t)8192 * 4096;
constexpr size_t OFF_RC_END = OFF_RCZ + (size_t)8192 * 4096;

DI int rc_tro(int c) { return c * (RC_TR * 2) + (c >> 3) * 16; }
DI bf16x8 rc_ld16(const char* p) { return *(const bf16x8*)p; }
DI bf16x8 rc_ld8x2(const char* p) {
    const uint2 a = *(const uint2*)p, b = *(const uint2*)(p + 16);
    return __builtin_bit_cast(bf16x8, make_uint4(a.x, a.y, b.x, b.y));
}
DI bf16x8 rc_pack(const f32x16& x, int s) {
    return __builtin_bit_cast(bf16x8, make_uint4(pk2(x[8 * s], x[8 * s + 1]), pk2(x[8 * s + 2], x[8 * s + 3]), pk2(x[8 * s + 4], x[8 * s + 5]), pk2(x[8 * s + 6], x[8 * s + 7])));
}
DI f32x16 rc_zero() { f32x16 z; _Pragma("unroll") for (int r = 0; r < 16; ++r) z[r] = 0.f; return z; }

DI void phase_r1(char* lds0, const Ctx& P, int li, int probe = 0) {
    const G4 G = g4_make(lds0);
    char* lds = G.lds;
    const int tid = G.tid, lane = tid & 63, wave = tid >> 6;
    const int ln = lane & 31, hf = lane >> 5;
    const bfr* u = (const bfr*)(P.ws + OFF_U);
    const float* mu = P.in[I_MU] + (size_t)li * 1792;
    const float* dlog = (const float*)(P.ws + OFF_DLOG);
    const bfr* ab = (const bfr*)(P.ws + OFF_ABUF);
    const bfr* vg = (const bfr*)(P.ws + OFF_VGATE);
    const bfr* vf = (const bfr*)(P.ws + OFF_VFIRST);
    bfr* bonus = (bfr*)(P.ws + OFF_BONUS);
    bfr* gG = (bfr*)(P.ws + OFF_RCG); bfr* gH = (bfr*)(P.ws + OFF_RCH); bfr* gQ = (bfr*)(P.ws + OFF_RCQ); bfr* gZ = (bfr*)(P.ws + OFF_RCZ);
    char* s_rm = lds + RC_OFF_AH;
    char* s_tr = lds + RC_OFF_AHT;
    char* s_im = lds + RC_OFF_FA;
    char* s_ma = lds + RC_OFF_MA;
    char* s_w2t = lds + RC_OFF_W2T;
    float* s_gl = (float*)(lds + RC_OFF_GL);
    constexpr int RMB = 32 * RC_RM * 2, TRB = RC_TRB, MAB = 32 * RC_TR * 2;
    const int ps = tid >> 3, pc0 = (tid & 7) * 8;
    float* s_cst = (float*)(lds + G4_AUX);
    float* s_tot = s_cst + 6 * 64;
    {
        const int h0 = (G.vb >> 6) & 7;
        if (tid < 64) {
            s_cst[0 * 64 + tid] = mu[h0 * 64 + tid]; s_cst[1 * 64 + tid] = mu[512 + h0 * 64 + tid]; s_cst[2 * 64 + tid] = mu[1024 + h0 * 64 + tid];
            s_cst[3 * 64 + tid] = P.in[I_KK][li * 512 + h0 * 64 + tid]; s_cst[4 * 64 + tid] = P.in[I_KA][li * 512 + h0 * 64 + tid]; s_cst[5 * 64 + tid] = P.in[I_RK][li * 512 + h0 * 64 + tid];
        }
        g4_bar(G);
    }
    uint4 g_ur, g_pr, g_uk, g_pk, g_uv, g_pv, g_a, g_vg, g_vf; float4 g_d0, g_d1;
#define RC_PREF(item_) do { const int bh_ = (item_) >> 6, c_ = (item_) & 63; const int t_ = c_ * RC_L + ps; const size_t tok_ = (size_t)(bh_ >> 3) * SEQ + t_; \
        const bfr* row_ = u + tok_ * EVEN_IN + (bh_ & 7) * 64 + pc0; const bfr* prow_ = row_ - (t_ > 0 ? EVEN_IN : 0); const size_t o_ = tok_ * 512 + (bh_ & 7) * 64 + pc0; \
        g_ur = *(const uint4*)row_; g_uk = *(const uint4*)(row_ + 512); g_uv = *(const uint4*)(row_ + 1024); \
        g_pr = *(const uint4*)prow_; g_pk = *(const uint4*)(prow_ + 512); g_pv = *(const uint4*)(prow_ + 1024); \
        g_a = *(const uint4*)(ab + o_); g_d0 = *(const float4*)(dlog + o_); g_d1 = *(const float4*)(dlog + o_ + 4); \
        if (li == 1) { g_vg = *(const uint4*)(vg + o_); g_vf = *(const uint4*)(vf + o_); } } while (0)
    if (G.vb < 128 * RC_NCH) RC_PREF(G.vb);
    for (int item = G.vb; item < 128 * RC_NCH; item += G.nvb) {
        const int bh = item >> 6, c = item & 63;
        const int b = bh >> 3, h = bh & 7;
        float lg[8], dl_[8];
        {
            float a_[8], b_[8], k_[8], r_[8], v_[8];
            const int t = c * RC_L + ps;
            const size_t tok = (size_t)b * SEQ + t;
            const float pz = t > 0 ? 1.f : 0.f;
            const size_t o512 = tok * 512 + h * 64 + pc0;
            float av[8];
            unpack8(g_a, av);
            float c8[8], m8[8], x8[8], y8[8];
#define RC_LD8(dst_, src_) { const float4 x0_ = *(const float4*)(src_), x1_ = *(const float4*)((src_) + 4); dst_[0] = x0_.x; dst_[1] = x0_.y; dst_[2] = x0_.z; dst_[3] = x0_.w; dst_[4] = x1_.x; dst_[5] = x1_.y; dst_[6] = x1_.z; dst_[7] = x1_.w; }
            unpack8(g_ur, x8); unpack8(g_pr, y8); RC_LD8(m8, s_cst + 0 * 64 + pc0)
#pragma unroll
            for (int j = 0; j < 8; ++j) r_[j] = x8[j] + (pz * y8[j] - x8[j]) * m8[j];
            unpack8(g_uk, x8); unpack8(g_pk, y8); RC_LD8(m8, s_cst + 1 * 64 + pc0)
            float kx[8], kkr[8]; float ssq = 0.f, bsum = 0.f;
            RC_LD8(c8, s_cst + 3 * 64 + pc0)
#pragma unroll
            for (int j = 0; j < 8; ++j) { kx[j] = x8[j] + (pz * y8[j] - x8[j]) * m8[j]; kkr[j] = kx[j] * c8[j]; ssq += kkr[j] * kkr[j]; }
            RC_LD8(c8, s_cst + 4 * 64 + pc0)
#pragma unroll
            for (int j = 0; j < 8; ++j) k_[j] = kx[j] * (1.0f + (av[j] - 1.0f) * c8[j]);
            RC_LD8(c8, s_cst + 5 * 64 + pc0)
#pragma unroll
            for (int j = 0; j < 8; ++j) bsum += r_[j] * k_[j] * c8[j];
            unpack8(g_uv, x8); unpack8(g_pv, y8); RC_LD8(m8, s_cst + 2 * 64 + pc0)
#pragma unroll
            for (int j = 0; j < 8; ++j) v_[j] = x8[j] + (pz * y8[j] - x8[j]) * m8[j];
            if (li == 1) {
                unpack8(g_vg, x8); unpack8(g_vf, y8);
#pragma unroll
                for (int j = 0; j < 8; ++j) v_[j] = v_[j] + (y8[j] - v_[j]) * x8[j];
            }
#undef RC_LD8
            ssq += __shfl_xor(ssq, 1); ssq += __shfl_xor(ssq, 2); ssq += __shfl_xor(ssq, 4);
            bsum += __shfl_xor(bsum, 1); bsum += __shfl_xor(bsum, 2); bsum += __shfl_xor(bsum, 4);
            const float inv = frcp(fmaxf(sqrtf(ssq), 1e-12f));
#pragma unroll
            for (int j = 0; j < 8; ++j) { const float kk = kkr[j] * inv; a_[j] = -kk; b_[j] = kk * av[j]; }
            { float bo[8];
#pragma unroll
              for (int j = 0; j < 8; ++j) bo[j] = bsum * v_[j];
              *(uint4*)(bonus + o512) = pack8(bo); }
#pragma unroll
            for (int j = 0; j < 8; ++j) *(bfr*)(s_tr + 3 * TRB + rc_tro(pc0 + j) + ps * 2) = f2bf(v_[j]);
            dl_[0] = g_d0.x; dl_[1] = g_d0.y; dl_[2] = g_d0.z; dl_[3] = g_d0.w; dl_[4] = g_d1.x; dl_[5] = g_d1.y; dl_[6] = g_d1.z; dl_[7] = g_d1.w;
#pragma unroll
            for (int j = 0; j < 8; ++j) lg[j] = dl_[j];
#pragma unroll
            for (int d = 8; d < 64; d <<= 1) {
#pragma unroll
                for (int j = 0; j < 8; ++j) { const float o = __shfl_up(lg[j], d); lg[j] += (lane >= d) ? o : 0.f; }
            }
            *(uint4*)(s_rm + 0 * RMB + (ps * RC_RM + pc0) * 2) = pack8(a_);
            *(uint4*)(s_rm + 1 * RMB + (ps * RC_RM + pc0) * 2) = pack8(b_);
            *(uint4*)(s_rm + 2 * RMB + (ps * RC_RM + pc0) * 2) = pack8(k_);
            *(uint4*)(s_rm + 3 * RMB + (ps * RC_RM + pc0) * 2) = pack8(r_);
            if ((lane >> 3) == 7) { *(float4*)(s_tot + wave * 64 + pc0) = make_float4(lg[0], lg[1], lg[2], lg[3]); *(float4*)(s_tot + wave * 64 + pc0 + 4) = make_float4(lg[4], lg[5], lg[6], lg[7]); }
        }
        g4_bar(G);
        {
#pragma unroll
            for (int w2 = 0; w2 < 3; ++w2) {
                if (w2 < wave) {
                    const float4 e0 = *(const float4*)(s_tot + w2 * 64 + pc0), e1 = *(const float4*)(s_tot + w2 * 64 + pc0 + 4);
                    lg[0] += e0.x; lg[1] += e0.y; lg[2] += e0.z; lg[3] += e0.w; lg[4] += e1.x; lg[5] += e1.y; lg[6] += e1.z; lg[7] += e1.w;
                }
            }
            float ah[8], bhh[8], kh[8], rh[8];
            unpack8(*(const uint4*)(s_rm + 0 * RMB + (ps * RC_RM + pc0) * 2), ah);
            unpack8(*(const uint4*)(s_rm + 1 * RMB + (ps * RC_RM + pc0) * 2), bhh);
            unpack8(*(const uint4*)(s_rm + 2 * RMB + (ps * RC_RM + pc0) * 2), kh);
            unpack8(*(const uint4*)(s_rm + 3 * RMB + (ps * RC_RM + pc0) * 2), rh);
#pragma unroll
            for (int j = 0; j < 8; ++j) {
                const float ep = fexp(lg[j]), em = fexp(-lg[j]), ep1 = fexp(lg[j] - dl_[j]);
                ah[j] *= ep1; bhh[j] *= em; kh[j] *= em; rh[j] *= ep;
                if (ps == RC_L - 1) s_gl[pc0 + j] = ep;
            }
            *(uint4*)(s_rm + 0 * RMB + (ps * RC_RM + pc0) * 2) = pack8(ah);
            *(uint4*)(s_rm + 1 * RMB + (ps * RC_RM + pc0) * 2) = pack8(bhh);
            *(uint4*)(s_rm + 2 * RMB + (ps * RC_RM + pc0) * 2) = pack8(kh);
            *(uint4*)(s_rm + 3 * RMB + (ps * RC_RM + pc0) * 2) = pack8(rh);
#pragma unroll
            for (int j = 0; j < 8; ++j) {
                *(bfr*)(s_tr + 0 * TRB + rc_tro(pc0 + j) + ps * 2) = f2bf(ah[j]);
                *(bfr*)(s_tr + 1 * TRB + rc_tro(pc0 + j) + ps * 2) = f2bf(bhh[j]);
                *(bfr*)(s_tr + 2 * TRB + rc_tro(pc0 + j) + ps * 2) = f2bf(kh[j]);
            }
        }
        if (item + G.nvb < 128 * RC_NCH) RC_PREF(item + G.nvb);
        g4_bar(G);
        if (probe < 3) {
            const char* xa = s_rm + (wave < 2 ? 0 : 3) * RMB;
            const char* xb = s_rm + ((wave & 1) ? 2 : 1) * RMB;
            f32x16 acc = rc_zero();
#pragma unroll
            for (int ks = 0; ks < 4; ++ks)
                acc = MFMA32(rc_ld16(xa + (ln * RC_RM + ks * 16 + hf * 8) * 2), rc_ld16(xb + (ln * RC_RM + ks * 16 + hf * 8) * 2), acc);
#pragma unroll
            for (int r = 0; r < 16; ++r) {
                const int t = (r & 3) + 8 * (r >> 2) + 4 * hf;
                const bool keep = (wave < 2) ? (ln < t) : (ln <= t);
                acc[r] = keep ? acc[r] : 0.f;
                if (wave != 0) *(bfr*)(s_ma + (wave - 1) * MAB + (t * RC_TR + ln) * 2) = f2bf(acc[r]);
            }
            if (wave == 0 && probe < 2) {
                f32x16 Ap = acc, Pa = acc;
#pragma unroll
                for (int r = 0; r < 16; ++r) { const int t = (r & 3) + 8 * (r >> 2) + 4 * hf; Pa[r] += (t == ln) ? 1.f : 0.f; }
                char* imA = s_im; char* imH = s_im + MAB;
#pragma unroll 1
                for (int it = 0; it < 4; ++it) {
#pragma unroll
                    for (int r = 0; r < 16; ++r) {
                        const int t = (r & 3) + 8 * (r >> 2) + 4 * hf;
                        *(bfr*)(imA + (t * RC_TR + ln) * 2) = f2bf(Ap[r]);
                        *(bfr*)(imH + (t * RC_TR + ln) * 2) = f2bf(Pa[r]);
                    }
                    const bf16x8 a0 = rc_pack(Ap, 0), a1 = rc_pack(Ap, 1);
                    const int ro = (ln * RC_TR + 4 * hf) * 2;
                    f32x16 An = rc_zero();
                    An = MFMA32(rc_ld8x2(imA + ro), a0, An);
                    An = MFMA32(rc_ld8x2(imA + ro + 32), a1, An);
                    Ap = An;
                    const bf16x8 b0 = rc_pack(Ap, 0), b1 = rc_pack(Ap, 1);
                    Pa = MFMA32(rc_ld8x2(imH + ro), b0, Pa); Pa = MFMA32(rc_ld8x2(imH + ro + 32), b1, Pa);
                }
#pragma unroll
                for (int r = 0; r < 16; ++r) { const int t = (r & 3) + 8 * (r >> 2) + 4 * hf; *(bfr*)(s_ma + 3 * MAB + (t * RC_TR + ln) * 2) = f2bf(Pa[r]); }
            } else if (wave == 1) {
#pragma unroll
                for (int it = 0; it < 2; ++it) {
                    f32x16 w2 = rc_zero();
#pragma unroll
                    for (int ks = 0; ks < 2; ++ks)
                        w2 = MFMA32(rc_ld16(s_ma + 0 * MAB + (ln * RC_TR + ks * 16 + hf * 8) * 2), rc_ld16(s_tr + 3 * TRB + rc_tro(it * 32 + ln) + (ks * 16 + hf * 8) * 2), w2);
#pragma unroll
                    for (int q = 0; q < 4; ++q)
                        *(uint2*)(s_w2t + rc_tro(it * 32 + ln) + (8 * q + 4 * hf) * 2) = make_uint2(pk2(w2[4 * q], w2[4 * q + 1]), pk2(w2[4 * q + 2], w2[4 * q + 3]));
                }
            }
        }
        g4_bar(G);
        if (probe < 1) {
            const int hp = wave & 1;
            const size_t chunk = (size_t)bh * RC_NCH + c;
            const char* tm = s_ma + 3 * MAB;
            const char* bsrc = (wave < 2) ? (s_tr + 0 * TRB) : s_w2t;
            f32x16 X = rc_zero();
#pragma unroll
            for (int ks = 0; ks < 2; ++ks)
                X = MFMA32(rc_ld16(tm + (ln * RC_TR + ks * 16 + hf * 8) * 2), rc_ld16(bsrc + rc_tro(hp * 32 + ln) + (ks * 16 + hf * 8) * 2), X);
            const bf16x8 xf0 = rc_pack(X, 0), xf1 = rc_pack(X, 1);
            const char* arb = s_ma + 1 * MAB; const char* ark = s_ma + 2 * MAB;
            if (wave < 2) {
#pragma unroll
                for (int jt = 0; jt < 2; ++jt) {
                    f32x16 acc = rc_zero();
                    const char* bp = s_tr + 1 * TRB + rc_tro(jt * 32 + ln) + 8 * hf;
                    acc = MFMA32(xf0, rc_ld8x2(bp), acc);
                    acc = MFMA32(xf1, rc_ld8x2(bp + 32), acc);
                    const int j = jt * 32 + ln;
                    const float gl = s_gl[j];
                    bfr* dst = gG + chunk * 4096 + (size_t)j * 64 + hp * 32 + 4 * hf;
#pragma unroll
                    for (int q = 0; q < 4; ++q) {
                        float o[4];
#pragma unroll
                        for (int e = 0; e < 4; ++e) { const int jp = hp * 32 + 8 * q + 4 * hf + e; o[e] = gl * (acc[4 * q + e] + (jp == j ? 1.f : 0.f)); }
                        *(uint2*)(dst + 8 * q) = make_uint2(pk2(o[0], o[1]), pk2(o[2], o[3]));
                    }
                }
                {
                    f32x16 acc = rc_zero();
                    const char* bp = arb + (ln * RC_TR + 4 * hf) * 2;
                    acc = MFMA32(xf0, rc_ld8x2(bp), acc);
                    acc = MFMA32(xf1, rc_ld8x2(bp + 32), acc);
                    bfr* dst = gQ + chunk * 2048 + (size_t)ln * 64 + hp * 32 + 4 * hf;
                    const char* rsrc = s_rm + 3 * RMB + (ln * RC_RM + hp * 32 + 4 * hf) * 2;
#pragma unroll
                    for (int q = 0; q < 4; ++q) {
                        const uint2 rr = *(const uint2*)(rsrc + 16 * q);
                        *(uint2*)(dst + 8 * q) = make_uint2(pk2(acc[4 * q] + bflo(rr.x), acc[4 * q + 1] + bfhi(rr.x)), pk2(acc[4 * q + 2] + bflo(rr.y), acc[4 * q + 3] + bfhi(rr.y)));
                    }
                }
            } else {
#pragma unroll
                for (int jt = 0; jt < 2; ++jt) {
                    f32x16 acc = rc_zero();
                    const char* ap = s_tr + 1 * TRB + rc_tro(jt * 32 + ln) + 8 * hf;
                    acc = MFMA32(rc_ld8x2(ap), xf0, acc);
                    acc = MFMA32(rc_ld8x2(ap + 32), xf1, acc);
#pragma unroll
                    for (int ks = 0; ks < 2; ++ks)
                        acc = MFMA32(rc_ld16(s_tr + 2 * TRB + rc_tro(jt * 32 + ln) + (ks * 16 + hf * 8) * 2), rc_ld16(s_tr + 3 * TRB + rc_tro(hp * 32 + ln) + (ks * 16 + hf * 8) * 2), acc);
                    bfr* dst = gH + chunk * 4096 + (size_t)(hp * 32 + ln) * 64 + jt * 32 + 4 * hf;
#pragma unroll
                    for (int q = 0; q < 4; ++q) {
                        const float4 gl = *(const float4*)(s_gl + jt * 32 + 8 * q + 4 * hf);
                        *(uint2*)(dst + 8 * q) = make_uint2(pk2(gl.x * acc[4 * q], gl.y * acc[4 * q + 1]), pk2(gl.z * acc[4 * q + 2], gl.w * acc[4 * q + 3]));
                    }
                }
                {
                    f32x16 acc = rc_zero();
                    const char* bp = arb + (ln * RC_TR + 4 * hf) * 2;
                    acc = MFMA32(xf0, rc_ld8x2(bp), acc);
                    acc = MFMA32(xf1, rc_ld8x2(bp + 32), acc);
#pragma unroll
                    for (int ks = 0; ks < 2; ++ks)
                        acc = MFMA32(rc_ld16(s_tr + 3 * TRB + rc_tro(hp * 32 + ln) + (ks * 16 + hf * 8) * 2), rc_ld16(ark + (ln * RC_TR + ks * 16 + hf * 8) * 2), acc);
                    bfr* dst = gZ + chunk * 2048 + (size_t)ln * 64 + hp * 32 + 4 * hf;
#pragma unroll
                    for (int q = 0; q < 4; ++q) *(uint2*)(dst + 8 * q) = make_uint2(pk2(acc[4 * q], acc[4 * q + 1]), pk2(acc[4 * q + 2], acc[4 * q + 3]));
                }
            }
        }
        g4_bar(G);
    }
}

DI bf16x8 rc_join(uint2 a, uint2 b) { return __builtin_bit_cast(bf16x8, make_uint4(a.x, a.y, b.x, b.y)); }
struct RcG { uint2 g[16]; };
DI void rc_load_g(RcG& f, const bfr* Gc, int ln, int hf) {
#pragma unroll
    for (int x = 0; x < 4; ++x) {
        const int o = (x >> 1) * 32 + (x & 1) * 16 + 4 * hf;
        f.g[4 * x] = *(const uint2*)(Gc + (size_t)ln * 64 + o);            f.g[4 * x + 1] = *(const uint2*)(Gc + (size_t)ln * 64 + o + 8);
        f.g[4 * x + 2] = *(const uint2*)(Gc + (size_t)(32 + ln) * 64 + o); f.g[4 * x + 3] = *(const uint2*)(Gc + (size_t)(32 + ln) * 64 + o + 8);
    }
}
DI void phase_r2(const Ctx& P) {
    const int tid = ltid(), lane = tid & 63, wave = tid >> 6;
    const int ln = lane & 31, hf = lane >> 5;
    const bfr* gG = (const bfr*)(P.ws + OFF_RCG); const bfr* gH = (const bfr*)(P.ws + OFF_RCH); const bfr* gQ = (const bfr*)(P.ws + OFF_RCQ); const bfr* gZ = (const bfr*)(P.ws + OFF_RCZ);
    bfr* yout = (bfr*)(P.ws + OFF_Y);
    if (wave != 0) return;
#define RC_LOAD_ALL(GV, QV, HV, ZV, ch_) do { const bfr* Hc_ = gH + (ch_) * 4096; const bfr* Qc_ = gQ + (ch_) * 2048; const bfr* Zc_ = gZ + (ch_) * 2048; \
        rc_load_g(GV, gG + (ch_) * 4096, ln, hf); \
        _Pragma("unroll") for (int x = 0; x < 4; ++x) { const int o_ = (x >> 1) * 32 + (x & 1) * 16 + 4 * hf; \
            QV[2 * x] = *(const uint2*)(Qc_ + (size_t)ln * 64 + o_); QV[2 * x + 1] = *(const uint2*)(Qc_ + (size_t)ln * 64 + o_ + 8); } \
        _Pragma("unroll") for (int q = 0; q < 4; ++q) { ZV[q] = *(const uint2*)(Zc_ + (size_t)ln * 64 + ic * 32 + 4 * hf + 8 * q); \
            HV[q] = *(const uint2*)(Hc_ + (size_t)(ic * 32 + ln) * 64 + 4 * hf + 8 * q); HV[4 + q] = *(const uint2*)(Hc_ + (size_t)(ic * 32 + ln) * 64 + 32 + 4 * hf + 8 * q); } } while (0)
#define RC_STEP(GV, QV, HV, ZV, c_) do { \
        bf16x8 mh[2][2]; \
        _Pragma("unroll") for (int ks = 0; ks < 2; ++ks) { mh[0][ks] = rc_pack(M0, ks); mh[1][ks] = rc_pack(M1, ks); } \
        f32x16 n0 = rc_zero(), n1 = rc_zero(), ya = rc_zero(); \
        _Pragma("unroll") for (int x = 0; x < 4; ++x) { \
            const bf16x8 g0 = rc_join(GV.g[4 * x], GV.g[4 * x + 1]), g1 = rc_join(GV.g[4 * x + 2], GV.g[4 * x + 3]); \
            n0 = MFMA32(g0, mh[x >> 1][x & 1], n0); n1 = MFMA32(g1, mh[x >> 1][x & 1], n1); \
            ya = MFMA32(mh[x >> 1][x & 1], rc_join(QV[2 * x], QV[2 * x + 1]), ya); } \
        bfr* yp = yout + ((size_t)b * SEQ + (c_) * RC_L + ln) * 512 + h * 64 + ic * 32 + 4 * hf; \
        _Pragma("unroll") for (int q = 0; q < 4; ++q) { const uint2 zz = ZV[q]; \
            *(uint2*)(yp + 8 * q) = make_uint2(pk2(ya[4 * q] + bflo(zz.x), ya[4 * q + 1] + bfhi(zz.x)), pk2(ya[4 * q + 2] + bflo(zz.y), ya[4 * q + 3] + bfhi(zz.y))); } \
        _Pragma("unroll") for (int q = 0; q < 4; ++q) { const uint2 h0 = HV[q], h1 = HV[4 + q]; \
            M0[4 * q] = n0[4 * q] + bflo(h0.x); M0[4 * q + 1] = n0[4 * q + 1] + bfhi(h0.x); M0[4 * q + 2] = n0[4 * q + 2] + bflo(h0.y); M0[4 * q + 3] = n0[4 * q + 3] + bfhi(h0.y); \
            M1[4 * q] = n1[4 * q] + bflo(h1.x); M1[4 * q + 1] = n1[4 * q + 1] + bfhi(h1.x); M1[4 * q + 2] = n1[4 * q + 2] + bflo(h1.y); M1[4 * q + 3] = n1[4 * q + 3] + bfhi(h1.y); } } while (0)
    for (int item = blockIdx.x; item < 256; item += gridDim.x) {
        const int bh = item >> 1, ic = item & 1;
        const int b = bh >> 3, h = bh & 7;
        f32x16 M0 = rc_zero(), M1 = rc_zero();
        const size_t ch0 = (size_t)bh * RC_NCH;
        RcG gA, gB; uint2 qA[8], hA[8], zA[4], qB[8], hB[8], zB[4];
        RC_LOAD_ALL(gA, qA, hA, zA, ch0);
#pragma unroll 1
        for (int c = 0; c < RC_NCH; c += 2) {
            RC_LOAD_ALL(gB, qB, hB, zB, ch0 + c + 1);
            RC_STEP(gA, qA, hA, zA, c);
            RC_LOAD_ALL(gA, qA, hA, zA, ch0 + (c + 2 < RC_NCH ? c + 2 : c));
            RC_STEP(gB, qB, hB, zB, c + 1);
        }
    }
#undef RC_LOAD_ALL
#undef RC_STEP
}
DI void phase_o1(char* lds, const Ctx& P, int li) {
    const bfr* hb = (const bfr*)(P.ws + OFF_HB);
    const bfr* w = (const bfr*)(P.ws + OFF_WINO) + (size_t)li * 2048 * 1024;
    bfr* qk = (bfr*)(P.ws + OFF_U);
    bfr* vT = (bfr*)(P.ws + OFF_VT);
    bfr* us5 = (bfr*)(P.ws + OFF_US5);
    struct O1Sched {
        const char* hb; const char* w;
        DI bool next(int i, p8::Unit& u) const { const int L = i * (int)gridDim.x + (int)blockIdx.x; if (L >= 1024) return false; tile_remap(L, 128, 8, u.pm, u.pn); u.x0 = (u.pn == 4 || u.pn == 5) ? 1 : 0; u.x1 = 0; return true; }
        DI const char* a_base(const p8::Unit& u) const { return u.x0 ? w + (size_t)u.pn * (256 * 1024 * 2) : hb + (size_t)u.pm * (256 * 1024 * 2); }
        DI const char* b_base(const p8::Unit& u) const { return u.x0 ? hb + (size_t)u.pm * (256 * 1024 * 2) : w + (size_t)u.pn * (256 * 1024 * 2); }
        DI void a_offs(int, const p8::Unit&, const int (&)[2], const int (&)[2], unsigned (&)[2][2]) const {}
    };
    O1Sched S{(const char*)hb, (const char*)w};
    p8::gemm_phase<true, false>(lds, 1024, S, [&](const p8::f32x4 (&acc)[2][2][4][2], const p8::Unit& un, int wr, int wc, int fr, int fq) __attribute__((always_inline)) {
        const int r0 = wr * 64 + fr, c0 = wc * 32 + 8 * fq;
        const int m0 = un.pm * 256;
        if (un.x0) {
            bfr* o = vT + ((size_t)((m0 >> 11) * 512 + (un.pn - 4) * 256 + r0)) * SEQ + (m0 & (SEQ - 1)) + c0;
#pragma unroll
            for (int ai = 0; ai < 2; ++ai)
#pragma unroll
                for (int m = 0; m < 4; ++m)
#pragma unroll
                    for (int bj = 0; bj < 2; ++bj)
                        *(uint4*)(o + (size_t)(ai * 128 + m * 16) * SEQ + bj * 128) = p8::pack_bf8(acc[ai][bj][m][0], acc[ai][bj][m][1]);
        } else if (un.pn < 4) {
            bfr* o = qk + (size_t)(m0 + r0) * 1024 + un.pn * 256 + c0;
#pragma unroll
            for (int ai = 0; ai < 2; ++ai)
#pragma unroll
                for (int m = 0; m < 4; ++m)
#pragma unroll
                    for (int bj = 0; bj < 2; ++bj)
                        *(uint4*)(o + (size_t)(ai * 128 + m * 16) * 1024 + bj * 128) = p8::pack_bf8(acc[ai][bj][m][0], acc[ai][bj][m][1]);
        } else {
#pragma unroll
            for (int bj = 0; bj < 2; ++bj) {
                const int cc = (un.pn - 6) * 256 + bj * 128 + c0;
                bfr* o = us5 + ((size_t)(cc >> 4) * NTOK + m0 + r0) * 16 + (cc & 15);
#pragma unroll
                for (int ai = 0; ai < 2; ++ai)
#pragma unroll
                    for (int m = 0; m < 4; ++m)
                        *(uint4*)(o + (size_t)(ai * 128 + m * 16) * 16) = p8::pack_bf8(acc[ai][bj][m][0], acc[ai][bj][m][1]);
            }
        }
    });
    __syncthreads();
}

DI void phase_o2(char* lds, const Ctx& P, int li) {
    const bfr* qk = (const bfr*)(P.ws + OFF_U);
    bfr* qn = (bfr*)(P.ws + OFF_QN);
    bfr* kn = (bfr*)(P.ws + OFF_KN);
    const float* gq = P.in[I_QN] + li * 64;
    const float* gk = P.in[I_KN] + li * 64;
    const bfr* us5 = (const bfr*)(P.ws + OFF_US5);
    const bfr* bl = (const bfr*)(P.ws + OFF_S5BL) + (size_t)li * 32 * 128 * 512;
    float* xloc = (float*)(P.ws + OFF_XLOC);
    for (int t = blockIdx.x; t < 128; t += gridDim.x) {
        const int g = t >> 2, mt = t & 3;
        RowLoader A(us5 + (size_t)g * NTOK * 16, mt * 256, 512), B(bl + (size_t)g * 128 * 512, 0, 512);
        GEMM128(lds, 8, A, B, [&](const float* stg, int) __attribute__((always_inline)) {
            epi_rows8(stg, [&](int r, int c0, const float (&v)[8]) __attribute__((always_inline)) {
                float* d = xloc + ((size_t)g * 1024 + mt * 256 + r) * 128 + c0;
                *(float4*)d = make_float4(v[0], v[1], v[2], v[3]); *(float4*)(d + 4) = make_float4(v[4], v[5], v[6], v[7]);
            });
        });
    }
    const int total = NTOK * 16 * 8;
    for (int idx = blockIdx.x * NTHREADS + ltid(); idx < total; idx += gridDim.x * NTHREADS) {
        const int l8 = idx & 7, item = idx >> 3;
        const int hm = item & 7, which = (item >> 3) & 1, tok = item >> 4;
        const int d0 = l8 * 4;
        const bfr* src = qk + (size_t)tok * 1024 + which * 512 + hm * 64;
        const uint2 ua = *(const uint2*)(src + d0), ub = *(const uint2*)(src + 32 + d0);
        float x1[4] = {bflo(ua.x), bfhi(ua.x), bflo(ua.y), bfhi(ua.y)};
        float x2[4] = {bflo(ub.x), bfhi(ub.x), bflo(ub.y), bfhi(ub.y)};
        float ss = 0.f;
#pragma unroll
        for (int j = 0; j < 4; ++j) ss += x1[j] * x1[j] + x2[j] * x2[j];
        ss += __shfl_xor(ss, 1); ss += __shfl_xor(ss, 2); ss += __shfl_xor(ss, 4);
        const float rs = rsqrtf(ss * (1.0f / 64.0f) + 1e-6f);
        const float* gg = which ? gk : gq;
        const float scl = which ? 1.0f : (0.125f * 1.4426950408889634f);
        const int t = tok & (SEQ - 1);
        float o1[4], o2[4];
#pragma unroll
        for (int j = 0; j < 4; ++j) {
            const int i = d0 + j;
            const float invf = exp2f(-(float)i * (13.287712379549449f / 32.0f));
            const float ang = (float)t * invf;
            float sn, cs;
            sincosf(ang, &sn, &cs);
            const float a = x1[j] * rs * gg[i], b2 = x2[j] * rs * gg[32 + i];
            o1[j] = (a * cs - b2 * sn) * scl;
            o2[j] = (b2 * cs + a * sn) * scl;
        }
        bfr* dst = (which ? kn : qn) + (size_t)tok * 512 + hm * 64;
        *(uint2*)(dst + d0) = make_uint2(pk2(o1[0], o1[1]), pk2(o1[2], o1[3]));
        *(uint2*)(dst + 32 + d0) = make_uint2(pk2(o2[0], o2[1]), pk2(o2[2], o2[3]));
    }
}

DI void s5_scan(const Ctx& P, int li) {
    const float* xloc = (const float*)(P.ws + OFF_XLOC);
    bfr* xin = (bfr*)(P.ws + OFF_XIN);
    const float* l32 = (const float*)(P.ws + OFF_S5L32) + (size_t)li * 32 * 128;
    for (int idx = blockIdx.x * NTHREADS + ltid(); idx < 32 * 16 * 64; idx += gridDim.x * NTHREADS) {
        const int p = idx & 63, b = (idx >> 6) & 15, g = idx >> 10;
        const float lr = l32[g * 128 + 2 * p], lim = l32[g * 128 + 2 * p + 1];
        float xr = 0.f, xi = 0.f;
        for (int ch = 0; ch < 64; ++ch) {
            const size_t o = ((size_t)g * 1024 + b * 64 + ch) * 128 + 2 * p;
            *(unsigned*)(xin + o) = pk2(xr, xi);
            const float2 a = *(const float2*)(xloc + o);
            const float nr = lr * xr - lim * xi + a.x, ni = lr * xi + lim * xr + a.y;
            xr = nr; xi = ni;
        }
    }
}

DI void attn_item(char* lds, const Ctx& P, int b, int h, int qt, float lam, float lam_init, const float* subln) {
    const bfr* qn = (const bfr*)(P.ws + OFF_QN);
    const bfr* kn = (const bfr*)(P.ws + OFF_KN);
    const bfr* vT = (const bfr*)(P.ws + OFF_VT) + (size_t)(b * 4 + h) * 128 * SEQ;
    bfr* am = (bfr*)(P.ws + OFF_AMIX);
    const int tid = ltid(), lane = tid & 63, wave = tid >> 6;
    const int m = wave >> 2, qw = (wave & 3) * 32;
    const int q0 = qt * 128 + qw;
    const int ln = lane & 31, hf = lane >> 5;
    bf16x8 qf[4];
    {
        const bfr* qp = qn + ((size_t)b * SEQ + q0 + ln) * 512 + h * 128 + m * 64 + hf * 8;
#pragma unroll
        for (int ks = 0; ks < 4; ++ks) qf[ks] = *(const bf16x8*)(qp + ks * 16);
    }
    f32x16 o[4];
#pragma unroll
    for (int d = 0; d < 4; ++d)
#pragma unroll
        for (int r = 0; r < 16; ++r) o[d][r] = 0.f;
    float mrun = 0.f, lrun = 0.f;
    const int nkt = 2 * (qt + 1);
    const int lrow = tid >> 3, lcol = (tid & 7) * 8;
    const bfr* kbase = kn + ((size_t)b * SEQ) * 512 + h * 128;
    unsigned ko = (unsigned)(lrow * 512 + lcol) * 2u, vo = (unsigned)(lrow * SEQ + lcol) * 2u;
    asm volatile("" : "+v"(ko), "+v"(vo));
    uint4 rk0, rk1, rv0, rv1;
#define ATT_GLOAD(kt_) do { const char* kp_ = (const char*)(kbase + (size_t)(kt_) * (64 * 512)); const char* vp_ = (const char*)(vT + (kt_) * 64); \
        rk0 = *(const uint4*)(kp_ + ko); rk1 = *(const uint4*)(kp_ + 64 * 2 + ko); \
        rv0 = *(const uint4*)(vp_ + vo); rv1 = *(const uint4*)(vp_ + 64 * SEQ * 2 + vo); } while (0)
#define ATT_S1(base_, i_, RK, RV) { *(uint4*)((base_) + (64 * (i_)) * LDA * 2) = RK; \
        *(uint4*)((base_) + TILE_B + (64 * (i_)) * LDA * 2) = RV; }
#define ATT_LSTORE(buf_) do { char* base_ = lds + (buf_) * (2 * TILE_B) + s_off; ATT_S1(base_, 0, rk0, rv0) ATT_S1(base_, 1, rk1, rv1) } while (0)
    int k_off = ((m * 64 + ln) * LDA + hf * 8) * 2;
    int v_off = TILE_B + (ln * LDA + 4 * hf) * 2;
    int s_off = (lrow * LDA + lcol) * 2;
    asm volatile("" : "+v"(k_off), "+v"(v_off), "+v"(s_off));
    ATT_GLOAD(0); ATT_LSTORE(0);
    __syncthreads();
    int buf = 0;
#pragma unroll 1
    for (int kt = 0; kt < nkt; ++kt) {
        const bool more = (kt + 1 < nkt);
        if (more) ATT_GLOAD(kt + 1);
        const char* ks_ = lds + buf * (2 * TILE_B) + k_off;
        const char* vs_ = lds + buf * (2 * TILE_B) + v_off;
        if (kt * 64 <= q0 + 31) {
            f32x16 s[2];
            const float negm = -mrun;
#pragma unroll
            for (int kb = 0; kb < 2; ++kb) {
#pragma unroll
                for (int r = 0; r < 16; ++r) s[kb][r] = negm;
#pragma unroll
                for (int ks = 0; ks < 4; ++ks) {
                    const bf16x8 kf = *(const bf16x8*)(ks_ + ((kb * 32) * LDA + ks * 16) * 2);
                    s[kb] = MFMA32(kf, qf[ks], s[kb]);
                }
            }
            const int qpos = q0 + ln;
            if (kt * 64 + 63 > q0) {
#pragma unroll
                for (int kb = 0; kb < 2; ++kb)
#pragma unroll
                    for (int r = 0; r < 16; ++r) {
                        const int key = kt * 64 + kb * 32 + (r & 3) + 8 * (r >> 2) + 4 * hf;
                        if (key > qpos) s[kb][r] = -INFINITY;
                    }
            }
            float mx = s[0][0];
#pragma unroll
            for (int kb = 0; kb < 2; ++kb)
#pragma unroll
                for (int r = 0; r < 16; ++r) mx = fmaxf(mx, s[kb][r]);
            mx = fmaxf(mx, __shfl_xor(mx, 32));
            if (kt == 0 || __any(mx > 8.0f)) {
                const float delta = (kt == 0 || mx > 8.0f) ? mx : 0.f;
                const float alpha = __builtin_amdgcn_exp2f(-delta);
                mrun += delta;
                lrun *= alpha;
#pragma unroll
                for (int kb = 0; kb < 2; ++kb)
#pragma unroll
                    for (int r = 0; r < 16; ++r) s[kb][r] -= delta;
#pragma unroll
                for (int d = 0; d < 4; ++d)
#pragma unroll
                    for (int r = 0; r < 16; ++r) o[d][r] *= alpha;
            }
            float rsum = 0.f;
#pragma unroll
            for (int kb = 0; kb < 2; ++kb)
#pragma unroll
                for (int r = 0; r < 16; ++r) { const float pv_ = __builtin_amdgcn_exp2f(s[kb][r]); s[kb][r] = pv_; rsum += pv_; }
            lrun += rsum;
#define ATT_VLD(V_, g_) do { _Pragma("unroll") for (int d_ = 0; d_ < 4; ++d_) { \
                V_[2 * d_] = *(const uint2*)(vs_ + ((d_ * 32) * LDA + 16 * (g_)) * 2); V_[2 * d_ + 1] = *(const uint2*)(vs_ + ((d_ * 32) * LDA + 16 * (g_) + 8) * 2); } } while (0)
#define ATT_PV(V_, g_) do { const int kb_ = (g_) >> 1, st_ = (g_) & 1; \
                const bf16x8 pf_ = __builtin_bit_cast(bf16x8, make_uint4(pk2(s[kb_][8 * st_ + 0], s[kb_][8 * st_ + 1]), pk2(s[kb_][8 * st_ + 2], s[kb_][8 * st_ + 3]), \
                                                                         pk2(s[kb_][8 * st_ + 4], s[kb_][8 * st_ + 5]), pk2(s[kb_][8 * st_ + 6], s[kb_][8 * st_ + 7]))); \
                _Pragma("unroll") for (int d_ = 0; d_ < 4; ++d_) \
                    o[d_] = MFMA32(__builtin_bit_cast(bf16x8, make_uint4(V_[2 * d_].x, V_[2 * d_].y, V_[2 * d_ + 1].x, V_[2 * d_ + 1].y)), pf_, o[d_]); } while (0)
            {
                uint2 va[8], vb[8];
                ATT_VLD(va, 0);
                ATT_VLD(vb, 1); ATT_PV(va, 0);
                ATT_VLD(va, 2); ATT_PV(vb, 1);
                ATT_VLD(vb, 3); ATT_PV(va, 2);
                ATT_PV(vb, 3);
            }
#undef ATT_VLD
#undef ATT_PV
        }
        if (more) ATT_LSTORE(buf ^ 1);
        __syncthreads();
        buf ^= 1;
    }
    const float ltot = lrun + __shfl_xor(lrun, 32);
    const float linv = 1.0f / ltot;
    float* ob = (float*)lds;
    int o_off = (m * 128 + qw + ln) * 129 + 4 * hf;
    asm volatile("" : "+v"(o_off));
#pragma unroll
    for (int d = 0; d < 4; ++d)
#pragma unroll
        for (int r = 0; r < 16; ++r) ob[o_off + d * 32 + (r & 3) + 8 * (r >> 2)] = o[d][r] * linv;
    __syncthreads();
#pragma unroll
    for (int it = 0; it < 4; ++it) {
        const int idx = it * NTHREADS + tid;
        const int q = idx >> 4, c0 = (idx & 15) * 8;
        float v[8];
        float ss = 0.f;
        int r_off = q * 129 + c0;
        asm volatile("" : "+v"(r_off));
#pragma unroll
        for (int j = 0; j < 8; ++j) { v[j] = ob[r_off + j] - lam * ob[r_off + 128 * 129 + j]; ss += v[j] * v[j]; }
        ss = row16_sum(ss);
        const float rs = rsqrtf(ss * (1.0f / 128.0f) + 1e-5f) * (1.0f - lam_init);
#pragma unroll
        for (int j = 0; j < 8; ++j) v[j] = v[j] * rs * subln[c0 + j];
        *(uint4*)(am + ((size_t)b * SEQ + qt * 128 + q) * 1024 + h * 128 + c0) = pack8(v);
    }
    __syncthreads();
}

DI void phase_o3(char* lds, const Ctx& P, int li, int layer) {
    s5_scan(P, li);
    float lam;
    {
        const int j = ltid() & 63;
        const float s1 = wave_sum(P.in[I_LQ1][li * 64 + j] * P.in[I_LK1][li * 64 + j]);
        const float s2 = wave_sum(P.in[I_LQ2][li * 64 + j] * P.in[I_LK2][li * 64 + j]);
        const float lam_init0 = 0.8f - 0.6f * __expf(-0.3f * (float)layer);
        lam = __expf(s1) - __expf(s2) + lam_init0;
    }
    const float lam_init = 0.8f - 0.6f * __expf(-0.3f * (float)layer);
    const float* subln = P.in[I_SUBLN] + li * 128;
    for (int item = blockIdx.x; item < 512; item += gridDim.x) {
        const int bh = item >> 3, pr = item & 7;
        for (int half = 0; half < 2; ++half) attn_item(lds, P, bh >> 2, bh & 3, half ? 15 - pr : pr, lam, lam_init, subln);
    }
}

DI void phase_o4(char* lds, const Ctx& P, int li) {
    const bfr* us5 = (const bfr*)(P.ws + OFF_US5);
    const bfr* xin = (const bfr*)(P.ws + OFF_XIN);
    const bfr* gt = (const bfr*)(P.ws + OFF_S5GT) + (size_t)li * 32 * 512 * 640;
    const float* dsk = P.in[I_S5D] + li * 512;
    bfr* zb = (bfr*)(P.ws + OFF_ZBUF);
    for (int t = blockIdx.x; t < 512; t += gridDim.x) {
        const int g = t >> 4, mt = (t >> 2) & 3, nt = t & 3;
        const int nloc = 2 * (nt + 1);
        const bfr* ag = us5 + (size_t)g * NTOK * 16;
        const bfr* xg = xin + (size_t)g * 1024 * 128;
        const int tq = ltid();
        const int arow = mt * 256 + (tq >> 3), acol = gt_lcol(tq);
        auto aptr = [&](int i, int kt) __attribute__((always_inline)) -> const bfr* {
            return (kt < nloc) ? ag + (size_t)(arow + 64 * i) * 512 + kt * 64 + acol
                               : xg + (size_t)(arow + 64 * i) * 128 + (kt - nloc) * 64 + acol;
        };
        const bfr* bg = gt + (size_t)g * 512 * 640 + (size_t)(nt * 128 + (tq >> 3)) * 640 + acol;
        auto bptr = [&](int i, int kt) __attribute__((always_inline)) -> const bfr* {
            return bg + (size_t)(64 * i) * 640 + ((kt < nloc) ? kt : (8 + kt - nloc)) * 64;
        };
        GEMM128(lds, nloc + 2, aptr, bptr, [&](const float* stg, int) __attribute__((always_inline)) {
            epi_rows8_pre<uint4>(stg,
                [&](int r, int c0) __attribute__((always_inline)) -> uint4 {
                    const int n = nt * 128 + c0;
                    return *(const uint4*)(ag + ((size_t)(mt * 256 + r) * 32 + (n >> 4)) * 16 + (n & 15)); },
                [&](int r, int c0, const float (&v)[8], const uint4& up) __attribute__((always_inline)) {
                    const int cb = mt * 256 + r;
                    const int n = nt * 128 + c0, tt = n >> 4, c1 = n & 15;
                    const size_t tok = (size_t)cb * 32 + tt;
                    float uu[8], z[8];
                    unpack8(up, uu);
#pragma unroll
                    for (int j = 0; j < 8; ++j) {
                        const float y = v[j] + dsk[g * 16 + c1 + j] * uu[j];
                        const float inner = 0.7978845608028654f * (y + 0.044715f * y * y * y);
                        z[j] = 0.5f * y * (1.0f + ftanh(inner));
                    }
                    *(uint4*)(zb + tok * 512 + g * 16 + c1) = pack8(z);
                });
        });
    }
}

DI void phase_o5(char* lds, const Ctx& P, int li) {
    const bfr* zb = (const bfr*)(P.ws + OFF_ZBUF);
    const bfr* w = (const bfr*)(P.ws + OFF_GLUT) + (size_t)li * 512 * 512;
    bfr* am = (bfr*)(P.ws + OFF_AMIX);
    for (int t = blockIdx.x; t < 512; t += gridDim.x) {
        int mt, nt; tile_remap(t, 128, 4, mt, nt);
        RowLoader A(zb, mt * 256, 512), B(w, nt * 128, 512);
        GEMM128(lds, 8, A, B, [&](const float* stg, int) __attribute__((always_inline)) {
            epi_rows8_pre<uint4>(stg,
                [&](int r, int c0) __attribute__((always_inline)) -> uint4 { return *(const uint4*)(zb + (size_t)(mt * 256 + r) * 512 + nt * 128 + c0); },
                [&](int r, int c0, const float (&v)[8], const uint4& zp) __attribute__((always_inline)) {
                    float zz[8], o[8];
                    unpack8(zp, zz);
#pragma unroll
                    for (int j = 0; j < 8; ++j) o[j] = zz[j] * sigmoidf_(v[j]);
                    *(uint4*)(am + (size_t)(mt * 256 + r) * 1024 + 512 + nt * 128 + c0) = pack8(o);
                });
        });
    }
}
DI void phase_router(char* lds, const Ctx& P, int layer) {
    const float* x = P.out;
    bfr* hb = (bfr*)(P.ws + OFF_HB);
    bfr* hlo = (bfr*)(P.ws + OFF_HLO);
    const bfr* rhi = (const bfr*)(P.ws + OFF_RHI) + (size_t)layer * 128 * 1024;
    const bfr* rlo = (const bfr*)(P.ws + OFF_RLO) + (size_t)layer * 128 * 1024;
    int* gcnt = (int*)(P.ws + OFF_CNT) + layer * 64;
    int* stok = (int*)(P.ws + OFF_TOK);
    float* sgate = (float*)(P.ws + OFF_GATE);
    int* tslot = (int*)(P.ws + OFF_TSLOT);
    int* lcnt = (int*)(lds + LDS_AUX);
    int* lbase = lcnt + 64;
    const float* bg = P.in[I_MBG] + layer * 4;
    const float* be = P.in[I_MBE] + layer * 32;
    const int tid = ltid();
    for (int u = blockIdx.x; u < 128; u += gridDim.x) {
        const int m0 = u * 256;
        norm_rows(x, P.in[I_NFFN] + (size_t)layer * DM, hb, hlo, nullptr, m0, 256);
        __syncthreads();
        const size_t roff = (size_t)(m0 + (tid >> 3)) * 1024 + gt_lcol(tid);
        const size_t boff = (size_t)(tid >> 3) * 1024 + gt_lcol(tid);
        auto aptr = [&](int i, int kt) __attribute__((always_inline)) -> const bfr* { return (kt < 32 ? hb : hlo) + roff + (size_t)(64 * i) * 1024 + (kt & 15) * 64; };
        auto bptr = [&](int i, int kt) __attribute__((always_inline)) -> const bfr* { return ((kt >= 16 && kt < 32) ? rlo : rhi) + boff + (size_t)(64 * i) * 1024 + (kt & 15) * 64; };
        GEMM128(lds, 48, aptr, bptr, [&](const float* stg, int) __attribute__((always_inline)) {
            if (tid < 64) lcnt[tid] = 0;
            __syncthreads();
            int seg0 = 0, seg1 = 0, p0 = 0, p1 = 0;
            float g0 = 0.f, g1 = 0.f;
            if (tid < 256) {
                const float* row = stg + tid * STG_LD;
                float gl[4];
#pragma unroll
                for (int j = 0; j < 4; ++j) gl[j] = row[32 + j] + bg[j];
                int gt = 0; float gm = gl[0];
#pragma unroll
                for (int j = 1; j < 4; ++j) if (gl[j] > gm) { gm = gl[j]; gt = j; }
                float gs = 0.f;
#pragma unroll
                for (int j = 0; j < 4; ++j) gs += __expf(gl[j] - gm);
                const float gw = 1.0f / gs;
                float l1 = -INFINITY, l2 = -INFINITY; int j1 = 0, j2 = 0;
                for (int j = 0; j < 8; ++j) {
                    const float v = row[gt * 8 + j] + be[gt * 8 + j];
                    if (v > l1) { l2 = l1; j2 = j1; l1 = v; j1 = j; }
                    else if (v > l2) { l2 = v; j2 = j; }
                }
                const float w1 = 1.0f / (1.0f + __expf(l2 - l1));
                g0 = gw * w1; g1 = gw * (1.0f - w1);
                seg0 = gt * 8 + j1; seg1 = 32 + gt * 8 + j2;
                p0 = atomicAdd(&lcnt[seg0], 1);
                p1 = atomicAdd(&lcnt[seg1], 1);
            }
            __syncthreads();
            if (tid < 64) { const int c = lcnt[tid]; lbase[tid] = c ? atomicAdd(&gcnt[tid], c) : 0; }
            __syncthreads();
            if (tid < 256) {
                const int q0 = lbase[seg0] + p0, q1 = lbase[seg1] + p1;
                stok[(size_t)seg0 * NTOK + q0] = m0 + tid; sgate[(size_t)seg0 * NTOK + q0] = g0;
                stok[(size_t)seg1 * NTOK + q1] = m0 + tid; sgate[(size_t)seg1 * NTOK + q1] = g1;
                tslot[m0 + tid] = seg0 * 32768 + q0;
            }
        });
    }
}

DI void moe_tables(char* lds, const Ctx& P, int layer) {
    int* cnt = (int*)(lds + LDS_AUX); int* rb0 = cnt + 64; int* hoff = rb0 + 65;
    const int* gcnt = (const int*)(P.ws + OFF_CNT) + layer * 64;
    const int tid = ltid();
    if (tid < 64) cnt[tid] = gcnt[tid];
    __syncthreads();
    if (tid == 0) {
        int acc = 0;
        for (int s = 0; s < 64; ++s) { rb0[s] = acc; hoff[s] = acc * 256; acc += (cnt[s] + 255) >> 8; }
        rb0[64] = acc;
    }
    __syncthreads();
}
DI int moe_find_seg(const int* rb0, int rbi) { int s = 0; while (rb0[s + 1] <= rbi) ++s; return s; }

DI void phase_moe_up(char* lds, const Ctx& P, int layer) {
    moe_tables(lds, P, layer);
    const int* cnt = (const int*)(lds + LDS_AUX); const int* rb0 = cnt + 64; const int* hoff = rb0 + 65;
    const bfr* hb = (const bfr*)(P.ws + OFF_HB);
    const bfr* wgu = (const bfr*)(P.ws + OFF_MWGU);
    const int* stok = (const int*)(P.ws + OFF_TOK);
    bfr* hid = (bfr*)(P.ws + OFF_HID);
    const int ntiles = rb0[64] * 4, G = gridDim.x;
    const int full = (ntiles / G) * G, rem = ntiles - full;
    const bool halves = rem > 0 && 2 * rem <= G;
    const int limit = halves ? full : ntiles, nrb = rb0[64];
    int* ltokt = (int*)(lds + LDS_AUX + 1024);
    for (int ui = 0; ui < 20; ++ui) {
        const int L = ui * G + (int)blockIdx.x;
        if (L >= limit) break;
        int rbi, nt; tile_remap(L, nrb, 4, rbi, nt);
        const int seg = moe_find_seg(rb0, rbi);
        const int tq = ltid();
        if (tq < 256) { const int c = cnt[seg]; int p = (rbi - rb0[seg]) * 256 + tq; p = p < c ? p : c - 1; ltokt[ui * 256 + tq] = stok[(size_t)seg * NTOK + p]; }
    }
    __syncthreads();
    {
        struct UpSched {
            const char* hb; const char* wgu; const int* rb0; const LAS int* ltokt; int limit, nrb;
            DI bool next(int i, p8::Unit& u) const {
                const int L = i * (int)gridDim.x + (int)blockIdx.x; if (L >= limit) return false;
                tile_remap(L, nrb, 4, u.pm, u.pn); u.x0 = moe_find_seg(rb0, u.pm); u.x1 = u.pm - rb0[u.x0]; return true; }
            DI const char* a_base(const p8::Unit&) const { return hb; }
            DI const char* b_base(const p8::Unit& u) const { return wgu + (size_t)(u.x0 & 31) * (1024 * 1024 * 2) + (size_t)u.pn * (256 * 1024 * 2); }
            DI void a_offs(int ui, const p8::Unit&, const int (&R)[2], const int (&C)[2], unsigned (&off)[2][2]) const {
#pragma unroll
                for (int h = 0; h < 2; ++h)
#pragma unroll
                    for (int i = 0; i < 2; ++i) off[h][i] = (unsigned)ltokt[ui * 256 + h * 128 + R[i]] * 2048u + (unsigned)C[i] * 2u;
            }
        };
        UpSched S{(const char*)hb, (const char*)wgu, rb0, (const LAS int*)ltokt, limit, nrb};
        p8::gemm_phase<true, true>(lds, 1024, S, [&](const p8::f32x4 (&acc)[2][2][4][2], const p8::Unit& un, int wr, int wc, int fr, int fq) __attribute__((always_inline)) {
            bfr* o = hid + ((size_t)hoff[un.x0] + un.x1 * 256 + wr * 64 + fr) * 512 + ((un.pn * 256 + wc * 32 + 8 * fq) >> 1);
#pragma unroll
            for (int ai = 0; ai < 2; ++ai)
#pragma unroll
                for (int m = 0; m < 4; ++m)
#pragma unroll
                    for (int bj = 0; bj < 2; ++bj) {
                        const p8::f32x4 g = acc[ai][bj][m][0], up = acc[ai][bj][m][1];
                        float h4[4];
#pragma unroll
                        for (int j = 0; j < 4; ++j) h4[j] = g[j] * sigmoidf_(g[j]) * up[j];
                        *(uint2*)(o + (size_t)(ai * 128 + m * 16) * 512 + bj * 64) = make_uint2(pk2(h4[0], h4[1]), pk2(h4[2], h4[3]));
                    }
        });
        __syncthreads();
    }
    if (halves && (int)blockIdx.x < 2 * rem) {
        const int t = full + ((int)blockIdx.x >> 1);
        const int hc = ((int)blockIdx.x & 1) * 128;
        int rbi, nt; tile_remap(t, rb0[64], 4, rbi, nt);
        const int seg = moe_find_seg(rb0, rbi);
        const int rb = rbi - rb0[seg], e = seg & 31, c = cnt[seg];
        const bfr* ap[4];
        const int tq = ltid();
#pragma unroll
        for (int i = 0; i < 4; ++i) {
            int p = rb * 256 + (tq >> 3) + 64 * i; p = p < c ? p : c - 1;
            ap[i] = hb + (size_t)stok[(size_t)seg * NTOK + p] * 1024 + gt_lcol(tq);
        }
        auto aptr = [&](int i, int kt) __attribute__((always_inline)) -> const bfr* { return ap[i] + kt * 64; };
        const size_t hrow0 = (size_t)hoff[seg] + rb * 256;
        RowLoader B(wgu + (size_t)e * 1024 * 1024, nt * 256 + hc, 1024);
        GEMM128(lds, 16, aptr, B, [&](const float* stg, int) __attribute__((always_inline)) {
            epi_rows8(stg, [&](int r, int c0, const float (&v)[8]) __attribute__((always_inline)) {
                float o[4];
#pragma unroll
                for (int j = 0; j < 4; ++j) o[j] = v[j] * sigmoidf_(v[j]) * v[4 + j];
                *(uint2*)(hid + (hrow0 + r) * 512 + ((nt * 256 + hc + c0) >> 1)) = make_uint2(pk2(o[0], o[1]), pk2(o[2], o[3]));
            });
        });
    }
}

struct F12 { float4 a, b; uint4 y; };
DI void phase_moe_down(char* lds, const Ctx& P, int layer, int k, float* x) {
    const G4 G = g4_make(lds);
    int* cnt = (int*)(G.lds + G4_AUX); int* rb0 = cnt + 64; int* hoff = rb0 + 65;
    {
        const int* gcnt = (const int*)(P.ws + OFF_CNT) + layer * 64;
        if (G.tid < 64) cnt[G.tid] = gcnt[G.tid];
        g4_bar(G);
        if (G.tid == 0) {
            int acc = 0, hacc = 0;
            for (int s = 0; s < 64; ++s) { rb0[s] = acc; hoff[s] = hacc; acc += (cnt[s] + 127) >> 7; hacc += ((cnt[s] + 255) >> 8) * 256; }
            rb0[64] = acc;
        }
        g4_bar(G);
    }
    const bfr* hid = (const bfr*)(P.ws + OFF_HID);
    const bfr* wd = (const bfr*)(P.ws + OFF_MWD);
    const int* stok = (const int*)(P.ws + OFF_TOK);
    const float* sgate = (const float*)(P.ws + OFF_GATE);
    const int* tslot = (const int*)(P.ws + OFF_TSLOT);
    bfr* y0 = (bfr*)(P.ws + OFF_Y0);
    const int rbA = rb0[k * 32], rbB = rb0[k * 32 + 32];
    const int ntiles = (rbB - rbA) * 8;
    for (int t = G.vb; t < ntiles; t += G.nvb) {
        int rbi, nt; tile_remap(t, rbB - rbA, 8, rbi, nt); rbi += rbA;
        const int seg = moe_find_seg(rb0, rbi);
        const int rb = rbi - rb0[seg], e = seg & 31, c = cnt[seg];
        const int hrow0 = hoff[seg] + rb * 128;
        G4RowLoader A(G, hid, hrow0, 512), B(G, wd + (size_t)e * 1024 * 512, nt * 128, 512);
        int* ltok = (int*)(G.lds + G4_AUX + 1024); float* lgate = (float*)(G.lds + G4_AUX + 1536); int* lrow = (int*)(G.lds + G4_AUX + 2048);
        if (G.tid < 128) {
            const int p = rb * 128 + G.tid;
            const int tok = p < c ? stok[(size_t)seg * NTOK + p] : -1;
            ltok[G.tid] = tok;
            lgate[G.tid] = p < c ? sgate[(size_t)seg * NTOK + p] : 0.f;
            int r0 = 0;
            if (k == 1 && tok >= 0) { const int ts = tslot[tok]; r0 = hoff[ts >> 15] + (ts & 32767); }
            lrow[G.tid] = r0;
        }
        if (k == 0) {
            g4_gemm_tile(G, G.lds, 8, A, B, [&](const float* stg) __attribute__((always_inline)) {
                g4_epi_rows8(G, stg, [&](int r, int c0, const float (&v)[8]) __attribute__((always_inline)) {
                    if (ltok[r] >= 0) {
                        const float gt = lgate[r];
                        float o[8];
#pragma unroll
                        for (int j = 0; j < 8; ++j) o[j] = gt * v[j];
                        *(uint4*)(y0 + (size_t)(hrow0 + r) * 1024 + nt * 128 + c0) = pack8(o);
                    }
                });
            });
        } else {
            g4_gemm_tile(G, G.lds, 8, A, B, [&](const float* stg) __attribute__((always_inline)) {
                g4_epi_rows8_pre<F12>(G, stg,
                    [&](int r, int c0) __attribute__((always_inline)) -> F12 {
                        int tok = ltok[r]; tok = tok < 0 ? 0 : tok;
                        const float* d = x + (size_t)tok * DM + nt * 128 + c0;
                        F12 o; o.a = *(const float4*)d; o.b = *(const float4*)(d + 4);
                        o.y = *(const uint4*)(y0 + (size_t)lrow[r] * 1024 + nt * 128 + c0);
                        return o; },
                    [&](int r, int c0, const float (&v)[8], const F12& o) __attribute__((always_inline)) {
                        const int tok = ltok[r];
                        if (tok >= 0) {
                            const float gt = lgate[r];
                            float yv[8];
                            unpack8(o.y, yv);
                            float* d = x + (size_t)tok * DM + nt * 128 + c0;
                            *(float4*)d = make_float4(o.a.x + gt * v[0] + yv[0], o.a.y + gt * v[1] + yv[1], o.a.z + gt * v[2] + yv[2], o.a.w + gt * v[3] + yv[3]);
                            *(float4*)(d + 4) = make_float4(o.b.x + gt * v[4] + yv[4], o.b.y + gt * v[5] + yv[5], o.b.z + gt * v[6] + yv[6], o.b.w + gt * v[7] + yv[7]);
                        }
                    });
            });
        }
    }
}
constexpr int PH_PER_LAYER = 11;
constexpr int N_PHASES = 1 + 4 * PH_PER_LAYER;

DI void phase_prologue(char* lds, const Ctx& P) {
    for (int u = blockIdx.x; u < 64; u += gridDim.x) s5_tables(lds, P, u >> 5, u & 31);
    const bool excl = gridDim.x >= 128;
    if (excl && blockIdx.x < 64) return;
    unsigned base = 0;
    const int wk = excl ? (int)blockIdx.x - 64 : (int)blockIdx.x, nw = excl ? (int)gridDim.x - 64 : (int)gridDim.x;
    for (int i = 0; i < 2; ++i) {
        cvt_matrix(lds, P.in[I_EWIN] + (size_t)i * 1024 * 2304, 1024, 2304, (bfr*)(P.ws + OFF_WINE) + (size_t)i * 2304 * 1024, 1024, 0, wk, nw, base);
        cvt_matrix(lds, P.in[I_EWOUT] + (size_t)i * 1024 * 1024, 1024, 1024, (bfr*)(P.ws + OFF_WOUTE) + (size_t)i * 1024 * 1024, 1024, 0, wk, nw, base);
        cvt_matrix(lds, P.in[I_OWIN] + (size_t)i * 1024 * 2048, 1024, 2048, (bfr*)(P.ws + OFF_WINO) + (size_t)i * 2048 * 1024, 1024, 0, wk, nw, base);
        cvt_matrix(lds, P.in[I_OWOUT] + (size_t)i * 1024 * 1024, 1024, 1024, (bfr*)(P.ws + OFF_WOUTO) + (size_t)i * 1024 * 1024, 1024, 0, wk, nw, base);
        cvt_matrix(lds, P.in[I_W2] + (size_t)i * 64 * 512, 64, 512, (bfr*)(P.ws + OFF_W2T) + (size_t)i * 512 * 64, 64, 0, wk, nw, base);
        cvt_matrix(lds, P.in[I_A2] + (size_t)i * 64 * 512, 64, 512, (bfr*)(P.ws + OFF_A2T) + (size_t)i * 512 * 64, 64, 0, wk, nw, base);
        cvt_matrix(lds, P.in[I_G2] + (size_t)i * 128 * 512, 128, 512, (bfr*)(P.ws + OFF_G2T) + (size_t)i * 512 * 128, 128, 0, wk, nw, base);
        for (int g = 0; g < 4; ++g)
            cvt_matrix(lds, P.in[I_POOLW] + (size_t)(i * 4 + g) * 128 * 128, 128, 128, (bfr*)(P.ws + OFF_POOLT) + (size_t)(i * 4 + g) * 128 * 128, 128, 0, wk, nw, base);
        cvt_matrix(lds, P.in[I_WGLU] + (size_t)i * 512 * 512, 512, 512, (bfr*)(P.ws + OFF_GLUT) + (size_t)i * 512 * 512, 512, 0, wk, nw, base);
    }
    const int gtid = wk * NTHREADS + ltid(), gsz = nw * NTHREADS;
    {
        bfr* rhi = (bfr*)(P.ws + OFF_RHI); bfr* rlo = (bfr*)(P.ws + OFF_RLO);
        for (int idx = gtid; idx < 4 * 128 * 1024; idx += gsz) {
            const int k = idx & 1023, n = (idx >> 10) & 127, l = idx >> 17;
            float w = 0.f;
            if (n < 32) w = P.in[I_MWE][((size_t)l * 1024 + k) * 32 + n];
            else if (n < 36) w = P.in[I_MWG][((size_t)l * 1024 + k) * 4 + (n - 32)];
            const bfr h = f2bf(w);
            rhi[idx] = h; rlo[idx] = f2bf(w - bf2f(h));
        }
    }
    {
        bfr* v12 = (bfr*)(P.ws + OFF_V12T);
        const float* v1 = P.in[I_V1]; const float* v2 = P.in[I_V2];
        for (int idx = gtid; idx < 512 * 512; idx += gsz) {
            const int k = idx & 511, n = idx >> 9;
            float s = 0.f;
            for (int r = 0; r < 32; ++r) s += v1[k * 32 + r] * v2[r * 512 + n];
            v12[idx] = f2bf(s);
        }
    }
    for (int tt = wk; tt < 512; tt += nw)
        norm_rows(P.in[I_X], P.in[I_NMIX], (bfr*)(P.ws + OFF_HB), nullptr, P.out, tt * 64, 64);
}

DI Ctx mkctx(unsigned char* ws, float* out) {
    size_t z = 0;
    asm volatile("" : "+s"(z));
    Ctx c;
    c.in.p = (KArgPtr)__builtin_amdgcn_kernarg_segment_ptr() + z;
    c.ws = ws + z; c.out = (float*)((char*)out + z);
    return c;
}
__global__ void __launch_bounds__(NTHREADS, 2) fwd_kernel(Params PA) {
    extern __shared__ __attribute__((aligned(16))) char lds[];
    if (threadIdx.x == 0) { *(uint4*)(lds + LDS_BYTES - 16) = make_uint4(0u, 0u, 0u, 0u); *(uint4*)(lds + LDS_BYTES - 32) = make_uint4(0u, 0u, 0u, 0u); }
    __syncthreads();
    XcdBarrier bar = xcd_barrier_post((unsigned*)(PA.ws + OFF_BAR), (volatile LAS unsigned*)(lds + LDS_BYTES - 16));
    const int lo = PA.ph_lo, hi = PA.ph_hi;
#ifndef RWKV_CHUNKED
#define RWKV_CHUNKED 1
#endif
#ifndef DUP_PH
#define DUP_PH (-1)
#endif
#define DUPX(k, call) do { call; if (DUP_PH == (k)) { __syncthreads(); call; } } while (0)
#define RUNS(id) ((id) >= lo && (id) < hi)
#define P mkctx(PA.ws, PA.out)
#define SEAM(id) do { if ((id) > lo && (id) < hi) xcd_barrier(bar); } while (0)
    if (RUNS(0)) DUPX(100, phase_prologue(lds, P));
    for (int layer = 0; layer < 4; ++layer) {
        const int base = 1 + layer * PH_PER_LAYER;
        const int li = layer >> 1;
        if ((layer & 1) == 0) {
            SEAM(base + 0); if (RUNS(base + 0)) DUPX(0, phase_e1(lds, P, li));
            SEAM(base + 1); if (RUNS(base + 1)) DUPX(1, phase_e2a(P, li));
            SEAM(base + 2); if (RUNS(base + 2)) DUPX(2, phase_e2b(lds, P, li));
#if RWKV_CHUNKED
            SEAM(base + 3); if (RUNS(base + 3)) { DUPX(43, phase_r1(lds, P, li)); if (DUP_PH >= 45 && DUP_PH <= 47) phase_r1(lds, P, li, DUP_PH - 44); xcd_barrier(bar); DUPX(44, phase_r2(P)); }
#else
            SEAM(base + 3); if (RUNS(base + 3)) { phase_e3(lds, P, li); if (DUP_PH == 3) phase_e3(lds, P, li, 3); }
#endif
            SEAM(base + 4); if (RUNS(base + 4)) DUPX(4, phase_e4(P, li));
            SEAM(base + 5); if (RUNS(base + 5)) { phase_wout(lds, P, (const bfr*)(P.ws + OFF_WOUTE) + (size_t)li * 1024 * 1024, P.out); if (DUP_PH == 5) phase_wout(lds, P, (const bfr*)(P.ws + OFF_WOUTE) + (size_t)li * 1024 * 1024, (float*)(P.ws + OFF_EV)); }
        } else {
            SEAM(base + 0); if (RUNS(base + 0)) DUPX(10, phase_o1(lds, P, li));
            SEAM(base + 1); if (RUNS(base + 1)) DUPX(11, phase_o2(lds, P, li));
            SEAM(base + 2); if (RUNS(base + 2)) DUPX(12, phase_o3(lds, P, li, layer));
            SEAM(base + 3); if (RUNS(base + 3)) DUPX(13, phase_o4(lds, P, li));
            SEAM(base + 4); if (RUNS(base + 4)) DUPX(14, phase_o5(lds, P, li));
            SEAM(base + 5); if (RUNS(base + 5)) { phase_wout(lds, P, (const bfr*)(P.ws + OFF_WOUTO) + (size_t)li * 1024 * 1024, P.out); if (DUP_PH == 5) phase_wout(lds, P, (const bfr*)(P.ws + OFF_WOUTO) + (size_t)li * 1024 * 1024, (float*)(P.ws + OFF_EV)); }
        }
        SEAM(base + 6);
        if (RUNS(base + 6)) {
            phase_router(lds, P, layer);
            if (gridDim.x >= 256) {
                const int b = blockIdx.x;
                const int per = 6144 / (int)gridDim.x;
                const int lo_n = per / 2, hi_n = per + per / 2;
                if (b < 128) moe_convert_range(lds, P, layer, (int)(gridDim.x - 128) * hi_n + b * lo_n, (int)(gridDim.x - 128) * hi_n + (b + 1) * lo_n);
                else { const int e1 = (b - 128 + 1) * hi_n; moe_convert_range(lds, P, layer, (b - 128) * hi_n, e1 < 6144 ? e1 : 6144); }
            } else {
                const int per = (6144 + (int)gridDim.x - 1) / (int)gridDim.x;
                const int t0 = blockIdx.x * per, t1 = t0 + per;
                moe_convert_range(lds, P, layer, t0 < 6144 ? t0 : 6144, t1 < 6144 ? t1 : 6144);
            }
        }
        SEAM(base + 7); if (RUNS(base + 7)) DUPX(7, phase_moe_up(lds, P, layer));
        SEAM(base + 8); if (RUNS(base + 8)) DUPX(8, phase_moe_down(lds, P, layer, 0, P.out));
        SEAM(base + 9); if (RUNS(base + 9)) phase_moe_down(lds, P, layer, 1, P.out);
        SEAM(base + 10);
        if (RUNS(base + 10) && layer < 3) {
            for (int rep = 0; rep < (DUP_PH == 20 ? 2 : 1); ++rep)
            for (int tt = blockIdx.x; tt < 512; tt += gridDim.x)
                norm_rows(P.out, P.in[I_NMIX] + (size_t)(layer + 1) * DM, (bfr*)(P.ws + OFF_HB), nullptr, nullptr, tt * 64, 64);
        }
    }
#undef P
#undef RUNS
#undef SEAM
}

#ifndef N_LAUNCH_SPLIT
#define N_LAUNCH_SPLIT 0
#endif
extern "C" void kernel_launch(void* const* d_in, const int* in_sizes, int n_in, void* d_out, int out_size, void* d_ws, size_t ws_size, hipStream_t stream) {
    static int grid = 0;
    if (grid == 0) {
        if (n_in != N_INPUTS || out_size != NTOK * DM || ws_size < WS_NEEDED || ws_size < OFF_RC_END) {
            fprintf(stderr, "kernel_launch: unexpected shapes: n_in %d out %d ws %zu (need %zu)\n", n_in, out_size, ws_size, (size_t)WS_NEEDED);
            grid = -1; return;
        }
        int dev = 0, cus = 0, per_cu = 0;
        (void)hipGetDevice(&dev);
        (void)hipDeviceGetAttribute(&cus, hipDeviceAttributeMultiprocessorCount, dev);
        if (hipFuncSetAttribute((const void*)fwd_kernel, hipFuncAttributeMaxDynamicSharedMemorySize, LDS_BYTES) != hipSuccess) { fprintf(stderr, "kernel_launch: hipFuncSetAttribute failed\n"); grid = -1; return; }
        if (hipOccupancyMaxActiveBlocksPerMultiprocessor(&per_cu, (const void*)fwd_kernel, NTHREADS, LDS_BYTES) != hipSuccess) per_cu = 1;
        (void)hipGetLastError();
        if (per_cu < 1) per_cu = 1;
        if (per_cu > 1) per_cu = 1;
        if (cus <= 0) cus = 256;
        grid = cus * per_cu;
    }
    if (grid < 0) return;
    (void)hipMemsetAsync(d_ws, 0, OFF_ZERO_END, stream);
    Params p{};
    for (int i = 0; i < N_INPUTS; ++i) p.in[i] = (const float*)d_in[i];
    p.out = (float*)d_out; p.ws = (unsigned char*)d_ws;
#if N_LAUNCH_SPLIT
    for (int ph = 0; ph < N_PHASES - 1; ++ph) {
        p.ph_lo = ph; p.ph_hi = ph + 1;
        hipLaunchKernelGGL(fwd_kernel, dim3(grid), dim3(NTHREADS), LDS_BYTES, stream, p);
    }
#else
    p.ph_lo = 0; p.ph_hi = N_PHASES;
    hipLaunchKernelGGL(fwd_kernel, dim3(grid), dim3(NTHREADS), LDS_BYTES, stream, p);
#endif
}
```

```cpp
#include <hip/hip_runtime.h>
#include <stdint.h>
#include <stdio.h>

typedef unsigned short bfr;
typedef __attribute__((ext_vector_type(8))) short bf16x8;
typedef __attribute__((ext_vector_type(16))) float f32x16;
typedef __attribute__((ext_vector_type(2))) __bf16 bf16x2_t;
#define DI __device__ __forceinline__
#define MFMA32(a, b, c) __builtin_amdgcn_mfma_f32_32x32x16_bf16((a), (b), (c), 0, 0, 0)

constexpr int NTOK = 32768, DM = 1024, SEQ = 2048, NB = 16;
constexpr int EVEN_IN = 2304, ODD_IN = 2048;
constexpr int NTHREADS = 512;
constexpr int NWAVES = NTHREADS / 64;
constexpr int LDS_BYTES = 161792;

enum { I_X = 0, I_NMIX, I_NFFN, I_EWIN, I_MU, I_W0, I_W2, I_A0, I_A2, I_G2, I_KK, I_KA, I_RK, I_LNG, I_LNB, I_V0, I_V1, I_V2,
       I_POOLW, I_POOLS, I_EWOUT, I_OWIN, I_QN, I_KN, I_LQ1, I_LK1, I_LQ2, I_LK2, I_SUBLN, I_ARE, I_AIM, I_LSTEP, I_BRE, I_BIM,
       I_CRE, I_CIM, I_S5D, I_WGLU, I_OWOUT, I_MWG, I_MBG, I_MWE, I_MBE, I_MWGATE, I_MWUP, I_MWDOWN, N_INPUTS };

constexpr size_t al256(size_t x) { return (x + 255) & ~(size_t)255; }
constexpr size_t OFF_BAR   = 0;
constexpr size_t OFF_CNT   = 16384;
constexpr size_t OFF_ZERO_END = 32768;
constexpr size_t OFF_WINE  = 65536;
constexpr size_t OFF_WOUTE = OFF_WINE  + (size_t)2 * 2304 * 1024 * 2;
constexpr size_t OFF_WINO  = OFF_WOUTE + (size_t)2 * 1024 * 1024 * 2;
constexpr size_t OFF_WOUTO = OFF_WINO  + (size_t)2 * 2048 * 1024 * 2;
constexpr size_t OFF_W2T   = OFF_WOUTO + (size_t)2 * 1024 * 1024 * 2;
constexpr size_t OFF_A2T   = OFF_W2T   + (size_t)2 * 512 * 64 * 2;
constexpr size_t OFF_G2T   = OFF_A2T   + (size_t)2 * 512 * 64 * 2;
constexpr size_t OFF_V12T  = OFF_G2T   + (size_t)2 * 512 * 128 * 2;
constexpr size_t OFF_POOLT = OFF_V12T  + (size_t)512 * 512 * 2;
constexpr size_t OFF_GLUT  = OFF_POOLT + (size_t)2 * 4 * 128 * 128 * 2;
constexpr size_t OFF_RHI   = OFF_GLUT  + (size_t)2 * 512 * 512 * 2;
constexpr size_t OFF_RLO   = OFF_RHI   + (size_t)4 * 128 * 1024 * 2;
constexpr size_t OFF_S5GT  = OFF_RLO   + (size_t)4 * 128 * 1024 * 2;
constexpr size_t OFF_S5BL  = OFF_S5GT  + (size_t)2 * 32 * 512 * 640 * 2;
constexpr size_t OFF_S5L32 = OFF_S5BL  + (size_t)2 * 32 * 128 * 512 * 2;
constexpr size_t OFF_MWGU  = al256(OFF_S5L32 + (size_t)2 * 32 * 64 * 2 * 4);
constexpr size_t OFF_MWD   = OFF_MWGU  + (size_t)32 * 1024 * 1024 * 2;
constexpr size_t OFF_HB    = OFF_MWD   + (size_t)32 * 1024 * 512 * 2;
constexpr size_t OFF_U     = OFF_HB    + (size_t)NTOK * 1024 * 2;
constexpr size_t OFF_US5   = OFF_U     + (size_t)NTOK * 1024 * 2;
constexpr size_t OFF_MIX   = OFF_U;
constexpr size_t OFF_AMIX  = OFF_U     + (size_t)NTOK * 2304 * 2;
constexpr size_t OFF_VFIRST= OFF_AMIX  + (size_t)NTOK * 1024 * 2;
constexpr size_t OFF_TOK   = OFF_VFIRST+ (size_t)NTOK * 512 * 2;
constexpr size_t OFF_GATE  = OFF_TOK   + (size_t)64 * NTOK * 4;
constexpr size_t OFF_HID   = OFF_GATE  + (size_t)64 * NTOK * 4;
constexpr size_t OFF_HLO   = OFF_HID;
constexpr size_t OFF_EV    = OFF_HID   + (size_t)81920 * 512 * 2;
constexpr size_t OFF_S     = OFF_EV;
constexpr size_t OFF_MV2   = OFF_S     + (size_t)NTOK * 256 * 2;
constexpr size_t OFF_DLOG  = OFF_MV2   + (size_t)NTOK * 512 * 2;
constexpr size_t OFF_ABUF  = OFF_DLOG  + (size_t)NTOK * 512 * 4;
constexpr size_t OFF_GBUF  = OFF_ABUF  + (size_t)NTOK * 512 * 2;
constexpr size_t OFF_VGATE = OFF_GBUF  + (size_t)NTOK * 512 * 2;
constexpr size_t OFF_Y     = OFF_VGATE + (size_t)NTOK * 512 * 2;
constexpr size_t OFF_DPOOL = OFF_Y + (size_t)NTOK * 512 * 2;
constexpr size_t OFF_BONUS = OFF_Y     + (size_t)NTOK * 512 * 4;
constexpr size_t OFF_EV_END= OFF_BONUS + (size_t)NTOK * 512 * 4;
constexpr size_t OFF_Y0    = OFF_EV;
constexpr size_t OFF_TSLOT = OFF_Y0    + (size_t)81920 * 1024 * 2;
constexpr size_t OFF_TGATE = OFF_TSLOT + (size_t)2 * NTOK * 4;
static_assert(OFF_TGATE + (size_t)2 * NTOK * 4 <= OFF_EV_END, "MoE scratch must fit the mixer scratch region");
constexpr size_t OFF_QN    = OFF_EV;
constexpr size_t OFF_KN    = OFF_QN    + (size_t)NTOK * 512 * 2;
constexpr size_t OFF_VT    = OFF_KN    + (size_t)NTOK * 512 * 2;
constexpr size_t OFF_XLOC  = OFF_VT    + (size_t)NTOK * 512 * 2;
constexpr size_t OFF_XIN   = OFF_XLOC  + (size_t)32 * 1024 * 128 * 4;
constexpr size_t OFF_ZBUF  = OFF_XIN   + (size_t)32 * 1024 * 128 * 2;
constexpr size_t OFF_OD_END= OFF_ZBUF  + (size_t)NTOK * 512 * 2;
constexpr size_t WS_NEEDED = OFF_EV_END > OFF_OD_END ? OFF_EV_END : OFF_OD_END;
constexpr size_t OFF_RCG = OFF_HID;
constexpr size_t OFF_RCH = OFF_HB;
constexpr size_t OFF_RCQ = OFF_EV_END;
constexpr size_t OFF_RCZ = OFF_RCQ + (size_t)8192 * 4096;
constexpr size_t OFF_RC_END = OFF_RCZ + (size_t)8192 * 4096;
constexpr size_t OFF_ROPE = OFF_RC_END;
constexpr size_t OFF_ROPE_END = OFF_ROPE + (size_t)2048 * 32 * 8;
constexpr size_t OFF_E2B1 = OFF_ROPE_END;
constexpr size_t OFF_E2B2 = OFF_E2B1 + (size_t)2 * 1536 * 256 * 2;
constexpr size_t OFF_E2B_END = OFF_E2B2 + (size_t)2 * 2 * 256 * 256 * 2;

struct Params {
    const float* in[N_INPUTS];
    float* out;
    unsigned char* ws;
    int ph_lo, ph_hi;
};
typedef const __attribute__((address_space(4))) char* KArgPtr;
struct InTab {
    KArgPtr p;
    DI const float* operator[](int i) const {
        const float* q = *(const float* const __attribute__((address_space(4)))*)(p + 8 * i);
        return (const float*)(const __attribute__((address_space(1))) float*)q;
    }
};
struct Ctx { InTab in; unsigned char* ws; float* out; };

DI unsigned pk2(float a, float b) { bf16x2_t v; v[0] = (__bf16)a; v[1] = (__bf16)b; return __builtin_bit_cast(unsigned, v); }
DI bfr f2bf(float a) { return (bfr)(pk2(a, 0.f) & 0xffffu); }
DI float bf2f(bfr b) { return __uint_as_float(((unsigned)b) << 16); }
DI float bflo(unsigned u) { return __uint_as_float(u << 16); }
DI float bfhi(unsigned u) { return __uint_as_float(u & 0xffff0000u); }
DI uint4 pack8(const float (&v)[8]) { return make_uint4(pk2(v[0], v[1]), pk2(v[2], v[3]), pk2(v[4], v[5]), pk2(v[6], v[7])); }
DI void unpack8(uint4 u, float (&v)[8]) { v[0] = bflo(u.x); v[1] = bfhi(u.x); v[2] = bflo(u.y); v[3] = bfhi(u.y); v[4] = bflo(u.z); v[5] = bfhi(u.z); v[6] = bflo(u.w); v[7] = bfhi(u.w); }
DI float frcp(float x) { return __builtin_amdgcn_rcpf(x); }
DI float fexp(float x) { return __builtin_amdgcn_exp2f(x * 1.4426950408889634f); }
DI float sigmoidf_(float x) { return frcp(1.0f + fexp(-x)); }
DI float ftanh(float x) { return 2.0f * frcp(1.0f + fexp(-2.0f * x)) - 1.0f; }
DI float fsoftplus(float z) { return z > 20.0f ? z : __logf(1.0f + fexp(z)); }
template <int CTRL> DI float dpp_f(float x) { return __builtin_bit_cast(float, __builtin_amdgcn_update_dpp(0, __builtin_bit_cast(int, x), CTRL, 0xf, 0xf, false)); }
DI float row16_sum(float s) {
    s += dpp_f<0x128>(s); s += dpp_f<0x124>(s); s += dpp_f<0x122>(s); s += dpp_f<0x121>(s); return s; }
DI int ltid() { int t = threadIdx.x; asm volatile("" : "+v"(t)); return t; }
DI float dot4n(float s0, float s1, float s2, float s3, const float4& a) {
    float d;
    asm("v_mul_f32 %0, %1, %5\n\tv_fma_f32 %0, %2, %6, %0\n\tv_fma_f32 %0, %3, %7, %0\n\tv_fma_f32 %0, %4, %8, %0\n\ts_nop 1"
        : "=&v"(d) : "v"(s0), "v"(s1), "v"(s2), "v"(s3), "v"(a.x), "v"(a.y), "v"(a.z), "v"(a.w));
    return d;
}
DI void rw_upd(float& S, float w, float sa, float b, float vi, float k) {
    float t;
    asm("v_mul_f32 %1, %4, %5\n\tv_fma_f32 %1, %2, %3, %1\n\tv_fma_f32 %0, %0, %6, %1"
        : "+v"(S), "=&v"(t) : "v"(sa), "v"(b), "v"(vi), "v"(k), "v"(w));
}
DI float wave_sum(float s) { s = row16_sum(s); s += __shfl_xor(s, 16); s += __shfl_xor(s, 32); return s; }
#define XB_TMO      128
#define XB_XCNT(j)  (256  + 64 * (j))
#define XB_XSUB(j)  (1280 + 64 * (j))
#define XB_XGEN(j)  (2304 + 64 * (j))
#define XB_TOP      3328
#define XB_TOPGEN   3392
#define XCD_BAR_WORDS 3456
#define XB_SPIN_CAP (1u << 18)
#define LAS __attribute__((address_space(3)))

__device__ __forceinline__ unsigned xb_ld(unsigned* p)              { return __hip_atomic_load(p, __ATOMIC_RELAXED, __HIP_MEMORY_SCOPE_AGENT); }
__device__ __forceinline__ unsigned xb_add(unsigned* p, unsigned v) { return __hip_atomic_fetch_add(p, v, __ATOMIC_RELAXED, __HIP_MEMORY_SCOPE_AGENT); }
__device__ __forceinline__ unsigned xb_xcc_id() { return (unsigned)__builtin_amdgcn_s_getreg((3 << 11) | 20) & 0xFu; }
#define XB_SPIN(cond, bar) do { unsigned _sp = 0; while (cond) { __builtin_amdgcn_s_sleep(1); \
    if ((++_sp & 255u) == 0u) { if (xb_ld(&(bar)[XB_TMO])) break; if (_sp > XB_SPIN_CAP) { atomicAdd(&(bar)[XB_TMO], 1u); break; } } } } while (0)

struct XcdBarrier {
    unsigned* bar; unsigned x;
    volatile LAS unsigned* st;
};
__device__ __forceinline__ XcdBarrier xcd_barrier_post(unsigned* bar, volatile LAS unsigned* st) {
    XcdBarrier b; b.bar = bar; b.x = xb_xcc_id(); b.st = st;
    if (threadIdx.x == 0) (void)xb_add(&bar[XB_XCNT(b.x)], 1u);
    return b;
}
__device__ __forceinline__ void xcd_barrier_complete(unsigned* bar, unsigned x, unsigned& nloc, unsigned& nx) {
    const unsigned G = gridDim.x * gridDim.y * gridDim.z;
    unsigned sum, cnt, mine, sp = 0u;
    for (;;) {
        sum = 0u; cnt = 0u; mine = 0u;
#pragma unroll
        for (unsigned j = 0; j < 16; ++j) { const unsigned c = xb_ld(&bar[XB_XCNT(j)]); sum += c; cnt += (c > 0u) ? 1u : 0u; mine = (j == x) ? c : mine; }
        if (sum == G) break;
        __builtin_amdgcn_s_sleep(1);
        if ((++sp & 255u) == 0u) { if (xb_ld(&bar[XB_TMO])) break; if (sp > XB_SPIN_CAP) { atomicAdd(&bar[XB_TMO], 1u); break; } }
    }
    nloc = mine > 0u ? mine : 1u; nx = cnt > 0u ? cnt : 1u;
}
__device__ __forceinline__ void xcd_barrier(const XcdBarrier& b) {
    asm volatile("s_waitcnt vmcnt(0)" ::: "memory");
    __syncthreads();
    if (threadIdx.x == 0) {
        unsigned* bar = b.bar;
        __builtin_amdgcn_s_waitcnt(0);
        unsigned nloc = b.st[0], nx = b.st[1];
        if (nloc == 0u) { xcd_barrier_complete(bar, b.x, nloc, nx); b.st[0] = nloc; b.st[1] = nx; }
        const unsigned old = xb_add(&bar[XB_XSUB(b.x)], 1u);
        const unsigned gen = old / nloc;
        if (old + 1u == (gen + 1u) * nloc) {
            __builtin_amdgcn_fence(__ATOMIC_RELEASE, "agent");
            asm volatile("s_waitcnt vmcnt(0)" ::: "memory");
            const unsigned og = xb_add(&bar[XB_TOP], 1u);
            const unsigned tg = og / nx;
            if (og + 1u == (tg + 1u) * nx) xb_add(&bar[XB_TOPGEN], 1u);
            else XB_SPIN(xb_ld(&bar[XB_TOPGEN]) == tg, bar);
            __builtin_amdgcn_fence(__ATOMIC_ACQUIRE, "agent");
            xb_add(&bar[XB_XGEN(b.x)], 1u);
            asm volatile("s_waitcnt vmcnt(0)" ::: "memory");
        } else {
            XB_SPIN(xb_ld(&bar[XB_XGEN(b.x)]) == gen, bar);
            __builtin_amdgcn_fence(__ATOMIC_ACQUIRE, "agent");
            asm volatile("s_waitcnt vmcnt(0)" ::: "memory");
        }
    }
    __syncthreads();
}

constexpr int LDA = 72;
constexpr int TILE_B = 128 * LDA * 2;
constexpr int STG_LD = 132;
constexpr int LDS_AUX = 139264;
typedef const __attribute__((address_space(1))) unsigned* GPtrU;
typedef __attribute__((address_space(3))) unsigned* LPtrU;
DI int gt_lcol(int t) { return (((t & 7) ^ ((t >> 4) & 7)) * 8); }

template <int WR, int WC, int MI, int NI, int ROWS = 256, class AF, class BF, class EF>
DI void gemm8(char* lds, int nk, AF aptr, BF bptr, EF epi) {
    static_assert(WR * WC == NWAVES && WR * MI * 32 == ROWS, "wave grid");
    constexpr int NT = WC * NI * 32, A_BYTES = ROWS * 128, STAGE = A_BYTES + NT * 128, NB = NT / 64, NP = NT / 128;
    const int tid = ltid(), lane = tid & 63, wave = tid >> 6;
    const int wr = wave / WC, wc = wave % WC;
    f32x16 acc[MI][NI];
#pragma unroll
    for (int a = 0; a < MI; ++a)
#pragma unroll
        for (int b = 0; b < NI; ++b)
#pragma unroll
            for (int r = 0; r < 16; ++r) acc[a][b][r] = 0.f;
#define G8_DMA(kt_, base_) do { char* db_ = (base_) + tid * 16; \
        _Pragma("unroll") for (int i_ = 0; i_ < ROWS / 64; ++i_) __builtin_amdgcn_global_load_lds((GPtrU)aptr(i_, kt_), (LPtrU)(db_ + i_ * 8192), 16, 0, 0); \
        _Pragma("unroll") for (int i_ = 0; i_ < NB; ++i_) __builtin_amdgcn_global_load_lds((GPtrU)bptr(i_, kt_), (LPtrU)(db_ + A_BYTES + i_ * 8192), 16, 0, 0); } while (0)
#define G8_KS(cb_, ao_, bo_) do { bf16x8 af_[MI], bf_[NI]; \
        _Pragma("unroll") for (int m_ = 0; m_ < MI; ++m_) af_[m_] = *(const bf16x8*)((cb_) + (ao_) + m_ * 4096); \
        _Pragma("unroll") for (int n_ = 0; n_ < NI; ++n_) bf_[n_] = *(const bf16x8*)((cb_) + (bo_) + n_ * 4096); \
        _Pragma("unroll") for (int m_ = 0; m_ < MI; ++m_) _Pragma("unroll") for (int n_ = 0; n_ < NI; ++n_) acc[m_][n_] = MFMA32(af_[m_], bf_[n_], acc[m_][n_]); } while (0)
    const int ln = lane & 31, hf = lane >> 5, sw = (ln >> 1) & 7;
    const int arow = (wr * MI * 32 + ln) * 128, brow = A_BYTES + (wc * NI * 32 + ln) * 128;
    int ao0 = arow + ((0 + hf) ^ sw) * 16, ao1 = arow + ((2 + hf) ^ sw) * 16, ao2 = arow + ((4 + hf) ^ sw) * 16, ao3 = arow + ((6 + hf) ^ sw) * 16;
    int bo0 = brow + ((0 + hf) ^ sw) * 16, bo1 = brow + ((2 + hf) ^ sw) * 16, bo2 = brow + ((4 + hf) ^ sw) * 16, bo3 = brow + ((6 + hf) ^ sw) * 16;
    asm volatile("" : "+v"(ao0), "+v"(ao1), "+v"(ao2), "+v"(ao3), "+v"(bo0), "+v"(bo1), "+v"(bo2), "+v"(bo3));
    G8_DMA(0, lds);
    asm volatile("s_waitcnt vmcnt(0)" ::: "memory");
    __syncthreads();
    int buf = 0;
#pragma unroll 1
    for (int kt = 0; kt < nk - 1; ++kt) {
        G8_DMA(kt + 1, lds + (buf ^ 1) * STAGE);
        const char* cb = lds + buf * STAGE;
        G8_KS(cb, ao0, bo0); G8_KS(cb, ao1, bo1); G8_KS(cb, ao2, bo2); G8_KS(cb, ao3, bo3);
        asm volatile("s_waitcnt vmcnt(0)" ::: "memory");
        __syncthreads();
        buf ^= 1;
    }
    {
        const char* cb = lds + buf * STAGE;
        G8_KS(cb, ao0, bo0); G8_KS(cb, ao1, bo1); G8_KS(cb, ao2, bo2); G8_KS(cb, ao3, bo3);
    }
    __syncthreads();
#undef G8_DMA
#undef G8_KS
    float* stg = (float*)lds;
    int w_off = (wr * MI * 32 + 4 * (lane >> 5)) * STG_LD + ((wc * NI * 32) & 127) + (lane & 31);
    asm volatile("" : "+v"(w_off));
#pragma unroll
    for (int p = 0; p < NP; ++p) {
        if (((wc * NI * 32) >> 7) == p) {
#pragma unroll
            for (int m = 0; m < MI; ++m)
#pragma unroll
                for (int n = 0; n < NI; ++n)
#pragma unroll
                    for (int r = 0; r < 16; ++r)
                        stg[w_off + (m * 32 + (r & 3) + 8 * (r >> 2)) * STG_LD + n * 32] = acc[m][n][r];
        }
        __syncthreads();
        epi((const float*)stg, p);
        __syncthreads();
    }
}
template <class AF, class BF, class EF>
DI void gemm8_ring128(char* lds, int nk, AF aptr, BF bptr, EF epi) {
    constexpr int WC = 2, NI = 2, A_BYTES = 128 * 128, STAGE = 2 * A_BYTES, NSTG = 4;
    const int tid = ltid(), lane = tid & 63, wave = tid >> 6;
    const int wr = wave / WC, wc = wave % WC;
    f32x16 acc[NI];
#pragma unroll
    for (int b = 0; b < NI; ++b)
#pragma unroll
        for (int r = 0; r < 16; ++r) acc[b][r] = 0.f;
#define G8R_DMA(kt_, base_) do { char* db_ = (base_) + tid * 16; \
        _Pragma("unroll") for (int i_ = 0; i_ < 2; ++i_) __builtin_amdgcn_global_load_lds((GPtrU)aptr(i_, kt_), (LPtrU)(db_ + i_ * 8192), 16, 0, 0); \
        _Pragma("unroll") for (int i_ = 0; i_ < 2; ++i_) __builtin_amdgcn_global_load_lds((GPtrU)bptr(i_, kt_), (LPtrU)(db_ + A_BYTES + i_ * 8192), 16, 0, 0); } while (0)
#define G8R_KS(cb_, ao_, bo_) do { const bf16x8 af_ = *(const bf16x8*)((cb_) + (ao_)); bf16x8 bf_[NI]; \
        _Pragma("unroll") for (int n_ = 0; n_ < NI; ++n_) bf_[n_] = *(const bf16x8*)((cb_) + (bo_) + n_ * 4096); \
        _Pragma("unroll") for (int n_ = 0; n_ < NI; ++n_) acc[n_] = MFMA32(af_, bf_[n_], acc[n_]); } while (0)
    const int ln = lane & 31, hf = lane >> 5, sw = (ln >> 1) & 7;
    const int arow = (wr * 32 + ln) * 128, brow = A_BYTES + (wc * NI * 32 + ln) * 128;
    int ao0 = arow + ((0 + hf) ^ sw) * 16, ao1 = arow + ((2 + hf) ^ sw) * 16, ao2 = arow + ((4 + hf) ^ sw) * 16, ao3 = arow + ((6 + hf) ^ sw) * 16;
    int bo0 = brow + ((0 + hf) ^ sw) * 16, bo1 = brow + ((2 + hf) ^ sw) * 16, bo2 = brow + ((4 + hf) ^ sw) * 16, bo3 = brow + ((6 + hf) ^ sw) * 16;
    asm volatile("" : "+v"(ao0), "+v"(ao1), "+v"(ao2), "+v"(ao3), "+v"(bo0), "+v"(bo1), "+v"(bo2), "+v"(bo3));
    asm volatile("s_waitcnt vmcnt(0)" ::: "memory");
    G8R_DMA(0, lds);
    if (nk > 1) G8R_DMA(1, lds + STAGE);
    if (nk > 2) G8R_DMA(2, lds + 2 * STAGE);
#pragma unroll 1
    for (int kt = 0; kt < nk; ++kt) {
        if (kt + 2 < nk) asm volatile("s_waitcnt vmcnt(8)" ::: "memory");
        else if (kt + 1 < nk) asm volatile("s_waitcnt vmcnt(4)" ::: "memory");
        else asm volatile("s_waitcnt vmcnt(0)" ::: "memory");
        __builtin_amdgcn_s_barrier();
        asm volatile("" ::: "memory");
        if (kt + 3 < nk) G8R_DMA(kt + 3, lds + ((kt + 3) & (NSTG - 1)) * STAGE);
        const char* cb = lds + (kt & (NSTG - 1)) * STAGE;
        G8R_KS(cb, ao0, bo0); G8R_KS(cb, ao1, bo1); G8R_KS(cb, ao2, bo2); G8R_KS(cb, ao3, bo3);
    }
    __syncthreads();
#undef G8R_DMA
#undef G8R_KS
    float* stg = (float*)lds;
    int w_off = (wr * 32 + 4 * (lane >> 5)) * STG_LD + wc * NI * 32 + (lane & 31);
    asm volatile("" : "+v"(w_off));
#pragma unroll
    for (int n = 0; n < NI; ++n)
#pragma unroll
        for (int r = 0; r < 16; ++r)
            stg[w_off + ((r & 3) + 8 * (r >> 2)) * STG_LD + n * 32] = acc[n][r];
    __syncthreads();
    epi((const float*)stg, 0);
    __syncthreads();
}
template <class F> DI void epi_rows8(const float* stg, F f) {
    const int tid0 = ltid();
#pragma unroll
    for (int it = 0; it < 8; ++it) {
        const int idx = it * NTHREADS + tid0;
        const int r = idx >> 4, c0 = (idx & 15) * 8;
        const float4 p = *(const float4*)(stg + r * STG_LD + c0);
        const float4 q = *(const float4*)(stg + r * STG_LD + c0 + 4);
        const float v[8] = {p.x, p.y, p.z, p.w, q.x, q.y, q.z, q.w};
        f(r, c0, v);
    }
}
template <class T, class L, class F> DI void epi_rows8_pre(const float* stg, L loadf, F f) {
    const int tid0 = ltid();
    constexpr int BATCH = sizeof(T) > 16 ? 2 : 4;
#pragma unroll
    for (int h = 0; h < 8 / BATCH; ++h) {
        T pre[BATCH];
#pragma unroll
        for (int it = 0; it < BATCH; ++it) { const int idx = (h * BATCH + it) * NTHREADS + tid0; pre[it] = loadf(idx >> 4, (idx & 15) * 8); }
#pragma unroll
        for (int it = 0; it < BATCH; ++it) {
            const int idx = (h * BATCH + it) * NTHREADS + tid0;
            const int r = idx >> 4, c0 = (idx & 15) * 8;
            const float4 p = *(const float4*)(stg + r * STG_LD + c0);
            const float4 q = *(const float4*)(stg + r * STG_LD + c0 + 4);
            const float v[8] = {p.x, p.y, p.z, p.w, q.x, q.y, q.z, q.w};
            f(r, c0, v, pre[it]);
        }
    }
}
struct F8 { float4 a, b; };
DI void tile_remap(int L, int nM, int nN, int& pm, int& pn) {
    const int ntiles = nM * nN;
    int w = L;
    if ((ntiles & 7) == 0) w = (L & 7) * (ntiles >> 3) + (L >> 3);
    constexpr int WGM = 4;
    const int nig = WGM * nN, gid = w / nig, fm = gid * WGM, rem = w - gid * nig;
    const int gsz = (nM - fm) < WGM ? (nM - fm) : WGM;
    pm = fm + rem % gsz; pn = rem / gsz;
}
struct RowLoader {
    const bfr* p; size_t ld;
    DI RowLoader(const bfr* base, int row0, size_t ld_) : ld(ld_) { const int t = ltid(); p = base + (size_t)(row0 + (t >> 3)) * ld_ + gt_lcol(t); }
    DI const bfr* operator()(int i, int kt) const { return p + (size_t)(64 * i) * ld + kt * 64; }
};
#define GEMM256 gemm8<2, 4, 4, 2>
#define GEMM128 gemm8<4, 2, 2, 2>
namespace p8 {
typedef float f32x4 __attribute__((ext_vector_type(4)));
constexpr int HTB = 128 * 64 * 2;
DI int lds_byte(int r, int c) { const int st = (r >> 4) * 2 + (c >> 5), rr = r & 15, cc = c & 31, ob = rr * 64 + cc * 2; return st * 1024 + (ob ^ (((ob >> 9) & 1) << 5)); }
DI void stage_rc(int b, int& R, int& C) { const int st = b / 1024, sb = b % 1024, swz = sb ^ (((sb >> 9) & 1) << 5); R = (st >> 1) * 16 + swz / 64; C = (st & 1) * 32 + (swz % 64) / 2; }
DI int perm32(int rho) { const int n = rho >> 4, i = rho & 15; return 8 * (i >> 2) + 4 * n + (i & 3); }
struct Unit { int pm, pn, x0, x1; };

template <bool PERM, bool GATHER, class Sched, class Epi>
DI void gemm_phase(char* lds_g, const int K, const Sched& S, const Epi& E, const int lda_ = 0, const int ldb_ = 0) {
    LAS unsigned char* lds = (LAS unsigned char*)lds_g;
    const int tid = ltid(), wid = __builtin_amdgcn_readfirstlane(tid >> 6), lane = tid & 63, wr = wid >> 2, wc = wid & 3, fr = lane & 15, fq = lane >> 4;
    const int nt = K / 64;
    unsigned voffA[2][2], voffB[2], nvA[2][2];
    int sR[2], sC[2];
    const int lda = lda_ ? lda_ : K, ldb = ldb_ ? ldb_ : K;
    const unsigned hstep = (unsigned)(128 * ldb * 2);
#pragma unroll
    for (int i = 0; i < 2; ++i) { int R, C; stage_rc(tid * 16 + i * 8192, R, C); const int Rb = PERM ? ((R & ~31) + perm32(R & 31)) : R; sR[i] = R; sC[i] = C;
        voffA[0][i] = (unsigned)(R * lda + C) * 2u; voffA[1][i] = voffA[0][i] + (unsigned)(128 * lda * 2); voffB[i] = (unsigned)(Rb * ldb + C) * 2u; }
    const size_t kstep = 128;
    const unsigned ldsw = (unsigned)wid * 1024u;
    const int aoff = lds_byte(wr * 64 + fr, fq * 8), boff = lds_byte(wc * 32 + fr, fq * 8);
#define PG8_SA(b, h) (((b) * 2 + (h)) * p8::HTB)
#define PG8_SB(b, h) ((4 + (b) * 2 + (h)) * p8::HTB)
#define PG8_STAGE(bufoff, gbase, voff) do { _Pragma("unroll") for (int _i = 0; _i < 2; ++_i) \
        __builtin_amdgcn_global_load_lds((GPtrU)((const char*)(gbase) + (voff)[_i]), (LPtrU)(lds + (bufoff) + ldsw + _i * 8192), 16, 0, 0); } while (0)
#define PG8_STAGE_A(bufoff, gbase, h) PG8_STAGE(bufoff, gbase, voffA[h])
#define PG8_STAGE_B(bufoff, gbase, h) PG8_STAGE(bufoff, (gbase) + (h) * (size_t)hstep, voffB)
#define PG8_LDA(dst, b, h) do { _Pragma("unroll") for (int m = 0; m < 4; ++m) _Pragma("unroll") for (int k = 0; k < 2; ++k) dst[m][k] = *(const LAS bf16x8*)(lds + PG8_SA(b, h) + aoff + m * 2048 + k * 1024); } while (0)
#define PG8_LDB(dst, b, h) do { _Pragma("unroll") for (int n = 0; n < 2; ++n) _Pragma("unroll") for (int k = 0; k < 2; ++k) dst[n][k] = *(const LAS bf16x8*)(lds + PG8_SB(b, h) + boff + n * 2048 + k * 1024); } while (0)
#define PG8_MMA(ai, bj, At, Bt) do { __builtin_amdgcn_s_setprio(1); _Pragma("unroll") for (int m = 0; m < 4; ++m) _Pragma("unroll") for (int n = 0; n < 2; ++n) _Pragma("unroll") for (int k = 0; k < 2; ++k) \
        acc[ai][bj][m][n] = __builtin_amdgcn_mfma_f32_16x16x32_bf16(Bt[n][k], At[m][k], acc[ai][bj][m][n], 0, 0, 0); __builtin_amdgcn_s_setprio(0); } while (0)
#define PG8_WAIT_V(n) asm volatile("s_waitcnt vmcnt(" #n ")" ::: "memory")
#define PG8_WAIT_L(n) asm volatile("s_waitcnt lgkmcnt(" #n ")" ::: "memory")
#define PG8_BAR __builtin_amdgcn_s_barrier()
#define PG8_SCHED __builtin_amdgcn_sched_barrier(0)
    Unit cur, nxt; int ui = 0;
    if (!S.next(0, cur)) return;
#ifndef P8_STAGGER
#define P8_STAGGER 0
#endif
    if (P8_STAGGER > 0) {
        const unsigned long long t0_ = wall_clock64(), d_ = (unsigned long long)(((unsigned)blockIdx.x >> 3) & 7u) * P8_STAGGER;
        while (wall_clock64() - t0_ < d_) __builtin_amdgcn_s_sleep(8);
    }
    f32x4 acc[2][2][4][2];
#pragma unroll
    for (int a = 0; a < 2; ++a)
#pragma unroll
        for (int b = 0; b < 2; ++b)
#pragma unroll
            for (int m = 0; m < 4; ++m)
#pragma unroll
                for (int n = 0; n < 2; ++n) acc[a][b][m][n] = (f32x4){0.f, 0.f, 0.f, 0.f};
    bf16x8 At[4][2], B0[2][2], B1[2][2];
    const char* cA = S.a_base(cur); const char* cB = S.b_base(cur);
    if (GATHER) S.a_offs(0, cur, sR, sC, voffA);
    PG8_STAGE_B(PG8_SB(0, 0), cB, 0); PG8_STAGE_B(PG8_SB(0, 1), cB, 1); PG8_STAGE_A(PG8_SA(0, 0), cA, 0); PG8_STAGE_A(PG8_SA(0, 1), cA, 1);
    if (wr == 1) PG8_BAR;
    PG8_WAIT_V(2); PG8_BAR;
    PG8_STAGE_B(PG8_SB(1, 0), cB + kstep, 0); PG8_STAGE_A(PG8_SA(1, 0), cA + kstep, 0); PG8_STAGE_B(PG8_SB(1, 1), cB + kstep, 1);
    PG8_WAIT_V(6); PG8_BAR;
    for (;;) {
        const bool has_next = S.next(ui + 1, nxt);
        const char* nA = has_next ? S.a_base(nxt) : cA; const char* nB = has_next ? S.b_base(nxt) : cB;
        if (GATHER) {
            if (has_next) S.a_offs(ui + 1, nxt, sR, sC, nvA);
            else { nvA[0][0] = voffA[0][0]; nvA[0][1] = voffA[0][1]; nvA[1][0] = voffA[1][0]; nvA[1][1] = voffA[1][1]; }
        }
#pragma unroll 1
        for (int t = 0; t < nt; t += 2) {
            const bool last = (t == nt - 2);
            const char* a1 = cA + (size_t)(t + 1) * kstep;
            const char* a2 = last ? nA : cA + (size_t)(t + 2) * kstep; const char* b2 = last ? nB : cB + (size_t)(t + 2) * kstep;
            const char* a3 = a2 + kstep; const char* b3 = b2 + kstep;
            PG8_LDB(B0, 0, 0); PG8_LDB(B1, 0, 1); PG8_SCHED; PG8_LDA(At, 0, 0); PG8_STAGE_A(PG8_SA(1, 1), a1, 1);
            if (GATHER && last) { voffA[0][0] = nvA[0][0]; voffA[0][1] = nvA[0][1]; voffA[1][0] = nvA[1][0]; voffA[1][1] = nvA[1][1]; }
            PG8_WAIT_V(8); PG8_WAIT_L(0); PG8_BAR; PG8_MMA(0, 0, At, B0); PG8_MMA(0, 1, At, B1); PG8_BAR; PG8_SCHED;
            PG8_LDA(At, 0, 1); PG8_STAGE_B(PG8_SB(0, 0), b2, 0); PG8_STAGE_B(PG8_SB(0, 1), b2, 1); PG8_STAGE_A(PG8_SA(0, 0), a2, 0);
            PG8_WAIT_V(8); PG8_WAIT_L(0); PG8_BAR; PG8_MMA(1, 0, At, B0); PG8_MMA(1, 1, At, B1); PG8_BAR; PG8_SCHED;
            PG8_LDB(B0, 1, 0); PG8_LDB(B1, 1, 1); PG8_SCHED; PG8_LDA(At, 1, 0); PG8_STAGE_A(PG8_SA(0, 1), a2, 1);
            PG8_WAIT_V(8); PG8_WAIT_L(0); PG8_BAR; PG8_MMA(0, 0, At, B0); PG8_MMA(0, 1, At, B1); PG8_BAR; PG8_SCHED;
            PG8_LDA(At, 1, 1); PG8_STAGE_B(PG8_SB(1, 0), b3, 0); PG8_STAGE_B(PG8_SB(1, 1), b3, 1); PG8_STAGE_A(PG8_SA(1, 0), a3, 0);
            PG8_WAIT_V(8); PG8_WAIT_L(0); PG8_BAR; PG8_MMA(1, 0, At, B0); PG8_MMA(1, 1, At, B1); PG8_BAR; PG8_SCHED;
        }
        if (wr == 0) PG8_BAR;
        E(acc, cur, wr, wc, fr, fq);
        if (!has_next) break;
#pragma unroll
        for (int a = 0; a < 2; ++a)
#pragma unroll
            for (int b = 0; b < 2; ++b)
#pragma unroll
                for (int m = 0; m < 4; ++m)
#pragma unroll
                    for (int n = 0; n < 2; ++n) acc[a][b][m][n] = (f32x4){0.f, 0.f, 0.f, 0.f};
        cur = nxt; cA = nA; cB = nB; ++ui;
        if (wr == 1) PG8_BAR;
    }
    PG8_WAIT_V(0);
    PG8_BAR;
#undef PG8_SA
#undef PG8_SB
#undef PG8_STAGE
#undef PG8_STAGE_A
#undef PG8_STAGE_B
#undef PG8_LDA
#undef PG8_LDB
#undef PG8_MMA
#undef PG8_WAIT_V
#undef PG8_WAIT_L
#undef PG8_BAR
#undef PG8_SCHED
}
typedef unsigned u32x4 __attribute__((ext_vector_type(4)));
typedef unsigned u32x2 __attribute__((ext_vector_type(2)));
#ifndef P8_NT
#define P8_NT 0
#endif
DI void st16(void* p, const uint4& v) { u32x4 t = {v.x, v.y, v.z, v.w};
    if (P8_NT == 2) asm volatile("global_store_dwordx4 %0, %1, off sc1\n\ts_nop 1" :: "v"(p), "v"(t) : "memory");
    else if (P8_NT == 1) __builtin_nontemporal_store(t, (u32x4*)p); else *(u32x4*)p = t; }
DI void st8(void* p, const uint2& v) { u32x2 t = {v.x, v.y};
    if (P8_NT == 2) asm volatile("global_store_dwordx2 %0, %1, off sc1\n\ts_nop 1" :: "v"(p), "v"(t) : "memory");
    else if (P8_NT == 1) __builtin_nontemporal_store(t, (u32x2*)p); else *(u32x2*)p = t; }
DI uint4 pack_bf8(const f32x4& v0, const f32x4& v1) { return make_uint4(pk2(v0[0], v0[1]), pk2(v0[2], v0[3]), pk2(v1[0], v1[1]), pk2(v1[2], v1[3])); }
struct PlainSched {
    const char* A; const char* B; int nM, nN, limit; size_t tstep;
    DI bool next(int i, Unit& u) const { const int L = i * (int)gridDim.x + (int)blockIdx.x; if (L >= limit) return false; tile_remap(L, nM, nN, u.pm, u.pn); u.x0 = 0; u.x1 = 0; return true; }
    DI const char* a_base(const Unit& u) const { return A + (size_t)u.pm * tstep; }
    DI const char* b_base(const Unit& u) const { return B + (size_t)u.pn * tstep; }
    DI void a_offs(int, const Unit&, const int (&)[2], const int (&)[2], unsigned (&)[2][2]) const {}
};
}
struct G4 { char* lds; int tid; int vb; int nvb; volatile LAS unsigned* cnt; };
constexpr int G4_LDS = 77824;
constexpr int G4_AUX = 73728;
constexpr int G4_TILE = 128 * 128;
DI G4 g4_make(char* lds) {
    G4 g; const int t = ltid(); const int grp = t >> 8;
    g.lds = lds + grp * G4_LDS; g.tid = t & 255; g.vb = blockIdx.x * 2 + grp; g.nvb = gridDim.x * 2;
    g.cnt = (volatile LAS unsigned*)(lds + LDS_BYTES - 32) + grp;
    return g;
}
DI void g4_bar(const G4& G) {
    asm volatile("s_waitcnt lgkmcnt(0)" ::: "memory");
    unsigned target = 0;
    if ((G.tid & 63) == 0) {
        const unsigned old = __hip_atomic_fetch_add((LAS unsigned*)G.cnt, 1u, __ATOMIC_RELAXED, __HIP_MEMORY_SCOPE_WORKGROUP);
        target = (old & ~3u) + 4u;
    }
    target = __builtin_amdgcn_readfirstlane(target);
    while ((int)(*G.cnt - target) < 0) __builtin_amdgcn_s_sleep(1);
    asm volatile("" ::: "memory");
}
template <class F> DI void g4_epi_rows8(const G4& G, const float* stg, F f) {
#pragma unroll
    for (int it = 0; it < 8; ++it) {
        const int idx = it * 256 + G.tid;
        const int r = idx >> 4, c0 = (idx & 15) * 8;
        const float4 p = *(const float4*)(stg + r * STG_LD + c0);
        const float4 q = *(const float4*)(stg + r * STG_LD + c0 + 4);
        const float v[8] = {p.x, p.y, p.z, p.w, q.x, q.y, q.z, q.w};
        f(r, c0, v);
    }
}
template <class T, class L, class F> DI void g4_epi_rows8_pre(const G4& G, const float* stg, L loadf, F f) {
    T pre[8];
#pragma unroll
    for (int it = 0; it < 8; ++it) { const int idx = it * 256 + G.tid; pre[it] = loadf(idx >> 4, (idx & 15) * 8); }
#pragma unroll
    for (int it = 0; it < 8; ++it) {
        const int idx = it * 256 + G.tid;
        const int r = idx >> 4, c0 = (idx & 15) * 8;
        const float4 p = *(const float4*)(stg + r * STG_LD + c0);
        const float4 q = *(const float4*)(stg + r * STG_LD + c0 + 4);
        const float v[8] = {p.x, p.y, p.z, p.w, q.x, q.y, q.z, q.w};
        f(r, c0, v, pre[it]);
    }
}
struct G4RowLoader {
    const bfr* p; size_t ld;
    DI G4RowLoader(const G4& G, const bfr* base, int row0, size_t ld_) : ld(ld_) { p = base + (size_t)(row0 + (G.tid >> 3)) * ld_ + gt_lcol(G.tid); }
    DI const bfr* operator()(int i, int kt) const { return p + (size_t)(32 * i) * ld + kt * 64; }
};
template <class AF, class BF, class EF>
DI void g4_gemm_tile(const G4& G, char* lds, int nk, AF aptr, BF bptr, EF epi) {
    const int tid = G.tid, lane = tid & 63, wave = tid >> 6;
    const int wr = wave >> 1, wc = wave & 1;
    f32x16 acc00, acc01, acc10, acc11;
#pragma unroll
    for (int r = 0; r < 16; ++r) { acc00[r] = 0.f; acc01[r] = 0.f; acc10[r] = 0.f; acc11[r] = 0.f; }
#define GT_DMA(kt_, base_) do { char* db_ = (base_) + tid * 16; _Pragma("unroll") for (int i_ = 0; i_ < 4; ++i_) { \
        __builtin_amdgcn_global_load_lds((GPtrU)aptr(i_, kt_), (LPtrU)(db_ + i_ * 4096), 16, 0, 0); \
        __builtin_amdgcn_global_load_lds((GPtrU)bptr(i_, kt_), (LPtrU)(db_ + G4_TILE + i_ * 4096), 16, 0, 0); } } while (0)
#define GT_FRAG(cb_, off_) (*(const bf16x8*)((cb_) + (off_)))
#define GT_COMPUTE(base_) do { const char* cb_ = (base_); \
        { const bf16x8 a0 = GT_FRAG(cb_, ao0), a1 = GT_FRAG(cb_, ao0 + 4096), b0 = GT_FRAG(cb_, bo0), b1 = GT_FRAG(cb_, bo0 + 4096); \
          acc00 = MFMA32(a0, b0, acc00); acc01 = MFMA32(a0, b1, acc01); acc10 = MFMA32(a1, b0, acc10); acc11 = MFMA32(a1, b1, acc11); } \
        { const bf16x8 a0 = GT_FRAG(cb_, ao1), a1 = GT_FRAG(cb_, ao1 + 4096), b0 = GT_FRAG(cb_, bo1), b1 = GT_FRAG(cb_, bo1 + 4096); \
          acc00 = MFMA32(a0, b0, acc00); acc01 = MFMA32(a0, b1, acc01); acc10 = MFMA32(a1, b0, acc10); acc11 = MFMA32(a1, b1, acc11); } \
        { const bf16x8 a0 = GT_FRAG(cb_, ao2), a1 = GT_FRAG(cb_, ao2 + 4096), b0 = GT_FRAG(cb_, bo2), b1 = GT_FRAG(cb_, bo2 + 4096); \
          acc00 = MFMA32(a0, b0, acc00); acc01 = MFMA32(a0, b1, acc01); acc10 = MFMA32(a1, b0, acc10); acc11 = MFMA32(a1, b1, acc11); } \
        { const bf16x8 a0 = GT_FRAG(cb_, ao3), a1 = GT_FRAG(cb_, ao3 + 4096), b0 = GT_FRAG(cb_, bo3), b1 = GT_FRAG(cb_, bo3 + 4096); \
          acc00 = MFMA32(a0, b0, acc00); acc01 = MFMA32(a0, b1, acc01); acc10 = MFMA32(a1, b0, acc10); acc11 = MFMA32(a1, b1, acc11); } } while (0)
    const int ln = lane & 31, hf = lane >> 5, sw = (ln >> 1) & 7;
    int ao0 = wr * 8192 + ln * 128 + ((0 + hf) ^ sw) * 16, ao1 = wr * 8192 + ln * 128 + ((2 + hf) ^ sw) * 16;
    int ao2 = wr * 8192 + ln * 128 + ((4 + hf) ^ sw) * 16, ao3 = wr * 8192 + ln * 128 + ((6 + hf) ^ sw) * 16;
    int bo0 = G4_TILE + wc * 8192 + ln * 128 + ((0 + hf) ^ sw) * 16, bo1 = G4_TILE + wc * 8192 + ln * 128 + ((2 + hf) ^ sw) * 16;
    int bo2 = G4_TILE + wc * 8192 + ln * 128 + ((4 + hf) ^ sw) * 16, bo3 = G4_TILE + wc * 8192 + ln * 128 + ((6 + hf) ^ sw) * 16;
    asm volatile("" : "+v"(ao0), "+v"(ao1), "+v"(ao2), "+v"(ao3), "+v"(bo0), "+v"(bo1), "+v"(bo2), "+v"(bo3));
    GT_DMA(0, lds);
    asm volatile("s_waitcnt vmcnt(0)" ::: "memory");
    g4_bar(G);
    int buf = 0;
#pragma unroll 1
    for (int kt = 0; kt < nk - 1; ++kt) {
        GT_DMA(kt + 1, lds + (buf ^ 1) * (2 * G4_TILE));
        GT_COMPUTE(lds + buf * (2 * G4_TILE));
        asm volatile("s_waitcnt vmcnt(0)" ::: "memory");
        g4_bar(G);
        buf ^= 1;
    }
    GT_COMPUTE(lds + buf * (2 * G4_TILE));
    g4_bar(G);
#undef GT_DMA
#undef GT_FRAG
#undef GT_COMPUTE
    float* stg = (float*)lds;
    int w_off = (wr * 64 + 4 * (lane >> 5)) * STG_LD + wc * 64 + (lane & 31);
    asm volatile("" : "+v"(w_off));
#pragma unroll
    for (int r = 0; r < 16; ++r) {
        const int ro = ((r & 3) + 8 * (r >> 2)) * STG_LD;
        stg[w_off + ro] = acc00[r];
        stg[w_off + ro + 32] = acc01[r];
        stg[w_off + ro + 32 * STG_LD] = acc10[r];
        stg[w_off + ro + 32 * STG_LD + 32] = acc11[r];
    }
    g4_bar(G);
    epi((const float*)stg);
    g4_bar(G);
}

DI void g4_attn_item(const G4& G, char* lds, const Ctx& P, int b, int h, int qt, float lam, float lam_init, const float* subln) {
    const bfr* qn = (const bfr*)(P.ws + OFF_QN);
    const bfr* kn = (const bfr*)(P.ws + OFF_KN);
    const bfr* vT = (const bfr*)(P.ws + OFF_VT) + (size_t)(b * 4 + h) * 128 * SEQ;
    bfr* am = (bfr*)(P.ws + OFF_AMIX);
    const int tid = G.tid, lane = tid & 63, wave = tid >> 6;
    const int m = wave >> 1, qw = (wave & 1) * 32;
    const int q0 = qt * 64 + qw;
    const int ln = lane & 31, hf = lane >> 5;
    bf16x8 qf[4];
    {
        const bfr* qp = qn + ((size_t)b * SEQ + q0 + ln) * 512 + h * 128 + m * 64 + hf * 8;
#pragma unroll
        for (int ks = 0; ks < 4; ++ks) qf[ks] = *(const bf16x8*)(qp + ks * 16);
    }
    f32x16 o[4];
#pragma unroll
    for (int d = 0; d < 4; ++d)
#pragma unroll
        for (int r = 0; r < 16; ++r) o[d][r] = 0.f;
    float mrun = -INFINITY, lrun = 0.f;
    const int nkt = qt + 1;
    const int lrow = tid >> 3, lcol = (tid & 7) * 8;
    const bfr* kbase = kn + ((size_t)b * SEQ) * 512 + h * 128;
    unsigned ko = (unsigned)(lrow * 512 + lcol) * 2u, vo = (unsigned)(lrow * SEQ + lcol) * 2u;
    asm volatile("" : "+v"(ko), "+v"(vo));
    uint4 rk0, rk1, rk2, rk3, rv0, rv1, rv2, rv3;
#define ATT_GLOAD(kt_) do { const char* kp_ = (const char*)(kbase + (size_t)(kt_) * (64 * 512)); const char* vp_ = (const char*)(vT + (kt_) * 64); \
        rk0 = *(const uint4*)(kp_ + ko); rk1 = *(const uint4*)(kp_ + 32 * 512 * 2 + ko); rk2 = *(const uint4*)(kp_ + 64 * 2 + ko); rk3 = *(const uint4*)(kp_ + 32 * 512 * 2 + 64 * 2 + ko); \
        rv0 = *(const uint4*)(vp_ + vo); rv1 = *(const uint4*)(vp_ + 32 * SEQ * 2 + vo); rv2 = *(const uint4*)(vp_ + 64 * SEQ * 2 + vo); rv3 = *(const uint4*)(vp_ + 96 * SEQ * 2 + vo); } while (0)
#define ATT_S1(base_, i_, RK, RV) { *(uint4*)((base_) + (32 * (i_)) * LDA * 2) = RK; \
        *(uint4*)((base_) + TILE_B + (32 * (i_)) * LDA * 2) = RV; }
#define ATT_LSTORE(buf_) do { char* base_ = lds + (buf_) * (2 * TILE_B) + s_off; ATT_S1(base_, 0, rk0, rv0) ATT_S1(base_, 1, rk1, rv1) ATT_S1(base_, 2, rk2, rv2) ATT_S1(base_, 3, rk3, rv3) } while (0)
    int k_off = ((m * 64 + ln) * LDA + hf * 8) * 2;
    int v_off = TILE_B + (ln * LDA + 4 * hf) * 2;
    int s_off = (lrow * LDA + lcol) * 2;
    asm volatile("" : "+v"(k_off), "+v"(v_off), "+v"(s_off));
    ATT_GLOAD(0); ATT_LSTORE(0);
    g4_bar(G);
    int buf = 0;
#pragma unroll 1
    for (int kt = 0; kt < nkt; ++kt) {
        const bool more = (kt + 1 < nkt);
        const char* ks_ = lds + buf * (2 * TILE_B) + k_off;
        const char* vs_ = lds + buf * (2 * TILE_B) + v_off;
        if (kt * 64 <= q0 + 31) {
            f32x16 s[2];
#pragma unroll
            for (int kb = 0; kb < 2; ++kb) {
#pragma unroll
                for (int r = 0; r < 16; ++r) s[kb][r] = 0.f;
#pragma unroll
                for (int ks = 0; ks < 4; ++ks) {
                    const bf16x8 kf = *(const bf16x8*)(ks_ + ((kb * 32) * LDA + ks * 16) * 2);
                    s[kb] = MFMA32(kf, qf[ks], s[kb]);
                }
            }
            const int qpos = q0 + ln;
            if (kt * 64 + 63 > q0) {
#pragma unroll
                for (int kb = 0; kb < 2; ++kb)
#pragma unroll
                    for (int r = 0; r < 16; ++r) {
                        const int key = kt * 64 + kb * 32 + (r & 3) + 8 * (r >> 2) + 4 * hf;
                        if (key > qpos) s[kb][r] = -INFINITY;
                    }
            }
            float mx = s[0][0];
#pragma unroll
            for (int kb = 0; kb < 2; ++kb)
#pragma unroll
                for (int r = 0; r < 16; ++r) mx = fmaxf(mx, s[kb][r]);
            mx = fmaxf(mx, __shfl_xor(mx, 32));
            const float mnew = fmaxf(mrun, mx);
            const float alpha = __builtin_amdgcn_exp2f(mrun - mnew);
            mrun = mnew;
            float rsum = 0.f;
#pragma unroll
            for (int kb = 0; kb < 2; ++kb)
#pragma unroll
                for (int r = 0; r < 16; ++r) { const float p = __builtin_amdgcn_exp2f(s[kb][r] - mnew); s[kb][r] = p; rsum += p; }
            lrun = lrun * alpha + rsum;
#pragma unroll
            for (int d = 0; d < 4; ++d)
#pragma unroll
                for (int r = 0; r < 16; ++r) o[d][r] *= alpha;
            __builtin_amdgcn_sched_barrier(0);
            if (more) ATT_GLOAD(kt + 1);
#pragma unroll
            for (int kb = 0; kb < 2; ++kb)
#pragma unroll
                for (int st = 0; st < 2; ++st) {
                    const uint4 pp = make_uint4(pk2(s[kb][8 * st + 0], s[kb][8 * st + 1]), pk2(s[kb][8 * st + 2], s[kb][8 * st + 3]),
                                                pk2(s[kb][8 * st + 4], s[kb][8 * st + 5]), pk2(s[kb][8 * st + 6], s[kb][8 * st + 7]));
                    const bf16x8 pf = __builtin_bit_cast(bf16x8, pp);
                    const int kc = kb * 32 + 16 * st;
#pragma unroll
                    for (int d = 0; d < 4; ++d) {
                        const uint2 v0 = *(const uint2*)(vs_ + ((d * 32) * LDA + kc) * 2);
                        const uint2 v1 = *(const uint2*)(vs_ + ((d * 32) * LDA + kc + 8) * 2);
                        const bf16x8 vf = __builtin_bit_cast(bf16x8, make_uint4(v0.x, v0.y, v1.x, v1.y));
                        o[d] = MFMA32(vf, pf, o[d]);
                    }
                }
        }
        else if (more) ATT_GLOAD(kt + 1);
        if (more) ATT_LSTORE(buf ^ 1);
        g4_bar(G);
        buf ^= 1;
    }
    const float ltot = lrun + __shfl_xor(lrun, 32);
    const float linv = 1.0f / ltot;
    float* ob = (float*)lds;
    int o_off = (m * 64 + qw + ln) * 129 + 4 * hf;
    asm volatile("" : "+v"(o_off));
#pragma unroll
    for (int d = 0; d < 4; ++d)
#pragma unroll
        for (int r = 0; r < 16; ++r) ob[o_off + d * 32 + (r & 3) + 8 * (r >> 2)] = o[d][r] * linv;
    g4_bar(G);
#pragma unroll
    for (int it = 0; it < 4; ++it) {
        const int idx = it * 256 + tid;
        const int q = idx >> 4, c0 = (idx & 15) * 8;
        float v[8];
        float ss = 0.f;
        int r_off = q * 129 + c0;
        asm volatile("" : "+v"(r_off));
#pragma unroll
        for (int j = 0; j < 8; ++j) { v[j] = ob[r_off + j] - lam * ob[r_off + 64 * 129 + j]; ss += v[j] * v[j]; }
        ss = row16_sum(ss);
        const float rs = rsqrtf(ss * (1.0f / 128.0f) + 1e-5f) * (1.0f - lam_init);
#pragma unroll
        for (int j = 0; j < 8; ++j) v[j] = v[j] * rs * subln[c0 + j];
        *(uint4*)(am + ((size_t)b * SEQ + qt * 64 + q) * 1024 + h * 128 + c0) = pack8(v);
    }
    g4_bar(G);
}

#undef ATT_GLOAD
#undef ATT_S1
#undef ATT_LSTORE
#undef ATT_OFF
#undef ATT_G1
DI int cvt_rowmap(int n, int mode) { return mode == 0 ? n : ((n >> 2) * 8 + (n & 3) + (mode == 2 ? 4 : 0)); }
DI void cvt_tile(char* lds, const float* __restrict__ src, int N, bfr* __restrict__ dst, int ldd, int k0, int n0, int mode) {
    float* t = (float*)lds;
    const int tid = ltid();
    const int r = tid >> 5, c = (tid & 31) * 4;
#pragma unroll
    for (int i = 0; i < 4; ++i) {
        const float4 v = *(const float4*)(src + (size_t)(k0 + r + 16 * i) * N + n0 + c);
        float* d = t + (r + 16 * i) * 129 + c;
        d[0] = v.x; d[1] = v.y; d[2] = v.z; d[3] = v.w;
    }
    __syncthreads();
#pragma unroll
    for (int i = 0; i < 2; ++i) {
        const int idx = tid + i * NTHREADS;
        const int kg = idx & 7, n = idx >> 3;
        float v[8];
#pragma unroll
        for (int j = 0; j < 8; ++j) v[j] = t[(kg * 8 + j) * 129 + n];
        *(uint4*)(dst + (size_t)cvt_rowmap(n0 + n, mode) * ldd + k0 + kg * 8) = pack8(v);
    }
    __syncthreads();
}
DI void cvt_matrix(char* lds, const float* src, int K, int N, bfr* dst, int ldd, int mode, int worker, int nworkers, unsigned& base) {
    if (worker < 0) return;
    const int ntn = N >> 7, ntiles = (K >> 6) * ntn;
    int t0 = (int)(((unsigned)worker + (unsigned)nworkers - (base % (unsigned)nworkers)) % (unsigned)nworkers);
    for (int t = t0; t < ntiles; t += nworkers) cvt_tile(lds, src, N, dst, ldd, (t / ntn) * 64, (t % ntn) * 128, mode);
    base += (unsigned)ntiles;
}
struct CvtTile { const float* src; bfr* dst; int N, ldd, mode; };
DI CvtTile moe_cvt_tile(const Ctx& P, int layer, int t) {
    const int e = t / 192, r = t % 192, m = r >> 6, q = r & 63;
    const size_t we = (size_t)(layer * 32 + e);
    CvtTile c;
    if (m < 2) {
        const int k0 = (q >> 2) * 64, n0 = (q & 3) * 128;
        c.src = P.in[m == 0 ? I_MWGATE : I_MWUP] + we * 1024 * 512 + (size_t)k0 * 512 + n0; c.N = 512;
        c.dst = (bfr*)(P.ws + OFF_MWGU) + (size_t)e * 1024 * 1024 + k0; c.ldd = 1024; c.mode = 1 + m;
        c.dst += (size_t)0; c.mode |= (n0 << 8);
    } else {
        const int k0 = (q >> 3) * 64, n0 = (q & 7) * 128;
        c.src = P.in[I_MWDOWN] + we * 512 * 1024 + (size_t)k0 * 1024 + n0; c.N = 1024;
        c.dst = (bfr*)(P.ws + OFF_MWD) + (size_t)e * 1024 * 512 + k0; c.ldd = 512; c.mode = (n0 << 8);
    }
    return c;
}
DI void moe_convert_range(char* lds, const Ctx& P, int layer, int t_begin, int t_end) {
    if (t_begin >= t_end) return;
    float* tl = (float*)lds;
    const int tid = ltid();
    const int r = tid >> 5, c4 = (tid & 31) * 4;
    float4 va[4], vb[4], vc[4];
#define CVT_LOAD(v_, t_) do { if ((t_) < t_end) { const CvtTile ct_ = moe_cvt_tile(P, layer, (t_)); const float* s_ = ct_.src + (size_t)r * ct_.N + c4; \
        v_[0] = *(const float4*)(s_); v_[1] = *(const float4*)(s_ + (size_t)16 * ct_.N); v_[2] = *(const float4*)(s_ + (size_t)32 * ct_.N); v_[3] = *(const float4*)(s_ + (size_t)48 * ct_.N); } } while (0)
#define CVT_STEP(v_, t_) do { if ((t_) < t_end) { \
        { float* d = tl + r * 129 + c4; \
          d[0] = v_[0].x; d[1] = v_[0].y; d[2] = v_[0].z; d[3] = v_[0].w; d += 16 * 129; d[0] = v_[1].x; d[1] = v_[1].y; d[2] = v_[1].z; d[3] = v_[1].w; \
          d += 16 * 129; d[0] = v_[2].x; d[1] = v_[2].y; d[2] = v_[2].z; d[3] = v_[2].w; d += 16 * 129; d[0] = v_[3].x; d[1] = v_[3].y; d[2] = v_[3].z; d[3] = v_[3].w; } \
        const CvtTile me = moe_cvt_tile(P, layer, (t_)); \
        CVT_LOAD(v_, (t_) + 3); \
        __syncthreads(); \
        const int mode = me.mode & 255, n0 = me.mode >> 8; \
        _Pragma("unroll") for (int i = 0; i < 2; ++i) { \
            const int idx = tid + i * NTHREADS; \
            const int kg = idx & 7, n = idx >> 3;                    \
            float v[8]; \
            _Pragma("unroll") for (int j = 0; j < 8; ++j) v[j] = tl[(kg * 8 + j) * 129 + n]; \
            *(uint4*)(me.dst + (size_t)cvt_rowmap(n0 + n, mode) * me.ldd + kg * 8) = pack8(v); } \
        __syncthreads(); } } while (0)
    CVT_LOAD(va, t_begin); CVT_LOAD(vb, t_begin + 1); CVT_LOAD(vc, t_begin + 2);
    for (int t = t_begin; t < t_end; t += 3) {
        CVT_STEP(va, t);
        CVT_STEP(vb, t + 1);
        CVT_STEP(vc, t + 2);
    }
#undef CVT_LOAD
#undef CVT_STEP
}
DI void g4_moe_convert_range(const G4& G, const Ctx& P, int layer, int t_begin, int t_end) {
    if (t_begin >= t_end) return;
    float* tl = (float*)G.lds;
    const int tid = G.tid;
    const int r = tid >> 5, c4 = (tid & 31) * 4;
    float4 va[8], vb[8];
#define G4C_LOAD(v_, t_) do { if ((t_) < t_end) { const CvtTile ct_ = moe_cvt_tile(P, layer, (t_)); const float* s_ = ct_.src + (size_t)r * ct_.N + c4; \
        _Pragma("unroll") for (int i_ = 0; i_ < 8; ++i_) v_[i_] = *(const float4*)(s_ + (size_t)(8 * i_) * ct_.N); } } while (0)
#define G4C_STEP(v_, t_) do { if ((t_) < t_end) { \
        _Pragma("unroll") for (int i_ = 0; i_ < 8; ++i_) { float* d = tl + (r + 8 * i_) * 129 + c4; d[0] = v_[i_].x; d[1] = v_[i_].y; d[2] = v_[i_].z; d[3] = v_[i_].w; } \
        const CvtTile me = moe_cvt_tile(P, layer, (t_)); \
        G4C_LOAD(v_, (t_) + 2); \
        g4_bar(G); \
        const int mode = me.mode & 255, n0 = me.mode >> 8; \
        _Pragma("unroll") for (int i = 0; i < 4; ++i) { \
            const int idx = tid + i * 256; \
            const int kg = idx & 7, n = idx >> 3; \
            float v[8]; \
            _Pragma("unroll") for (int j = 0; j < 8; ++j) v[j] = tl[(kg * 8 + j) * 129 + n]; \
            *(uint4*)(me.dst + (size_t)cvt_rowmap(n0 + n, mode) * me.ldd + kg * 8) = pack8(v); } \
        g4_bar(G); } } while (0)
    G4C_LOAD(va, t_begin); G4C_LOAD(vb, t_begin + 1);
    for (int t = t_begin; t < t_end; t += 2) {
        G4C_STEP(va, t);
        G4C_STEP(vb, t + 1);
    }
#undef G4C_LOAD
#undef G4C_STEP
}
DI void s5_tables(char* lds, const Ctx& P, int i, int g) {
    float2* pw = (float2*)lds;
    float2* bb = pw + 64 * 33;
    float2* cm = bb + 64 * 16;
    float*  kt = (float*)(cm + 16 * 64);
    const int tid = ltid();
    const size_t gp = (size_t)(i * 32 + g) * 64;
    for (int idx = tid; idx < 64 * 33; idx += NTHREADS) {
        const int p = idx / 33, tau = idx % 33;
        const float re = fminf(P.in[I_ARE][gp + p], -1e-4f), im = P.in[I_AIM][gp + p];
        const float st = expf(P.in[I_LSTEP][gp + p]);
        const float mag = expf(re * st * (float)tau);
        const double angd = (double)im * (double)st * (double)tau;
        const double red = angd - 6.283185307179586 * floor(angd * 0.15915494309189535);
        float sn, cs; sincosf((float)red, &sn, &cs);
        pw[idx] = make_float2(mag * cs, mag * sn);
    }
    for (int idx = tid; idx < 64 * 16; idx += NTHREADS) {
        const int p = idx >> 4, c = idx & 15;
        const double re = fmin((double)P.in[I_ARE][gp + p], -1e-4), im = (double)P.in[I_AIM][gp + p];
        const double st = exp((double)P.in[I_LSTEP][gp + p]);
        const double mag = exp(re * st), lr = mag * cos(im * st) - 1.0, li = mag * sin(im * st);
        const double den = re * re + im * im;
        const double fr = (lr * re + li * im) / den, fi = (li * re - lr * im) / den;
        const double br = (double)P.in[I_BRE][(gp + p) * 16 + c], bi = (double)P.in[I_BIM][(gp + p) * 16 + c];
        bb[idx] = make_float2((float)(fr * br - fi * bi), (float)(fr * bi + fi * br));
        const int cc = idx >> 6, pp = idx & 63;
        cm[idx] = make_float2(P.in[I_CRE][((size_t)(i * 32 + g) * 16 + cc) * 64 + pp], P.in[I_CIM][((size_t)(i * 32 + g) * 16 + cc) * 64 + pp]);
    }
    __syncthreads();
    for (int idx = tid; idx < 32 * 16; idx += NTHREADS) {
        const int tau = idx >> 4, c1 = idx & 15;
        float s[16];
#pragma unroll
        for (int c = 0; c < 16; ++c) s[c] = 0.f;
        for (int p = 0; p < 64; ++p) {
            const float2 a = cm[c1 * 64 + p], w = pw[p * 33 + tau];
            const float tr = a.x * w.x - a.y * w.y, ti = a.x * w.y + a.y * w.x;
            const float4* b4 = (const float4*)(bb + p * 16);
#pragma unroll
            for (int c2 = 0; c2 < 8; ++c2) { const float4 b = b4[c2]; s[2 * c2] += tr * b.x - ti * b.y; s[2 * c2 + 1] += tr * b.z - ti * b.w; }
        }
#pragma unroll
        for (int c = 0; c < 16; ++c) kt[idx * 16 + c] = s[c];
    }
    __syncthreads();
    bfr* gt = (bfr*)(P.ws + OFF_S5GT) + (size_t)(i * 32 + g) * 512 * 640;
    for (int idx = tid; idx < 512 * 80; idx += NTHREADS) {
        const int n = idx / 80, ch = idx % 80;
        const int t = n >> 4, c1 = n & 15;
        float v[8];
        if (ch < 64) {
            const int s = ch >> 1, c0 = (ch & 1) * 8;
#pragma unroll
            for (int j = 0; j < 8; ++j) v[j] = (t >= s) ? kt[((t - s) * 16 + c1) * 16 + c0 + j] : 0.f;
        } else {
            const int p0 = (ch - 64) * 4;
#pragma unroll
            for (int j = 0; j < 4; ++j) {
                const float2 a = cm[c1 * 64 + p0 + j], w = pw[(p0 + j) * 33 + t + 1];
                v[2 * j] = a.x * w.x - a.y * w.y;
                v[2 * j + 1] = -(a.x * w.y + a.y * w.x);
            }
        }
        *(uint4*)(gt + (size_t)n * 640 + ch * 8) = pack8(v);
    }
    bfr* bl = (bfr*)(P.ws + OFF_S5BL) + (size_t)(i * 32 + g) * 128 * 512;
    for (int idx = tid; idx < 128 * 64; idx += NTHREADS) {
        const int n = idx >> 6, ch = idx & 63;
        const int p = n >> 1, ri = n & 1, s = ch >> 1, c0 = (ch & 1) * 8;
        const float2 w = pw[p * 33 + 31 - s];
        float v[8];
#pragma unroll
        for (int j = 0; j < 8; ++j) { const float2 b = bb[p * 16 + c0 + j]; v[j] = ri ? (w.x * b.y + w.y * b.x) : (w.x * b.x - w.y * b.y); }
        *(uint4*)(bl + (size_t)n * 512 + ch * 8) = pack8(v);
    }
    float* l32 = (float*)(P.ws + OFF_S5L32) + (size_t)(i * 32 + g) * 128;
    if (tid < 64) { l32[2 * tid] = pw[tid * 33 + 32].x; l32[2 * tid + 1] = pw[tid * 33 + 32].y; }
    __syncthreads();
}

DI void norm_rows(const float* __restrict__ x, const float* __restrict__ g, bfr* __restrict__ hb, bfr* __restrict__ hlo, float* __restrict__ xcopy, int tok0, int ntok, const bfr* __restrict__ mix = nullptr) {
    const int tid_ = ltid();
    const int lane = tid_ & 63, wave = tid_ >> 6;
    constexpr int NT = 4;
    for (int tk = wave * NT; tk < ntok; tk += NWAVES * NT) {
        float4 v[NT][4]; uint2 mm[NT][4];
#pragma unroll
        for (int q = 0; q < NT; ++q) {
            const size_t tok = (size_t)(tok0 + tk + q);
#pragma unroll
            for (int i = 0; i < 4; ++i) {
                v[q][i] = *(const float4*)(x + tok * DM + i * 256 + lane * 4);
                if (mix) mm[q][i] = *(const uint2*)(mix + tok * DM + i * 256 + lane * 4);
            }
        }
#pragma unroll
        for (int q = 0; q < NT; ++q) {
            const size_t tok = (size_t)(tok0 + tk + q);
            float ss = 0.f;
#pragma unroll
            for (int i = 0; i < 4; ++i) {
                if (mix) { v[q][i].x += bflo(mm[q][i].x); v[q][i].y += bfhi(mm[q][i].x); v[q][i].z += bflo(mm[q][i].y); v[q][i].w += bfhi(mm[q][i].y); }
                ss += v[q][i].x * v[q][i].x + v[q][i].y * v[q][i].y + v[q][i].z * v[q][i].z + v[q][i].w * v[q][i].w;
            }
            ss = wave_sum(ss);
            const float rs = rsqrtf(ss * (1.0f / DM) + 1e-6f);
#pragma unroll
            for (int i = 0; i < 4; ++i) {
                const float4 gg = *(const float4*)(g + i * 256 + lane * 4);
                const float h0 = v[q][i].x * rs * gg.x, h1 = v[q][i].y * rs * gg.y, h2 = v[q][i].z * rs * gg.z, h3 = v[q][i].w * rs * gg.w;
                const unsigned p0 = pk2(h0, h1), p1 = pk2(h2, h3);
                *(uint2*)(hb + tok * DM + i * 256 + lane * 4) = make_uint2(p0, p1);
                if (hlo) {
                    const unsigned q0 = pk2(h0 - bflo(p0), h1 - bfhi(p0)), q1 = pk2(h2 - bflo(p1), h3 - bfhi(p1));
                    *(uint2*)(hlo + tok * DM + i * 256 + lane * 4) = make_uint2(q0, q1);
                }
                if (xcopy) *(float4*)(xcopy + tok * DM + i * 256 + lane * 4) = v[q][i];
            }
        }
    }
}
DI void phase_e1(char* lds, const Ctx& P, int li) {
    const bfr* hb = (const bfr*)(P.ws + OFF_HB);
    const bfr* w = (const bfr*)(P.ws + OFF_WINE) + (size_t)li * 2304 * 1024;
    bfr* u = (bfr*)(P.ws + OFF_U);
    const int ntiles = 128 * 9, G = gridDim.x;
    const int full = (ntiles / G) * G, rem = ntiles - full;
    const bool halves = rem > 0 && 2 * rem <= G;
    {
        p8::PlainSched S{(const char*)hb, (const char*)w, 128, 9, halves ? full : ntiles, (size_t)256 * 1024 * 2};
        p8::gemm_phase<true, false>(lds, 1024, S, [&](const p8::f32x4 (&acc)[2][2][4][2], const p8::Unit& un, int wr, int wc, int fr, int fq) __attribute__((always_inline)) {
            bfr* o = u + (size_t)(un.pm * 256 + wr * 64 + fr) * EVEN_IN + un.pn * 256 + wc * 32 + 8 * fq;
#pragma unroll
            for (int ai = 0; ai < 2; ++ai)
#pragma unroll
                for (int m = 0; m < 4; ++m)
#pragma unroll
                    for (int bj = 0; bj < 2; ++bj)
                        p8::st16(o + (size_t)(ai * 128 + m * 16) * EVEN_IN + bj * 128, p8::pack_bf8(acc[ai][bj][m][0], acc[ai][bj][m][1]));
        });
        __syncthreads();
    }
    if (halves && (int)blockIdx.x < 2 * rem) {
        int mt, nt; tile_remap(full + ((int)blockIdx.x >> 1), 128, 9, mt, nt);
        const int hc = (blockIdx.x & 1) * 128;
        RowLoader A(hb, mt * 256, 1024), B(w, nt * 256 + hc, 1024);
        GEMM128(lds, 16, A, B, [&](const float* stg, int) __attribute__((always_inline)) {
            epi_rows8(stg, [&](int r, int c0, const float (&v)[8]) __attribute__((always_inline)) {
                *(uint4*)(u + (size_t)(mt * 256 + r) * EVEN_IN + nt * 256 + hc + c0) = pack8(v);
            });
        });
    }
}

DI void phase_e2a(const Ctx& P, int li) {
    const bfr* __restrict__ u = (const bfr*)(P.ws + OFF_U);
    const float* __restrict__ mu = P.in[I_MU] + (size_t)li * 1792;
    bfr* __restrict__ S = (bfr*)(P.ws + OFF_S);
    bfr* __restrict__ mv = (bfr*)(P.ws + (li == 0 ? OFF_VFIRST : OFF_MV2));
    bfr* __restrict__ dpool = (bfr*)(P.ws + OFF_DPOOL);
    const int gtid = blockIdx.x * NTHREADS + ltid(), gsz = gridDim.x * NTHREADS;
    {
        constexpr int UN = 4;
        const int total = NTOK * 96;
        for (int idx0 = gtid; idx0 < total; idx0 += gsz * UN) {
            uint4 cu[UN], pv[UN];
#pragma unroll
            for (int q = 0; q < UN; ++q) {
                int idx = idx0 + q * gsz; idx = idx < total ? idx : total - 1;
                const int tok = idx / 96, col = 1024 + (idx % 96) * 8;
                const bfr* row = u + (size_t)tok * EVEN_IN + col;
                cu[q] = *(const uint4*)row;
                pv[q] = *(const uint4*)(row - ((tok & (SEQ - 1)) > 0 ? EVEN_IN : 0));
            }
#pragma unroll
            for (int q = 0; q < UN; ++q) {
                const int idx = idx0 + q * gsz;
                if (idx < total) {
                    const int tok = idx / 96, col = 1024 + (idx % 96) * 8;
                    float cur[8], prv[8], m[8];
                    unpack8(cu[q], cur); unpack8(pv[q], prv);
                    const bool first = (tok & (SEQ - 1)) == 0;
                    const float4 m0 = *(const float4*)(mu + col), m1 = *(const float4*)(mu + col + 4);
                    const float mm[8] = {m0.x, m0.y, m0.z, m0.w, m1.x, m1.y, m1.z, m1.w};
#pragma unroll
                    for (int j = 0; j < 8; ++j) m[j] = cur[j] + ((first ? 0.f : prv[j]) - cur[j]) * mm[j];
                    if (col < 1536) {
                        *(uint4*)(mv + (size_t)tok * 512 + (col - 1024)) = pack8(m);
                    } else if (col < 1600) {
#pragma unroll
                        for (int j = 0; j < 8; ++j) m[j] = ftanh(m[j]);
                        *(uint4*)(S + (size_t)tok * 256 + (col - 1536)) = pack8(m);
                    } else if (col < 1664) {
                        *(uint4*)(S + (size_t)tok * 256 + 64 + (col - 1600)) = pack8(m);
                    } else {
#pragma unroll
                        for (int j = 0; j < 8; ++j) m[j] = sigmoidf_(m[j]);
                        *(uint4*)(S + (size_t)tok * 256 + 128 + (col - 1664)) = pack8(m);
                    }
                }
            }
        }
    }
#define POOL_PASS(GI, W, UN) { const int total = NTOK * 16; \
        for (int idx0 = gtid; idx0 < total; idx0 += gsz * UN) { \
            uint4 rv[UN][W]; \
            _Pragma("unroll") for (int q = 0; q < UN; ++q) { int idx = idx0 + q * gsz; idx = idx < total ? idx : total - 1; \
                const int tok = idx >> 4, col = 1792 + GI * 128 + (idx & 15) * 8; const int t = tok & (SEQ - 1); const int nw = (t + 1 < W) ? (t + 1) : W; \
                const bfr* row = u + (size_t)tok * EVEN_IN + col; \
                _Pragma("unroll") for (int s_ = 0; s_ < W; ++s_) rv[q][s_] = *(const uint4*)(row - (size_t)(s_ < nw ? s_ : 0) * EVEN_IN); } \
            _Pragma("unroll") for (int q = 0; q < UN; ++q) { const int idx = idx0 + q * gsz; if (idx < total) { \
                const int tok = idx >> 4, col = GI * 128 + (idx & 15) * 8; const int t = tok & (SEQ - 1); const int nw = (t + 1 < W) ? (t + 1) : W; \
                float cur[8], acc[8]; unpack8(rv[q][0], cur); \
                _Pragma("unroll") for (int j = 0; j < 8; ++j) acc[j] = cur[j]; \
                _Pragma("unroll") for (int s_ = 1; s_ < W; ++s_) { float pq[8]; unpack8(rv[q][s_], pq); const float wgt = s_ < nw ? 1.f : 0.f; \
                    _Pragma("unroll") for (int j = 0; j < 8; ++j) acc[j] += wgt * pq[j]; } \
                const float inv = frcp((float)nw); \
                _Pragma("unroll") for (int j = 0; j < 8; ++j) acc[j] = acc[j] * inv - cur[j]; \
                *(uint4*)(dpool + (size_t)tok * 512 + col) = pack8(acc); } } } }
    POOL_PASS(0, 2, 4)
    POOL_PASS(1, 4, 4)
    POOL_PASS(2, 8, 2)
    POOL_PASS(3, 16, 1)
#undef POOL_PASS
}

DI void phase_e2b(char* lds, const Ctx& P, int li) {
    const bfr* S_ = (const bfr*)(P.ws + OFF_S);
    const bfr* e1 = (const bfr*)(P.ws + OFF_E2B1) + (size_t)li * 1536 * 256;
#ifndef E2B_MASK
#define E2B_MASK 19
#endif
    if (E2B_MASK & 3) {
        const float* w0 = P.in[I_W0] + li * 512;
        const float* a0 = P.in[I_A0] + li * 512;
        float* dlog = (float*)(P.ws + OFF_DLOG);
        bfr* ab = (bfr*)(P.ws + OFF_ABUF);
        p8::PlainSched S{(const char*)S_, (const char*)e1, 128, 4, 512, (size_t)256 * 256 * 2};
        p8::gemm_phase<true, false>(lds, 256, S, [&](const p8::f32x4 (&acc)[2][2][4][2], const p8::Unit& un, int wr, int wc, int fr, int fq) __attribute__((always_inline)) {
            const int row = un.pm * 256 + wr * 64 + fr, col = (un.pn & 1) * 256 + wc * 32 + 8 * fq;
            if (un.pn < 2) {
#pragma unroll
                for (int ai = 0; ai < 2; ++ai)
#pragma unroll
                    for (int m = 0; m < 4; ++m)
#pragma unroll
                        for (int bj = 0; bj < 2; ++bj) {
                            const int c = col + bj * 128;
                            const float4 b0 = *(const float4*)(w0 + c), b1 = *(const float4*)(w0 + c + 4);
                            p8::f32x4 v0 = acc[ai][bj][m][0], v1 = acc[ai][bj][m][1];
                            asm volatile("" : "+v"(v0), "+v"(v1));
                            float4 o0, o1;
                            o0.x = -fexp(-fsoftplus(-(b0.x + v0[0])) - 0.5f); o0.y = -fexp(-fsoftplus(-(b0.y + v0[1])) - 0.5f); o0.z = -fexp(-fsoftplus(-(b0.z + v0[2])) - 0.5f); o0.w = -fexp(-fsoftplus(-(b0.w + v0[3])) - 0.5f);
                            o1.x = -fexp(-fsoftplus(-(b1.x + v1[0])) - 0.5f); o1.y = -fexp(-fsoftplus(-(b1.y + v1[1])) - 0.5f); o1.z = -fexp(-fsoftplus(-(b1.z + v1[2])) - 0.5f); o1.w = -fexp(-fsoftplus(-(b1.w + v1[3])) - 0.5f);
                            float* d = dlog + (size_t)(row + ai * 128 + m * 16) * 512 + c;
                            *(float4*)d = o0; *(float4*)(d + 4) = o1;
                        }
            } else {
#pragma unroll
                for (int ai = 0; ai < 2; ++ai)
#pragma unroll
                    for (int m = 0; m < 4; ++m)
#pragma unroll
                        for (int bj = 0; bj < 2; ++bj) {
                            const int c = col + bj * 128;
                            const float4 b0 = *(const float4*)(a0 + c), b1 = *(const float4*)(a0 + c + 4);
                            p8::f32x4 v0 = acc[ai][bj][m][0], v1 = acc[ai][bj][m][1];
                            asm volatile("" : "+v"(v0), "+v"(v1));
                            const float o[8] = {sigmoidf_(b0.x + v0[0]), sigmoidf_(b0.y + v0[1]), sigmoidf_(b0.z + v0[2]), sigmoidf_(b0.w + v0[3]),
                                                sigmoidf_(b1.x + v1[0]), sigmoidf_(b1.y + v1[1]), sigmoidf_(b1.z + v1[2]), sigmoidf_(b1.w + v1[3])};
                            *(uint4*)(ab + (size_t)(row + ai * 128 + m * 16) * 512 + c) = pack8(o);
                        }
            }
        });
        __syncthreads();
    }
    if (E2B_MASK & 4) {
        bfr* gb = (bfr*)(P.ws + OFF_GBUF);
        p8::PlainSched S{(const char*)S_, (const char*)(e1 + (size_t)1024 * 256), 128, 2, 256, (size_t)256 * 256 * 2};
        p8::gemm_phase<true, false>(lds, 256, S, [&](const p8::f32x4 (&acc)[2][2][4][2], const p8::Unit& un, int wr, int wc, int fr, int fq) __attribute__((always_inline)) {
            bfr* o = gb + (size_t)(un.pm * 256 + wr * 64 + fr) * 512 + un.pn * 256 + wc * 32 + 8 * fq;
#pragma unroll
            for (int ai = 0; ai < 2; ++ai)
#pragma unroll
                for (int m = 0; m < 4; ++m)
#pragma unroll
                    for (int bj = 0; bj < 2; ++bj)
                        *(uint4*)(o + (size_t)(ai * 128 + m * 16) * 512 + bj * 128) = p8::pack_bf8(acc[ai][bj][m][0], acc[ai][bj][m][1]);
        });
        __syncthreads();
    }
    if (E2B_MASK & 8) {
        const float* ps = P.in[I_POOLS] + li * 512;
        bfr* am = (bfr*)(P.ws + OFF_AMIX);
        struct PoolSched {
            const char* A; const char* B;
            DI bool next(int i, p8::Unit& u) const { const int L = i * (int)gridDim.x + (int)blockIdx.x; if (L >= 256) return false; u.pm = L >> 1; u.pn = L & 1; u.x0 = 0; u.x1 = 0; return true; }
            DI const char* a_base(const p8::Unit& u) const { return A + (size_t)u.pm * (256 * 512 * 2) + (size_t)u.pn * (256 * 2); }
            DI const char* b_base(const p8::Unit& u) const { return B + (size_t)u.pn * (256 * 256 * 2); }
            DI void a_offs(int, const p8::Unit&, const int (&)[2], const int (&)[2], unsigned (&)[2][2]) const {}
        };
        PoolSched S{(const char*)(P.ws + OFF_DPOOL), (const char*)((const bfr*)(P.ws + OFF_E2B2) + (size_t)li * 2 * 256 * 256)};
        p8::gemm_phase<true, false>(lds, 256, S, [&](const p8::f32x4 (&acc)[2][2][4][2], const p8::Unit& un, int wr, int wc, int fr, int fq) __attribute__((always_inline)) {
            const int row = un.pm * 256 + wr * 64 + fr, col = un.pn * 256 + wc * 32 + 8 * fq;
#pragma unroll
            for (int bj = 0; bj < 2; ++bj) {
                const int c = col + bj * 128;
                const float4 s0 = *(const float4*)(ps + c), s1 = *(const float4*)(ps + c + 4);
#pragma unroll
                for (int ai = 0; ai < 2; ++ai)
#pragma unroll
                    for (int m = 0; m < 4; ++m) {
                        const p8::f32x4 a0 = acc[ai][bj][m][0], a1 = acc[ai][bj][m][1];
                        const float o[8] = {a0[0] * s0.x, a0[1] * s0.y, a0[2] * s0.z, a0[3] * s0.w, a1[0] * s1.x, a1[1] * s1.y, a1[2] * s1.z, a1[3] * s1.w};
                        *(uint4*)(am + (size_t)(row + ai * 128 + m * 16) * 1024 + 512 + c) = pack8(o);
                    }
            }
        }, 512, 256);
        __syncthreads();
    }
    if ((E2B_MASK & 16) && li == 1) {
        const float* v0 = P.in[I_V0];
        bfr* vg = (bfr*)(P.ws + OFF_VGATE);
        p8::PlainSched S{(const char*)(P.ws + OFF_MV2), (const char*)(P.ws + OFF_V12T), 128, 2, 256, (size_t)256 * 512 * 2};
        p8::gemm_phase<true, false>(lds, 512, S, [&](const p8::f32x4 (&acc)[2][2][4][2], const p8::Unit& un, int wr, int wc, int fr, int fq) __attribute__((always_inline)) {
            const int row = un.pm * 256 + wr * 64 + fr, col = un.pn * 256 + wc * 32 + 8 * fq;
#pragma unroll
            for (int bj = 0; bj < 2; ++bj) {
                const int c = col + bj * 128;
                const float4 b0 = *(const float4*)(v0 + c), b1 = *(const float4*)(v0 + c + 4);
                const float bb[8] = {b0.x, b0.y, b0.z, b0.w, b1.x, b1.y, b1.z, b1.w};
#pragma unroll
                for (int ai = 0; ai < 2; ++ai)
#pragma unroll
                    for (int m = 0; m < 4; ++m) {
                        float o[8];
#pragma unroll
                        for (int j = 0; j < 4; ++j) { o[j] = sigmoidf_(bb[j] + acc[ai][bj][m][0][j]); o[4 + j] = sigmoidf_(bb[4 + j] + acc[ai][bj][m][1][j]); }
                        *(uint4*)(vg + (size_t)(row + ai * 128 + m * 16) * 512 + c) = pack8(o);
                    }
            }
        });
        __syncthreads();
    }
}

constexpr int RW_TC = 32;
constexpr int RW_ROWS = 32;
constexpr int RW_BUF = (5 * RW_TC * 64 + RW_TC * RW_ROWS + RW_TC * RW_ROWS) * 4;
DI void phase_e3(char* lds, const Ctx& P, int li, int probe = 0) {
    const bfr* u = (const bfr*)(P.ws + OFF_U);
    const float* mu = P.in[I_MU] + (size_t)li * 1792;
    const float* dlog = (const float*)(P.ws + OFF_DLOG);
    const bfr* ab = (const bfr*)(P.ws + OFF_ABUF);
    const bfr* vg = (const bfr*)(P.ws + OFF_VGATE);
    const bfr* vf = (const bfr*)(P.ws + OFF_VFIRST);
    float* yout = (float*)(P.ws + (probe ? OFF_HID : OFF_Y));
    float* bonus = (float*)(P.ws + (probe ? OFF_HID : OFF_BONUS));
    const int tid = ltid(), lane = tid & 63, wave = tid >> 6;
    const int pstep = tid >> 4, pc0 = (tid & 15) * 4;
    for (int item = blockIdx.x; item < 256; item += gridDim.x) {
        const int bh = item >> 1, qtr = item & 1;
        const int b = bh >> 3, h = bh & 7;
        const int i0 = qtr * RW_ROWS;
        float c_mur[4], c_muk[4], c_muv[4], c_kk[4], c_ka[4], c_rk[4];
#pragma unroll
        for (int j = 0; j < 4; ++j) {
            const int c = h * 64 + pc0 + j;
            c_mur[j] = mu[c]; c_muk[j] = mu[512 + c]; c_muv[j] = mu[1024 + c];
            c_kk[j] = P.in[I_KK][li * 512 + c]; c_ka[j] = P.in[I_KA][li * 512 + c]; c_rk[j] = P.in[I_RK][li * 512 + c];
        }
        float S0 = 0.f, S1 = 0.f, S2 = 0.f, S3 = 0.f;
        const int rloc = wave * 4 + (lane >> 4);
        const int j0 = (lane & 15) * 4;
        const bool mine = ((pc0 >> 5) == qtr);
        uint2 g_ur, g_uk, g_uv, g_pr, g_pk, g_pv, g_a, g_vg, g_vf; float4 g_d;
#define E3_GLOAD(c_) do { const int t_ = (c_) * RW_TC + pstep; const size_t tok_ = (size_t)b * SEQ + t_; \
            const bfr* row_ = u + tok_ * EVEN_IN + h * 64 + pc0; const bfr* prow_ = row_ - (t_ > 0 ? EVEN_IN : 0); \
            g_ur = *(const uint2*)(row_); g_uk = *(const uint2*)(row_ + 512); g_uv = *(const uint2*)(row_ + 1024); \
            g_pr = *(const uint2*)(prow_); g_pk = *(const uint2*)(prow_ + 512); g_pv = *(const uint2*)(prow_ + 1024); \
            const size_t o_ = tok_ * 512 + h * 64 + pc0; \
            g_a = *(const uint2*)(ab + o_); g_d = *(const float4*)(dlog + o_); \
            if (li == 1) { g_vg = *(const uint2*)(vg + o_); g_vf = *(const uint2*)(vf + o_); } } while (0)
#define E3_PREP(c_, buf_) do { const int t_ = (c_) * RW_TC + pstep; const size_t o_ = ((size_t)b * SEQ + t_) * 512 + h * 64 + pc0; \
            float* sw_ = (float*)(lds + (buf_) * RW_BUF); float* sa_ = sw_ + RW_TC * 64; float* sb_ = sa_ + RW_TC * 64; float* sk_ = sb_ + RW_TC * 64; \
            float* sr_ = sk_ + RW_TC * 64; float* sv_ = sr_ + RW_TC * 64; \
            const float pz_ = t_ > 0 ? 1.f : 0.f; \
            const float ur_[4] = {bflo(g_ur.x), bfhi(g_ur.x), bflo(g_ur.y), bfhi(g_ur.y)}, uk_[4] = {bflo(g_uk.x), bfhi(g_uk.x), bflo(g_uk.y), bfhi(g_uk.y)}; \
            const float uv_[4] = {bflo(g_uv.x), bfhi(g_uv.x), bflo(g_uv.y), bfhi(g_uv.y)}; \
            const float pr_[4] = {bflo(g_pr.x), bfhi(g_pr.x), bflo(g_pr.y), bfhi(g_pr.y)}, pk_[4] = {bflo(g_pk.x), bfhi(g_pk.x), bflo(g_pk.y), bfhi(g_pk.y)}; \
            const float pv_[4] = {bflo(g_pv.x), bfhi(g_pv.x), bflo(g_pv.y), bfhi(g_pv.y)}; \
            const float av_[4] = {bflo(g_a.x), bfhi(g_a.x), bflo(g_a.y), bfhi(g_a.y)}; \
            const float dl_[4] = {g_d.x, g_d.y, g_d.z, g_d.w}; \
            float gv_[4] = {0.f, 0.f, 0.f, 0.f}, fv_[4] = {0.f, 0.f, 0.f, 0.f}; \
            if (li == 1) { gv_[0] = bflo(g_vg.x); gv_[1] = bfhi(g_vg.x); gv_[2] = bflo(g_vg.y); gv_[3] = bfhi(g_vg.y); \
                           fv_[0] = bflo(g_vf.x); fv_[1] = bfhi(g_vf.x); fv_[2] = bflo(g_vf.y); fv_[3] = bfhi(g_vf.y); } \
            float kkr_[4], kmod_[4], rr_[4], vv_[4]; float ssq_ = 0.f, bsum_ = 0.f; \
            _Pragma("unroll") for (int j = 0; j < 4; ++j) { \
                rr_[j] = ur_[j] + (pz_ * pr_[j] - ur_[j]) * c_mur[j]; \
                const float k_ = uk_[j] + (pz_ * pk_[j] - uk_[j]) * c_muk[j]; \
                float v_ = uv_[j] + (pz_ * pv_[j] - uv_[j]) * c_muv[j]; \
                if (li == 1) v_ = v_ + (fv_[j] - v_) * gv_[j]; \
                vv_[j] = v_; kkr_[j] = k_ * c_kk[j]; ssq_ += kkr_[j] * kkr_[j]; \
                kmod_[j] = k_ * (1.0f + (av_[j] - 1.0f) * c_ka[j]); bsum_ += rr_[j] * kmod_[j] * c_rk[j]; } \
            ssq_ = row16_sum(ssq_); bsum_ = row16_sum(bsum_); \
            const float inv_ = frcp(fmaxf(sqrtf(ssq_), 1e-12f)); \
            float4 w4_, a4_, b4_; \
            w4_.x = fexp(dl_[0]); w4_.y = fexp(dl_[1]); w4_.z = fexp(dl_[2]); w4_.w = fexp(dl_[3]); \
            a4_.x = -kkr_[0] * inv_; a4_.y = -kkr_[1] * inv_; a4_.z = -kkr_[2] * inv_; a4_.w = -kkr_[3] * inv_; \
            b4_.x = -a4_.x * av_[0]; b4_.y = -a4_.y * av_[1]; b4_.z = -a4_.z * av_[2]; b4_.w = -a4_.w * av_[3]; \
            *(float4*)(sw_ + pstep * 64 + pc0) = w4_; *(float4*)(sa_ + pstep * 64 + pc0) = a4_; *(float4*)(sb_ + pstep * 64 + pc0) = b4_; \
            *(float4*)(sk_ + pstep * 64 + pc0) = make_float4(kmod_[0], kmod_[1], kmod_[2], kmod_[3]); \
            *(float4*)(sr_ + pstep * 64 + pc0) = make_float4(rr_[0], rr_[1], rr_[2], rr_[3]); \
            if (mine) { *(float4*)(sv_ + pstep * RW_ROWS + (pc0 & 31)) = make_float4(vv_[0], vv_[1], vv_[2], vv_[3]); \
                        *(float4*)(bonus + o_) = make_float4(bsum_ * vv_[0], bsum_ * vv_[1], bsum_ * vv_[2], bsum_ * vv_[3]); } } while (0)
        __syncthreads();
        E3_GLOAD(0);
        E3_PREP(0, 0);
        __syncthreads();
        constexpr int NCH = SEQ / RW_TC;
#pragma unroll 1
        for (int c = 0; c < NCH; ++c) {
            const int buf = c & 1;
            if (c + 1 < NCH && probe != 2) E3_GLOAD(c + 1);
            if (probe != 1) {
                const float* s_w = (const float*)(lds + buf * RW_BUF); const float* s_a = s_w + RW_TC * 64; const float* s_b = s_a + RW_TC * 64;
                const float* s_k = s_b + RW_TC * 64; const float* s_r = s_k + RW_TC * 64; const float* s_v = s_r + RW_TC * 64;
                float* s_y = (float*)(s_v + RW_TC * RW_ROWS);
                float4 na4 = *(const float4*)(s_a + j0), nw4 = *(const float4*)(s_w + j0), nb4 = *(const float4*)(s_b + j0);
                float4 nk4 = *(const float4*)(s_k + j0), nr4 = *(const float4*)(s_r + j0);
                float nvi = s_v[rloc];
#pragma unroll 1
                for (int sg = 0; sg < RW_TC; sg += 4) {
                    float yv[4];
#pragma unroll
                    for (int q = 0; q < 4; ++q) {
                        const int sn = (sg + q + 1) & (RW_TC - 1);
                        const float4 a4 = na4, w4 = nw4, b4 = nb4, k4 = nk4, r4 = nr4; const float vi = nvi;
                        na4 = *(const float4*)(s_a + sn * 64 + j0); nw4 = *(const float4*)(s_w + sn * 64 + j0); nb4 = *(const float4*)(s_b + sn * 64 + j0);
                        nk4 = *(const float4*)(s_k + sn * 64 + j0); nr4 = *(const float4*)(s_r + sn * 64 + j0); nvi = s_v[sn * RW_ROWS + rloc];
                        float sa = dot4n(S0, S1, S2, S3, a4);
                        sa = row16_sum(sa);
                        rw_upd(S0, w4.x, sa, b4.x, vi, k4.x);
                        rw_upd(S1, w4.y, sa, b4.y, vi, k4.y);
                        rw_upd(S2, w4.z, sa, b4.z, vi, k4.z);
                        rw_upd(S3, w4.w, sa, b4.w, vi, k4.w);
                        const float y = dot4n(S0, S1, S2, S3, r4);
                        yv[q] = row16_sum(y);
                    }
                    const int ls = lane & 3;
                    const float yo = ls == 0 ? yv[0] : (ls == 1 ? yv[1] : (ls == 2 ? yv[2] : yv[3]));
                    if ((lane & 15) < 4) s_y[(sg + ls) * RW_ROWS + rloc] = yo;
                }
            }
            if (c + 1 < NCH && probe != 2) E3_PREP(c + 1, buf ^ 1);
            __syncthreads();
            {
                const float* s_y = (const float*)(lds + buf * RW_BUF) + 5 * RW_TC * 64 + RW_TC * RW_ROWS;
#pragma unroll
                for (int q = 0; q < RW_TC * RW_ROWS / NTHREADS; ++q) {
                    const int idx = q * NTHREADS + tid;
                    const int s = idx >> 5, r = idx & 31;
                    yout[((size_t)b * SEQ + c * RW_TC + s) * 512 + h * 64 + i0 + r] = s_y[idx];
                }
            }
        }
#undef E3_GLOAD
#undef E3_PREP
    }
}

DI void phase_e4(const Ctx& P, int li) {
    const bfr* __restrict__ y = (const bfr*)(P.ws + OFF_Y);
    const bfr* __restrict__ bonus = (const bfr*)(P.ws + OFF_BONUS);
    const bfr* __restrict__ gb = (const bfr*)(P.ws + OFF_GBUF);
    const float* __restrict__ lng = P.in[I_LNG] + li * 512;
    const float* __restrict__ lnb = P.in[I_LNB] + li * 512;
    bfr* __restrict__ am = (bfr*)(P.ws + OFF_AMIX);
    const int total = NTOK * 64;
    constexpr int UN = 4;
    const int gsz = gridDim.x * NTHREADS;
    for (int idx0 = blockIdx.x * NTHREADS + ltid(); idx0 < total; idx0 += gsz * UN) {
        uint4 yv[UN], bv[UN], gv4[UN];
#pragma unroll
        for (int q = 0; q < UN; ++q) {
            int idx = idx0 + q * gsz; idx = idx < total ? idx : total - 1;
            const size_t o = (size_t)(idx >> 6) * 512 + (idx & 63) * 8;
            yv[q] = *(const uint4*)(y + o); bv[q] = *(const uint4*)(bonus + o); gv4[q] = *(const uint4*)(gb + o);
        }
#pragma unroll
        for (int q = 0; q < UN; ++q) {
            const int idx = idx0 + q * gsz;
            const int tok = idx >> 6, c = (idx & 63) * 8;
            float v[8], bo[8], gv[8];
            unpack8(yv[q], v); unpack8(bv[q], bo); unpack8(gv4[q], gv);
            float s = 0.f;
#pragma unroll
            for (int j = 0; j < 8; ++j) s += v[j];
            s += __shfl_xor(s, 1); s += __shfl_xor(s, 2); s += __shfl_xor(s, 4);
            const float mean = s * (1.0f / 64.0f);
            float qq = 0.f;
#pragma unroll
            for (int j = 0; j < 8; ++j) { v[j] -= mean; qq += v[j] * v[j]; }
            qq += __shfl_xor(qq, 1); qq += __shfl_xor(qq, 2); qq += __shfl_xor(qq, 4);
            const float rstd = rsqrtf(qq * (1.0f / 64.0f) + 64e-5f);
            float out[8];
#pragma unroll
            for (int j = 0; j < 8; ++j) out[j] = (v[j] * rstd * lng[c + j] + lnb[c + j] + bo[j]) * gv[j];
            if (idx < total) *(uint4*)(am + (size_t)tok * 1024 + c) = pack8(out);
        }
    }
}

DI void phase_wout(char* lds, const Ctx& P, const bfr* w, bfr* mix) {
    const bfr* am = (const bfr*)(P.ws + OFF_AMIX);
    p8::PlainSched S{(const char*)am, (const char*)w, 128, 4, 512, (size_t)256 * 1024 * 2};
    p8::gemm_phase<true, false>(lds, 1024, S, [&](const p8::f32x4 (&acc)[2][2][4][2], const p8::Unit& un, int wr, int wc, int fr, int fq) __attribute__((always_inline)) {
        bfr* o = mix + (size_t)(un.pm * 256 + wr * 64 + fr) * DM + un.pn * 256 + wc * 32 + 8 * fq;
#pragma unroll
        for (int ai = 0; ai < 2; ++ai)
#pragma unroll
            for (int m = 0; m < 4; ++m)
#pragma unroll
                for (int bj = 0; bj < 2; ++bj)
                    p8::st16(o + (size_t)(ai * 128 + m * 16) * DM + bj * 128, p8::pack_bf8(acc[ai][bj][m][0], acc[ai][bj][m][1]));
    });
    __syncthreads();
}
constexpr int RC_L = 32;
constexpr int RC_NCH = SEQ / RC_L;
constexpr int RC_RM = 72;
constexpr int RC_TR = 40;
constexpr int RC_OFF_LG  = 0;
constexpr int RC_OFF_AH  = 8192;
constexpr int RC_OFF_AHT = RC_OFF_AH + 4 * 32 * RC_RM * 2;
constexpr int RC_TRB = 64 * RC_TR * 2 + 8 * 16;
constexpr int RC_OFF_FA  = RC_OFF_AHT + 4 * RC_TRB;
constexpr int RC_OFF_MA  = RC_OFF_FA + 2 * 32 * RC_TR * 2;
constexpr int RC_OFF_W2T = RC_OFF_MA + 4 * 32 * RC_TR * 2;
constexpr int RC_OFF_GL  = RC_OFF_W2T + RC_TRB;
constexpr int RC_LDS_END = RC_OFF_GL + 256;
static_assert(RC_LDS_END <= G4_AUX, "chunk scratch must fit a 4-wave group's LDS");


DI int rc_tro(int c) { return c * (RC_TR * 2) + (c >> 3) * 16; }
DI bf16x8 rc_ld16(const char* p) { return *(const bf16x8*)p; }
DI bf16x8 rc_ld8x2(const char* p) {
    const uint2 a = *(const uint2*)p, b = *(const uint2*)(p + 16);
    return __builtin_bit_cast(bf16x8, make_uint4(a.x, a.y, b.x, b.y));
}
DI bf16x8 rc_pack(const f32x16& x, int s) {
    return __builtin_bit_cast(bf16x8, make_uint4(pk2(x[8 * s], x[8 * s + 1]), pk2(x[8 * s + 2], x[8 * s + 3]), pk2(x[8 * s + 4], x[8 * s + 5]), pk2(x[8 * s + 6], x[8 * s + 7])));
}
DI f32x16 rc_zero() { f32x16 z; _Pragma("unroll") for (int r = 0; r < 16; ++r) z[r] = 0.f; return z; }

DI void phase_r1(char* lds0, const Ctx& P, int li, int probe = 0) {
    const G4 G = g4_make(lds0);
    char* lds = G.lds;
    const int tid = G.tid, lane = tid & 63, wave = tid >> 6;
    const int ln = lane & 31, hf = lane >> 5;
    const bfr* u = (const bfr*)(P.ws + OFF_U);
    const float* mu = P.in[I_MU] + (size_t)li * 1792;
    const float* dlog = (const float*)(P.ws + OFF_DLOG);
    const bfr* ab = (const bfr*)(P.ws + OFF_ABUF);
    const bfr* vg = (const bfr*)(P.ws + OFF_VGATE);
    const bfr* vf = (const bfr*)(P.ws + OFF_VFIRST);
    bfr* bonus = (bfr*)(P.ws + OFF_BONUS);
    bfr* gG = (bfr*)(P.ws + OFF_RCG); bfr* gH = (bfr*)(P.ws + OFF_RCH); bfr* gQ = (bfr*)(P.ws + OFF_RCQ); bfr* gZ = (bfr*)(P.ws + OFF_RCZ);
    char* s_rm = lds + RC_OFF_AH;
    char* s_tr = lds + RC_OFF_AHT;
    char* s_im = lds + RC_OFF_FA;
    char* s_ma = lds + RC_OFF_MA;
    char* s_w2t = lds + RC_OFF_W2T;
    float* s_gl = (float*)(lds + RC_OFF_GL);
    constexpr int RMB = 32 * RC_RM * 2, TRB = RC_TRB, MAB = 32 * RC_TR * 2;
    const int ps = tid >> 3, pc0 = (tid & 7) * 8;
    float* s_cst = (float*)(lds + G4_AUX);
    float* s_tot = s_cst + 6 * 64;
    {
        const int h0 = (G.vb >> 6) & 7;
        if (tid < 64) {
            s_cst[0 * 64 + tid] = mu[h0 * 64 + tid]; s_cst[1 * 64 + tid] = mu[512 + h0 * 64 + tid]; s_cst[2 * 64 + tid] = mu[1024 + h0 * 64 + tid];
            s_cst[3 * 64 + tid] = P.in[I_KK][li * 512 + h0 * 64 + tid]; s_cst[4 * 64 + tid] = P.in[I_KA][li * 512 + h0 * 64 + tid]; s_cst[5 * 64 + tid] = P.in[I_RK][li * 512 + h0 * 64 + tid];
        }
        g4_bar(G);
    }
    uint4 g_ur, g_pr, g_uk, g_pk, g_uv, g_pv, g_a, g_vg, g_vf; float4 g_d0, g_d1;
#define RC_PREF(item_) do { const int bh_ = (item_) >> 6, c_ = (item_) & 63; const int t_ = c_ * RC_L + ps; const size_t tok_ = (size_t)(bh_ >> 3) * SEQ + t_; \
        const bfr* row_ = u + tok_ * EVEN_IN + (bh_ & 7) * 64 + pc0; const bfr* prow_ = row_ - (t_ > 0 ? EVEN_IN : 0); const size_t o_ = tok_ * 512 + (bh_ & 7) * 64 + pc0; \
        g_ur = *(const uint4*)row_; g_uk = *(const uint4*)(row_ + 512); g_uv = *(const uint4*)(row_ + 1024); \
        g_pr = *(const uint4*)prow_; g_pk = *(const uint4*)(prow_ + 512); g_pv = *(const uint4*)(prow_ + 1024); \
        g_a = *(const uint4*)(ab + o_); g_d0 = *(const float4*)(dlog + o_); g_d1 = *(const float4*)(dlog + o_ + 4); \
        if (li == 1) { g_vg = *(const uint4*)(vg + o_); g_vf = *(const uint4*)(vf + o_); } } while (0)
    if (G.vb < 128 * RC_NCH) RC_PREF(G.vb);
    for (int item = G.vb; item < 128 * RC_NCH; item += G.nvb) {
        const int bh = item >> 6, c = item & 63;
        const int b = bh >> 3, h = bh & 7;
        float lg[8], dl_[8];
        {
            float a_[8], b_[8], k_[8], r_[8], v_[8];
            const int t = c * RC_L + ps;
            const size_t tok = (size_t)b * SEQ + t;
            const float pz = t > 0 ? 1.f : 0.f;
            const size_t o512 = tok * 512 + h * 64 + pc0;
            float av[8];
            unpack8(g_a, av);
            float c8[8], m8[8], x8[8], y8[8];
#define RC_LD8(dst_, src_) { const float4 x0_ = *(const float4*)(src_), x1_ = *(const float4*)((src_) + 4); dst_[0] = x0_.x; dst_[1] = x0_.y; dst_[2] = x0_.z; dst_[3] = x0_.w; dst_[4] = x1_.x; dst_[5] = x1_.y; dst_[6] = x1_.z; dst_[7] = x1_.w; }
            unpack8(g_ur, x8); unpack8(g_pr, y8); RC_LD8(m8, s_cst + 0 * 64 + pc0)
#pragma unroll
            for (int j = 0; j < 8; ++j) r_[j] = x8[j] + (pz * y8[j] - x8[j]) * m8[j];
            unpack8(g_uk, x8); unpack8(g_pk, y8); RC_LD8(m8, s_cst + 1 * 64 + pc0)
            float kx[8], kkr[8]; float ssq = 0.f, bsum = 0.f;
            RC_LD8(c8, s_cst + 3 * 64 + pc0)
#pragma unroll
            for (int j = 0; j < 8; ++j) { kx[j] = x8[j] + (pz * y8[j] - x8[j]) * m8[j]; kkr[j] = kx[j] * c8[j]; ssq += kkr[j] * kkr[j]; }
            RC_LD8(c8, s_cst + 4 * 64 + pc0)
#pragma unroll
            for (int j = 0; j < 8; ++j) k_[j] = kx[j] * (1.0f + (av[j] - 1.0f) * c8[j]);
            RC_LD8(c8, s_cst + 5 * 64 + pc0)
#pragma unroll
            for (int j = 0; j < 8; ++j) bsum += r_[j] * k_[j] * c8[j];
            unpack8(g_uv, x8); unpack8(g_pv, y8); RC_LD8(m8, s_cst + 2 * 64 + pc0)
#pragma unroll
            for (int j = 0; j < 8; ++j) v_[j] = x8[j] + (pz * y8[j] - x8[j]) * m8[j];
            if (li == 1) {
                unpack8(g_vg, x8); unpack8(g_vf, y8);
#pragma unroll
                for (int j = 0; j < 8; ++j) v_[j] = v_[j] + (y8[j] - v_[j]) * x8[j];
            }
#undef RC_LD8
            ssq += __shfl_xor(ssq, 1); ssq += __shfl_xor(ssq, 2); ssq += __shfl_xor(ssq, 4);
            bsum += __shfl_xor(bsum, 1); bsum += __shfl_xor(bsum, 2); bsum += __shfl_xor(bsum, 4);
            const float inv = frcp(fmaxf(sqrtf(ssq), 1e-12f));
#pragma unroll
            for (int j = 0; j < 8; ++j) { const float kk = kkr[j] * inv; a_[j] = -kk; b_[j] = kk * av[j]; }
            { float bo[8];
#pragma unroll
              for (int j = 0; j < 8; ++j) bo[j] = bsum * v_[j];
              *(uint4*)(bonus + o512) = pack8(bo); }
#pragma unroll
            for (int j = 0; j < 8; ++j) *(bfr*)(s_tr + 3 * TRB + rc_tro(pc0 + j) + ps * 2) = f2bf(v_[j]);
            dl_[0] = g_d0.x; dl_[1] = g_d0.y; dl_[2] = g_d0.z; dl_[3] = g_d0.w; dl_[4] = g_d1.x; dl_[5] = g_d1.y; dl_[6] = g_d1.z; dl_[7] = g_d1.w;
#pragma unroll
            for (int j = 0; j < 8; ++j) lg[j] = dl_[j];
#pragma unroll
            for (int d = 8; d < 64; d <<= 1) {
#pragma unroll
                for (int j = 0; j < 8; ++j) { const float o = __shfl_up(lg[j], d); lg[j] += (lane >= d) ? o : 0.f; }
            }
            *(uint4*)(s_rm + 0 * RMB + (ps * RC_RM + pc0) * 2) = pack8(a_);
            *(uint4*)(s_rm + 1 * RMB + (ps * RC_RM + pc0) * 2) = pack8(b_);
            *(uint4*)(s_rm + 2 * RMB + (ps * RC_RM + pc0) * 2) = pack8(k_);
            *(uint4*)(s_rm + 3 * RMB + (ps * RC_RM + pc0) * 2) = pack8(r_);
            if ((lane >> 3) == 7) { *(float4*)(s_tot + wave * 64 + pc0) = make_float4(lg[0], lg[1], lg[2], lg[3]); *(float4*)(s_tot + wave * 64 + pc0 + 4) = make_float4(lg[4], lg[5], lg[6], lg[7]); }
        }
        g4_bar(G);
        {
#pragma unroll
            for (int w2 = 0; w2 < 3; ++w2) {
                if (w2 < wave) {
                    const float4 e0 = *(const float4*)(s_tot + w2 * 64 + pc0), e1 = *(const float4*)(s_tot + w2 * 64 + pc0 + 4);
                    lg[0] += e0.x; lg[1] += e0.y; lg[2] += e0.z; lg[3] += e0.w; lg[4] += e1.x; lg[5] += e1.y; lg[6] += e1.z; lg[7] += e1.w;
                }
            }
            float ah[8], bhh[8], kh[8], rh[8];
            unpack8(*(const uint4*)(s_rm + 0 * RMB + (ps * RC_RM + pc0) * 2), ah);
            unpack8(*(const uint4*)(s_rm + 1 * RMB + (ps * RC_RM + pc0) * 2), bhh);
            unpack8(*(const uint4*)(s_rm + 2 * RMB + (ps * RC_RM + pc0) * 2), kh);
            unpack8(*(const uint4*)(s_rm + 3 * RMB + (ps * RC_RM + pc0) * 2), rh);
#pragma unroll
            for (int j = 0; j < 8; ++j) {
                const float ep = fexp(lg[j]), em = fexp(-lg[j]), ep1 = fexp(lg[j] - dl_[j]);
                ah[j] *= ep1; bhh[j] *= em; kh[j] *= em; rh[j] *= ep;
                if (ps == RC_L - 1) s_gl[pc0 + j] = ep;
            }
            *(uint4*)(s_rm + 0 * RMB + (ps * RC_RM + pc0) * 2) = pack8(ah);
            *(uint4*)(s_rm + 1 * RMB + (ps * RC_RM + pc0) * 2) = pack8(bhh);
            *(uint4*)(s_rm + 2 * RMB + (ps * RC_RM + pc0) * 2) = pack8(kh);
            *(uint4*)(s_rm + 3 * RMB + (ps * RC_RM + pc0) * 2) = pack8(rh);
#pragma unroll
            for (int j = 0; j < 8; ++j) {
                *(bfr*)(s_tr + 0 * TRB + rc_tro(pc0 + j) + ps * 2) = f2bf(ah[j]);
                *(bfr*)(s_tr + 1 * TRB + rc_tro(pc0 + j) + ps * 2) = f2bf(bhh[j]);
                *(bfr*)(s_tr + 2 * TRB + rc_tro(pc0 + j) + ps * 2) = f2bf(kh[j]);
            }
        }
        if (item + G.nvb < 128 * RC_NCH) RC_PREF(item + G.nvb);
        g4_bar(G);
        if (probe < 3) {
            const char* xa = s_rm + (wave < 2 ? 0 : 3) * RMB;
            const char* xb = s_rm + ((wave & 1) ? 2 : 1) * RMB;
            f32x16 acc = rc_zero();
#pragma unroll
            for (int ks = 0; ks < 4; ++ks)
                acc = MFMA32(rc_ld16(xa + (ln * RC_RM + ks * 16 + hf * 8) * 2), rc_ld16(xb + (ln * RC_RM + ks * 16 + hf * 8) * 2), acc);
#pragma unroll
            for (int r = 0; r < 16; ++r) {
                const int t = (r & 3) + 8 * (r >> 2) + 4 * hf;
                const bool keep = (wave < 2) ? (ln < t) : (ln <= t);
                acc[r] = keep ? acc[r] : 0.f;
                if (wave != 0) *(bfr*)(s_ma + (wave - 1) * MAB + (t * RC_TR + ln) * 2) = f2bf(acc[r]);
            }
            if (wave == 0 && probe < 2) {
                f32x16 Ap = acc, Pa = acc;
#pragma unroll
                for (int r = 0; r < 16; ++r) { const int t = (r & 3) + 8 * (r >> 2) + 4 * hf; Pa[r] += (t == ln) ? 1.f : 0.f; }
                char* imA = s_im; char* imH = s_im + MAB;
#pragma unroll 1
                for (int it = 0; it < 4; ++it) {
#pragma unroll
                    for (int r = 0; r < 16; ++r) {
                        const int t = (r & 3) + 8 * (r >> 2) + 4 * hf;
                        *(bfr*)(imA + (t * RC_TR + ln) * 2) = f2bf(Ap[r]);
                        *(bfr*)(imH + (t * RC_TR + ln) * 2) = f2bf(Pa[r]);
                    }
                    const bf16x8 a0 = rc_pack(Ap, 0), a1 = rc_pack(Ap, 1);
                    const int ro = (ln * RC_TR + 4 * hf) * 2;
                    f32x16 An = rc_zero();
                    An = MFMA32(rc_ld8x2(imA + ro), a0, An);
                    An = MFMA32(rc_ld8x2(imA + ro + 32), a1, An);
                    Ap = An;
                    const bf16x8 b0 = rc_pack(Ap, 0), b1 = rc_pack(Ap, 1);
                    Pa = MFMA32(rc_ld8x2(imH + ro), b0, Pa); Pa = MFMA32(rc_ld8x2(imH + ro + 32), b1, Pa);
                }
#pragma unroll
                for (int r = 0; r < 16; ++r) { const int t = (r & 3) + 8 * (r >> 2) + 4 * hf; *(bfr*)(s_ma + 3 * MAB + (t * RC_TR + ln) * 2) = f2bf(Pa[r]); }
            } else if (wave == 1) {
#pragma unroll
                for (int it = 0; it < 2; ++it) {
                    f32x16 w2 = rc_zero();
#pragma unroll
                    for (int ks = 0; ks < 2; ++ks)
                        w2 = MFMA32(rc_ld16(s_ma + 0 * MAB + (ln * RC_TR + ks * 16 + hf * 8) * 2), rc_ld16(s_tr + 3 * TRB + rc_tro(it * 32 + ln) + (ks * 16 + hf * 8) * 2), w2);
#pragma unroll
                    for (int q = 0; q < 4; ++q)
                        *(uint2*)(s_w2t + rc_tro(it * 32 + ln) + (8 * q + 4 * hf) * 2) = make_uint2(pk2(w2[4 * q], w2[4 * q + 1]), pk2(w2[4 * q + 2], w2[4 * q + 3]));
                }
            }
        }
        g4_bar(G);
        if (probe < 1) {
            const int hp = wave & 1;
            const size_t chunk = (size_t)bh * RC_NCH + c;
            const char* tm = s_ma + 3 * MAB;
            const char* bsrc = (wave < 2) ? (s_tr + 0 * TRB) : s_w2t;
            f32x16 X = rc_zero();
#pragma unroll
            for (int ks = 0; ks < 2; ++ks)
                X = MFMA32(rc_ld16(tm + (ln * RC_TR + ks * 16 + hf * 8) * 2), rc_ld16(bsrc + rc_tro(hp * 32 + ln) + (ks * 16 + hf * 8) * 2), X);
            const bf16x8 xf0 = rc_pack(X, 0), xf1 = rc_pack(X, 1);
            const char* arb = s_ma + 1 * MAB; const char* ark = s_ma + 2 * MAB;
            if (wave < 2) {
#pragma unroll
                for (int jt = 0; jt < 2; ++jt) {
                    f32x16 acc = rc_zero();
                    const char* bp = s_tr + 1 * TRB + rc_tro(jt * 32 + ln) + 8 * hf;
                    acc = MFMA32(xf0, rc_ld8x2(bp), acc);
                    acc = MFMA32(xf1, rc_ld8x2(bp + 32), acc);
                    const int j = jt * 32 + ln;
                    const float gl = s_gl[j];
                    bfr* dst = gG + chunk * 4096 + (size_t)j * 64 + hp * 32 + 4 * hf;
#pragma unroll
                    for (int q = 0; q < 4; ++q) {
                        float o[4];
#pragma unroll
                        for (int e = 0; e < 4; ++e) { const int jp = hp * 32 + 8 * q + 4 * hf + e; o[e] = gl * (acc[4 * q + e] + (jp == j ? 1.f : 0.f)); }
                        *(uint2*)(dst + 8 * q) = make_uint2(pk2(o[0], o[1]), pk2(o[2], o[3]));
                    }
                }
                {
                    f32x16 acc = rc_zero();
                    const char* bp = arb + (ln * RC_TR + 4 * hf) * 2;
                    acc = MFMA32(xf0, rc_ld8x2(bp), acc);
                    acc = MFMA32(xf1, rc_ld8x2(bp + 32), acc);
                    bfr* dst = gQ + chunk * 2048 + (size_t)ln * 64 + hp * 32 + 4 * hf;
                    const char* rsrc = s_rm + 3 * RMB + (ln * RC_RM + hp * 32 + 4 * hf) * 2;
#pragma unroll
                    for (int q = 0; q < 4; ++q) {
                        const uint2 rr = *(const uint2*)(rsrc + 16 * q);
                        *(uint2*)(dst + 8 * q) = make_uint2(pk2(acc[4 * q] + bflo(rr.x), acc[4 * q + 1] + bfhi(rr.x)), pk2(acc[4 * q + 2] + bflo(rr.y), acc[4 * q + 3] + bfhi(rr.y)));
                    }
                }
            } else {
#pragma unroll
                for (int jt = 0; jt < 2; ++jt) {
                    f32x16 acc = rc_zero();
                    const char* ap = s_tr + 1 * TRB + rc_tro(jt * 32 + ln) + 8 * hf;
                    acc = MFMA32(rc_ld8x2(ap), xf0, acc);
                    acc = MFMA32(rc_ld8x2(ap + 32), xf1, acc);
#pragma unroll
                    for (int ks = 0; ks < 2; ++ks)
                        acc = MFMA32(rc_ld16(s_tr + 2 * TRB + rc_tro(jt * 32 + ln) + (ks * 16 + hf * 8) * 2), rc_ld16(s_tr + 3 * TRB + rc_tro(hp * 32 + ln) + (ks * 16 + hf * 8) * 2), acc);
                    bfr* dst = gH + chunk * 4096 + (size_t)(hp * 32 + ln) * 64 + jt * 32 + 4 * hf;
#pragma unroll
                    for (int q = 0; q < 4; ++q) {
                        const float4 gl = *(const float4*)(s_gl + jt * 32 + 8 * q + 4 * hf);
                        *(uint2*)(dst + 8 * q) = make_uint2(pk2(gl.x * acc[4 * q], gl.y * acc[4 * q + 1]), pk2(gl.z * acc[4 * q + 2], gl.w * acc[4 * q + 3]));
                    }
                }
                {
                    f32x16 acc = rc_zero();
                    const char* bp = arb + (ln * RC_TR + 4 * hf) * 2;
                    acc = MFMA32(xf0, rc_ld8x2(bp), acc);
                    acc = MFMA32(xf1, rc_ld8x2(bp + 32), acc);
#pragma unroll
                    for (int ks = 0; ks < 2; ++ks)
                        acc = MFMA32(rc_ld16(s_tr + 3 * TRB + rc_tro(hp * 32 + ln) + (ks * 16 + hf * 8) * 2), rc_ld16(ark + (ln * RC_TR + ks * 16 + hf * 8) * 2), acc);
                    bfr* dst = gZ + chunk * 2048 + (size_t)ln * 64 + hp * 32 + 4 * hf;
#pragma unroll
                    for (int q = 0; q < 4; ++q) *(uint2*)(dst + 8 * q) = make_uint2(pk2(acc[4 * q], acc[4 * q + 1]), pk2(acc[4 * q + 2], acc[4 * q + 3]));
                }
            }
        }
        g4_bar(G);
    }
}

DI bf16x8 rc_join(uint2 a, uint2 b) { return __builtin_bit_cast(bf16x8, make_uint4(a.x, a.y, b.x, b.y)); }
struct RcG { uint2 g[16]; };
DI void rc_load_g(RcG& f, const bfr* Gc, int ln, int hf) {
#pragma unroll
    for (int x = 0; x < 4; ++x) {
        const int o = (x >> 1) * 32 + (x & 1) * 16 + 4 * hf;
        f.g[4 * x] = *(const uint2*)(Gc + (size_t)ln * 64 + o);            f.g[4 * x + 1] = *(const uint2*)(Gc + (size_t)ln * 64 + o + 8);
        f.g[4 * x + 2] = *(const uint2*)(Gc + (size_t)(32 + ln) * 64 + o); f.g[4 * x + 3] = *(const uint2*)(Gc + (size_t)(32 + ln) * 64 + o + 8);
    }
}
DI void phase_r2(char* lds, const Ctx& P, int li, int layer, int cvt_t0, int cvt_tm) {
    const int tid = ltid(), lane = tid & 63, wave = tid >> 6;
    const int ln = lane & 31, hf = lane >> 5;
    const bfr* gG = (const bfr*)(P.ws + OFF_RCG); const bfr* gH = (const bfr*)(P.ws + OFF_RCH); const bfr* gQ = (const bfr*)(P.ws + OFF_RCQ); const bfr* gZ = (const bfr*)(P.ws + OFF_RCZ);
    bfr* yout = (bfr*)(P.ws + OFF_Y);
    if (wave == 1 || wave == 2 || wave == 3 || wave == 5) {
        G4 G;
        G.lds = lds + G4_LDS; G.tid = (wave < 4 ? wave - 1 : 3) * 64 + lane; G.vb = 0; G.nvb = 1;
        G.cnt = (volatile LAS unsigned*)(lds + LDS_BYTES - 32) + 1;
        const bfr* S_ = (const bfr*)(P.ws + OFF_S);
        const bfr* e1 = (const bfr*)(P.ws + OFF_E2B1) + (size_t)li * 1536 * 256;
        const bfr* e2 = (const bfr*)(P.ws + OFF_E2B2) + (size_t)li * 2 * 256 * 256;
        const bfr* dpool = (const bfr*)(P.ws + OFF_DPOOL);
        const float* ps = P.in[I_POOLS] + li * 512;
        bfr* gb = (bfr*)(P.ws + OFF_GBUF);
        bfr* am = (bfr*)(P.ws + OFF_AMIX);
        for (int t = blockIdx.x; t < 2048; t += gridDim.x) {
            const int mt = t >> 3, j = t & 7, nt = j & 3;
            const int m0 = mt * 128;
            if (j < 4) {
                G4RowLoader A(G, S_ + 128, m0, 256), B(G, e1 + (size_t)1024 * 256 + 128, nt * 128, 256);
                g4_gemm_tile(G, G.lds, 2, A, B, [&](const float* stg) __attribute__((always_inline)) {
                    g4_epi_rows8(G, stg, [&](int r, int c0, const float (&v)[8]) __attribute__((always_inline)) {
                        *(uint4*)(gb + (size_t)(m0 + r) * 512 + nt * 128 + c0) = pack8(v);
                    });
                });
            } else {
                G4RowLoader A(G, dpool + nt * 128, m0, 512), B(G, e2 + ((size_t)(nt >> 1) * 256 + (nt & 1) * 128) * 256 + (nt & 1) * 128, 0, 256);
                g4_gemm_tile(G, G.lds, 2, A, B, [&](const float* stg) __attribute__((always_inline)) {
                    g4_epi_rows8(G, stg, [&](int r, int c0, const float (&v)[8]) __attribute__((always_inline)) {
                        float o[8];
#pragma unroll
                        for (int q = 0; q < 8; ++q) o[q] = v[q] * ps[nt * 128 + c0 + q];
                        *(uint4*)(am + (size_t)(m0 + r) * 1024 + 512 + nt * 128 + c0) = pack8(o);
                    });
                });
            }
        }
        g4_moe_convert_range(G, P, layer, cvt_t0, cvt_tm);
        return;
    }
    if (wave != 0) return;
#define RC_LOAD_ALL(GV, QV, HV, ZV, ch_) do { const bfr* Hc_ = gH + (ch_) * 4096; const bfr* Qc_ = gQ + (ch_) * 2048; const bfr* Zc_ = gZ + (ch_) * 2048; \
        rc_load_g(GV, gG + (ch_) * 4096, ln, hf); \
        _Pragma("unroll") for (int x = 0; x < 4; ++x) { const int o_ = (x >> 1) * 32 + (x & 1) * 16 + 4 * hf; \
            QV[2 * x] = *(const uint2*)(Qc_ + (size_t)ln * 64 + o_); QV[2 * x + 1] = *(const uint2*)(Qc_ + (size_t)ln * 64 + o_ + 8); } \
        _Pragma("unroll") for (int q = 0; q < 4; ++q) { ZV[q] = *(const uint2*)(Zc_ + (size_t)ln * 64 + ic * 32 + 4 * hf + 8 * q); \
            HV[q] = *(const uint2*)(Hc_ + (size_t)(ic * 32 + ln) * 64 + 4 * hf + 8 * q); HV[4 + q] = *(const uint2*)(Hc_ + (size_t)(ic * 32 + ln) * 64 + 32 + 4 * hf + 8 * q); } } while (0)
#define RC_STEP(GV, QV, HV, ZV, c_) do { \
        bf16x8 mh[2][2]; \
        _Pragma("unroll") for (int ks = 0; ks < 2; ++ks) { mh[0][ks] = rc_pack(M0, ks); mh[1][ks] = rc_pack(M1, ks); } \
        f32x16 n0 = rc_zero(), n1 = rc_zero(), ya = rc_zero(); \
        _Pragma("unroll") for (int x = 0; x < 4; ++x) { \
            const bf16x8 g0 = rc_join(GV.g[4 * x], GV.g[4 * x + 1]), g1 = rc_join(GV.g[4 * x + 2], GV.g[4 * x + 3]); \
            n0 = MFMA32(g0, mh[x >> 1][x & 1], n0); n1 = MFMA32(g1, mh[x >> 1][x & 1], n1); \
            ya = MFMA32(mh[x >> 1][x & 1], rc_join(QV[2 * x], QV[2 * x + 1]), ya); } \
        bfr* yp = yout + ((size_t)b * SEQ + (c_) * RC_L + ln) * 512 + h * 64 + ic * 32 + 4 * hf; \
        _Pragma("unroll") for (int q = 0; q < 4; ++q) { const uint2 zz = ZV[q]; \
            *(uint2*)(yp + 8 * q) = make_uint2(pk2(ya[4 * q] + bflo(zz.x), ya[4 * q + 1] + bfhi(zz.x)), pk2(ya[4 * q + 2] + bflo(zz.y), ya[4 * q + 3] + bfhi(zz.y))); } \
        _Pragma("unroll") for (int q = 0; q < 4; ++q) { const uint2 h0 = HV[q], h1 = HV[4 + q]; \
            M0[4 * q] = n0[4 * q] + bflo(h0.x); M0[4 * q + 1] = n0[4 * q + 1] + bfhi(h0.x); M0[4 * q + 2] = n0[4 * q + 2] + bflo(h0.y); M0[4 * q + 3] = n0[4 * q + 3] + bfhi(h0.y); \
            M1[4 * q] = n1[4 * q] + bflo(h1.x); M1[4 * q + 1] = n1[4 * q + 1] + bfhi(h1.x); M1[4 * q + 2] = n1[4 * q + 2] + bflo(h1.y); M1[4 * q + 3] = n1[4 * q + 3] + bfhi(h1.y); } } while (0)
    for (int item = blockIdx.x; item < 256; item += gridDim.x) {
        const int bh = item >> 1, ic = item & 1;
        const int b = bh >> 3, h = bh & 7;
        f32x16 M0 = rc_zero(), M1 = rc_zero();
        const size_t ch0 = (size_t)bh * RC_NCH;
        RcG gA, gB; uint2 qA[8], hA[8], zA[4], qB[8], hB[8], zB[4];
        RC_LOAD_ALL(gA, qA, hA, zA, ch0);
#pragma unroll 1
        for (int c = 0; c < RC_NCH; c += 2) {
            RC_LOAD_ALL(gB, qB, hB, zB, ch0 + c + 1);
            RC_STEP(gA, qA, hA, zA, c);
            RC_LOAD_ALL(gA, qA, hA, zA, ch0 + (c + 2 < RC_NCH ? c + 2 : c));
            RC_STEP(gB, qB, hB, zB, c + 1);
        }
    }
#undef RC_LOAD_ALL
#undef RC_STEP
}
DI void phase_o1(char* lds, const Ctx& P, int li) {
    const bfr* hb = (const bfr*)(P.ws + OFF_HB);
    const bfr* w = (const bfr*)(P.ws + OFF_WINO) + (size_t)li * 2048 * 1024;
    bfr* qk = (bfr*)(P.ws + OFF_U);
    bfr* vT = (bfr*)(P.ws + OFF_VT);
    bfr* us5 = (bfr*)(P.ws + OFF_US5);
    struct O1Sched {
        const char* hb; const char* w;
        DI bool next(int i, p8::Unit& u) const { const int L = i * (int)gridDim.x + (int)blockIdx.x; if (L >= 1024) return false; tile_remap(L, 128, 8, u.pm, u.pn); u.x0 = (u.pn == 4 || u.pn == 5) ? 1 : 0; u.x1 = 0; return true; }
        DI const char* a_base(const p8::Unit& u) const { return u.x0 ? w + (size_t)u.pn * (256 * 1024 * 2) : hb + (size_t)u.pm * (256 * 1024 * 2); }
        DI const char* b_base(const p8::Unit& u) const { return u.x0 ? hb + (size_t)u.pm * (256 * 1024 * 2) : w + (size_t)u.pn * (256 * 1024 * 2); }
        DI void a_offs(int, const p8::Unit&, const int (&)[2], const int (&)[2], unsigned (&)[2][2]) const {}
    };
    O1Sched S{(const char*)hb, (const char*)w};
    p8::gemm_phase<true, false>(lds, 1024, S, [&](const p8::f32x4 (&acc)[2][2][4][2], const p8::Unit& un, int wr, int wc, int fr, int fq) __attribute__((always_inline)) {
        const int r0 = wr * 64 + fr, c0 = wc * 32 + 8 * fq;
        const int m0 = un.pm * 256;
        if (un.x0) {
            bfr* o = vT + ((size_t)((m0 >> 11) * 512 + (un.pn - 4) * 256 + r0)) * SEQ + (m0 & (SEQ - 1)) + c0;
#pragma unroll
            for (int ai = 0; ai < 2; ++ai)
#pragma unroll
                for (int m = 0; m < 4; ++m)
#pragma unroll
                    for (int bj = 0; bj < 2; ++bj)
                        p8::st16(o + (size_t)(ai * 128 + m * 16) * SEQ + bj * 128, p8::pack_bf8(acc[ai][bj][m][0], acc[ai][bj][m][1]));
        } else if (un.pn < 4) {
            bfr* o = qk + (size_t)(m0 + r0) * 1024 + un.pn * 256 + c0;
#pragma unroll
            for (int ai = 0; ai < 2; ++ai)
#pragma unroll
                for (int m = 0; m < 4; ++m)
#pragma unroll
                    for (int bj = 0; bj < 2; ++bj)
                        p8::st16(o + (size_t)(ai * 128 + m * 16) * 1024 + bj * 128, p8::pack_bf8(acc[ai][bj][m][0], acc[ai][bj][m][1]));
        } else {
#pragma unroll
            for (int bj = 0; bj < 2; ++bj) {
                const int cc = (un.pn - 6) * 256 + bj * 128 + c0;
                bfr* o = us5 + ((size_t)(cc >> 4) * NTOK + m0 + r0) * 16 + (cc & 15);
#pragma unroll
                for (int ai = 0; ai < 2; ++ai)
#pragma unroll
                    for (int m = 0; m < 4; ++m)
                        p8::st16(o + (size_t)(ai * 128 + m * 16) * 16, p8::pack_bf8(acc[ai][bj][m][0], acc[ai][bj][m][1]));
            }
        }
    });
    __syncthreads();
}

DI void phase_o2(char* lds, const Ctx& P, int li) {
    const bfr* qk = (const bfr*)(P.ws + OFF_U);
    bfr* qn = (bfr*)(P.ws + OFF_QN);
    bfr* kn = (bfr*)(P.ws + OFF_KN);
    const float* gq = P.in[I_QN] + li * 64;
    const float* gk = P.in[I_KN] + li * 64;
    const bfr* us5 = (const bfr*)(P.ws + OFF_US5);
    const bfr* bl = (const bfr*)(P.ws + OFF_S5BL) + (size_t)li * 32 * 128 * 512;
    float* xloc = (float*)(P.ws + OFF_XLOC);
    for (int t = blockIdx.x; t < 128; t += gridDim.x) {
        const int g = t >> 2, mt = t & 3;
        RowLoader A(us5 + (size_t)g * NTOK * 16, mt * 256, 512), B(bl + (size_t)g * 128 * 512, 0, 512);
        GEMM128(lds, 8, A, B, [&](const float* stg, int) __attribute__((always_inline)) {
            epi_rows8(stg, [&](int r, int c0, const float (&v)[8]) __attribute__((always_inline)) {
                float* d = xloc + ((size_t)g * 1024 + mt * 256 + r) * 128 + c0;
                *(float4*)d = make_float4(v[0], v[1], v[2], v[3]); *(float4*)(d + 4) = make_float4(v[4], v[5], v[6], v[7]);
            });
        });
    }
    const float2* __restrict__ rope = (const float2*)(P.ws + OFF_ROPE);
    const int total = NTOK * 16 * 8;
    constexpr int UN = 4;
    constexpr int gsz = NTHREADS;
    const int ntrips = total / (NTHREADS * UN);
    int tr0, tr1;
    if (gridDim.x == 256) { const int b = blockIdx.x; tr0 = b < 128 ? b * 6 : 768 + (b - 128) * 10; tr1 = tr0 + (b < 128 ? 6 : 10); }
    else { const int per = (ntrips + (int)gridDim.x - 1) / (int)gridDim.x; tr0 = blockIdx.x * per; tr1 = tr0 + per < ntrips ? tr0 + per : ntrips; }
    for (int tr = tr0; tr < tr1; ++tr) {
        const int idx0 = tr * (NTHREADS * UN) + ltid();
        uint2 ua[UN], ub[UN]; float4 r0[UN], r1[UN];
#pragma unroll
        for (int q = 0; q < UN; ++q) {
            int idx = idx0 + q * gsz; idx = idx < total ? idx : total - 1;
            const int l8 = idx & 7, item = idx >> 3;
            const int hm = item & 7, which = (item >> 3) & 1, tok = item >> 4;
            const bfr* src = qk + (size_t)tok * 1024 + which * 512 + hm * 64 + l8 * 4;
            ua[q] = *(const uint2*)src; ub[q] = *(const uint2*)(src + 32);
            const float4* rp = (const float4*)(rope + (size_t)(tok & (SEQ - 1)) * 32 + l8 * 4);
            r0[q] = rp[0]; r1[q] = rp[1];
        }
#pragma unroll
        for (int q = 0; q < UN; ++q) {
            const int idx = idx0 + q * gsz;
            const int l8 = idx & 7, item = idx >> 3;
            const int hm = item & 7, which = (item >> 3) & 1, tok = item >> 4;
            const int d0 = l8 * 4;
            float x1[4] = {bflo(ua[q].x), bfhi(ua[q].x), bflo(ua[q].y), bfhi(ua[q].y)};
            float x2[4] = {bflo(ub[q].x), bfhi(ub[q].x), bflo(ub[q].y), bfhi(ub[q].y)};
            float ss = 0.f;
#pragma unroll
            for (int j = 0; j < 4; ++j) ss += x1[j] * x1[j] + x2[j] * x2[j];
            ss += __shfl_xor(ss, 1); ss += __shfl_xor(ss, 2); ss += __shfl_xor(ss, 4);
            const float rs = rsqrtf(ss * (1.0f / 64.0f) + 1e-6f);
            const float* gg = which ? gk : gq;
            const float scl = which ? 1.0f : (0.125f * 1.4426950408889634f);
            const float cs[4] = {r0[q].x, r0[q].z, r1[q].x, r1[q].z}, sn[4] = {r0[q].y, r0[q].w, r1[q].y, r1[q].w};
            float o1[4], o2[4];
#pragma unroll
            for (int j = 0; j < 4; ++j) {
                const int i = d0 + j;
                const float a = x1[j] * rs * gg[i], b2 = x2[j] * rs * gg[32 + i];
                o1[j] = (a * cs[j] - b2 * sn[j]) * scl;
                o2[j] = (b2 * cs[j] + a * sn[j]) * scl;
            }
            if (idx < total) {
                bfr* dst = (which ? kn : qn) + (size_t)tok * 512 + hm * 64;
                *(uint2*)(dst + d0) = make_uint2(pk2(o1[0], o1[1]), pk2(o1[2], o1[3]));
                *(uint2*)(dst + 32 + d0) = make_uint2(pk2(o2[0], o2[1]), pk2(o2[2], o2[3]));
            }
        }
    }
}

DI void s5_scan(const Ctx& P, int li) {
    const float* __restrict__ xloc = (const float*)(P.ws + OFF_XLOC);
    bfr* __restrict__ xin = (bfr*)(P.ws + OFF_XIN);
    const float* l32 = (const float*)(P.ws + OFF_S5L32) + (size_t)li * 32 * 128;
    const int tq = ltid();
    if (tq >= 128) return;
    for (int idx = blockIdx.x * 128 + tq; idx < 32 * 16 * 64; idx += gridDim.x * 128) {
        const int p = idx & 63, b = (idx >> 6) & 15, g = idx >> 10;
        const float lr = l32[g * 128 + 2 * p], lim = l32[g * 128 + 2 * p + 1];
        const size_t o0 = ((size_t)g * 1024 + b * 64) * 128 + 2 * p;
        float xr = 0.f, xi = 0.f;
#pragma unroll 1
        for (int c0 = 0; c0 < 64; c0 += 16) {
            float2 a[16];
#pragma unroll
            for (int j = 0; j < 16; ++j) a[j] = *(const float2*)(xloc + o0 + (size_t)(c0 + j) * 128);
#pragma unroll
            for (int j = 0; j < 16; ++j) {
                *(unsigned*)(xin + o0 + (size_t)(c0 + j) * 128) = pk2(xr, xi);
                const float nr = lr * xr - lim * xi + a[j].x, ni = lr * xi + lim * xr + a[j].y;
                xr = nr; xi = ni;
            }
        }
    }
}

DI void attn_item(char* lds, const Ctx& P, int b, int h, int qt, float lam, float lam_init, const float* subln) {
    const bfr* qn = (const bfr*)(P.ws + OFF_QN);
    const bfr* kn = (const bfr*)(P.ws + OFF_KN);
    const bfr* vT = (const bfr*)(P.ws + OFF_VT) + (size_t)(b * 4 + h) * 128 * SEQ;
    bfr* am = (bfr*)(P.ws + OFF_AMIX);
    const int tid = ltid(), lane = tid & 63, wave = tid >> 6;
    const int m = wave >> 2, qw = (wave & 3) * 32;
    const int q0 = qt * 128 + qw;
    const int ln = lane & 31, hf = lane >> 5;
    bf16x8 qf[4];
    {
        const bfr* qp = qn + ((size_t)b * SEQ + q0 + ln) * 512 + h * 128 + m * 64 + hf * 8;
#pragma unroll
        for (int ks = 0; ks < 4; ++ks) qf[ks] = *(const bf16x8*)(qp + ks * 16);
    }
    f32x16 o[4];
#pragma unroll
    for (int d = 0; d < 4; ++d)
#pragma unroll
        for (int r = 0; r < 16; ++r) o[d][r] = 0.f;
    float mrun = 0.f, lrun = 0.f;
    const int nkt = 2 * (qt + 1);
    const int lrow = tid >> 3, lcol = (tid & 7) * 8;
    const bfr* kbase = kn + ((size_t)b * SEQ) * 512 + h * 128;
    unsigned ko = (unsigned)(lrow * 512 + lcol) * 2u, vo = (unsigned)(lrow * SEQ + lcol) * 2u;
    asm volatile("" : "+v"(ko), "+v"(vo));
    uint4 rk0, rk1, rv0, rv1;
#define ATT_GLOAD(kt_) do { const char* kp_ = (const char*)(kbase + (size_t)(kt_) * (64 * 512)); const char* vp_ = (const char*)(vT + (kt_) * 64); \
        rk0 = *(const uint4*)(kp_ + ko); rk1 = *(const uint4*)(kp_ + 64 * 2 + ko); \
        rv0 = *(const uint4*)(vp_ + vo); rv1 = *(const uint4*)(vp_ + 64 * SEQ * 2 + vo); } while (0)
#define ATT_S1(base_, i_, RK, RV) { *(uint4*)((base_) + (64 * (i_)) * LDA * 2) = RK; \
        *(uint4*)((base_) + TILE_B + (64 * (i_)) * LDA * 2) = RV; }
#define ATT_LSTORE(buf_) do { char* base_ = lds + (buf_) * (2 * TILE_B) + s_off; ATT_S1(base_, 0, rk0, rv0) ATT_S1(base_, 1, rk1, rv1) } while (0)
    int k_off = ((m * 64 + ln) * LDA + hf * 8) * 2;
    int v_off = TILE_B + (ln * LDA + 4 * hf) * 2;
    int s_off = (lrow * LDA + lcol) * 2;
    asm volatile("" : "+v"(k_off), "+v"(v_off), "+v"(s_off));
#define ATT_VLD(V_, vbase_, g_) do { _Pragma("unroll") for (int d_ = 0; d_ < 4; ++d_) { \
                V_[2 * d_] = *(const uint2*)((vbase_) + ((d_ * 32) * LDA + 16 * (g_)) * 2); V_[2 * d_ + 1] = *(const uint2*)((vbase_) + ((d_ * 32) * LDA + 16 * (g_) + 8) * 2); } } while (0)
#define ATT_PVF(V_, pf_) do { _Pragma("unroll") for (int d_ = 0; d_ < 4; ++d_) \
                    o[d_] = MFMA32(__builtin_bit_cast(bf16x8, make_uint4(V_[2 * d_].x, V_[2 * d_].y, V_[2 * d_ + 1].x, V_[2 * d_ + 1].y)), (pf_), o[d_]); } while (0)
#define ATT_PV_ALL(vbase_, P0, P1, P2, P3) do { uint2 va[8], vb[8]; \
                ATT_VLD(va, vbase_, 0); \
                ATT_VLD(vb, vbase_, 1); ATT_PVF(va, P0); \
                ATT_VLD(va, vbase_, 2); ATT_PVF(vb, P1); \
                ATT_VLD(vb, vbase_, 3); ATT_PVF(va, P2); \
                ATT_PVF(vb, P3); } while (0)
    ATT_GLOAD(0); ATT_LSTORE(0);
    __syncthreads();
    int bc = 0, bn = 1, bp = 2;
    bf16x8 pp[4];
    bool have_prev = false;
#pragma unroll
    for (int g = 0; g < 4; ++g) pp[g] = (bf16x8){0, 0, 0, 0, 0, 0, 0, 0};
#pragma unroll 1
    for (int kt = 0; kt < nkt; ++kt) {
        const bool more = (kt + 1 < nkt);
        if (more) ATT_GLOAD(kt + 1);
        const char* ks_ = lds + bc * (2 * TILE_B) + k_off;
        const char* vs_ = lds + bc * (2 * TILE_B) + v_off;
        if (m == 1 && have_prev) {
            const char* vp_ = lds + bp * (2 * TILE_B) + v_off;
            ATT_PV_ALL(vp_, pp[0], pp[1], pp[2], pp[3]);
            have_prev = false;
        }
        if (kt * 64 <= q0 + 31) {
            f32x16 s[2];
            const float negm = -mrun;
#pragma unroll
            for (int kb = 0; kb < 2; ++kb) {
#pragma unroll
                for (int r = 0; r < 16; ++r) s[kb][r] = negm;
#pragma unroll
                for (int ks = 0; ks < 4; ++ks) {
                    const bf16x8 kf = *(const bf16x8*)(ks_ + ((kb * 32) * LDA + ks * 16) * 2);
                    s[kb] = MFMA32(kf, qf[ks], s[kb]);
                }
            }
            const int qpos = q0 + ln;
            if (kt * 64 + 63 > q0) {
#pragma unroll
                for (int kb = 0; kb < 2; ++kb)
#pragma unroll
                    for (int r = 0; r < 16; ++r) {
                        const int key = kt * 64 + kb * 32 + (r & 3) + 8 * (r >> 2) + 4 * hf;
                        if (key > qpos) s[kb][r] = -INFINITY;
                    }
            }
            float mx = s[0][0];
#pragma unroll
            for (int kb = 0; kb < 2; ++kb)
#pragma unroll
                for (int r = 0; r < 16; ++r) mx = fmaxf(mx, s[kb][r]);
            mx = fmaxf(mx, __shfl_xor(mx, 32));
            if (kt == 0 || __any(mx > 8.0f)) {
                const float delta = (kt == 0 || mx > 8.0f) ? mx : 0.f;
                const float alpha = __builtin_amdgcn_exp2f(-delta);
                mrun += delta;
                lrun *= alpha;
#pragma unroll
                for (int kb = 0; kb < 2; ++kb)
#pragma unroll
                    for (int r = 0; r < 16; ++r) s[kb][r] -= delta;
#pragma unroll
                for (int d = 0; d < 4; ++d)
#pragma unroll
                    for (int r = 0; r < 16; ++r) o[d][r] *= alpha;
            }
            float rsum = 0.f;
#pragma unroll
            for (int kb = 0; kb < 2; ++kb)
#pragma unroll
                for (int r = 0; r < 16; ++r) { const float pv_ = __builtin_amdgcn_exp2f(s[kb][r]); s[kb][r] = pv_; rsum += pv_; }
            lrun += rsum;
            bf16x8 pf[4];
#pragma unroll
            for (int g = 0; g < 4; ++g) { const int kb_ = g >> 1, st_ = g & 1;
                pf[g] = __builtin_bit_cast(bf16x8, make_uint4(pk2(s[kb_][8 * st_ + 0], s[kb_][8 * st_ + 1]), pk2(s[kb_][8 * st_ + 2], s[kb_][8 * st_ + 3]),
                                                              pk2(s[kb_][8 * st_ + 4], s[kb_][8 * st_ + 5]), pk2(s[kb_][8 * st_ + 6], s[kb_][8 * st_ + 7]))); }
            if (m == 0) {
                ATT_PV_ALL(vs_, pf[0], pf[1], pf[2], pf[3]);
            } else {
#pragma unroll
                for (int g = 0; g < 4; ++g) pp[g] = pf[g];
                have_prev = true;
            }
        }
        if (more) ATT_LSTORE(bn);
        __syncthreads();
        { const int t_ = bp; bp = bc; bc = bn; bn = t_; }
    }
    if (m == 1 && have_prev) {
        const char* vp_ = lds + bp * (2 * TILE_B) + v_off;
        ATT_PV_ALL(vp_, pp[0], pp[1], pp[2], pp[3]);
    }
    __syncthreads();
#undef ATT_VLD
#undef ATT_PVF
#undef ATT_PV_ALL
    const float ltot = lrun + __shfl_xor(lrun, 32);
    const float linv = 1.0f / ltot;
    float* ob = (float*)lds;
    int o_off = (m * 128 + qw + ln) * 129 + 4 * hf;
    asm volatile("" : "+v"(o_off));
#pragma unroll
    for (int d = 0; d < 4; ++d)
#pragma unroll
        for (int r = 0; r < 16; ++r) ob[o_off + d * 32 + (r & 3) + 8 * (r >> 2)] = o[d][r] * linv;
    __syncthreads();
#pragma unroll
    for (int it = 0; it < 4; ++it) {
        const int idx = it * NTHREADS + tid;
        const int q = idx >> 4, c0 = (idx & 15) * 8;
        float v[8];
        float ss = 0.f;
        int r_off = q * 129 + c0;
        asm volatile("" : "+v"(r_off));
#pragma unroll
        for (int j = 0; j < 8; ++j) { v[j] = ob[r_off + j] - lam * ob[r_off + 128 * 129 + j]; ss += v[j] * v[j]; }
        ss = row16_sum(ss);
        const float rs = rsqrtf(ss * (1.0f / 128.0f) + 1e-5f) * (1.0f - lam_init);
#pragma unroll
        for (int j = 0; j < 8; ++j) v[j] = v[j] * rs * subln[c0 + j];
        *(uint4*)(am + ((size_t)b * SEQ + qt * 128 + q) * 1024 + h * 128 + c0) = pack8(v);
    }
    __syncthreads();
}

DI void phase_o3(char* lds, const Ctx& P, int li, int layer) {
    s5_scan(P, li);
    float lam;
    {
        const int j = ltid() & 63;
        const float s1 = wave_sum(P.in[I_LQ1][li * 64 + j] * P.in[I_LK1][li * 64 + j]);
        const float s2 = wave_sum(P.in[I_LQ2][li * 64 + j] * P.in[I_LK2][li * 64 + j]);
        const float lam_init0 = 0.8f - 0.6f * __expf(-0.3f * (float)layer);
        lam = __expf(s1) - __expf(s2) + lam_init0;
    }
    const float lam_init = 0.8f - 0.6f * __expf(-0.3f * (float)layer);
    const float* subln = P.in[I_SUBLN] + li * 128;
    for (int item = blockIdx.x; item < 512; item += gridDim.x) {
        const int bh = item >> 3, pr = item & 7;
        for (int half = 0; half < 2; ++half) attn_item(lds, P, bh >> 2, bh & 3, half ? 15 - pr : pr, lam, lam_init, subln);
    }
}

DI void phase_o4(char* lds, const Ctx& P, int li) {
    const bfr* us5 = (const bfr*)(P.ws + OFF_US5);
    const bfr* xin = (const bfr*)(P.ws + OFF_XIN);
    const bfr* gt = (const bfr*)(P.ws + OFF_S5GT) + (size_t)li * 32 * 512 * 640;
    const float* dsk = P.in[I_S5D] + li * 512;
    bfr* zb = (bfr*)(P.ws + OFF_ZBUF);
    for (int t = blockIdx.x; t < 512; t += gridDim.x) {
        const int g = t >> 4, mt = (t >> 2) & 3, nt = ((t / (int)gridDim.x) & 1) ? 3 - (t & 3) : (t & 3);
        const int nloc = 2 * (nt + 1);
        const bfr* ag = us5 + (size_t)g * NTOK * 16;
        const bfr* xg = xin + (size_t)g * 1024 * 128;
        const int tq = ltid();
        const int arow = mt * 256 + (tq >> 3), acol = gt_lcol(tq);
        auto aptr = [&](int i, int kt) __attribute__((always_inline)) -> const bfr* {
            return (kt < nloc) ? ag + (size_t)(arow + 64 * i) * 512 + kt * 64 + acol
                               : xg + (size_t)(arow + 64 * i) * 128 + (kt - nloc) * 64 + acol;
        };
        const bfr* bg = gt + (size_t)g * 512 * 640 + (size_t)(nt * 128 + (tq >> 3)) * 640 + acol;
        auto bptr = [&](int i, int kt) __attribute__((always_inline)) -> const bfr* {
            return bg + (size_t)(64 * i) * 640 + ((kt < nloc) ? kt : (8 + kt - nloc)) * 64;
        };
        GEMM128(lds, nloc + 2, aptr, bptr, [&](const float* stg, int) __attribute__((always_inline)) {
            epi_rows8_pre<uint4>(stg,
                [&](int r, int c0) __attribute__((always_inline)) -> uint4 {
                    const int n = nt * 128 + c0;
                    return *(const uint4*)(ag + ((size_t)(mt * 256 + r) * 32 + (n >> 4)) * 16 + (n & 15)); },
                [&](int r, int c0, const float (&v)[8], const uint4& up) __attribute__((always_inline)) {
                    const int cb = mt * 256 + r;
                    const int n = nt * 128 + c0, tt = n >> 4, c1 = n & 15;
                    const size_t tok = (size_t)cb * 32 + tt;
                    float uu[8], z[8];
                    unpack8(up, uu);
#pragma unroll
                    for (int j = 0; j < 8; ++j) {
                        const float y = v[j] + dsk[g * 16 + c1 + j] * uu[j];
                        const float inner = 0.7978845608028654f * (y + 0.044715f * y * y * y);
                        z[j] = 0.5f * y * (1.0f + ftanh(inner));
                    }
                    *(uint4*)(zb + tok * 512 + g * 16 + c1) = pack8(z);
                });
        });
    }
}

DI void phase_o5(char* lds, const Ctx& P, int li) {
    const bfr* zb = (const bfr*)(P.ws + OFF_ZBUF);
    const bfr* w = (const bfr*)(P.ws + OFF_GLUT) + (size_t)li * 512 * 512;
    bfr* am = (bfr*)(P.ws + OFF_AMIX);
    p8::PlainSched S{(const char*)zb, (const char*)w, 128, 2, 256, (size_t)256 * 512 * 2};
    p8::gemm_phase<true, false>(lds, 512, S, [&](const p8::f32x4 (&acc)[2][2][4][2], const p8::Unit& un, int wr, int wc, int fr, int fq) __attribute__((always_inline)) {
        const int row = un.pm * 256 + wr * 64 + fr, col = un.pn * 256 + wc * 32 + 8 * fq;
#pragma unroll
        for (int ai = 0; ai < 2; ++ai) {
            uint4 zp[4][2];
#pragma unroll
            for (int m = 0; m < 4; ++m)
#pragma unroll
                for (int bj = 0; bj < 2; ++bj) zp[m][bj] = *(const uint4*)(zb + (size_t)(row + ai * 128 + m * 16) * 512 + col + bj * 128);
#pragma unroll
            for (int m = 0; m < 4; ++m)
#pragma unroll
                for (int bj = 0; bj < 2; ++bj) {
                    float zz[8], o[8];
                    unpack8(zp[m][bj], zz);
                    const p8::f32x4 a0 = acc[ai][bj][m][0], a1 = acc[ai][bj][m][1];
#pragma unroll
                    for (int j = 0; j < 4; ++j) { o[j] = zz[j] * sigmoidf_(a0[j]); o[4 + j] = zz[4 + j] * sigmoidf_(a1[j]); }
                    *(uint4*)(am + (size_t)(row + ai * 128 + m * 16) * 1024 + 512 + col + bj * 128) = pack8(o);
                }
        }
    });
    __syncthreads();
}
DI void phase_router(char* lds, const Ctx& P, int layer) {
    const float* x = layer == 0 ? P.in[I_X] : P.out;
    bfr* hb = (bfr*)(P.ws + OFF_HB);
    bfr* hlo = (bfr*)(P.ws + OFF_HLO);
    const bfr* rhi = (const bfr*)(P.ws + OFF_RHI) + (size_t)layer * 128 * 1024;
    const bfr* rlo = (const bfr*)(P.ws + OFF_RLO) + (size_t)layer * 128 * 1024;
    int* gcnt = (int*)(P.ws + OFF_CNT) + layer * 64;
    int* stok = (int*)(P.ws + OFF_TOK);
    float* tgate = (float*)(P.ws + OFF_TGATE);
    int* tslot = (int*)(P.ws + OFF_TSLOT);
    int* lcnt = (int*)(lds + LDS_AUX);
    int* lbase = lcnt + 64;
    const float* bg = P.in[I_MBG] + layer * 4;
    const float* be = P.in[I_MBE] + layer * 32;
    const int tid = ltid();
    for (int u = blockIdx.x; u < 256; u += gridDim.x) {
        const int m0 = u * 128;
        norm_rows(x, P.in[I_NFFN] + (size_t)layer * DM, hb, hlo, nullptr, m0, 128, (const bfr*)(P.ws + OFF_MIX));
        __syncthreads();
        const size_t roff = (size_t)(m0 + (tid >> 3)) * 1024 + gt_lcol(tid);
        const size_t boff = (size_t)(tid >> 3) * 1024 + gt_lcol(tid);
        auto aptr = [&](int i, int kt) __attribute__((always_inline)) -> const bfr* { return (kt < 16 ? hb : hlo) + roff + (size_t)(64 * i) * 1024 + (kt & 15) * 64; };
        auto bptr = [&](int i, int kt) __attribute__((always_inline)) -> const bfr* { return (kt < 16 ? rlo : rhi) + boff + (size_t)(64 * i) * 1024 + (kt & 15) * 64; };
        gemm8_ring128(lds, 32, aptr, bptr, [&](const float* stg, int) __attribute__((always_inline)) {
            if (tid < 64) lcnt[tid] = 0;
            __syncthreads();
            int seg0 = 0, seg1 = 0, p0 = 0, p1 = 0;
            float g0 = 0.f, g1 = 0.f;
            if (tid < 128) {
                const float* row = stg + tid * STG_LD;
                float gl[4];
#pragma unroll
                for (int j = 0; j < 4; ++j) gl[j] = row[32 + j] + row[96 + j] + bg[j];
                int gt = 0; float gm = gl[0];
#pragma unroll
                for (int j = 1; j < 4; ++j) if (gl[j] > gm) { gm = gl[j]; gt = j; }
                float gs = 0.f;
#pragma unroll
                for (int j = 0; j < 4; ++j) gs += __expf(gl[j] - gm);
                const float gw = 1.0f / gs;
                float l1 = -INFINITY, l2 = -INFINITY; int j1 = 0, j2 = 0;
                for (int j = 0; j < 8; ++j) {
                    const float v = row[gt * 8 + j] + row[64 + gt * 8 + j] + be[gt * 8 + j];
                    if (v > l1) { l2 = l1; j2 = j1; l1 = v; j1 = j; }
                    else if (v > l2) { l2 = v; j2 = j; }
                }
                const float w1 = 1.0f / (1.0f + __expf(l2 - l1));
                g0 = gw * w1; g1 = gw * (1.0f - w1);
                seg0 = gt * 8 + j1; seg1 = 32 + gt * 8 + j2;
                p0 = atomicAdd(&lcnt[seg0], 1);
                p1 = atomicAdd(&lcnt[seg1], 1);
            }
            __syncthreads();
            if (tid < 64) { const int c = lcnt[tid]; lbase[tid] = c ? atomicAdd(&gcnt[tid], c) : 0; }
            __syncthreads();
            if (tid < 128) {
                const int q0 = lbase[seg0] + p0, q1 = lbase[seg1] + p1;
                stok[(size_t)seg0 * NTOK + q0] = m0 + tid;
                stok[(size_t)seg1 * NTOK + q1] = m0 + tid;
                tslot[m0 + tid] = seg0 * 32768 + q0; tslot[NTOK + m0 + tid] = seg1 * 32768 + q1;
                *(float2*)(tgate + 2 * (size_t)(m0 + tid)) = make_float2(g0, g1);
            }
        });
    }
}

DI void moe_tables(char* lds, const Ctx& P, int layer) {
    int* cnt = (int*)(lds + LDS_AUX); int* rb0 = cnt + 64; int* hoff = rb0 + 65;
    int* rbseg = (int*)(lds + 135168);
    const int* gcnt = (const int*)(P.ws + OFF_CNT) + layer * 64;
    const int tid = ltid();
    if (tid < 64) {
        const int c = gcnt[tid];
        const int nb = (c + 255) >> 8;
        int inc = nb;
#pragma unroll
        for (int d = 1; d < 64; d <<= 1) { const int o = __shfl_up(inc, d); if (tid >= d) inc += o; }
        cnt[tid] = c; rb0[tid] = inc - nb; hoff[tid] = (inc - nb) * 256;
        if (tid == 63) rb0[64] = inc;
    }
    __syncthreads();
    if (tid < rb0[64] && tid < 320) {
        int s = 0;
#pragma unroll
        for (int st = 32; st > 0; st >>= 1) if (rb0[s + st] <= tid) s += st;
        rbseg[tid] = s;
    }
    __syncthreads();
}
DI int moe_find_seg(const int* rb0, int rbi) { return ((const int*)((const char*)rb0 - 256 - LDS_AUX + 135168))[rbi]; }

DI void phase_moe_up(char* lds, const Ctx& P, int layer) {
    moe_tables(lds, P, layer);
    const int* cnt = (const int*)(lds + LDS_AUX); const int* rb0 = cnt + 64; const int* hoff = rb0 + 65;
    const bfr* hb = (const bfr*)(P.ws + OFF_HB);
    const bfr* wgu = (const bfr*)(P.ws + OFF_MWGU);
    const int* stok = (const int*)(P.ws + OFF_TOK);
    bfr* hid = (bfr*)(P.ws + OFF_HID);
    const int ntiles = rb0[64] * 4, G = gridDim.x;
    const int full = (ntiles / G) * G, rem = ntiles - full;
    const bool halves = rem > 0 && 2 * rem <= G;
    const int limit = halves ? full : ntiles, nrb = rb0[64];
    int* ltokt = (int*)(lds + LDS_AUX + 1024);
    for (int ui = 0; ui < 20; ++ui) {
        const int L = ui * G + (int)blockIdx.x;
        if (L >= limit) break;
        int rbi, nt; tile_remap(L, nrb, 4, rbi, nt);
        const int seg = moe_find_seg(rb0, rbi);
        const int tq = ltid();
        if (tq < 256) { const int c = cnt[seg]; int p = (rbi - rb0[seg]) * 256 + tq; p = p < c ? p : c - 1; ltokt[ui * 256 + tq] = stok[(size_t)seg * NTOK + p]; }
    }
    __syncthreads();
    {
        struct UpSched {
            const char* hb; const char* wgu; const int* rb0; const LAS int* ltokt; int limit, nrb;
            DI bool next(int i, p8::Unit& u) const {
                const int L = i * (int)gridDim.x + (int)blockIdx.x; if (L >= limit) return false;
                tile_remap(L, nrb, 4, u.pm, u.pn); u.x0 = moe_find_seg(rb0, u.pm); u.x1 = u.pm - rb0[u.x0]; return true; }
            DI const char* a_base(const p8::Unit&) const { return hb; }
            DI const char* b_base(const p8::Unit& u) const { return wgu + (size_t)(u.x0 & 31) * (1024 * 1024 * 2) + (size_t)u.pn * (256 * 1024 * 2); }
            DI void a_offs(int ui, const p8::Unit&, const int (&R)[2], const int (&C)[2], unsigned (&off)[2][2]) const {
#pragma unroll
                for (int h = 0; h < 2; ++h)
#pragma unroll
                    for (int i = 0; i < 2; ++i) off[h][i] = (unsigned)ltokt[ui * 256 + h * 128 + R[i]] * 2048u + (unsigned)C[i] * 2u;
            }
        };
        UpSched S{(const char*)hb, (const char*)wgu, rb0, (const LAS int*)ltokt, limit, nrb};
        p8::gemm_phase<true, true>(lds, 1024, S, [&](const p8::f32x4 (&acc)[2][2][4][2], const p8::Unit& un, int wr, int wc, int fr, int fq) __attribute__((always_inline)) {
            bfr* o = hid + ((size_t)hoff[un.x0] + un.x1 * 256 + wr * 64 + fr) * 512 + ((un.pn * 256 + wc * 32 + 8 * fq) >> 1);
#pragma unroll
            for (int ai = 0; ai < 2; ++ai)
#pragma unroll
                for (int m = 0; m < 4; ++m)
#pragma unroll
                    for (int bj = 0; bj < 2; ++bj) {
                        const p8::f32x4 g = acc[ai][bj][m][0], up = acc[ai][bj][m][1];
                        float h4[4];
#pragma unroll
                        for (int j = 0; j < 4; ++j) h4[j] = g[j] * sigmoidf_(g[j]) * up[j];
                        p8::st8(o + (size_t)(ai * 128 + m * 16) * 512 + bj * 64, make_uint2(pk2(h4[0], h4[1]), pk2(h4[2], h4[3])));
                    }
        });
        __syncthreads();
    }
    if (halves && (int)blockIdx.x < 2 * rem) {
        const int t = full + ((int)blockIdx.x >> 1);
        const int hc = ((int)blockIdx.x & 1) * 128;
        int rbi, nt; tile_remap(t, rb0[64], 4, rbi, nt);
        const int seg = moe_find_seg(rb0, rbi);
        const int rb = rbi - rb0[seg], e = seg & 31, c = cnt[seg];
        const bfr* ap[4];
        const int tq = ltid();
#pragma unroll
        for (int i = 0; i < 4; ++i) {
            int p = rb * 256 + (tq >> 3) + 64 * i; p = p < c ? p : c - 1;
            ap[i] = hb + (size_t)stok[(size_t)seg * NTOK + p] * 1024 + gt_lcol(tq);
        }
        auto aptr = [&](int i, int kt) __attribute__((always_inline)) -> const bfr* { return ap[i] + kt * 64; };
        const size_t hrow0 = (size_t)hoff[seg] + rb * 256;
        RowLoader B(wgu + (size_t)e * 1024 * 1024, nt * 256 + hc, 1024);
        GEMM128(lds, 16, aptr, B, [&](const float* stg, int) __attribute__((always_inline)) {
            epi_rows8(stg, [&](int r, int c0, const float (&v)[8]) __attribute__((always_inline)) {
                float o[4];
#pragma unroll
                for (int j = 0; j < 4; ++j) o[j] = v[j] * sigmoidf_(v[j]) * v[4 + j];
                *(uint2*)(hid + (hrow0 + r) * 512 + ((nt * 256 + hc + c0) >> 1)) = make_uint2(pk2(o[0], o[1]), pk2(o[2], o[3]));
            });
        });
    }
}

DI void phase_moe_down(char* lds, const Ctx& P, int layer) {
    const int* cnt = (const int*)(lds + LDS_AUX); const int* rb0 = cnt + 64;
    const bfr* hid = (const bfr*)(P.ws + OFF_HID);
    const bfr* wd = (const bfr*)(P.ws + OFF_MWD);
    bfr* y = (bfr*)(P.ws + OFF_Y0);
    const int nrb = rb0[64];
    const int ntiles = nrb * 4, G = gridDim.x;
    const int full = (ntiles / G) * G, rem = ntiles - full;
    const bool halves = rem > 0 && 2 * rem <= G;
    const int limit = halves ? full : ntiles;
    {
        struct DnSched {
            const char* hid; const char* wd; const int* rb0; int limit, nrb;
            DI bool next(int i, p8::Unit& u) const {
                const int L = i * (int)gridDim.x + (int)blockIdx.x; if (L >= limit) return false;
                tile_remap(L, nrb, 4, u.pm, u.pn); u.x0 = moe_find_seg(rb0, u.pm); u.x1 = 0; return true; }
            DI const char* a_base(const p8::Unit& u) const { return hid + (size_t)u.pm * (256 * 512 * 2); }
            DI const char* b_base(const p8::Unit& u) const { return wd + (size_t)(u.x0 & 31) * (1024 * 512 * 2) + (size_t)u.pn * (256 * 512 * 2); }
            DI void a_offs(int, const p8::Unit&, const int (&)[2], const int (&)[2], unsigned (&)[2][2]) const {}
        };
        DnSched S{(const char*)hid, (const char*)wd, rb0, limit, nrb};
        p8::gemm_phase<true, false>(lds, 512, S, [&](const p8::f32x4 (&acc)[2][2][4][2], const p8::Unit& un, int wr, int wc, int fr, int fq) __attribute__((always_inline)) {
            bfr* o = y + (size_t)(un.pm * 256 + wr * 64 + fr) * 1024 + un.pn * 256 + wc * 32 + 8 * fq;
#pragma unroll
            for (int ai = 0; ai < 2; ++ai)
#pragma unroll
                for (int m = 0; m < 4; ++m)
#pragma unroll
                    for (int bj = 0; bj < 2; ++bj)
                        p8::st16(o + (size_t)(ai * 128 + m * 16) * 1024 + bj * 128, p8::pack_bf8(acc[ai][bj][m][0], acc[ai][bj][m][1]));
        });
        __syncthreads();
    }
    if (halves && (int)blockIdx.x < 2 * rem) {
        int rbi, nt; tile_remap(full + ((int)blockIdx.x >> 1), nrb, 4, rbi, nt);
        const int hc = ((int)blockIdx.x & 1) * 128;
        const int e = moe_find_seg(rb0, rbi) & 31;
        RowLoader A(hid, rbi * 256, 512), B(wd + (size_t)e * 1024 * 512, nt * 256 + hc, 512);
        GEMM128(lds, 8, A, B, [&](const float* stg, int) __attribute__((always_inline)) {
            epi_rows8(stg, [&](int r, int c0, const float (&v)[8]) __attribute__((always_inline)) {
                *(uint4*)(y + (size_t)(rbi * 256 + r) * 1024 + nt * 256 + hc + c0) = pack8(v);
            });
        });
    }
}
DI void phase_combine(char* lds, const Ctx& P, int layer) {
    const int* hoff = (const int*)(lds + LDS_AUX) + 64 + 65;
    const int* tslot = (const int*)(P.ws + OFF_TSLOT);
    const float* tgate = (const float*)(P.ws + OFF_TGATE);
    const bfr* y = (const bfr*)(P.ws + OFF_Y0);
    const bfr* mix = (const bfr*)(P.ws + OFF_MIX);
    float* x = P.out;
    const float* xsrc = layer == 0 ? P.in[I_X] : P.out;
    bfr* hb = (bfr*)(P.ws + OFF_HB);
    const float* g = P.in[I_NMIX] + (size_t)(layer < 3 ? layer + 1 : 0) * DM;
    const int tid_ = ltid();
    const int lane = tid_ & 63, wave = tid_ >> 6;
    for (int tt = blockIdx.x; tt < 512; tt += gridDim.x) {
        int ts0[8], ts1[8]; float2 gts[8];
#pragma unroll
        for (int k = 0; k < 8; ++k) { const size_t tok = (size_t)(tt * 64 + wave + 8 * k); ts0[k] = tslot[tok]; ts1[k] = tslot[NTOK + tok]; gts[k] = *(const float2*)(tgate + 2 * tok); }
#pragma unroll
        for (int kp = 0; kp < 2; ++kp) {
            float4 v[4][4]; uint2 a[4][4], b[4][4], mm[4][4];
#pragma unroll
            for (int q = 0; q < 4; ++q) {
                const int k = kp * 4 + q;
                const size_t tok = (size_t)(tt * 64 + wave + 8 * k);
                const bfr* y0 = y + (size_t)(hoff[ts0[k] >> 15] + (ts0[k] & 32767)) * 1024;
                const bfr* y1 = y + (size_t)(hoff[ts1[k] >> 15] + (ts1[k] & 32767)) * 1024;
#pragma unroll
                for (int i = 0; i < 4; ++i) {
                    v[q][i] = *(const float4*)(xsrc + tok * DM + i * 256 + lane * 4);
                    a[q][i] = *(const uint2*)(y0 + i * 256 + lane * 4);
                    b[q][i] = *(const uint2*)(y1 + i * 256 + lane * 4);
                    mm[q][i] = *(const uint2*)(mix + tok * DM + i * 256 + lane * 4);
                }
            }
#pragma unroll
            for (int q = 0; q < 4; ++q) {
                const int k = kp * 4 + q;
                const size_t tok = (size_t)(tt * 64 + wave + 8 * k);
                const float2 gt = gts[k];
                float ss = 0.f;
#pragma unroll
                for (int i = 0; i < 4; ++i) {
                    float4 w = v[q][i];
                    w.x += bflo(mm[q][i].x) + gt.x * bflo(a[q][i].x) + gt.y * bflo(b[q][i].x); w.y += bfhi(mm[q][i].x) + gt.x * bfhi(a[q][i].x) + gt.y * bfhi(b[q][i].x);
                    w.z += bflo(mm[q][i].y) + gt.x * bflo(a[q][i].y) + gt.y * bflo(b[q][i].y); w.w += bfhi(mm[q][i].y) + gt.x * bfhi(a[q][i].y) + gt.y * bfhi(b[q][i].y);
                    v[q][i] = w;
                    *(float4*)(x + tok * DM + i * 256 + lane * 4) = w;
                    ss += w.x * w.x + w.y * w.y + w.z * w.z + w.w * w.w;
                }
                if (layer < 3) {
                    ss = wave_sum(ss);
                    const float rs = rsqrtf(ss * (1.0f / DM) + 1e-6f);
#pragma unroll
                    for (int i = 0; i < 4; ++i) {
                        const float4 gg = *(const float4*)(g + i * 256 + lane * 4);
                        *(uint2*)(hb + tok * DM + i * 256 + lane * 4) = make_uint2(pk2(v[q][i].x * rs * gg.x, v[q][i].y * rs * gg.y), pk2(v[q][i].z * rs * gg.z, v[q][i].w * rs * gg.w));
                    }
                }
            }
        }
    }
}
constexpr int PH_PER_LAYER = 10;
constexpr int N_PHASES = 1 + 4 * PH_PER_LAYER;

DI void prologue_norm_queue(char* lds, const Ctx& P) {
    int* counter = (int*)(P.ws + OFF_CNT + 2048);
    volatile LAS int* slot = (volatile LAS int*)(lds + LDS_AUX);
    const int tid = ltid();
    for (;;) {
        __syncthreads();
        if (tid == 0) *slot = atomicAdd(counter, 1);
        __syncthreads();
        const int tt = *slot;
        if (tt >= 512) break;
        norm_rows(P.in[I_X], P.in[I_NMIX], (bfr*)(P.ws + OFF_HB), nullptr, nullptr, tt * 64, 64);
    }
}
DI void phase_prologue(char* lds, const Ctx& P) {
    for (int u = blockIdx.x; u < 64; u += gridDim.x) s5_tables(lds, P, u >> 5, u & 31);
    const bool excl = gridDim.x >= 128;
    if (excl && blockIdx.x < 64) { prologue_norm_queue(lds, P); return; }
    unsigned base = 0;
    const int wk = excl ? (int)blockIdx.x - 64 : (int)blockIdx.x, nw = excl ? (int)gridDim.x - 64 : (int)gridDim.x;
    for (int i = 0; i < 2; ++i) {
        cvt_matrix(lds, P.in[I_EWIN] + (size_t)i * 1024 * 2304, 1024, 2304, (bfr*)(P.ws + OFF_WINE) + (size_t)i * 2304 * 1024, 1024, 0, wk, nw, base);
        cvt_matrix(lds, P.in[I_EWOUT] + (size_t)i * 1024 * 1024, 1024, 1024, (bfr*)(P.ws + OFF_WOUTE) + (size_t)i * 1024 * 1024, 1024, 0, wk, nw, base);
        cvt_matrix(lds, P.in[I_OWIN] + (size_t)i * 1024 * 2048, 1024, 2048, (bfr*)(P.ws + OFF_WINO) + (size_t)i * 2048 * 1024, 1024, 0, wk, nw, base);
        cvt_matrix(lds, P.in[I_OWOUT] + (size_t)i * 1024 * 1024, 1024, 1024, (bfr*)(P.ws + OFF_WOUTO) + (size_t)i * 1024 * 1024, 1024, 0, wk, nw, base);
        {
            bfr* e1 = (bfr*)(P.ws + OFF_E2B1) + (size_t)i * 1536 * 256;
            cvt_matrix(lds, P.in[I_W2] + (size_t)i * 64 * 512, 64, 512, e1, 256, 0, wk, nw, base);
            cvt_matrix(lds, P.in[I_A2] + (size_t)i * 64 * 512, 64, 512, e1 + (size_t)512 * 256 + 64, 256, 0, wk, nw, base);
            cvt_matrix(lds, P.in[I_G2] + (size_t)i * 128 * 512, 128, 512, e1 + (size_t)1024 * 256 + 128, 256, 0, wk, nw, base);
            for (int g = 0; g < 4; ++g)
                cvt_matrix(lds, P.in[I_POOLW] + (size_t)(i * 4 + g) * 128 * 128, 128, 128, (bfr*)(P.ws + OFF_E2B2) + ((size_t)(i * 2 + (g >> 1)) * 256 + (g & 1) * 128) * 256 + (g & 1) * 128, 256, 0, wk, nw, base);
        }
        cvt_matrix(lds, P.in[I_WGLU] + (size_t)i * 512 * 512, 512, 512, (bfr*)(P.ws + OFF_GLUT) + (size_t)i * 512 * 512, 512, 0, wk, nw, base);
    }
    const int gtid = wk * NTHREADS + ltid(), gsz = nw * NTHREADS;
    {
        bfr* e1 = (bfr*)(P.ws + OFF_E2B1); bfr* e2 = (bfr*)(P.ws + OFF_E2B2);
        for (int idx = gtid; idx < 2 * 1536 * 32; idx += gsz) {
            const int kc = (idx & 31) * 8, n = (idx >> 5) % 1536;
            const bool live = n < 512 ? kc < 64 : (n < 1024 ? (kc >= 64 && kc < 128) : kc >= 128);
            if (!live) *(uint4*)(e1 + (size_t)(idx >> 5) * 256 + kc) = make_uint4(0u, 0u, 0u, 0u);
        }
        for (int idx = gtid; idx < 4 * 256 * 32; idx += gsz) {
            const int kc = (idx & 31) * 8, n = (idx >> 5) & 255;
            if ((n >= 128) != (kc >= 128)) *(uint4*)(e2 + (size_t)(idx >> 5) * 256 + kc) = make_uint4(0u, 0u, 0u, 0u);
        }
    }
    {
        float2* rope = (float2*)(P.ws + OFF_ROPE);
        for (int idx = gtid; idx < SEQ * 32; idx += gsz) {
            const int i = idx & 31, t = idx >> 5;
            const float invf = exp2f(-(float)i * (13.287712379549449f / 32.0f));
            float sn, cs;
            sincosf((float)t * invf, &sn, &cs);
            rope[idx] = make_float2(cs, sn);
        }
    }
    {
        bfr* rhi = (bfr*)(P.ws + OFF_RHI); bfr* rb1 = (bfr*)(P.ws + OFF_RLO);
        for (int idx = gtid; idx < 4 * 128 * 1024; idx += gsz) {
            const int k = idx & 1023, n = (idx >> 10) & 127, l = idx >> 17;
            const int nn = n & 63;
            float w = 0.f;
            if (nn < 32) w = P.in[I_MWE][((size_t)l * 1024 + k) * 32 + nn];
            else if (nn < 36) w = P.in[I_MWG][((size_t)l * 1024 + k) * 4 + (nn - 32)];
            const bfr h = f2bf(w);
            rhi[idx] = n < 64 ? h : (bfr)0;
            rb1[idx] = n < 64 ? h : f2bf(w - bf2f(h));
        }
    }
    {
        bfr* v12 = (bfr*)(P.ws + OFF_V12T);
        const float* v1 = P.in[I_V1]; const float* v2 = P.in[I_V2];
        for (int idx = gtid; idx < 512 * 512; idx += gsz) {
            const int k = idx & 511, n = idx >> 9;
            float s = 0.f;
            for (int r = 0; r < 32; ++r) s += v1[k * 32 + r] * v2[r * 512 + n];
            v12[idx] = f2bf(s);
        }
    }
    prologue_norm_queue(lds, P);
}

DI Ctx mkctx(unsigned char* ws, float* out) {
    size_t z = 0;
    asm volatile("" : "+s"(z));
    Ctx c;
    c.in.p = (KArgPtr)__builtin_amdgcn_kernarg_segment_ptr() + z;
    c.ws = ws + z; c.out = (float*)((char*)out + z);
    return c;
}
__global__ void __launch_bounds__(NTHREADS, 2) fwd_kernel(Params PA) {
    extern __shared__ __attribute__((aligned(16))) char lds[];
    if (threadIdx.x == 0) { *(uint4*)(lds + LDS_BYTES - 16) = make_uint4(0u, 0u, 0u, 0u); *(uint4*)(lds + LDS_BYTES - 32) = make_uint4(0u, 0u, 0u, 0u); }
    __syncthreads();
    XcdBarrier bar = xcd_barrier_post((unsigned*)(PA.ws + OFF_BAR), (volatile LAS unsigned*)(lds + LDS_BYTES - 16));
    const int lo = PA.ph_lo, hi = PA.ph_hi;
#ifndef RWKV_CHUNKED
#define RWKV_CHUNKED 1
#endif
#ifndef DUP_PH
#define DUP_PH (-1)
#endif
#define DUPX(k, call) do { call; if (DUP_PH == (k)) { __syncthreads(); call; } } while (0)
#define RUNS(id) ((id) >= lo && (id) < hi)
#define P mkctx(PA.ws, PA.out)
#ifndef TIME_SLOT
#define TIME_SLOT (-1)
#define TIME_PAR 2
#endif
    unsigned long long t0v = 0; bool tmark = false;
#define TIME_MATCH(id) (TIME_SLOT >= 0 && (id) >= 1 && ((id) - 1) % PH_PER_LAYER == TIME_SLOT && (TIME_PAR == 2 || ((((id) - 1) / PH_PER_LAYER) & 1) == TIME_PAR))
#define SEAM(id) do { if ((id) > lo && (id) < hi) { xcd_barrier(bar); \
        if (TIME_SLOT != -1 && tmark) { const unsigned long long t1_ = wall_clock64(); while (wall_clock64() - t1_ < t1_ - t0v) __builtin_amdgcn_s_sleep(4); tmark = false; } } \
        if (TIME_MATCH(id)) { t0v = wall_clock64(); tmark = true; } } while (0)
    if (TIME_SLOT == -2) { t0v = wall_clock64(); tmark = true; }
    if (RUNS(0)) DUPX(100, phase_prologue(lds, P));
    for (int layer = 0; layer < 4; ++layer) {
        const int base = 1 + layer * PH_PER_LAYER;
        const int li = layer >> 1;
#ifndef CVT_R2
#define CVT_R2 12
#endif
        const int cvt_per = (6144 + (int)gridDim.x - 1) / (int)gridDim.x;
        const int cvt_t0 = min((int)blockIdx.x * cvt_per, 6144), cvt_t1 = min(cvt_t0 + cvt_per, 6144), cvt_tm = min(cvt_t0 + CVT_R2, cvt_t1);
        const int cvt_ts = (layer & 1) ? cvt_t0 : cvt_tm;
        if ((layer & 1) == 0) {
            SEAM(base + 0); if (RUNS(base + 0)) DUPX(0, phase_e1(lds, P, li));
            SEAM(base + 1); if (RUNS(base + 1)) DUPX(1, phase_e2a(P, li));
            SEAM(base + 2); if (RUNS(base + 2)) DUPX(2, phase_e2b(lds, P, li));
#if RWKV_CHUNKED
            SEAM(base + 3); if (RUNS(base + 3)) { DUPX(43, phase_r1(lds, P, li)); if (DUP_PH >= 45 && DUP_PH <= 47) phase_r1(lds, P, li, DUP_PH - 44); xcd_barrier(bar); DUPX(44, phase_r2(lds, P, li, layer, cvt_t0, cvt_tm)); }
#else
            SEAM(base + 3); if (RUNS(base + 3)) { phase_e3(lds, P, li); if (DUP_PH == 3) phase_e3(lds, P, li, 3); }
#endif
            SEAM(base + 4); if (RUNS(base + 4)) DUPX(4, phase_e4(P, li));
            SEAM(base + 5); if (RUNS(base + 5)) { phase_wout(lds, P, (const bfr*)(P.ws + OFF_WOUTE) + (size_t)li * 1024 * 1024, (bfr*)(P.ws + OFF_MIX)); if (DUP_PH == 5) phase_wout(lds, P, (const bfr*)(P.ws + OFF_WOUTE) + (size_t)li * 1024 * 1024, (bfr*)(P.ws + OFF_EV)); }
        } else {
            SEAM(base + 0); if (RUNS(base + 0)) DUPX(10, phase_o1(lds, P, li));
            SEAM(base + 1); if (RUNS(base + 1)) DUPX(11, phase_o2(lds, P, li));
            SEAM(base + 2); if (RUNS(base + 2)) DUPX(12, phase_o3(lds, P, li, layer));
            SEAM(base + 3); if (RUNS(base + 3)) DUPX(13, phase_o4(lds, P, li));
            SEAM(base + 4); if (RUNS(base + 4)) DUPX(14, phase_o5(lds, P, li));
            SEAM(base + 5); if (RUNS(base + 5)) { phase_wout(lds, P, (const bfr*)(P.ws + OFF_WOUTO) + (size_t)li * 1024 * 1024, (bfr*)(P.ws + OFF_MIX)); if (DUP_PH == 5) phase_wout(lds, P, (const bfr*)(P.ws + OFF_WOUTO) + (size_t)li * 1024 * 1024, (bfr*)(P.ws + OFF_EV)); }
        }
        SEAM(base + 6);
        if (RUNS(base + 6)) {
            if (blockIdx.x & 1) { moe_convert_range(lds, P, layer, cvt_ts, cvt_t1); __syncthreads(); phase_router(lds, P, layer); }
            else { phase_router(lds, P, layer); __syncthreads(); moe_convert_range(lds, P, layer, cvt_ts, cvt_t1); }
        }
        SEAM(base + 7); if (RUNS(base + 7)) DUPX(7, phase_moe_up(lds, P, layer));
        SEAM(base + 8); if (RUNS(base + 8)) DUPX(8, phase_moe_down(lds, P, layer));
        SEAM(base + 9); if (RUNS(base + 9)) DUPX(9, phase_combine(lds, P, layer));
    }
    if (TIME_SLOT != -1) SEAM(N_PHASES - 1);
#undef P
#undef RUNS
#undef SEAM
}

#ifndef N_LAUNCH_SPLIT
#define N_LAUNCH_SPLIT 0
#endif
extern "C" void kernel_launch(void* const* d_in, const int* in_sizes, int n_in, void* d_out, int out_size, void* d_ws, size_t ws_size, hipStream_t stream) {
    static int grid = 0;
    if (grid == 0) {
        if (n_in != N_INPUTS || out_size != NTOK * DM || ws_size < WS_NEEDED || ws_size < OFF_E2B_END) {
            fprintf(stderr, "kernel_launch: unexpected shapes: n_in %d out %d ws %zu (need %zu)\n", n_in, out_size, ws_size, (size_t)WS_NEEDED);
            grid = -1; return;
        }
        int dev = 0, cus = 0, per_cu = 0;
        (void)hipGetDevice(&dev);
        (void)hipDeviceGetAttribute(&cus, hipDeviceAttributeMultiprocessorCount, dev);
        if (hipFuncSetAttribute((const void*)fwd_kernel, hipFuncAttributeMaxDynamicSharedMemorySize, LDS_BYTES) != hipSuccess) { fprintf(stderr, "kernel_launch: hipFuncSetAttribute failed\n"); grid = -1; return; }
        if (hipOccupancyMaxActiveBlocksPerMultiprocessor(&per_cu, (const void*)fwd_kernel, NTHREADS, LDS_BYTES) != hipSuccess) per_cu = 1;
        (void)hipGetLastError();
        if (per_cu < 1) per_cu = 1;
        if (per_cu > 1) per_cu = 1;
        if (cus <= 0) cus = 256;
        grid = cus * per_cu;
    }
    if (grid < 0) return;
    (void)hipMemsetAsync(d_ws, 0, OFF_ZERO_END, stream);
    Params p{};
    for (int i = 0; i < N_INPUTS; ++i) p.in[i] = (const float*)d_in[i];
    p.out = (float*)d_out; p.ws = (unsigned char*)d_ws;
#if N_LAUNCH_SPLIT
    for (int ph = 0; ph < N_PHASES - 1; ++ph) {
        p.ph_lo = ph; p.ph_hi = ph + 1;
        hipLaunchKernelGGL(fwd_kernel, dim3(grid), dim3(NTHREADS), LDS_BYTES, stream, p);
    }
#else
    p.ph_lo = 0; p.ph_hi = N_PHASES;
    hipLaunchKernelGGL(fwd_kernel, dim3(grid), dim3(NTHREADS), LDS_BYTES, stream, p);
#endif
}
```
